# Optimizing an MI355X kernel written in HIP

```python
import math
import jax, jax.numpy as jnp
from jax import lax
import numpy as np

D_MODEL = 1024
BATCH = 8
SEQ = 2048
DEPTH = 2

HEAD_DIM = 64
N_Q_HEADS = 8
N_KV_HEADS = 2
WINDOW = 128
BLOCK = 128
N_BUCKETS = 32
MAX_DISTANCE = 128
SSM_HEADS = 8
SSM_HEAD_DIM = 64
SSM_GROUPS = 2
SSM_STATE = 128
CONV_WIDTH = 4
CHUNK = 128
D_FF = 4 * D_MODEL

D_ATTN = N_Q_HEADS * HEAD_DIM
D_KV = N_KV_HEADS * HEAD_DIM
D_SSM = SSM_HEADS * SSM_HEAD_DIM
D_BC = SSM_GROUPS * SSM_STATE
D_CONV = D_SSM + 2 * D_BC
D_MIX = D_ATTN + D_SSM
D_IN = D_ATTN + 2 * D_KV + D_SSM + D_CONV + SSM_HEADS
SPLITS = [D_ATTN, D_ATTN + D_KV, D_ATTN + 2 * D_KV, D_ATTN + 2 * D_KV + D_SSM,
          D_ATTN + 2 * D_KV + D_SSM + D_CONV]
EPS = 1e-6

kernel_name = "hymba_swa_sink_ssd_hybrid"


def rms_norm(x, g):
    xf = x.astype(jnp.float32)
    y = xf * lax.rsqrt(jnp.mean(jnp.square(xf), axis=-1, keepdims=True) + EPS)
    return (y * g.astype(jnp.float32)).astype(x.dtype)


def t5_causal_bucket(dist):
    max_exact = N_BUCKETS // 2
    d_f = jnp.maximum(dist, 1).astype(jnp.float32)
    large = max_exact + (jnp.log(d_f / max_exact) / math.log(MAX_DISTANCE / max_exact)
                         * (N_BUCKETS - max_exact)).astype(jnp.int32)
    large = jnp.minimum(large, N_BUCKETS - 1)
    return jnp.where(dist < max_exact, dist, large)


def band_bias_and_mask(rel_bias, n_blocks):
    qi = jnp.arange(BLOCK)[:, None]
    kj = jnp.arange(2 * BLOCK)[None, :]
    dist = qi + BLOCK - kj
    in_window = (dist >= 0) & (dist < WINDOW)
    bucket = t5_causal_bucket(jnp.clip(dist, 0, None))
    bias = jnp.transpose(rel_bias[bucket], (2, 0, 1))
    key_pos = jnp.arange(n_blocks)[:, None] * BLOCK + kj - BLOCK
    mask = in_window[None] & (key_pos >= 0)[:, None, :]
    return bias, mask


def sliding_window_attention(q, k, v, q_gain, k_gain, sinks, bias, mask):
    b, s = q.shape[:2]
    nb = s // BLOCK
    g = N_Q_HEADS // N_KV_HEADS
    q = rms_norm(q.reshape(b, s, N_Q_HEADS, HEAD_DIM), q_gain)
    k = rms_norm(k.reshape(b, s, N_KV_HEADS, HEAD_DIM), k_gain)
    v = v.reshape(b, s, N_KV_HEADS, HEAD_DIM)
    qb = q.reshape(b, nb, BLOCK, N_KV_HEADS, g, HEAD_DIM)

    def band(t):
        t = t.reshape(b, nb, BLOCK, N_KV_HEADS, HEAD_DIM)
        prev = jnp.pad(t, ((0, 0), (1, 0), (0, 0), (0, 0), (0, 0)))[:, :-1]
        return jnp.concatenate([prev, t], axis=2)

    kb, vb = band(k), band(v)
    scores = jnp.einsum('bnqhgd,bnkhd->bnhgqk', qb, kb).astype(jnp.float32) * (HEAD_DIM ** -0.5)
    scores = scores + bias.reshape(N_KV_HEADS, g, BLOCK, 2 * BLOCK).astype(jnp.float32)
    scores = jnp.where(mask[None, :, None, None], scores, -jnp.inf)
    sink = jnp.broadcast_to(sinks.reshape(N_KV_HEADS, g, 1, 1).astype(jnp.float32),
                            scores.shape[:-1] + (1,))
    probs = jax.nn.softmax(jnp.concatenate([scores, sink], axis=-1), axis=-1)[..., :-1]
    out = jnp.einsum('bnhgqk,bnkhd->bnqhgd', probs.astype(v.dtype), vb)
    return out.reshape(b, s, D_ATTN)


def causal_depthwise_conv(u, w, bias):
    out = lax.conv_general_dilated(u, w[:, None, :], window_strides=(1,),
                                   padding=[(CONV_WIDTH - 1, 0)],
                                   dimension_numbers=('NWC', 'WIO', 'NWC'),
                                   feature_group_count=u.shape[-1])
    return out + bias


def ssd_mixer(z, xbc, dt_raw, conv_w, conv_b, dt_bias, a_log, d_skip, norm_g):
    f32 = jnp.float32
    b, s = z.shape[:2]
    nc = s // CHUNK
    r = SSM_HEADS // SSM_GROUPS
    xbc = jax.nn.silu(causal_depthwise_conv(xbc, conv_w, conv_b))
    xs, bm, cm = jnp.split(xbc, [D_SSM, D_SSM + D_BC], axis=-1)
    xs = xs.astype(f32).reshape(b, nc, CHUNK, SSM_GROUPS, r, SSM_HEAD_DIM)
    bm = bm.astype(f32).reshape(b, nc, CHUNK, SSM_GROUPS, SSM_STATE)
    cm = cm.astype(f32).reshape(b, nc, CHUNK, SSM_GROUPS, SSM_STATE)
    dt = jax.nn.softplus(dt_raw.astype(f32) + dt_bias.astype(f32)).reshape(b, nc, CHUNK, SSM_GROUPS, r)
    a = -jnp.exp(a_log.astype(f32)).reshape(SSM_GROUPS, r)
    a_cs = jnp.cumsum(dt * a, axis=2)
    xdt = xs * dt[..., None]
    li = jnp.arange(CHUNK)
    causal = (li[:, None] >= li[None, :])[:, :, None, None]
    seg = a_cs[:, :, :, None] - a_cs[:, :, None, :]
    decay = jnp.exp(jnp.where(causal, seg, -jnp.inf))
    cb = jnp.einsum('bclgn,bcsgn->bclsg', cm, bm)
    y_diag = jnp.einsum('bclsgr,bcsgrp->bclgrp', cb[..., None] * decay, xdt)
    decay_to_end = jnp.exp(a_cs[:, :, -1:] - a_cs)
    states = jnp.einsum('bclgn,bclgr,bclgrp->bcgrpn', bm, decay_to_end, xdt)
    chunk_decay = jnp.exp(a_cs[:, :, -1])

    def step(h, inp):
        st, dec = inp
        return h * dec[..., None, None] + st, h

    h0 = jnp.zeros((b, SSM_GROUPS, r, SSM_HEAD_DIM, SSM_STATE), f32)
    _, prev = lax.scan(step, h0, (jnp.moveaxis(states, 1, 0), jnp.moveaxis(chunk_decay, 1, 0)))
    prev = jnp.moveaxis(prev, 0, 1)
    y_off = jnp.einsum('bclgn,bcgrpn,bclgr->bclgrp', cm, prev, jnp.exp(a_cs))
    y = y_diag + y_off + xs * d_skip.astype(f32).reshape(SSM_GROUPS, r)[:, :, None]
    y = y.reshape(b, s, D_SSM) * jax.nn.silu(z.astype(f32))
    yg = y.reshape(b, s, SSM_GROUPS, D_SSM // SSM_GROUPS)
    yg = yg * lax.rsqrt(jnp.mean(jnp.square(yg), axis=-1, keepdims=True) + EPS)
    y = yg.reshape(b, s, D_SSM) * norm_g.astype(f32)
    return y.astype(z.dtype)


def setup_inputs(seed: int = 0) -> dict:
    key = jax.random.key(seed)
    ks = jax.random.split(key, 20)
    nrm = jax.random.normal
    dt0 = jnp.exp(jax.random.uniform(ks[9], (DEPTH, SSM_HEADS), minval=math.log(1e-3), maxval=math.log(1e-1)))
    return {
        "x": nrm(ks[0], (BATCH, SEQ, D_MODEL), jnp.float32),
        "mix_norm_g": 1.0 + 0.01 * nrm(ks[1], (DEPTH, D_MODEL), jnp.float32),
        "w_in": nrm(ks[2], (DEPTH, D_MODEL, D_IN), jnp.float32) * D_MODEL ** -0.5,
        "q_gain": 1.0 + 0.01 * nrm(ks[3], (DEPTH, HEAD_DIM), jnp.float32),
        "k_gain": 1.0 + 0.01 * nrm(ks[4], (DEPTH, HEAD_DIM), jnp.float32),
        "sinks": 0.5 * nrm(ks[5], (DEPTH, N_Q_HEADS), jnp.float32),
        "rel_bias": 0.1 * nrm(ks[6], (N_BUCKETS, N_Q_HEADS), jnp.float32),
        "conv_w": nrm(ks[7], (DEPTH, CONV_WIDTH, D_CONV), jnp.float32) * CONV_WIDTH ** -0.5,
        "conv_b": 0.01 * nrm(ks[8], (DEPTH, D_CONV), jnp.float32),
        "dt_bias": dt0 + jnp.log(-jnp.expm1(-dt0)),
        "a_log": jnp.log(jax.random.uniform(ks[10], (DEPTH, SSM_HEADS), minval=1.0, maxval=16.0)),
        "d_skip": 1.0 + 0.01 * nrm(ks[11], (DEPTH, SSM_HEADS), jnp.float32),
        "ssm_norm_g": 1.0 + 0.01 * nrm(ks[12], (DEPTH, D_SSM), jnp.float32),
        "w_out": nrm(ks[13], (DEPTH, D_MIX, D_MODEL), jnp.float32) * D_MIX ** -0.5,
        "mlp_norm_g": 1.0 + 0.01 * nrm(ks[14], (DEPTH, D_MODEL), jnp.float32),
        "w_up": nrm(ks[15], (DEPTH, D_MODEL, D_FF), jnp.float32) * D_MODEL ** -0.5,
        "w_down": nrm(ks[16], (DEPTH, D_FF, D_MODEL), jnp.float32) * D_FF ** -0.5,
    }


def reference(x, mix_norm_g, w_in, q_gain, k_gain, sinks, rel_bias, conv_w, conv_b,
              dt_bias, a_log, d_skip, ssm_norm_g, w_out, mlp_norm_g, w_up, w_down):
    bias, mask = band_bias_and_mask(rel_bias, x.shape[1] // BLOCK)
    for l in range(DEPTH):
        h = rms_norm(x, mix_norm_g[l])
        proj = h @ w_in[l]
        q, k, v, z, xbc, dt_raw = jnp.split(proj, SPLITS, axis=-1)
        attn = sliding_window_attention(q, k, v, q_gain[l], k_gain[l], sinks[l], bias, mask)
        ssm = ssd_mixer(z, xbc, dt_raw, conv_w[l], conv_b[l], dt_bias[l], a_log[l],
                        d_skip[l], ssm_norm_g[l])
        x = x + jnp.concatenate([attn, ssm], axis=-1) @ w_out[l]
        h = rms_norm(x, mlp_norm_g[l])
        x = x + jnp.square(jax.nn.relu(h @ w_up[l])) @ w_down[l]
    return x
```

```cpp
#include <hip/hip_runtime.h>
#include <cstdio>
#include <cstdint>

#ifndef ONE_LAUNCH
#define ONE_LAUNCH 0
#endif

namespace pg8 {
#define PG8_LAS __attribute__((address_space(3)))
typedef unsigned short bf16_t;
typedef short bf16x8 __attribute__((ext_vector_type(8)));
typedef float f32x4 __attribute__((ext_vector_type(4)));
typedef unsigned u32x4 __attribute__((ext_vector_type(4)));
constexpr int BM = 256, BK = 64, HALF = 128, HTB = HALF * BK * 2  , STAGE_BYTES = 8 * HTB, NXCD = 8, WGM = 8;

__host__ __device__ __forceinline__ int lds_byte(int r, int c) { const int st = (r >> 4) * 2 + (c >> 5), rr = r & 15, cc = c & 31, ob = rr * 64 + cc * 2; return st * 1024 + (ob ^ (((ob >> 9) & 1) << 5)); }
__host__ __device__ __forceinline__ void stage_rc(int b, int& R, int& C) { const int st = b / 1024, sb = b % 1024, swz = sb ^ (((sb >> 9) & 1) << 5); R = (st >> 1) * 16 + swz / 64; C = (st & 1) * 32 + (swz % 64) / 2; }
__host__ __device__ __forceinline__ int perm32(int rho) { const int n = rho >> 4, i = rho & 15; return 8 * (i >> 2) + 4 * n + (i & 3); }

struct Unit { int pm, pn; };
struct Gemm { const bf16_t* A; const bf16_t* Bt; int M, N, K, lda; };

struct StaticOrder {
    int nM, nN, nwg, G, c;
    __host__ __device__ void init(int M, int N, int G_, int c_) { nM = M / BM; nN = N / BM; nwg = nM * nN; G = G_; c = c_; }
    __host__ __device__ bool next(int i, Unit& u) const {
        const long L = (long)i * G + c; if (L >= nwg) return false;
        int wgid = (int)L; { const int q = nwg / NXCD, r = nwg % NXCD, xcd = wgid % NXCD, off = wgid / NXCD; wgid = (xcd < r ? xcd * (q + 1) : r * (q + 1) + (xcd - r) * q) + off; }
        const int nig = WGM * nN, gid = wgid / nig, fm = gid * WGM, gsz = (nM - fm) < WGM ? (nM - fm) : WGM;
        u.pm = fm + ((wgid % nig) % gsz); u.pn = (wgid % nig) / gsz; return true;
    }
    __device__ __forceinline__ void a_ready(const Unit&) const {}
    __device__ __forceinline__ void done(const Unit&) const {}
};

__device__ __forceinline__ unsigned cvt_pk_bf16(float lo, float hi) { unsigned r; asm volatile("v_cvt_pk_bf16_f32 %0, %1, %2" : "=v"(r) : "v"(lo), "v"(hi)); return r; }

constexpr int PROJ_PITCH = 2304, DT_TILE = 9;
struct EpiProj {
    static constexpr bool PERM = true, AFTER_DRAIN = false;
    bf16_t* O; float* dtraw; const PG8_LAS float* rstd;
    __device__ __forceinline__ void operator()(const f32x4 (&acc)[2][2][4][2], const Unit& u, int ui, int wr, int wc, int fr, int fq) const {
        const int rt0 = wr * 64 + fr;
        if (u.pn == DT_TILE) {
            if (wc == 0 && fq == 0) {
#pragma unroll
                for (int ai = 0; ai < 2; ++ai)
#pragma unroll
                    for (int m = 0; m < 4; ++m) { const int rt = ai * HALF + rt0 + m * 16; const float rs = rstd[ui * BM + rt]; float* p = dtraw + (size_t)(u.pm * BM + rt) * 8;
                        *(f32x4*)p = acc[ai][0][m][0] * rs; *(f32x4*)(p + 4) = acc[ai][0][m][1] * rs; }
            }
            return;
        }
        const int col0 = u.pn * BM + wc * 32 + 8 * fq;
#pragma unroll
        for (int ai = 0; ai < 2; ++ai)
#pragma unroll
            for (int m = 0; m < 4; ++m) { const int rt = ai * HALF + rt0 + m * 16; const float rs = rstd[ui * BM + rt]; bf16_t* rowp = O + (size_t)(u.pm * BM + rt) * PROJ_PITCH + col0;
#pragma unroll
                for (int bj = 0; bj < 2; ++bj) { const f32x4 v0 = acc[ai][bj][m][0] * rs, v1 = acc[ai][bj][m][1] * rs;
                    u32x4 w; w.x = cvt_pk_bf16(v0[0], v0[1]); w.y = cvt_pk_bf16(v0[2], v0[3]); w.z = cvt_pk_bf16(v1[0], v1[1]); w.w = cvt_pk_bf16(v1[2], v1[3]);
                    *(u32x4*)(rowp + bj * HALF) = w; } }
    }
};
struct EpiUp {
    static constexpr bool PERM = true, AFTER_DRAIN = false;
    bf16_t* O; int ldc; const PG8_LAS float* rstd;
    __device__ __forceinline__ void operator()(const f32x4 (&acc)[2][2][4][2], const Unit& u, int ui, int wr, int wc, int fr, int fq) const {
        const int rt0 = wr * 64 + fr, col0 = u.pn * BM + wc * 32 + 8 * fq;
#pragma unroll
        for (int ai = 0; ai < 2; ++ai)
#pragma unroll
            for (int m = 0; m < 4; ++m) { const int rt = ai * HALF + rt0 + m * 16; const float rs = rstd[ui * BM + rt]; bf16_t* rowp = O + (size_t)(u.pm * BM + rt) * ldc + col0;
#pragma unroll
                for (int bj = 0; bj < 2; ++bj) { f32x4 v0 = acc[ai][bj][m][0] * rs, v1 = acc[ai][bj][m][1] * rs;
#pragma unroll
                    for (int e = 0; e < 4; ++e) { const float a = fmaxf(v0[e], 0.f), b = fmaxf(v1[e], 0.f); v0[e] = a * a; v1[e] = b * b; }
                    u32x4 w; w.x = cvt_pk_bf16(v0[0], v0[1]); w.y = cvt_pk_bf16(v0[2], v0[3]); w.z = cvt_pk_bf16(v1[0], v1[1]); w.w = cvt_pk_bf16(v1[2], v1[3]);
                    *(u32x4*)(rowp + bj * HALF) = w; } }
    }
};
struct EpiRes {
    static constexpr bool PERM = true, AFTER_DRAIN = false;
    const float* res; float* out; bf16_t* xb; float* ssq;
    __device__ __forceinline__ void operator()(const f32x4 (&acc)[2][2][4][2], const Unit& u, int ui, int wr, int wc, int fr, int fq) const {
        const int rt0 = wr * 64 + fr, col0 = u.pn * BM + wc * 32 + 8 * fq;
#pragma unroll
        for (int ai = 0; ai < 2; ++ai)
#pragma unroll
            for (int m = 0; m < 4; ++m) { const int row = u.pm * BM + ai * HALF + rt0 + m * 16; const size_t off = (size_t)row * 1024 + col0; float s = 0.f;
#pragma unroll
                for (int bj = 0; bj < 2; ++bj) { const f32x4 r0 = *(const f32x4*)(res + off + bj * HALF), r1 = *(const f32x4*)(res + off + bj * HALF + 4);
                    const f32x4 v0 = r0 + acc[ai][bj][m][0], v1 = r1 + acc[ai][bj][m][1];
                    *(f32x4*)(out + off + bj * HALF) = v0; *(f32x4*)(out + off + bj * HALF + 4) = v1;
                    u32x4 w; w.x = cvt_pk_bf16(v0[0], v0[1]); w.y = cvt_pk_bf16(v0[2], v0[3]); w.z = cvt_pk_bf16(v1[0], v1[1]); w.w = cvt_pk_bf16(v1[2], v1[3]);
                    *(u32x4*)(xb + off + bj * HALF) = w;
                    s += (v0[0] * v0[0] + v0[1] * v0[1]) + (v0[2] * v0[2] + v0[3] * v0[3]) + (v1[0] * v1[0] + v1[1] * v1[1]) + (v1[2] * v1[2] + v1[3] * v1[3]); }
                s += __shfl_xor(s, 16); s += __shfl_xor(s, 32);
                if (fq == 0) ssq[(size_t)row * 16 + u.pn * 4 + wc] = s;
                if (m & 1) asm volatile("" ::: "memory"); }
    }
};

template <class Epi, class Sched, bool ALIGN_EPI = false, bool SP2 = false>
__device__ __forceinline__ void gemm_phase(PG8_LAS unsigned char* lds, const Gemm g, const Sched& S, const Epi& E) {
    int tid_ = threadIdx.x; asm volatile("" : "+v"(tid_));
    const int tid = tid_, wid = __builtin_amdgcn_readfirstlane(tid >> 6), lane = tid & 63, wr = wid >> 2, wc = wid & 3, fr = lane & 15, fq = lane >> 4;
    const int K = g.K, nt = K / BK;
    unsigned voffA[2], voffB[2];
#pragma unroll
    for (int i = 0; i < 2; ++i) { int R, C; stage_rc(tid * 16 + i * 8192, R, C); const int Rb = Epi::PERM ? ((R & ~31) + perm32(R & 31)) : R;
        voffA[i] = (unsigned)(R * g.lda + C) * 2u; voffB[i] = (unsigned)(Rb * K + C) * 2u; }
    const size_t kstep = (size_t)(BK * 2);
    const size_t hstepA = (size_t)HALF * g.lda * 2, hstepB = (size_t)HALF * K * 2;
    const size_t tstepA = 2 * hstepA, tstepB = 2 * hstepB;
    const unsigned ldsw = (unsigned)wid * 1024u;
    const int aoff = lds_byte(wr * 64 + fr, fq * 8), boff = lds_byte(wc * 32 + fr, fq * 8);
#define PG8_SA(b, h) (((b) * 2 + (h)) * HTB)
#define PG8_SB(b, h) ((4 + (b) * 2 + (h)) * HTB)
#define PG8_STAGE(bufoff, gbase, voff) do { _Pragma("unroll") for (int _i = 0; _i < 2; ++_i) \
        __builtin_amdgcn_global_load_lds((const unsigned*)((const char*)(gbase) + (voff)[_i]), (PG8_LAS unsigned*)(lds + (bufoff) + ldsw + _i * 8192), 16, 0, 0); } while (0)
#define PG8_LDA(dst, b, h) do { _Pragma("unroll") for (int m = 0; m < 4; ++m) _Pragma("unroll") for (int k = 0; k < 2; ++k) dst[m][k] = *(const PG8_LAS bf16x8*)(lds + PG8_SA(b, h) + aoff + m * 2048 + k * 1024); } while (0)
#define PG8_LDB(dst, b, h) do { _Pragma("unroll") for (int n = 0; n < 2; ++n) _Pragma("unroll") for (int k = 0; k < 2; ++k) dst[n][k] = *(const PG8_LAS bf16x8*)(lds + PG8_SB(b, h) + boff + n * 2048 + k * 1024); } while (0)
#define PG8_MMA(ai, bj, At, Bt) do { __builtin_amdgcn_s_setprio(1); _Pragma("unroll") for (int m = 0; m < 4; ++m) _Pragma("unroll") for (int n = 0; n < 2; ++n) _Pragma("unroll") for (int k = 0; k < 2; ++k) \
        acc[ai][bj][m][n] = __builtin_amdgcn_mfma_f32_16x16x32_bf16(Bt[n][k], At[m][k], acc[ai][bj][m][n], 0, 0, 0); __builtin_amdgcn_s_setprio(0); } while (0)
#define PG8_WAIT_V(n) asm volatile("s_waitcnt vmcnt(" #n ")" ::: "memory")
#define PG8_WAIT_L(n) asm volatile("s_waitcnt lgkmcnt(" #n ")" ::: "memory")
#define PG8_BAR __builtin_amdgcn_s_barrier()
#define PG8_SCHED __builtin_amdgcn_sched_barrier(0)
    Unit cur, nxt; int ui = 0;
    if (!S.next(0, cur)) return;
    f32x4 acc[2][2][4][2];
#pragma unroll
    for (int a = 0; a < 2; ++a)
#pragma unroll
        for (int b = 0; b < 2; ++b)
#pragma unroll
            for (int m = 0; m < 4; ++m)
#pragma unroll
                for (int n = 0; n < 2; ++n) acc[a][b][m][n] = (f32x4){0.f, 0.f, 0.f, 0.f};
    bf16x8 At[4][2], B0[2][2], B1[2][2];
    const char* cA = (const char*)g.A + (size_t)cur.pm * tstepA; const char* cB = (const char*)g.Bt + (size_t)cur.pn * tstepB;
    S.a_ready(cur);
    if constexpr (SP2) {
        PG8_STAGE(PG8_SB(0, 0), cB, voffB); PG8_STAGE(PG8_SB(0, 1), cB + hstepB, voffB); PG8_STAGE(PG8_SA(0, 0), cA, voffA); PG8_STAGE(PG8_SA(0, 1), cA + hstepA, voffA);
        if (wr == 1) PG8_BAR;
        PG8_WAIT_V(2); PG8_BAR;
        PG8_STAGE(PG8_SB(1, 0), cB + kstep, voffB); PG8_STAGE(PG8_SA(1, 0), cA + kstep, voffA); PG8_STAGE(PG8_SB(1, 1), cB + hstepB + kstep, voffB);
        PG8_WAIT_V(6); PG8_BAR;
    } else {
        PG8_STAGE(PG8_SB(0, 0), cB, voffB); PG8_STAGE(PG8_SA(0, 0), cA, voffA); PG8_STAGE(PG8_SB(0, 1), cB + hstepB, voffB); PG8_STAGE(PG8_SA(0, 1), cA + hstepA, voffA);
        if (wr == 1) PG8_BAR;
        PG8_WAIT_V(4); PG8_BAR;
        PG8_STAGE(PG8_SB(1, 0), cB + kstep, voffB); PG8_STAGE(PG8_SA(1, 0), cA + kstep, voffA); PG8_STAGE(PG8_SB(1, 1), cB + hstepB + kstep, voffB);
        PG8_WAIT_V(6); PG8_BAR;
    }
    for (;;) {
        const bool has_next = S.next(ui + 1, nxt);
        const char* nA = has_next ? (const char*)g.A + (size_t)nxt.pm * tstepA : cA; const char* nB = has_next ? (const char*)g.Bt + (size_t)nxt.pn * tstepB : cB;
        for (int t = 0; t < nt; t += 2) {
            const bool last = (t == nt - 2);
            const char* a1 = cA + (size_t)(t + 1) * kstep;
            const char* a2 = last ? nA : cA + (size_t)(t + 2) * kstep; const char* b2 = last ? nB : cB + (size_t)(t + 2) * kstep;
            const char* a3 = a2 + kstep; const char* b3 = b2 + kstep;
            if (last && has_next) S.a_ready(nxt);
            if constexpr (SP2) {
            PG8_LDB(B0, 0, 0); PG8_LDB(B1, 0, 1); PG8_SCHED; PG8_LDA(At, 0, 0); PG8_STAGE(PG8_SA(1, 1), a1 + hstepA, voffA);
            PG8_WAIT_V(8); PG8_WAIT_L(0); PG8_BAR; PG8_MMA(0, 0, At, B0); PG8_MMA(0, 1, At, B1); PG8_BAR; PG8_SCHED;
            PG8_LDA(At, 0, 1); PG8_STAGE(PG8_SB(0, 0), b2, voffB); PG8_STAGE(PG8_SB(0, 1), b2 + hstepB, voffB); PG8_STAGE(PG8_SA(0, 0), a2, voffA);
            PG8_WAIT_V(8); PG8_WAIT_L(0); PG8_BAR; PG8_MMA(1, 0, At, B0); PG8_MMA(1, 1, At, B1); PG8_BAR; PG8_SCHED;
            PG8_LDB(B0, 1, 0); PG8_LDB(B1, 1, 1); PG8_SCHED; PG8_LDA(At, 1, 0); PG8_STAGE(PG8_SA(0, 1), a2 + hstepA, voffA);
            PG8_WAIT_V(8); PG8_WAIT_L(0); PG8_BAR; PG8_MMA(0, 0, At, B0); PG8_MMA(0, 1, At, B1); PG8_BAR; PG8_SCHED;
            PG8_LDA(At, 1, 1); PG8_STAGE(PG8_SB(1, 0), b3, voffB); PG8_STAGE(PG8_SB(1, 1), b3 + hstepB, voffB); PG8_STAGE(PG8_SA(1, 0), a3, voffA);
            PG8_WAIT_V(8); PG8_WAIT_L(0); PG8_BAR; PG8_MMA(1, 0, At, B0); PG8_MMA(1, 1, At, B1); PG8_BAR; PG8_SCHED;
            } else {
            PG8_LDB(B0, 0, 0); PG8_SCHED; PG8_LDA(At, 0, 0); PG8_STAGE(PG8_SA(1, 1), a1 + hstepA, voffA);
            PG8_WAIT_L(8); PG8_BAR; PG8_WAIT_L(0); PG8_MMA(0, 0, At, B0); PG8_BAR; PG8_SCHED;
            PG8_LDB(B1, 0, 1); PG8_STAGE(PG8_SB(0, 0), b2, voffB);
            PG8_BAR; PG8_WAIT_L(0); PG8_MMA(0, 1, At, B1); PG8_BAR;
            PG8_LDA(At, 0, 1); PG8_STAGE(PG8_SA(0, 0), a2, voffA);
            PG8_BAR; PG8_WAIT_L(0); PG8_MMA(1, 0, At, B0); PG8_BAR; PG8_SCHED;
            PG8_STAGE(PG8_SB(0, 1), b2 + hstepB, voffB);
            PG8_WAIT_V(6); PG8_BAR; PG8_MMA(1, 1, At, B1); PG8_BAR;
            PG8_LDB(B0, 1, 0); PG8_SCHED; PG8_LDA(At, 1, 0); PG8_STAGE(PG8_SA(0, 1), a2 + hstepA, voffA);
            PG8_WAIT_L(8); PG8_BAR; PG8_WAIT_L(0); PG8_MMA(0, 0, At, B0); PG8_BAR; PG8_SCHED;
            PG8_LDB(B1, 1, 1); PG8_STAGE(PG8_SB(1, 0), b3, voffB);
            PG8_BAR; PG8_WAIT_L(0); PG8_MMA(0, 1, At, B1); PG8_BAR;
            PG8_LDA(At, 1, 1); PG8_STAGE(PG8_SA(1, 0), a3, voffA);
            PG8_BAR; PG8_WAIT_L(0); PG8_MMA(1, 0, At, B0); PG8_BAR; PG8_SCHED;
            PG8_STAGE(PG8_SB(1, 1), b3 + hstepB, voffB);
            PG8_WAIT_V(6); PG8_BAR; PG8_MMA(1, 1, At, B1); PG8_BAR;
            }
        }
        if constexpr (ALIGN_EPI) { if (wr == 0) PG8_BAR; }
        if constexpr (!Epi::AFTER_DRAIN) { E(acc, cur, ui, wr, wc, fr, fq); S.done(cur); }
        if (!has_next) break;
#pragma unroll
        for (int a = 0; a < 2; ++a)
#pragma unroll
            for (int b = 0; b < 2; ++b)
#pragma unroll
                for (int m = 0; m < 4; ++m)
#pragma unroll
                    for (int n = 0; n < 2; ++n) acc[a][b][m][n] = (f32x4){0.f, 0.f, 0.f, 0.f};
        cur = nxt; cA = nA; cB = nB; ++ui;
        if constexpr (ALIGN_EPI) { if (wr == 1) PG8_BAR; }
    }
    PG8_WAIT_V(0);
    if constexpr (!ALIGN_EPI) { if (wr == 0) PG8_BAR; }
    PG8_BAR;

#undef PG8_SA
#undef PG8_SB
#undef PG8_STAGE
#undef PG8_LDA
#undef PG8_LDB
#undef PG8_MMA
#undef PG8_WAIT_V
#undef PG8_WAIT_L
#undef PG8_BAR
#undef PG8_SCHED
}
}

constexpr int NWAVES = 8, NTHREADS = NWAVES * 64;
constexpr int BATCH = 8, SEQ = 2048, D = 1024, M = BATCH * SEQ, FF = 4096, DEPTH = 2;
constexpr int D_IN = 2312, NPROJ = 2560, PP = pg8::PROJ_PITCH;
constexpr int CQ = 0, CZ = 512, CK = 1024, CV = 1152, CX = 1280, CBM = 1792, CCM = 2048;
constexpr float EPS = 1e-6f;
constexpr int NPH = 1 + 7 * DEPTH;

constexpr size_t MiB = 1u << 20;
constexpr size_t WS_CTL = 0, CTL_ZERO_BYTES = 1 * MiB;
constexpr size_t WS_SSQ = 1 * MiB;
constexpr size_t WS_DTRAW = 2 * MiB;
constexpr size_t WS_WIN = 4 * MiB, WS_WOUT = 14 * MiB, WS_WUP = 18 * MiB, WS_WDOWN = 34 * MiB;
constexpr size_t WS_XB = 50 * MiB;
constexpr size_t WS_PROJ = 82 * MiB;
constexpr size_t WS_XBCF = 154 * MiB;
constexpr size_t WS_YN = 218 * MiB;
constexpr size_t WS_HID = 82 * MiB;
constexpr size_t WS_END = 256 * MiB;
constexpr int CW_BAR = 4096;

constexpr int RING_OFF = 0, RING_BYTES = 131072;
constexpr int LDSCTL_OFF = RING_BYTES, MISC_OFF = LDSCTL_OFF + 320, RSTD_OFF = LDSCTL_OFF + 512, PTR_OFF = RSTD_OFF + 4096;
constexpr int LDS_BYTES = 147456;
static_assert(PTR_OFF + 512 <= LDS_BYTES, "LDS map");

#define GAS __attribute__((address_space(1)))
#define LAS __attribute__((address_space(3)))
typedef unsigned short bf16;
typedef unsigned v4u __attribute__((ext_vector_type(4)));
typedef unsigned v2u __attribute__((ext_vector_type(2)));
typedef float f32x4 __attribute__((ext_vector_type(4)));
typedef GAS unsigned gu32;
#define RLX_AGENT __ATOMIC_RELAXED, __HIP_MEMORY_SCOPE_AGENT
#define LDS_WAIT() asm volatile("s_waitcnt lgkmcnt(0)" ::: "memory")
#define VM_WAIT() asm volatile("s_waitcnt vmcnt(0)" ::: "memory")
__device__ __forceinline__ unsigned f2bf(float f) { unsigned u = __builtin_bit_cast(unsigned, f); return (u + 0x7fffu + ((u >> 16) & 1u)) >> 16; }
__device__ __forceinline__ unsigned pk2(float lo, float hi) { return f2bf(lo) | (f2bf(hi) << 16); }
__device__ __forceinline__ float bflo(unsigned w) { return __uint_as_float(w << 16); }
__device__ __forceinline__ float bfhi(unsigned w) { return __uint_as_float(w & 0xffff0000u); }
__device__ __forceinline__ float silu_f(float v) { return v / (1.f + expf(-v)); }
__device__ __forceinline__ float softplus_f(float v) { return fmaxf(v, 0.f) + log1pf(expf(-fabsf(v))); }

#define XB_TMO      128
#define XB_XCNT(j)  (256  + 64 * (j))
#define XB_XSUB(j)  (1280 + 64 * (j))
#define XB_XGEN(j)  (2304 + 64 * (j))
#define XB_TOP      3328
#define XB_TOPGEN   3392
#define XCD_BAR_WORDS 3456
#define XB_SPIN_CAP (1u << 22)
__device__ __forceinline__ unsigned xb_ld(unsigned* p)              { return __hip_atomic_load(p, __ATOMIC_RELAXED, __HIP_MEMORY_SCOPE_AGENT); }
__device__ __forceinline__ unsigned xb_add(unsigned* p, unsigned v) { return __hip_atomic_fetch_add(p, v, __ATOMIC_RELAXED, __HIP_MEMORY_SCOPE_AGENT); }
__device__ __forceinline__ unsigned xb_xcc_id() { return (unsigned)__builtin_amdgcn_s_getreg((3 << 11) | 20) & 0xFu; }
#define XB_SPIN(cond, bar) do { unsigned _sp = 0; while (cond) { __builtin_amdgcn_s_sleep(1); \
    if ((++_sp & 255u) == 0u) { if (xb_ld(&(bar)[XB_TMO])) break; if (_sp > XB_SPIN_CAP) { atomicAdd(&(bar)[XB_TMO], 1u); break; } } } } while (0)
struct XcdBarrier { unsigned* bar; unsigned x; volatile LAS unsigned* st; };
__device__ __forceinline__ XcdBarrier xcd_barrier_post(unsigned* bar, volatile LAS unsigned* st) {
    XcdBarrier b; b.bar = bar; b.x = xb_xcc_id(); b.st = st;
    if (threadIdx.x == 0) (void)xb_add(&bar[XB_XCNT(b.x)], 1u);
    return b;
}
__device__ __forceinline__ void xcd_barrier_complete(unsigned* bar, unsigned x, unsigned& nloc, unsigned& nx) {
    const unsigned G = gridDim.x * gridDim.y * gridDim.z;
    unsigned sum, cnt, mine, sp = 0u;
    for (;;) {
        sum = 0u; cnt = 0u; mine = 0u;
#pragma unroll
        for (unsigned j = 0; j < 16; ++j) { const unsigned c = xb_ld(&bar[XB_XCNT(j)]); sum += c; cnt += (c > 0u) ? 1u : 0u; mine = (j == x) ? c : mine; }
        if (sum == G) break;
        __builtin_amdgcn_s_sleep(1);
        if ((++sp & 255u) == 0u) { if (xb_ld(&bar[XB_TMO])) break; if (sp > XB_SPIN_CAP) { atomicAdd(&bar[XB_TMO], 1u); break; } }
    }
    nloc = mine > 0u ? mine : 1u; nx = cnt > 0u ? cnt : 1u;
}
__device__ __forceinline__ void xcd_barrier(const XcdBarrier& b) {
    asm volatile("s_waitcnt vmcnt(0)" ::: "memory");
    __syncthreads();
    if (threadIdx.x == 0) {
        unsigned* bar = b.bar;
        __builtin_amdgcn_s_waitcnt(0);
        unsigned nloc = b.st[0], nx = b.st[1];
        if (nloc == 0u) { xcd_barrier_complete(bar, b.x, nloc, nx); b.st[0] = nloc; b.st[1] = nx; }
        const unsigned old = xb_add(&bar[XB_XSUB(b.x)], 1u);
        const unsigned gen = old / nloc;
        if (old + 1u == (gen + 1u) * nloc) {
            __builtin_amdgcn_fence(__ATOMIC_RELEASE, "agent");
            asm volatile("s_waitcnt vmcnt(0)" ::: "memory");
            const unsigned og = xb_add(&bar[XB_TOP], 1u);
            const unsigned tg = og / nx;
            if (og + 1u == (tg + 1u) * nx) xb_add(&bar[XB_TOPGEN], 1u);
            else XB_SPIN(xb_ld(&bar[XB_TOPGEN]) == tg, bar);
            __builtin_amdgcn_fence(__ATOMIC_ACQUIRE, "agent");
            xb_add(&bar[XB_XGEN(b.x)], 1u);
            asm volatile("s_waitcnt vmcnt(0)" ::: "memory");
        } else {
            XB_SPIN(xb_ld(&bar[XB_XGEN(b.x)]) == gen, bar);
            __builtin_amdgcn_fence(__ATOMIC_ACQUIRE, "agent");
            asm volatile("s_waitcnt vmcnt(0)" ::: "memory");
        }
    }
    __syncthreads();
}

struct Frame {
    LAS unsigned char* lds;
    int tid, lane, wave, bid, G;
};
enum { I_X = 0, I_MIXG, I_WIN, I_QG, I_KG, I_SINK, I_RELB, I_CONVW, I_CONVB, I_DTB, I_ALOG, I_DSKIP, I_SSMG, I_WOUT, I_MLPG, I_WUP, I_WDOWN, I_OUT, I_WS, I_NPTR };
__device__ __forceinline__ unsigned char* ptr_at(const Frame& F, int i) {
    const LAS unsigned* t = (const LAS unsigned*)(F.lds + PTR_OFF) + 2 * i;
    const unsigned lo = __builtin_amdgcn_readfirstlane(t[0]), hi = __builtin_amdgcn_readfirstlane(t[1]);
    return (unsigned char*)(((unsigned long long)hi << 32) | lo);
}
#define FIN(i) ((const float*)ptr_at(F, (i)))
#define FWS(off) (ptr_at(F, I_WS) + (off))
__device__ __forceinline__ float wave_sum(float v) {
#pragma unroll
    for (int o = 1; o < 64; o <<= 1) v += __shfl_xor(v, o);
    return v;
}

__device__ __forceinline__ void tr_item(const float* W, int Nsrc, int nsrc0, int nvalid, int K, const float* gain, bf16* WT, int ndst0, int k0, LAS float* scr, int lane) {
    const int n = lane & 31;
#pragma unroll 8
    for (int i = 0; i < 32; ++i) { const int kk = 2 * i + (lane >> 5); float v = 0.f;
        if (n < nvalid) { v = W[(size_t)(k0 + kk) * Nsrc + nsrc0 + n]; if (gain) v *= gain[k0 + kk]; }
        scr[kk * 33 + n] = v; }
    LDS_WAIT(); asm volatile("" ::: "memory");
    const int c = lane & 7;
#pragma unroll
    for (int j = 0; j < 4; ++j) { const int nn = (lane >> 3) + 8 * j; const LAS float* s = scr + (8 * c) * 33 + nn;
        v4u o; o.x = pk2(s[0 * 33], s[1 * 33]); o.y = pk2(s[2 * 33], s[3 * 33]); o.z = pk2(s[4 * 33], s[5 * 33]); o.w = pk2(s[6 * 33], s[7 * 33]);
        *(GAS v4u*)(WT + (size_t)(ndst0 + nn) * K + k0 + 8 * c) = o; }
    LDS_WAIT(); asm volatile("" ::: "memory");
}
__device__ __forceinline__ void p0_prologue(Frame& F) {
    LAS float* scr = (LAS float*)(F.lds + RING_OFF + F.wave * 16384);
    const int gw = F.bid * NWAVES + F.wave, NGW = F.G * NWAVES;
    constexpr int I_IN = 16 * 80, I_OUT = 16 * 32, I_UP = 16 * 128, I_DN = 64 * 32, I_L = I_IN + I_OUT + I_UP + I_DN;
    {
    const float *w_in = FIN(I_WIN), *mix_g = FIN(I_MIXG), *w_out = FIN(I_WOUT), *w_up = FIN(I_WUP), *mlp_g = FIN(I_MLPG), *w_down = FIN(I_WDOWN);
    bf16 *WIN = (bf16*)FWS(WS_WIN), *WOUT = (bf16*)FWS(WS_WOUT), *WUP = (bf16*)FWS(WS_WUP), *WDOWN = (bf16*)FWS(WS_WDOWN);
    for (int it = gw; it < DEPTH * I_L; it += NGW) {
        const int L = it / I_L; int r = it % I_L;
        if (r < I_IN) {
            const int kb = r / 80, nb = r % 80; int src, nv = 32;
            if (nb < 16) src = nb * 32; else if (nb < 32) src = 768 + (nb - 16) * 32; else if (nb < 36) src = 512 + (nb - 32) * 32; else if (nb < 40) src = 640 + (nb - 36) * 32;
            else if (nb < 72) src = nb * 32; else if (nb == 72) { src = 2304; nv = 8; } else { src = 0; nv = 0; }
            tr_item(w_in + (size_t)L * D * D_IN, D_IN, src, nv, D, mix_g + L * D, WIN + (size_t)L * NPROJ * D, nb * 32, kb * 64, scr, F.lane); continue; }
        r -= I_IN;
        if (r < I_OUT) { const int kb = r / 32, nb = r % 32; tr_item(w_out + (size_t)L * D * D, D, nb * 32, 32, D, nullptr, WOUT + (size_t)L * D * D, nb * 32, kb * 64, scr, F.lane); continue; }
        r -= I_OUT;
        if (r < I_UP) { const int kb = r / 128, nb = r % 128; tr_item(w_up + (size_t)L * D * FF, FF, nb * 32, 32, D, mlp_g + L * D, WUP + (size_t)L * FF * D, nb * 32, kb * 64, scr, F.lane); continue; }
        r -= I_UP;
        { const int kb = r / 32, nb = r % 32; tr_item(w_down + (size_t)L * FF * D, D, nb * 32, 32, FF, nullptr, WDOWN + (size_t)L * D * FF, nb * 32, kb * 64, scr, F.lane); }
    }
    }
    const float* x = FIN(I_X); bf16* XB = (bf16*)FWS(WS_XB); float* SSQ = (float*)FWS(WS_SSQ);
    for (int m = gw; m < M; m += NGW) {
        const GAS f32x4* xr = (const GAS f32x4*)(x + (size_t)m * D) + F.lane;
        f32x4 v[4]; float s = 0.f;
#pragma unroll
        for (int j = 0; j < 4; ++j) { v[j] = xr[64 * j]; s += (v[j].x * v[j].x + v[j].y * v[j].y) + (v[j].z * v[j].z + v[j].w * v[j].w); }
        s = wave_sum(s);
        GAS v2u* o8 = (GAS v2u*)(XB + (size_t)m * D) + F.lane;
#pragma unroll
        for (int j = 0; j < 4; ++j) { v2u o; o.x = pk2(v[j].x, v[j].y); o.y = pk2(v[j].z, v[j].w); o8[64 * j] = o; }
        if (F.lane < 16) SSQ[(size_t)m * 16 + F.lane] = (F.lane == 0) ? s : 0.f;
    }
}
__device__ __forceinline__ void rstd_prepass(Frame& F, const pg8::StaticOrder& S, LAS float* tab) {
    const float* SSQ = (const float*)FWS(WS_SSQ);
    pg8::Unit u;
    for (int i = 0; i < 4 && S.next(i, u); ++i) {
        const int r = F.tid >> 1, h = F.tid & 1;
        const f32x4* p = (const f32x4*)(SSQ + (size_t)(u.pm * 256 + r) * 16 + h * 8);
        const f32x4 a = p[0], b = p[1];
        float s = (a.x + a.y) + (a.z + a.w) + (b.x + b.y) + (b.z + b.w);
        s += __shfl_xor(s, 1);
        if (h == 0) tab[i * 256 + r] = 1.0f / sqrtf(s * (1.0f / D) + EPS);
    }
    LDS_WAIT(); __syncthreads();
}

__device__ __forceinline__ int t5_bucket(int d) {
    if (d < 16) return d;
    return 16 + (d >= 19) + (d >= 21) + (d >= 24) + (d >= 27) + (d >= 31) + (d >= 35) + (d >= 40) + (d >= 46) + (d >= 52) + (d >= 59) + (d >= 67) + (d >= 77) + (d >= 87) + (d >= 99) + (d >= 113);
}
__device__ __forceinline__ void ld8(const bf16* p, float (&v)[8]) {
    const v4u w = *(const v4u*)p;
    v[0] = bflo(w.x); v[1] = bfhi(w.x); v[2] = bflo(w.y); v[3] = bfhi(w.y); v[4] = bflo(w.z); v[5] = bfhi(w.z); v[6] = bflo(w.w); v[7] = bfhi(w.w);
}
__device__ __forceinline__ void attn_naive(Frame& F, int L) {
    const float* qg = FIN(I_QG) + L * 64; const float* kg = FIN(I_KG) + L * 64; const float* sinks = FIN(I_SINK); const float* rel_bias = FIN(I_RELB);
    bf16* PROJ = (bf16*)FWS(WS_PROJ);
    for (int it = F.bid * NTHREADS + F.tid; it < M * 8; it += F.G * NTHREADS) {
        const int m = it >> 3, hq = it & 7, hkv = hq >> 2, t = m & (SEQ - 1);
        bf16* qp = PROJ + (size_t)m * PP + CQ + hq * 64;
        float q[64]; float ss = 0.f;
#pragma unroll
        for (int c = 0; c < 8; ++c) { float v[8]; ld8(qp + 8 * c, v);
#pragma unroll
            for (int e = 0; e < 8; ++e) { q[8 * c + e] = v[e]; ss += v[e] * v[e]; } }
        const float rq = 1.0f / sqrtf(ss * (1.0f / 64.0f) + EPS);
#pragma unroll
        for (int d = 0; d < 64; ++d) q[d] = q[d] * rq * qg[d] * 0.125f * kg[d];
        const float sink = sinks[L * 8 + hq];
        float mrun = sink, l = 1.f; float acc[64];
#pragma unroll
        for (int d = 0; d < 64; ++d) acc[d] = 0.f;
        const int j0 = t - 127 > 0 ? t - 127 : 0;
        for (int j = j0; j <= t; ++j) {
            const bf16* kp = PROJ + (size_t)(m - t + j) * PP + CK + hkv * 64;
            float dot = 0.f, sk = 0.f;
#pragma unroll
            for (int c = 0; c < 8; ++c) { float v[8]; ld8(kp + 8 * c, v);
#pragma unroll
                for (int e = 0; e < 8; ++e) { dot += q[8 * c + e] * v[e]; sk += v[e] * v[e]; } }
            const float s = dot / sqrtf(sk * (1.0f / 64.0f) + EPS) + rel_bias[t5_bucket(t - j) * 8 + hq];
            const float mn = fmaxf(mrun, s), a = expf(mrun - mn), p = expf(s - mn);
            l = l * a + p; mrun = mn;
            const bf16* vp = kp + (CV - CK);
#pragma unroll
            for (int c = 0; c < 8; ++c) { float v[8]; ld8(vp + 8 * c, v);
#pragma unroll
                for (int e = 0; e < 8; ++e) acc[8 * c + e] = acc[8 * c + e] * a + p * v[e]; }
        }
        const float inv = 1.0f / l;
#pragma unroll
        for (int c = 0; c < 8; ++c) { v4u o; o.x = pk2(acc[8 * c] * inv, acc[8 * c + 1] * inv); o.y = pk2(acc[8 * c + 2] * inv, acc[8 * c + 3] * inv);
            o.z = pk2(acc[8 * c + 4] * inv, acc[8 * c + 5] * inv); o.w = pk2(acc[8 * c + 6] * inv, acc[8 * c + 7] * inv); *(v4u*)(qp + 8 * c) = o; }
    }
}
__device__ __forceinline__ void conv_naive(Frame& F, int L) {
    const float* conv_w = FIN(I_CONVW); const float* conv_b = FIN(I_CONVB); const bf16* PROJ = (const bf16*)FWS(WS_PROJ); float* XBCF = (float*)FWS(WS_XBCF);
    for (int it = F.bid * NTHREADS + F.tid; it < M * 128; it += F.G * NTHREADS) {
        const int m = it >> 7, c0 = (it & 127) * 8, t = m & (SEQ - 1);
        float o[8];
#pragma unroll
        for (int e = 0; e < 8; ++e) o[e] = conv_b[L * 1024 + c0 + e];
#pragma unroll
        for (int k = 0; k < 4; ++k) { if (t - 3 + k >= 0) { float v[8]; ld8(PROJ + (size_t)(m - 3 + k) * PP + CX + c0, v);
#pragma unroll
                for (int e = 0; e < 8; ++e) o[e] += conv_w[(size_t)(L * 4 + k) * 1024 + c0 + e] * v[e]; } }
        f32x4 a, b; a.x = silu_f(o[0]); a.y = silu_f(o[1]); a.z = silu_f(o[2]); a.w = silu_f(o[3]); b.x = silu_f(o[4]); b.y = silu_f(o[5]); b.z = silu_f(o[6]); b.w = silu_f(o[7]);
        *(f32x4*)(XBCF + (size_t)m * 1024 + c0) = a; *(f32x4*)(XBCF + (size_t)m * 1024 + c0 + 4) = b;
    }
}
__device__ __forceinline__ void ssd_naive(Frame& F, int L) {
    if (F.wave != 0 || F.bid >= 64) return;
    const int b = F.bid >> 3, hh = F.bid & 7, g = hh >> 2, p = F.lane;
    const float a = -expf(FIN(I_ALOG)[L * 8 + hh]), dtb = FIN(I_DTB)[L * 8 + hh], dsk = FIN(I_DSKIP)[L * 8 + hh];
    const float* DTRAW = (const float*)FWS(WS_DTRAW); const float* XBCF = (const float*)FWS(WS_XBCF); float* YN = (float*)FWS(WS_YN);
    float st[128];
#pragma unroll
    for (int n = 0; n < 128; ++n) st[n] = 0.f;
    for (int t = 0; t < SEQ; ++t) {
        const size_t m = (size_t)b * SEQ + t;
        const float dtv = softplus_f(DTRAW[m * 8 + hh] + dtb), dA = expf(dtv * a), xv = XBCF[m * 1024 + hh * 64 + p], xd = xv * dtv;
        const GAS f32x4* Bp = (const GAS f32x4*)(XBCF + m * 1024 + 512 + g * 128); const GAS f32x4* Cp = (const GAS f32x4*)(XBCF + m * 1024 + 768 + g * 128);
        float y = 0.f;
#pragma unroll
        for (int n4 = 0; n4 < 32; ++n4) { const f32x4 bv = Bp[n4], cv = Cp[n4];
#pragma unroll
            for (int e = 0; e < 4; ++e) { st[4 * n4 + e] = st[4 * n4 + e] * dA + xd * bv[e]; y += cv[e] * st[4 * n4 + e]; } }
        YN[m * 512 + hh * 64 + p] = y + dsk * xv;
    }
}
__device__ __forceinline__ void gate_naive(Frame& F, int L) {
    const int gw = F.bid * NWAVES + F.wave, NGW = F.G * NWAVES;
    const float* ssm_g = FIN(I_SSMG); bf16* PROJ = (bf16*)FWS(WS_PROJ); const float* YN = (const float*)FWS(WS_YN);
    for (int it = gw; it < M * 2; it += NGW) {
        const int m = it >> 1, g = it & 1, ch = g * 256 + 4 * F.lane;
        const f32x4 y = *(const f32x4*)(YN + (size_t)m * 512 + ch);
        bf16* zp = PROJ + (size_t)m * PP + CZ + ch;
        const v2u zw = *(const v2u*)zp;
        float v[4]; v[0] = y.x * silu_f(bflo(zw.x)); v[1] = y.y * silu_f(bfhi(zw.x)); v[2] = y.z * silu_f(bflo(zw.y)); v[3] = y.w * silu_f(bfhi(zw.y));
        const float ss = wave_sum((v[0] * v[0] + v[1] * v[1]) + (v[2] * v[2] + v[3] * v[3]));
        const float r = 1.0f / sqrtf(ss * (1.0f / 256.0f) + EPS);
        const float* ng = ssm_g + L * 512 + ch;
        v2u o; o.x = pk2(v[0] * r * ng[0], v[1] * r * ng[1]); o.y = pk2(v[2] * r * ng[2], v[3] * r * ng[3]);
        *(v2u*)zp = o;
    }
}

__device__ __forceinline__ void ph_inproj(Frame& F, int L) {
    LAS float* rstd_tab = (LAS float*)(F.lds + RSTD_OFF);
    int bid_ = F.bid; asm volatile("" : "+s"(bid_)); pg8::StaticOrder S; S.init(M, NPROJ, F.G, bid_);
    rstd_prepass(F, S, rstd_tab);
    pg8::Gemm g{(const bf16*)FWS(WS_XB), (const bf16*)FWS(WS_WIN) + (size_t)L * NPROJ * D, M, NPROJ, D, D};
    pg8::EpiProj E{(bf16*)FWS(WS_PROJ), (float*)FWS(WS_DTRAW), (const LAS float*)rstd_tab};
    pg8::gemm_phase<pg8::EpiProj, pg8::StaticOrder, true, true>(F.lds + RING_OFF, g, S, E);
}
__device__ __forceinline__ void ph_outproj(Frame& F, int L) {
    int bid_ = F.bid; asm volatile("" : "+s"(bid_)); pg8::StaticOrder S; S.init(M, D, F.G, bid_);
    pg8::Gemm g{(const bf16*)FWS(WS_PROJ), (const bf16*)FWS(WS_WOUT) + (size_t)L * D * D, M, D, D, PP};
    float* out = (float*)ptr_at(F, I_OUT);
    pg8::EpiRes E{L == 0 ? FIN(I_X) : (const float*)out, out, (bf16*)FWS(WS_XB), (float*)FWS(WS_SSQ)};
    pg8::gemm_phase<pg8::EpiRes, pg8::StaticOrder, false, true>(F.lds + RING_OFF, g, S, E);
}
__device__ __forceinline__ void ph_up(Frame& F, int L) {
    LAS float* rstd_tab = (LAS float*)(F.lds + RSTD_OFF);
    int bid_ = F.bid; asm volatile("" : "+s"(bid_)); pg8::StaticOrder S; S.init(M, FF, F.G, bid_);
    rstd_prepass(F, S, rstd_tab);
    pg8::Gemm g{(const bf16*)FWS(WS_XB), (const bf16*)FWS(WS_WUP) + (size_t)L * FF * D, M, FF, D, D};
    pg8::EpiUp E{(bf16*)FWS(WS_HID), FF, (const LAS float*)rstd_tab};
    pg8::gemm_phase<pg8::EpiUp, pg8::StaticOrder, true, true>(F.lds + RING_OFF, g, S, E);
}
__device__ __forceinline__ void ph_down(Frame& F, int L) {
    int bid_ = F.bid; asm volatile("" : "+s"(bid_)); pg8::StaticOrder S; S.init(M, D, F.G, bid_);
    pg8::Gemm g{(const bf16*)FWS(WS_HID), (const bf16*)FWS(WS_WDOWN) + (size_t)L * D * FF, M, D, FF, FF};
    float* out = (float*)ptr_at(F, I_OUT);
    pg8::EpiRes E{(const float*)out, out, (bf16*)FWS(WS_XB), (float*)FWS(WS_SSQ)};
    pg8::gemm_phase<pg8::EpiRes, pg8::StaticOrder, false, true>(F.lds + RING_OFF, g, S, E);
}

struct Args { const float* in[17]; float* out; unsigned char* ws; int ph_lo, ph_hi; };
#define FRAME_INIT() \
    extern __shared__ __attribute__((aligned(16))) unsigned char lds[]; \
    Frame F; \
    F.lds = (LAS unsigned char*)lds; \
    F.tid = threadIdx.x; F.lane = F.tid & 63; F.wave = __builtin_amdgcn_readfirstlane(F.tid >> 6); F.bid = blockIdx.x; F.G = gridDim.x; \
    for (int u = F.tid; u < (LDS_BYTES - LDSCTL_OFF) / 4; u += NTHREADS) ((LAS unsigned*)(F.lds + LDSCTL_OFF))[u] = 0u; \
    __syncthreads(); \
    if (F.tid < I_NPTR) { const unsigned long long p = F.tid < 17 ? (unsigned long long)args.in[F.tid < 17 ? F.tid : 0] : (F.tid == I_OUT ? (unsigned long long)args.out : (unsigned long long)args.ws); \
        LAS unsigned* t = (LAS unsigned*)(F.lds + PTR_OFF) + 2 * F.tid; t[0] = (unsigned)p; t[1] = (unsigned)(p >> 32); } \
    LDS_WAIT(); __syncthreads();

#if !ONE_LAUNCH
__global__ void __launch_bounds__(NTHREADS, 2) k_mix1_naive(Args args) { FRAME_INIT(); attn_naive(F, args.ph_lo); conv_naive(F, args.ph_lo); }
__global__ void __launch_bounds__(NTHREADS, 2) k_mix2_naive(Args args) { FRAME_INIT(); ssd_naive(F, args.ph_lo); }
__global__ void __launch_bounds__(NTHREADS, 2) k_mix3_naive(Args args) { FRAME_INIT(); gate_naive(F, args.ph_lo); }
#endif
#define PH_MIX1(F, L) do {} while (0)
#define PH_MIX2(F, L) do {} while (0)
#define PH_MIX3(F, L) do {} while (0)

__global__ void __launch_bounds__(NTHREADS, 2) fwd(Args args) {
    FRAME_INIT();
    const int lo = args.ph_lo, hi = args.ph_hi;
#if ONE_LAUNCH
    XcdBarrier bar = xcd_barrier_post((unsigned*)(FWS(WS_CTL)) + CW_BAR, (volatile LAS unsigned*)(F.lds + MISC_OFF) + 8);
#define GRID_BAR() xcd_barrier(bar)
#else
#define GRID_BAR() do {} while (0)
#endif
#define IN(k) (lo <= (k) && (k) < hi)
#define SEAM(k) do { if (IN(k) && IN((k) + 1)) GRID_BAR(); } while (0)

    if (IN(0)) { p0_prologue(F); SEAM(0); }
    for (int L = 0; L < DEPTH; ++L) {
        const int pb = 1 + 7 * L;
        if (IN(pb + 0)) { ph_inproj(F, L); SEAM(pb + 0); }
        if (IN(pb + 1)) { PH_MIX1(F, L); SEAM(pb + 1); }
        if (IN(pb + 2)) { PH_MIX2(F, L); SEAM(pb + 2); }
        if (IN(pb + 3)) { PH_MIX3(F, L); SEAM(pb + 3); }
        if (IN(pb + 4)) { ph_outproj(F, L); SEAM(pb + 4); }
        if (IN(pb + 5)) { ph_up(F, L); SEAM(pb + 5); }
        if (IN(pb + 6)) { ph_down(F, L); SEAM(pb + 6); }
    }
#undef IN
#undef SEAM
}

extern "C" void kernel_launch(void* const* d_in, const int* in_sizes, int n_in, void* d_out, int out_size, void* d_ws, size_t ws_size, hipStream_t stream) {
    static int grid = 0;
    if (grid == 0) {
        if (n_in != 17 || in_sizes[0] != M * D || out_size != M * D || ws_size < WS_END) { fprintf(stderr, "kernel_launch: unexpected shapes (n_in %d, in0 %d, out %d, ws %zu)\n", n_in, n_in > 0 ? in_sizes[0] : -1, out_size, ws_size); grid = -1; return; }
        int dev = 0, cus = 0, per_cu = 0;
        if (hipGetDevice(&dev) != hipSuccess || hipDeviceGetAttribute(&cus, hipDeviceAttributeMultiprocessorCount, dev) != hipSuccess) { grid = -1; return; }
        if (hipFuncSetAttribute((const void*)fwd, hipFuncAttributeMaxDynamicSharedMemorySize, LDS_BYTES) != hipSuccess) { fprintf(stderr, "kernel_launch: hipFuncSetAttribute failed\n"); grid = -1; return; }
#if !ONE_LAUNCH
        (void)hipFuncSetAttribute((const void*)k_mix1_naive, hipFuncAttributeMaxDynamicSharedMemorySize, LDS_BYTES);
        (void)hipFuncSetAttribute((const void*)k_mix2_naive, hipFuncAttributeMaxDynamicSharedMemorySize, LDS_BYTES);
        (void)hipFuncSetAttribute((const void*)k_mix3_naive, hipFuncAttributeMaxDynamicSharedMemorySize, LDS_BYTES);
#endif
        if (hipOccupancyMaxActiveBlocksPerMultiprocessor(&per_cu, (const void*)fwd, NTHREADS, LDS_BYTES) != hipSuccess || per_cu < 1) { fprintf(stderr, "kernel_launch: occupancy query says %d\n", per_cu); per_cu = 1; }
        (void)hipGetLastError();
        grid = cus;
    }
    if (grid < 0) return;
    (void)hipMemsetAsync((char*)d_ws + WS_CTL, 0, CTL_ZERO_BYTES, stream);
    Args a{};
    for (int i = 0; i < 17; ++i) a.in[i] = (const float*)d_in[i];
    a.out = (float*)d_out; a.ws = (unsigned char*)d_ws;
#if ONE_LAUNCH
    a.ph_lo = 0; a.ph_hi = NPH;
    void* kargs[] = {&a};
    hipError_t e = hipLaunchCooperativeKernel((const void*)fwd, dim3(grid), dim3(NTHREADS), kargs, LDS_BYTES, stream);
    if (e != hipSuccess) fprintf(stderr, "kernel_launch: cooperative launch failed: %s (grid %d)\n", hipGetErrorString(e), grid);
#else
    for (int ph = 0; ph < NPH; ++ph) {
        const int r = ph == 0 ? -1 : (ph - 1) % 7, L = ph == 0 ? 0 : (ph - 1) / 7;
        a.ph_lo = ph; a.ph_hi = ph + 1;
        if (r == 1) { a.ph_lo = L; hipLaunchKernelGGL(k_mix1_naive, dim3(grid), dim3(NTHREADS), LDS_BYTES, stream, a); }
        else if (r == 2) { a.ph_lo = L; hipLaunchKernelGGL(k_mix2_naive, dim3(grid), dim3(NTHREADS), LDS_BYTES, stream, a); }
        else if (r == 3) { a.ph_lo = L; hipLaunchKernelGGL(k_mix3_naive, dim3(grid), dim3(NTHREADS), LDS_BYTES, stream, a); }
        else hipLaunchKernelGGL(fwd, dim3(grid), dim3(NTHREADS), LDS_BYTES, stream, a);
    }
#endif
}
```

```cpp
#include <hip/hip_runtime.h>
#include <cstdio>
#include <cstdint>

#ifndef ONE_LAUNCH
#define ONE_LAUNCH 1
#endif

namespace pg8 {
#define PG8_LAS __attribute__((address_space(3)))
typedef unsigned short bf16_t;
typedef short bf16x8 __attribute__((ext_vector_type(8)));
typedef float f32x4 __attribute__((ext_vector_type(4)));
typedef unsigned u32x4 __attribute__((ext_vector_type(4)));
constexpr int BM = 256, BK = 64, HALF = 128, HTB = HALF * BK * 2  , STAGE_BYTES = 8 * HTB, NXCD = 8, WGM = 8;

__host__ __device__ __forceinline__ int lds_byte(int r, int c) { const int st = (r >> 4) * 2 + (c >> 5), rr = r & 15, cc = c & 31, ob = rr * 64 + cc * 2; return st * 1024 + (ob ^ (((ob >> 9) & 1) << 5)); }
__host__ __device__ __forceinline__ void stage_rc(int b, int& R, int& C) { const int st = b / 1024, sb = b % 1024, swz = sb ^ (((sb >> 9) & 1) << 5); R = (st >> 1) * 16 + swz / 64; C = (st & 1) * 32 + (swz % 64) / 2; }
__host__ __device__ __forceinline__ int perm32(int rho) { const int n = rho >> 4, i = rho & 15; return 8 * (i >> 2) + 4 * n + (i & 3); }

struct Unit { int pm, pn; };
struct Gemm { const bf16_t* A; const bf16_t* Bt; int M, N, K, lda; };

struct StaticOrder {
    int nM, nN, nwg, G, c;
    __host__ __device__ void init(int M, int N, int G_, int c_) { nM = M / BM; nN = N / BM; nwg = nM * nN; G = G_; c = c_; }
    __host__ __device__ bool next(int i, Unit& u) const {
        const long L = (long)i * G + c; if (L >= nwg) return false;
        int wgid = (int)L; { const int q = nwg / NXCD, r = nwg % NXCD, xcd = wgid % NXCD, off = wgid / NXCD; wgid = (xcd < r ? xcd * (q + 1) : r * (q + 1) + (xcd - r) * q) + off; }
        const int nig = WGM * nN, gid = wgid / nig, fm = gid * WGM, gsz = (nM - fm) < WGM ? (nM - fm) : WGM;
        u.pm = fm + ((wgid % nig) % gsz); u.pn = (wgid % nig) / gsz; return true;
    }
    __device__ __forceinline__ void a_ready(const Unit&) const {}
    __device__ __forceinline__ void done(const Unit&) const {}
};

__device__ __forceinline__ unsigned cvt_pk_bf16(float lo, float hi) { unsigned r; asm volatile("v_cvt_pk_bf16_f32 %0, %1, %2" : "=v"(r) : "v"(lo), "v"(hi)); return r; }

constexpr int PROJ_PITCH = 2304, DT_TILE = 9;
struct EpiProj {
    static constexpr bool PERM = true, AFTER_DRAIN = false;
    bf16_t* O; float* dtraw; const PG8_LAS float* rstd;
    __device__ __forceinline__ void operator()(const f32x4 (&acc)[2][2][4][2], const Unit& u, int ui, int wr, int wc, int fr, int fq) const {
        const int rt0 = wr * 64 + fr;
        if (u.pn == DT_TILE) {
            if (wc == 0 && fq == 0) {
#pragma unroll
                for (int ai = 0; ai < 2; ++ai)
#pragma unroll
                    for (int m = 0; m < 4; ++m) { const int rt = ai * HALF + rt0 + m * 16; const float rs = rstd[ui * BM + rt]; float* p = dtraw + (size_t)(u.pm * BM + rt) * 8;
                        *(f32x4*)p = acc[ai][0][m][0] * rs; *(f32x4*)(p + 4) = acc[ai][0][m][1] * rs; }
            }
            return;
        }
        const int col0 = u.pn * BM + wc * 32 + 8 * fq;
#pragma unroll
        for (int ai = 0; ai < 2; ++ai)
#pragma unroll
            for (int m = 0; m < 4; ++m) { const int rt = ai * HALF + rt0 + m * 16; const float rs = rstd[ui * BM + rt]; bf16_t* rowp = O + (size_t)(u.pm * BM + rt) * PROJ_PITCH + col0;
#pragma unroll
                for (int bj = 0; bj < 2; ++bj) { const f32x4 v0 = acc[ai][bj][m][0] * rs, v1 = acc[ai][bj][m][1] * rs;
                    u32x4 w; w.x = cvt_pk_bf16(v0[0], v0[1]); w.y = cvt_pk_bf16(v0[2], v0[3]); w.z = cvt_pk_bf16(v1[0], v1[1]); w.w = cvt_pk_bf16(v1[2], v1[3]);
                    *(u32x4*)(rowp + bj * HALF) = w; } }
    }
};
struct EpiUp {
    static constexpr bool PERM = true, AFTER_DRAIN = false;
    bf16_t* O; int ldc; const PG8_LAS float* rstd;
    __device__ __forceinline__ void operator()(const f32x4 (&acc)[2][2][4][2], const Unit& u, int ui, int wr, int wc, int fr, int fq) const {
        const int rt0 = wr * 64 + fr, col0 = u.pn * BM + wc * 32 + 8 * fq;
#pragma unroll
        for (int ai = 0; ai < 2; ++ai)
#pragma unroll
            for (int m = 0; m < 4; ++m) { const int rt = ai * HALF + rt0 + m * 16; const float rs = rstd[ui * BM + rt]; bf16_t* rowp = O + (size_t)(u.pm * BM + rt) * ldc + col0;
#pragma unroll
                for (int bj = 0; bj < 2; ++bj) { f32x4 v0 = acc[ai][bj][m][0] * rs, v1 = acc[ai][bj][m][1] * rs;
#pragma unroll
                    for (int e = 0; e < 4; ++e) { const float a = fmaxf(v0[e], 0.f), b = fmaxf(v1[e], 0.f); v0[e] = a * a; v1[e] = b * b; }
                    u32x4 w; w.x = cvt_pk_bf16(v0[0], v0[1]); w.y = cvt_pk_bf16(v0[2], v0[3]); w.z = cvt_pk_bf16(v1[0], v1[1]); w.w = cvt_pk_bf16(v1[2], v1[3]);
                    *(u32x4*)(rowp + bj * HALF) = w; } }
    }
};
struct EpiRes {
    static constexpr bool PERM = true, AFTER_DRAIN = false;
    const float* res; float* out; bf16_t* xb; float* ssq;
    __device__ __forceinline__ void operator()(const f32x4 (&acc)[2][2][4][2], const Unit& u, int ui, int wr, int wc, int fr, int fq) const {
        const int rt0 = wr * 64 + fr, col0 = u.pn * BM + wc * 32 + 8 * fq;
#pragma unroll
        for (int ai = 0; ai < 2; ++ai)
#pragma unroll
            for (int m = 0; m < 4; ++m) { const int row = u.pm * BM + ai * HALF + rt0 + m * 16; const size_t off = (size_t)row * 1024 + col0; float s = 0.f;
#pragma unroll
                for (int bj = 0; bj < 2; ++bj) { const f32x4 r0 = *(const f32x4*)(res + off + bj * HALF), r1 = *(const f32x4*)(res + off + bj * HALF + 4);
                    const f32x4 v0 = r0 + acc[ai][bj][m][0], v1 = r1 + acc[ai][bj][m][1];
                    *(f32x4*)(out + off + bj * HALF) = v0; *(f32x4*)(out + off + bj * HALF + 4) = v1;
                    u32x4 w; w.x = cvt_pk_bf16(v0[0], v0[1]); w.y = cvt_pk_bf16(v0[2], v0[3]); w.z = cvt_pk_bf16(v1[0], v1[1]); w.w = cvt_pk_bf16(v1[2], v1[3]);
                    *(u32x4*)(xb + off + bj * HALF) = w;
                    s += (v0[0] * v0[0] + v0[1] * v0[1]) + (v0[2] * v0[2] + v0[3] * v0[3]) + (v1[0] * v1[0] + v1[1] * v1[1]) + (v1[2] * v1[2] + v1[3] * v1[3]); }
                s += __shfl_xor(s, 16); s += __shfl_xor(s, 32);
                if (fq == 0) ssq[(size_t)row * 16 + u.pn * 4 + wc] = s;
                if (m & 1) asm volatile("" ::: "memory"); }
    }
};

template <class Epi, class Sched, bool ALIGN_EPI = false, bool SP2 = false>
__device__ __forceinline__ void gemm_phase(PG8_LAS unsigned char* lds, const Gemm g, const Sched& S, const Epi& E) {
    int tid_ = threadIdx.x; asm volatile("" : "+v"(tid_));
    const int tid = tid_, wid = __builtin_amdgcn_readfirstlane(tid >> 6), lane = tid & 63, wr = wid >> 2, wc = wid & 3, fr = lane & 15, fq = lane >> 4;
    const int K = g.K, nt = K / BK;
    unsigned voffA[2], voffB[2];
#pragma unroll
    for (int i = 0; i < 2; ++i) { int R, C; stage_rc(tid * 16 + i * 8192, R, C); const int Rb = Epi::PERM ? ((R & ~31) + perm32(R & 31)) : R;
        voffA[i] = (unsigned)(R * g.lda + C) * 2u; voffB[i] = (unsigned)(Rb * K + C) * 2u; }
    const size_t kstep = (size_t)(BK * 2);
    const size_t hstepA = (size_t)HALF * g.lda * 2, hstepB = (size_t)HALF * K * 2;
    const size_t tstepA = 2 * hstepA, tstepB = 2 * hstepB;
    const unsigned ldsw = (unsigned)wid * 1024u;
    const int aoff = lds_byte(wr * 64 + fr, fq * 8), boff = lds_byte(wc * 32 + fr, fq * 8);
#define PG8_SA(b, h) (((b) * 2 + (h)) * HTB)
#define PG8_SB(b, h) ((4 + (b) * 2 + (h)) * HTB)
#define PG8_STAGE(bufoff, gbase, voff) do { _Pragma("unroll") for (int _i = 0; _i < 2; ++_i) \
        __builtin_amdgcn_global_load_lds((const unsigned*)((const char*)(gbase) + (voff)[_i]), (PG8_LAS unsigned*)(lds + (bufoff) + ldsw + _i * 8192), 16, 0, 0); } while (0)
#define PG8_LDA(dst, b, h) do { _Pragma("unroll") for (int m = 0; m < 4; ++m) _Pragma("unroll") for (int k = 0; k < 2; ++k) dst[m][k] = *(const PG8_LAS bf16x8*)(lds + PG8_SA(b, h) + aoff + m * 2048 + k * 1024); } while (0)
#define PG8_LDB(dst, b, h) do { _Pragma("unroll") for (int n = 0; n < 2; ++n) _Pragma("unroll") for (int k = 0; k < 2; ++k) dst[n][k] = *(const PG8_LAS bf16x8*)(lds + PG8_SB(b, h) + boff + n * 2048 + k * 1024); } while (0)
#define PG8_MMA(ai, bj, At, Bt) do { __builtin_amdgcn_s_setprio(1); _Pragma("unroll") for (int m = 0; m < 4; ++m) _Pragma("unroll") for (int n = 0; n < 2; ++n) _Pragma("unroll") for (int k = 0; k < 2; ++k) \
        acc[ai][bj][m][n] = __builtin_amdgcn_mfma_f32_16x16x32_bf16(Bt[n][k], At[m][k], acc[ai][bj][m][n], 0, 0, 0); __builtin_amdgcn_s_setprio(0); } while (0)
#define PG8_WAIT_V(n) asm volatile("s_waitcnt vmcnt(" #n ")" ::: "memory")
#define PG8_WAIT_L(n) asm volatile("s_waitcnt lgkmcnt(" #n ")" ::: "memory")
#define PG8_BAR __builtin_amdgcn_s_barrier()
#define PG8_SCHED __builtin_amdgcn_sched_barrier(0)
    Unit cur, nxt; int ui = 0;
    if (!S.next(0, cur)) return;
    f32x4 acc[2][2][4][2];
#pragma unroll
    for (int a = 0; a < 2; ++a)
#pragma unroll
        for (int b = 0; b < 2; ++b)
#pragma unroll
            for (int m = 0; m < 4; ++m)
#pragma unroll
                for (int n = 0; n < 2; ++n) acc[a][b][m][n] = (f32x4){0.f, 0.f, 0.f, 0.f};
    bf16x8 At[4][2], B0[2][2], B1[2][2];
    const char* cA = (const char*)g.A + (size_t)cur.pm * tstepA; const char* cB = (const char*)g.Bt + (size_t)cur.pn * tstepB;
    S.a_ready(cur);
    if constexpr (SP2) {
        PG8_STAGE(PG8_SB(0, 0), cB, voffB); PG8_STAGE(PG8_SB(0, 1), cB + hstepB, voffB); PG8_STAGE(PG8_SA(0, 0), cA, voffA); PG8_STAGE(PG8_SA(0, 1), cA + hstepA, voffA);
        if (wr == 1) PG8_BAR;
        PG8_WAIT_V(2); PG8_BAR;
        PG8_STAGE(PG8_SB(1, 0), cB + kstep, voffB); PG8_STAGE(PG8_SA(1, 0), cA + kstep, voffA); PG8_STAGE(PG8_SB(1, 1), cB + hstepB + kstep, voffB);
        PG8_WAIT_V(6); PG8_BAR;
    } else {
        PG8_STAGE(PG8_SB(0, 0), cB, voffB); PG8_STAGE(PG8_SA(0, 0), cA, voffA); PG8_STAGE(PG8_SB(0, 1), cB + hstepB, voffB); PG8_STAGE(PG8_SA(0, 1), cA + hstepA, voffA);
        if (wr == 1) PG8_BAR;
        PG8_WAIT_V(4); PG8_BAR;
        PG8_STAGE(PG8_SB(1, 0), cB + kstep, voffB); PG8_STAGE(PG8_SA(1, 0), cA + kstep, voffA); PG8_STAGE(PG8_SB(1, 1), cB + hstepB + kstep, voffB);
        PG8_WAIT_V(6); PG8_BAR;
    }
    for (;;) {
        const bool has_next = S.next(ui + 1, nxt);
        const char* nA = has_next ? (const char*)g.A + (size_t)nxt.pm * tstepA : cA; const char* nB = has_next ? (const char*)g.Bt + (size_t)nxt.pn * tstepB : cB;
        for (int t = 0; t < nt; t += 2) {
            const bool last = (t == nt - 2);
            const char* a1 = cA + (size_t)(t + 1) * kstep;
            const char* a2 = last ? nA : cA + (size_t)(t + 2) * kstep; const char* b2 = last ? nB : cB + (size_t)(t + 2) * kstep;
            const char* a3 = a2 + kstep; const char* b3 = b2 + kstep;
            if (last && has_next) S.a_ready(nxt);
            if constexpr (SP2) {
            PG8_LDB(B0, 0, 0); PG8_LDB(B1, 0, 1); PG8_SCHED; PG8_LDA(At, 0, 0); PG8_STAGE(PG8_SA(1, 1), a1 + hstepA, voffA);
            PG8_WAIT_V(8); PG8_WAIT_L(0); PG8_BAR; PG8_MMA(0, 0, At, B0); PG8_MMA(0, 1, At, B1); PG8_BAR; PG8_SCHED;
            PG8_LDA(At, 0, 1); PG8_STAGE(PG8_SB(0, 0), b2, voffB); PG8_STAGE(PG8_SB(0, 1), b2 + hstepB, voffB); PG8_STAGE(PG8_SA(0, 0), a2, voffA);
            PG8_WAIT_V(8); PG8_WAIT_L(0); PG8_BAR; PG8_MMA(1, 0, At, B0); PG8_MMA(1, 1, At, B1); PG8_BAR; PG8_SCHED;
            PG8_LDB(B0, 1, 0); PG8_LDB(B1, 1, 1); PG8_SCHED; PG8_LDA(At, 1, 0); PG8_STAGE(PG8_SA(0, 1), a2 + hstepA, voffA);
            PG8_WAIT_V(8); PG8_WAIT_L(0); PG8_BAR; PG8_MMA(0, 0, At, B0); PG8_MMA(0, 1, At, B1); PG8_BAR; PG8_SCHED;
            PG8_LDA(At, 1, 1); PG8_STAGE(PG8_SB(1, 0), b3, voffB); PG8_STAGE(PG8_SB(1, 1), b3 + hstepB, voffB); PG8_STAGE(PG8_SA(1, 0), a3, voffA);
            PG8_WAIT_V(8); PG8_WAIT_L(0); PG8_BAR; PG8_MMA(1, 0, At, B0); PG8_MMA(1, 1, At, B1); PG8_BAR; PG8_SCHED;
            } else {
            PG8_LDB(B0, 0, 0); PG8_SCHED; PG8_LDA(At, 0, 0); PG8_STAGE(PG8_SA(1, 1), a1 + hstepA, voffA);
            PG8_WAIT_L(8); PG8_BAR; PG8_WAIT_L(0); PG8_MMA(0, 0, At, B0); PG8_BAR; PG8_SCHED;
            PG8_LDB(B1, 0, 1); PG8_STAGE(PG8_SB(0, 0), b2, voffB);
            PG8_BAR; PG8_WAIT_L(0); PG8_MMA(0, 1, At, B1); PG8_BAR;
            PG8_LDA(At, 0, 1); PG8_STAGE(PG8_SA(0, 0), a2, voffA);
            PG8_BAR; PG8_WAIT_L(0); PG8_MMA(1, 0, At, B0); PG8_BAR; PG8_SCHED;
            PG8_STAGE(PG8_SB(0, 1), b2 + hstepB, voffB);
            PG8_WAIT_V(6); PG8_BAR; PG8_MMA(1, 1, At, B1); PG8_BAR;
            PG8_LDB(B0, 1, 0); PG8_SCHED; PG8_LDA(At, 1, 0); PG8_STAGE(PG8_SA(0, 1), a2 + hstepA, voffA);
            PG8_WAIT_L(8); PG8_BAR; PG8_WAIT_L(0); PG8_MMA(0, 0, At, B0); PG8_BAR; PG8_SCHED;
            PG8_LDB(B1, 1, 1); PG8_STAGE(PG8_SB(1, 0), b3, voffB);
            PG8_BAR; PG8_WAIT_L(0); PG8_MMA(0, 1, At, B1); PG8_BAR;
            PG8_LDA(At, 1, 1); PG8_STAGE(PG8_SA(1, 0), a3, voffA);
            PG8_BAR; PG8_WAIT_L(0); PG8_MMA(1, 0, At, B0); PG8_BAR; PG8_SCHED;
            PG8_STAGE(PG8_SB(1, 1), b3 + hstepB, voffB);
            PG8_WAIT_V(6); PG8_BAR; PG8_MMA(1, 1, At, B1); PG8_BAR;
            }
        }
        if constexpr (ALIGN_EPI) { if (wr == 0) PG8_BAR; }
        if constexpr (!Epi::AFTER_DRAIN) { E(acc, cur, ui, wr, wc, fr, fq); S.done(cur); }
        if (!has_next) break;
#pragma unroll
        for (int a = 0; a < 2; ++a)
#pragma unroll
            for (int b = 0; b < 2; ++b)
#pragma unroll
                for (int m = 0; m < 4; ++m)
#pragma unroll
                    for (int n = 0; n < 2; ++n) acc[a][b][m][n] = (f32x4){0.f, 0.f, 0.f, 0.f};
        cur = nxt; cA = nA; cB = nB; ++ui;
        if constexpr (ALIGN_EPI) { if (wr == 1) PG8_BAR; }
    }
    PG8_WAIT_V(0);
    if constexpr (!ALIGN_EPI) { if (wr == 0) PG8_BAR; }
    PG8_BAR;

#undef PG8_SA
#undef PG8_SB
#undef PG8_STAGE
#undef PG8_LDA
#undef PG8_LDB
#undef PG8_MMA
#undef PG8_WAIT_V
#undef PG8_WAIT_L
#undef PG8_BAR
#undef PG8_SCHED
}
}

constexpr int NWAVES = 8, NTHREADS = NWAVES * 64;
constexpr int BATCH = 8, SEQ = 2048, D = 1024, M = BATCH * SEQ, FF = 4096, DEPTH = 2;
constexpr int D_IN = 2312, NPROJ = 2560, PP = pg8::PROJ_PITCH;
constexpr int CQ = 0, CZ = 512, CK = 1024, CV = 1152, CX = 1280, CBM = 1792, CCM = 2048;
constexpr float EPS = 1e-6f;
constexpr int NPH = 1 + 7 * DEPTH;

constexpr size_t MiB = 1u << 20;
constexpr size_t WS_CTL = 0, CTL_ZERO_BYTES = 1 * MiB;
constexpr size_t WS_SSQ = 1 * MiB;
constexpr size_t WS_DTRAW = 2 * MiB;
constexpr size_t WS_WIN = 4 * MiB, WS_WOUT = 14 * MiB, WS_WUP = 18 * MiB, WS_WDOWN = 34 * MiB;
constexpr size_t WS_XB = 50 * MiB;
constexpr size_t WS_PROJ = 82 * MiB;
constexpr size_t WS_XBCF = 154 * MiB;
constexpr size_t WS_YN = 218 * MiB;
constexpr size_t WS_HID = 82 * MiB;
constexpr size_t WS_END = 256 * MiB;
constexpr int CW_BAR = 4096;

constexpr int RING_OFF = 0, RING_BYTES = 131072;
constexpr int LDSCTL_OFF = RING_BYTES, MISC_OFF = LDSCTL_OFF + 320, RSTD_OFF = LDSCTL_OFF + 512, PTR_OFF = RSTD_OFF + 4096;
constexpr int LDS_BYTES = 147456;
static_assert(PTR_OFF + 512 <= LDS_BYTES, "LDS map");

#define GAS __attribute__((address_space(1)))
#define LAS __attribute__((address_space(3)))
typedef unsigned short bf16;
typedef unsigned v4u __attribute__((ext_vector_type(4)));
typedef unsigned v2u __attribute__((ext_vector_type(2)));
typedef float f32x4 __attribute__((ext_vector_type(4)));
typedef GAS unsigned gu32;
#define RLX_AGENT __ATOMIC_RELAXED, __HIP_MEMORY_SCOPE_AGENT
#define LDS_WAIT() asm volatile("s_waitcnt lgkmcnt(0)" ::: "memory")
#define VM_WAIT() asm volatile("s_waitcnt vmcnt(0)" ::: "memory")
__device__ __forceinline__ unsigned f2bf(float f) { unsigned u = __builtin_bit_cast(unsigned, f); return (u + 0x7fffu + ((u >> 16) & 1u)) >> 16; }
__device__ __forceinline__ unsigned pk2(float lo, float hi) { return f2bf(lo) | (f2bf(hi) << 16); }
__device__ __forceinline__ float bflo(unsigned w) { return __uint_as_float(w << 16); }
__device__ __forceinline__ float bfhi(unsigned w) { return __uint_as_float(w & 0xffff0000u); }
__device__ __forceinline__ float silu_f(float v) { return v / (1.f + expf(-v)); }
__device__ __forceinline__ float softplus_f(float v) { return fmaxf(v, 0.f) + log1pf(expf(-fabsf(v))); }

#define XB_TMO      128
#define XB_XCNT(j)  (256  + 64 * (j))
#define XB_XSUB(j)  (1280 + 64 * (j))
#define XB_XGEN(j)  (2304 + 64 * (j))
#define XB_TOP      3328
#define XB_TOPGEN   3392
#define XCD_BAR_WORDS 3456
#define XB_SPIN_CAP (1u << 22)
__device__ __forceinline__ unsigned xb_ld(unsigned* p)              { return __hip_atomic_load(p, __ATOMIC_RELAXED, __HIP_MEMORY_SCOPE_AGENT); }
__device__ __forceinline__ unsigned xb_add(unsigned* p, unsigned v) { return __hip_atomic_fetch_add(p, v, __ATOMIC_RELAXED, __HIP_MEMORY_SCOPE_AGENT); }
__device__ __forceinline__ unsigned xb_xcc_id() { return (unsigned)__builtin_amdgcn_s_getreg((3 << 11) | 20) & 0xFu; }
#define XB_SPIN(cond, bar) do { unsigned _sp = 0; while (cond) { __builtin_amdgcn_s_sleep(1); \
    if ((++_sp & 255u) == 0u) { if (xb_ld(&(bar)[XB_TMO])) break; if (_sp > XB_SPIN_CAP) { atomicAdd(&(bar)[XB_TMO], 1u); break; } } } } while (0)
struct XcdBarrier { unsigned* bar; unsigned x; volatile LAS unsigned* st; };
__device__ __forceinline__ XcdBarrier xcd_barrier_post(unsigned* bar, volatile LAS unsigned* st) {
    XcdBarrier b; b.bar = bar; b.x = xb_xcc_id(); b.st = st;
    if (threadIdx.x == 0) (void)xb_add(&bar[XB_XCNT(b.x)], 1u);
    return b;
}
__device__ __forceinline__ void xcd_barrier_complete(unsigned* bar, unsigned x, unsigned& nloc, unsigned& nx) {
    const unsigned G = gridDim.x * gridDim.y * gridDim.z;
    unsigned sum, cnt, mine, sp = 0u;
    for (;;) {
        sum = 0u; cnt = 0u; mine = 0u;
#pragma unroll
        for (unsigned j = 0; j < 16; ++j) { const unsigned c = xb_ld(&bar[XB_XCNT(j)]); sum += c; cnt += (c > 0u) ? 1u : 0u; mine = (j == x) ? c : mine; }
        if (sum == G) break;
        __builtin_amdgcn_s_sleep(1);
        if ((++sp & 255u) == 0u) { if (xb_ld(&bar[XB_TMO])) break; if (sp > XB_SPIN_CAP) { atomicAdd(&bar[XB_TMO], 1u); break; } }
    }
    nloc = mine > 0u ? mine : 1u; nx = cnt > 0u ? cnt : 1u;
}
__device__ __forceinline__ void xcd_barrier(const XcdBarrier& b) {
    asm volatile("s_waitcnt vmcnt(0)" ::: "memory");
    __syncthreads();
    if (threadIdx.x == 0) {
        unsigned* bar = b.bar;
        __builtin_amdgcn_s_waitcnt(0);
        unsigned nloc = b.st[0], nx = b.st[1];
        if (nloc == 0u) { xcd_barrier_complete(bar, b.x, nloc, nx); b.st[0] = nloc; b.st[1] = nx; }
        const unsigned old = xb_add(&bar[XB_XSUB(b.x)], 1u);
        const unsigned gen = old / nloc;
        if (old + 1u == (gen + 1u) * nloc) {
            __builtin_amdgcn_fence(__ATOMIC_RELEASE, "agent");
            asm volatile("s_waitcnt vmcnt(0)" ::: "memory");
            const unsigned og = xb_add(&bar[XB_TOP], 1u);
            const unsigned tg = og / nx;
            if (og + 1u == (tg + 1u) * nx) xb_add(&bar[XB_TOPGEN], 1u);
            else XB_SPIN(xb_ld(&bar[XB_TOPGEN]) == tg, bar);
            __builtin_amdgcn_fence(__ATOMIC_ACQUIRE, "agent");
            xb_add(&bar[XB_XGEN(b.x)], 1u);
            asm volatile("s_waitcnt vmcnt(0)" ::: "memory");
        } else {
            XB_SPIN(xb_ld(&bar[XB_XGEN(b.x)]) == gen, bar);
            __builtin_amdgcn_fence(__ATOMIC_ACQUIRE, "agent");
            asm volatile("s_waitcnt vmcnt(0)" ::: "memory");
        }
    }
    __syncthreads();
}

struct Frame {
    LAS unsigned char* lds;
    int tid, lane, wave, bid, G;
};
enum { I_X = 0, I_MIXG, I_WIN, I_QG, I_KG, I_SINK, I_RELB, I_CONVW, I_CONVB, I_DTB, I_ALOG, I_DSKIP, I_SSMG, I_WOUT, I_MLPG, I_WUP, I_WDOWN, I_OUT, I_WS, I_NPTR };
__device__ __forceinline__ unsigned char* ptr_at(const Frame& F, int i) {
    const LAS unsigned* t = (const LAS unsigned*)(F.lds + PTR_OFF) + 2 * i;
    const unsigned lo = __builtin_amdgcn_readfirstlane(t[0]), hi = __builtin_amdgcn_readfirstlane(t[1]);
    return (unsigned char*)(((unsigned long long)hi << 32) | lo);
}
#define FIN(i) ((const float*)ptr_at(F, (i)))
#define FWS(off) (ptr_at(F, I_WS) + (off))
__device__ __forceinline__ float wave_sum(float v) {
#pragma unroll
    for (int o = 1; o < 64; o <<= 1) v += __shfl_xor(v, o);
    return v;
}

__device__ __forceinline__ void tr_item(const float* W, int Nsrc, int nsrc0, int nvalid, int K, const float* gain, bf16* WT, int ndst0, int k0, LAS float* scr, int lane) {
    const int n = lane & 31;
#pragma unroll 8
    for (int i = 0; i < 32; ++i) { const int kk = 2 * i + (lane >> 5); float v = 0.f;
        if (n < nvalid) { v = W[(size_t)(k0 + kk) * Nsrc + nsrc0 + n]; if (gain) v *= gain[k0 + kk]; }
        scr[kk * 33 + n] = v; }
    LDS_WAIT(); asm volatile("" ::: "memory");
    const int c = lane & 7;
#pragma unroll
    for (int j = 0; j < 4; ++j) { const int nn = (lane >> 3) + 8 * j; const LAS float* s = scr + (8 * c) * 33 + nn;
        v4u o; o.x = pk2(s[0 * 33], s[1 * 33]); o.y = pk2(s[2 * 33], s[3 * 33]); o.z = pk2(s[4 * 33], s[5 * 33]); o.w = pk2(s[6 * 33], s[7 * 33]);
        *(GAS v4u*)(WT + (size_t)(ndst0 + nn) * K + k0 + 8 * c) = o; }
    LDS_WAIT(); asm volatile("" ::: "memory");
}
__device__ __forceinline__ void p0_prologue(Frame& F) {
    LAS float* scr = (LAS float*)(F.lds + RING_OFF + F.wave * 16384);
    const int gw = F.bid * NWAVES + F.wave, NGW = F.G * NWAVES;
    constexpr int I_IN = 16 * 80, I_OUT = 16 * 32, I_UP = 16 * 128, I_DN = 64 * 32, I_L = I_IN + I_OUT + I_UP + I_DN;
    {
    const float *w_in = FIN(I_WIN), *mix_g = FIN(I_MIXG), *w_out = FIN(I_WOUT), *w_up = FIN(I_WUP), *mlp_g = FIN(I_MLPG), *w_down = FIN(I_WDOWN);
    bf16 *WIN = (bf16*)FWS(WS_WIN), *WOUT = (bf16*)FWS(WS_WOUT), *WUP = (bf16*)FWS(WS_WUP), *WDOWN = (bf16*)FWS(WS_WDOWN);
    for (int it = gw; it < DEPTH * I_L; it += NGW) {
        const int L = it / I_L; int r = it % I_L;
        if (r < I_IN) {
            const int kb = r / 80, nb = r % 80; int src, nv = 32;
            if (nb < 16) src = nb * 32; else if (nb < 32) src = 768 + (nb - 16) * 32; else if (nb < 36) src = 512 + (nb - 32) * 32; else if (nb < 40) src = 640 + (nb - 36) * 32;
            else if (nb < 72) src = nb * 32; else if (nb == 72) { src = 2304; nv = 8; } else { src = 0; nv = 0; }
            tr_item(w_in + (size_t)L * D * D_IN, D_IN, src, nv, D, mix_g + L * D, WIN + (size_t)L * NPROJ * D, nb * 32, kb * 64, scr, F.lane); continue; }
        r -= I_IN;
        if (r < I_OUT) { const int kb = r / 32, nb = r % 32; tr_item(w_out + (size_t)L * D * D, D, nb * 32, 32, D, nullptr, WOUT + (size_t)L * D * D, nb * 32, kb * 64, scr, F.lane); continue; }
        r -= I_OUT;
        if (r < I_UP) { const int kb = r / 128, nb = r % 128; tr_item(w_up + (size_t)L * D * FF, FF, nb * 32, 32, D, mlp_g + L * D, WUP + (size_t)L * FF * D, nb * 32, kb * 64, scr, F.lane); continue; }
        r -= I_UP;
        { const int kb = r / 32, nb = r % 32; tr_item(w_down + (size_t)L * FF * D, D, nb * 32, 32, FF, nullptr, WDOWN + (size_t)L * D * FF, nb * 32, kb * 64, scr, F.lane); }
    }
    }
    const float* x = FIN(I_X); bf16* XB = (bf16*)FWS(WS_XB); float* SSQ = (float*)FWS(WS_SSQ);
    for (int m = gw; m < M; m += NGW) {
        const GAS f32x4* xr = (const GAS f32x4*)(x + (size_t)m * D) + F.lane;
        f32x4 v[4]; float s = 0.f;
#pragma unroll
        for (int j = 0; j < 4; ++j) { v[j] = xr[64 * j]; s += (v[j].x * v[j].x + v[j].y * v[j].y) + (v[j].z * v[j].z + v[j].w * v[j].w); }
        s = wave_sum(s);
        GAS v2u* o8 = (GAS v2u*)(XB + (size_t)m * D) + F.lane;
#pragma unroll
        for (int j = 0; j < 4; ++j) { v2u o; o.x = pk2(v[j].x, v[j].y); o.y = pk2(v[j].z, v[j].w); o8[64 * j] = o; }
        if (F.lane < 16) SSQ[(size_t)m * 16 + F.lane] = (F.lane == 0) ? s : 0.f;
    }
}
__device__ __forceinline__ void rstd_prepass(Frame& F, const pg8::StaticOrder& S, LAS float* tab) {
    const float* SSQ = (const float*)FWS(WS_SSQ);
    pg8::Unit u;
    for (int i = 0; i < 4 && S.next(i, u); ++i) {
        const int r = F.tid >> 1, h = F.tid & 1;
        const f32x4* p = (const f32x4*)(SSQ + (size_t)(u.pm * 256 + r) * 16 + h * 8);
        const f32x4 a = p[0], b = p[1];
        float s = (a.x + a.y) + (a.z + a.w) + (b.x + b.y) + (b.z + b.w);
        s += __shfl_xor(s, 1);
        if (h == 0) tab[i * 256 + r] = 1.0f / sqrtf(s * (1.0f / D) + EPS);
    }
    LDS_WAIT(); __syncthreads();
}

__device__ __forceinline__ int t5_bucket(int d) {
    if (d < 16) return d;
    return 16 + (d >= 19) + (d >= 21) + (d >= 24) + (d >= 27) + (d >= 31) + (d >= 35) + (d >= 40) + (d >= 46) + (d >= 52) + (d >= 59) + (d >= 67) + (d >= 77) + (d >= 87) + (d >= 99) + (d >= 113);
}
__device__ __forceinline__ void ld8(const bf16* p, float (&v)[8]) {
    const v4u w = *(const v4u*)p;
    v[0] = bflo(w.x); v[1] = bfhi(w.x); v[2] = bflo(w.y); v[3] = bfhi(w.y); v[4] = bflo(w.z); v[5] = bfhi(w.z); v[6] = bflo(w.w); v[7] = bfhi(w.w);
}
__device__ __forceinline__ void attn_naive(Frame& F, int L) {
    const float* qg = FIN(I_QG) + L * 64; const float* kg = FIN(I_KG) + L * 64; const float* sinks = FIN(I_SINK); const float* rel_bias = FIN(I_RELB);
    bf16* PROJ = (bf16*)FWS(WS_PROJ);
    for (int it = F.bid * NTHREADS + F.tid; it < M * 8; it += F.G * NTHREADS) {
        const int m = it >> 3, hq = it & 7, hkv = hq >> 2, t = m & (SEQ - 1);
        bf16* qp = PROJ + (size_t)m * PP + CQ + hq * 64;
        float q[64]; float ss = 0.f;
#pragma unroll
        for (int c = 0; c < 8; ++c) { float v[8]; ld8(qp + 8 * c, v);
#pragma unroll
            for (int e = 0; e < 8; ++e) { q[8 * c + e] = v[e]; ss += v[e] * v[e]; } }
        const float rq = 1.0f / sqrtf(ss * (1.0f / 64.0f) + EPS);
#pragma unroll
        for (int d = 0; d < 64; ++d) q[d] = q[d] * rq * qg[d] * 0.125f * kg[d];
        const float sink = sinks[L * 8 + hq];
        float mrun = sink, l = 1.f; float acc[64];
#pragma unroll
        for (int d = 0; d < 64; ++d) acc[d] = 0.f;
        const int j0 = t - 127 > 0 ? t - 127 : 0;
        for (int j = j0; j <= t; ++j) {
            const bf16* kp = PROJ + (size_t)(m - t + j) * PP + CK + hkv * 64;
            float dot = 0.f, sk = 0.f;
#pragma unroll
            for (int c = 0; c < 8; ++c) { float v[8]; ld8(kp + 8 * c, v);
#pragma unroll
                for (int e = 0; e < 8; ++e) { dot += q[8 * c + e] * v[e]; sk += v[e] * v[e]; } }
            const float s = dot / sqrtf(sk * (1.0f / 64.0f) + EPS) + rel_bias[t5_bucket(t - j) * 8 + hq];
            const float mn = fmaxf(mrun, s), a = expf(mrun - mn), p = expf(s - mn);
            l = l * a + p; mrun = mn;
            const bf16* vp = kp + (CV - CK);
#pragma unroll
            for (int c = 0; c < 8; ++c) { float v[8]; ld8(vp + 8 * c, v);
#pragma unroll
                for (int e = 0; e < 8; ++e) acc[8 * c + e] = acc[8 * c + e] * a + p * v[e]; }
        }
        const float inv = 1.0f / l;
#pragma unroll
        for (int c = 0; c < 8; ++c) { v4u o; o.x = pk2(acc[8 * c] * inv, acc[8 * c + 1] * inv); o.y = pk2(acc[8 * c + 2] * inv, acc[8 * c + 3] * inv);
            o.z = pk2(acc[8 * c + 4] * inv, acc[8 * c + 5] * inv); o.w = pk2(acc[8 * c + 6] * inv, acc[8 * c + 7] * inv); *(v4u*)(qp + 8 * c) = o; }
    }
}
__device__ __forceinline__ void conv_naive(Frame& F, int L) {
    const float* conv_w = FIN(I_CONVW); const float* conv_b = FIN(I_CONVB); const bf16* PROJ = (const bf16*)FWS(WS_PROJ); float* XBCF = (float*)FWS(WS_XBCF);
    for (int it = F.bid * NTHREADS + F.tid; it < M * 128; it += F.G * NTHREADS) {
        const int m = it >> 7, c0 = (it & 127) * 8, t = m & (SEQ - 1);
        float o[8];
#pragma unroll
        for (int e = 0; e < 8; ++e) o[e] = conv_b[L * 1024 + c0 + e];
#pragma unroll
        for (int k = 0; k < 4; ++k) { if (t - 3 + k >= 0) { float v[8]; ld8(PROJ + (size_t)(m - 3 + k) * PP + CX + c0, v);
#pragma unroll
                for (int e = 0; e < 8; ++e) o[e] += conv_w[(size_t)(L * 4 + k) * 1024 + c0 + e] * v[e]; } }
        f32x4 a, b; a.x = silu_f(o[0]); a.y = silu_f(o[1]); a.z = silu_f(o[2]); a.w = silu_f(o[3]); b.x = silu_f(o[4]); b.y = silu_f(o[5]); b.z = silu_f(o[6]); b.w = silu_f(o[7]);
        *(f32x4*)(XBCF + (size_t)m * 1024 + c0) = a; *(f32x4*)(XBCF + (size_t)m * 1024 + c0 + 4) = b;
    }
}
__device__ __forceinline__ void ssd_naive(Frame& F, int L) {
    if (F.wave != 0 || F.bid >= 64) return;
    const int b = F.bid >> 3, hh = F.bid & 7, g = hh >> 2, p = F.lane;
    const float a = -expf(FIN(I_ALOG)[L * 8 + hh]), dtb = FIN(I_DTB)[L * 8 + hh], dsk = FIN(I_DSKIP)[L * 8 + hh];
    const float* DTRAW = (const float*)FWS(WS_DTRAW); const float* XBCF = (const float*)FWS(WS_XBCF); float* YN = (float*)FWS(WS_YN);
    float st[128];
#pragma unroll
    for (int n = 0; n < 128; ++n) st[n] = 0.f;
    for (int t = 0; t < SEQ; ++t) {
        const size_t m = (size_t)b * SEQ + t;
        const float dtv = softplus_f(DTRAW[m * 8 + hh] + dtb), dA = expf(dtv * a), xv = XBCF[m * 1024 + hh * 64 + p], xd = xv * dtv;
        const GAS f32x4* Bp = (const GAS f32x4*)(XBCF + m * 1024 + 512 + g * 128); const GAS f32x4* Cp = (const GAS f32x4*)(XBCF + m * 1024 + 768 + g * 128);
        float y = 0.f;
#pragma unroll
        for (int n4 = 0; n4 < 32; ++n4) { const f32x4 bv = Bp[n4], cv = Cp[n4];
#pragma unroll
            for (int e = 0; e < 4; ++e) { st[4 * n4 + e] = st[4 * n4 + e] * dA + xd * bv[e]; y += cv[e] * st[4 * n4 + e]; } }
        YN[m * 512 + hh * 64 + p] = y + dsk * xv;
    }
}
__device__ __forceinline__ void gate_naive(Frame& F, int L) {
    const int gw = F.bid * NWAVES + F.wave, NGW = F.G * NWAVES;
    const float* ssm_g = FIN(I_SSMG); bf16* PROJ = (bf16*)FWS(WS_PROJ); const float* YN = (const float*)FWS(WS_YN);
    for (int it = gw; it < M * 2; it += NGW) {
        const int m = it >> 1, g = it & 1, ch = g * 256 + 4 * F.lane;
        const f32x4 y = *(const f32x4*)(YN + (size_t)m * 512 + ch);
        bf16* zp = PROJ + (size_t)m * PP + CZ + ch;
        const v2u zw = *(const v2u*)zp;
        float v[4]; v[0] = y.x * silu_f(bflo(zw.x)); v[1] = y.y * silu_f(bfhi(zw.x)); v[2] = y.z * silu_f(bflo(zw.y)); v[3] = y.w * silu_f(bfhi(zw.y));
        const float ss = wave_sum((v[0] * v[0] + v[1] * v[1]) + (v[2] * v[2] + v[3] * v[3]));
        const float r = 1.0f / sqrtf(ss * (1.0f / 256.0f) + EPS);
        const float* ng = ssm_g + L * 512 + ch;
        v2u o; o.x = pk2(v[0] * r * ng[0], v[1] * r * ng[1]); o.y = pk2(v[2] * r * ng[2], v[3] * r * ng[3]);
        *(v2u*)zp = o;
    }
}

__device__ __forceinline__ void ph_inproj(Frame& F, int L) {
    LAS float* rstd_tab = (LAS float*)(F.lds + RSTD_OFF);
    int bid_ = F.bid; asm volatile("" : "+s"(bid_)); pg8::StaticOrder S; S.init(M, NPROJ, F.G, bid_);
    rstd_prepass(F, S, rstd_tab);
    pg8::Gemm g{(const bf16*)FWS(WS_XB), (const bf16*)FWS(WS_WIN) + (size_t)L * NPROJ * D, M, NPROJ, D, D};
    pg8::EpiProj E{(bf16*)FWS(WS_PROJ), (float*)FWS(WS_DTRAW), (const LAS float*)rstd_tab};
    pg8::gemm_phase<pg8::EpiProj, pg8::StaticOrder, true, true>(F.lds + RING_OFF, g, S, E);
}
__device__ __forceinline__ void ph_outproj(Frame& F, int L) {
    int bid_ = F.bid; asm volatile("" : "+s"(bid_)); pg8::StaticOrder S; S.init(M, D, F.G, bid_);
    pg8::Gemm g{(const bf16*)FWS(WS_PROJ), (const bf16*)FWS(WS_WOUT) + (size_t)L * D * D, M, D, D, PP};
    float* out = (float*)ptr_at(F, I_OUT);
    pg8::EpiRes E{L == 0 ? FIN(I_X) : (const float*)out, out, (bf16*)FWS(WS_XB), (float*)FWS(WS_SSQ)};
    pg8::gemm_phase<pg8::EpiRes, pg8::StaticOrder, false, true>(F.lds + RING_OFF, g, S, E);
}
__device__ __forceinline__ void ph_up(Frame& F, int L) {
    LAS float* rstd_tab = (LAS float*)(F.lds + RSTD_OFF);
    int bid_ = F.bid; asm volatile("" : "+s"(bid_)); pg8::StaticOrder S; S.init(M, FF, F.G, bid_);
    rstd_prepass(F, S, rstd_tab);
    pg8::Gemm g{(const bf16*)FWS(WS_XB), (const bf16*)FWS(WS_WUP) + (size_t)L * FF * D, M, FF, D, D};
    pg8::EpiUp E{(bf16*)FWS(WS_HID), FF, (const LAS float*)rstd_tab};
    pg8::gemm_phase<pg8::EpiUp, pg8::StaticOrder, true, true>(F.lds + RING_OFF, g, S, E);
}
__device__ __forceinline__ void ph_down(Frame& F, int L) {
    int bid_ = F.bid; asm volatile("" : "+s"(bid_)); pg8::StaticOrder S; S.init(M, D, F.G, bid_);
    pg8::Gemm g{(const bf16*)FWS(WS_HID), (const bf16*)FWS(WS_WDOWN) + (size_t)L * D * FF, M, D, FF, FF};
    float* out = (float*)ptr_at(F, I_OUT);
    pg8::EpiRes E{(const float*)out, out, (bf16*)FWS(WS_XB), (float*)FWS(WS_SSQ)};
    pg8::gemm_phase<pg8::EpiRes, pg8::StaticOrder, false, true>(F.lds + RING_OFF, g, S, E);
}

struct Args { const float* in[17]; float* out; unsigned char* ws; int ph_lo, ph_hi; };
#define FRAME_INIT() \
    extern __shared__ __attribute__((aligned(16))) unsigned char lds[]; \
    Frame F; \
    F.lds = (LAS unsigned char*)lds; \
    F.tid = threadIdx.x; F.lane = F.tid & 63; F.wave = __builtin_amdgcn_readfirstlane(F.tid >> 6); F.bid = blockIdx.x; F.G = gridDim.x; \
    for (int u = F.tid; u < (LDS_BYTES - LDSCTL_OFF) / 4; u += NTHREADS) ((LAS unsigned*)(F.lds + LDSCTL_OFF))[u] = 0u; \
    __syncthreads(); \
    if (F.tid < I_NPTR) { const unsigned long long p = F.tid < 17 ? (unsigned long long)args.in[F.tid < 17 ? F.tid : 0] : (F.tid == I_OUT ? (unsigned long long)args.out : (unsigned long long)args.ws); \
        LAS unsigned* t = (LAS unsigned*)(F.lds + PTR_OFF) + 2 * F.tid; t[0] = (unsigned)p; t[1] = (unsigned)(p >> 32); } \
    LDS_WAIT(); __syncthreads();

#if !ONE_LAUNCH
__global__ void __launch_bounds__(NTHREADS, 2) k_mix1_naive(Args args) { FRAME_INIT(); attn_naive(F, args.ph_lo); conv_naive(F, args.ph_lo); }
__global__ void __launch_bounds__(NTHREADS, 2) k_mix2_naive(Args args) { FRAME_INIT(); ssd_naive(F, args.ph_lo); }
__global__ void __launch_bounds__(NTHREADS, 2) k_mix3_naive(Args args) { FRAME_INIT(); gate_naive(F, args.ph_lo); }
#endif
#define PH_MIX1(F, L) do { attn_naive(F, L); conv_naive(F, L); } while (0)
#define PH_MIX2(F, L) ssd_naive(F, L)
#define PH_MIX3(F, L) gate_naive(F, L)

__global__ void __launch_bounds__(NTHREADS, 2) fwd(Args args) {
    FRAME_INIT();
    const int lo = args.ph_lo, hi = args.ph_hi;
#if ONE_LAUNCH
    XcdBarrier bar = xcd_barrier_post((unsigned*)(FWS(WS_CTL)) + CW_BAR, (volatile LAS unsigned*)(F.lds + MISC_OFF) + 8);
#define GRID_BAR() xcd_barrier(bar)
#else
#define GRID_BAR() do {} while (0)
#endif
#define IN(k) (lo <= (k) && (k) < hi)
#define RELAUNDER() do { int t_ = threadIdx.x; asm volatile("" : "+v"(t_)); F.tid = t_; F.lane = t_ & 63; F.wave = __builtin_amdgcn_readfirstlane(t_ >> 6); \
    int b_ = blockIdx.x; asm volatile("" : "+s"(b_)); F.bid = b_; } while (0)
#define SEAM(k) do { if (IN(k) && IN((k) + 1)) GRID_BAR(); } while (0)

    if (IN(0)) { p0_prologue(F); SEAM(0); }
    for (int L = 0; L < DEPTH; ++L) {
        const int pb = 1 + 7 * L;
        if (IN(pb + 0)) { RELAUNDER(); ph_inproj(F, L); SEAM(pb + 0); }
        if (IN(pb + 1)) { RELAUNDER(); PH_MIX1(F, L); SEAM(pb + 1); }
        if (IN(pb + 2)) { RELAUNDER(); PH_MIX2(F, L); SEAM(pb + 2); }
        if (IN(pb + 3)) { RELAUNDER(); PH_MIX3(F, L); SEAM(pb + 3); }
        if (IN(pb + 4)) { RELAUNDER(); ph_outproj(F, L); SEAM(pb + 4); }
        if (IN(pb + 5)) { RELAUNDER(); ph_up(F, L); SEAM(pb + 5); }
        if (IN(pb + 6)) { RELAUNDER(); ph_down(F, L); SEAM(pb + 6); }
    }
#undef IN
#undef SEAM
}

extern "C" void kernel_launch(void* const* d_in, const int* in_sizes, int n_in, void* d_out, int out_size, void* d_ws, size_t ws_size, hipStream_t stream) {
    static int grid = 0;
    if (grid == 0) {
        if (n_in != 17 || in_sizes[0] != M * D || out_size != M * D || ws_size < WS_END) { fprintf(stderr, "kernel_launch: unexpected shapes (n_in %d, in0 %d, out %d, ws %zu)\n", n_in, n_in > 0 ? in_sizes[0] : -1, out_size, ws_size); grid = -1; return; }
        int dev = 0, cus = 0, per_cu = 0;
        if (hipGetDevice(&dev) != hipSuccess || hipDeviceGetAttribute(&cus, hipDeviceAttributeMultiprocessorCount, dev) != hipSuccess) { grid = -1; return; }
        if (hipFuncSetAttribute((const void*)fwd, hipFuncAttributeMaxDynamicSharedMemorySize, LDS_BYTES) != hipSuccess) { fprintf(stderr, "kernel_launch: hipFuncSetAttribute failed\n"); grid = -1; return; }
#if !ONE_LAUNCH
        (void)hipFuncSetAttribute((const void*)k_mix1_naive, hipFuncAttributeMaxDynamicSharedMemorySize, LDS_BYTES);
        (void)hipFuncSetAttribute((const void*)k_mix2_naive, hipFuncAttributeMaxDynamicSharedMemorySize, LDS_BYTES);
        (void)hipFuncSetAttribute((const void*)k_mix3_naive, hipFuncAttributeMaxDynamicSharedMemorySize, LDS_BYTES);
#endif
        if (hipOccupancyMaxActiveBlocksPerMultiprocessor(&per_cu, (const void*)fwd, NTHREADS, LDS_BYTES) != hipSuccess || per_cu < 1) { fprintf(stderr, "kernel_launch: occupancy query says %d\n", per_cu); per_cu = 1; }
        (void)hipGetLastError();
        grid = cus;
    }
    if (grid < 0) return;
    (void)hipMemsetAsync((char*)d_ws + WS_CTL, 0, CTL_ZERO_BYTES, stream);
    Args a{};
    for (int i = 0; i < 17; ++i) a.in[i] = (const float*)d_in[i];
    a.out = (float*)d_out; a.ws = (unsigned char*)d_ws;
#if ONE_LAUNCH
    a.ph_lo = 0; a.ph_hi = NPH;
    void* kargs[] = {&a};
    hipError_t e = hipLaunchCooperativeKernel((const void*)fwd, dim3(grid), dim3(NTHREADS), kargs, LDS_BYTES, stream);
    if (e != hipSuccess) fprintf(stderr, "kernel_launch: cooperative launch failed: %s (grid %d)\n", hipGetErrorString(e), grid);
#else
    for (int ph = 0; ph < NPH; ++ph) {
        const int r = ph == 0 ? -1 : (ph - 1) % 7, L = ph == 0 ? 0 : (ph - 1) / 7;
        a.ph_lo = ph; a.ph_hi = ph + 1;
        if (r == 1) { a.ph_lo = L; hipLaunchKernelGGL(k_mix1_naive, dim3(grid), dim3(NTHREADS), LDS_BYTES, stream, a); }
        else if (r == 2) { a.ph_lo = L; hipLaunchKernelGGL(k_mix2_naive, dim3(grid), dim3(NTHREADS), LDS_BYTES, stream, a); }
        else if (r == 3) { a.ph_lo = L; hipLaunchKernelGGL(k_mix3_naive, dim3(grid), dim3(NTHREADS), LDS_BYTES, stream, a); }
        else hipLaunchKernelGGL(fwd, dim3(grid), dim3(NTHREADS), LDS_BYTES, stream, a);
    }
#endif
}
```

```cpp
#include <hip/hip_runtime.h>
#include <cstdio>
#include <cstdint>

#ifndef ONE_LAUNCH
#define ONE_LAUNCH 1
#endif

namespace pg8 {
#define PG8_LAS __attribute__((address_space(3)))
typedef unsigned short bf16_t;
typedef short bf16x8 __attribute__((ext_vector_type(8)));
typedef float f32x4 __attribute__((ext_vector_type(4)));
typedef unsigned u32x4 __attribute__((ext_vector_type(4)));
constexpr int BM = 256, BK = 64, HALF = 128, HTB = HALF * BK * 2  , STAGE_BYTES = 8 * HTB, NXCD = 8, WGM = 8;

__host__ __device__ __forceinline__ int lds_byte(int r, int c) { const int st = (r >> 4) * 2 + (c >> 5), rr = r & 15, cc = c & 31, ob = rr * 64 + cc * 2; return st * 1024 + (ob ^ (((ob >> 9) & 1) << 5)); }
__host__ __device__ __forceinline__ void stage_rc(int b, int& R, int& C) { const int st = b / 1024, sb = b % 1024, swz = sb ^ (((sb >> 9) & 1) << 5); R = (st >> 1) * 16 + swz / 64; C = (st & 1) * 32 + (swz % 64) / 2; }
__host__ __device__ __forceinline__ int perm32(int rho) { const int n = rho >> 4, i = rho & 15; return 8 * (i >> 2) + 4 * n + (i & 3); }

struct Unit { int pm, pn; };
struct Gemm { const bf16_t* A; const bf16_t* Bt; int M, N, K, lda; };

struct StaticOrder {
    int nM, nN, nwg, G, c;
    __host__ __device__ void init(int M, int N, int G_, int c_) { nM = M / BM; nN = N / BM; nwg = nM * nN; G = G_; c = c_; }
    __host__ __device__ bool next(int i, Unit& u) const {
        const long L = (long)i * G + c; if (L >= nwg) return false;
        int wgid = (int)L; { const int q = nwg / NXCD, r = nwg % NXCD, xcd = wgid % NXCD, off = wgid / NXCD; wgid = (xcd < r ? xcd * (q + 1) : r * (q + 1) + (xcd - r) * q) + off; }
        const int nig = WGM * nN, gid = wgid / nig, fm = gid * WGM, gsz = (nM - fm) < WGM ? (nM - fm) : WGM;
        u.pm = fm + ((wgid % nig) % gsz); u.pn = (wgid % nig) / gsz; return true;
    }
    __device__ __forceinline__ void a_ready(const Unit&) const {}
    __device__ __forceinline__ void done(const Unit&) const {}
};

__device__ __forceinline__ unsigned cvt_pk_bf16(float lo, float hi) { unsigned r; asm volatile("v_cvt_pk_bf16_f32 %0, %1, %2" : "=v"(r) : "v"(lo), "v"(hi)); return r; }

constexpr int PROJ_PITCH = 2304, DT_TILE = 9;
struct EpiProj {
    static constexpr bool PERM = true, AFTER_DRAIN = false;
    bf16_t* O; float* dtraw; const PG8_LAS float* rstd;
    __device__ __forceinline__ void operator()(const f32x4 (&acc)[2][2][4][2], const Unit& u, int ui, int wr, int wc, int fr, int fq) const {
        const int rt0 = wr * 64 + fr;
        if (u.pn == DT_TILE) {
            if (wc == 0 && fq == 0) {
#pragma unroll
                for (int ai = 0; ai < 2; ++ai)
#pragma unroll
                    for (int m = 0; m < 4; ++m) { const int rt = ai * HALF + rt0 + m * 16; const float rs = rstd[ui * BM + rt]; float* p = dtraw + (size_t)(u.pm * BM + rt) * 8;
                        *(f32x4*)p = acc[ai][0][m][0] * rs; *(f32x4*)(p + 4) = acc[ai][0][m][1] * rs; }
            }
            return;
        }
        const int col0 = u.pn * BM + wc * 32 + 8 * fq;
#pragma unroll
        for (int ai = 0; ai < 2; ++ai)
#pragma unroll
            for (int m = 0; m < 4; ++m) { const int rt = ai * HALF + rt0 + m * 16; const float rs = rstd[ui * BM + rt]; bf16_t* rowp = O + (size_t)(u.pm * BM + rt) * PROJ_PITCH + col0;
#pragma unroll
                for (int bj = 0; bj < 2; ++bj) { const f32x4 v0 = acc[ai][bj][m][0] * rs, v1 = acc[ai][bj][m][1] * rs;
                    u32x4 w; w.x = cvt_pk_bf16(v0[0], v0[1]); w.y = cvt_pk_bf16(v0[2], v0[3]); w.z = cvt_pk_bf16(v1[0], v1[1]); w.w = cvt_pk_bf16(v1[2], v1[3]);
                    *(u32x4*)(rowp + bj * HALF) = w; } }
    }
};
struct EpiUp {
    static constexpr bool PERM = true, AFTER_DRAIN = false;
    bf16_t* O; int ldc; const PG8_LAS float* rstd;
    __device__ __forceinline__ void operator()(const f32x4 (&acc)[2][2][4][2], const Unit& u, int ui, int wr, int wc, int fr, int fq) const {
        const int rt0 = wr * 64 + fr, col0 = u.pn * BM + wc * 32 + 8 * fq;
#pragma unroll
        for (int ai = 0; ai < 2; ++ai)
#pragma unroll
            for (int m = 0; m < 4; ++m) { const int rt = ai * HALF + rt0 + m * 16; const float rs = rstd[ui * BM + rt]; bf16_t* rowp = O + (size_t)(u.pm * BM + rt) * ldc + col0;
#pragma unroll
                for (int bj = 0; bj < 2; ++bj) { f32x4 v0 = acc[ai][bj][m][0] * rs, v1 = acc[ai][bj][m][1] * rs;
#pragma unroll
                    for (int e = 0; e < 4; ++e) { const float a = fmaxf(v0[e], 0.f), b = fmaxf(v1[e], 0.f); v0[e] = a * a; v1[e] = b * b; }
                    u32x4 w; w.x = cvt_pk_bf16(v0[0], v0[1]); w.y = cvt_pk_bf16(v0[2], v0[3]); w.z = cvt_pk_bf16(v1[0], v1[1]); w.w = cvt_pk_bf16(v1[2], v1[3]);
                    *(u32x4*)(rowp + bj * HALF) = w; } }
    }
};
struct EpiRes {
    static constexpr bool PERM = true, AFTER_DRAIN = false;
    const float* res; float* out; bf16_t* xb; float* ssq;
    __device__ __forceinline__ void operator()(const f32x4 (&acc)[2][2][4][2], const Unit& u, int ui, int wr, int wc, int fr, int fq) const {
        const int rt0 = wr * 64 + fr, col0 = u.pn * BM + wc * 32 + 8 * fq;
#pragma unroll
        for (int ai = 0; ai < 2; ++ai)
#pragma unroll
            for (int m = 0; m < 4; ++m) { const int row = u.pm * BM + ai * HALF + rt0 + m * 16; const size_t off = (size_t)row * 1024 + col0; float s = 0.f;
#pragma unroll
                for (int bj = 0; bj < 2; ++bj) { const f32x4 r0 = *(const f32x4*)(res + off + bj * HALF), r1 = *(const f32x4*)(res + off + bj * HALF + 4);
                    const f32x4 v0 = r0 + acc[ai][bj][m][0], v1 = r1 + acc[ai][bj][m][1];
                    *(f32x4*)(out + off + bj * HALF) = v0; *(f32x4*)(out + off + bj * HALF + 4) = v1;
                    u32x4 w; w.x = cvt_pk_bf16(v0[0], v0[1]); w.y = cvt_pk_bf16(v0[2], v0[3]); w.z = cvt_pk_bf16(v1[0], v1[1]); w.w = cvt_pk_bf16(v1[2], v1[3]);
                    *(u32x4*)(xb + off + bj * HALF) = w;
                    s += (v0[0] * v0[0] + v0[1] * v0[1]) + (v0[2] * v0[2] + v0[3] * v0[3]) + (v1[0] * v1[0] + v1[1] * v1[1]) + (v1[2] * v1[2] + v1[3] * v1[3]); }
                s += __shfl_xor(s, 16); s += __shfl_xor(s, 32);
                if (fq == 0) ssq[(size_t)row * 16 + u.pn * 4 + wc] = s;
                if (m & 1) asm volatile("" ::: "memory"); }
    }
};

template <class Epi, class Sched, bool ALIGN_EPI = false, bool SP2 = false>
__device__ __forceinline__ void gemm_phase(PG8_LAS unsigned char* lds, const Gemm g, const Sched& S, const Epi& E) {
    int tid_ = threadIdx.x; asm volatile("" : "+v"(tid_));
    const int tid = tid_, wid = __builtin_amdgcn_readfirstlane(tid >> 6), lane = tid & 63, wr = wid >> 2, wc = wid & 3, fr = lane & 15, fq = lane >> 4;
    const int K = g.K, nt = K / BK;
    unsigned voffA[2], voffB[2];
#pragma unroll
    for (int i = 0; i < 2; ++i) { int R, C; stage_rc(tid * 16 + i * 8192, R, C); const int Rb = Epi::PERM ? ((R & ~31) + perm32(R & 31)) : R;
        voffA[i] = (unsigned)(R * g.lda + C) * 2u; voffB[i] = (unsigned)(Rb * K + C) * 2u; }
    const size_t kstep = (size_t)(BK * 2);
    const size_t hstepA = (size_t)HALF * g.lda * 2, hstepB = (size_t)HALF * K * 2;
    const size_t tstepA = 2 * hstepA, tstepB = 2 * hstepB;
    const unsigned ldsw = (unsigned)wid * 1024u;
    const int aoff = lds_byte(wr * 64 + fr, fq * 8), boff = lds_byte(wc * 32 + fr, fq * 8);
#define PG8_SA(b, h) (((b) * 2 + (h)) * HTB)
#define PG8_SB(b, h) ((4 + (b) * 2 + (h)) * HTB)
#define PG8_STAGE(bufoff, gbase, voff) do { _Pragma("unroll") for (int _i = 0; _i < 2; ++_i) \
        __builtin_amdgcn_global_load_lds((const unsigned*)((const char*)(gbase) + (voff)[_i]), (PG8_LAS unsigned*)(lds + (bufoff) + ldsw + _i * 8192), 16, 0, 0); } while (0)
#define PG8_LDA(dst, b, h) do { _Pragma("unroll") for (int m = 0; m < 4; ++m) _Pragma("unroll") for (int k = 0; k < 2; ++k) dst[m][k] = *(const PG8_LAS bf16x8*)(lds + PG8_SA(b, h) + aoff + m * 2048 + k * 1024); } while (0)
#define PG8_LDB(dst, b, h) do { _Pragma("unroll") for (int n = 0; n < 2; ++n) _Pragma("unroll") for (int k = 0; k < 2; ++k) dst[n][k] = *(const PG8_LAS bf16x8*)(lds + PG8_SB(b, h) + boff + n * 2048 + k * 1024); } while (0)
#define PG8_MMA(ai, bj, At, Bt) do { __builtin_amdgcn_s_setprio(1); _Pragma("unroll") for (int m = 0; m < 4; ++m) _Pragma("unroll") for (int n = 0; n < 2; ++n) _Pragma("unroll") for (int k = 0; k < 2; ++k) \
        acc[ai][bj][m][n] = __builtin_amdgcn_mfma_f32_16x16x32_bf16(Bt[n][k], At[m][k], acc[ai][bj][m][n], 0, 0, 0); __builtin_amdgcn_s_setprio(0); } while (0)
#define PG8_WAIT_V(n) asm volatile("s_waitcnt vmcnt(" #n ")" ::: "memory")
#define PG8_WAIT_L(n) asm volatile("s_waitcnt lgkmcnt(" #n ")" ::: "memory")
#define PG8_BAR __builtin_amdgcn_s_barrier()
#define PG8_SCHED __builtin_amdgcn_sched_barrier(0)
    Unit cur, nxt; int ui = 0;
    if (!S.next(0, cur)) return;
    f32x4 acc[2][2][4][2];
#pragma unroll
    for (int a = 0; a < 2; ++a)
#pragma unroll
        for (int b = 0; b < 2; ++b)
#pragma unroll
            for (int m = 0; m < 4; ++m)
#pragma unroll
                for (int n = 0; n < 2; ++n) acc[a][b][m][n] = (f32x4){0.f, 0.f, 0.f, 0.f};
    bf16x8 At[4][2], B0[2][2], B1[2][2];
    const char* cA = (const char*)g.A + (size_t)cur.pm * tstepA; const char* cB = (const char*)g.Bt + (size_t)cur.pn * tstepB;
    S.a_ready(cur);
    if constexpr (SP2) {
        PG8_STAGE(PG8_SB(0, 0), cB, voffB); PG8_STAGE(PG8_SB(0, 1), cB + hstepB, voffB); PG8_STAGE(PG8_SA(0, 0), cA, voffA); PG8_STAGE(PG8_SA(0, 1), cA + hstepA, voffA);
        if (wr == 1) PG8_BAR;
        PG8_WAIT_V(2); PG8_BAR;
        PG8_STAGE(PG8_SB(1, 0), cB + kstep, voffB); PG8_STAGE(PG8_SA(1, 0), cA + kstep, voffA); PG8_STAGE(PG8_SB(1, 1), cB + hstepB + kstep, voffB);
        PG8_WAIT_V(6); PG8_BAR;
    } else {
        PG8_STAGE(PG8_SB(0, 0), cB, voffB); PG8_STAGE(PG8_SA(0, 0), cA, voffA); PG8_STAGE(PG8_SB(0, 1), cB + hstepB, voffB); PG8_STAGE(PG8_SA(0, 1), cA + hstepA, voffA);
        if (wr == 1) PG8_BAR;
        PG8_WAIT_V(4); PG8_BAR;
        PG8_STAGE(PG8_SB(1, 0), cB + kstep, voffB); PG8_STAGE(PG8_SA(1, 0), cA + kstep, voffA); PG8_STAGE(PG8_SB(1, 1), cB + hstepB + kstep, voffB);
        PG8_WAIT_V(6); PG8_BAR;
    }
    for (;;) {
        const bool has_next = S.next(ui + 1, nxt);
        const char* nA = has_next ? (const char*)g.A + (size_t)nxt.pm * tstepA : cA; const char* nB = has_next ? (const char*)g.Bt + (size_t)nxt.pn * tstepB : cB;
        for (int t = 0; t < nt; t += 2) {
            const bool last = (t == nt - 2);
            const char* a1 = cA + (size_t)(t + 1) * kstep;
            const char* a2 = last ? nA : cA + (size_t)(t + 2) * kstep; const char* b2 = last ? nB : cB + (size_t)(t + 2) * kstep;
            const char* a3 = a2 + kstep; const char* b3 = b2 + kstep;
            if (last && has_next) S.a_ready(nxt);
            if constexpr (SP2) {
            PG8_LDB(B0, 0, 0); PG8_LDB(B1, 0, 1); PG8_SCHED; PG8_LDA(At, 0, 0); PG8_STAGE(PG8_SA(1, 1), a1 + hstepA, voffA);
            PG8_WAIT_V(8); PG8_WAIT_L(0); PG8_BAR; PG8_MMA(0, 0, At, B0); PG8_MMA(0, 1, At, B1); PG8_BAR; PG8_SCHED;
            PG8_LDA(At, 0, 1); PG8_STAGE(PG8_SB(0, 0), b2, voffB); PG8_STAGE(PG8_SB(0, 1), b2 + hstepB, voffB); PG8_STAGE(PG8_SA(0, 0), a2, voffA);
            PG8_WAIT_V(8); PG8_WAIT_L(0); PG8_BAR; PG8_MMA(1, 0, At, B0); PG8_MMA(1, 1, At, B1); PG8_BAR; PG8_SCHED;
            PG8_LDB(B0, 1, 0); PG8_LDB(B1, 1, 1); PG8_SCHED; PG8_LDA(At, 1, 0); PG8_STAGE(PG8_SA(0, 1), a2 + hstepA, voffA);
            PG8_WAIT_V(8); PG8_WAIT_L(0); PG8_BAR; PG8_MMA(0, 0, At, B0); PG8_MMA(0, 1, At, B1); PG8_BAR; PG8_SCHED;
            PG8_LDA(At, 1, 1); PG8_STAGE(PG8_SB(1, 0), b3, voffB); PG8_STAGE(PG8_SB(1, 1), b3 + hstepB, voffB); PG8_STAGE(PG8_SA(1, 0), a3, voffA);
            PG8_WAIT_V(8); PG8_WAIT_L(0); PG8_BAR; PG8_MMA(1, 0, At, B0); PG8_MMA(1, 1, At, B1); PG8_BAR; PG8_SCHED;
            } else {
            PG8_LDB(B0, 0, 0); PG8_SCHED; PG8_LDA(At, 0, 0); PG8_STAGE(PG8_SA(1, 1), a1 + hstepA, voffA);
            PG8_WAIT_L(8); PG8_BAR; PG8_WAIT_L(0); PG8_MMA(0, 0, At, B0); PG8_BAR; PG8_SCHED;
            PG8_LDB(B1, 0, 1); PG8_STAGE(PG8_SB(0, 0), b2, voffB);
            PG8_BAR; PG8_WAIT_L(0); PG8_MMA(0, 1, At, B1); PG8_BAR;
            PG8_LDA(At, 0, 1); PG8_STAGE(PG8_SA(0, 0), a2, voffA);
            PG8_BAR; PG8_WAIT_L(0); PG8_MMA(1, 0, At, B0); PG8_BAR; PG8_SCHED;
            PG8_STAGE(PG8_SB(0, 1), b2 + hstepB, voffB);
            PG8_WAIT_V(6); PG8_BAR; PG8_MMA(1, 1, At, B1); PG8_BAR;
            PG8_LDB(B0, 1, 0); PG8_SCHED; PG8_LDA(At, 1, 0); PG8_STAGE(PG8_SA(0, 1), a2 + hstepA, voffA);
            PG8_WAIT_L(8); PG8_BAR; PG8_WAIT_L(0); PG8_MMA(0, 0, At, B0); PG8_BAR; PG8_SCHED;
            PG8_LDB(B1, 1, 1); PG8_STAGE(PG8_SB(1, 0), b3, voffB);
            PG8_BAR; PG8_WAIT_L(0); PG8_MMA(0, 1, At, B1); PG8_BAR;
            PG8_LDA(At, 1, 1); PG8_STAGE(PG8_SA(1, 0), a3, voffA);
            PG8_BAR; PG8_WAIT_L(0); PG8_MMA(1, 0, At, B0); PG8_BAR; PG8_SCHED;
            PG8_STAGE(PG8_SB(1, 1), b3 + hstepB, voffB);
            PG8_WAIT_V(6); PG8_BAR; PG8_MMA(1, 1, At, B1); PG8_BAR;
            }
        }
        if constexpr (ALIGN_EPI) { if (wr == 0) PG8_BAR; }
        if constexpr (!Epi::AFTER_DRAIN) { E(acc, cur, ui, wr, wc, fr, fq); S.done(cur); }
        if (!has_next) break;
#pragma unroll
        for (int a = 0; a < 2; ++a)
#pragma unroll
            for (int b = 0; b < 2; ++b)
#pragma unroll
                for (int m = 0; m < 4; ++m)
#pragma unroll
                    for (int n = 0; n < 2; ++n) acc[a][b][m][n] = (f32x4){0.f, 0.f, 0.f, 0.f};
        cur = nxt; cA = nA; cB = nB; ++ui;
        if constexpr (ALIGN_EPI) { if (wr == 1) PG8_BAR; }
    }
    PG8_WAIT_V(0);
    if constexpr (!ALIGN_EPI) { if (wr == 0) PG8_BAR; }
    PG8_BAR;

#undef PG8_SA
#undef PG8_SB
#undef PG8_STAGE
#undef PG8_LDA
#undef PG8_LDB
#undef PG8_MMA
#undef PG8_WAIT_V
#undef PG8_WAIT_L
#undef PG8_BAR
#undef PG8_SCHED
}
}

constexpr int NWAVES = 8, NTHREADS = NWAVES * 64;
constexpr int BATCH = 8, SEQ = 2048, D = 1024, M = BATCH * SEQ, FF = 4096, DEPTH = 2;
constexpr int D_IN = 2312, NPROJ = 2560, PP = pg8::PROJ_PITCH;
constexpr int CQ = 0, CZ = 512, CK = 1024, CV = 1152, CX = 1280, CBM = 1792, CCM = 2048;
constexpr float EPS = 1e-6f;
constexpr int NPH = 1 + 7 * DEPTH;

constexpr size_t MiB = 1u << 20;
constexpr size_t WS_CTL = 0, CTL_ZERO_BYTES = 1 * MiB;
constexpr size_t WS_SSQ = 1 * MiB;
constexpr size_t WS_DTRAW = 2 * MiB;
constexpr size_t WS_WIN = 4 * MiB, WS_WOUT = 14 * MiB, WS_WUP = 18 * MiB, WS_WDOWN = 34 * MiB;
constexpr size_t WS_XB = 50 * MiB;
constexpr size_t WS_PROJ = 82 * MiB;
constexpr size_t WS_XBCF = 154 * MiB;
constexpr size_t WS_YN = 218 * MiB;
constexpr size_t WS_HID = 82 * MiB;
constexpr size_t WS_END = 256 * MiB;
constexpr int CW_BAR = 4096;

constexpr int RING_OFF = 0, RING_BYTES = 131072;
constexpr int LDSCTL_OFF = RING_BYTES, MISC_OFF = LDSCTL_OFF + 320, RSTD_OFF = LDSCTL_OFF + 512, PTR_OFF = RSTD_OFF + 4096;
constexpr int LDS_BYTES = 147456;
static_assert(PTR_OFF + 512 <= LDS_BYTES, "LDS map");

#define GAS __attribute__((address_space(1)))
#define LAS __attribute__((address_space(3)))
typedef unsigned short bf16;
typedef unsigned v4u __attribute__((ext_vector_type(4)));
typedef unsigned v2u __attribute__((ext_vector_type(2)));
typedef float f32x4 __attribute__((ext_vector_type(4)));
typedef GAS unsigned gu32;
#define RLX_AGENT __ATOMIC_RELAXED, __HIP_MEMORY_SCOPE_AGENT
#define LDS_WAIT() asm volatile("s_waitcnt lgkmcnt(0)" ::: "memory")
#define VM_WAIT() asm volatile("s_waitcnt vmcnt(0)" ::: "memory")
__device__ __forceinline__ unsigned f2bf(float f) { unsigned u = __builtin_bit_cast(unsigned, f); return (u + 0x7fffu + ((u >> 16) & 1u)) >> 16; }
__device__ __forceinline__ unsigned pk2(float lo, float hi) { return f2bf(lo) | (f2bf(hi) << 16); }
__device__ __forceinline__ float bflo(unsigned w) { return __uint_as_float(w << 16); }
__device__ __forceinline__ float bfhi(unsigned w) { return __uint_as_float(w & 0xffff0000u); }
__device__ __forceinline__ float silu_f(float v) { return v / (1.f + expf(-v)); }
__device__ __forceinline__ float softplus_f(float v) { return fmaxf(v, 0.f) + log1pf(expf(-fabsf(v))); }

#define XB_TMO      128
#define XB_XCNT(j)  (256  + 64 * (j))
#define XB_XSUB(j)  (1280 + 64 * (j))
#define XB_XGEN(j)  (2304 + 64 * (j))
#define XB_TOP      3328
#define XB_TOPGEN   3392
#define XCD_BAR_WORDS 3456
#define XB_SPIN_CAP (1u << 22)
__device__ __forceinline__ unsigned xb_ld(unsigned* p)              { return __hip_atomic_load(p, __ATOMIC_RELAXED, __HIP_MEMORY_SCOPE_AGENT); }
__device__ __forceinline__ unsigned xb_add(unsigned* p, unsigned v) { return __hip_atomic_fetch_add(p, v, __ATOMIC_RELAXED, __HIP_MEMORY_SCOPE_AGENT); }
__device__ __forceinline__ unsigned xb_xcc_id() { return (unsigned)__builtin_amdgcn_s_getreg((3 << 11) | 20) & 0xFu; }
#define XB_SPIN(cond, bar) do { unsigned _sp = 0; while (cond) { __builtin_amdgcn_s_sleep(1); \
    if ((++_sp & 255u) == 0u) { if (xb_ld(&(bar)[XB_TMO])) break; if (_sp > XB_SPIN_CAP) { atomicAdd(&(bar)[XB_TMO], 1u); break; } } } } while (0)
struct XcdBarrier { unsigned* bar; unsigned x; volatile LAS unsigned* st; };
__device__ __forceinline__ XcdBarrier xcd_barrier_post(unsigned* bar, volatile LAS unsigned* st) {
    XcdBarrier b; b.bar = bar; b.x = xb_xcc_id(); b.st = st;
    if (threadIdx.x == 0) (void)xb_add(&bar[XB_XCNT(b.x)], 1u);
    return b;
}
__device__ __forceinline__ void xcd_barrier_complete(unsigned* bar, unsigned x, unsigned& nloc, unsigned& nx) {
    const unsigned G = gridDim.x * gridDim.y * gridDim.z;
    unsigned sum, cnt, mine, sp = 0u;
    for (;;) {
        sum = 0u; cnt = 0u; mine = 0u;
#pragma unroll
        for (unsigned j = 0; j < 16; ++j) { const unsigned c = xb_ld(&bar[XB_XCNT(j)]); sum += c; cnt += (c > 0u) ? 1u : 0u; mine = (j == x) ? c : mine; }
        if (sum == G) break;
        __builtin_amdgcn_s_sleep(1);
        if ((++sp & 255u) == 0u) { if (xb_ld(&bar[XB_TMO])) break; if (sp > XB_SPIN_CAP) { atomicAdd(&bar[XB_TMO], 1u); break; } }
    }
    nloc = mine > 0u ? mine : 1u; nx = cnt > 0u ? cnt : 1u;
}
__device__ __forceinline__ void xcd_barrier(const XcdBarrier& b) {
    asm volatile("s_waitcnt vmcnt(0)" ::: "memory");
    __syncthreads();
    if (threadIdx.x == 0) {
        unsigned* bar = b.bar;
        __builtin_amdgcn_s_waitcnt(0);
        unsigned nloc = b.st[0], nx = b.st[1];
        if (nloc == 0u) { xcd_barrier_complete(bar, b.x, nloc, nx); b.st[0] = nloc; b.st[1] = nx; }
        const unsigned old = xb_add(&bar[XB_XSUB(b.x)], 1u);
        const unsigned gen = old / nloc;
        if (old + 1u == (gen + 1u) * nloc) {
            __builtin_amdgcn_fence(__ATOMIC_RELEASE, "agent");
            asm volatile("s_waitcnt vmcnt(0)" ::: "memory");
            const unsigned og = xb_add(&bar[XB_TOP], 1u);
            const unsigned tg = og / nx;
            if (og + 1u == (tg + 1u) * nx) xb_add(&bar[XB_TOPGEN], 1u);
            else XB_SPIN(xb_ld(&bar[XB_TOPGEN]) == tg, bar);
            __builtin_amdgcn_fence(__ATOMIC_ACQUIRE, "agent");
            xb_add(&bar[XB_XGEN(b.x)], 1u);
            asm volatile("s_waitcnt vmcnt(0)" ::: "memory");
        } else {
            XB_SPIN(xb_ld(&bar[XB_XGEN(b.x)]) == gen, bar);
            __builtin_amdgcn_fence(__ATOMIC_ACQUIRE, "agent");
            asm volatile("s_waitcnt vmcnt(0)" ::: "memory");
        }
    }
    __syncthreads();
}

struct Frame {
    LAS unsigned char* lds;
    int tid, lane, wave, bid, G;
};
enum { I_X = 0, I_MIXG, I_WIN, I_QG, I_KG, I_SINK, I_RELB, I_CONVW, I_CONVB, I_DTB, I_ALOG, I_DSKIP, I_SSMG, I_WOUT, I_MLPG, I_WUP, I_WDOWN, I_OUT, I_WS, I_NPTR };
__device__ __forceinline__ unsigned char* ptr_at(const Frame& F, int i) {
    const LAS unsigned* t = (const LAS unsigned*)(F.lds + PTR_OFF) + 2 * i;
    const unsigned lo = __builtin_amdgcn_readfirstlane(t[0]), hi = __builtin_amdgcn_readfirstlane(t[1]);
    return (unsigned char*)(((unsigned long long)hi << 32) | lo);
}
#define FIN(i) ((const float*)ptr_at(F, (i)))
#define FWS(off) (ptr_at(F, I_WS) + (off))
__device__ __forceinline__ float wave_sum(float v) {
#pragma unroll
    for (int o = 1; o < 64; o <<= 1) v += __shfl_xor(v, o);
    return v;
}

__device__ __forceinline__ void tr_item(const float* W, int Nsrc, int nsrc0, int nvalid, int K, const float* gain, bf16* WT, int ndst0, int k0, LAS float* scr, int lane) {
    const int n = lane & 31;
#pragma unroll 8
    for (int i = 0; i < 32; ++i) { const int kk = 2 * i + (lane >> 5); float v = 0.f;
        if (n < nvalid) { v = W[(size_t)(k0 + kk) * Nsrc + nsrc0 + n]; if (gain) v *= gain[k0 + kk]; }
        scr[kk * 33 + n] = v; }
    LDS_WAIT(); asm volatile("" ::: "memory");
    const int c = lane & 7;
#pragma unroll
    for (int j = 0; j < 4; ++j) { const int nn = (lane >> 3) + 8 * j; const LAS float* s = scr + (8 * c) * 33 + nn;
        v4u o; o.x = pk2(s[0 * 33], s[1 * 33]); o.y = pk2(s[2 * 33], s[3 * 33]); o.z = pk2(s[4 * 33], s[5 * 33]); o.w = pk2(s[6 * 33], s[7 * 33]);
        *(GAS v4u*)(WT + (size_t)(ndst0 + nn) * K + k0 + 8 * c) = o; }
    LDS_WAIT(); asm volatile("" ::: "memory");
}
__device__ __forceinline__ void p0_prologue(Frame& F) {
    LAS float* scr = (LAS float*)(F.lds + RING_OFF + F.wave * 16384);
    const int gw = F.bid * NWAVES + F.wave, NGW = F.G * NWAVES;
    constexpr int I_IN = 16 * 80, I_OUT = 16 * 32, I_UP = 16 * 128, I_DN = 64 * 32, I_L = I_IN + I_OUT + I_UP + I_DN;
    {
    const float *w_in = FIN(I_WIN), *mix_g = FIN(I_MIXG), *w_out = FIN(I_WOUT), *w_up = FIN(I_WUP), *mlp_g = FIN(I_MLPG), *w_down = FIN(I_WDOWN);
    bf16 *WIN = (bf16*)FWS(WS_WIN), *WOUT = (bf16*)FWS(WS_WOUT), *WUP = (bf16*)FWS(WS_WUP), *WDOWN = (bf16*)FWS(WS_WDOWN);
    for (int it = gw; it < DEPTH * I_L; it += NGW) {
        const int L = it / I_L; int r = it % I_L;
        if (r < I_IN) {
            const int kb = r / 80, nb = r % 80; int src, nv = 32;
            if (nb < 16) src = nb * 32; else if (nb < 32) src = 768 + (nb - 16) * 32; else if (nb < 36) src = 512 + (nb - 32) * 32; else if (nb < 40) src = 640 + (nb - 36) * 32;
            else if (nb < 72) src = nb * 32; else if (nb == 72) { src = 2304; nv = 8; } else { src = 0; nv = 0; }
            tr_item(w_in + (size_t)L * D * D_IN, D_IN, src, nv, D, mix_g + L * D, WIN + (size_t)L * NPROJ * D, nb * 32, kb * 64, scr, F.lane); continue; }
        r -= I_IN;
        if (r < I_OUT) { const int kb = r / 32, nb = r % 32; tr_item(w_out + (size_t)L * D * D, D, nb * 32, 32, D, nullptr, WOUT + (size_t)L * D * D, nb * 32, kb * 64, scr, F.lane); continue; }
        r -= I_OUT;
        if (r < I_UP) { const int kb = r / 128, nb = r % 128; tr_item(w_up + (size_t)L * D * FF, FF, nb * 32, 32, D, mlp_g + L * D, WUP + (size_t)L * FF * D, nb * 32, kb * 64, scr, F.lane); continue; }
        r -= I_UP;
        { const int kb = r / 32, nb = r % 32; tr_item(w_down + (size_t)L * FF * D, D, nb * 32, 32, FF, nullptr, WDOWN + (size_t)L * D * FF, nb * 32, kb * 64, scr, F.lane); }
    }
    }
    const float* x = FIN(I_X); bf16* XB = (bf16*)FWS(WS_XB); float* SSQ = (float*)FWS(WS_SSQ);
    for (int m = gw; m < M; m += NGW) {
        const GAS f32x4* xr = (const GAS f32x4*)(x + (size_t)m * D) + F.lane;
        f32x4 v[4]; float s = 0.f;
#pragma unroll
        for (int j = 0; j < 4; ++j) { v[j] = xr[64 * j]; s += (v[j].x * v[j].x + v[j].y * v[j].y) + (v[j].z * v[j].z + v[j].w * v[j].w); }
        s = wave_sum(s);
        GAS v2u* o8 = (GAS v2u*)(XB + (size_t)m * D) + F.lane;
#pragma unroll
        for (int j = 0; j < 4; ++j) { v2u o; o.x = pk2(v[j].x, v[j].y); o.y = pk2(v[j].z, v[j].w); o8[64 * j] = o; }
        if (F.lane < 16) SSQ[(size_t)m * 16 + F.lane] = (F.lane == 0) ? s : 0.f;
    }
}
__device__ __forceinline__ void rstd_prepass(Frame& F, const pg8::StaticOrder& S, LAS float* tab) {
    const float* SSQ = (const float*)FWS(WS_SSQ);
    pg8::Unit u;
    for (int i = 0; i < 4 && S.next(i, u); ++i) {
        const int r = F.tid >> 1, h = F.tid & 1;
        const f32x4* p = (const f32x4*)(SSQ + (size_t)(u.pm * 256 + r) * 16 + h * 8);
        const f32x4 a = p[0], b = p[1];
        float s = (a.x + a.y) + (a.z + a.w) + (b.x + b.y) + (b.z + b.w);
        s += __shfl_xor(s, 1);
        if (h == 0) tab[i * 256 + r] = 1.0f / sqrtf(s * (1.0f / D) + EPS);
    }
    LDS_WAIT(); __syncthreads();
}

__device__ __forceinline__ int t5_bucket(int d) {
    if (d < 16) return d;
    return 16 + (d >= 19) + (d >= 21) + (d >= 24) + (d >= 27) + (d >= 31) + (d >= 35) + (d >= 40) + (d >= 46) + (d >= 52) + (d >= 59) + (d >= 67) + (d >= 77) + (d >= 87) + (d >= 99) + (d >= 113);
}
__device__ __forceinline__ void ld8(const bf16* p, float (&v)[8]) {
    const v4u w = *(const v4u*)p;
    v[0] = bflo(w.x); v[1] = bfhi(w.x); v[2] = bflo(w.y); v[3] = bfhi(w.y); v[4] = bflo(w.z); v[5] = bfhi(w.z); v[6] = bflo(w.w); v[7] = bfhi(w.w);
}
__device__ __forceinline__ void attn_naive(Frame& F, int L) {
    const float* qg = FIN(I_QG) + L * 64; const float* kg = FIN(I_KG) + L * 64; const float* sinks = FIN(I_SINK); const float* rel_bias = FIN(I_RELB);
    bf16* PROJ = (bf16*)FWS(WS_PROJ);
    for (int it = F.bid * NTHREADS + F.tid; it < M * 8; it += F.G * NTHREADS) {
        const int m = it >> 3, hq = it & 7, hkv = hq >> 2, t = m & (SEQ - 1);
        bf16* qp = PROJ + (size_t)m * PP + CQ + hq * 64;
        float q[64]; float ss = 0.f;
#pragma unroll
        for (int c = 0; c < 8; ++c) { float v[8]; ld8(qp + 8 * c, v);
#pragma unroll
            for (int e = 0; e < 8; ++e) { q[8 * c + e] = v[e]; ss += v[e] * v[e]; } }
        const float rq = 1.0f / sqrtf(ss * (1.0f / 64.0f) + EPS);
#pragma unroll
        for (int d = 0; d < 64; ++d) q[d] = q[d] * rq * qg[d] * 0.125f * kg[d];
        const float sink = sinks[L * 8 + hq];
        float mrun = sink, l = 1.f; float acc[64];
#pragma unroll
        for (int d = 0; d < 64; ++d) acc[d] = 0.f;
        const int j0 = t - 127 > 0 ? t - 127 : 0;
        for (int j = j0; j <= t; ++j) {
            const bf16* kp = PROJ + (size_t)(m - t + j) * PP + CK + hkv * 64;
            float dot = 0.f, sk = 0.f;
#pragma unroll
            for (int c = 0; c < 8; ++c) { float v[8]; ld8(kp + 8 * c, v);
#pragma unroll
                for (int e = 0; e < 8; ++e) { dot += q[8 * c + e] * v[e]; sk += v[e] * v[e]; } }
            const float s = dot / sqrtf(sk * (1.0f / 64.0f) + EPS) + rel_bias[t5_bucket(t - j) * 8 + hq];
            const float mn = fmaxf(mrun, s), a = expf(mrun - mn), p = expf(s - mn);
            l = l * a + p; mrun = mn;
            const bf16* vp = kp + (CV - CK);
#pragma unroll
            for (int c = 0; c < 8; ++c) { float v[8]; ld8(vp + 8 * c, v);
#pragma unroll
                for (int e = 0; e < 8; ++e) acc[8 * c + e] = acc[8 * c + e] * a + p * v[e]; }
        }
        const float inv = 1.0f / l;
#pragma unroll
        for (int c = 0; c < 8; ++c) { v4u o; o.x = pk2(acc[8 * c] * inv, acc[8 * c + 1] * inv); o.y = pk2(acc[8 * c + 2] * inv, acc[8 * c + 3] * inv);
            o.z = pk2(acc[8 * c + 4] * inv, acc[8 * c + 5] * inv); o.w = pk2(acc[8 * c + 6] * inv, acc[8 * c + 7] * inv); *(v4u*)(qp + 8 * c) = o; }
    }
}
__device__ __forceinline__ void conv_naive(Frame& F, int L) {
    const float* conv_w = FIN(I_CONVW); const float* conv_b = FIN(I_CONVB); const bf16* PROJ = (const bf16*)FWS(WS_PROJ); float* XBCF = (float*)FWS(WS_XBCF);
    for (int it = F.bid * NTHREADS + F.tid; it < M * 128; it += F.G * NTHREADS) {
        const int m = it >> 7, c0 = (it & 127) * 8, t = m & (SEQ - 1);
        float o[8];
#pragma unroll
        for (int e = 0; e < 8; ++e) o[e] = conv_b[L * 1024 + c0 + e];
#pragma unroll
        for (int k = 0; k < 4; ++k) { if (t - 3 + k >= 0) { float v[8]; ld8(PROJ + (size_t)(m - 3 + k) * PP + CX + c0, v);
#pragma unroll
                for (int e = 0; e < 8; ++e) o[e] += conv_w[(size_t)(L * 4 + k) * 1024 + c0 + e] * v[e]; } }
        f32x4 a, b; a.x = silu_f(o[0]); a.y = silu_f(o[1]); a.z = silu_f(o[2]); a.w = silu_f(o[3]); b.x = silu_f(o[4]); b.y = silu_f(o[5]); b.z = silu_f(o[6]); b.w = silu_f(o[7]);
        *(f32x4*)(XBCF + (size_t)m * 1024 + c0) = a; *(f32x4*)(XBCF + (size_t)m * 1024 + c0 + 4) = b;
    }
}
__device__ __forceinline__ void ssd_naive(Frame& F, int L) {
    if (F.wave != 0 || F.bid >= 64) return;
    const int b = F.bid >> 3, hh = F.bid & 7, g = hh >> 2, p = F.lane;
    const float a = -expf(FIN(I_ALOG)[L * 8 + hh]), dtb = FIN(I_DTB)[L * 8 + hh], dsk = FIN(I_DSKIP)[L * 8 + hh];
    const float* DTRAW = (const float*)FWS(WS_DTRAW); const float* XBCF = (const float*)FWS(WS_XBCF); float* YN = (float*)FWS(WS_YN);
    float st[128];
#pragma unroll
    for (int n = 0; n < 128; ++n) st[n] = 0.f;
    for (int t = 0; t < SEQ; ++t) {
        const size_t m = (size_t)b * SEQ + t;
        const float dtv = softplus_f(DTRAW[m * 8 + hh] + dtb), dA = expf(dtv * a), xv = XBCF[m * 1024 + hh * 64 + p], xd = xv * dtv;
        const GAS f32x4* Bp = (const GAS f32x4*)(XBCF + m * 1024 + 512 + g * 128); const GAS f32x4* Cp = (const GAS f32x4*)(XBCF + m * 1024 + 768 + g * 128);
        float y = 0.f;
#pragma unroll
        for (int n4 = 0; n4 < 32; ++n4) { const f32x4 bv = Bp[n4], cv = Cp[n4];
#pragma unroll
            for (int e = 0; e < 4; ++e) { st[4 * n4 + e] = st[4 * n4 + e] * dA + xd * bv[e]; y += cv[e] * st[4 * n4 + e]; } }
        YN[m * 512 + hh * 64 + p] = y + dsk * xv;
    }
}
__device__ __forceinline__ void gate_naive(Frame& F, int L) {
    const int gw = F.bid * NWAVES + F.wave, NGW = F.G * NWAVES;
    const float* ssm_g = FIN(I_SSMG); bf16* PROJ = (bf16*)FWS(WS_PROJ); const float* YN = (const float*)FWS(WS_YN);
    for (int it = gw; it < M * 2; it += NGW) {
        const int m = it >> 1, g = it & 1, ch = g * 256 + 4 * F.lane;
        const f32x4 y = *(const f32x4*)(YN + (size_t)m * 512 + ch);
        bf16* zp = PROJ + (size_t)m * PP + CZ + ch;
        const v2u zw = *(const v2u*)zp;
        float v[4]; v[0] = y.x * silu_f(bflo(zw.x)); v[1] = y.y * silu_f(bfhi(zw.x)); v[2] = y.z * silu_f(bflo(zw.y)); v[3] = y.w * silu_f(bfhi(zw.y));
        const float ss = wave_sum((v[0] * v[0] + v[1] * v[1]) + (v[2] * v[2] + v[3] * v[3]));
        const float r = 1.0f / sqrtf(ss * (1.0f / 256.0f) + EPS);
        const float* ng = ssm_g + L * 512 + ch;
        v2u o; o.x = pk2(v[0] * r * ng[0], v[1] * r * ng[1]); o.y = pk2(v[2] * r * ng[2], v[3] * r * ng[3]);
        *(v2u*)zp = o;
    }
}

typedef short bf16x8_t __attribute__((ext_vector_type(8)));
typedef float f32x16 __attribute__((ext_vector_type(16)));
constexpr float LOG2E = 1.4426950408889634f;
constexpr int AT_KS = 0, AT_KSTRIDE = 144, AT_VT = 36864, AT_VSTRIDE = 520, AT_BIAS = AT_VT + 64 * AT_VSTRIDE, AT_END = AT_BIAS + 2048;
static_assert(AT_END <= RING_BYTES, "attention LDS");
__device__ __forceinline__ unsigned pkbf(float lo, float hi) { return pg8::cvt_pk_bf16(lo, hi); }
__device__ __forceinline__ void attn_fast(Frame& F, int L) {
    bf16* PROJ = (bf16*)FWS(WS_PROJ);
    const float* qg = FIN(I_QG) + L * 64; const float* kg = FIN(I_KG) + L * 64; const float* sinks = FIN(I_SINK) + L * 8; const float* rel_bias = FIN(I_RELB);
    LAS unsigned char* Ks = F.lds + AT_KS; LAS unsigned char* Vt = F.lds + AT_VT; LAS float* biasT = (LAS float*)(F.lds + AT_BIAS);
    const int tid = F.tid, lane = F.lane, wave = F.wave, q = lane & 31, hh = lane >> 5;
    for (int unit = F.bid; unit < BATCH * 2 * 16; unit += F.G) {
        const int b = unit >> 5, kvh = (unit >> 4) & 1, qb = unit & 15;
        const size_t m0 = (size_t)b * SEQ + qb * 128;
        __syncthreads();
        { const int gi = tid >> 7, dist = tid & 127; biasT[tid] = rel_bias[t5_bucket(dist) * 8 + kvh * 4 + gi] * LOG2E; }
#pragma unroll
        for (int i = 0; i < 4; ++i) {
            const int c = tid + NTHREADS * i, key = c >> 3, part = c & 7;
            const bool valid = (qb > 0) || (key >= 128);
            v4u kw = {0u, 0u, 0u, 0u}, vw = {0u, 0u, 0u, 0u};
            if (valid) { const bf16* kp = PROJ + (m0 + key - 128) * PP + CK + kvh * 64 + part * 8; kw = *(const v4u*)kp; vw = *(const v4u*)(kp + (CV - CK)); }
            float kv[8]; kv[0] = bflo(kw.x); kv[1] = bfhi(kw.x); kv[2] = bflo(kw.y); kv[3] = bfhi(kw.y); kv[4] = bflo(kw.z); kv[5] = bfhi(kw.z); kv[6] = bflo(kw.w); kv[7] = bfhi(kw.w);
            float ss = 0.f;
#pragma unroll
            for (int e = 0; e < 8; ++e) ss += kv[e] * kv[e];
            ss += __shfl_xor(ss, 1); ss += __shfl_xor(ss, 2); ss += __shfl_xor(ss, 4);
            const float rk = 1.0f / sqrtf(ss * (1.0f / 64.0f) + EPS);
            const f32x4 g0 = *(const f32x4*)(kg + part * 8), g1 = *(const f32x4*)(kg + part * 8 + 4);
            v4u ko; ko.x = pkbf(kv[0] * rk * g0.x, kv[1] * rk * g0.y); ko.y = pkbf(kv[2] * rk * g0.z, kv[3] * rk * g0.w); ko.z = pkbf(kv[4] * rk * g1.x, kv[5] * rk * g1.y); ko.w = pkbf(kv[6] * rk * g1.z, kv[7] * rk * g1.w);
            *(LAS v4u*)(Ks + key * AT_KSTRIDE + part * 16) = ko;
            LAS unsigned short* vt = (LAS unsigned short*)(Vt + (part * 8) * AT_VSTRIDE + key * 2);
            vt[0 * (AT_VSTRIDE / 2)] = (unsigned short)(vw.x & 0xffffu); vt[1 * (AT_VSTRIDE / 2)] = (unsigned short)(vw.x >> 16);
            vt[2 * (AT_VSTRIDE / 2)] = (unsigned short)(vw.y & 0xffffu); vt[3 * (AT_VSTRIDE / 2)] = (unsigned short)(vw.y >> 16);
            vt[4 * (AT_VSTRIDE / 2)] = (unsigned short)(vw.z & 0xffffu); vt[5 * (AT_VSTRIDE / 2)] = (unsigned short)(vw.z >> 16);
            vt[6 * (AT_VSTRIDE / 2)] = (unsigned short)(vw.w & 0xffffu); vt[7 * (AT_VSTRIDE / 2)] = (unsigned short)(vw.w >> 16);
        }
        LDS_WAIT(); __syncthreads();
        const int gi = wave >> 1, qh = wave & 1, hq = kvh * 4 + gi;
        const float sink2 = sinks[hq] * LOG2E;
#pragma unroll 1
        for (int s = 0; s < 2; ++s) {
            const int a = 64 * qh + 32 * s;
            bf16* qrow = PROJ + (m0 + a + q) * PP + CQ + hq * 64;
            float qv[4][8]; float ss = 0.f;
#pragma unroll
            for (int d0 = 0; d0 < 4; ++d0) { ld8(qrow + d0 * 16 + hh * 8, qv[d0]);
#pragma unroll
                for (int e = 0; e < 8; ++e) ss += qv[d0][e] * qv[d0][e]; }
            ss += __shfl_xor(ss, 32);
            const float rq = (1.0f / sqrtf(ss * (1.0f / 64.0f) + EPS)) * (0.125f * LOG2E);
            bf16x8_t qf[4];
#pragma unroll
            for (int d0 = 0; d0 < 4; ++d0) { const f32x4 g0 = *(const f32x4*)(qg + d0 * 16 + hh * 8), g1 = *(const f32x4*)(qg + d0 * 16 + hh * 8 + 4);
                v4u w; w.x = pkbf(qv[d0][0] * rq * g0.x, qv[d0][1] * rq * g0.y); w.y = pkbf(qv[d0][2] * rq * g0.z, qv[d0][3] * rq * g0.w);
                w.z = pkbf(qv[d0][4] * rq * g1.x, qv[d0][5] * rq * g1.y); w.w = pkbf(qv[d0][6] * rq * g1.z, qv[d0][7] * rq * g1.w);
                qf[d0] = __builtin_bit_cast(bf16x8_t, w); }
            f32x16 S[5];
#pragma unroll
            for (int kt = 0; kt < 5; ++kt) { f32x16 acc = {};
#pragma unroll
                for (int d0 = 0; d0 < 4; ++d0) { const bf16x8_t kf = *(const LAS bf16x8_t*)(Ks + (a + 32 * kt + q) * AT_KSTRIDE + d0 * 32 + hh * 16);
                    acc = __builtin_amdgcn_mfma_f32_32x32x16_bf16(kf, qf[d0], acc, 0, 0, 0); }
                S[kt] = acc; }
            float mx = sink2;
#pragma unroll
            for (int kt = 0; kt < 5; ++kt)
#pragma unroll
                for (int i = 0; i < 16; ++i) { const int cr = (i & 3) + 8 * (i >> 2) + 4 * hh, dist = 128 + q - 32 * kt - cr, kidx = a + 32 * kt + cr;
                    const bool ok = (dist >= 0) && (dist < 128) && ((qb > 0) || (kidx >= 128));
                    const float v = ok ? S[kt][i] + biasT[gi * 128 + (dist & 127)] : -INFINITY;
                    S[kt][i] = v; mx = fmaxf(mx, v); }
            mx = fmaxf(mx, __shfl_xor(mx, 32));
            float lsum = 0.f; bf16x8_t pf[5][2];
#pragma unroll
            for (int kt = 0; kt < 5; ++kt) {
#pragma unroll
                for (int i = 0; i < 16; ++i) { const float p = __builtin_amdgcn_exp2f(S[kt][i] - mx); S[kt][i] = p; lsum += p; }
#pragma unroll
                for (int s2 = 0; s2 < 2; ++s2) { v4u w; w.x = pkbf(S[kt][8 * s2 + 0], S[kt][8 * s2 + 1]); w.y = pkbf(S[kt][8 * s2 + 2], S[kt][8 * s2 + 3]);
                    w.z = pkbf(S[kt][8 * s2 + 4], S[kt][8 * s2 + 5]); w.w = pkbf(S[kt][8 * s2 + 6], S[kt][8 * s2 + 7]); pf[kt][s2] = __builtin_bit_cast(bf16x8_t, w); } }
            lsum += __shfl_xor(lsum, 32);
            lsum += __builtin_amdgcn_exp2f(sink2 - mx);
            f32x16 O[2] = {{}, {}};
#pragma unroll
            for (int kt = 0; kt < 5; ++kt)
#pragma unroll
                for (int s2 = 0; s2 < 2; ++s2)
#pragma unroll
                    for (int db = 0; db < 2; ++db) { const LAS unsigned char* vb = Vt + (32 * db + q) * AT_VSTRIDE + (a + 32 * kt + 16 * s2 + 4 * hh) * 2;
                        const v2u lo = *(const LAS v2u*)vb, hi2 = *(const LAS v2u*)(vb + 16); v4u w; w.x = lo.x; w.y = lo.y; w.z = hi2.x; w.w = hi2.y;
                        O[db] = __builtin_amdgcn_mfma_f32_32x32x16_bf16(__builtin_bit_cast(bf16x8_t, w), pf[kt][s2], O[db], 0, 0, 0); }
            const float inv = 1.0f / lsum;
#pragma unroll
            for (int db = 0; db < 2; ++db)
#pragma unroll
                for (int g4 = 0; g4 < 4; ++g4) { v2u w; w.x = pkbf(O[db][4 * g4] * inv, O[db][4 * g4 + 1] * inv); w.y = pkbf(O[db][4 * g4 + 2] * inv, O[db][4 * g4 + 3] * inv);
                    *(v2u*)(qrow + 32 * db + 8 * g4 + 4 * hh) = w; }
        }
    }
}

__device__ __forceinline__ void ph_inproj(Frame& F, int L) {
    LAS float* rstd_tab = (LAS float*)(F.lds + RSTD_OFF);
    int bid_ = F.bid; asm volatile("" : "+s"(bid_)); pg8::StaticOrder S; S.init(M, NPROJ, F.G, bid_);
    rstd_prepass(F, S, rstd_tab);
    pg8::Gemm g{(const bf16*)FWS(WS_XB), (const bf16*)FWS(WS_WIN) + (size_t)L * NPROJ * D, M, NPROJ, D, D};
    pg8::EpiProj E{(bf16*)FWS(WS_PROJ), (float*)FWS(WS_DTRAW), (const LAS float*)rstd_tab};
    pg8::gemm_phase<pg8::EpiProj, pg8::StaticOrder, true, true>(F.lds + RING_OFF, g, S, E);
}
__device__ __forceinline__ void ph_outproj(Frame& F, int L) {
    int bid_ = F.bid; asm volatile("" : "+s"(bid_)); pg8::StaticOrder S; S.init(M, D, F.G, bid_);
    pg8::Gemm g{(const bf16*)FWS(WS_PROJ), (const bf16*)FWS(WS_WOUT) + (size_t)L * D * D, M, D, D, PP};
    float* out = (float*)ptr_at(F, I_OUT);
    pg8::EpiRes E{L == 0 ? FIN(I_X) : (const float*)out, out, (bf16*)FWS(WS_XB), (float*)FWS(WS_SSQ)};
    pg8::gemm_phase<pg8::EpiRes, pg8::StaticOrder, false, true>(F.lds + RING_OFF, g, S, E);
}
__device__ __forceinline__ void ph_up(Frame& F, int L) {
    LAS float* rstd_tab = (LAS float*)(F.lds + RSTD_OFF);
    int bid_ = F.bid; asm volatile("" : "+s"(bid_)); pg8::StaticOrder S; S.init(M, FF, F.G, bid_);
    rstd_prepass(F, S, rstd_tab);
    pg8::Gemm g{(const bf16*)FWS(WS_XB), (const bf16*)FWS(WS_WUP) + (size_t)L * FF * D, M, FF, D, D};
    pg8::EpiUp E{(bf16*)FWS(WS_HID), FF, (const LAS float*)rstd_tab};
    pg8::gemm_phase<pg8::EpiUp, pg8::StaticOrder, true, true>(F.lds + RING_OFF, g, S, E);
}
__device__ __forceinline__ void ph_down(Frame& F, int L) {
    int bid_ = F.bid; asm volatile("" : "+s"(bid_)); pg8::StaticOrder S; S.init(M, D, F.G, bid_);
    pg8::Gemm g{(const bf16*)FWS(WS_HID), (const bf16*)FWS(WS_WDOWN) + (size_t)L * D * FF, M, D, FF, FF};
    float* out = (float*)ptr_at(F, I_OUT);
    pg8::EpiRes E{(const float*)out, out, (bf16*)FWS(WS_XB), (float*)FWS(WS_SSQ)};
    pg8::gemm_phase<pg8::EpiRes, pg8::StaticOrder, false, true>(F.lds + RING_OFF, g, S, E);
}

struct Args { const float* in[17]; float* out; unsigned char* ws; int ph_lo, ph_hi; };
#define FRAME_INIT() \
    extern __shared__ __attribute__((aligned(16))) unsigned char lds[]; \
    Frame F; \
    F.lds = (LAS unsigned char*)lds; \
    F.tid = threadIdx.x; F.lane = F.tid & 63; F.wave = __builtin_amdgcn_readfirstlane(F.tid >> 6); F.bid = blockIdx.x; F.G = gridDim.x; \
    for (int u = F.tid; u < (LDS_BYTES - LDSCTL_OFF) / 4; u += NTHREADS) ((LAS unsigned*)(F.lds + LDSCTL_OFF))[u] = 0u; \
    __syncthreads(); \
    if (F.tid < I_NPTR) { const unsigned long long p = F.tid < 17 ? (unsigned long long)args.in[F.tid < 17 ? F.tid : 0] : (F.tid == I_OUT ? (unsigned long long)args.out : (unsigned long long)args.ws); \
        LAS unsigned* t = (LAS unsigned*)(F.lds + PTR_OFF) + 2 * F.tid; t[0] = (unsigned)p; t[1] = (unsigned)(p >> 32); } \
    LDS_WAIT(); __syncthreads();

#if !ONE_LAUNCH
__global__ void __launch_bounds__(NTHREADS, 2) k_mix1_naive(Args args) { FRAME_INIT(); attn_naive(F, args.ph_lo); conv_naive(F, args.ph_lo); }
__global__ void __launch_bounds__(NTHREADS, 2) k_mix2_naive(Args args) { FRAME_INIT(); ssd_naive(F, args.ph_lo); }
__global__ void __launch_bounds__(NTHREADS, 2) k_mix3_naive(Args args) { FRAME_INIT(); gate_naive(F, args.ph_lo); }
#endif
#define PH_MIX1(F, L) do { attn_fast(F, L); conv_naive(F, L); } while (0)
#define PH_MIX2(F, L) ssd_naive(F, L)
#define PH_MIX3(F, L) gate_naive(F, L)

__global__ void __launch_bounds__(NTHREADS, 2) fwd(Args args) {
    FRAME_INIT();
    const int lo = args.ph_lo, hi = args.ph_hi;
#if ONE_LAUNCH
    XcdBarrier bar = xcd_barrier_post((unsigned*)(FWS(WS_CTL)) + CW_BAR, (volatile LAS unsigned*)(F.lds + MISC_OFF) + 8);
#define GRID_BAR() xcd_barrier(bar)
#else
#define GRID_BAR() do {} while (0)
#endif
#define IN(k) (lo <= (k) && (k) < hi)
#define RELAUNDER() do { int t_ = threadIdx.x; asm volatile("" : "+v"(t_)); F.tid = t_; F.lane = t_ & 63; F.wave = __builtin_amdgcn_readfirstlane(t_ >> 6); \
    int b_ = blockIdx.x; asm volatile("" : "+s"(b_)); F.bid = b_; } while (0)
#define SEAM(k) do { if (IN(k) && IN((k) + 1)) GRID_BAR(); } while (0)

    if (IN(0)) { p0_prologue(F); SEAM(0); }
    for (int L = 0; L < DEPTH; ++L) {
        const int pb = 1 + 7 * L;
        if (IN(pb + 0)) { RELAUNDER(); ph_inproj(F, L); SEAM(pb + 0); }
        if (IN(pb + 1)) { RELAUNDER(); PH_MIX1(F, L); SEAM(pb + 1); }
        if (IN(pb + 2)) { RELAUNDER(); PH_MIX2(F, L); SEAM(pb + 2); }
        if (IN(pb + 3)) { RELAUNDER(); PH_MIX3(F, L); SEAM(pb + 3); }
        if (IN(pb + 4)) { RELAUNDER(); ph_outproj(F, L); SEAM(pb + 4); }
        if (IN(pb + 5)) { RELAUNDER(); ph_up(F, L); SEAM(pb + 5); }
        if (IN(pb + 6)) { RELAUNDER(); ph_down(F, L); SEAM(pb + 6); }
    }
#undef IN
#undef SEAM
}

extern "C" void kernel_launch(void* const* d_in, const int* in_sizes, int n_in, void* d_out, int out_size, void* d_ws, size_t ws_size, hipStream_t stream) {
    static int grid = 0;
    if (grid == 0) {
        if (n_in != 17 || in_sizes[0] != M * D || out_size != M * D || ws_size < WS_END) { fprintf(stderr, "kernel_launch: unexpected shapes (n_in %d, in0 %d, out %d, ws %zu)\n", n_in, n_in > 0 ? in_sizes[0] : -1, out_size, ws_size); grid = -1; return; }
        int dev = 0, cus = 0, per_cu = 0;
        if (hipGetDevice(&dev) != hipSuccess || hipDeviceGetAttribute(&cus, hipDeviceAttributeMultiprocessorCount, dev) != hipSuccess) { grid = -1; return; }
        if (hipFuncSetAttribute((const void*)fwd, hipFuncAttributeMaxDynamicSharedMemorySize, LDS_BYTES) != hipSuccess) { fprintf(stderr, "kernel_launch: hipFuncSetAttribute failed\n"); grid = -1; return; }
#if !ONE_LAUNCH
        (void)hipFuncSetAttribute((const void*)k_mix1_naive, hipFuncAttributeMaxDynamicSharedMemorySize, LDS_BYTES);
        (void)hipFuncSetAttribute((const void*)k_mix2_naive, hipFuncAttributeMaxDynamicSharedMemorySize, LDS_BYTES);
        (void)hipFuncSetAttribute((const void*)k_mix3_naive, hipFuncAttributeMaxDynamicSharedMemorySize, LDS_BYTES);
#endif
        if (hipOccupancyMaxActiveBlocksPerMultiprocessor(&per_cu, (const void*)fwd, NTHREADS, LDS_BYTES) != hipSuccess || per_cu < 1) { fprintf(stderr, "kernel_launch: occupancy query says %d\n", per_cu); per_cu = 1; }
        (void)hipGetLastError();
        grid = cus;
    }
    if (grid < 0) return;
    (void)hipMemsetAsync((char*)d_ws + WS_CTL, 0, CTL_ZERO_BYTES, stream);
    Args a{};
    for (int i = 0; i < 17; ++i) a.in[i] = (const float*)d_in[i];
    a.out = (float*)d_out; a.ws = (unsigned char*)d_ws;
#if ONE_LAUNCH
    a.ph_lo = 0; a.ph_hi = NPH;
    void* kargs[] = {&a};
    hipError_t e = hipLaunchCooperativeKernel((const void*)fwd, dim3(grid), dim3(NTHREADS), kargs, LDS_BYTES, stream);
    if (e != hipSuccess) fprintf(stderr, "kernel_launch: cooperative launch failed: %s (grid %d)\n", hipGetErrorString(e), grid);
#else
    for (int ph = 0; ph < NPH; ++ph) {
        const int r = ph == 0 ? -1 : (ph - 1) % 7, L = ph == 0 ? 0 : (ph - 1) / 7;
        a.ph_lo = ph; a.ph_hi = ph + 1;
        if (r == 1) { a.ph_lo = L; hipLaunchKernelGGL(k_mix1_naive, dim3(grid), dim3(NTHREADS), LDS_BYTES, stream, a); }
        else if (r == 2) { a.ph_lo = L; hipLaunchKernelGGL(k_mix2_naive, dim3(grid), dim3(NTHREADS), LDS_BYTES, stream, a); }
        else if (r == 3) { a.ph_lo = L; hipLaunchKernelGGL(k_mix3_naive, dim3(grid), dim3(NTHREADS), LDS_BYTES, stream, a); }
        else hipLaunchKernelGGL(fwd, dim3(grid), dim3(NTHREADS), LDS_BYTES, stream, a);
    }
#endif
}
```

```cpp
#include <hip/hip_runtime.h>
#include <cstdio>
#include <cstdint>

#ifndef ONE_LAUNCH
#define ONE_LAUNCH 1
#endif

namespace pg8 {
#define PG8_LAS __attribute__((address_space(3)))
typedef unsigned short bf16_t;
typedef short bf16x8 __attribute__((ext_vector_type(8)));
typedef float f32x4 __attribute__((ext_vector_type(4)));
typedef unsigned u32x4 __attribute__((ext_vector_type(4)));
constexpr int BM = 256, BK = 64, HALF = 128, HTB = HALF * BK * 2  , STAGE_BYTES = 8 * HTB, NXCD = 8, WGM = 8;

__host__ __device__ __forceinline__ int lds_byte(int r, int c) { const int st = (r >> 4) * 2 + (c >> 5), rr = r & 15, cc = c & 31, ob = rr * 64 + cc * 2; return st * 1024 + (ob ^ (((ob >> 9) & 1) << 5)); }
__host__ __device__ __forceinline__ void stage_rc(int b, int& R, int& C) { const int st = b / 1024, sb = b % 1024, swz = sb ^ (((sb >> 9) & 1) << 5); R = (st >> 1) * 16 + swz / 64; C = (st & 1) * 32 + (swz % 64) / 2; }
__host__ __device__ __forceinline__ int perm32(int rho) { const int n = rho >> 4, i = rho & 15; return 8 * (i >> 2) + 4 * n + (i & 3); }

struct Unit { int pm, pn; };
struct Gemm { const bf16_t* A; const bf16_t* Bt; int M, N, K, lda; };

struct StaticOrder {
    int nM, nN, nwg, G, c;
    __host__ __device__ void init(int M, int N, int G_, int c_) { nM = M / BM; nN = N / BM; nwg = nM * nN; G = G_; c = c_; }
    __host__ __device__ bool next(int i, Unit& u) const {
        const long L = (long)i * G + c; if (L >= nwg) return false;
        int wgid = (int)L; { const int q = nwg / NXCD, r = nwg % NXCD, xcd = wgid % NXCD, off = wgid / NXCD; wgid = (xcd < r ? xcd * (q + 1) : r * (q + 1) + (xcd - r) * q) + off; }
        const int nig = WGM * nN, gid = wgid / nig, fm = gid * WGM, gsz = (nM - fm) < WGM ? (nM - fm) : WGM;
        u.pm = fm + ((wgid % nig) % gsz); u.pn = (wgid % nig) / gsz; return true;
    }
    __device__ __forceinline__ void a_ready(const Unit&) const {}
    __device__ __forceinline__ void done(const Unit&) const {}
};

__device__ __forceinline__ unsigned cvt_pk_bf16(float lo, float hi) { unsigned r; asm volatile("v_cvt_pk_bf16_f32 %0, %1, %2" : "=v"(r) : "v"(lo), "v"(hi)); return r; }

constexpr int PROJ_PITCH = 2304, DT_TILE = 9;
struct EpiProj {
    static constexpr bool PERM = true, AFTER_DRAIN = false;
    bf16_t* O; float* dtraw; const PG8_LAS float* rstd;
    __device__ __forceinline__ void operator()(const f32x4 (&acc)[2][2][4][2], const Unit& u, int ui, int wr, int wc, int fr, int fq) const {
        const int rt0 = wr * 64 + fr;
        if (u.pn == DT_TILE) {
            if (wc == 0 && fq == 0) {
#pragma unroll
                for (int ai = 0; ai < 2; ++ai)
#pragma unroll
                    for (int m = 0; m < 4; ++m) { const int rt = ai * HALF + rt0 + m * 16; const float rs = rstd[ui * BM + rt]; float* p = dtraw + (size_t)(u.pm * BM + rt) * 8;
                        *(f32x4*)p = acc[ai][0][m][0] * rs; *(f32x4*)(p + 4) = acc[ai][0][m][1] * rs; }
            }
            return;
        }
        const int col0 = u.pn * BM + wc * 32 + 8 * fq;
#pragma unroll
        for (int ai = 0; ai < 2; ++ai)
#pragma unroll
            for (int m = 0; m < 4; ++m) { const int rt = ai * HALF + rt0 + m * 16; const float rs = rstd[ui * BM + rt]; bf16_t* rowp = O + (size_t)(u.pm * BM + rt) * PROJ_PITCH + col0;
#pragma unroll
                for (int bj = 0; bj < 2; ++bj) { const f32x4 v0 = acc[ai][bj][m][0] * rs, v1 = acc[ai][bj][m][1] * rs;
                    u32x4 w; w.x = cvt_pk_bf16(v0[0], v0[1]); w.y = cvt_pk_bf16(v0[2], v0[3]); w.z = cvt_pk_bf16(v1[0], v1[1]); w.w = cvt_pk_bf16(v1[2], v1[3]);
                    *(u32x4*)(rowp + bj * HALF) = w; } }
    }
};
struct EpiUp {
    static constexpr bool PERM = true, AFTER_DRAIN = false;
    bf16_t* O; int ldc; const PG8_LAS float* rstd;
    __device__ __forceinline__ void operator()(const f32x4 (&acc)[2][2][4][2], const Unit& u, int ui, int wr, int wc, int fr, int fq) const {
        const int rt0 = wr * 64 + fr, col0 = u.pn * BM + wc * 32 + 8 * fq;
#pragma unroll
        for (int ai = 0; ai < 2; ++ai)
#pragma unroll
            for (int m = 0; m < 4; ++m) { const int rt = ai * HALF + rt0 + m * 16; const float rs = rstd[ui * BM + rt]; bf16_t* rowp = O + (size_t)(u.pm * BM + rt) * ldc + col0;
#pragma unroll
                for (int bj = 0; bj < 2; ++bj) { f32x4 v0 = acc[ai][bj][m][0] * rs, v1 = acc[ai][bj][m][1] * rs;
#pragma unroll
                    for (int e = 0; e < 4; ++e) { const float a = fmaxf(v0[e], 0.f), b = fmaxf(v1[e], 0.f); v0[e] = a * a; v1[e] = b * b; }
                    u32x4 w; w.x = cvt_pk_bf16(v0[0], v0[1]); w.y = cvt_pk_bf16(v0[2], v0[3]); w.z = cvt_pk_bf16(v1[0], v1[1]); w.w = cvt_pk_bf16(v1[2], v1[3]);
                    *(u32x4*)(rowp + bj * HALF) = w; } }
    }
};
struct EpiRes {
    static constexpr bool PERM = true, AFTER_DRAIN = false;
    const float* res; float* out; bf16_t* xb; float* ssq;
    __device__ __forceinline__ void operator()(const f32x4 (&acc)[2][2][4][2], const Unit& u, int ui, int wr, int wc, int fr, int fq) const {
        const int rt0 = wr * 64 + fr, col0 = u.pn * BM + wc * 32 + 8 * fq;
#pragma unroll
        for (int ai = 0; ai < 2; ++ai)
#pragma unroll
            for (int m = 0; m < 4; ++m) { const int row = u.pm * BM + ai * HALF + rt0 + m * 16; const size_t off = (size_t)row * 1024 + col0; float s = 0.f;
#pragma unroll
                for (int bj = 0; bj < 2; ++bj) { const f32x4 r0 = *(const f32x4*)(res + off + bj * HALF), r1 = *(const f32x4*)(res + off + bj * HALF + 4);
                    const f32x4 v0 = r0 + acc[ai][bj][m][0], v1 = r1 + acc[ai][bj][m][1];
                    *(f32x4*)(out + off + bj * HALF) = v0; *(f32x4*)(out + off + bj * HALF + 4) = v1;
                    u32x4 w; w.x = cvt_pk_bf16(v0[0], v0[1]); w.y = cvt_pk_bf16(v0[2], v0[3]); w.z = cvt_pk_bf16(v1[0], v1[1]); w.w = cvt_pk_bf16(v1[2], v1[3]);
                    *(u32x4*)(xb + off + bj * HALF) = w;
                    s += (v0[0] * v0[0] + v0[1] * v0[1]) + (v0[2] * v0[2] + v0[3] * v0[3]) + (v1[0] * v1[0] + v1[1] * v1[1]) + (v1[2] * v1[2] + v1[3] * v1[3]); }
                s += __shfl_xor(s, 16); s += __shfl_xor(s, 32);
                if (fq == 0) ssq[(size_t)row * 16 + u.pn * 4 + wc] = s;
                if (m & 1) asm volatile("" ::: "memory"); }
    }
};

template <class Epi, class Sched, bool ALIGN_EPI = false, bool SP2 = false>
__device__ __forceinline__ void gemm_phase(PG8_LAS unsigned char* lds, const Gemm g, const Sched& S, const Epi& E) {
    int tid_ = threadIdx.x; asm volatile("" : "+v"(tid_));
    const int tid = tid_, wid = __builtin_amdgcn_readfirstlane(tid >> 6), lane = tid & 63, wr = wid >> 2, wc = wid & 3, fr = lane & 15, fq = lane >> 4;
    const int K = g.K, nt = K / BK;
    unsigned voffA[2], voffB[2];
#pragma unroll
    for (int i = 0; i < 2; ++i) { int R, C; stage_rc(tid * 16 + i * 8192, R, C); const int Rb = Epi::PERM ? ((R & ~31) + perm32(R & 31)) : R;
        voffA[i] = (unsigned)(R * g.lda + C) * 2u; voffB[i] = (unsigned)(Rb * K + C) * 2u; }
    const size_t kstep = (size_t)(BK * 2);
    const size_t hstepA = (size_t)HALF * g.lda * 2, hstepB = (size_t)HALF * K * 2;
    const size_t tstepA = 2 * hstepA, tstepB = 2 * hstepB;
    const unsigned ldsw = (unsigned)wid * 1024u;
    const int aoff = lds_byte(wr * 64 + fr, fq * 8), boff = lds_byte(wc * 32 + fr, fq * 8);
#define PG8_SA(b, h) (((b) * 2 + (h)) * HTB)
#define PG8_SB(b, h) ((4 + (b) * 2 + (h)) * HTB)
#define PG8_STAGE(bufoff, gbase, voff) do { _Pragma("unroll") for (int _i = 0; _i < 2; ++_i) \
        __builtin_amdgcn_global_load_lds((const unsigned*)((const char*)(gbase) + (voff)[_i]), (PG8_LAS unsigned*)(lds + (bufoff) + ldsw + _i * 8192), 16, 0, 0); } while (0)
#define PG8_LDA(dst, b, h) do { _Pragma("unroll") for (int m = 0; m < 4; ++m) _Pragma("unroll") for (int k = 0; k < 2; ++k) dst[m][k] = *(const PG8_LAS bf16x8*)(lds + PG8_SA(b, h) + aoff + m * 2048 + k * 1024); } while (0)
#define PG8_LDB(dst, b, h) do { _Pragma("unroll") for (int n = 0; n < 2; ++n) _Pragma("unroll") for (int k = 0; k < 2; ++k) dst[n][k] = *(const PG8_LAS bf16x8*)(lds + PG8_SB(b, h) + boff + n * 2048 + k * 1024); } while (0)
#define PG8_MMA(ai, bj, At, Bt) do { __builtin_amdgcn_s_setprio(1); _Pragma("unroll") for (int m = 0; m < 4; ++m) _Pragma("unroll") for (int n = 0; n < 2; ++n) _Pragma("unroll") for (int k = 0; k < 2; ++k) \
        acc[ai][bj][m][n] = __builtin_amdgcn_mfma_f32_16x16x32_bf16(Bt[n][k], At[m][k], acc[ai][bj][m][n], 0, 0, 0); __builtin_amdgcn_s_setprio(0); } while (0)
#define PG8_WAIT_V(n) asm volatile("s_waitcnt vmcnt(" #n ")" ::: "memory")
#define PG8_WAIT_L(n) asm volatile("s_waitcnt lgkmcnt(" #n ")" ::: "memory")
#define PG8_BAR __builtin_amdgcn_s_barrier()
#define PG8_SCHED __builtin_amdgcn_sched_barrier(0)
    Unit cur, nxt; int ui = 0;
    if (!S.next(0, cur)) return;
    f32x4 acc[2][2][4][2];
#pragma unroll
    for (int a = 0; a < 2; ++a)
#pragma unroll
        for (int b = 0; b < 2; ++b)
#pragma unroll
            for (int m = 0; m < 4; ++m)
#pragma unroll
                for (int n = 0; n < 2; ++n) acc[a][b][m][n] = (f32x4){0.f, 0.f, 0.f, 0.f};
    bf16x8 At[4][2], B0[2][2], B1[2][2];
    const char* cA = (const char*)g.A + (size_t)cur.pm * tstepA; const char* cB = (const char*)g.Bt + (size_t)cur.pn * tstepB;
    S.a_ready(cur);
    if constexpr (SP2) {
        PG8_STAGE(PG8_SB(0, 0), cB, voffB); PG8_STAGE(PG8_SB(0, 1), cB + hstepB, voffB); PG8_STAGE(PG8_SA(0, 0), cA, voffA); PG8_STAGE(PG8_SA(0, 1), cA + hstepA, voffA);
        if (wr == 1) PG8_BAR;
        PG8_WAIT_V(2); PG8_BAR;
        PG8_STAGE(PG8_SB(1, 0), cB + kstep, voffB); PG8_STAGE(PG8_SA(1, 0), cA + kstep, voffA); PG8_STAGE(PG8_SB(1, 1), cB + hstepB + kstep, voffB);
        PG8_WAIT_V(6); PG8_BAR;
    } else {
        PG8_STAGE(PG8_SB(0, 0), cB, voffB); PG8_STAGE(PG8_SA(0, 0), cA, voffA); PG8_STAGE(PG8_SB(0, 1), cB + hstepB, voffB); PG8_STAGE(PG8_SA(0, 1), cA + hstepA, voffA);
        if (wr == 1) PG8_BAR;
        PG8_WAIT_V(4); PG8_BAR;
        PG8_STAGE(PG8_SB(1, 0), cB + kstep, voffB); PG8_STAGE(PG8_SA(1, 0), cA + kstep, voffA); PG8_STAGE(PG8_SB(1, 1), cB + hstepB + kstep, voffB);
        PG8_WAIT_V(6); PG8_BAR;
    }
    for (;;) {
        const bool has_next = S.next(ui + 1, nxt);
        const char* nA = has_next ? (const char*)g.A + (size_t)nxt.pm * tstepA : cA; const char* nB = has_next ? (const char*)g.Bt + (size_t)nxt.pn * tstepB : cB;
        for (int t = 0; t < nt; t += 2) {
            const bool last = (t == nt - 2);
            const char* a1 = cA + (size_t)(t + 1) * kstep;
            const char* a2 = last ? nA : cA + (size_t)(t + 2) * kstep; const char* b2 = last ? nB : cB + (size_t)(t + 2) * kstep;
            const char* a3 = a2 + kstep; const char* b3 = b2 + kstep;
            if (last && has_next) S.a_ready(nxt);
            if constexpr (SP2) {
            PG8_LDB(B0, 0, 0); PG8_LDB(B1, 0, 1); PG8_SCHED; PG8_LDA(At, 0, 0); PG8_STAGE(PG8_SA(1, 1), a1 + hstepA, voffA);
            PG8_WAIT_V(8); PG8_WAIT_L(0); PG8_BAR; PG8_MMA(0, 0, At, B0); PG8_MMA(0, 1, At, B1); PG8_BAR; PG8_SCHED;
            PG8_LDA(At, 0, 1); PG8_STAGE(PG8_SB(0, 0), b2, voffB); PG8_STAGE(PG8_SB(0, 1), b2 + hstepB, voffB); PG8_STAGE(PG8_SA(0, 0), a2, voffA);
            PG8_WAIT_V(8); PG8_WAIT_L(0); PG8_BAR; PG8_MMA(1, 0, At, B0); PG8_MMA(1, 1, At, B1); PG8_BAR; PG8_SCHED;
            PG8_LDB(B0, 1, 0); PG8_LDB(B1, 1, 1); PG8_SCHED; PG8_LDA(At, 1, 0); PG8_STAGE(PG8_SA(0, 1), a2 + hstepA, voffA);
            PG8_WAIT_V(8); PG8_WAIT_L(0); PG8_BAR; PG8_MMA(0, 0, At, B0); PG8_MMA(0, 1, At, B1); PG8_BAR; PG8_SCHED;
            PG8_LDA(At, 1, 1); PG8_STAGE(PG8_SB(1, 0), b3, voffB); PG8_STAGE(PG8_SB(1, 1), b3 + hstepB, voffB); PG8_STAGE(PG8_SA(1, 0), a3, voffA);
            PG8_WAIT_V(8); PG8_WAIT_L(0); PG8_BAR; PG8_MMA(1, 0, At, B0); PG8_MMA(1, 1, At, B1); PG8_BAR; PG8_SCHED;
            } else {
            PG8_LDB(B0, 0, 0); PG8_SCHED; PG8_LDA(At, 0, 0); PG8_STAGE(PG8_SA(1, 1), a1 + hstepA, voffA);
            PG8_WAIT_L(8); PG8_BAR; PG8_WAIT_L(0); PG8_MMA(0, 0, At, B0); PG8_BAR; PG8_SCHED;
            PG8_LDB(B1, 0, 1); PG8_STAGE(PG8_SB(0, 0), b2, voffB);
            PG8_BAR; PG8_WAIT_L(0); PG8_MMA(0, 1, At, B1); PG8_BAR;
            PG8_LDA(At, 0, 1); PG8_STAGE(PG8_SA(0, 0), a2, voffA);
            PG8_BAR; PG8_WAIT_L(0); PG8_MMA(1, 0, At, B0); PG8_BAR; PG8_SCHED;
            PG8_STAGE(PG8_SB(0, 1), b2 + hstepB, voffB);
            PG8_WAIT_V(6); PG8_BAR; PG8_MMA(1, 1, At, B1); PG8_BAR;
            PG8_LDB(B0, 1, 0); PG8_SCHED; PG8_LDA(At, 1, 0); PG8_STAGE(PG8_SA(0, 1), a2 + hstepA, voffA);
            PG8_WAIT_L(8); PG8_BAR; PG8_WAIT_L(0); PG8_MMA(0, 0, At, B0); PG8_BAR; PG8_SCHED;
            PG8_LDB(B1, 1, 1); PG8_STAGE(PG8_SB(1, 0), b3, voffB);
            PG8_BAR; PG8_WAIT_L(0); PG8_MMA(0, 1, At, B1); PG8_BAR;
            PG8_LDA(At, 1, 1); PG8_STAGE(PG8_SA(1, 0), a3, voffA);
            PG8_BAR; PG8_WAIT_L(0); PG8_MMA(1, 0, At, B0); PG8_BAR; PG8_SCHED;
            PG8_STAGE(PG8_SB(1, 1), b3 + hstepB, voffB);
            PG8_WAIT_V(6); PG8_BAR; PG8_MMA(1, 1, At, B1); PG8_BAR;
            }
        }
        if constexpr (ALIGN_EPI) { if (wr == 0) PG8_BAR; }
        if constexpr (!Epi::AFTER_DRAIN) { E(acc, cur, ui, wr, wc, fr, fq); S.done(cur); }
        if (!has_next) break;
#pragma unroll
        for (int a = 0; a < 2; ++a)
#pragma unroll
            for (int b = 0; b < 2; ++b)
#pragma unroll
                for (int m = 0; m < 4; ++m)
#pragma unroll
                    for (int n = 0; n < 2; ++n) acc[a][b][m][n] = (f32x4){0.f, 0.f, 0.f, 0.f};
        cur = nxt; cA = nA; cB = nB; ++ui;
        if constexpr (ALIGN_EPI) { if (wr == 1) PG8_BAR; }
    }
    PG8_WAIT_V(0);
    if constexpr (!ALIGN_EPI) { if (wr == 0) PG8_BAR; }
    PG8_BAR;

#undef PG8_SA
#undef PG8_SB
#undef PG8_STAGE
#undef PG8_LDA
#undef PG8_LDB
#undef PG8_MMA
#undef PG8_WAIT_V
#undef PG8_WAIT_L
#undef PG8_BAR
#undef PG8_SCHED
}
}

constexpr int NWAVES = 8, NTHREADS = NWAVES * 64;
constexpr int BATCH = 8, SEQ = 2048, D = 1024, M = BATCH * SEQ, FF = 4096, DEPTH = 2;
constexpr int D_IN = 2312, NPROJ = 2560, PP = pg8::PROJ_PITCH;
constexpr int CQ = 0, CZ = 512, CK = 1024, CV = 1152, CX = 1280, CBM = 1792, CCM = 2048;
constexpr float EPS = 1e-6f;
constexpr int NPH = 1 + 7 * DEPTH;

constexpr size_t MiB = 1u << 20;
constexpr size_t WS_CTL = 0, CTL_ZERO_BYTES = 1 * MiB;
constexpr size_t WS_SSQ = 1 * MiB;
constexpr size_t WS_DTRAW = 2 * MiB;
constexpr size_t WS_WIN = 4 * MiB, WS_WOUT = 14 * MiB, WS_WUP = 18 * MiB, WS_WDOWN = 34 * MiB;
constexpr size_t WS_XB = 50 * MiB;
constexpr size_t WS_PROJ = 82 * MiB;
constexpr size_t WS_XBCF = 154 * MiB;
constexpr size_t WS_YN = 218 * MiB;
constexpr size_t WS_HID = 82 * MiB;
constexpr size_t WS_END = 256 * MiB;
constexpr int CW_BAR = 4096;

constexpr int RING_OFF = 0, RING_BYTES = 131072;
constexpr int LDSCTL_OFF = RING_BYTES, MISC_OFF = LDSCTL_OFF + 320, RSTD_OFF = LDSCTL_OFF + 512, PTR_OFF = RSTD_OFF + 4096;
constexpr int LDS_BYTES = 147456;
static_assert(PTR_OFF + 512 <= LDS_BYTES, "LDS map");

#define GAS __attribute__((address_space(1)))
#define LAS __attribute__((address_space(3)))
typedef unsigned short bf16;
typedef unsigned v4u __attribute__((ext_vector_type(4)));
typedef unsigned v2u __attribute__((ext_vector_type(2)));
typedef float f32x4 __attribute__((ext_vector_type(4)));
typedef GAS unsigned gu32;
#define RLX_AGENT __ATOMIC_RELAXED, __HIP_MEMORY_SCOPE_AGENT
#define LDS_WAIT() asm volatile("s_waitcnt lgkmcnt(0)" ::: "memory")
#define VM_WAIT() asm volatile("s_waitcnt vmcnt(0)" ::: "memory")
__device__ __forceinline__ unsigned f2bf(float f) { unsigned u = __builtin_bit_cast(unsigned, f); return (u + 0x7fffu + ((u >> 16) & 1u)) >> 16; }
__device__ __forceinline__ unsigned pk2(float lo, float hi) { return f2bf(lo) | (f2bf(hi) << 16); }
__device__ __forceinline__ float bflo(unsigned w) { return __uint_as_float(w << 16); }
__device__ __forceinline__ float bfhi(unsigned w) { return __uint_as_float(w & 0xffff0000u); }
__device__ __forceinline__ float silu_f(float v) { return v / (1.f + expf(-v)); }
__device__ __forceinline__ float softplus_f(float v) { return fmaxf(v, 0.f) + log1pf(expf(-fabsf(v))); }

#define XB_TMO      128
#define XB_XCNT(j)  (256  + 64 * (j))
#define XB_XSUB(j)  (1280 + 64 * (j))
#define XB_XGEN(j)  (2304 + 64 * (j))
#define XB_TOP      3328
#define XB_TOPGEN   3392
#define XCD_BAR_WORDS 3456
#define XB_SPIN_CAP (1u << 22)
__device__ __forceinline__ unsigned xb_ld(unsigned* p)              { return __hip_atomic_load(p, __ATOMIC_RELAXED, __HIP_MEMORY_SCOPE_AGENT); }
__device__ __forceinline__ unsigned xb_add(unsigned* p, unsigned v) { return __hip_atomic_fetch_add(p, v, __ATOMIC_RELAXED, __HIP_MEMORY_SCOPE_AGENT); }
__device__ __forceinline__ unsigned xb_xcc_id() { return (unsigned)__builtin_amdgcn_s_getreg((3 << 11) | 20) & 0xFu; }
#define XB_SPIN(cond, bar) do { unsigned _sp = 0; while (cond) { __builtin_amdgcn_s_sleep(1); \
    if ((++_sp & 255u) == 0u) { if (xb_ld(&(bar)[XB_TMO])) break; if (_sp > XB_SPIN_CAP) { atomicAdd(&(bar)[XB_TMO], 1u); break; } } } } while (0)
struct XcdBarrier { unsigned* bar; unsigned x; volatile LAS unsigned* st; };
__device__ __forceinline__ XcdBarrier xcd_barrier_post(unsigned* bar, volatile LAS unsigned* st) {
    XcdBarrier b; b.bar = bar; b.x = xb_xcc_id(); b.st = st;
    if (threadIdx.x == 0) (void)xb_add(&bar[XB_XCNT(b.x)], 1u);
    return b;
}
__device__ __forceinline__ void xcd_barrier_complete(unsigned* bar, unsigned x, unsigned& nloc, unsigned& nx) {
    const unsigned G = gridDim.x * gridDim.y * gridDim.z;
    unsigned sum, cnt, mine, sp = 0u;
    for (;;) {
        sum = 0u; cnt = 0u; mine = 0u;
#pragma unroll
        for (unsigned j = 0; j < 16; ++j) { const unsigned c = xb_ld(&bar[XB_XCNT(j)]); sum += c; cnt += (c > 0u) ? 1u : 0u; mine = (j == x) ? c : mine; }
        if (sum == G) break;
        __builtin_amdgcn_s_sleep(1);
        if ((++sp & 255u) == 0u) { if (xb_ld(&bar[XB_TMO])) break; if (sp > XB_SPIN_CAP) { atomicAdd(&bar[XB_TMO], 1u); break; } }
    }
    nloc = mine > 0u ? mine : 1u; nx = cnt > 0u ? cnt : 1u;
}
__device__ __forceinline__ void xcd_barrier(const XcdBarrier& b) {
    asm volatile("s_waitcnt vmcnt(0)" ::: "memory");
    __syncthreads();
    if (threadIdx.x == 0) {
        unsigned* bar = b.bar;
        __builtin_amdgcn_s_waitcnt(0);
        unsigned nloc = b.st[0], nx = b.st[1];
        if (nloc == 0u) { xcd_barrier_complete(bar, b.x, nloc, nx); b.st[0] = nloc; b.st[1] = nx; }
        const unsigned old = xb_add(&bar[XB_XSUB(b.x)], 1u);
        const unsigned gen = old / nloc;
        if (old + 1u == (gen + 1u) * nloc) {
            __builtin_amdgcn_fence(__ATOMIC_RELEASE, "agent");
            asm volatile("s_waitcnt vmcnt(0)" ::: "memory");
            const unsigned og = xb_add(&bar[XB_TOP], 1u);
            const unsigned tg = og / nx;
            if (og + 1u == (tg + 1u) * nx) xb_add(&bar[XB_TOPGEN], 1u);
            else XB_SPIN(xb_ld(&bar[XB_TOPGEN]) == tg, bar);
            __builtin_amdgcn_fence(__ATOMIC_ACQUIRE, "agent");
            xb_add(&bar[XB_XGEN(b.x)], 1u);
            asm volatile("s_waitcnt vmcnt(0)" ::: "memory");
        } else {
            XB_SPIN(xb_ld(&bar[XB_XGEN(b.x)]) == gen, bar);
            __builtin_amdgcn_fence(__ATOMIC_ACQUIRE, "agent");
            asm volatile("s_waitcnt vmcnt(0)" ::: "memory");
        }
    }
    __syncthreads();
}

struct Frame {
    LAS unsigned char* lds;
    int tid, lane, wave, bid, G;
};
enum { I_X = 0, I_MIXG, I_WIN, I_QG, I_KG, I_SINK, I_RELB, I_CONVW, I_CONVB, I_DTB, I_ALOG, I_DSKIP, I_SSMG, I_WOUT, I_MLPG, I_WUP, I_WDOWN, I_OUT, I_WS, I_NPTR };
__device__ __forceinline__ unsigned char* ptr_at(const Frame& F, int i) {
    const LAS unsigned* t = (const LAS unsigned*)(F.lds + PTR_OFF) + 2 * i;
    const unsigned lo = __builtin_amdgcn_readfirstlane(t[0]), hi = __builtin_amdgcn_readfirstlane(t[1]);
    return (unsigned char*)(((unsigned long long)hi << 32) | lo);
}
#define FIN(i) ((const float*)ptr_at(F, (i)))
#define FWS(off) (ptr_at(F, I_WS) + (off))
__device__ __forceinline__ float wave_sum(float v) {
#pragma unroll
    for (int o = 1; o < 64; o <<= 1) v += __shfl_xor(v, o);
    return v;
}

__device__ __forceinline__ void tr_item(const float* W, int Nsrc, int nsrc0, int nvalid, int K, const float* gain, bf16* WT, int ndst0, int k0, LAS float* scr, int lane) {
    const int n = lane & 31;
#pragma unroll 8
    for (int i = 0; i < 32; ++i) { const int kk = 2 * i + (lane >> 5); float v = 0.f;
        if (n < nvalid) { v = W[(size_t)(k0 + kk) * Nsrc + nsrc0 + n]; if (gain) v *= gain[k0 + kk]; }
        scr[kk * 33 + n] = v; }
    LDS_WAIT(); asm volatile("" ::: "memory");
    const int c = lane & 7;
#pragma unroll
    for (int j = 0; j < 4; ++j) { const int nn = (lane >> 3) + 8 * j; const LAS float* s = scr + (8 * c) * 33 + nn;
        v4u o; o.x = pk2(s[0 * 33], s[1 * 33]); o.y = pk2(s[2 * 33], s[3 * 33]); o.z = pk2(s[4 * 33], s[5 * 33]); o.w = pk2(s[6 * 33], s[7 * 33]);
        *(GAS v4u*)(WT + (size_t)(ndst0 + nn) * K + k0 + 8 * c) = o; }
    LDS_WAIT(); asm volatile("" ::: "memory");
}
__device__ __forceinline__ void p0_prologue(Frame& F) {
    LAS float* scr = (LAS float*)(F.lds + RING_OFF + F.wave * 16384);
    const int gw = F.bid * NWAVES + F.wave, NGW = F.G * NWAVES;
    constexpr int I_IN = 16 * 80, I_OUT = 16 * 32, I_UP = 16 * 128, I_DN = 64 * 32, I_L = I_IN + I_OUT + I_UP + I_DN;
    {
    const float *w_in = FIN(I_WIN), *mix_g = FIN(I_MIXG), *w_out = FIN(I_WOUT), *w_up = FIN(I_WUP), *mlp_g = FIN(I_MLPG), *w_down = FIN(I_WDOWN);
    bf16 *WIN = (bf16*)FWS(WS_WIN), *WOUT = (bf16*)FWS(WS_WOUT), *WUP = (bf16*)FWS(WS_WUP), *WDOWN = (bf16*)FWS(WS_WDOWN);
    for (int it = gw; it < DEPTH * I_L; it += NGW) {
        const int L = it / I_L; int r = it % I_L;
        if (r < I_IN) {
            const int kb = r / 80, nb = r % 80; int src, nv = 32;
            if (nb < 16) src = nb * 32; else if (nb < 32) src = 768 + (nb - 16) * 32; else if (nb < 36) src = 512 + (nb - 32) * 32; else if (nb < 40) src = 640 + (nb - 36) * 32;
            else if (nb < 72) src = nb * 32; else if (nb == 72) { src = 2304; nv = 8; } else { src = 0; nv = 0; }
            tr_item(w_in + (size_t)L * D * D_IN, D_IN, src, nv, D, mix_g + L * D, WIN + (size_t)L * NPROJ * D, nb * 32, kb * 64, scr, F.lane); continue; }
        r -= I_IN;
        if (r < I_OUT) { const int kb = r / 32, nb = r % 32; tr_item(w_out + (size_t)L * D * D, D, nb * 32, 32, D, nullptr, WOUT + (size_t)L * D * D, nb * 32, kb * 64, scr, F.lane); continue; }
        r -= I_OUT;
        if (r < I_UP) { const int kb = r / 128, nb = r % 128; tr_item(w_up + (size_t)L * D * FF, FF, nb * 32, 32, D, mlp_g + L * D, WUP + (size_t)L * FF * D, nb * 32, kb * 64, scr, F.lane); continue; }
        r -= I_UP;
        { const int kb = r / 32, nb = r % 32; tr_item(w_down + (size_t)L * FF * D, D, nb * 32, 32, FF, nullptr, WDOWN + (size_t)L * D * FF, nb * 32, kb * 64, scr, F.lane); }
    }
    }
    const float* x = FIN(I_X); bf16* XB = (bf16*)FWS(WS_XB); float* SSQ = (float*)FWS(WS_SSQ);
    for (int m = gw; m < M; m += NGW) {
        const GAS f32x4* xr = (const GAS f32x4*)(x + (size_t)m * D) + F.lane;
        f32x4 v[4]; float s = 0.f;
#pragma unroll
        for (int j = 0; j < 4; ++j) { v[j] = xr[64 * j]; s += (v[j].x * v[j].x + v[j].y * v[j].y) + (v[j].z * v[j].z + v[j].w * v[j].w); }
        s = wave_sum(s);
        GAS v2u* o8 = (GAS v2u*)(XB + (size_t)m * D) + F.lane;
#pragma unroll
        for (int j = 0; j < 4; ++j) { v2u o; o.x = pk2(v[j].x, v[j].y); o.y = pk2(v[j].z, v[j].w); o8[64 * j] = o; }
        if (F.lane < 16) SSQ[(size_t)m * 16 + F.lane] = (F.lane == 0) ? s : 0.f;
    }
}
__device__ __forceinline__ void rstd_prepass(Frame& F, const pg8::StaticOrder& S, LAS float* tab) {
    const float* SSQ = (const float*)FWS(WS_SSQ);
    pg8::Unit u;
    for (int i = 0; i < 4 && S.next(i, u); ++i) {
        const int r = F.tid >> 1, h = F.tid & 1;
        const f32x4* p = (const f32x4*)(SSQ + (size_t)(u.pm * 256 + r) * 16 + h * 8);
        const f32x4 a = p[0], b = p[1];
        float s = (a.x + a.y) + (a.z + a.w) + (b.x + b.y) + (b.z + b.w);
        s += __shfl_xor(s, 1);
        if (h == 0) tab[i * 256 + r] = 1.0f / sqrtf(s * (1.0f / D) + EPS);
    }
    LDS_WAIT(); __syncthreads();
}

__device__ __forceinline__ int t5_bucket(int d) {
    if (d < 16) return d;
    return 16 + (d >= 19) + (d >= 21) + (d >= 24) + (d >= 27) + (d >= 31) + (d >= 35) + (d >= 40) + (d >= 46) + (d >= 52) + (d >= 59) + (d >= 67) + (d >= 77) + (d >= 87) + (d >= 99) + (d >= 113);
}
__device__ __forceinline__ void ld8(const bf16* p, float (&v)[8]) {
    const v4u w = *(const v4u*)p;
    v[0] = bflo(w.x); v[1] = bfhi(w.x); v[2] = bflo(w.y); v[3] = bfhi(w.y); v[4] = bflo(w.z); v[5] = bfhi(w.z); v[6] = bflo(w.w); v[7] = bfhi(w.w);
}
__device__ __forceinline__ void attn_naive(Frame& F, int L) {
    const float* qg = FIN(I_QG) + L * 64; const float* kg = FIN(I_KG) + L * 64; const float* sinks = FIN(I_SINK); const float* rel_bias = FIN(I_RELB);
    bf16* PROJ = (bf16*)FWS(WS_PROJ);
    for (int it = F.bid * NTHREADS + F.tid; it < M * 8; it += F.G * NTHREADS) {
        const int m = it >> 3, hq = it & 7, hkv = hq >> 2, t = m & (SEQ - 1);
        bf16* qp = PROJ + (size_t)m * PP + CQ + hq * 64;
        float q[64]; float ss = 0.f;
#pragma unroll
        for (int c = 0; c < 8; ++c) { float v[8]; ld8(qp + 8 * c, v);
#pragma unroll
            for (int e = 0; e < 8; ++e) { q[8 * c + e] = v[e]; ss += v[e] * v[e]; } }
        const float rq = 1.0f / sqrtf(ss * (1.0f / 64.0f) + EPS);
#pragma unroll
        for (int d = 0; d < 64; ++d) q[d] = q[d] * rq * qg[d] * 0.125f * kg[d];
        const float sink = sinks[L * 8 + hq];
        float mrun = sink, l = 1.f; float acc[64];
#pragma unroll
        for (int d = 0; d < 64; ++d) acc[d] = 0.f;
        const int j0 = t - 127 > 0 ? t - 127 : 0;
        for (int j = j0; j <= t; ++j) {
            const bf16* kp = PROJ + (size_t)(m - t + j) * PP + CK + hkv * 64;
            float dot = 0.f, sk = 0.f;
#pragma unroll
            for (int c = 0; c < 8; ++c) { float v[8]; ld8(kp + 8 * c, v);
#pragma unroll
                for (int e = 0; e < 8; ++e) { dot += q[8 * c + e] * v[e]; sk += v[e] * v[e]; } }
            const float s = dot / sqrtf(sk * (1.0f / 64.0f) + EPS) + rel_bias[t5_bucket(t - j) * 8 + hq];
            const float mn = fmaxf(mrun, s), a = expf(mrun - mn), p = expf(s - mn);
            l = l * a + p; mrun = mn;
            const bf16* vp = kp + (CV - CK);
#pragma unroll
            for (int c = 0; c < 8; ++c) { float v[8]; ld8(vp + 8 * c, v);
#pragma unroll
                for (int e = 0; e < 8; ++e) acc[8 * c + e] = acc[8 * c + e] * a + p * v[e]; }
        }
        const float inv = 1.0f / l;
#pragma unroll
        for (int c = 0; c < 8; ++c) { v4u o; o.x = pk2(acc[8 * c] * inv, acc[8 * c + 1] * inv); o.y = pk2(acc[8 * c + 2] * inv, acc[8 * c + 3] * inv);
            o.z = pk2(acc[8 * c + 4] * inv, acc[8 * c + 5] * inv); o.w = pk2(acc[8 * c + 6] * inv, acc[8 * c + 7] * inv); *(v4u*)(qp + 8 * c) = o; }
    }
}
__device__ __forceinline__ void conv_naive(Frame& F, int L) {
    const float* conv_w = FIN(I_CONVW); const float* conv_b = FIN(I_CONVB); const bf16* PROJ = (const bf16*)FWS(WS_PROJ); float* XBCF = (float*)FWS(WS_XBCF);
    for (int it = F.bid * NTHREADS + F.tid; it < M * 128; it += F.G * NTHREADS) {
        const int m = it >> 7, c0 = (it & 127) * 8, t = m & (SEQ - 1);
        float o[8];
#pragma unroll
        for (int e = 0; e < 8; ++e) o[e] = conv_b[L * 1024 + c0 + e];
#pragma unroll
        for (int k = 0; k < 4; ++k) { if (t - 3 + k >= 0) { float v[8]; ld8(PROJ + (size_t)(m - 3 + k) * PP + CX + c0, v);
#pragma unroll
                for (int e = 0; e < 8; ++e) o[e] += conv_w[(size_t)(L * 4 + k) * 1024 + c0 + e] * v[e]; } }
        f32x4 a, b; a.x = silu_f(o[0]); a.y = silu_f(o[1]); a.z = silu_f(o[2]); a.w = silu_f(o[3]); b.x = silu_f(o[4]); b.y = silu_f(o[5]); b.z = silu_f(o[6]); b.w = silu_f(o[7]);
        *(f32x4*)(XBCF + (size_t)m * 1024 + c0) = a; *(f32x4*)(XBCF + (size_t)m * 1024 + c0 + 4) = b;
    }
}
__device__ __forceinline__ void ssd_naive(Frame& F, int L) {
    if (F.wave != 0 || F.bid >= 64) return;
    const int b = F.bid >> 3, hh = F.bid & 7, g = hh >> 2, p = F.lane;
    const float a = -expf(FIN(I_ALOG)[L * 8 + hh]), dtb = FIN(I_DTB)[L * 8 + hh], dsk = FIN(I_DSKIP)[L * 8 + hh];
    const float* DTRAW = (const float*)FWS(WS_DTRAW); const float* XBCF = (const float*)FWS(WS_XBCF); float* YN = (float*)FWS(WS_YN);
    float st[128];
#pragma unroll
    for (int n = 0; n < 128; ++n) st[n] = 0.f;
    for (int t = 0; t < SEQ; ++t) {
        const size_t m = (size_t)b * SEQ + t;
        const float dtv = softplus_f(DTRAW[m * 8 + hh] + dtb), dA = expf(dtv * a), xv = XBCF[m * 1024 + hh * 64 + p], xd = xv * dtv;
        const GAS f32x4* Bp = (const GAS f32x4*)(XBCF + m * 1024 + 512 + g * 128); const GAS f32x4* Cp = (const GAS f32x4*)(XBCF + m * 1024 + 768 + g * 128);
        float y = 0.f;
#pragma unroll
        for (int n4 = 0; n4 < 32; ++n4) { const f32x4 bv = Bp[n4], cv = Cp[n4];
#pragma unroll
            for (int e = 0; e < 4; ++e) { st[4 * n4 + e] = st[4 * n4 + e] * dA + xd * bv[e]; y += cv[e] * st[4 * n4 + e]; } }
        YN[m * 512 + hh * 64 + p] = y + dsk * xv;
    }
}
__device__ __forceinline__ void gate_naive(Frame& F, int L) {
    const int gw = F.bid * NWAVES + F.wave, NGW = F.G * NWAVES;
    const float* ssm_g = FIN(I_SSMG); bf16* PROJ = (bf16*)FWS(WS_PROJ); const float* YN = (const float*)FWS(WS_YN);
    for (int it = gw; it < M * 2; it += NGW) {
        const int m = it >> 1, g = it & 1, ch = g * 256 + 4 * F.lane;
        const f32x4 y = *(const f32x4*)(YN + (size_t)m * 512 + ch);
        bf16* zp = PROJ + (size_t)m * PP + CZ + ch;
        const v2u zw = *(const v2u*)zp;
        float v[4]; v[0] = y.x * silu_f(bflo(zw.x)); v[1] = y.y * silu_f(bfhi(zw.x)); v[2] = y.z * silu_f(bflo(zw.y)); v[3] = y.w * silu_f(bfhi(zw.y));
        const float ss = wave_sum((v[0] * v[0] + v[1] * v[1]) + (v[2] * v[2] + v[3] * v[3]));
        const float r = 1.0f / sqrtf(ss * (1.0f / 256.0f) + EPS);
        const float* ng = ssm_g + L * 512 + ch;
        v2u o; o.x = pk2(v[0] * r * ng[0], v[1] * r * ng[1]); o.y = pk2(v[2] * r * ng[2], v[3] * r * ng[3]);
        *(v2u*)zp = o;
    }
}

typedef short bf16x8_t __attribute__((ext_vector_type(8)));
typedef float f32x16 __attribute__((ext_vector_type(16)));
constexpr float LOG2E = 1.4426950408889634f;
constexpr int AT_KS = 0, AT_KSTRIDE = 144, AT_VT = 36864, AT_VSTRIDE = 520, AT_BIAS = AT_VT + 64 * AT_VSTRIDE, AT_END = AT_BIAS + 2048;
static_assert(AT_END <= RING_BYTES, "attention LDS");
__device__ __forceinline__ unsigned pkbf(float lo, float hi) { return pg8::cvt_pk_bf16(lo, hi); }
__device__ __forceinline__ void attn_fast(Frame& F, int L) {
    bf16* PROJ = (bf16*)FWS(WS_PROJ);
    const float* qg = FIN(I_QG) + L * 64; const float* kg = FIN(I_KG) + L * 64; const float* sinks = FIN(I_SINK) + L * 8; const float* rel_bias = FIN(I_RELB);
    LAS unsigned char* Ks = F.lds + AT_KS; LAS unsigned char* Vt = F.lds + AT_VT; LAS float* biasT = (LAS float*)(F.lds + AT_BIAS);
    const int tid = F.tid, lane = F.lane, wave = F.wave, q = lane & 31, hh = lane >> 5;
    for (int unit = F.bid; unit < BATCH * 2 * 16; unit += F.G) {
        const int b = unit >> 5, kvh = (unit >> 4) & 1, qb = unit & 15;
        const size_t m0 = (size_t)b * SEQ + qb * 128;
        __syncthreads();
        { const int gi = tid >> 7, dist = tid & 127; biasT[tid] = rel_bias[t5_bucket(dist) * 8 + kvh * 4 + gi] * LOG2E; }
#pragma unroll
        for (int i = 0; i < 4; ++i) {
            const int c = tid + NTHREADS * i, key = c >> 3, part = c & 7;
            const bool valid = (qb > 0) || (key >= 128);
            v4u kw = {0u, 0u, 0u, 0u}, vw = {0u, 0u, 0u, 0u};
            if (valid) { const bf16* kp = PROJ + (m0 + key - 128) * PP + CK + kvh * 64 + part * 8; kw = *(const v4u*)kp; vw = *(const v4u*)(kp + (CV - CK)); }
            float kv[8]; kv[0] = bflo(kw.x); kv[1] = bfhi(kw.x); kv[2] = bflo(kw.y); kv[3] = bfhi(kw.y); kv[4] = bflo(kw.z); kv[5] = bfhi(kw.z); kv[6] = bflo(kw.w); kv[7] = bfhi(kw.w);
            float ss = 0.f;
#pragma unroll
            for (int e = 0; e < 8; ++e) ss += kv[e] * kv[e];
            ss += __shfl_xor(ss, 1); ss += __shfl_xor(ss, 2); ss += __shfl_xor(ss, 4);
            const float rk = 1.0f / sqrtf(ss * (1.0f / 64.0f) + EPS);
            const f32x4 g0 = *(const f32x4*)(kg + part * 8), g1 = *(const f32x4*)(kg + part * 8 + 4);
            v4u ko; ko.x = pkbf(kv[0] * rk * g0.x, kv[1] * rk * g0.y); ko.y = pkbf(kv[2] * rk * g0.z, kv[3] * rk * g0.w); ko.z = pkbf(kv[4] * rk * g1.x, kv[5] * rk * g1.y); ko.w = pkbf(kv[6] * rk * g1.z, kv[7] * rk * g1.w);
            *(LAS v4u*)(Ks + key * AT_KSTRIDE + part * 16) = ko;
            LAS unsigned short* vt = (LAS unsigned short*)(Vt + (part * 8) * AT_VSTRIDE + key * 2);
            vt[0 * (AT_VSTRIDE / 2)] = (unsigned short)(vw.x & 0xffffu); vt[1 * (AT_VSTRIDE / 2)] = (unsigned short)(vw.x >> 16);
            vt[2 * (AT_VSTRIDE / 2)] = (unsigned short)(vw.y & 0xffffu); vt[3 * (AT_VSTRIDE / 2)] = (unsigned short)(vw.y >> 16);
            vt[4 * (AT_VSTRIDE / 2)] = (unsigned short)(vw.z & 0xffffu); vt[5 * (AT_VSTRIDE / 2)] = (unsigned short)(vw.z >> 16);
            vt[6 * (AT_VSTRIDE / 2)] = (unsigned short)(vw.w & 0xffffu); vt[7 * (AT_VSTRIDE / 2)] = (unsigned short)(vw.w >> 16);
        }
        LDS_WAIT(); __syncthreads();
        const int gi = wave >> 1, qh = wave & 1, hq = kvh * 4 + gi;
        const float sink2 = sinks[hq] * LOG2E;
#pragma unroll 1
        for (int s = 0; s < 2; ++s) {
            const int a = 64 * qh + 32 * s;
            bf16* qrow = PROJ + (m0 + a + q) * PP + CQ + hq * 64;
            float qv[4][8]; float ss = 0.f;
#pragma unroll
            for (int d0 = 0; d0 < 4; ++d0) { ld8(qrow + d0 * 16 + hh * 8, qv[d0]);
#pragma unroll
                for (int e = 0; e < 8; ++e) ss += qv[d0][e] * qv[d0][e]; }
            ss += __shfl_xor(ss, 32);
            const float rq = (1.0f / sqrtf(ss * (1.0f / 64.0f) + EPS)) * (0.125f * LOG2E);
            bf16x8_t qf[4];
#pragma unroll
            for (int d0 = 0; d0 < 4; ++d0) { const f32x4 g0 = *(const f32x4*)(qg + d0 * 16 + hh * 8), g1 = *(const f32x4*)(qg + d0 * 16 + hh * 8 + 4);
                v4u w; w.x = pkbf(qv[d0][0] * rq * g0.x, qv[d0][1] * rq * g0.y); w.y = pkbf(qv[d0][2] * rq * g0.z, qv[d0][3] * rq * g0.w);
                w.z = pkbf(qv[d0][4] * rq * g1.x, qv[d0][5] * rq * g1.y); w.w = pkbf(qv[d0][6] * rq * g1.z, qv[d0][7] * rq * g1.w);
                qf[d0] = __builtin_bit_cast(bf16x8_t, w); }
            f32x16 S[5];
#pragma unroll
            for (int kt = 0; kt < 5; ++kt) { f32x16 acc = {};
#pragma unroll
                for (int d0 = 0; d0 < 4; ++d0) { const bf16x8_t kf = *(const LAS bf16x8_t*)(Ks + (a + 32 * kt + q) * AT_KSTRIDE + d0 * 32 + hh * 16);
                    acc = __builtin_amdgcn_mfma_f32_32x32x16_bf16(kf, qf[d0], acc, 0, 0, 0); }
                S[kt] = acc; }
            float mx = sink2;
#pragma unroll
            for (int kt = 0; kt < 5; ++kt)
#pragma unroll
                for (int i = 0; i < 16; ++i) { const int cr = (i & 3) + 8 * (i >> 2) + 4 * hh, dist = 128 + q - 32 * kt - cr, kidx = a + 32 * kt + cr;
                    const bool ok = (dist >= 0) && (dist < 128) && ((qb > 0) || (kidx >= 128));
                    const float v = ok ? S[kt][i] + biasT[gi * 128 + (dist & 127)] : -INFINITY;
                    S[kt][i] = v; mx = fmaxf(mx, v); }
            mx = fmaxf(mx, __shfl_xor(mx, 32));
            float lsum = 0.f; bf16x8_t pf[5][2];
#pragma unroll
            for (int kt = 0; kt < 5; ++kt) {
#pragma unroll
                for (int i = 0; i < 16; ++i) { const float p = __builtin_amdgcn_exp2f(S[kt][i] - mx); S[kt][i] = p; lsum += p; }
#pragma unroll
                for (int s2 = 0; s2 < 2; ++s2) { v4u w; w.x = pkbf(S[kt][8 * s2 + 0], S[kt][8 * s2 + 1]); w.y = pkbf(S[kt][8 * s2 + 2], S[kt][8 * s2 + 3]);
                    w.z = pkbf(S[kt][8 * s2 + 4], S[kt][8 * s2 + 5]); w.w = pkbf(S[kt][8 * s2 + 6], S[kt][8 * s2 + 7]); pf[kt][s2] = __builtin_bit_cast(bf16x8_t, w); } }
            lsum += __shfl_xor(lsum, 32);
            lsum += __builtin_amdgcn_exp2f(sink2 - mx);
            f32x16 O[2] = {{}, {}};
#pragma unroll
            for (int kt = 0; kt < 5; ++kt)
#pragma unroll
                for (int s2 = 0; s2 < 2; ++s2)
#pragma unroll
                    for (int db = 0; db < 2; ++db) { const LAS unsigned char* vb = Vt + (32 * db + q) * AT_VSTRIDE + (a + 32 * kt + 16 * s2 + 4 * hh) * 2;
                        const v2u lo = *(const LAS v2u*)vb, hi2 = *(const LAS v2u*)(vb + 16); v4u w; w.x = lo.x; w.y = lo.y; w.z = hi2.x; w.w = hi2.y;
                        O[db] = __builtin_amdgcn_mfma_f32_32x32x16_bf16(__builtin_bit_cast(bf16x8_t, w), pf[kt][s2], O[db], 0, 0, 0); }
            const float inv = 1.0f / lsum;
#pragma unroll
            for (int db = 0; db < 2; ++db)
#pragma unroll
                for (int g4 = 0; g4 < 4; ++g4) { v2u w; w.x = pkbf(O[db][4 * g4] * inv, O[db][4 * g4 + 1] * inv); w.y = pkbf(O[db][4 * g4 + 2] * inv, O[db][4 * g4 + 3] * inv);
                    *(v2u*)(qrow + 32 * db + 8 * g4 + 4 * hh) = w; }
        }
    }
}

constexpr size_t WS_ACS = 2 * MiB + 512 * 1024, WS_CHDEC = 3 * MiB;
constexpr size_t WS_STATES = 154 * MiB, WS_YPART = 186 * MiB, WS_CC = 218 * MiB, WS_PREV = 226 * MiB;
constexpr int SD_CM = 0, SD_BM = 34816, SD_BMT = 69632, SD_DT = 104448, SD_ACS = SD_DT + 2048, SD_WT = SD_ACS + 2048, SD_END = SD_WT + 64;
constexpr int SD_ROW = 272, SD_XT = 264, SD_HIMG = 64 * SD_XT + 64 * SD_ROW;
static_assert(2 * SD_HIMG <= SD_BMT && SD_END <= RING_BYTES, "SSD LDS map");
__device__ __forceinline__ int crow32(int i, int hh) { return (i & 3) + 8 * (i >> 2) + 4 * hh; }
__device__ __forceinline__ void conv8x4(const bf16* PROJ, size_t m0, int c, int l0, int col0, const float* cw, const float* cbias, float (&out)[4][8]) {
    float w[4][8], bs[8], u[7][8];
#pragma unroll
    for (int k = 0; k < 4; ++k) { const f32x4 a = *(const f32x4*)(cw + k * 1024), b = *(const f32x4*)(cw + k * 1024 + 4); w[k][0] = a.x; w[k][1] = a.y; w[k][2] = a.z; w[k][3] = a.w; w[k][4] = b.x; w[k][5] = b.y; w[k][6] = b.z; w[k][7] = b.w; }
    { const f32x4 a = *(const f32x4*)cbias, b = *(const f32x4*)(cbias + 4); bs[0] = a.x; bs[1] = a.y; bs[2] = a.z; bs[3] = a.w; bs[4] = b.x; bs[5] = b.y; bs[6] = b.z; bs[7] = b.w; }
#pragma unroll
    for (int i = 0; i < 7; ++i) { const int row = l0 - 3 + i;
        if (c > 0 || row >= 0) ld8(PROJ + (size_t)((long)m0 + row) * PP + col0, u[i]);
        else {
#pragma unroll
            for (int e = 0; e < 8; ++e) u[i][e] = 0.f; } }
#pragma unroll
    for (int r = 0; r < 4; ++r)
#pragma unroll
        for (int e = 0; e < 8; ++e) out[r][e] = silu_f(bs[e] + w[0][e] * u[r][e] + w[1][e] * u[r + 1][e] + w[2][e] * u[r + 2][e] + w[3][e] * u[r + 3][e]);
}
__device__ __forceinline__ void ssd1_fast(Frame& F, int L) {
    const bf16* PROJ = (const bf16*)FWS(WS_PROJ);
    const float* conv_w = FIN(I_CONVW) + (size_t)L * 4 * 1024; const float* conv_b = FIN(I_CONVB) + L * 1024;
    const float* dt_bias = FIN(I_DTB) + L * 8; const float* a_log = FIN(I_ALOG) + L * 8; const float* d_skip = FIN(I_DSKIP) + L * 8;
    const float* DTRAW = (const float*)FWS(WS_DTRAW); float* ACS = (float*)FWS(WS_ACS); float* CHDEC = (float*)FWS(WS_CHDEC);
    float* STATES = (float*)FWS(WS_STATES); float* YPART = (float*)FWS(WS_YPART); bf16* CC = (bf16*)FWS(WS_CC);
    LAS unsigned char* Cm = F.lds + SD_CM; LAS unsigned char* Bm = F.lds + SD_BM; LAS unsigned char* BmT = F.lds + SD_BMT;
    LAS float* dt_l = (LAS float*)(F.lds + SD_DT); LAS float* acs_l = (LAS float*)(F.lds + SD_ACS); LAS float* wt = (LAS float*)(F.lds + SD_WT);
    const int wave = F.wave;
    for (int unit = F.bid; unit < BATCH * 16 * 2; unit += F.G) {
        const int b = unit >> 5, c = (unit >> 1) & 15, g = unit & 1;
        const size_t m0 = (size_t)b * SEQ + c * 128;
        int tid = F.tid; asm volatile("" : "+v"(tid));
        int lane = tid & 63, q = lane & 31, hh = lane >> 5;
        __syncthreads();
        { const int r = tid >> 7, l = tid & 127, head = 4 * g + r;
          const float dtv = softplus_f(DTRAW[(m0 + l) * 8 + head] + dt_bias[head]);
          float v = dtv * (-expf(a_log[head]));
#pragma unroll
          for (int o = 1; o < 64; o <<= 1) { const float t = __shfl_up(v, o); if (lane >= o) v += t; }
          if (lane == 63) wt[wave] = v;
          LDS_WAIT(); __syncthreads();
          if (wave & 1) v += wt[wave - 1];
          dt_l[tid] = dtv; acs_l[tid] = v; ACS[(m0 + l) * 8 + head] = v;
          if (l == 127) CHDEC[(size_t)(b * 16 + c) * 8 + head] = expf(v); }
#pragma unroll 1
        for (int it = tid; it < 1024; it += NTHREADS) {
            const int cg = it & 31, rg = it >> 5, isC = cg >> 4, n0 = (cg & 15) * 8, col0 = (isC ? CCM : CBM) + g * 128 + n0, l0 = 4 * rg;
            float o[4][8];
            conv8x4(PROJ, m0, c, l0, col0, conv_w + (col0 - CX), conv_b + (col0 - CX), o);
#pragma unroll
            for (int r = 0; r < 4; ++r) { const int l = l0 + r;
                v4u pk; pk.x = pkbf(o[r][0], o[r][1]); pk.y = pkbf(o[r][2], o[r][3]); pk.z = pkbf(o[r][4], o[r][5]); pk.w = pkbf(o[r][6], o[r][7]);
                *(LAS v4u*)((isC ? Cm : Bm) + l * SD_ROW + n0 * 2) = pk;
                if (isC) *(v4u*)(CC + (m0 + l) * 256 + g * 128 + n0) = pk;
                else { LAS unsigned short* t = (LAS unsigned short*)(BmT + n0 * SD_ROW + l * 2);
                    t[0 * (SD_ROW / 2)] = (unsigned short)(pk.x & 0xffffu); t[1 * (SD_ROW / 2)] = (unsigned short)(pk.x >> 16); t[2 * (SD_ROW / 2)] = (unsigned short)(pk.y & 0xffffu); t[3 * (SD_ROW / 2)] = (unsigned short)(pk.y >> 16);
                    t[4 * (SD_ROW / 2)] = (unsigned short)(pk.z & 0xffffu); t[5 * (SD_ROW / 2)] = (unsigned short)(pk.z >> 16); t[6 * (SD_ROW / 2)] = (unsigned short)(pk.w & 0xffffu); t[7 * (SD_ROW / 2)] = (unsigned short)(pk.w >> 16); } }
        }
        LDS_WAIT(); __syncthreads();
        asm volatile("" : "+v"(tid)); lane = tid & 63; q = lane & 31; hh = lane >> 5;
        const int j = (wave < 4) ? (wave & 3) : 3 - (wave & 3);
        f32x16 cbT[4];
        { bf16x8_t cf[8];
#pragma unroll
          for (int ks = 0; ks < 8; ++ks) cf[ks] = *(const LAS bf16x8_t*)(Cm + (32 * j + q) * SD_ROW + (16 * ks + 8 * hh) * 2);
#pragma unroll
          for (int i = 0; i < 4; ++i) { f32x16 acc = {};
              if (i <= j) {
#pragma unroll
                  for (int ks = 0; ks < 8; ++ks) { const bf16x8_t bfr = *(const LAS bf16x8_t*)(Bm + (32 * i + q) * SD_ROW + (16 * ks + 8 * hh) * 2);
                      acc = __builtin_amdgcn_mfma_f32_32x32x16_bf16(bfr, cf[ks], acc, 0, 0, 0); } }
              cbT[i] = acc; } }
#pragma unroll 1
        for (int hp = 0; hp < 2; ++hp) {
            __syncthreads();
            asm volatile("" : "+v"(tid)); lane = tid & 63; q = lane & 31; hh = lane >> 5;
            { const int cg = tid & 15, rg = tid >> 4, h2 = cg >> 3, p0 = (cg & 7) * 8, r = 2 * hp + h2, col0 = CX + (4 * g + r) * 64 + p0, l0 = 4 * rg;
              float o[4][8];
              conv8x4(PROJ, m0, c, l0, col0, conv_w + (col0 - CX), conv_b + (col0 - CX), o);
              LAS unsigned char* T1 = F.lds + h2 * SD_HIMG; LAS unsigned char* T2 = T1 + 64 * SD_XT;
              const float aend = acs_l[r * 128 + 127];
#pragma unroll
              for (int rr = 0; rr < 4; ++rr) { const int l = l0 + rr; const float dtv = dt_l[r * 128 + l], wl = expf(aend - acs_l[r * 128 + l]);
#pragma unroll
                  for (int e = 0; e < 8; ++e) { const float xd = o[rr][e] * dtv;
                      *(LAS unsigned short*)(T1 + (p0 + e) * SD_XT + l * 2) = (unsigned short)f2bf(xd);
                      *(LAS unsigned short*)(T2 + (p0 + e) * SD_ROW + l * 2) = (unsigned short)f2bf(xd * wl); } } }
            LDS_WAIT(); __syncthreads();
            asm volatile("" : "+v"(tid)); lane = tid & 63; q = lane & 31; hh = lane >> 5;
            const int h2 = wave >> 2, r = 2 * hp + h2, head = 4 * g + r;
            const LAS unsigned char* T1 = F.lds + h2 * SD_HIMG; const LAS unsigned char* T2 = T1 + 64 * SD_XT;
            {
              const float acl = acs_l[r * 128 + 32 * j + q], diag = d_skip[head] / dt_l[r * 128 + 32 * j + q];
              f32x16 O[2] = {{}, {}};
#pragma unroll
              for (int i = 0; i < 4; ++i) { if (i <= j) {
                  int qq = q; asm volatile("" : "+v"(qq));
                  float xv[16];
#pragma unroll
                  for (int e = 0; e < 16; ++e) { const int cr = crow32(e, hh); const float dec = __builtin_amdgcn_exp2f((acl - acs_l[r * 128 + 32 * i + cr]) * LOG2E);
                      const bool ok = (i < j) || (cr <= qq);
                      float v = ok ? cbT[i][e] * dec : 0.f;
                      if (i == j && cr == qq) v += diag;
                      xv[e] = v; }
#pragma unroll
                  for (int s2 = 0; s2 < 2; ++s2) { v4u w; w.x = pkbf(xv[8 * s2 + 0], xv[8 * s2 + 1]); w.y = pkbf(xv[8 * s2 + 2], xv[8 * s2 + 3]); w.z = pkbf(xv[8 * s2 + 4], xv[8 * s2 + 5]); w.w = pkbf(xv[8 * s2 + 6], xv[8 * s2 + 7]);
                      const bf16x8_t xf = __builtin_bit_cast(bf16x8_t, w);
#pragma unroll
                      for (int pt = 0; pt < 2; ++pt) { const LAS unsigned char* ab = T1 + (32 * pt + q) * SD_XT + (32 * i + 16 * s2 + 4 * hh) * 2;
                          const v2u lo = *(const LAS v2u*)ab, hi2 = *(const LAS v2u*)(ab + 16); v4u aw; aw.x = lo.x; aw.y = lo.y; aw.z = hi2.x; aw.w = hi2.y;
                          O[pt] = __builtin_amdgcn_mfma_f32_32x32x16_bf16(__builtin_bit_cast(bf16x8_t, aw), xf, O[pt], 0, 0, 0); } } } }
              float* yp = YPART + (m0 + 32 * j + q) * 512 + head * 64;
#pragma unroll
              for (int pt = 0; pt < 2; ++pt)
#pragma unroll
                  for (int g4 = 0; g4 < 4; ++g4) { f32x4 v; v.x = O[pt][4 * g4]; v.y = O[pt][4 * g4 + 1]; v.z = O[pt][4 * g4 + 2]; v.w = O[pt][4 * g4 + 3];
                      *(f32x4*)(yp + 32 * pt + 8 * g4 + 4 * hh) = v; } }
            asm volatile("" : "+v"(tid)); lane = tid & 63; q = lane & 31; hh = lane >> 5;
            {
              const int nt = wave & 3;
              f32x16 St[2] = {{}, {}};
#pragma unroll
              for (int ks = 0; ks < 8; ++ks) { const bf16x8_t bfr = *(const LAS bf16x8_t*)(BmT + (32 * nt + q) * SD_ROW + (16 * ks + 8 * hh) * 2);
#pragma unroll
                  for (int pt = 0; pt < 2; ++pt) { const bf16x8_t af = *(const LAS bf16x8_t*)(T2 + (32 * pt + q) * SD_ROW + (16 * ks + 8 * hh) * 2);
                      St[pt] = __builtin_amdgcn_mfma_f32_32x32x16_bf16(af, bfr, St[pt], 0, 0, 0); } }
              float* sp = STATES + ((size_t)(b * 16 + c) * 8 + head) * 8192 + 32 * nt + q;
#pragma unroll
              for (int pt = 0; pt < 2; ++pt)
#pragma unroll
                  for (int e = 0; e < 16; ++e) sp[(32 * pt + crow32(e, hh)) * 128] = St[pt][e]; }
        }
    }
}
__device__ __forceinline__ void ssd2_scan(Frame& F, int L) {
    const float* STATES = (const float*)FWS(WS_STATES); const float* CHDEC = (const float*)FWS(WS_CHDEC); bf16* PREV = (bf16*)FWS(WS_PREV);
    for (int idx = F.bid * NTHREADS + F.tid; idx < BATCH * 8 * 64 * 32; idx += F.G * NTHREADS) {
        const int n4 = idx & 31, p = (idx >> 5) & 63, head = (idx >> 11) & 7, b = idx >> 14;
        f32x4 s[16]; float dec[16];
#pragma unroll
        for (int c = 0; c < 16; ++c) { const size_t o = ((size_t)(b * 16 + c) * 8 + head) * 8192 + p * 128 + 4 * n4; s[c] = *(const f32x4*)(STATES + o); dec[c] = CHDEC[(size_t)(b * 16 + c) * 8 + head]; }
        f32x4 h = {0.f, 0.f, 0.f, 0.f};
#pragma unroll
        for (int c = 0; c < 16; ++c) { const size_t o = ((size_t)(b * 16 + c) * 8 + head) * 8192 + p * 128 + 4 * n4;
            v2u w; w.x = pkbf(h.x, h.y); w.y = pkbf(h.z, h.w); *(v2u*)(PREV + o) = w;
            h = h * dec[c] + s[c]; }
    }
}
__device__ __forceinline__ void ssd3_fast(Frame& F, int L) {
    bf16* PROJ = (bf16*)FWS(WS_PROJ); const bf16* PREV = (const bf16*)FWS(WS_PREV); const bf16* CC = (const bf16*)FWS(WS_CC);
    const float* YPART = (const float*)FWS(WS_YPART); const float* ACS = (const float*)FWS(WS_ACS); const float* ssm_g = FIN(I_SSMG) + L * 512;
    LAS float* exch = (LAS float*)(F.lds);
    const int lane = F.lane, wave = F.wave, q = lane & 31, hh = lane >> 5;
    for (int unit = F.bid; unit < BATCH * 16 * 2; unit += F.G) {
        const int b = unit >> 5, c = (unit >> 1) & 15, g = unit & 1;
        const size_t m0 = (size_t)b * SEQ + c * 128;
        const int j = wave & 3, hp = wave >> 2;
        const size_t row = m0 + 32 * j + q;
        bf16x8_t cf[8];
#pragma unroll
        for (int ks = 0; ks < 8; ++ks) cf[ks] = *(const bf16x8_t*)(CC + row * 256 + g * 128 + 16 * ks + 8 * hh);
        float v[2][2][16]; float ss = 0.f;
#pragma unroll
        for (int h2 = 0; h2 < 2; ++h2) { const int head = 4 * g + 2 * hp + h2;
            const bf16* pv = PREV + ((size_t)(b * 16 + c) * 8 + head) * 8192;
            f32x16 O[2] = {{}, {}};
#pragma unroll
            for (int ks = 0; ks < 8; ++ks)
#pragma unroll
                for (int pt = 0; pt < 2; ++pt) { const bf16x8_t af = *(const bf16x8_t*)(pv + (32 * pt + q) * 128 + 16 * ks + 8 * hh);
                    O[pt] = __builtin_amdgcn_mfma_f32_32x32x16_bf16(af, cf[ks], O[pt], 0, 0, 0); }
            const float ea = expf(ACS[row * 8 + head]);
#pragma unroll
            for (int pt = 0; pt < 2; ++pt)
#pragma unroll
                for (int g4 = 0; g4 < 4; ++g4) { const int p = 32 * pt + 8 * g4 + 4 * hh;
                    const f32x4 yp = *(const f32x4*)(YPART + row * 512 + head * 64 + p);
                    const v2u zw = *(const v2u*)(PROJ + row * PP + CZ + head * 64 + p);
                    const float y0 = yp.x + ea * O[pt][4 * g4], y1 = yp.y + ea * O[pt][4 * g4 + 1], y2 = yp.z + ea * O[pt][4 * g4 + 2], y3 = yp.w + ea * O[pt][4 * g4 + 3];
                    const float u0 = y0 * silu_f(bflo(zw.x)), u1 = y1 * silu_f(bfhi(zw.x)), u2 = y2 * silu_f(bflo(zw.y)), u3 = y3 * silu_f(bfhi(zw.y));
                    v[h2][pt][4 * g4] = u0; v[h2][pt][4 * g4 + 1] = u1; v[h2][pt][4 * g4 + 2] = u2; v[h2][pt][4 * g4 + 3] = u3;
                    ss += (u0 * u0 + u1 * u1) + (u2 * u2 + u3 * u3); } }
        ss += __shfl_xor(ss, 32);
        __syncthreads();
        if (hh == 0) exch[hp * 128 + 32 * j + q] = ss;
        LDS_WAIT(); __syncthreads();
        const float tot = exch[32 * j + q] + exch[128 + 32 * j + q];
        const float rn = 1.0f / sqrtf(tot * (1.0f / 256.0f) + EPS);
#pragma unroll
        for (int h2 = 0; h2 < 2; ++h2) { const int head = 4 * g + 2 * hp + h2;
#pragma unroll
            for (int pt = 0; pt < 2; ++pt)
#pragma unroll
                for (int g4 = 0; g4 < 4; ++g4) { const int p = 32 * pt + 8 * g4 + 4 * hh;
                    const f32x4 ng = *(const f32x4*)(ssm_g + head * 64 + p);
                    v2u w; w.x = pkbf(v[h2][pt][4 * g4] * rn * ng.x, v[h2][pt][4 * g4 + 1] * rn * ng.y); w.y = pkbf(v[h2][pt][4 * g4 + 2] * rn * ng.z, v[h2][pt][4 * g4 + 3] * rn * ng.w);
                    *(v2u*)(PROJ + row * PP + CZ + head * 64 + p) = w; } }
    }
}

__device__ __forceinline__ void ph_inproj(Frame& F, int L) {
    LAS float* rstd_tab = (LAS float*)(F.lds + RSTD_OFF);
    int bid_ = F.bid; asm volatile("" : "+s"(bid_)); pg8::StaticOrder S; S.init(M, NPROJ, F.G, bid_);
    rstd_prepass(F, S, rstd_tab);
    pg8::Gemm g{(const bf16*)FWS(WS_XB), (const bf16*)FWS(WS_WIN) + (size_t)L * NPROJ * D, M, NPROJ, D, D};
    pg8::EpiProj E{(bf16*)FWS(WS_PROJ), (float*)FWS(WS_DTRAW), (const LAS float*)rstd_tab};
    pg8::gemm_phase<pg8::EpiProj, pg8::StaticOrder, true, true>(F.lds + RING_OFF, g, S, E);
}
__device__ __forceinline__ void ph_outproj(Frame& F, int L) {
    int bid_ = F.bid; asm volatile("" : "+s"(bid_)); pg8::StaticOrder S; S.init(M, D, F.G, bid_);
    pg8::Gemm g{(const bf16*)FWS(WS_PROJ), (const bf16*)FWS(WS_WOUT) + (size_t)L * D * D, M, D, D, PP};
    float* out = (float*)ptr_at(F, I_OUT);
    pg8::EpiRes E{L == 0 ? FIN(I_X) : (const float*)out, out, (bf16*)FWS(WS_XB), (float*)FWS(WS_SSQ)};
    pg8::gemm_phase<pg8::EpiRes, pg8::StaticOrder, false, true>(F.lds + RING_OFF, g, S, E);
}
__device__ __forceinline__ void ph_up(Frame& F, int L) {
    LAS float* rstd_tab = (LAS float*)(F.lds + RSTD_OFF);
    int bid_ = F.bid; asm volatile("" : "+s"(bid_)); pg8::StaticOrder S; S.init(M, FF, F.G, bid_);
    rstd_prepass(F, S, rstd_tab);
    pg8::Gemm g{(const bf16*)FWS(WS_XB), (const bf16*)FWS(WS_WUP) + (size_t)L * FF * D, M, FF, D, D};
    pg8::EpiUp E{(bf16*)FWS(WS_HID), FF, (const LAS float*)rstd_tab};
    pg8::gemm_phase<pg8::EpiUp, pg8::StaticOrder, true, true>(F.lds + RING_OFF, g, S, E);
}
__device__ __forceinline__ void ph_down(Frame& F, int L) {
    int bid_ = F.bid; asm volatile("" : "+s"(bid_)); pg8::StaticOrder S; S.init(M, D, F.G, bid_);
    pg8::Gemm g{(const bf16*)FWS(WS_HID), (const bf16*)FWS(WS_WDOWN) + (size_t)L * D * FF, M, D, FF, FF};
    float* out = (float*)ptr_at(F, I_OUT);
    pg8::EpiRes E{(const float*)out, out, (bf16*)FWS(WS_XB), (float*)FWS(WS_SSQ)};
    pg8::gemm_phase<pg8::EpiRes, pg8::StaticOrder, false, true>(F.lds + RING_OFF, g, S, E);
}

struct Args { const float* in[17]; float* out; unsigned char* ws; int ph_lo, ph_hi; };
#define FRAME_INIT() \
    extern __shared__ __attribute__((aligned(16))) unsigned char lds[]; \
    Frame F; \
    F.lds = (LAS unsigned char*)lds; \
    F.tid = threadIdx.x; F.lane = F.tid & 63; F.wave = __builtin_amdgcn_readfirstlane(F.tid >> 6); F.bid = blockIdx.x; F.G = gridDim.x; \
    for (int u = F.tid; u < (LDS_BYTES - LDSCTL_OFF) / 4; u += NTHREADS) ((LAS unsigned*)(F.lds + LDSCTL_OFF))[u] = 0u; \
    __syncthreads(); \
    if (F.tid < I_NPTR) { const unsigned long long p = F.tid < 17 ? (unsigned long long)args.in[F.tid < 17 ? F.tid : 0] : (F.tid == I_OUT ? (unsigned long long)args.out : (unsigned long long)args.ws); \
        LAS unsigned* t = (LAS unsigned*)(F.lds + PTR_OFF) + 2 * F.tid; t[0] = (unsigned)p; t[1] = (unsigned)(p >> 32); } \
    LDS_WAIT(); __syncthreads();

#if !ONE_LAUNCH
__global__ void __launch_bounds__(NTHREADS, 2) k_mix1_naive(Args args) { FRAME_INIT(); attn_naive(F, args.ph_lo); conv_naive(F, args.ph_lo); }
__global__ void __launch_bounds__(NTHREADS, 2) k_mix2_naive(Args args) { FRAME_INIT(); ssd_naive(F, args.ph_lo); }
__global__ void __launch_bounds__(NTHREADS, 2) k_mix3_naive(Args args) { FRAME_INIT(); gate_naive(F, args.ph_lo); }
#endif
#define PH_MIX1(F, L) do { attn_fast(F, L); ssd1_fast(F, L); } while (0)
#define PH_MIX2(F, L) ssd2_scan(F, L)
#define PH_MIX3(F, L) ssd3_fast(F, L)

__global__ void __launch_bounds__(NTHREADS, 2) fwd(Args args) {
    FRAME_INIT();
    const int lo = args.ph_lo, hi = args.ph_hi;
#if ONE_LAUNCH
    XcdBarrier bar = xcd_barrier_post((unsigned*)(FWS(WS_CTL)) + CW_BAR, (volatile LAS unsigned*)(F.lds + MISC_OFF) + 8);
#define GRID_BAR() xcd_barrier(bar)
#else
#define GRID_BAR() do {} while (0)
#endif
#define IN(k) (lo <= (k) && (k) < hi)
#define RELAUNDER() do { int t_ = threadIdx.x; asm volatile("" : "+v"(t_)); F.tid = t_; F.lane = t_ & 63; F.wave = __builtin_amdgcn_readfirstlane(t_ >> 6); \
    int b_ = blockIdx.x; asm volatile("" : "+s"(b_)); F.bid = b_; } while (0)
#define SEAM(k) do { if (IN(k) && IN((k) + 1)) GRID_BAR(); } while (0)

    if (IN(0)) { p0_prologue(F); SEAM(0); }
    for (int L = 0; L < DEPTH; ++L) {
        const int pb = 1 + 7 * L;
        if (IN(pb + 0)) { RELAUNDER(); ph_inproj(F, L); SEAM(pb + 0); }
        if (IN(pb + 1)) { RELAUNDER(); PH_MIX1(F, L); SEAM(pb + 1); }
        if (IN(pb + 2)) { RELAUNDER(); PH_MIX2(F, L); SEAM(pb + 2); }
        if (IN(pb + 3)) { RELAUNDER(); PH_MIX3(F, L); SEAM(pb + 3); }
        if (IN(pb + 4)) { RELAUNDER(); ph_outproj(F, L); SEAM(pb + 4); }
        if (IN(pb + 5)) { RELAUNDER(); ph_up(F, L); SEAM(pb + 5); }
        if (IN(pb + 6)) { RELAUNDER(); ph_down(F, L); SEAM(pb + 6); }
    }
#undef IN
#undef SEAM
}

extern "C" void kernel_launch(void* const* d_in, const int* in_sizes, int n_in, void* d_out, int out_size, void* d_ws, size_t ws_size, hipStream_t stream) {
    static int grid = 0;
    if (grid == 0) {
        if (n_in != 17 || in_sizes[0] != M * D || out_size != M * D || ws_size < WS_END) { fprintf(stderr, "kernel_launch: unexpected shapes (n_in %d, in0 %d, out %d, ws %zu)\n", n_in, n_in > 0 ? in_sizes[0] : -1, out_size, ws_size); grid = -1; return; }
        int dev = 0, cus = 0, per_cu = 0;
        if (hipGetDevice(&dev) != hipSuccess || hipDeviceGetAttribute(&cus, hipDeviceAttributeMultiprocessorCount, dev) != hipSuccess) { grid = -1; return; }
        if (hipFuncSetAttribute((const void*)fwd, hipFuncAttributeMaxDynamicSharedMemorySize, LDS_BYTES) != hipSuccess) { fprintf(stderr, "kernel_launch: hipFuncSetAttribute failed\n"); grid = -1; return; }
#if !ONE_LAUNCH
        (void)hipFuncSetAttribute((const void*)k_mix1_naive, hipFuncAttributeMaxDynamicSharedMemorySize, LDS_BYTES);
        (void)hipFuncSetAttribute((const void*)k_mix2_naive, hipFuncAttributeMaxDynamicSharedMemorySize, LDS_BYTES);
        (void)hipFuncSetAttribute((const void*)k_mix3_naive, hipFuncAttributeMaxDynamicSharedMemorySize, LDS_BYTES);
#endif
        if (hipOccupancyMaxActiveBlocksPerMultiprocessor(&per_cu, (const void*)fwd, NTHREADS, LDS_BYTES) != hipSuccess || per_cu < 1) { fprintf(stderr, "kernel_launch: occupancy query says %d\n", per_cu); per_cu = 1; }
        (void)hipGetLastError();
        grid = cus;
    }
    if (grid < 0) return;
    (void)hipMemsetAsync((char*)d_ws + WS_CTL, 0, CTL_ZERO_BYTES, stream);
    Args a{};
    for (int i = 0; i < 17; ++i) a.in[i] = (const float*)d_in[i];
    a.out = (float*)d_out; a.ws = (unsigned char*)d_ws;
#if ONE_LAUNCH
    a.ph_lo = 0; a.ph_hi = NPH;
    void* kargs[] = {&a};
    hipError_t e = hipLaunchCooperativeKernel((const void*)fwd, dim3(grid), dim3(NTHREADS), kargs, LDS_BYTES, stream);
    if (e != hipSuccess) fprintf(stderr, "kernel_launch: cooperative launch failed: %s (grid %d)\n", hipGetErrorString(e), grid);
#else
    for (int ph = 0; ph < NPH; ++ph) {
        const int r = ph == 0 ? -1 : (ph - 1) % 7, L = ph == 0 ? 0 : (ph - 1) / 7;
        a.ph_lo = ph; a.ph_hi = ph + 1;
        if (r == 1) { a.ph_lo = L; hipLaunchKernelGGL(k_mix1_naive, dim3(grid), dim3(NTHREADS), LDS_BYTES, stream, a); }
        else if (r == 2) { a.ph_lo = L; hipLaunchKernelGGL(k_mix2_naive, dim3(grid), dim3(NTHREADS), LDS_BYTES, stream, a); }
        else if (r == 3) { a.ph_lo = L; hipLaunchKernelGGL(k_mix3_naive, dim3(grid), dim3(NTHREADS), LDS_BYTES, stream, a); }
        else hipLaunchKernelGGL(fwd, dim3(grid), dim3(NTHREADS), LDS_BYTES, stream, a);
    }
#endif
}
```

```cpp
#include <hip/hip_runtime.h>
#include <cstdio>
#include <cstdint>

#ifndef ONE_LAUNCH
#define ONE_LAUNCH 1
#endif

namespace pg8 {
#define PG8_LAS __attribute__((address_space(3)))
#define PG8_GAS __attribute__((address_space(1)))
typedef unsigned short bf16_t;
typedef short bf16x8 __attribute__((ext_vector_type(8)));
typedef float f32x4 __attribute__((ext_vector_type(4)));
typedef unsigned u32x4 __attribute__((ext_vector_type(4)));
constexpr int BM = 256, BK = 64, HALF = 128, HTB = HALF * BK * 2  , STAGE_BYTES = 8 * HTB, NXCD = 8, WGM = 8;

__host__ __device__ __forceinline__ int lds_byte(int r, int c) { const int st = (r >> 4) * 2 + (c >> 5), rr = r & 15, cc = c & 31, ob = rr * 64 + cc * 2; return st * 1024 + (ob ^ (((ob >> 9) & 1) << 5)); }
__host__ __device__ __forceinline__ void stage_rc(int b, int& R, int& C) { const int st = b / 1024, sb = b % 1024, swz = sb ^ (((sb >> 9) & 1) << 5); R = (st >> 1) * 16 + swz / 64; C = (st & 1) * 32 + (swz % 64) / 2; }
__host__ __device__ __forceinline__ int perm32(int rho) { const int n = rho >> 4, i = rho & 15; return 8 * (i >> 2) + 4 * n + (i & 3); }

struct Unit { int pm, pn; };
struct Gemm { const PG8_GAS bf16_t* A; const PG8_GAS bf16_t* Bt; int M, N, K, lda; };

struct StaticOrder {
    int nM, nN, nwg, G, c;
    __host__ __device__ void init(int M, int N, int G_, int c_) { nM = M / BM; nN = N / BM; nwg = nM * nN; G = G_; c = c_; }
    __host__ __device__ bool next(int i, Unit& u) const {
        const long L = (long)i * G + c; if (L >= nwg) return false;
        int wgid = (int)L; { const int q = nwg / NXCD, r = nwg % NXCD, xcd = wgid % NXCD, off = wgid / NXCD; wgid = (xcd < r ? xcd * (q + 1) : r * (q + 1) + (xcd - r) * q) + off; }
        const int nig = WGM * nN, gid = wgid / nig, fm = gid * WGM, gsz = (nM - fm) < WGM ? (nM - fm) : WGM;
        u.pm = fm + ((wgid % nig) % gsz); u.pn = (wgid % nig) / gsz; return true;
    }
    __device__ __forceinline__ void a_ready(const Unit&) const {}
    __device__ __forceinline__ void done(const Unit&) const {}
};

__device__ __forceinline__ unsigned cvt_pk_bf16(float lo, float hi) { unsigned r; asm volatile("v_cvt_pk_bf16_f32 %0, %1, %2" : "=v"(r) : "v"(lo), "v"(hi)); return r; }

constexpr int PROJ_PITCH = 2304, DT_TILE = 9;
struct EpiProj {
    static constexpr bool PERM = true, AFTER_DRAIN = false;
    PG8_GAS bf16_t* O; PG8_GAS float* dtraw; const PG8_LAS float* rstd;
    __device__ __forceinline__ void operator()(const f32x4 (&acc)[2][2][4][2], const Unit& u, int ui, int wr, int wc, int fr, int fq) const {
        const int rt0 = wr * 64 + fr;
        if (u.pn == DT_TILE) {
            if (wc == 0 && fq == 0) {
#pragma unroll
                for (int ai = 0; ai < 2; ++ai)
#pragma unroll
                    for (int m = 0; m < 4; ++m) { const int rt = ai * HALF + rt0 + m * 16; const float rs = rstd[ui * BM + rt]; PG8_GAS float* p = dtraw + (size_t)(u.pm * BM + rt) * 8;
                        *(PG8_GAS f32x4*)p = acc[ai][0][m][0] * rs; *(PG8_GAS f32x4*)(p + 4) = acc[ai][0][m][1] * rs; }
            }
            return;
        }
        const int col0 = u.pn * BM + wc * 32 + 8 * fq;
#pragma unroll
        for (int ai = 0; ai < 2; ++ai)
#pragma unroll
            for (int m = 0; m < 4; ++m) { const int rt = ai * HALF + rt0 + m * 16; const float rs = rstd[ui * BM + rt]; PG8_GAS bf16_t* rowp = O + (size_t)(u.pm * BM + rt) * PROJ_PITCH + col0;
#pragma unroll
                for (int bj = 0; bj < 2; ++bj) { const f32x4 v0 = acc[ai][bj][m][0] * rs, v1 = acc[ai][bj][m][1] * rs;
                    u32x4 w; w.x = cvt_pk_bf16(v0[0], v0[1]); w.y = cvt_pk_bf16(v0[2], v0[3]); w.z = cvt_pk_bf16(v1[0], v1[1]); w.w = cvt_pk_bf16(v1[2], v1[3]);
                    *(PG8_GAS u32x4*)(rowp + bj * HALF) = w; } }
    }
};
struct EpiUp {
    static constexpr bool PERM = true, AFTER_DRAIN = false;
    PG8_GAS bf16_t* O; int ldc; const PG8_LAS float* rstd;
    __device__ __forceinline__ void operator()(const f32x4 (&acc)[2][2][4][2], const Unit& u, int ui, int wr, int wc, int fr, int fq) const {
        const int rt0 = wr * 64 + fr, col0 = u.pn * BM + wc * 32 + 8 * fq;
#pragma unroll
        for (int ai = 0; ai < 2; ++ai)
#pragma unroll
            for (int m = 0; m < 4; ++m) { const int rt = ai * HALF + rt0 + m * 16; const float rs = rstd[ui * BM + rt]; PG8_GAS bf16_t* rowp = O + (size_t)(u.pm * BM + rt) * ldc + col0;
#pragma unroll
                for (int bj = 0; bj < 2; ++bj) { f32x4 v0 = acc[ai][bj][m][0] * rs, v1 = acc[ai][bj][m][1] * rs;
#pragma unroll
                    for (int e = 0; e < 4; ++e) { const float a = fmaxf(v0[e], 0.f), b = fmaxf(v1[e], 0.f); v0[e] = a * a; v1[e] = b * b; }
                    u32x4 w; w.x = cvt_pk_bf16(v0[0], v0[1]); w.y = cvt_pk_bf16(v0[2], v0[3]); w.z = cvt_pk_bf16(v1[0], v1[1]); w.w = cvt_pk_bf16(v1[2], v1[3]);
                    *(PG8_GAS u32x4*)(rowp + bj * HALF) = w; } }
    }
};
struct EpiRes {
    static constexpr bool PERM = true, AFTER_DRAIN = false;
    const PG8_GAS float* res; PG8_GAS float* out; PG8_GAS bf16_t* xb; PG8_GAS float* ssq;
    __device__ __forceinline__ void operator()(const f32x4 (&acc)[2][2][4][2], const Unit& u, int ui, int wr, int wc, int fr, int fq) const {
        const int rt0 = wr * 64 + fr, col0 = u.pn * BM + wc * 32 + 8 * fq;
#pragma unroll
        for (int ai = 0; ai < 2; ++ai)
#pragma unroll
            for (int m = 0; m < 4; ++m) { const int row = u.pm * BM + ai * HALF + rt0 + m * 16; const size_t off = (size_t)row * 1024 + col0; float s = 0.f;
#pragma unroll
                for (int bj = 0; bj < 2; ++bj) { const f32x4 r0 = *(const PG8_GAS f32x4*)(res + off + bj * HALF), r1 = *(const PG8_GAS f32x4*)(res + off + bj * HALF + 4);
                    const f32x4 v0 = r0 + acc[ai][bj][m][0], v1 = r1 + acc[ai][bj][m][1];
                    *(PG8_GAS f32x4*)(out + off + bj * HALF) = v0; *(PG8_GAS f32x4*)(out + off + bj * HALF + 4) = v1;
                    u32x4 w; w.x = cvt_pk_bf16(v0[0], v0[1]); w.y = cvt_pk_bf16(v0[2], v0[3]); w.z = cvt_pk_bf16(v1[0], v1[1]); w.w = cvt_pk_bf16(v1[2], v1[3]);
                    *(PG8_GAS u32x4*)(xb + off + bj * HALF) = w;
                    s += (v0[0] * v0[0] + v0[1] * v0[1]) + (v0[2] * v0[2] + v0[3] * v0[3]) + (v1[0] * v1[0] + v1[1] * v1[1]) + (v1[2] * v1[2] + v1[3] * v1[3]); }
                s += __shfl_xor(s, 16); s += __shfl_xor(s, 32);
                if (fq == 0) ssq[(size_t)row * 16 + u.pn * 4 + wc] = s;
                if (m & 1) asm volatile("" ::: "memory"); }
    }
};

template <class Epi, class Sched, bool ALIGN_EPI = false, bool SP2 = false>
__device__ __forceinline__ void gemm_phase(PG8_LAS unsigned char* lds, const Gemm g, const Sched& S, const Epi& E) {
    int tid_ = threadIdx.x; asm volatile("" : "+v"(tid_));
    const int tid = tid_, wid = __builtin_amdgcn_readfirstlane(tid >> 6), lane = tid & 63, wr = wid >> 2, wc = wid & 3, fr = lane & 15, fq = lane >> 4;
    const int K = g.K, nt = K / BK;
    unsigned voffA[2], voffB[2];
#pragma unroll
    for (int i = 0; i < 2; ++i) { int R, C; stage_rc(tid * 16 + i * 8192, R, C); const int Rb = Epi::PERM ? ((R & ~31) + perm32(R & 31)) : R;
        voffA[i] = (unsigned)(R * g.lda + C) * 2u; voffB[i] = (unsigned)(Rb * K + C) * 2u; }
    const size_t kstep = (size_t)(BK * 2);
    const size_t hstepA = (size_t)HALF * g.lda * 2, hstepB = (size_t)HALF * K * 2;
    const size_t tstepA = 2 * hstepA, tstepB = 2 * hstepB;
    const unsigned ldsw = (unsigned)wid * 1024u;
    const int aoff = lds_byte(wr * 64 + fr, fq * 8), boff = lds_byte(wc * 32 + fr, fq * 8);
#define PG8_SA(b, h) (((b) * 2 + (h)) * HTB)
#define PG8_SB(b, h) ((4 + (b) * 2 + (h)) * HTB)
#define PG8_STAGE(bufoff, gbase, voff) do { _Pragma("unroll") for (int _i = 0; _i < 2; ++_i) \
        __builtin_amdgcn_global_load_lds((const unsigned*)((const char*)(gbase) + (voff)[_i]), (PG8_LAS unsigned*)(lds + (bufoff) + ldsw + _i * 8192), 16, 0, 0); } while (0)
#define PG8_LDA(dst, b, h) do { _Pragma("unroll") for (int m = 0; m < 4; ++m) _Pragma("unroll") for (int k = 0; k < 2; ++k) dst[m][k] = *(const PG8_LAS bf16x8*)(lds + PG8_SA(b, h) + aoff + m * 2048 + k * 1024); } while (0)
#define PG8_LDB(dst, b, h) do { _Pragma("unroll") for (int n = 0; n < 2; ++n) _Pragma("unroll") for (int k = 0; k < 2; ++k) dst[n][k] = *(const PG8_LAS bf16x8*)(lds + PG8_SB(b, h) + boff + n * 2048 + k * 1024); } while (0)
#define PG8_MMA(ai, bj, At, Bt) do { __builtin_amdgcn_s_setprio(1); _Pragma("unroll") for (int m = 0; m < 4; ++m) _Pragma("unroll") for (int n = 0; n < 2; ++n) _Pragma("unroll") for (int k = 0; k < 2; ++k) \
        acc[ai][bj][m][n] = __builtin_amdgcn_mfma_f32_16x16x32_bf16(Bt[n][k], At[m][k], acc[ai][bj][m][n], 0, 0, 0); __builtin_amdgcn_s_setprio(0); } while (0)
#define PG8_WAIT_V(n) asm volatile("s_waitcnt vmcnt(" #n ")" ::: "memory")
#define PG8_WAIT_L(n) asm volatile("s_waitcnt lgkmcnt(" #n ")" ::: "memory")
#define PG8_BAR __builtin_amdgcn_s_barrier()
#define PG8_SCHED __builtin_amdgcn_sched_barrier(0)
    Unit cur, nxt; int ui = 0;
    if (!S.next(0, cur)) return;
    f32x4 acc[2][2][4][2];
#pragma unroll
    for (int a = 0; a < 2; ++a)
#pragma unroll
        for (int b = 0; b < 2; ++b)
#pragma unroll
            for (int m = 0; m < 4; ++m)
#pragma unroll
                for (int n = 0; n < 2; ++n) acc[a][b][m][n] = (f32x4){0.f, 0.f, 0.f, 0.f};
    bf16x8 At[4][2], B0[2][2], B1[2][2];
    const char* cA = (const char*)g.A + (size_t)cur.pm * tstepA; const char* cB = (const char*)g.Bt + (size_t)cur.pn * tstepB;
    S.a_ready(cur);
    if constexpr (SP2) {
        PG8_STAGE(PG8_SB(0, 0), cB, voffB); PG8_STAGE(PG8_SB(0, 1), cB + hstepB, voffB); PG8_STAGE(PG8_SA(0, 0), cA, voffA); PG8_STAGE(PG8_SA(0, 1), cA + hstepA, voffA);
        if (wr == 1) PG8_BAR;
        PG8_WAIT_V(2); PG8_BAR;
        PG8_STAGE(PG8_SB(1, 0), cB + kstep, voffB); PG8_STAGE(PG8_SA(1, 0), cA + kstep, voffA); PG8_STAGE(PG8_SB(1, 1), cB + hstepB + kstep, voffB);
        PG8_WAIT_V(6); PG8_BAR;
    } else {
        PG8_STAGE(PG8_SB(0, 0), cB, voffB); PG8_STAGE(PG8_SA(0, 0), cA, voffA); PG8_STAGE(PG8_SB(0, 1), cB + hstepB, voffB); PG8_STAGE(PG8_SA(0, 1), cA + hstepA, voffA);
        if (wr == 1) PG8_BAR;
        PG8_WAIT_V(4); PG8_BAR;
        PG8_STAGE(PG8_SB(1, 0), cB + kstep, voffB); PG8_STAGE(PG8_SA(1, 0), cA + kstep, voffA); PG8_STAGE(PG8_SB(1, 1), cB + hstepB + kstep, voffB);
        PG8_WAIT_V(6); PG8_BAR;
    }
    for (;;) {
        const bool has_next = S.next(ui + 1, nxt);
        const char* nA = has_next ? (const char*)g.A + (size_t)nxt.pm * tstepA : cA; const char* nB = has_next ? (const char*)g.Bt + (size_t)nxt.pn * tstepB : cB;
        for (int t = 0; t < nt; t += 2) {
            const bool last = (t == nt - 2);
            const char* a1 = cA + (size_t)(t + 1) * kstep;
            const char* a2 = last ? nA : cA + (size_t)(t + 2) * kstep; const char* b2 = last ? nB : cB + (size_t)(t + 2) * kstep;
            const char* a3 = a2 + kstep; const char* b3 = b2 + kstep;
            if (last && has_next) S.a_ready(nxt);
            if constexpr (SP2) {
            PG8_LDB(B0, 0, 0); PG8_LDB(B1, 0, 1); PG8_SCHED; PG8_LDA(At, 0, 0); PG8_STAGE(PG8_SA(1, 1), a1 + hstepA, voffA);
            PG8_WAIT_V(8); PG8_WAIT_L(0); PG8_BAR; PG8_MMA(0, 0, At, B0); PG8_MMA(0, 1, At, B1); PG8_BAR; PG8_SCHED;
            PG8_LDA(At, 0, 1); PG8_STAGE(PG8_SB(0, 0), b2, voffB); PG8_STAGE(PG8_SB(0, 1), b2 + hstepB, voffB); PG8_STAGE(PG8_SA(0, 0), a2, voffA);
            PG8_WAIT_V(8); PG8_WAIT_L(0); PG8_BAR; PG8_MMA(1, 0, At, B0); PG8_MMA(1, 1, At, B1); PG8_BAR; PG8_SCHED;
            PG8_LDB(B0, 1, 0); PG8_LDB(B1, 1, 1); PG8_SCHED; PG8_LDA(At, 1, 0); PG8_STAGE(PG8_SA(0, 1), a2 + hstepA, voffA);
            PG8_WAIT_V(8); PG8_WAIT_L(0); PG8_BAR; PG8_MMA(0, 0, At, B0); PG8_MMA(0, 1, At, B1); PG8_BAR; PG8_SCHED;
            PG8_LDA(At, 1, 1); PG8_STAGE(PG8_SB(1, 0), b3, voffB); PG8_STAGE(PG8_SB(1, 1), b3 + hstepB, voffB); PG8_STAGE(PG8_SA(1, 0), a3, voffA);
            PG8_WAIT_V(8); PG8_WAIT_L(0); PG8_BAR; PG8_MMA(1, 0, At, B0); PG8_MMA(1, 1, At, B1); PG8_BAR; PG8_SCHED;
            } else {
            PG8_LDB(B0, 0, 0); PG8_SCHED; PG8_LDA(At, 0, 0); PG8_STAGE(PG8_SA(1, 1), a1 + hstepA, voffA);
            PG8_WAIT_L(8); PG8_BAR; PG8_WAIT_L(0); PG8_MMA(0, 0, At, B0); PG8_BAR; PG8_SCHED;
            PG8_LDB(B1, 0, 1); PG8_STAGE(PG8_SB(0, 0), b2, voffB);
            PG8_BAR; PG8_WAIT_L(0); PG8_MMA(0, 1, At, B1); PG8_BAR;
            PG8_LDA(At, 0, 1); PG8_STAGE(PG8_SA(0, 0), a2, voffA);
            PG8_BAR; PG8_WAIT_L(0); PG8_MMA(1, 0, At, B0); PG8_BAR; PG8_SCHED;
            PG8_STAGE(PG8_SB(0, 1), b2 + hstepB, voffB);
            PG8_WAIT_V(6); PG8_BAR; PG8_MMA(1, 1, At, B1); PG8_BAR;
            PG8_LDB(B0, 1, 0); PG8_SCHED; PG8_LDA(At, 1, 0); PG8_STAGE(PG8_SA(0, 1), a2 + hstepA, voffA);
            PG8_WAIT_L(8); PG8_BAR; PG8_WAIT_L(0); PG8_MMA(0, 0, At, B0); PG8_BAR; PG8_SCHED;
            PG8_LDB(B1, 1, 1); PG8_STAGE(PG8_SB(1, 0), b3, voffB);
            PG8_BAR; PG8_WAIT_L(0); PG8_MMA(0, 1, At, B1); PG8_BAR;
            PG8_LDA(At, 1, 1); PG8_STAGE(PG8_SA(1, 0), a3, voffA);
            PG8_BAR; PG8_WAIT_L(0); PG8_MMA(1, 0, At, B0); PG8_BAR; PG8_SCHED;
            PG8_STAGE(PG8_SB(1, 1), b3 + hstepB, voffB);
            PG8_WAIT_V(6); PG8_BAR; PG8_MMA(1, 1, At, B1); PG8_BAR;
            }
        }
        if constexpr (ALIGN_EPI) { if (wr == 0) PG8_BAR; }
        if constexpr (!Epi::AFTER_DRAIN) { E(acc, cur, ui, wr, wc, fr, fq); S.done(cur); }
        if (!has_next) break;
#pragma unroll
        for (int a = 0; a < 2; ++a)
#pragma unroll
            for (int b = 0; b < 2; ++b)
#pragma unroll
                for (int m = 0; m < 4; ++m)
#pragma unroll
                    for (int n = 0; n < 2; ++n) acc[a][b][m][n] = (f32x4){0.f, 0.f, 0.f, 0.f};
        cur = nxt; cA = nA; cB = nB; ++ui;
        if constexpr (ALIGN_EPI) { if (wr == 1) PG8_BAR; }
    }
    PG8_WAIT_V(0);
    if constexpr (!ALIGN_EPI) { if (wr == 0) PG8_BAR; }
    PG8_BAR;

#undef PG8_SA
#undef PG8_SB
#undef PG8_STAGE
#undef PG8_LDA
#undef PG8_LDB
#undef PG8_MMA
#undef PG8_WAIT_V
#undef PG8_WAIT_L
#undef PG8_BAR
#undef PG8_SCHED
}
}

constexpr int NWAVES = 8, NTHREADS = NWAVES * 64;
constexpr int BATCH = 8, SEQ = 2048, D = 1024, M = BATCH * SEQ, FF = 4096, DEPTH = 2;
constexpr int D_IN = 2312, NPROJ = 2560, PP = pg8::PROJ_PITCH;
constexpr int CQ = 0, CZ = 512, CK = 1024, CV = 1152, CX = 1280, CBM = 1792, CCM = 2048;
constexpr float EPS = 1e-6f;
constexpr int NPH = 1 + 7 * DEPTH;

constexpr size_t MiB = 1u << 20;
constexpr size_t WS_CTL = 0, CTL_ZERO_BYTES = 1 * MiB;
constexpr size_t WS_SSQ = 1 * MiB;
constexpr size_t WS_DTRAW = 2 * MiB;
constexpr size_t WS_WIN = 4 * MiB, WS_WOUT = 14 * MiB, WS_WUP = 18 * MiB, WS_WDOWN = 34 * MiB;
constexpr size_t WS_XB = 50 * MiB;
constexpr size_t WS_PROJ = 82 * MiB;
constexpr size_t WS_XBCF = 154 * MiB;
constexpr size_t WS_YN = 218 * MiB;
constexpr size_t WS_HID = 82 * MiB;
constexpr size_t WS_END = 256 * MiB;
constexpr int CW_BAR = 4096;

constexpr int RING_OFF = 0, RING_BYTES = 131072;
constexpr int LDSCTL_OFF = RING_BYTES, MISC_OFF = LDSCTL_OFF + 320, RSTD_OFF = LDSCTL_OFF + 512, PTR_OFF = RSTD_OFF + 4096;
constexpr int LDS_BYTES = 147456;
static_assert(PTR_OFF + 512 <= LDS_BYTES, "LDS map");

#define GAS __attribute__((address_space(1)))
#define LAS __attribute__((address_space(3)))
typedef unsigned short bf16;
typedef unsigned v4u __attribute__((ext_vector_type(4)));
typedef unsigned v2u __attribute__((ext_vector_type(2)));
typedef float f32x4 __attribute__((ext_vector_type(4)));
typedef GAS unsigned gu32;
#define RLX_AGENT __ATOMIC_RELAXED, __HIP_MEMORY_SCOPE_AGENT
#define LDS_WAIT() asm volatile("s_waitcnt lgkmcnt(0)" ::: "memory")
#define VM_WAIT() asm volatile("s_waitcnt vmcnt(0)" ::: "memory")
__device__ __forceinline__ unsigned f2bf(float f) { unsigned u = __builtin_bit_cast(unsigned, f); return (u + 0x7fffu + ((u >> 16) & 1u)) >> 16; }
__device__ __forceinline__ unsigned pk2(float lo, float hi) { return f2bf(lo) | (f2bf(hi) << 16); }
__device__ __forceinline__ float bflo(unsigned w) { return __uint_as_float(w << 16); }
__device__ __forceinline__ float bfhi(unsigned w) { return __uint_as_float(w & 0xffff0000u); }
__device__ __forceinline__ float silu_f(float v) { return v / (1.f + expf(-v)); }
__device__ __forceinline__ float softplus_f(float v) { return fmaxf(v, 0.f) + log1pf(expf(-fabsf(v))); }

#define XB_TMO      128
#define XB_XCNT(j)  (256  + 64 * (j))
#define XB_XSUB(j)  (1280 + 64 * (j))
#define XB_XGEN(j)  (2304 + 64 * (j))
#define XB_TOP      3328
#define XB_TOPGEN   3392
#define XCD_BAR_WORDS 3456
#define XB_SPIN_CAP (1u << 22)
__device__ __forceinline__ unsigned xb_ld(unsigned* p)              { return __hip_atomic_load(p, __ATOMIC_RELAXED, __HIP_MEMORY_SCOPE_AGENT); }
__device__ __forceinline__ unsigned xb_add(unsigned* p, unsigned v) { return __hip_atomic_fetch_add(p, v, __ATOMIC_RELAXED, __HIP_MEMORY_SCOPE_AGENT); }
__device__ __forceinline__ unsigned xb_xcc_id() { return (unsigned)__builtin_amdgcn_s_getreg((3 << 11) | 20) & 0xFu; }
#define XB_SPIN(cond, bar) do { unsigned _sp = 0; while (cond) { __builtin_amdgcn_s_sleep(1); \
    if ((++_sp & 255u) == 0u) { if (xb_ld(&(bar)[XB_TMO])) break; if (_sp > XB_SPIN_CAP) { atomicAdd(&(bar)[XB_TMO], 1u); break; } } } } while (0)
struct XcdBarrier { unsigned* bar; unsigned x; volatile LAS unsigned* st; };
__device__ __forceinline__ XcdBarrier xcd_barrier_post(unsigned* bar, volatile LAS unsigned* st) {
    XcdBarrier b; b.bar = bar; b.x = xb_xcc_id(); b.st = st;
    if (threadIdx.x == 0) (void)xb_add(&bar[XB_XCNT(b.x)], 1u);
    return b;
}
__device__ __forceinline__ void xcd_barrier_complete(unsigned* bar, unsigned x, unsigned& nloc, unsigned& nx) {
    const unsigned G = gridDim.x * gridDim.y * gridDim.z;
    unsigned sum, cnt, mine, sp = 0u;
    for (;;) {
        sum = 0u; cnt = 0u; mine = 0u;
#pragma unroll
        for (unsigned j = 0; j < 16; ++j) { const unsigned c = xb_ld(&bar[XB_XCNT(j)]); sum += c; cnt += (c > 0u) ? 1u : 0u; mine = (j == x) ? c : mine; }
        if (sum == G) break;
        __builtin_amdgcn_s_sleep(1);
        if ((++sp & 255u) == 0u) { if (xb_ld(&bar[XB_TMO])) break; if (sp > XB_SPIN_CAP) { atomicAdd(&bar[XB_TMO], 1u); break; } }
    }
    nloc = mine > 0u ? mine : 1u; nx = cnt > 0u ? cnt : 1u;
}
__device__ __forceinline__ void xcd_barrier(const XcdBarrier& b) {
    asm volatile("s_waitcnt vmcnt(0)" ::: "memory");
    __syncthreads();
    if (threadIdx.x == 0) {
        unsigned* bar = b.bar;
        __builtin_amdgcn_s_waitcnt(0);
        unsigned nloc = b.st[0], nx = b.st[1];
        if (nloc == 0u) { xcd_barrier_complete(bar, b.x, nloc, nx); b.st[0] = nloc; b.st[1] = nx; }
        const unsigned old = xb_add(&bar[XB_XSUB(b.x)], 1u);
        const unsigned gen = old / nloc;
        if (old + 1u == (gen + 1u) * nloc) {
            __builtin_amdgcn_fence(__ATOMIC_RELEASE, "agent");
            asm volatile("s_waitcnt vmcnt(0)" ::: "memory");
            const unsigned og = xb_add(&bar[XB_TOP], 1u);
            const unsigned tg = og / nx;
            if (og + 1u == (tg + 1u) * nx) xb_add(&bar[XB_TOPGEN], 1u);
            else XB_SPIN(xb_ld(&bar[XB_TOPGEN]) == tg, bar);
            __builtin_amdgcn_fence(__ATOMIC_ACQUIRE, "agent");
            xb_add(&bar[XB_XGEN(b.x)], 1u);
            asm volatile("s_waitcnt vmcnt(0)" ::: "memory");
        } else {
            XB_SPIN(xb_ld(&bar[XB_XGEN(b.x)]) == gen, bar);
            __builtin_amdgcn_fence(__ATOMIC_ACQUIRE, "agent");
            asm volatile("s_waitcnt vmcnt(0)" ::: "memory");
        }
    }
    __syncthreads();
}

struct Frame {
    LAS unsigned char* lds;
    int tid, lane, wave, bid, G;
};
enum { I_X = 0, I_MIXG, I_WIN, I_QG, I_KG, I_SINK, I_RELB, I_CONVW, I_CONVB, I_DTB, I_ALOG, I_DSKIP, I_SSMG, I_WOUT, I_MLPG, I_WUP, I_WDOWN, I_OUT, I_WS, I_NPTR };
__device__ __forceinline__ GAS unsigned char* ptr_at(const Frame& F, int i) {
    const LAS unsigned* t = (const LAS unsigned*)(F.lds + PTR_OFF) + 2 * i;
    const unsigned lo = __builtin_amdgcn_readfirstlane(t[0]), hi = __builtin_amdgcn_readfirstlane(t[1]);
    return (GAS unsigned char*)(((unsigned long long)hi << 32) | lo);
}
#define FIN(i) ((const GAS float*)ptr_at(F, (i)))
#define FWS(off) (ptr_at(F, I_WS) + (off))
__device__ __forceinline__ float wave_sum(float v) {
#pragma unroll
    for (int o = 1; o < 64; o <<= 1) v += __shfl_xor(v, o);
    return v;
}

__device__ __forceinline__ void tr_item(const GAS float* W, int Nsrc, int nsrc0, int nvalid, int K, const GAS float* gain, GAS bf16* WT, int ndst0, int k0, LAS float* scr, int lane) {
    const int n = lane & 31;
#pragma unroll 8
    for (int i = 0; i < 32; ++i) { const int kk = 2 * i + (lane >> 5); float v = 0.f;
        if (n < nvalid) { v = W[(size_t)(k0 + kk) * Nsrc + nsrc0 + n]; if (gain) v *= gain[k0 + kk]; }
        scr[kk * 33 + n] = v; }
    LDS_WAIT(); asm volatile("" ::: "memory");
    const int c = lane & 7;
#pragma unroll
    for (int j = 0; j < 4; ++j) { const int nn = (lane >> 3) + 8 * j; const LAS float* s = scr + (8 * c) * 33 + nn;
        v4u o; o.x = pk2(s[0 * 33], s[1 * 33]); o.y = pk2(s[2 * 33], s[3 * 33]); o.z = pk2(s[4 * 33], s[5 * 33]); o.w = pk2(s[6 * 33], s[7 * 33]);
        *(GAS v4u*)(WT + (size_t)(ndst0 + nn) * K + k0 + 8 * c) = o; }
    LDS_WAIT(); asm volatile("" ::: "memory");
}
__device__ __forceinline__ void p0_prologue(Frame& F) {
    LAS float* scr = (LAS float*)(F.lds + RING_OFF + F.wave * 16384);
    const int gw = F.bid * NWAVES + F.wave, NGW = F.G * NWAVES;
    constexpr int I_IN = 16 * 80, I_OUT = 16 * 32, I_UP = 16 * 128, I_DN = 64 * 32, I_L = I_IN + I_OUT + I_UP + I_DN;
    {
    const GAS float *w_in = FIN(I_WIN), *mix_g = FIN(I_MIXG), *w_out = FIN(I_WOUT), *w_up = FIN(I_WUP), *mlp_g = FIN(I_MLPG), *w_down = FIN(I_WDOWN);
    GAS bf16 *WIN = (GAS bf16*)FWS(WS_WIN), *WOUT = (GAS bf16*)FWS(WS_WOUT), *WUP = (GAS bf16*)FWS(WS_WUP), *WDOWN = (GAS bf16*)FWS(WS_WDOWN);
    for (int it = gw; it < DEPTH * I_L; it += NGW) {
        const int L = it / I_L; int r = it % I_L;
        if (r < I_IN) {
            const int kb = r / 80, nb = r % 80; int src, nv = 32;
            if (nb < 16) src = nb * 32; else if (nb < 32) src = 768 + (nb - 16) * 32; else if (nb < 36) src = 512 + (nb - 32) * 32; else if (nb < 40) src = 640 + (nb - 36) * 32;
            else if (nb < 72) src = nb * 32; else if (nb == 72) { src = 2304; nv = 8; } else { src = 0; nv = 0; }
            tr_item(w_in + (size_t)L * D * D_IN, D_IN, src, nv, D, mix_g + L * D, WIN + (size_t)L * NPROJ * D, nb * 32, kb * 64, scr, F.lane); continue; }
        r -= I_IN;
        if (r < I_OUT) { const int kb = r / 32, nb = r % 32; tr_item(w_out + (size_t)L * D * D, D, nb * 32, 32, D, nullptr, WOUT + (size_t)L * D * D, nb * 32, kb * 64, scr, F.lane); continue; }
        r -= I_OUT;
        if (r < I_UP) { const int kb = r / 128, nb = r % 128; tr_item(w_up + (size_t)L * D * FF, FF, nb * 32, 32, D, mlp_g + L * D, WUP + (size_t)L * FF * D, nb * 32, kb * 64, scr, F.lane); continue; }
        r -= I_UP;
        { const int kb = r / 32, nb = r % 32; tr_item(w_down + (size_t)L * FF * D, D, nb * 32, 32, FF, nullptr, WDOWN + (size_t)L * D * FF, nb * 32, kb * 64, scr, F.lane); }
    }
    }
    const GAS float* x = FIN(I_X); GAS bf16* XB = (GAS bf16*)FWS(WS_XB); GAS float* SSQ = (GAS float*)FWS(WS_SSQ);
    for (int m = gw; m < M; m += NGW) {
        const GAS f32x4* xr = (const GAS f32x4*)(x + (size_t)m * D) + F.lane;
        f32x4 v[4]; float s = 0.f;
#pragma unroll
        for (int j = 0; j < 4; ++j) { v[j] = xr[64 * j]; s += (v[j].x * v[j].x + v[j].y * v[j].y) + (v[j].z * v[j].z + v[j].w * v[j].w); }
        s = wave_sum(s);
        GAS v2u* o8 = (GAS v2u*)(XB + (size_t)m * D) + F.lane;
#pragma unroll
        for (int j = 0; j < 4; ++j) { v2u o; o.x = pk2(v[j].x, v[j].y); o.y = pk2(v[j].z, v[j].w); o8[64 * j] = o; }
        if (F.lane < 16) SSQ[(size_t)m * 16 + F.lane] = (F.lane == 0) ? s : 0.f;
    }
}
__device__ __forceinline__ void rstd_prepass(Frame& F, const pg8::StaticOrder& S, LAS float* tab) {
    const GAS float* SSQ = (const GAS float*)FWS(WS_SSQ);
    pg8::Unit u;
    for (int i = 0; i < 4 && S.next(i, u); ++i) {
        const int r = F.tid >> 1, h = F.tid & 1;
        const GAS f32x4* p = (const GAS f32x4*)(SSQ + (size_t)(u.pm * 256 + r) * 16 + h * 8);
        const f32x4 a = p[0], b = p[1];
        float s = (a.x + a.y) + (a.z + a.w) + (b.x + b.y) + (b.z + b.w);
        s += __shfl_xor(s, 1);
        if (h == 0) tab[i * 256 + r] = 1.0f / sqrtf(s * (1.0f / D) + EPS);
    }
    LDS_WAIT(); __syncthreads();
}

__device__ __forceinline__ int t5_bucket(int d) {
    if (d < 16) return d;
    return 16 + (d >= 19) + (d >= 21) + (d >= 24) + (d >= 27) + (d >= 31) + (d >= 35) + (d >= 40) + (d >= 46) + (d >= 52) + (d >= 59) + (d >= 67) + (d >= 77) + (d >= 87) + (d >= 99) + (d >= 113);
}
__device__ __forceinline__ void ld8(const GAS bf16* p, float (&v)[8]) {
    const v4u w = *(const GAS v4u*)p;
    v[0] = bflo(w.x); v[1] = bfhi(w.x); v[2] = bflo(w.y); v[3] = bfhi(w.y); v[4] = bflo(w.z); v[5] = bfhi(w.z); v[6] = bflo(w.w); v[7] = bfhi(w.w);
}
__device__ __forceinline__ void attn_naive(Frame& F, int L) {
    const GAS float* qg = FIN(I_QG) + L * 64; const GAS float* kg = FIN(I_KG) + L * 64; const GAS float* sinks = FIN(I_SINK); const GAS float* rel_bias = FIN(I_RELB);
    GAS bf16* PROJ = (GAS bf16*)FWS(WS_PROJ);
    for (int it = F.bid * NTHREADS + F.tid; it < M * 8; it += F.G * NTHREADS) {
        const int m = it >> 3, hq = it & 7, hkv = hq >> 2, t = m & (SEQ - 1);
        GAS bf16* qp = PROJ + (size_t)m * PP + CQ + hq * 64;
        float q[64]; float ss = 0.f;
#pragma unroll
        for (int c = 0; c < 8; ++c) { float v[8]; ld8(qp + 8 * c, v);
#pragma unroll
            for (int e = 0; e < 8; ++e) { q[8 * c + e] = v[e]; ss += v[e] * v[e]; } }
        const float rq = 1.0f / sqrtf(ss * (1.0f / 64.0f) + EPS);
#pragma unroll
        for (int d = 0; d < 64; ++d) q[d] = q[d] * rq * qg[d] * 0.125f * kg[d];
        const float sink = sinks[L * 8 + hq];
        float mrun = sink, l = 1.f; float acc[64];
#pragma unroll
        for (int d = 0; d < 64; ++d) acc[d] = 0.f;
        const int j0 = t - 127 > 0 ? t - 127 : 0;
        for (int j = j0; j <= t; ++j) {
            const GAS bf16* kp = PROJ + (size_t)(m - t + j) * PP + CK + hkv * 64;
            float dot = 0.f, sk = 0.f;
#pragma unroll
            for (int c = 0; c < 8; ++c) { float v[8]; ld8(kp + 8 * c, v);
#pragma unroll
                for (int e = 0; e < 8; ++e) { dot += q[8 * c + e] * v[e]; sk += v[e] * v[e]; } }
            const float s = dot / sqrtf(sk * (1.0f / 64.0f) + EPS) + rel_bias[t5_bucket(t - j) * 8 + hq];
            const float mn = fmaxf(mrun, s), a = expf(mrun - mn), p = expf(s - mn);
            l = l * a + p; mrun = mn;
            const GAS bf16* vp = kp + (CV - CK);
#pragma unroll
            for (int c = 0; c < 8; ++c) { float v[8]; ld8(vp + 8 * c, v);
#pragma unroll
                for (int e = 0; e < 8; ++e) acc[8 * c + e] = acc[8 * c + e] * a + p * v[e]; }
        }
        const float inv = 1.0f / l;
#pragma unroll
        for (int c = 0; c < 8; ++c) { v4u o; o.x = pk2(acc[8 * c] * inv, acc[8 * c + 1] * inv); o.y = pk2(acc[8 * c + 2] * inv, acc[8 * c + 3] * inv);
            o.z = pk2(acc[8 * c + 4] * inv, acc[8 * c + 5] * inv); o.w = pk2(acc[8 * c + 6] * inv, acc[8 * c + 7] * inv); *(GAS v4u*)(qp + 8 * c) = o; }
    }
}
__device__ __forceinline__ void conv_naive(Frame& F, int L) {
    const GAS float* conv_w = FIN(I_CONVW); const GAS float* conv_b = FIN(I_CONVB); const GAS bf16* PROJ = (const GAS bf16*)FWS(WS_PROJ); GAS float* XBCF = (GAS float*)FWS(WS_XBCF);
    for (int it = F.bid * NTHREADS + F.tid; it < M * 128; it += F.G * NTHREADS) {
        const int m = it >> 7, c0 = (it & 127) * 8, t = m & (SEQ - 1);
        float o[8];
#pragma unroll
        for (int e = 0; e < 8; ++e) o[e] = conv_b[L * 1024 + c0 + e];
#pragma unroll
        for (int k = 0; k < 4; ++k) { if (t - 3 + k >= 0) { float v[8]; ld8(PROJ + (size_t)(m - 3 + k) * PP + CX + c0, v);
#pragma unroll
                for (int e = 0; e < 8; ++e) o[e] += conv_w[(size_t)(L * 4 + k) * 1024 + c0 + e] * v[e]; } }
        f32x4 a, b; a.x = silu_f(o[0]); a.y = silu_f(o[1]); a.z = silu_f(o[2]); a.w = silu_f(o[3]); b.x = silu_f(o[4]); b.y = silu_f(o[5]); b.z = silu_f(o[6]); b.w = silu_f(o[7]);
        *(GAS f32x4*)(XBCF + (size_t)m * 1024 + c0) = a; *(GAS f32x4*)(XBCF + (size_t)m * 1024 + c0 + 4) = b;
    }
}
__device__ __forceinline__ void ssd_naive(Frame& F, int L) {
    if (F.wave != 0 || F.bid >= 64) return;
    const int b = F.bid >> 3, hh = F.bid & 7, g = hh >> 2, p = F.lane;
    const float a = -expf(FIN(I_ALOG)[L * 8 + hh]), dtb = FIN(I_DTB)[L * 8 + hh], dsk = FIN(I_DSKIP)[L * 8 + hh];
    const GAS float* DTRAW = (const GAS float*)FWS(WS_DTRAW); const GAS float* XBCF = (const GAS float*)FWS(WS_XBCF); GAS float* YN = (GAS float*)FWS(WS_YN);
    float st[128];
#pragma unroll
    for (int n = 0; n < 128; ++n) st[n] = 0.f;
    for (int t = 0; t < SEQ; ++t) {
        const size_t m = (size_t)b * SEQ + t;
        const float dtv = softplus_f(DTRAW[m * 8 + hh] + dtb), dA = expf(dtv * a), xv = XBCF[m * 1024 + hh * 64 + p], xd = xv * dtv;
        const GAS f32x4* Bp = (const GAS f32x4*)(XBCF + m * 1024 + 512 + g * 128); const GAS f32x4* Cp = (const GAS f32x4*)(XBCF + m * 1024 + 768 + g * 128);
        float y = 0.f;
#pragma unroll
        for (int n4 = 0; n4 < 32; ++n4) { const f32x4 bv = Bp[n4], cv = Cp[n4];
#pragma unroll
            for (int e = 0; e < 4; ++e) { st[4 * n4 + e] = st[4 * n4 + e] * dA + xd * bv[e]; y += cv[e] * st[4 * n4 + e]; } }
        YN[m * 512 + hh * 64 + p] = y + dsk * xv;
    }
}
__device__ __forceinline__ void gate_naive(Frame& F, int L) {
    const int gw = F.bid * NWAVES + F.wave, NGW = F.G * NWAVES;
    const GAS float* ssm_g = FIN(I_SSMG); GAS bf16* PROJ = (GAS bf16*)FWS(WS_PROJ); const GAS float* YN = (const GAS float*)FWS(WS_YN);
    for (int it = gw; it < M * 2; it += NGW) {
        const int m = it >> 1, g = it & 1, ch = g * 256 + 4 * F.lane;
        const f32x4 y = *(const GAS f32x4*)(YN + (size_t)m * 512 + ch);
        GAS bf16* zp = PROJ + (size_t)m * PP + CZ + ch;
        const v2u zw = *(const GAS v2u*)zp;
        float v[4]; v[0] = y.x * silu_f(bflo(zw.x)); v[1] = y.y * silu_f(bfhi(zw.x)); v[2] = y.z * silu_f(bflo(zw.y)); v[3] = y.w * silu_f(bfhi(zw.y));
        const float ss = wave_sum((v[0] * v[0] + v[1] * v[1]) + (v[2] * v[2] + v[3] * v[3]));
        const float r = 1.0f / sqrtf(ss * (1.0f / 256.0f) + EPS);
        const GAS float* ng = ssm_g + L * 512 + ch;
        v2u o; o.x = pk2(v[0] * r * ng[0], v[1] * r * ng[1]); o.y = pk2(v[2] * r * ng[2], v[3] * r * ng[3]);
        *(GAS v2u*)zp = o;
    }
}

typedef short bf16x8_t __attribute__((ext_vector_type(8)));
typedef float f32x16 __attribute__((ext_vector_type(16)));
constexpr float LOG2E = 1.4426950408889634f;
constexpr int AT_KS = 0, AT_KSTRIDE = 144, AT_VT = 36864, AT_VSTRIDE = 520, AT_BIAS = AT_VT + 64 * AT_VSTRIDE, AT_END = AT_BIAS + 2048;
static_assert(AT_END <= RING_BYTES, "attention LDS");
__device__ __forceinline__ unsigned pkbf(float lo, float hi) { return pg8::cvt_pk_bf16(lo, hi); }
__device__ __forceinline__ void attn_fast(Frame& F, int L) {
    GAS bf16* PROJ = (GAS bf16*)FWS(WS_PROJ);
    const GAS float* qg = FIN(I_QG) + L * 64; const GAS float* kg = FIN(I_KG) + L * 64; const GAS float* sinks = FIN(I_SINK) + L * 8; const GAS float* rel_bias = FIN(I_RELB);
    LAS unsigned char* Ks = F.lds + AT_KS; LAS unsigned char* Vt = F.lds + AT_VT; LAS float* biasT = (LAS float*)(F.lds + AT_BIAS);
    const int tid = F.tid, lane = F.lane, wave = F.wave, q = lane & 31, hh = lane >> 5;
    for (int unit = F.bid; unit < BATCH * 2 * 16; unit += F.G) {
        const int b = unit >> 5, kvh = (unit >> 4) & 1, qb = unit & 15;
        const size_t m0 = (size_t)b * SEQ + qb * 128;
        __syncthreads();
        { const int gi = tid >> 7, dist = tid & 127; biasT[tid] = rel_bias[t5_bucket(dist) * 8 + kvh * 4 + gi] * LOG2E; }
#pragma unroll
        for (int i = 0; i < 4; ++i) {
            const int c = tid + NTHREADS * i, key = c >> 3, part = c & 7;
            const bool valid = (qb > 0) || (key >= 128);
            v4u kw = {0u, 0u, 0u, 0u}, vw = {0u, 0u, 0u, 0u};
            if (valid) { const GAS bf16* kp = PROJ + (m0 + key - 128) * PP + CK + kvh * 64 + part * 8; kw = *(const GAS v4u*)kp; vw = *(const GAS v4u*)(kp + (CV - CK)); }
            float kv[8]; kv[0] = bflo(kw.x); kv[1] = bfhi(kw.x); kv[2] = bflo(kw.y); kv[3] = bfhi(kw.y); kv[4] = bflo(kw.z); kv[5] = bfhi(kw.z); kv[6] = bflo(kw.w); kv[7] = bfhi(kw.w);
            float ss = 0.f;
#pragma unroll
            for (int e = 0; e < 8; ++e) ss += kv[e] * kv[e];
            ss += __shfl_xor(ss, 1); ss += __shfl_xor(ss, 2); ss += __shfl_xor(ss, 4);
            const float rk = 1.0f / sqrtf(ss * (1.0f / 64.0f) + EPS);
            const f32x4 g0 = *(const GAS f32x4*)(kg + part * 8), g1 = *(const GAS f32x4*)(kg + part * 8 + 4);
            v4u ko; ko.x = pkbf(kv[0] * rk * g0.x, kv[1] * rk * g0.y); ko.y = pkbf(kv[2] * rk * g0.z, kv[3] * rk * g0.w); ko.z = pkbf(kv[4] * rk * g1.x, kv[5] * rk * g1.y); ko.w = pkbf(kv[6] * rk * g1.z, kv[7] * rk * g1.w);
            *(LAS v4u*)(Ks + key * AT_KSTRIDE + part * 16) = ko;
            LAS unsigned short* vt = (LAS unsigned short*)(Vt + (part * 8) * AT_VSTRIDE + key * 2);
            vt[0 * (AT_VSTRIDE / 2)] = (unsigned short)(vw.x & 0xffffu); vt[1 * (AT_VSTRIDE / 2)] = (unsigned short)(vw.x >> 16);
            vt[2 * (AT_VSTRIDE / 2)] = (unsigned short)(vw.y & 0xffffu); vt[3 * (AT_VSTRIDE / 2)] = (unsigned short)(vw.y >> 16);
            vt[4 * (AT_VSTRIDE / 2)] = (unsigned short)(vw.z & 0xffffu); vt[5 * (AT_VSTRIDE / 2)] = (unsigned short)(vw.z >> 16);
            vt[6 * (AT_VSTRIDE / 2)] = (unsigned short)(vw.w & 0xffffu); vt[7 * (AT_VSTRIDE / 2)] = (unsigned short)(vw.w >> 16);
        }
        LDS_WAIT(); __syncthreads();
        const int gi = wave >> 1, qh = wave & 1, hq = kvh * 4 + gi;
        const float sink2 = sinks[hq] * LOG2E;
#pragma unroll 1
        for (int s = 0; s < 2; ++s) {
            const int a = 64 * qh + 32 * s;
            GAS bf16* qrow = PROJ + (m0 + a + q) * PP + CQ + hq * 64;
            float qv[4][8]; float ss = 0.f;
#pragma unroll
            for (int d0 = 0; d0 < 4; ++d0) { ld8(qrow + d0 * 16 + hh * 8, qv[d0]);
#pragma unroll
                for (int e = 0; e < 8; ++e) ss += qv[d0][e] * qv[d0][e]; }
            ss += __shfl_xor(ss, 32);
            const float rq = (1.0f / sqrtf(ss * (1.0f / 64.0f) + EPS)) * (0.125f * LOG2E);
            bf16x8_t qf[4];
#pragma unroll
            for (int d0 = 0; d0 < 4; ++d0) { const f32x4 g0 = *(const GAS f32x4*)(qg + d0 * 16 + hh * 8), g1 = *(const GAS f32x4*)(qg + d0 * 16 + hh * 8 + 4);
                v4u w; w.x = pkbf(qv[d0][0] * rq * g0.x, qv[d0][1] * rq * g0.y); w.y = pkbf(qv[d0][2] * rq * g0.z, qv[d0][3] * rq * g0.w);
                w.z = pkbf(qv[d0][4] * rq * g1.x, qv[d0][5] * rq * g1.y); w.w = pkbf(qv[d0][6] * rq * g1.z, qv[d0][7] * rq * g1.w);
                qf[d0] = __builtin_bit_cast(bf16x8_t, w); }
            f32x16 S[5];
#pragma unroll
            for (int kt = 0; kt < 5; ++kt) { f32x16 acc = {};
#pragma unroll
                for (int d0 = 0; d0 < 4; ++d0) { const bf16x8_t kf = *(const LAS bf16x8_t*)(Ks + (a + 32 * kt + q) * AT_KSTRIDE + d0 * 32 + hh * 16);
                    acc = __builtin_amdgcn_mfma_f32_32x32x16_bf16(kf, qf[d0], acc, 0, 0, 0); }
                S[kt] = acc; }
            float mx = sink2;
#pragma unroll
            for (int kt = 0; kt < 5; ++kt)
#pragma unroll
                for (int i = 0; i < 16; ++i) { const int cr = (i & 3) + 8 * (i >> 2) + 4 * hh, dist = 128 + q - 32 * kt - cr, kidx = a + 32 * kt + cr;
                    const bool ok = (dist >= 0) && (dist < 128) && ((qb > 0) || (kidx >= 128));
                    const float v = ok ? S[kt][i] + biasT[gi * 128 + (dist & 127)] : -INFINITY;
                    S[kt][i] = v; mx = fmaxf(mx, v); }
            mx = fmaxf(mx, __shfl_xor(mx, 32));
            float lsum = 0.f; bf16x8_t pf[5][2];
#pragma unroll
            for (int kt = 0; kt < 5; ++kt) {
#pragma unroll
                for (int i = 0; i < 16; ++i) { const float p = __builtin_amdgcn_exp2f(S[kt][i] - mx); S[kt][i] = p; lsum += p; }
#pragma unroll
                for (int s2 = 0; s2 < 2; ++s2) { v4u w; w.x = pkbf(S[kt][8 * s2 + 0], S[kt][8 * s2 + 1]); w.y = pkbf(S[kt][8 * s2 + 2], S[kt][8 * s2 + 3]);
                    w.z = pkbf(S[kt][8 * s2 + 4], S[kt][8 * s2 + 5]); w.w = pkbf(S[kt][8 * s2 + 6], S[kt][8 * s2 + 7]); pf[kt][s2] = __builtin_bit_cast(bf16x8_t, w); } }
            lsum += __shfl_xor(lsum, 32);
            lsum += __builtin_amdgcn_exp2f(sink2 - mx);
            f32x16 O[2] = {{}, {}};
#pragma unroll
            for (int kt = 0; kt < 5; ++kt)
#pragma unroll
                for (int s2 = 0; s2 < 2; ++s2)
#pragma unroll
                    for (int db = 0; db < 2; ++db) { const LAS unsigned char* vb = Vt + (32 * db + q) * AT_VSTRIDE + (a + 32 * kt + 16 * s2 + 4 * hh) * 2;
                        const v2u lo = *(const LAS v2u*)vb, hi2 = *(const LAS v2u*)(vb + 16); v4u w; w.x = lo.x; w.y = lo.y; w.z = hi2.x; w.w = hi2.y;
                        O[db] = __builtin_amdgcn_mfma_f32_32x32x16_bf16(__builtin_bit_cast(bf16x8_t, w), pf[kt][s2], O[db], 0, 0, 0); }
            const float inv = 1.0f / lsum;
#pragma unroll
            for (int db = 0; db < 2; ++db)
#pragma unroll
                for (int g4 = 0; g4 < 4; ++g4) { v2u w; w.x = pkbf(O[db][4 * g4] * inv, O[db][4 * g4 + 1] * inv); w.y = pkbf(O[db][4 * g4 + 2] * inv, O[db][4 * g4 + 3] * inv);
                    *(GAS v2u*)(qrow + 32 * db + 8 * g4 + 4 * hh) = w; }
        }
    }
}

constexpr size_t WS_ACS = 2 * MiB + 512 * 1024, WS_CHDEC = 3 * MiB;
constexpr size_t WS_STATES = 154 * MiB, WS_YPART = 186 * MiB, WS_CC = 218 * MiB, WS_PREV = 226 * MiB;
constexpr int SD_CM = 0, SD_BM = 34816, SD_BMT = 69632, SD_DT = 104448, SD_ACS = SD_DT + 2048, SD_WT = SD_ACS + 2048, SD_END = SD_WT + 64;
constexpr int SD_ROW = 272, SD_XT = 264, SD_HIMG = 64 * SD_XT + 64 * SD_ROW;
static_assert(2 * SD_HIMG <= SD_BMT && SD_END <= RING_BYTES, "SSD LDS map");
__device__ __forceinline__ int crow32(int i, int hh) { return (i & 3) + 8 * (i >> 2) + 4 * hh; }
__device__ __forceinline__ void conv8x4(const GAS bf16* PROJ, size_t m0, int c, int l0, int col0, const GAS float* cw, const GAS float* cbias, float (&out)[4][8]) {
    float w[4][8], bs[8], u[7][8];
#pragma unroll
    for (int k = 0; k < 4; ++k) { const f32x4 a = *(const GAS f32x4*)(cw + k * 1024), b = *(const GAS f32x4*)(cw + k * 1024 + 4); w[k][0] = a.x; w[k][1] = a.y; w[k][2] = a.z; w[k][3] = a.w; w[k][4] = b.x; w[k][5] = b.y; w[k][6] = b.z; w[k][7] = b.w; }
    { const f32x4 a = *(const GAS f32x4*)cbias, b = *(const GAS f32x4*)(cbias + 4); bs[0] = a.x; bs[1] = a.y; bs[2] = a.z; bs[3] = a.w; bs[4] = b.x; bs[5] = b.y; bs[6] = b.z; bs[7] = b.w; }
#pragma unroll
    for (int i = 0; i < 7; ++i) { const int row = l0 - 3 + i;
        if (c > 0 || row >= 0) ld8(PROJ + (size_t)((long)m0 + row) * PP + col0, u[i]);
        else {
#pragma unroll
            for (int e = 0; e < 8; ++e) u[i][e] = 0.f; } }
#pragma unroll
    for (int r = 0; r < 4; ++r)
#pragma unroll
        for (int e = 0; e < 8; ++e) out[r][e] = silu_f(bs[e] + w[0][e] * u[r][e] + w[1][e] * u[r + 1][e] + w[2][e] * u[r + 2][e] + w[3][e] * u[r + 3][e]);
}
__device__ __forceinline__ void ssd1_fast(Frame& F, int L) {
    const GAS bf16* PROJ = (const GAS bf16*)FWS(WS_PROJ);
    const GAS float* conv_w = FIN(I_CONVW) + (size_t)L * 4 * 1024; const GAS float* conv_b = FIN(I_CONVB) + L * 1024;
    const GAS float* dt_bias = FIN(I_DTB) + L * 8; const GAS float* a_log = FIN(I_ALOG) + L * 8; const GAS float* d_skip = FIN(I_DSKIP) + L * 8;
    const GAS float* DTRAW = (const GAS float*)FWS(WS_DTRAW); GAS float* ACS = (GAS float*)FWS(WS_ACS); GAS float* CHDEC = (GAS float*)FWS(WS_CHDEC);
    GAS float* STATES = (GAS float*)FWS(WS_STATES); GAS float* YPART = (GAS float*)FWS(WS_YPART); GAS bf16* CC = (GAS bf16*)FWS(WS_CC);
    LAS unsigned char* Cm = F.lds + SD_CM; LAS unsigned char* Bm = F.lds + SD_BM; LAS unsigned char* BmT = F.lds + SD_BMT;
    LAS float* dt_l = (LAS float*)(F.lds + SD_DT); LAS float* acs_l = (LAS float*)(F.lds + SD_ACS); LAS float* wt = (LAS float*)(F.lds + SD_WT);
    const int wave = F.wave;
    for (int unit = F.bid; unit < BATCH * 16 * 2; unit += F.G) {
        const int b = unit >> 5, c = (unit >> 1) & 15, g = unit & 1;
        const size_t m0 = (size_t)b * SEQ + c * 128;
        int tid = F.tid; asm volatile("" : "+v"(tid));
        int lane = tid & 63, q = lane & 31, hh = lane >> 5;
        __syncthreads();
        { const int r = tid >> 7, l = tid & 127, head = 4 * g + r;
          const float dtv = softplus_f(DTRAW[(m0 + l) * 8 + head] + dt_bias[head]);
          float v = dtv * (-expf(a_log[head]));
#pragma unroll
          for (int o = 1; o < 64; o <<= 1) { const float t = __shfl_up(v, o); if (lane >= o) v += t; }
          if (lane == 63) wt[wave] = v;
          LDS_WAIT(); __syncthreads();
          if (wave & 1) v += wt[wave - 1];
          dt_l[tid] = dtv; acs_l[tid] = v; ACS[(m0 + l) * 8 + head] = v;
          if (l == 127) CHDEC[(size_t)(b * 16 + c) * 8 + head] = expf(v); }
#pragma unroll 1
        for (int it = tid; it < 1024; it += NTHREADS) {
            const int cg = it & 31, rg = it >> 5, isC = cg >> 4, n0 = (cg & 15) * 8, col0 = (isC ? CCM : CBM) + g * 128 + n0, l0 = 4 * rg;
            float o[4][8];
            conv8x4(PROJ, m0, c, l0, col0, conv_w + (col0 - CX), conv_b + (col0 - CX), o);
#pragma unroll
            for (int r = 0; r < 4; ++r) { const int l = l0 + r;
                v4u pk; pk.x = pkbf(o[r][0], o[r][1]); pk.y = pkbf(o[r][2], o[r][3]); pk.z = pkbf(o[r][4], o[r][5]); pk.w = pkbf(o[r][6], o[r][7]);
                *(LAS v4u*)((isC ? Cm : Bm) + l * SD_ROW + n0 * 2) = pk;
                if (isC) *(GAS v4u*)(CC + (m0 + l) * 256 + g * 128 + n0) = pk;
                else { LAS unsigned short* t = (LAS unsigned short*)(BmT + n0 * SD_ROW + l * 2);
                    t[0 * (SD_ROW / 2)] = (unsigned short)(pk.x & 0xffffu); t[1 * (SD_ROW / 2)] = (unsigned short)(pk.x >> 16); t[2 * (SD_ROW / 2)] = (unsigned short)(pk.y & 0xffffu); t[3 * (SD_ROW / 2)] = (unsigned short)(pk.y >> 16);
                    t[4 * (SD_ROW / 2)] = (unsigned short)(pk.z & 0xffffu); t[5 * (SD_ROW / 2)] = (unsigned short)(pk.z >> 16); t[6 * (SD_ROW / 2)] = (unsigned short)(pk.w & 0xffffu); t[7 * (SD_ROW / 2)] = (unsigned short)(pk.w >> 16); } }
        }
        LDS_WAIT(); __syncthreads();
        asm volatile("" : "+v"(tid)); lane = tid & 63; q = lane & 31; hh = lane >> 5;
        const int j = (wave < 4) ? (wave & 3) : 3 - (wave & 3);
        f32x16 cbT[4];
        { bf16x8_t cf[8];
#pragma unroll
          for (int ks = 0; ks < 8; ++ks) cf[ks] = *(const LAS bf16x8_t*)(Cm + (32 * j + q) * SD_ROW + (16 * ks + 8 * hh) * 2);
#pragma unroll
          for (int i = 0; i < 4; ++i) { f32x16 acc = {};
              if (i <= j) {
#pragma unroll
                  for (int ks = 0; ks < 8; ++ks) { const bf16x8_t bfr = *(const LAS bf16x8_t*)(Bm + (32 * i + q) * SD_ROW + (16 * ks + 8 * hh) * 2);
                      acc = __builtin_amdgcn_mfma_f32_32x32x16_bf16(bfr, cf[ks], acc, 0, 0, 0); } }
              cbT[i] = acc; } }
#pragma unroll 1
        for (int hp = 0; hp < 2; ++hp) {
            __syncthreads();
            asm volatile("" : "+v"(tid)); lane = tid & 63; q = lane & 31; hh = lane >> 5;
            { const int cg = tid & 15, rg = tid >> 4, h2 = cg >> 3, p0 = (cg & 7) * 8, r = 2 * hp + h2, col0 = CX + (4 * g + r) * 64 + p0, l0 = 4 * rg;
              float o[4][8];
              conv8x4(PROJ, m0, c, l0, col0, conv_w + (col0 - CX), conv_b + (col0 - CX), o);
              LAS unsigned char* T1 = F.lds + h2 * SD_HIMG; LAS unsigned char* T2 = T1 + 64 * SD_XT;
              const float aend = acs_l[r * 128 + 127];
#pragma unroll
              for (int rr = 0; rr < 4; ++rr) { const int l = l0 + rr; const float dtv = dt_l[r * 128 + l], wl = expf(aend - acs_l[r * 128 + l]);
#pragma unroll
                  for (int e = 0; e < 8; ++e) { const float xd = o[rr][e] * dtv;
                      *(LAS unsigned short*)(T1 + (p0 + e) * SD_XT + l * 2) = (unsigned short)f2bf(xd);
                      *(LAS unsigned short*)(T2 + (p0 + e) * SD_ROW + l * 2) = (unsigned short)f2bf(xd * wl); } } }
            LDS_WAIT(); __syncthreads();
            asm volatile("" : "+v"(tid)); lane = tid & 63; q = lane & 31; hh = lane >> 5;
            const int h2 = wave >> 2, r = 2 * hp + h2, head = 4 * g + r;
            const LAS unsigned char* T1 = F.lds + h2 * SD_HIMG; const LAS unsigned char* T2 = T1 + 64 * SD_XT;
            {
              const float acl = acs_l[r * 128 + 32 * j + q], diag = d_skip[head] / dt_l[r * 128 + 32 * j + q];
              f32x16 O[2] = {{}, {}};
#pragma unroll
              for (int i = 0; i < 4; ++i) { if (i <= j) {
                  int qq = q; asm volatile("" : "+v"(qq));
                  float xv[16];
#pragma unroll
                  for (int e = 0; e < 16; ++e) { const int cr = crow32(e, hh); const float dec = __builtin_amdgcn_exp2f((acl - acs_l[r * 128 + 32 * i + cr]) * LOG2E);
                      const bool ok = (i < j) || (cr <= qq);
                      float v = ok ? cbT[i][e] * dec : 0.f;
                      if (i == j && cr == qq) v += diag;
                      xv[e] = v; }
#pragma unroll
                  for (int s2 = 0; s2 < 2; ++s2) { v4u w; w.x = pkbf(xv[8 * s2 + 0], xv[8 * s2 + 1]); w.y = pkbf(xv[8 * s2 + 2], xv[8 * s2 + 3]); w.z = pkbf(xv[8 * s2 + 4], xv[8 * s2 + 5]); w.w = pkbf(xv[8 * s2 + 6], xv[8 * s2 + 7]);
                      const bf16x8_t xf = __builtin_bit_cast(bf16x8_t, w);
#pragma unroll
                      for (int pt = 0; pt < 2; ++pt) { const LAS unsigned char* ab = T1 + (32 * pt + q) * SD_XT + (32 * i + 16 * s2 + 4 * hh) * 2;
                          const v2u lo = *(const LAS v2u*)ab, hi2 = *(const LAS v2u*)(ab + 16); v4u aw; aw.x = lo.x; aw.y = lo.y; aw.z = hi2.x; aw.w = hi2.y;
                          O[pt] = __builtin_amdgcn_mfma_f32_32x32x16_bf16(__builtin_bit_cast(bf16x8_t, aw), xf, O[pt], 0, 0, 0); } } } }
              GAS float* yp = YPART + (m0 + 32 * j + q) * 512 + head * 64;
#pragma unroll
              for (int pt = 0; pt < 2; ++pt)
#pragma unroll
                  for (int g4 = 0; g4 < 4; ++g4) { f32x4 v; v.x = O[pt][4 * g4]; v.y = O[pt][4 * g4 + 1]; v.z = O[pt][4 * g4 + 2]; v.w = O[pt][4 * g4 + 3];
                      *(GAS f32x4*)(yp + 32 * pt + 8 * g4 + 4 * hh) = v; } }
            asm volatile("" : "+v"(tid)); lane = tid & 63; q = lane & 31; hh = lane >> 5;
            {
              const int nt = wave & 3;
              f32x16 St[2] = {{}, {}};
#pragma unroll
              for (int ks = 0; ks < 8; ++ks) { const bf16x8_t bfr = *(const LAS bf16x8_t*)(BmT + (32 * nt + q) * SD_ROW + (16 * ks + 8 * hh) * 2);
#pragma unroll
                  for (int pt = 0; pt < 2; ++pt) { const bf16x8_t af = *(const LAS bf16x8_t*)(T2 + (32 * pt + q) * SD_ROW + (16 * ks + 8 * hh) * 2);
                      St[pt] = __builtin_amdgcn_mfma_f32_32x32x16_bf16(af, bfr, St[pt], 0, 0, 0); } }
              GAS float* sp = STATES + ((size_t)(b * 16 + c) * 8 + head) * 8192 + 32 * nt + q;
#pragma unroll
              for (int pt = 0; pt < 2; ++pt)
#pragma unroll
                  for (int e = 0; e < 16; ++e) sp[(32 * pt + crow32(e, hh)) * 128] = St[pt][e]; }
        }
    }
}
__device__ __forceinline__ void ssd2_scan(Frame& F, int L) {
    const GAS float* STATES = (const GAS float*)FWS(WS_STATES); const GAS float* CHDEC = (const GAS float*)FWS(WS_CHDEC); GAS bf16* PREV = (GAS bf16*)FWS(WS_PREV);
    for (int idx = F.bid * NTHREADS + F.tid; idx < BATCH * 8 * 64 * 32; idx += F.G * NTHREADS) {
        const int n4 = idx & 31, p = (idx >> 5) & 63, head = (idx >> 11) & 7, b = idx >> 14;
        f32x4 s[16]; float dec[16];
#pragma unroll
        for (int c = 0; c < 16; ++c) { const size_t o = ((size_t)(b * 16 + c) * 8 + head) * 8192 + p * 128 + 4 * n4; s[c] = *(const GAS f32x4*)(STATES + o); dec[c] = CHDEC[(size_t)(b * 16 + c) * 8 + head]; }
        f32x4 h = {0.f, 0.f, 0.f, 0.f};
#pragma unroll
        for (int c = 0; c < 16; ++c) { const size_t o = ((size_t)(b * 16 + c) * 8 + head) * 8192 + p * 128 + 4 * n4;
            v2u w; w.x = pkbf(h.x, h.y); w.y = pkbf(h.z, h.w); *(GAS v2u*)(PREV + o) = w;
            h = h * dec[c] + s[c]; }
    }
}
__device__ __forceinline__ void ssd3_fast(Frame& F, int L) {
    GAS bf16* PROJ = (GAS bf16*)FWS(WS_PROJ); const GAS bf16* PREV = (const GAS bf16*)FWS(WS_PREV); const GAS bf16* CC = (const GAS bf16*)FWS(WS_CC);
    const GAS float* YPART = (const GAS float*)FWS(WS_YPART); const GAS float* ACS = (const GAS float*)FWS(WS_ACS); const GAS float* ssm_g = FIN(I_SSMG) + L * 512;
    LAS float* exch = (LAS float*)(F.lds);
    const int lane = F.lane, wave = F.wave, q = lane & 31, hh = lane >> 5;
    for (int unit = F.bid; unit < BATCH * 16 * 2; unit += F.G) {
        const int b = unit >> 5, c = (unit >> 1) & 15, g = unit & 1;
        const size_t m0 = (size_t)b * SEQ + c * 128;
        const int j = wave & 3, hp = wave >> 2;
        const size_t row = m0 + 32 * j + q;
        bf16x8_t cf[8];
#pragma unroll
        for (int ks = 0; ks < 8; ++ks) cf[ks] = *(const GAS bf16x8_t*)(CC + row * 256 + g * 128 + 16 * ks + 8 * hh);
        float v[2][2][16]; float ss = 0.f;
#pragma unroll
        for (int h2 = 0; h2 < 2; ++h2) { const int head = 4 * g + 2 * hp + h2;
            const GAS bf16* pv = PREV + ((size_t)(b * 16 + c) * 8 + head) * 8192;
            f32x16 O[2] = {{}, {}};
#pragma unroll
            for (int ks = 0; ks < 8; ++ks)
#pragma unroll
                for (int pt = 0; pt < 2; ++pt) { const bf16x8_t af = *(const GAS bf16x8_t*)(pv + (32 * pt + q) * 128 + 16 * ks + 8 * hh);
                    O[pt] = __builtin_amdgcn_mfma_f32_32x32x16_bf16(af, cf[ks], O[pt], 0, 0, 0); }
            const float ea = expf(ACS[row * 8 + head]);
#pragma unroll
            for (int pt = 0; pt < 2; ++pt)
#pragma unroll
                for (int g4 = 0; g4 < 4; ++g4) { const int p = 32 * pt + 8 * g4 + 4 * hh;
                    const f32x4 yp = *(const GAS f32x4*)(YPART + row * 512 + head * 64 + p);
                    const v2u zw = *(const GAS v2u*)(PROJ + row * PP + CZ + head * 64 + p);
                    const float y0 = yp.x + ea * O[pt][4 * g4], y1 = yp.y + ea * O[pt][4 * g4 + 1], y2 = yp.z + ea * O[pt][4 * g4 + 2], y3 = yp.w + ea * O[pt][4 * g4 + 3];
                    const float u0 = y0 * silu_f(bflo(zw.x)), u1 = y1 * silu_f(bfhi(zw.x)), u2 = y2 * silu_f(bflo(zw.y)), u3 = y3 * silu_f(bfhi(zw.y));
                    v[h2][pt][4 * g4] = u0; v[h2][pt][4 * g4 + 1] = u1; v[h2][pt][4 * g4 + 2] = u2; v[h2][pt][4 * g4 + 3] = u3;
                    ss += (u0 * u0 + u1 * u1) + (u2 * u2 + u3 * u3); } }
        ss += __shfl_xor(ss, 32);
        __syncthreads();
        if (hh == 0) exch[hp * 128 + 32 * j + q] = ss;
        LDS_WAIT(); __syncthreads();
        const float tot = exch[32 * j + q] + exch[128 + 32 * j + q];
        const float rn = 1.0f / sqrtf(tot * (1.0f / 256.0f) + EPS);
#pragma unroll
        for (int h2 = 0; h2 < 2; ++h2) { const int head = 4 * g + 2 * hp + h2;
#pragma unroll
            for (int pt = 0; pt < 2; ++pt)
#pragma unroll
                for (int g4 = 0; g4 < 4; ++g4) { const int p = 32 * pt + 8 * g4 + 4 * hh;
                    const f32x4 ng = *(const GAS f32x4*)(ssm_g + head * 64 + p);
                    v2u w; w.x = pkbf(v[h2][pt][4 * g4] * rn * ng.x, v[h2][pt][4 * g4 + 1] * rn * ng.y); w.y = pkbf(v[h2][pt][4 * g4 + 2] * rn * ng.z, v[h2][pt][4 * g4 + 3] * rn * ng.w);
                    *(GAS v2u*)(PROJ + row * PP + CZ + head * 64 + p) = w; } }
    }
}

__device__ __forceinline__ void ph_inproj(Frame& F, int L) {
    LAS float* rstd_tab = (LAS float*)(F.lds + RSTD_OFF);
    int bid_ = F.bid; asm volatile("" : "+s"(bid_)); pg8::StaticOrder S; S.init(M, NPROJ, F.G, bid_);
    rstd_prepass(F, S, rstd_tab);
    pg8::Gemm g{(const GAS bf16*)FWS(WS_XB), (const GAS bf16*)FWS(WS_WIN) + (size_t)L * NPROJ * D, M, NPROJ, D, D};
    pg8::EpiProj E{(GAS bf16*)FWS(WS_PROJ), (GAS float*)FWS(WS_DTRAW), (const LAS float*)rstd_tab};
    pg8::gemm_phase<pg8::EpiProj, pg8::StaticOrder, true, true>(F.lds + RING_OFF, g, S, E);
}
__device__ __forceinline__ void ph_outproj(Frame& F, int L) {
    int bid_ = F.bid; asm volatile("" : "+s"(bid_)); pg8::StaticOrder S; S.init(M, D, F.G, bid_);
    pg8::Gemm g{(const GAS bf16*)FWS(WS_PROJ), (const GAS bf16*)FWS(WS_WOUT) + (size_t)L * D * D, M, D, D, PP};
    GAS float* out = (GAS float*)ptr_at(F, I_OUT);
    pg8::EpiRes E{L == 0 ? FIN(I_X) : (const GAS float*)out, out, (GAS bf16*)FWS(WS_XB), (GAS float*)FWS(WS_SSQ)};
    pg8::gemm_phase<pg8::EpiRes, pg8::StaticOrder, false, true>(F.lds + RING_OFF, g, S, E);
}
__device__ __forceinline__ void ph_up(Frame& F, int L) {
    LAS float* rstd_tab = (LAS float*)(F.lds + RSTD_OFF);
    int bid_ = F.bid; asm volatile("" : "+s"(bid_)); pg8::StaticOrder S; S.init(M, FF, F.G, bid_);
    rstd_prepass(F, S, rstd_tab);
    pg8::Gemm g{(const GAS bf16*)FWS(WS_XB), (const GAS bf16*)FWS(WS_WUP) + (size_t)L * FF * D, M, FF, D, D};
    pg8::EpiUp E{(GAS bf16*)FWS(WS_HID), FF, (const LAS float*)rstd_tab};
    pg8::gemm_phase<pg8::EpiUp, pg8::StaticOrder, true, true>(F.lds + RING_OFF, g, S, E);
}
__device__ __forceinline__ void ph_down(Frame& F, int L) {
    int bid_ = F.bid; asm volatile("" : "+s"(bid_)); pg8::StaticOrder S; S.init(M, D, F.G, bid_);
    pg8::Gemm g{(const GAS bf16*)FWS(WS_HID), (const GAS bf16*)FWS(WS_WDOWN) + (size_t)L * D * FF, M, D, FF, FF};
    GAS float* out = (GAS float*)ptr_at(F, I_OUT);
    pg8::EpiRes E{(const GAS float*)out, out, (GAS bf16*)FWS(WS_XB), (GAS float*)FWS(WS_SSQ)};
    pg8::gemm_phase<pg8::EpiRes, pg8::StaticOrder, false, true>(F.lds + RING_OFF, g, S, E);
}

struct Args { const float* in[17]; float* out; unsigned char* ws; int ph_lo, ph_hi; };
#define FRAME_INIT() \
    extern __shared__ __attribute__((aligned(16))) unsigned char lds[]; \
    Frame F; \
    F.lds = (LAS unsigned char*)lds; \
    F.tid = threadIdx.x; F.lane = F.tid & 63; F.wave = __builtin_amdgcn_readfirstlane(F.tid >> 6); F.bid = blockIdx.x; F.G = gridDim.x; \
    for (int u = F.tid; u < (LDS_BYTES - LDSCTL_OFF) / 4; u += NTHREADS) ((LAS unsigned*)(F.lds + LDSCTL_OFF))[u] = 0u; \
    __syncthreads(); \
    if (F.tid < I_NPTR) { const unsigned long long p = F.tid < 17 ? (unsigned long long)args.in[F.tid < 17 ? F.tid : 0] : (F.tid == I_OUT ? (unsigned long long)args.out : (unsigned long long)args.ws); \
        LAS unsigned* t = (LAS unsigned*)(F.lds + PTR_OFF) + 2 * F.tid; t[0] = (unsigned)p; t[1] = (unsigned)(p >> 32); } \
    LDS_WAIT(); __syncthreads();

#if !ONE_LAUNCH
__global__ void __launch_bounds__(NTHREADS, 2) k_mix1_naive(Args args) { FRAME_INIT(); attn_naive(F, args.ph_lo); conv_naive(F, args.ph_lo); }
__global__ void __launch_bounds__(NTHREADS, 2) k_mix2_naive(Args args) { FRAME_INIT(); ssd_naive(F, args.ph_lo); }
__global__ void __launch_bounds__(NTHREADS, 2) k_mix3_naive(Args args) { FRAME_INIT(); gate_naive(F, args.ph_lo); }
#endif
#define PH_MIX1(F, L) do { attn_fast(F, L); ssd1_fast(F, L); } while (0)
#define PH_MIX2(F, L) ssd2_scan(F, L)
#define PH_MIX3(F, L) ssd3_fast(F, L)

__global__ void __launch_bounds__(NTHREADS, 2) fwd(Args args) {
    FRAME_INIT();
    const int lo = args.ph_lo, hi = args.ph_hi;
#if ONE_LAUNCH
    XcdBarrier bar = xcd_barrier_post((unsigned*)(unsigned char*)(FWS(WS_CTL)) + CW_BAR, (volatile LAS unsigned*)(F.lds + MISC_OFF) + 8);
#define GRID_BAR() xcd_barrier(bar)
#else
#define GRID_BAR() do {} while (0)
#endif
#define IN(k) (lo <= (k) && (k) < hi)
#define RELAUNDER() do { int t_ = threadIdx.x; asm volatile("" : "+v"(t_)); F.tid = t_; F.lane = t_ & 63; F.wave = __builtin_amdgcn_readfirstlane(t_ >> 6); \
    int b_ = blockIdx.x; asm volatile("" : "+s"(b_)); F.bid = b_; } while (0)
#define SEAM(k) do { if (IN(k) && IN((k) + 1)) GRID_BAR(); } while (0)

    if (IN(0)) { p0_prologue(F); SEAM(0); }
    for (int L = 0; L < DEPTH; ++L) {
        const int pb = 1 + 7 * L;
        if (IN(pb + 0)) { RELAUNDER(); ph_inproj(F, L); SEAM(pb + 0); }
        if (IN(pb + 1)) { RELAUNDER(); PH_MIX1(F, L); SEAM(pb + 1); }
        if (IN(pb + 2)) { RELAUNDER(); PH_MIX2(F, L); SEAM(pb + 2); }
        if (IN(pb + 3)) { RELAUNDER(); PH_MIX3(F, L); SEAM(pb + 3); }
        if (IN(pb + 4)) { RELAUNDER(); ph_outproj(F, L); SEAM(pb + 4); }
        if (IN(pb + 5)) { RELAUNDER(); ph_up(F, L); SEAM(pb + 5); }
        if (IN(pb + 6)) { RELAUNDER(); ph_down(F, L); SEAM(pb + 6); }
    }
#undef IN
#undef SEAM
}

extern "C" void kernel_launch(void* const* d_in, const int* in_sizes, int n_in, void* d_out, int out_size, void* d_ws, size_t ws_size, hipStream_t stream) {
    static int grid = 0;
    if (grid == 0) {
        if (n_in != 17 || in_sizes[0] != M * D || out_size != M * D || ws_size < WS_END) { fprintf(stderr, "kernel_launch: unexpected shapes (n_in %d, in0 %d, out %d, ws %zu)\n", n_in, n_in > 0 ? in_sizes[0] : -1, out_size, ws_size); grid = -1; return; }
        int dev = 0, cus = 0, per_cu = 0;
        if (hipGetDevice(&dev) != hipSuccess || hipDeviceGetAttribute(&cus, hipDeviceAttributeMultiprocessorCount, dev) != hipSuccess) { grid = -1; return; }
        if (hipFuncSetAttribute((const void*)fwd, hipFuncAttributeMaxDynamicSharedMemorySize, LDS_BYTES) != hipSuccess) { fprintf(stderr, "kernel_launch: hipFuncSetAttribute failed\n"); grid = -1; return; }
#if !ONE_LAUNCH
        (void)hipFuncSetAttribute((const void*)k_mix1_naive, hipFuncAttributeMaxDynamicSharedMemorySize, LDS_BYTES);
        (void)hipFuncSetAttribute((const void*)k_mix2_naive, hipFuncAttributeMaxDynamicSharedMemorySize, LDS_BYTES);
        (void)hipFuncSetAttribute((const void*)k_mix3_naive, hipFuncAttributeMaxDynamicSharedMemorySize, LDS_BYTES);
#endif
        if (hipOccupancyMaxActiveBlocksPerMultiprocessor(&per_cu, (const void*)fwd, NTHREADS, LDS_BYTES) != hipSuccess || per_cu < 1) { fprintf(stderr, "kernel_launch: occupancy query says %d\n", per_cu); per_cu = 1; }
        (void)hipGetLastError();
        grid = cus;
    }
    if (grid < 0) return;
    (void)hipMemsetAsync((char*)d_ws + WS_CTL, 0, CTL_ZERO_BYTES, stream);
    Args a{};
    for (int i = 0; i < 17; ++i) a.in[i] = (const float*)d_in[i];
    a.out = (float*)d_out; a.ws = (unsigned char*)d_ws;
#if ONE_LAUNCH
    a.ph_lo = 0; a.ph_hi = NPH;
    void* kargs[] = {&a};
    hipError_t e = hipLaunchCooperativeKernel((const void*)fwd, dim3(grid), dim3(NTHREADS), kargs, LDS_BYTES, stream);
    if (e != hipSuccess) fprintf(stderr, "kernel_launch: cooperative launch failed: %s (grid %d)\n", hipGetErrorString(e), grid);
#else
    for (int ph = 0; ph < NPH; ++ph) {
        const int r = ph == 0 ? -1 : (ph - 1) % 7, L = ph == 0 ? 0 : (ph - 1) / 7;
        a.ph_lo = ph; a.ph_hi = ph + 1;
        if (r == 1) { a.ph_lo = L; hipLaunchKernelGGL(k_mix1_naive, dim3(grid), dim3(NTHREADS), LDS_BYTES, stream, a); }
        else if (r == 2) { a.ph_lo = L; hipLaunchKernelGGL(k_mix2_naive, dim3(grid), dim3(NTHREADS), LDS_BYTES, stream, a); }
        else if (r == 3) { a.ph_lo = L; hipLaunchKernelGGL(k_mix3_naive, dim3(grid), dim3(NTHREADS), LDS_BYTES, stream, a); }
        else hipLaunchKernelGGL(fwd, dim3(grid), dim3(NTHREADS), LDS_BYTES, stream, a);
    }
#endif
}
```

```cpp
#include <hip/hip_runtime.h>
#include <cstdio>
#include <cstdint>

#ifndef ONE_LAUNCH
#define ONE_LAUNCH 1
#define PROBE_REP 0
#endif

namespace pg8 {
#define PG8_LAS __attribute__((address_space(3)))
#define PG8_GAS __attribute__((address_space(1)))
typedef unsigned short bf16_t;
typedef short bf16x8 __attribute__((ext_vector_type(8)));
typedef float f32x4 __attribute__((ext_vector_type(4)));
typedef unsigned u32x4 __attribute__((ext_vector_type(4)));
constexpr int BM = 256, BK = 64, HALF = 128, HTB = HALF * BK * 2  , STAGE_BYTES = 8 * HTB, NXCD = 8, WGM = 8;

__host__ __device__ __forceinline__ int lds_byte(int r, int c) { const int st = (r >> 4) * 2 + (c >> 5), rr = r & 15, cc = c & 31, ob = rr * 64 + cc * 2; return st * 1024 + (ob ^ (((ob >> 9) & 1) << 5)); }
__host__ __device__ __forceinline__ void stage_rc(int b, int& R, int& C) { const int st = b / 1024, sb = b % 1024, swz = sb ^ (((sb >> 9) & 1) << 5); R = (st >> 1) * 16 + swz / 64; C = (st & 1) * 32 + (swz % 64) / 2; }
__host__ __device__ __forceinline__ int perm32(int rho) { const int n = rho >> 4, i = rho & 15; return 8 * (i >> 2) + 4 * n + (i & 3); }

struct Unit { int pm, pn; };
struct Gemm { const PG8_GAS bf16_t* A; const PG8_GAS bf16_t* Bt; int M, N, K, lda; };

struct StaticOrder {
    int nM, nN, nwg, G, c;
    __host__ __device__ void init(int M, int N, int G_, int c_) { nM = M / BM; nN = N / BM; nwg = nM * nN; G = G_; c = c_; }
    __host__ __device__ bool next(int i, Unit& u) const {
        const long L = (long)i * G + c; if (L >= nwg) return false;
        int wgid = (int)L; { const int q = nwg / NXCD, r = nwg % NXCD, xcd = wgid % NXCD, off = wgid / NXCD; wgid = (xcd < r ? xcd * (q + 1) : r * (q + 1) + (xcd - r) * q) + off; }
        const int nig = WGM * nN, gid = wgid / nig, fm = gid * WGM, gsz = (nM - fm) < WGM ? (nM - fm) : WGM;
        u.pm = fm + ((wgid % nig) % gsz); u.pn = (wgid % nig) / gsz; return true;
    }
    __device__ __forceinline__ void a_ready(const Unit&) const {}
    __device__ __forceinline__ void done(const Unit&) const {}
};

__device__ __forceinline__ unsigned cvt_pk_bf16(float lo, float hi) { unsigned r; asm volatile("v_cvt_pk_bf16_f32 %0, %1, %2" : "=v"(r) : "v"(lo), "v"(hi)); return r; }

constexpr int PROJ_PITCH = 2304, DT_TILE = 9;
struct EpiProj {
    static constexpr bool PERM = true, AFTER_DRAIN = false;
    PG8_GAS bf16_t* O; PG8_GAS float* dtraw; const PG8_LAS float* rstd;
    __device__ __forceinline__ void operator()(const f32x4 (&acc)[2][2][4][2], const Unit& u, int ui, int wr, int wc, int fr, int fq) const {
        const int rt0 = wr * 64 + fr;
        if (u.pn == DT_TILE) {
            if (wc == 0 && fq == 0) {
#pragma unroll
                for (int ai = 0; ai < 2; ++ai)
#pragma unroll
                    for (int m = 0; m < 4; ++m) { const int rt = ai * HALF + rt0 + m * 16; const float rs = rstd[ui * BM + rt]; PG8_GAS float* p = dtraw + (size_t)(u.pm * BM + rt) * 8;
                        *(PG8_GAS f32x4*)p = acc[ai][0][m][0] * rs; *(PG8_GAS f32x4*)(p + 4) = acc[ai][0][m][1] * rs; }
            }
            return;
        }
        const int col0 = u.pn * BM + wc * 32 + 8 * fq;
#pragma unroll
        for (int ai = 0; ai < 2; ++ai)
#pragma unroll
            for (int m = 0; m < 4; ++m) { const int rt = ai * HALF + rt0 + m * 16; const float rs = rstd[ui * BM + rt]; PG8_GAS bf16_t* rowp = O + (size_t)(u.pm * BM + rt) * PROJ_PITCH + col0;
#pragma unroll
                for (int bj = 0; bj < 2; ++bj) { const f32x4 v0 = acc[ai][bj][m][0] * rs, v1 = acc[ai][bj][m][1] * rs;
                    u32x4 w; w.x = cvt_pk_bf16(v0[0], v0[1]); w.y = cvt_pk_bf16(v0[2], v0[3]); w.z = cvt_pk_bf16(v1[0], v1[1]); w.w = cvt_pk_bf16(v1[2], v1[3]);
                    *(PG8_GAS u32x4*)(rowp + bj * HALF) = w; } }
    }
};
struct EpiUp {
    static constexpr bool PERM = true, AFTER_DRAIN = false;
    PG8_GAS bf16_t* O; int ldc; const PG8_LAS float* rstd;
    __device__ __forceinline__ void operator()(const f32x4 (&acc)[2][2][4][2], const Unit& u, int ui, int wr, int wc, int fr, int fq) const {
        const int rt0 = wr * 64 + fr, col0 = u.pn * BM + wc * 32 + 8 * fq;
#pragma unroll
        for (int ai = 0; ai < 2; ++ai)
#pragma unroll
            for (int m = 0; m < 4; ++m) { const int rt = ai * HALF + rt0 + m * 16; const float rs = rstd[ui * BM + rt]; PG8_GAS bf16_t* rowp = O + (size_t)(u.pm * BM + rt) * ldc + col0;
#pragma unroll
                for (int bj = 0; bj < 2; ++bj) { f32x4 v0 = acc[ai][bj][m][0] * rs, v1 = acc[ai][bj][m][1] * rs;
#pragma unroll
                    for (int e = 0; e < 4; ++e) { const float a = fmaxf(v0[e], 0.f), b = fmaxf(v1[e], 0.f); v0[e] = a * a; v1[e] = b * b; }
                    u32x4 w; w.x = cvt_pk_bf16(v0[0], v0[1]); w.y = cvt_pk_bf16(v0[2], v0[3]); w.z = cvt_pk_bf16(v1[0], v1[1]); w.w = cvt_pk_bf16(v1[2], v1[3]);
                    *(PG8_GAS u32x4*)(rowp + bj * HALF) = w; } }
    }
};
template <bool FINAL> struct EpiRes {
    static constexpr bool PERM = true, AFTER_DRAIN = false;
    PG8_GAS bf16_t* xb; PG8_GAS float* ssq; PG8_GAS float* out;
    __device__ __forceinline__ void operator()(const f32x4 (&acc)[2][2][4][2], const Unit& u, int ui, int wr, int wc, int fr, int fq) const {
        const int rt0 = wr * 64 + fr, col0 = u.pn * BM + wc * 32 + 8 * fq;
#pragma unroll
        for (int ai = 0; ai < 2; ++ai)
#pragma unroll
            for (int m = 0; m < 4; ++m) { const int row = u.pm * BM + ai * HALF + rt0 + m * 16; const size_t off = (size_t)row * 1024 + col0; float s = 0.f;
#pragma unroll
                for (int bj = 0; bj < 2; ++bj) { const u32x4 rw = *(const PG8_GAS u32x4*)(xb + off + bj * HALF);
                    f32x4 v0, v1;
                    v0[0] = __uint_as_float(rw.x << 16) + acc[ai][bj][m][0][0]; v0[1] = __uint_as_float(rw.x & 0xffff0000u) + acc[ai][bj][m][0][1];
                    v0[2] = __uint_as_float(rw.y << 16) + acc[ai][bj][m][0][2]; v0[3] = __uint_as_float(rw.y & 0xffff0000u) + acc[ai][bj][m][0][3];
                    v1[0] = __uint_as_float(rw.z << 16) + acc[ai][bj][m][1][0]; v1[1] = __uint_as_float(rw.z & 0xffff0000u) + acc[ai][bj][m][1][1];
                    v1[2] = __uint_as_float(rw.w << 16) + acc[ai][bj][m][1][2]; v1[3] = __uint_as_float(rw.w & 0xffff0000u) + acc[ai][bj][m][1][3];
                    if (FINAL) { *(PG8_GAS f32x4*)(out + off + bj * HALF) = v0; *(PG8_GAS f32x4*)(out + off + bj * HALF + 4) = v1; }
                    else { u32x4 w; w.x = cvt_pk_bf16(v0[0], v0[1]); w.y = cvt_pk_bf16(v0[2], v0[3]); w.z = cvt_pk_bf16(v1[0], v1[1]); w.w = cvt_pk_bf16(v1[2], v1[3]);
                        *(PG8_GAS u32x4*)(xb + off + bj * HALF) = w;
                        s += (v0[0] * v0[0] + v0[1] * v0[1]) + (v0[2] * v0[2] + v0[3] * v0[3]) + (v1[0] * v1[0] + v1[1] * v1[1]) + (v1[2] * v1[2] + v1[3] * v1[3]); } }
                if (!FINAL) { s += __shfl_xor(s, 16); s += __shfl_xor(s, 32);
                    if (fq == 0) ssq[(size_t)row * 16 + u.pn * 4 + wc] = s; } }
    }
};

template <class Epi, class Sched, bool ALIGN_EPI = false, bool SP2 = false>
__device__ __forceinline__ void gemm_phase(PG8_LAS unsigned char* lds, const Gemm g, const Sched& S, const Epi& E) {
    int tid_ = threadIdx.x; asm volatile("" : "+v"(tid_));
    const int tid = tid_, wid = __builtin_amdgcn_readfirstlane(tid >> 6), lane = tid & 63, wr = wid >> 2, wc = wid & 3, fr = lane & 15, fq = lane >> 4;
    const int K = g.K, nt = K / BK;
    unsigned voffA[2], voffB[2];
#pragma unroll
    for (int i = 0; i < 2; ++i) { int R, C; stage_rc(tid * 16 + i * 8192, R, C); const int Rb = Epi::PERM ? ((R & ~31) + perm32(R & 31)) : R;
        voffA[i] = (unsigned)(R * g.lda + C) * 2u; voffB[i] = (unsigned)(Rb * K + C) * 2u; }
    const size_t kstep = (size_t)(BK * 2);
    const size_t hstepA = (size_t)HALF * g.lda * 2, hstepB = (size_t)HALF * K * 2;
    const size_t tstepA = 2 * hstepA, tstepB = 2 * hstepB;
    const unsigned ldsw = (unsigned)wid * 1024u;
    const int aoff = lds_byte(wr * 64 + fr, fq * 8), boff = lds_byte(wc * 32 + fr, fq * 8);
#define PG8_SA(b, h) (((b) * 2 + (h)) * HTB)
#define PG8_SB(b, h) ((4 + (b) * 2 + (h)) * HTB)
#define PG8_STAGE(bufoff, gbase, voff) do { _Pragma("unroll") for (int _i = 0; _i < 2; ++_i) \
        __builtin_amdgcn_global_load_lds((const unsigned*)((const char*)(gbase) + (voff)[_i]), (PG8_LAS unsigned*)(lds + (bufoff) + ldsw + _i * 8192), 16, 0, 0); } while (0)
#define PG8_LDA(dst, b, h) do { _Pragma("unroll") for (int m = 0; m < 4; ++m) _Pragma("unroll") for (int k = 0; k < 2; ++k) dst[m][k] = *(const PG8_LAS bf16x8*)(lds + PG8_SA(b, h) + aoff + m * 2048 + k * 1024); } while (0)
#define PG8_LDB(dst, b, h) do { _Pragma("unroll") for (int n = 0; n < 2; ++n) _Pragma("unroll") for (int k = 0; k < 2; ++k) dst[n][k] = *(const PG8_LAS bf16x8*)(lds + PG8_SB(b, h) + boff + n * 2048 + k * 1024); } while (0)
#define PG8_MMA(ai, bj, At, Bt) do { __builtin_amdgcn_s_setprio(1); _Pragma("unroll") for (int m = 0; m < 4; ++m) _Pragma("unroll") for (int n = 0; n < 2; ++n) _Pragma("unroll") for (int k = 0; k < 2; ++k) \
        acc[ai][bj][m][n] = __builtin_amdgcn_mfma_f32_16x16x32_bf16(Bt[n][k], At[m][k], acc[ai][bj][m][n], 0, 0, 0); __builtin_amdgcn_s_setprio(0); } while (0)
#define PG8_WAIT_V(n) asm volatile("s_waitcnt vmcnt(" #n ")" ::: "memory")
#define PG8_WAIT_L(n) asm volatile("s_waitcnt lgkmcnt(" #n ")" ::: "memory")
#define PG8_BAR __builtin_amdgcn_s_barrier()
#define PG8_SCHED __builtin_amdgcn_sched_barrier(0)
    Unit cur, nxt; int ui = 0;
    if (!S.next(0, cur)) return;
    f32x4 acc[2][2][4][2];
#pragma unroll
    for (int a = 0; a < 2; ++a)
#pragma unroll
        for (int b = 0; b < 2; ++b)
#pragma unroll
            for (int m = 0; m < 4; ++m)
#pragma unroll
                for (int n = 0; n < 2; ++n) acc[a][b][m][n] = (f32x4){0.f, 0.f, 0.f, 0.f};
    bf16x8 At[4][2], B0[2][2], B1[2][2];
    const char* cA = (const char*)g.A + (size_t)cur.pm * tstepA; const char* cB = (const char*)g.Bt + (size_t)cur.pn * tstepB;
    S.a_ready(cur);
    if constexpr (SP2) {
        PG8_STAGE(PG8_SB(0, 0), cB, voffB); PG8_STAGE(PG8_SB(0, 1), cB + hstepB, voffB); PG8_STAGE(PG8_SA(0, 0), cA, voffA); PG8_STAGE(PG8_SA(0, 1), cA + hstepA, voffA);
        if (wr == 1) PG8_BAR;
        PG8_WAIT_V(2); PG8_BAR;
        PG8_STAGE(PG8_SB(1, 0), cB + kstep, voffB); PG8_STAGE(PG8_SA(1, 0), cA + kstep, voffA); PG8_STAGE(PG8_SB(1, 1), cB + hstepB + kstep, voffB);
        PG8_WAIT_V(6); PG8_BAR;
    } else {
        PG8_STAGE(PG8_SB(0, 0), cB, voffB); PG8_STAGE(PG8_SA(0, 0), cA, voffA); PG8_STAGE(PG8_SB(0, 1), cB + hstepB, voffB); PG8_STAGE(PG8_SA(0, 1), cA + hstepA, voffA);
        if (wr == 1) PG8_BAR;
        PG8_WAIT_V(4); PG8_BAR;
        PG8_STAGE(PG8_SB(1, 0), cB + kstep, voffB); PG8_STAGE(PG8_SA(1, 0), cA + kstep, voffA); PG8_STAGE(PG8_SB(1, 1), cB + hstepB + kstep, voffB);
        PG8_WAIT_V(6); PG8_BAR;
    }
    for (;;) {
        const bool has_next = S.next(ui + 1, nxt);
        const char* nA = has_next ? (const char*)g.A + (size_t)nxt.pm * tstepA : cA; const char* nB = has_next ? (const char*)g.Bt + (size_t)nxt.pn * tstepB : cB;
        for (int t = 0; t < nt; t += 2) {
            const bool last = (t == nt - 2);
            const char* a1 = cA + (size_t)(t + 1) * kstep;
            const char* a2 = last ? nA : cA + (size_t)(t + 2) * kstep; const char* b2 = last ? nB : cB + (size_t)(t + 2) * kstep;
            const char* a3 = a2 + kstep; const char* b3 = b2 + kstep;
            if (last && has_next) S.a_ready(nxt);
            if constexpr (SP2) {
            PG8_LDB(B0, 0, 0); PG8_LDB(B1, 0, 1); PG8_SCHED; PG8_LDA(At, 0, 0); PG8_STAGE(PG8_SA(1, 1), a1 + hstepA, voffA);
            PG8_WAIT_V(8); PG8_WAIT_L(0); PG8_BAR; PG8_MMA(0, 0, At, B0); PG8_MMA(0, 1, At, B1); PG8_BAR; PG8_SCHED;
            PG8_LDA(At, 0, 1); PG8_STAGE(PG8_SB(0, 0), b2, voffB); PG8_STAGE(PG8_SB(0, 1), b2 + hstepB, voffB); PG8_STAGE(PG8_SA(0, 0), a2, voffA);
            PG8_WAIT_V(8); PG8_WAIT_L(0); PG8_BAR; PG8_MMA(1, 0, At, B0); PG8_MMA(1, 1, At, B1); PG8_BAR; PG8_SCHED;
            PG8_LDB(B0, 1, 0); PG8_LDB(B1, 1, 1); PG8_SCHED; PG8_LDA(At, 1, 0); PG8_STAGE(PG8_SA(0, 1), a2 + hstepA, voffA);
            PG8_WAIT_V(8); PG8_WAIT_L(0); PG8_BAR; PG8_MMA(0, 0, At, B0); PG8_MMA(0, 1, At, B1); PG8_BAR; PG8_SCHED;
            PG8_LDA(At, 1, 1); PG8_STAGE(PG8_SB(1, 0), b3, voffB); PG8_STAGE(PG8_SB(1, 1), b3 + hstepB, voffB); PG8_STAGE(PG8_SA(1, 0), a3, voffA);
            PG8_WAIT_V(8); PG8_WAIT_L(0); PG8_BAR; PG8_MMA(1, 0, At, B0); PG8_MMA(1, 1, At, B1); PG8_BAR; PG8_SCHED;
            } else {
            PG8_LDB(B0, 0, 0); PG8_SCHED; PG8_LDA(At, 0, 0); PG8_STAGE(PG8_SA(1, 1), a1 + hstepA, voffA);
            PG8_WAIT_L(8); PG8_BAR; PG8_WAIT_L(0); PG8_MMA(0, 0, At, B0); PG8_BAR; PG8_SCHED;
            PG8_LDB(B1, 0, 1); PG8_STAGE(PG8_SB(0, 0), b2, voffB);
            PG8_BAR; PG8_WAIT_L(0); PG8_MMA(0, 1, At, B1); PG8_BAR;
            PG8_LDA(At, 0, 1); PG8_STAGE(PG8_SA(0, 0), a2, voffA);
            PG8_BAR; PG8_WAIT_L(0); PG8_MMA(1, 0, At, B0); PG8_BAR; PG8_SCHED;
            PG8_STAGE(PG8_SB(0, 1), b2 + hstepB, voffB);
            PG8_WAIT_V(6); PG8_BAR; PG8_MMA(1, 1, At, B1); PG8_BAR;
            PG8_LDB(B0, 1, 0); PG8_SCHED; PG8_LDA(At, 1, 0); PG8_STAGE(PG8_SA(0, 1), a2 + hstepA, voffA);
            PG8_WAIT_L(8); PG8_BAR; PG8_WAIT_L(0); PG8_MMA(0, 0, At, B0); PG8_BAR; PG8_SCHED;
            PG8_LDB(B1, 1, 1); PG8_STAGE(PG8_SB(1, 0), b3, voffB);
            PG8_BAR; PG8_WAIT_L(0); PG8_MMA(0, 1, At, B1); PG8_BAR;
            PG8_LDA(At, 1, 1); PG8_STAGE(PG8_SA(1, 0), a3, voffA);
            PG8_BAR; PG8_WAIT_L(0); PG8_MMA(1, 0, At, B0); PG8_BAR; PG8_SCHED;
            PG8_STAGE(PG8_SB(1, 1), b3 + hstepB, voffB);
            PG8_WAIT_V(6); PG8_BAR; PG8_MMA(1, 1, At, B1); PG8_BAR;
            }
        }
        if constexpr (ALIGN_EPI) { if (wr == 0) PG8_BAR; }
        if constexpr (!Epi::AFTER_DRAIN) { E(acc, cur, ui, wr, wc, fr, fq); S.done(cur); }
        if (!has_next) break;
#pragma unroll
        for (int a = 0; a < 2; ++a)
#pragma unroll
            for (int b = 0; b < 2; ++b)
#pragma unroll
                for (int m = 0; m < 4; ++m)
#pragma unroll
                    for (int n = 0; n < 2; ++n) acc[a][b][m][n] = (f32x4){0.f, 0.f, 0.f, 0.f};
        cur = nxt; cA = nA; cB = nB; ++ui;
        if constexpr (ALIGN_EPI) { if (wr == 1) PG8_BAR; }
    }
    PG8_WAIT_V(0);
    if constexpr (!ALIGN_EPI) { if (wr == 0) PG8_BAR; }
    PG8_BAR;

#undef PG8_SA
#undef PG8_SB
#undef PG8_STAGE
#undef PG8_LDA
#undef PG8_LDB
#undef PG8_MMA
#undef PG8_WAIT_V
#undef PG8_WAIT_L
#undef PG8_BAR
#undef PG8_SCHED
}
}

constexpr int NWAVES = 8, NTHREADS = NWAVES * 64;
constexpr int BATCH = 8, SEQ = 2048, D = 1024, M = BATCH * SEQ, FF = 4096, DEPTH = 2;
constexpr int D_IN = 2312, NPROJ = 2560, PP = pg8::PROJ_PITCH;
constexpr int CQ = 0, CZ = 512, CK = 1024, CV = 1152, CX = 1280, CBM = 1792, CCM = 2048;
constexpr float EPS = 1e-6f;
constexpr int NPH = 1 + 7 * DEPTH;

constexpr size_t MiB = 1u << 20;
constexpr size_t WS_CTL = 0, CTL_ZERO_BYTES = 1 * MiB;
constexpr size_t WS_SSQ = 1 * MiB;
constexpr size_t WS_DTRAW = 2 * MiB;
constexpr size_t WS_WIN = 4 * MiB, WS_WOUT = 14 * MiB, WS_WUP = 18 * MiB, WS_WDOWN = 34 * MiB;
constexpr size_t WS_XB = 50 * MiB;
constexpr size_t WS_PROJ = 82 * MiB;
constexpr size_t WS_XBCF = 154 * MiB;
constexpr size_t WS_YN = 218 * MiB;
constexpr size_t WS_HID = 82 * MiB;
constexpr size_t WS_END = 256 * MiB;
constexpr int CW_BAR = 4096;

constexpr int RING_OFF = 0, RING_BYTES = 131072;
constexpr int LDSCTL_OFF = RING_BYTES, MISC_OFF = LDSCTL_OFF + 320, RSTD_OFF = LDSCTL_OFF + 512, PTR_OFF = RSTD_OFF + 4096;
constexpr int LDS_BYTES = 147456;
static_assert(PTR_OFF + 512 <= LDS_BYTES, "LDS map");

#define GAS __attribute__((address_space(1)))
#define LAS __attribute__((address_space(3)))
typedef unsigned short bf16;
typedef unsigned v4u __attribute__((ext_vector_type(4)));
typedef unsigned v2u __attribute__((ext_vector_type(2)));
typedef float f32x4 __attribute__((ext_vector_type(4)));
typedef GAS unsigned gu32;
#define RLX_AGENT __ATOMIC_RELAXED, __HIP_MEMORY_SCOPE_AGENT
#define LDS_WAIT() asm volatile("s_waitcnt lgkmcnt(0)" ::: "memory")
#define VM_WAIT() asm volatile("s_waitcnt vmcnt(0)" ::: "memory")
__device__ __forceinline__ unsigned f2bf(float f) { unsigned u = __builtin_bit_cast(unsigned, f); return (u + 0x7fffu + ((u >> 16) & 1u)) >> 16; }
__device__ __forceinline__ unsigned pk2(float lo, float hi) { return f2bf(lo) | (f2bf(hi) << 16); }
__device__ __forceinline__ float bflo(unsigned w) { return __uint_as_float(w << 16); }
__device__ __forceinline__ float bfhi(unsigned w) { return __uint_as_float(w & 0xffff0000u); }
__device__ __forceinline__ float silu_f(float v) { return v / (1.f + expf(-v)); }
__device__ __forceinline__ float softplus_f(float v) { return fmaxf(v, 0.f) + log1pf(expf(-fabsf(v))); }

#define XB_TMO      128
#define XB_XCNT(j)  (256  + 64 * (j))
#define XB_XSUB(j)  (1280 + 64 * (j))
#define XB_XGEN(j)  (2304 + 64 * (j))
#define XB_TOP      3328
#define XB_TOPGEN   3392
#define XCD_BAR_WORDS 3456
#define XB_SPIN_CAP (1u << 22)
__device__ __forceinline__ unsigned xb_ld(unsigned* p)              { return __hip_atomic_load(p, __ATOMIC_RELAXED, __HIP_MEMORY_SCOPE_AGENT); }
__device__ __forceinline__ unsigned xb_add(unsigned* p, unsigned v) { return __hip_atomic_fetch_add(p, v, __ATOMIC_RELAXED, __HIP_MEMORY_SCOPE_AGENT); }
__device__ __forceinline__ unsigned xb_xcc_id() { return (unsigned)__builtin_amdgcn_s_getreg((3 << 11) | 20) & 0xFu; }
#define XB_SPIN(cond, bar) do { unsigned _sp = 0; while (cond) { __builtin_amdgcn_s_sleep(1); \
    if ((++_sp & 255u) == 0u) { if (xb_ld(&(bar)[XB_TMO])) break; if (_sp > XB_SPIN_CAP) { atomicAdd(&(bar)[XB_TMO], 1u); break; } } } } while (0)
struct XcdBarrier { unsigned* bar; unsigned x; volatile LAS unsigned* st; };
__device__ __forceinline__ XcdBarrier xcd_barrier_post(unsigned* bar, volatile LAS unsigned* st) {
    XcdBarrier b; b.bar = bar; b.x = xb_xcc_id(); b.st = st;
    if (threadIdx.x == 0) (void)xb_add(&bar[XB_XCNT(b.x)], 1u);
    return b;
}
__device__ __forceinline__ void xcd_barrier_complete(unsigned* bar, unsigned x, unsigned& nloc, unsigned& nx) {
    const unsigned G = gridDim.x * gridDim.y * gridDim.z;
    unsigned sum, cnt, mine, sp = 0u;
    for (;;) {
        sum = 0u; cnt = 0u; mine = 0u;
#pragma unroll
        for (unsigned j = 0; j < 16; ++j) { const unsigned c = xb_ld(&bar[XB_XCNT(j)]); sum += c; cnt += (c > 0u) ? 1u : 0u; mine = (j == x) ? c : mine; }
        if (sum == G) break;
        __builtin_amdgcn_s_sleep(1);
        if ((++sp & 255u) == 0u) { if (xb_ld(&bar[XB_TMO])) break; if (sp > XB_SPIN_CAP) { atomicAdd(&bar[XB_TMO], 1u); break; } }
    }
    nloc = mine > 0u ? mine : 1u; nx = cnt > 0u ? cnt : 1u;
}
__device__ __forceinline__ void xcd_barrier(const XcdBarrier& b) {
    asm volatile("s_waitcnt vmcnt(0)" ::: "memory");
    __syncthreads();
    if (threadIdx.x == 0) {
        unsigned* bar = b.bar;
        __builtin_amdgcn_s_waitcnt(0);
        unsigned nloc = b.st[0], nx = b.st[1];
        if (nloc == 0u) { xcd_barrier_complete(bar, b.x, nloc, nx); b.st[0] = nloc; b.st[1] = nx; }
        const unsigned old = xb_add(&bar[XB_XSUB(b.x)], 1u);
        const unsigned gen = old / nloc;
        if (old + 1u == (gen + 1u) * nloc) {
            __builtin_amdgcn_fence(__ATOMIC_RELEASE, "agent");
            asm volatile("s_waitcnt vmcnt(0)" ::: "memory");
            const unsigned og = xb_add(&bar[XB_TOP], 1u);
            const unsigned tg = og / nx;
            if (og + 1u == (tg + 1u) * nx) xb_add(&bar[XB_TOPGEN], 1u);
            else XB_SPIN(xb_ld(&bar[XB_TOPGEN]) == tg, bar);
            __builtin_amdgcn_fence(__ATOMIC_ACQUIRE, "agent");
            xb_add(&bar[XB_XGEN(b.x)], 1u);
            asm volatile("s_waitcnt vmcnt(0)" ::: "memory");
        } else {
            XB_SPIN(xb_ld(&bar[XB_XGEN(b.x)]) == gen, bar);
            __builtin_amdgcn_fence(__ATOMIC_ACQUIRE, "agent");
            asm volatile("s_waitcnt vmcnt(0)" ::: "memory");
        }
    }
    __syncthreads();
}

struct Frame {
    LAS unsigned char* lds;
    int tid, lane, wave, bid, G;
};
enum { I_X = 0, I_MIXG, I_WIN, I_QG, I_KG, I_SINK, I_RELB, I_CONVW, I_CONVB, I_DTB, I_ALOG, I_DSKIP, I_SSMG, I_WOUT, I_MLPG, I_WUP, I_WDOWN, I_OUT, I_WS, I_NPTR };
__device__ __forceinline__ GAS unsigned char* ptr_at(const Frame& F, int i) {
    const LAS unsigned* t = (const LAS unsigned*)(F.lds + PTR_OFF) + 2 * i;
    const unsigned lo = __builtin_amdgcn_readfirstlane(t[0]), hi = __builtin_amdgcn_readfirstlane(t[1]);
    return (GAS unsigned char*)(((unsigned long long)hi << 32) | lo);
}
#define FIN(i) ((const GAS float*)ptr_at(F, (i)))
#define FWS(off) (ptr_at(F, I_WS) + (off))
__device__ __forceinline__ float wave_sum(float v) {
#pragma unroll
    for (int o = 1; o < 64; o <<= 1) v += __shfl_xor(v, o);
    return v;
}

__device__ __forceinline__ void tr_item(const GAS float* W, int Nsrc, int nsrc0, int nvalid, int K, const GAS float* gain, GAS bf16* WT, int ndst0, int k0, LAS float* scr, int lane) {
    const int n = lane & 31;
#pragma unroll 8
    for (int i = 0; i < 32; ++i) { const int kk = 2 * i + (lane >> 5); float v = 0.f;
        if (n < nvalid) { v = W[(size_t)(k0 + kk) * Nsrc + nsrc0 + n]; if (gain) v *= gain[k0 + kk]; }
        scr[kk * 33 + n] = v; }
    LDS_WAIT(); asm volatile("" ::: "memory");
    const int c = lane & 7;
#pragma unroll
    for (int j = 0; j < 4; ++j) { const int nn = (lane >> 3) + 8 * j; const LAS float* s = scr + (8 * c) * 33 + nn;
        v4u o; o.x = pk2(s[0 * 33], s[1 * 33]); o.y = pk2(s[2 * 33], s[3 * 33]); o.z = pk2(s[4 * 33], s[5 * 33]); o.w = pk2(s[6 * 33], s[7 * 33]);
        *(GAS v4u*)(WT + (size_t)(ndst0 + nn) * K + k0 + 8 * c) = o; }
    LDS_WAIT(); asm volatile("" ::: "memory");
}
__device__ __forceinline__ void p0_prologue(Frame& F) {
    LAS float* scr = (LAS float*)(F.lds + RING_OFF + F.wave * 16384);
    const int gw = F.bid * NWAVES + F.wave, NGW = F.G * NWAVES;
    constexpr int I_IN = 16 * 80, I_OUT = 16 * 32, I_UP = 16 * 128, I_DN = 64 * 32, I_L = I_IN + I_OUT + I_UP + I_DN;
    {
    const GAS float *w_in = FIN(I_WIN), *mix_g = FIN(I_MIXG), *w_out = FIN(I_WOUT), *w_up = FIN(I_WUP), *mlp_g = FIN(I_MLPG), *w_down = FIN(I_WDOWN);
    GAS bf16 *WIN = (GAS bf16*)FWS(WS_WIN), *WOUT = (GAS bf16*)FWS(WS_WOUT), *WUP = (GAS bf16*)FWS(WS_WUP), *WDOWN = (GAS bf16*)FWS(WS_WDOWN);
    for (int it = gw; it < DEPTH * I_L; it += NGW) {
        const int L = it / I_L; int r = it % I_L;
        if (r < I_IN) {
            const int kb = r / 80, nb = r % 80; int src, nv = 32;
            if (nb < 16) src = nb * 32; else if (nb < 32) src = 768 + (nb - 16) * 32; else if (nb < 36) src = 512 + (nb - 32) * 32; else if (nb < 40) src = 640 + (nb - 36) * 32;
            else if (nb < 72) src = nb * 32; else if (nb == 72) { src = 2304; nv = 8; } else { src = 0; nv = 0; }
            tr_item(w_in + (size_t)L * D * D_IN, D_IN, src, nv, D, mix_g + L * D, WIN + (size_t)L * NPROJ * D, nb * 32, kb * 64, scr, F.lane); continue; }
        r -= I_IN;
        if (r < I_OUT) { const int kb = r / 32, nb = r % 32; tr_item(w_out + (size_t)L * D * D, D, nb * 32, 32, D, nullptr, WOUT + (size_t)L * D * D, nb * 32, kb * 64, scr, F.lane); continue; }
        r -= I_OUT;
        if (r < I_UP) { const int kb = r / 128, nb = r % 128; tr_item(w_up + (size_t)L * D * FF, FF, nb * 32, 32, D, mlp_g + L * D, WUP + (size_t)L * FF * D, nb * 32, kb * 64, scr, F.lane); continue; }
        r -= I_UP;
        { const int kb = r / 32, nb = r % 32; tr_item(w_down + (size_t)L * FF * D, D, nb * 32, 32, FF, nullptr, WDOWN + (size_t)L * D * FF, nb * 32, kb * 64, scr, F.lane); }
    }
    }
    const GAS float* x = FIN(I_X); GAS bf16* XB = (GAS bf16*)FWS(WS_XB); GAS float* SSQ = (GAS float*)FWS(WS_SSQ);
    for (int m = gw; m < M; m += NGW) {
        const GAS f32x4* xr = (const GAS f32x4*)(x + (size_t)m * D) + F.lane;
        f32x4 v[4]; float s = 0.f;
#pragma unroll
        for (int j = 0; j < 4; ++j) { v[j] = xr[64 * j]; s += (v[j].x * v[j].x + v[j].y * v[j].y) + (v[j].z * v[j].z + v[j].w * v[j].w); }
        s = wave_sum(s);
        GAS v2u* o8 = (GAS v2u*)(XB + (size_t)m * D) + F.lane;
#pragma unroll
        for (int j = 0; j < 4; ++j) { v2u o; o.x = pk2(v[j].x, v[j].y); o.y = pk2(v[j].z, v[j].w); o8[64 * j] = o; }
        if (F.lane < 16) SSQ[(size_t)m * 16 + F.lane] = (F.lane == 0) ? s : 0.f;
    }
}
__device__ __forceinline__ void rstd_prepass(Frame& F, const pg8::StaticOrder& S, LAS float* tab) {
    const GAS float* SSQ = (const GAS float*)FWS(WS_SSQ);
    pg8::Unit u;
    for (int i = 0; i < 4 && S.next(i, u); ++i) {
        const int r = F.tid >> 1, h = F.tid & 1;
        const GAS f32x4* p = (const GAS f32x4*)(SSQ + (size_t)(u.pm * 256 + r) * 16 + h * 8);
        const f32x4 a = p[0], b = p[1];
        float s = (a.x + a.y) + (a.z + a.w) + (b.x + b.y) + (b.z + b.w);
        s += __shfl_xor(s, 1);
        if (h == 0) tab[i * 256 + r] = 1.0f / sqrtf(s * (1.0f / D) + EPS);
    }
    LDS_WAIT(); __syncthreads();
}

__device__ __forceinline__ int t5_bucket(int d) {
    if (d < 16) return d;
    return 16 + (d >= 19) + (d >= 21) + (d >= 24) + (d >= 27) + (d >= 31) + (d >= 35) + (d >= 40) + (d >= 46) + (d >= 52) + (d >= 59) + (d >= 67) + (d >= 77) + (d >= 87) + (d >= 99) + (d >= 113);
}
__device__ __forceinline__ void ld8(const GAS bf16* p, float (&v)[8]) {
    const v4u w = *(const GAS v4u*)p;
    v[0] = bflo(w.x); v[1] = bfhi(w.x); v[2] = bflo(w.y); v[3] = bfhi(w.y); v[4] = bflo(w.z); v[5] = bfhi(w.z); v[6] = bflo(w.w); v[7] = bfhi(w.w);
}
__device__ __forceinline__ void attn_naive(Frame& F, int L) {
    const GAS float* qg = FIN(I_QG) + L * 64; const GAS float* kg = FIN(I_KG) + L * 64; const GAS float* sinks = FIN(I_SINK); const GAS float* rel_bias = FIN(I_RELB);
    GAS bf16* PROJ = (GAS bf16*)FWS(WS_PROJ);
    for (int it = F.bid * NTHREADS + F.tid; it < M * 8; it += F.G * NTHREADS) {
        const int m = it >> 3, hq = it & 7, hkv = hq >> 2, t = m & (SEQ - 1);
        GAS bf16* qp = PROJ + (size_t)m * PP + CQ + hq * 64;
        float q[64]; float ss = 0.f;
#pragma unroll
        for (int c = 0; c < 8; ++c) { float v[8]; ld8(qp + 8 * c, v);
#pragma unroll
            for (int e = 0; e < 8; ++e) { q[8 * c + e] = v[e]; ss += v[e] * v[e]; } }
        const float rq = 1.0f / sqrtf(ss * (1.0f / 64.0f) + EPS);
#pragma unroll
        for (int d = 0; d < 64; ++d) q[d] = q[d] * rq * qg[d] * 0.125f * kg[d];
        const float sink = sinks[L * 8 + hq];
        float mrun = sink, l = 1.f; float acc[64];
#pragma unroll
        for (int d = 0; d < 64; ++d) acc[d] = 0.f;
        const int j0 = t - 127 > 0 ? t - 127 : 0;
        for (int j = j0; j <= t; ++j) {
            const GAS bf16* kp = PROJ + (size_t)(m - t + j) * PP + CK + hkv * 64;
            float dot = 0.f, sk = 0.f;
#pragma unroll
            for (int c = 0; c < 8; ++c) { float v[8]; ld8(kp + 8 * c, v);
#pragma unroll
                for (int e = 0; e < 8; ++e) { dot += q[8 * c + e] * v[e]; sk += v[e] * v[e]; } }
            const float s = dot / sqrtf(sk * (1.0f / 64.0f) + EPS) + rel_bias[t5_bucket(t - j) * 8 + hq];
            const float mn = fmaxf(mrun, s), a = expf(mrun - mn), p = expf(s - mn);
            l = l * a + p; mrun = mn;
            const GAS bf16* vp = kp + (CV - CK);
#pragma unroll
            for (int c = 0; c < 8; ++c) { float v[8]; ld8(vp + 8 * c, v);
#pragma unroll
                for (int e = 0; e < 8; ++e) acc[8 * c + e] = acc[8 * c + e] * a + p * v[e]; }
        }
        const float inv = 1.0f / l;
#pragma unroll
        for (int c = 0; c < 8; ++c) { v4u o; o.x = pk2(acc[8 * c] * inv, acc[8 * c + 1] * inv); o.y = pk2(acc[8 * c + 2] * inv, acc[8 * c + 3] * inv);
            o.z = pk2(acc[8 * c + 4] * inv, acc[8 * c + 5] * inv); o.w = pk2(acc[8 * c + 6] * inv, acc[8 * c + 7] * inv); *(GAS v4u*)(qp + 8 * c) = o; }
    }
}
__device__ __forceinline__ void conv_naive(Frame& F, int L) {
    const GAS float* conv_w = FIN(I_CONVW); const GAS float* conv_b = FIN(I_CONVB); const GAS bf16* PROJ = (const GAS bf16*)FWS(WS_PROJ); GAS float* XBCF = (GAS float*)FWS(WS_XBCF);
    for (int it = F.bid * NTHREADS + F.tid; it < M * 128; it += F.G * NTHREADS) {
        const int m = it >> 7, c0 = (it & 127) * 8, t = m & (SEQ - 1);
        float o[8];
#pragma unroll
        for (int e = 0; e < 8; ++e) o[e] = conv_b[L * 1024 + c0 + e];
#pragma unroll
        for (int k = 0; k < 4; ++k) { if (t - 3 + k >= 0) { float v[8]; ld8(PROJ + (size_t)(m - 3 + k) * PP + CX + c0, v);
#pragma unroll
                for (int e = 0; e < 8; ++e) o[e] += conv_w[(size_t)(L * 4 + k) * 1024 + c0 + e] * v[e]; } }
        f32x4 a, b; a.x = silu_f(o[0]); a.y = silu_f(o[1]); a.z = silu_f(o[2]); a.w = silu_f(o[3]); b.x = silu_f(o[4]); b.y = silu_f(o[5]); b.z = silu_f(o[6]); b.w = silu_f(o[7]);
        *(GAS f32x4*)(XBCF + (size_t)m * 1024 + c0) = a; *(GAS f32x4*)(XBCF + (size_t)m * 1024 + c0 + 4) = b;
    }
}
__device__ __forceinline__ void ssd_naive(Frame& F, int L) {
    if (F.wave != 0 || F.bid >= 64) return;
    const int b = F.bid >> 3, hh = F.bid & 7, g = hh >> 2, p = F.lane;
    const float a = -expf(FIN(I_ALOG)[L * 8 + hh]), dtb = FIN(I_DTB)[L * 8 + hh], dsk = FIN(I_DSKIP)[L * 8 + hh];
    const GAS float* DTRAW = (const GAS float*)FWS(WS_DTRAW); const GAS float* XBCF = (const GAS float*)FWS(WS_XBCF); GAS float* YN = (GAS float*)FWS(WS_YN);
    float st[128];
#pragma unroll
    for (int n = 0; n < 128; ++n) st[n] = 0.f;
    for (int t = 0; t < SEQ; ++t) {
        const size_t m = (size_t)b * SEQ + t;
        const float dtv = softplus_f(DTRAW[m * 8 + hh] + dtb), dA = expf(dtv * a), xv = XBCF[m * 1024 + hh * 64 + p], xd = xv * dtv;
        const GAS f32x4* Bp = (const GAS f32x4*)(XBCF + m * 1024 + 512 + g * 128); const GAS f32x4* Cp = (const GAS f32x4*)(XBCF + m * 1024 + 768 + g * 128);
        float y = 0.f;
#pragma unroll
        for (int n4 = 0; n4 < 32; ++n4) { const f32x4 bv = Bp[n4], cv = Cp[n4];
#pragma unroll
            for (int e = 0; e < 4; ++e) { st[4 * n4 + e] = st[4 * n4 + e] * dA + xd * bv[e]; y += cv[e] * st[4 * n4 + e]; } }
        YN[m * 512 + hh * 64 + p] = y + dsk * xv;
    }
}
__device__ __forceinline__ void gate_naive(Frame& F, int L) {
    const int gw = F.bid * NWAVES + F.wave, NGW = F.G * NWAVES;
    const GAS float* ssm_g = FIN(I_SSMG); GAS bf16* PROJ = (GAS bf16*)FWS(WS_PROJ); const GAS float* YN = (const GAS float*)FWS(WS_YN);
    for (int it = gw; it < M * 2; it += NGW) {
        const int m = it >> 1, g = it & 1, ch = g * 256 + 4 * F.lane;
        const f32x4 y = *(const GAS f32x4*)(YN + (size_t)m * 512 + ch);
        GAS bf16* zp = PROJ + (size_t)m * PP + CZ + ch;
        const v2u zw = *(const GAS v2u*)zp;
        float v[4]; v[0] = y.x * silu_f(bflo(zw.x)); v[1] = y.y * silu_f(bfhi(zw.x)); v[2] = y.z * silu_f(bflo(zw.y)); v[3] = y.w * silu_f(bfhi(zw.y));
        const float ss = wave_sum((v[0] * v[0] + v[1] * v[1]) + (v[2] * v[2] + v[3] * v[3]));
        const float r = 1.0f / sqrtf(ss * (1.0f / 256.0f) + EPS);
        const GAS float* ng = ssm_g + L * 512 + ch;
        v2u o; o.x = pk2(v[0] * r * ng[0], v[1] * r * ng[1]); o.y = pk2(v[2] * r * ng[2], v[3] * r * ng[3]);
        *(GAS v2u*)zp = o;
    }
}

typedef short bf16x8_t __attribute__((ext_vector_type(8)));
typedef float f32x16 __attribute__((ext_vector_type(16)));
constexpr float LOG2E = 1.4426950408889634f;
constexpr int AT_KS = 0, AT_KSTRIDE = 144, AT_VT = 36864, AT_VSTRIDE = 520, AT_BIAS = AT_VT + 64 * AT_VSTRIDE, AT_END = AT_BIAS + 2048;
static_assert(AT_END <= RING_BYTES, "attention LDS");
__device__ __forceinline__ unsigned pkbf(float lo, float hi) { return pg8::cvt_pk_bf16(lo, hi); }
__device__ __forceinline__ void attn_fast(Frame& F, int L) {
    GAS bf16* PROJ = (GAS bf16*)FWS(WS_PROJ);
    const GAS float* qg = FIN(I_QG) + L * 64; const GAS float* kg = FIN(I_KG) + L * 64; const GAS float* sinks = FIN(I_SINK) + L * 8; const GAS float* rel_bias = FIN(I_RELB);
    LAS unsigned char* Ks = F.lds + AT_KS; LAS unsigned char* Vt = F.lds + AT_VT; LAS float* biasT = (LAS float*)(F.lds + AT_BIAS);
    const int tid = F.tid, lane = F.lane, wave = F.wave, q = lane & 31, hh = lane >> 5;
    for (int unit = F.bid; unit < BATCH * 2 * 16; unit += F.G) {
        const int b = unit >> 5, kvh = (unit >> 4) & 1, qb = unit & 15;
        const size_t m0 = (size_t)b * SEQ + qb * 128;
        __syncthreads();
        { const int gi = tid >> 7, dist = tid & 127; biasT[tid] = rel_bias[t5_bucket(dist) * 8 + kvh * 4 + gi] * LOG2E; }
#pragma unroll
        for (int i = 0; i < 4; ++i) {
            const int c = tid + NTHREADS * i, key = c >> 3, part = c & 7;
            const bool valid = (qb > 0) || (key >= 128);
            v4u kw = {0u, 0u, 0u, 0u}, vw = {0u, 0u, 0u, 0u};
            if (valid) { const GAS bf16* kp = PROJ + (m0 + key - 128) * PP + CK + kvh * 64 + part * 8; kw = *(const GAS v4u*)kp; vw = *(const GAS v4u*)(kp + (CV - CK)); }
            float kv[8]; kv[0] = bflo(kw.x); kv[1] = bfhi(kw.x); kv[2] = bflo(kw.y); kv[3] = bfhi(kw.y); kv[4] = bflo(kw.z); kv[5] = bfhi(kw.z); kv[6] = bflo(kw.w); kv[7] = bfhi(kw.w);
            float ss = 0.f;
#pragma unroll
            for (int e = 0; e < 8; ++e) ss += kv[e] * kv[e];
            ss += __shfl_xor(ss, 1); ss += __shfl_xor(ss, 2); ss += __shfl_xor(ss, 4);
            const float rk = 1.0f / sqrtf(ss * (1.0f / 64.0f) + EPS);
            const f32x4 g0 = *(const GAS f32x4*)(kg + part * 8), g1 = *(const GAS f32x4*)(kg + part * 8 + 4);
            v4u ko; ko.x = pkbf(kv[0] * rk * g0.x, kv[1] * rk * g0.y); ko.y = pkbf(kv[2] * rk * g0.z, kv[3] * rk * g0.w); ko.z = pkbf(kv[4] * rk * g1.x, kv[5] * rk * g1.y); ko.w = pkbf(kv[6] * rk * g1.z, kv[7] * rk * g1.w);
            *(LAS v4u*)(Ks + key * AT_KSTRIDE + part * 16) = ko;
            LAS unsigned short* vt = (LAS unsigned short*)(Vt + (part * 8) * AT_VSTRIDE + key * 2);
            vt[0 * (AT_VSTRIDE / 2)] = (unsigned short)(vw.x & 0xffffu); vt[1 * (AT_VSTRIDE / 2)] = (unsigned short)(vw.x >> 16);
            vt[2 * (AT_VSTRIDE / 2)] = (unsigned short)(vw.y & 0xffffu); vt[3 * (AT_VSTRIDE / 2)] = (unsigned short)(vw.y >> 16);
            vt[4 * (AT_VSTRIDE / 2)] = (unsigned short)(vw.z & 0xffffu); vt[5 * (AT_VSTRIDE / 2)] = (unsigned short)(vw.z >> 16);
            vt[6 * (AT_VSTRIDE / 2)] = (unsigned short)(vw.w & 0xffffu); vt[7 * (AT_VSTRIDE / 2)] = (unsigned short)(vw.w >> 16);
        }
        LDS_WAIT(); __syncthreads();
        const int gi = wave >> 1, qh = wave & 1, hq = kvh * 4 + gi;
        const float sink2 = sinks[hq] * LOG2E;
#pragma unroll 1
        for (int s = 0; s < 2; ++s) {
            const int a = 64 * qh + 32 * s;
            GAS bf16* qrow = PROJ + (m0 + a + q) * PP + CQ + hq * 64;
            float qv[4][8]; float ss = 0.f;
#pragma unroll
            for (int d0 = 0; d0 < 4; ++d0) { ld8(qrow + d0 * 16 + hh * 8, qv[d0]);
#pragma unroll
                for (int e = 0; e < 8; ++e) ss += qv[d0][e] * qv[d0][e]; }
            ss += __shfl_xor(ss, 32);
            const float rq = (1.0f / sqrtf(ss * (1.0f / 64.0f) + EPS)) * (0.125f * LOG2E);
            bf16x8_t qf[4];
#pragma unroll
            for (int d0 = 0; d0 < 4; ++d0) { const f32x4 g0 = *(const GAS f32x4*)(qg + d0 * 16 + hh * 8), g1 = *(const GAS f32x4*)(qg + d0 * 16 + hh * 8 + 4);
                v4u w; w.x = pkbf(qv[d0][0] * rq * g0.x, qv[d0][1] * rq * g0.y); w.y = pkbf(qv[d0][2] * rq * g0.z, qv[d0][3] * rq * g0.w);
                w.z = pkbf(qv[d0][4] * rq * g1.x, qv[d0][5] * rq * g1.y); w.w = pkbf(qv[d0][6] * rq * g1.z, qv[d0][7] * rq * g1.w);
                qf[d0] = __builtin_bit_cast(bf16x8_t, w); }
            f32x16 S[5];
#pragma unroll
            for (int kt = 0; kt < 5; ++kt) { f32x16 acc = {};
#pragma unroll
                for (int d0 = 0; d0 < 4; ++d0) { const bf16x8_t kf = *(const LAS bf16x8_t*)(Ks + (a + 32 * kt + q) * AT_KSTRIDE + d0 * 32 + hh * 16);
                    acc = __builtin_amdgcn_mfma_f32_32x32x16_bf16(kf, qf[d0], acc, 0, 0, 0); }
                S[kt] = acc; }
            float mx = sink2;
#pragma unroll
            for (int kt = 0; kt < 5; ++kt)
#pragma unroll
                for (int i = 0; i < 16; ++i) { const int cr = (i & 3) + 8 * (i >> 2) + 4 * hh, dist = 128 + q - 32 * kt - cr, kidx = a + 32 * kt + cr;
                    const bool ok = (dist >= 0) && (dist < 128) && ((qb > 0) || (kidx >= 128));
                    const float v = ok ? S[kt][i] + biasT[gi * 128 + (dist & 127)] : -INFINITY;
                    S[kt][i] = v; mx = fmaxf(mx, v); }
            mx = fmaxf(mx, __shfl_xor(mx, 32));
            float lsum = 0.f; bf16x8_t pf[5][2];
#pragma unroll
            for (int kt = 0; kt < 5; ++kt) {
#pragma unroll
                for (int i = 0; i < 16; ++i) { const float p = __builtin_amdgcn_exp2f(S[kt][i] - mx); S[kt][i] = p; lsum += p; }
#pragma unroll
                for (int s2 = 0; s2 < 2; ++s2) { v4u w; w.x = pkbf(S[kt][8 * s2 + 0], S[kt][8 * s2 + 1]); w.y = pkbf(S[kt][8 * s2 + 2], S[kt][8 * s2 + 3]);
                    w.z = pkbf(S[kt][8 * s2 + 4], S[kt][8 * s2 + 5]); w.w = pkbf(S[kt][8 * s2 + 6], S[kt][8 * s2 + 7]); pf[kt][s2] = __builtin_bit_cast(bf16x8_t, w); } }
            lsum += __shfl_xor(lsum, 32);
            lsum += __builtin_amdgcn_exp2f(sink2 - mx);
            f32x16 O[2] = {{}, {}};
#pragma unroll
            for (int kt = 0; kt < 5; ++kt)
#pragma unroll
                for (int s2 = 0; s2 < 2; ++s2)
#pragma unroll
                    for (int db = 0; db < 2; ++db) { const LAS unsigned char* vb = Vt + (32 * db + q) * AT_VSTRIDE + (a + 32 * kt + 16 * s2 + 4 * hh) * 2;
                        const v2u lo = *(const LAS v2u*)vb, hi2 = *(const LAS v2u*)(vb + 16); v4u w; w.x = lo.x; w.y = lo.y; w.z = hi2.x; w.w = hi2.y;
                        O[db] = __builtin_amdgcn_mfma_f32_32x32x16_bf16(__builtin_bit_cast(bf16x8_t, w), pf[kt][s2], O[db], 0, 0, 0); }
            const float inv = 1.0f / lsum;
#pragma unroll
            for (int db = 0; db < 2; ++db)
#pragma unroll
                for (int g4 = 0; g4 < 4; ++g4) { v2u w; w.x = pkbf(O[db][4 * g4] * inv, O[db][4 * g4 + 1] * inv); w.y = pkbf(O[db][4 * g4 + 2] * inv, O[db][4 * g4 + 3] * inv);
                    *(GAS v2u*)(qrow + 32 * db + 8 * g4 + 4 * hh) = w; }
        }
    }
}

constexpr size_t WS_ACS = 2 * MiB + 512 * 1024, WS_CHDEC = 3 * MiB;
constexpr size_t WS_STATES = 154 * MiB, WS_YPART = 186 * MiB, WS_CC = 218 * MiB, WS_PREV = 226 * MiB;
constexpr int SD_CM = 0, SD_BM = 34816, SD_BMT = 69632, SD_DT = 104448, SD_ACS = SD_DT + 2048, SD_WT = SD_ACS + 2048, SD_END = SD_WT + 64;
constexpr int SD_ROW = 272, SD_XT = 264, SD_HIMG = 64 * SD_XT + 64 * SD_ROW;
static_assert(2 * SD_HIMG <= SD_BMT && SD_END <= RING_BYTES, "SSD LDS map");
__device__ __forceinline__ int crow32(int i, int hh) { return (i & 3) + 8 * (i >> 2) + 4 * hh; }
__device__ __forceinline__ void conv8x4(const GAS bf16* PROJ, size_t m0, int c, int l0, int col0, const GAS float* cw, const GAS float* cbias, float (&out)[4][8]) {
    float w[4][8], bs[8], u[7][8];
#pragma unroll
    for (int k = 0; k < 4; ++k) { const f32x4 a = *(const GAS f32x4*)(cw + k * 1024), b = *(const GAS f32x4*)(cw + k * 1024 + 4); w[k][0] = a.x; w[k][1] = a.y; w[k][2] = a.z; w[k][3] = a.w; w[k][4] = b.x; w[k][5] = b.y; w[k][6] = b.z; w[k][7] = b.w; }
    { const f32x4 a = *(const GAS f32x4*)cbias, b = *(const GAS f32x4*)(cbias + 4); bs[0] = a.x; bs[1] = a.y; bs[2] = a.z; bs[3] = a.w; bs[4] = b.x; bs[5] = b.y; bs[6] = b.z; bs[7] = b.w; }
#pragma unroll
    for (int i = 0; i < 7; ++i) { const int row = l0 - 3 + i;
        if (c > 0 || row >= 0) ld8(PROJ + (size_t)((long)m0 + row) * PP + col0, u[i]);
        else {
#pragma unroll
            for (int e = 0; e < 8; ++e) u[i][e] = 0.f; } }
#pragma unroll
    for (int r = 0; r < 4; ++r)
#pragma unroll
        for (int e = 0; e < 8; ++e) out[r][e] = silu_f(bs[e] + w[0][e] * u[r][e] + w[1][e] * u[r + 1][e] + w[2][e] * u[r + 2][e] + w[3][e] * u[r + 3][e]);
}
__device__ __forceinline__ void ssd1_fast(Frame& F, int L) {
    const GAS bf16* PROJ = (const GAS bf16*)FWS(WS_PROJ);
    const GAS float* conv_w = FIN(I_CONVW) + (size_t)L * 4 * 1024; const GAS float* conv_b = FIN(I_CONVB) + L * 1024;
    const GAS float* dt_bias = FIN(I_DTB) + L * 8; const GAS float* a_log = FIN(I_ALOG) + L * 8; const GAS float* d_skip = FIN(I_DSKIP) + L * 8;
    const GAS float* DTRAW = (const GAS float*)FWS(WS_DTRAW); GAS float* ACS = (GAS float*)FWS(WS_ACS); GAS float* CHDEC = (GAS float*)FWS(WS_CHDEC);
    GAS float* STATES = (GAS float*)FWS(WS_STATES); GAS float* YPART = (GAS float*)FWS(WS_YPART); GAS bf16* CC = (GAS bf16*)FWS(WS_CC);
    LAS unsigned char* Cm = F.lds + SD_CM; LAS unsigned char* Bm = F.lds + SD_BM; LAS unsigned char* BmT = F.lds + SD_BMT;
    LAS float* dt_l = (LAS float*)(F.lds + SD_DT); LAS float* acs_l = (LAS float*)(F.lds + SD_ACS); LAS float* wt = (LAS float*)(F.lds + SD_WT);
    const int wave = F.wave;
    for (int unit = F.bid; unit < BATCH * 16 * 2; unit += F.G) {
        const int b = unit >> 5, c = (unit >> 1) & 15, g = unit & 1;
        const size_t m0 = (size_t)b * SEQ + c * 128;
        int tid = F.tid; asm volatile("" : "+v"(tid));
        int lane = tid & 63, q = lane & 31, hh = lane >> 5;
        __syncthreads();
        { const int r = tid >> 7, l = tid & 127, head = 4 * g + r;
          const float dtv = softplus_f(DTRAW[(m0 + l) * 8 + head] + dt_bias[head]);
          float v = dtv * (-expf(a_log[head]));
#pragma unroll
          for (int o = 1; o < 64; o <<= 1) { const float t = __shfl_up(v, o); if (lane >= o) v += t; }
          if (lane == 63) wt[wave] = v;
          LDS_WAIT(); __syncthreads();
          if (wave & 1) v += wt[wave - 1];
          dt_l[tid] = dtv; acs_l[tid] = v; ACS[(m0 + l) * 8 + head] = v;
          if (l == 127) CHDEC[(size_t)(b * 16 + c) * 8 + head] = expf(v); }
#pragma unroll 1
        for (int it = tid; it < 1024; it += NTHREADS) {
            const int cg = it & 31, rg = it >> 5, isC = cg >> 4, n0 = (cg & 15) * 8, col0 = (isC ? CCM : CBM) + g * 128 + n0, l0 = 4 * rg;
            float o[4][8];
            conv8x4(PROJ, m0, c, l0, col0, conv_w + (col0 - CX), conv_b + (col0 - CX), o);
#pragma unroll
            for (int r = 0; r < 4; ++r) { const int l = l0 + r;
                v4u pk; pk.x = pkbf(o[r][0], o[r][1]); pk.y = pkbf(o[r][2], o[r][3]); pk.z = pkbf(o[r][4], o[r][5]); pk.w = pkbf(o[r][6], o[r][7]);
                *(LAS v4u*)((isC ? Cm : Bm) + l * SD_ROW + n0 * 2) = pk;
                if (isC) *(GAS v4u*)(CC + (m0 + l) * 256 + g * 128 + n0) = pk;
                else { LAS unsigned short* t = (LAS unsigned short*)(BmT + n0 * SD_ROW + l * 2);
                    t[0 * (SD_ROW / 2)] = (unsigned short)(pk.x & 0xffffu); t[1 * (SD_ROW / 2)] = (unsigned short)(pk.x >> 16); t[2 * (SD_ROW / 2)] = (unsigned short)(pk.y & 0xffffu); t[3 * (SD_ROW / 2)] = (unsigned short)(pk.y >> 16);
                    t[4 * (SD_ROW / 2)] = (unsigned short)(pk.z & 0xffffu); t[5 * (SD_ROW / 2)] = (unsigned short)(pk.z >> 16); t[6 * (SD_ROW / 2)] = (unsigned short)(pk.w & 0xffffu); t[7 * (SD_ROW / 2)] = (unsigned short)(pk.w >> 16); } }
        }
        LDS_WAIT(); __syncthreads();
        asm volatile("" : "+v"(tid)); lane = tid & 63; q = lane & 31; hh = lane >> 5;
        const int j = (wave < 4) ? (wave & 3) : 3 - (wave & 3);
        f32x16 cbT[4];
        { bf16x8_t cf[8];
#pragma unroll
          for (int ks = 0; ks < 8; ++ks) cf[ks] = *(const LAS bf16x8_t*)(Cm + (32 * j + q) * SD_ROW + (16 * ks + 8 * hh) * 2);
#pragma unroll
          for (int i = 0; i < 4; ++i) { f32x16 acc = {};
              if (i <= j) {
#pragma unroll
                  for (int ks = 0; ks < 8; ++ks) { const bf16x8_t bfr = *(const LAS bf16x8_t*)(Bm + (32 * i + q) * SD_ROW + (16 * ks + 8 * hh) * 2);
                      acc = __builtin_amdgcn_mfma_f32_32x32x16_bf16(bfr, cf[ks], acc, 0, 0, 0); } }
              cbT[i] = acc; } }
#pragma unroll 1
        for (int hp = 0; hp < 2; ++hp) {
            __syncthreads();
            asm volatile("" : "+v"(tid)); lane = tid & 63; q = lane & 31; hh = lane >> 5;
            { const int cg = tid & 15, rg = tid >> 4, h2 = cg >> 3, p0 = (cg & 7) * 8, r = 2 * hp + h2, col0 = CX + (4 * g + r) * 64 + p0, l0 = 4 * rg;
              float o[4][8];
              conv8x4(PROJ, m0, c, l0, col0, conv_w + (col0 - CX), conv_b + (col0 - CX), o);
              LAS unsigned char* T1 = F.lds + h2 * SD_HIMG; LAS unsigned char* T2 = T1 + 64 * SD_XT;
              const float aend = acs_l[r * 128 + 127];
#pragma unroll
              for (int rr = 0; rr < 4; ++rr) { const int l = l0 + rr; const float dtv = dt_l[r * 128 + l], wl = expf(aend - acs_l[r * 128 + l]);
#pragma unroll
                  for (int e = 0; e < 8; ++e) { const float xd = o[rr][e] * dtv;
                      *(LAS unsigned short*)(T1 + (p0 + e) * SD_XT + l * 2) = (unsigned short)f2bf(xd);
                      *(LAS unsigned short*)(T2 + (p0 + e) * SD_ROW + l * 2) = (unsigned short)f2bf(xd * wl); } } }
            LDS_WAIT(); __syncthreads();
            asm volatile("" : "+v"(tid)); lane = tid & 63; q = lane & 31; hh = lane >> 5;
            const int h2 = wave >> 2, r = 2 * hp + h2, head = 4 * g + r;
            const LAS unsigned char* T1 = F.lds + h2 * SD_HIMG; const LAS unsigned char* T2 = T1 + 64 * SD_XT;
            {
              const float acl = acs_l[r * 128 + 32 * j + q], diag = d_skip[head] / dt_l[r * 128 + 32 * j + q];
              f32x16 O[2] = {{}, {}};
#pragma unroll
              for (int i = 0; i < 4; ++i) { if (i <= j) {
                  int qq = q; asm volatile("" : "+v"(qq));
                  float xv[16];
#pragma unroll
                  for (int e = 0; e < 16; ++e) { const int cr = crow32(e, hh); const float dec = __builtin_amdgcn_exp2f((acl - acs_l[r * 128 + 32 * i + cr]) * LOG2E);
                      const bool ok = (i < j) || (cr <= qq);
                      float v = ok ? cbT[i][e] * dec : 0.f;
                      if (i == j && cr == qq) v += diag;
                      xv[e] = v; }
#pragma unroll
                  for (int s2 = 0; s2 < 2; ++s2) { v4u w; w.x = pkbf(xv[8 * s2 + 0], xv[8 * s2 + 1]); w.y = pkbf(xv[8 * s2 + 2], xv[8 * s2 + 3]); w.z = pkbf(xv[8 * s2 + 4], xv[8 * s2 + 5]); w.w = pkbf(xv[8 * s2 + 6], xv[8 * s2 + 7]);
                      const bf16x8_t xf = __builtin_bit_cast(bf16x8_t, w);
#pragma unroll
                      for (int pt = 0; pt < 2; ++pt) { const LAS unsigned char* ab = T1 + (32 * pt + q) * SD_XT + (32 * i + 16 * s2 + 4 * hh) * 2;
                          const v2u lo = *(const LAS v2u*)ab, hi2 = *(const LAS v2u*)(ab + 16); v4u aw; aw.x = lo.x; aw.y = lo.y; aw.z = hi2.x; aw.w = hi2.y;
                          O[pt] = __builtin_amdgcn_mfma_f32_32x32x16_bf16(__builtin_bit_cast(bf16x8_t, aw), xf, O[pt], 0, 0, 0); } } } }
              GAS float* yp = YPART + (m0 + 32 * j + q) * 512 + head * 64;
#pragma unroll
              for (int pt = 0; pt < 2; ++pt)
#pragma unroll
                  for (int g4 = 0; g4 < 4; ++g4) { f32x4 v; v.x = O[pt][4 * g4]; v.y = O[pt][4 * g4 + 1]; v.z = O[pt][4 * g4 + 2]; v.w = O[pt][4 * g4 + 3];
                      *(GAS f32x4*)(yp + 32 * pt + 8 * g4 + 4 * hh) = v; } }
            asm volatile("" : "+v"(tid)); lane = tid & 63; q = lane & 31; hh = lane >> 5;
            {
              const int nt = wave & 3;
              f32x16 St[2] = {{}, {}};
#pragma unroll
              for (int ks = 0; ks < 8; ++ks) { const bf16x8_t bfr = *(const LAS bf16x8_t*)(BmT + (32 * nt + q) * SD_ROW + (16 * ks + 8 * hh) * 2);
#pragma unroll
                  for (int pt = 0; pt < 2; ++pt) { const bf16x8_t af = *(const LAS bf16x8_t*)(T2 + (32 * pt + q) * SD_ROW + (16 * ks + 8 * hh) * 2);
                      St[pt] = __builtin_amdgcn_mfma_f32_32x32x16_bf16(af, bfr, St[pt], 0, 0, 0); } }
              GAS float* sp = STATES + ((size_t)(b * 16 + c) * 8 + head) * 8192 + 32 * nt + q;
#pragma unroll
              for (int pt = 0; pt < 2; ++pt)
#pragma unroll
                  for (int e = 0; e < 16; ++e) sp[(32 * pt + crow32(e, hh)) * 128] = St[pt][e]; }
        }
    }
}
__device__ __forceinline__ void ssd2_scan(Frame& F, int L) {
    const GAS float* STATES = (const GAS float*)FWS(WS_STATES); const GAS float* CHDEC = (const GAS float*)FWS(WS_CHDEC); GAS bf16* PREV = (GAS bf16*)FWS(WS_PREV);
    for (int idx = F.bid * NTHREADS + F.tid; idx < BATCH * 8 * 64 * 32; idx += F.G * NTHREADS) {
        const int n4 = idx & 31, p = (idx >> 5) & 63, head = (idx >> 11) & 7, b = idx >> 14;
        f32x4 s[16]; float dec[16];
#pragma unroll
        for (int c = 0; c < 16; ++c) { const size_t o = ((size_t)(b * 16 + c) * 8 + head) * 8192 + p * 128 + 4 * n4; s[c] = *(const GAS f32x4*)(STATES + o); dec[c] = CHDEC[(size_t)(b * 16 + c) * 8 + head]; }
        f32x4 h = {0.f, 0.f, 0.f, 0.f};
#pragma unroll
        for (int c = 0; c < 16; ++c) { const size_t o = ((size_t)(b * 16 + c) * 8 + head) * 8192 + p * 128 + 4 * n4;
            v2u w; w.x = pkbf(h.x, h.y); w.y = pkbf(h.z, h.w); *(GAS v2u*)(PREV + o) = w;
            h = h * dec[c] + s[c]; }
    }
}
__device__ __forceinline__ void ssd3_fast(Frame& F, int L) {
    GAS bf16* PROJ = (GAS bf16*)FWS(WS_PROJ); const GAS bf16* PREV = (const GAS bf16*)FWS(WS_PREV); const GAS bf16* CC = (const GAS bf16*)FWS(WS_CC);
    const GAS float* YPART = (const GAS float*)FWS(WS_YPART); const GAS float* ACS = (const GAS float*)FWS(WS_ACS); const GAS float* ssm_g = FIN(I_SSMG) + L * 512;
    LAS float* exch = (LAS float*)(F.lds);
    const int lane = F.lane, wave = F.wave, q = lane & 31, hh = lane >> 5;
    for (int unit = F.bid; unit < BATCH * 16 * 2; unit += F.G) {
        const int b = unit >> 5, c = (unit >> 1) & 15, g = unit & 1;
        const size_t m0 = (size_t)b * SEQ + c * 128;
        const int j = wave & 3, hp = wave >> 2;
        const size_t row = m0 + 32 * j + q;
        bf16x8_t cf[8];
#pragma unroll
        for (int ks = 0; ks < 8; ++ks) cf[ks] = *(const GAS bf16x8_t*)(CC + row * 256 + g * 128 + 16 * ks + 8 * hh);
        float v[2][2][16]; float ss = 0.f;
#pragma unroll
        for (int h2 = 0; h2 < 2; ++h2) { const int head = 4 * g + 2 * hp + h2;
            const GAS bf16* pv = PREV + ((size_t)(b * 16 + c) * 8 + head) * 8192;
            f32x16 O[2] = {{}, {}};
#pragma unroll
            for (int ks = 0; ks < 8; ++ks)
#pragma unroll
                for (int pt = 0; pt < 2; ++pt) { const bf16x8_t af = *(const GAS bf16x8_t*)(pv + (32 * pt + q) * 128 + 16 * ks + 8 * hh);
                    O[pt] = __builtin_amdgcn_mfma_f32_32x32x16_bf16(af, cf[ks], O[pt], 0, 0, 0); }
            const float ea = expf(ACS[row * 8 + head]);
#pragma unroll
            for (int pt = 0; pt < 2; ++pt)
#pragma unroll
                for (int g4 = 0; g4 < 4; ++g4) { const int p = 32 * pt + 8 * g4 + 4 * hh;
                    const f32x4 yp = *(const GAS f32x4*)(YPART + row * 512 + head * 64 + p);
                    const v2u zw = *(const GAS v2u*)(PROJ + row * PP + CZ + head * 64 + p);
                    const float y0 = yp.x + ea * O[pt][4 * g4], y1 = yp.y + ea * O[pt][4 * g4 + 1], y2 = yp.z + ea * O[pt][4 * g4 + 2], y3 = yp.w + ea * O[pt][4 * g4 + 3];
                    const float u0 = y0 * silu_f(bflo(zw.x)), u1 = y1 * silu_f(bfhi(zw.x)), u2 = y2 * silu_f(bflo(zw.y)), u3 = y3 * silu_f(bfhi(zw.y));
                    v[h2][pt][4 * g4] = u0; v[h2][pt][4 * g4 + 1] = u1; v[h2][pt][4 * g4 + 2] = u2; v[h2][pt][4 * g4 + 3] = u3;
                    ss += (u0 * u0 + u1 * u1) + (u2 * u2 + u3 * u3); } }
        ss += __shfl_xor(ss, 32);
        __syncthreads();
        if (hh == 0) exch[hp * 128 + 32 * j + q] = ss;
        LDS_WAIT(); __syncthreads();
        const float tot = exch[32 * j + q] + exch[128 + 32 * j + q];
        const float rn = 1.0f / sqrtf(tot * (1.0f / 256.0f) + EPS);
#pragma unroll
        for (int h2 = 0; h2 < 2; ++h2) { const int head = 4 * g + 2 * hp + h2;
#pragma unroll
            for (int pt = 0; pt < 2; ++pt)
#pragma unroll
                for (int g4 = 0; g4 < 4; ++g4) { const int p = 32 * pt + 8 * g4 + 4 * hh;
                    const f32x4 ng = *(const GAS f32x4*)(ssm_g + head * 64 + p);
                    v2u w; w.x = pkbf(v[h2][pt][4 * g4] * rn * ng.x, v[h2][pt][4 * g4 + 1] * rn * ng.y); w.y = pkbf(v[h2][pt][4 * g4 + 2] * rn * ng.z, v[h2][pt][4 * g4 + 3] * rn * ng.w);
                    *(GAS v2u*)(PROJ + row * PP + CZ + head * 64 + p) = w; } }
    }
}

__device__ __forceinline__ void ph_inproj(Frame& F, int L) {
    LAS float* rstd_tab = (LAS float*)(F.lds + RSTD_OFF);
    int bid_ = F.bid; asm volatile("" : "+s"(bid_)); pg8::StaticOrder S; S.init(M, NPROJ, F.G, bid_);
    rstd_prepass(F, S, rstd_tab);
    pg8::Gemm g{(const GAS bf16*)FWS(WS_XB), (const GAS bf16*)FWS(WS_WIN) + (size_t)L * NPROJ * D, M, NPROJ, D, D};
    pg8::EpiProj E{(GAS bf16*)FWS(WS_PROJ), (GAS float*)FWS(WS_DTRAW), (const LAS float*)rstd_tab};
    pg8::gemm_phase<pg8::EpiProj, pg8::StaticOrder, true, true>(F.lds + RING_OFF, g, S, E);
}
__device__ __forceinline__ void ph_outproj(Frame& F, int L) {
    int bid_ = F.bid; asm volatile("" : "+s"(bid_)); pg8::StaticOrder S; S.init(M, D, F.G, bid_);
    pg8::Gemm g{(const GAS bf16*)FWS(WS_PROJ), (const GAS bf16*)FWS(WS_WOUT) + (size_t)L * D * D, M, D, D, PP};
    pg8::EpiRes<false> E{(GAS bf16*)FWS(WS_XB), (GAS float*)FWS(WS_SSQ), nullptr};
    pg8::gemm_phase<pg8::EpiRes<false>, pg8::StaticOrder, false, true>(F.lds + RING_OFF, g, S, E);
}
__device__ __forceinline__ void ph_up(Frame& F, int L) {
    LAS float* rstd_tab = (LAS float*)(F.lds + RSTD_OFF);
    int bid_ = F.bid; asm volatile("" : "+s"(bid_)); pg8::StaticOrder S; S.init(M, FF, F.G, bid_);
    rstd_prepass(F, S, rstd_tab);
    pg8::Gemm g{(const GAS bf16*)FWS(WS_XB), (const GAS bf16*)FWS(WS_WUP) + (size_t)L * FF * D, M, FF, D, D};
    pg8::EpiUp E{(GAS bf16*)FWS(WS_HID), FF, (const LAS float*)rstd_tab};
    pg8::gemm_phase<pg8::EpiUp, pg8::StaticOrder, true, true>(F.lds + RING_OFF, g, S, E);
}
__device__ __forceinline__ void ph_down(Frame& F, int L) {
    int bid_ = F.bid; asm volatile("" : "+s"(bid_)); pg8::StaticOrder S; S.init(M, D, F.G, bid_);
    pg8::Gemm g{(const GAS bf16*)FWS(WS_HID), (const GAS bf16*)FWS(WS_WDOWN) + (size_t)L * D * FF, M, D, FF, FF};
    if (L == DEPTH - 1) { pg8::EpiRes<true> E{(GAS bf16*)FWS(WS_XB), (GAS float*)FWS(WS_SSQ), (GAS float*)ptr_at(F, I_OUT)};
        pg8::gemm_phase<pg8::EpiRes<true>, pg8::StaticOrder, false, true>(F.lds + RING_OFF, g, S, E); }
    else { pg8::EpiRes<false> E{(GAS bf16*)FWS(WS_XB), (GAS float*)FWS(WS_SSQ), nullptr};
        pg8::gemm_phase<pg8::EpiRes<false>, pg8::StaticOrder, false, true>(F.lds + RING_OFF, g, S, E); }
}

struct Args { const float* in[17]; float* out; unsigned char* ws; int ph_lo, ph_hi; };
#define FRAME_INIT() \
    extern __shared__ __attribute__((aligned(16))) unsigned char lds[]; \
    Frame F; \
    F.lds = (LAS unsigned char*)lds; \
    F.tid = threadIdx.x; F.lane = F.tid & 63; F.wave = __builtin_amdgcn_readfirstlane(F.tid >> 6); F.bid = blockIdx.x; F.G = gridDim.x; \
    for (int u = F.tid; u < (LDS_BYTES - LDSCTL_OFF) / 4; u += NTHREADS) ((LAS unsigned*)(F.lds + LDSCTL_OFF))[u] = 0u; \
    __syncthreads(); \
    if (F.tid < I_NPTR) { const unsigned long long p = F.tid < 17 ? (unsigned long long)args.in[F.tid < 17 ? F.tid : 0] : (F.tid == I_OUT ? (unsigned long long)args.out : (unsigned long long)args.ws); \
        LAS unsigned* t = (LAS unsigned*)(F.lds + PTR_OFF) + 2 * F.tid; t[0] = (unsigned)p; t[1] = (unsigned)(p >> 32); } \
    LDS_WAIT(); __syncthreads();

#if !ONE_LAUNCH
__global__ void __launch_bounds__(NTHREADS, 2) k_mix1_naive(Args args) { FRAME_INIT(); attn_naive(F, args.ph_lo); conv_naive(F, args.ph_lo); }
__global__ void __launch_bounds__(NTHREADS, 2) k_mix2_naive(Args args) { FRAME_INIT(); ssd_naive(F, args.ph_lo); }
__global__ void __launch_bounds__(NTHREADS, 2) k_mix3_naive(Args args) { FRAME_INIT(); gate_naive(F, args.ph_lo); }
#endif
#define PH_MIX1(F, L) do { attn_fast(F, L); ssd1_fast(F, L); if (PROBE_REP == 3) { REP_BAR(); RELAUNDER(); ssd1_fast(F, L); } } while (0)
#define PH_MIX2(F, L) ssd2_scan(F, L)
#define PH_MIX3(F, L) ssd3_fast(F, L)

__global__ void __launch_bounds__(NTHREADS, 2) fwd(Args args) {
    FRAME_INIT();
    const int lo = args.ph_lo, hi = args.ph_hi;
#if ONE_LAUNCH
    XcdBarrier bar = xcd_barrier_post((unsigned*)(unsigned char*)(FWS(WS_CTL)) + CW_BAR, (volatile LAS unsigned*)(F.lds + MISC_OFF) + 8);
#define GRID_BAR() xcd_barrier(bar)
#else
#define GRID_BAR() do {} while (0)
#endif
#define IN(k) (lo <= (k) && (k) < hi)
#define RELAUNDER() do { int t_ = threadIdx.x; asm volatile("" : "+v"(t_)); F.tid = t_; F.lane = t_ & 63; F.wave = __builtin_amdgcn_readfirstlane(t_ >> 6); \
    int b_ = blockIdx.x; asm volatile("" : "+s"(b_)); F.bid = b_; } while (0)
#define SEAM(k) do { if (IN(k) && IN((k) + 1)) GRID_BAR(); } while (0)

#ifndef PROBE_REP
#define PROBE_REP 0
#endif
#if ONE_LAUNCH
#define REP_BAR() GRID_BAR()
#else
#define REP_BAR() do {} while (0)
#endif
    if (IN(0)) { p0_prologue(F);
        if (PROBE_REP == 1) { REP_BAR(); RELAUNDER(); p0_prologue(F); }
        if (PROBE_REP == 6) { for (int k = 0; k < 8; ++k) REP_BAR(); }
        SEAM(0); }
    for (int L = 0; L < DEPTH; ++L) {
        const int pb = 1 + 7 * L;
        if (IN(pb + 0)) { RELAUNDER(); ph_inproj(F, L); if (PROBE_REP == 2) { REP_BAR(); RELAUNDER(); ph_inproj(F, L); } SEAM(pb + 0); }
        if (IN(pb + 1)) { RELAUNDER(); PH_MIX1(F, L); SEAM(pb + 1); }
        if (IN(pb + 2)) { RELAUNDER(); PH_MIX2(F, L); if (PROBE_REP == 4) { REP_BAR(); RELAUNDER(); PH_MIX2(F, L); } SEAM(pb + 2); }
        if (IN(pb + 3)) { RELAUNDER(); PH_MIX3(F, L); SEAM(pb + 3); }
        if (IN(pb + 4)) { RELAUNDER(); ph_outproj(F, L);  SEAM(pb + 4); }
        if (IN(pb + 5)) { RELAUNDER(); ph_up(F, L); if (PROBE_REP == 5) { REP_BAR(); RELAUNDER(); ph_up(F, L); } SEAM(pb + 5); }
        if (IN(pb + 6)) { RELAUNDER(); ph_down(F, L); SEAM(pb + 6); }
    }
#undef IN
#undef SEAM
}

extern "C" void kernel_launch(void* const* d_in, const int* in_sizes, int n_in, void* d_out, int out_size, void* d_ws, size_t ws_size, hipStream_t stream) {
    static int grid = 0;
    if (grid == 0) {
        if (n_in != 17 || in_sizes[0] != M * D || out_size != M * D || ws_size < WS_END) { fprintf(stderr, "kernel_launch: unexpected shapes (n_in %d, in0 %d, out %d, ws %zu)\n", n_in, n_in > 0 ? in_sizes[0] : -1, out_size, ws_size); grid = -1; return; }
        int dev = 0, cus = 0, per_cu = 0;
        if (hipGetDevice(&dev) != hipSuccess || hipDeviceGetAttribute(&cus, hipDeviceAttributeMultiprocessorCount, dev) != hipSuccess) { grid = -1; return; }
        if (hipFuncSetAttribute((const void*)fwd, hipFuncAttributeMaxDynamicSharedMemorySize, LDS_BYTES) != hipSuccess) { fprintf(stderr, "kernel_launch: hipFuncSetAttribute failed\n"); grid = -1; return; }
#if !ONE_LAUNCH
        (void)hipFuncSetAttribute((const void*)k_mix1_naive, hipFuncAttributeMaxDynamicSharedMemorySize, LDS_BYTES);
        (void)hipFuncSetAttribute((const void*)k_mix2_naive, hipFuncAttributeMaxDynamicSharedMemorySize, LDS_BYTES);
        (void)hipFuncSetAttribute((const void*)k_mix3_naive, hipFuncAttributeMaxDynamicSharedMemorySize, LDS_BYTES);
#endif
        if (hipOccupancyMaxActiveBlocksPerMultiprocessor(&per_cu, (const void*)fwd, NTHREADS, LDS_BYTES) != hipSuccess || per_cu < 1) { fprintf(stderr, "kernel_launch: occupancy query says %d\n", per_cu); per_cu = 1; }
        (void)hipGetLastError();
        grid = cus;
    }
    if (grid < 0) return;
    (void)hipMemsetAsync((char*)d_ws + WS_CTL, 0, CTL_ZERO_BYTES, stream);
    Args a{};
    for (int i = 0; i < 17; ++i) a.in[i] = (const float*)d_in[i];
    a.out = (float*)d_out; a.ws = (unsigned char*)d_ws;
#if ONE_LAUNCH
    a.ph_lo = 0; a.ph_hi = NPH;
    void* kargs[] = {&a};
    hipError_t e = hipLaunchCooperativeKernel((const void*)fwd, dim3(grid), dim3(NTHREADS), kargs, LDS_BYTES, stream);
    if (e != hipSuccess) fprintf(stderr, "kernel_launch: cooperative launch failed: %s (grid %d)\n", hipGetErrorString(e), grid);
#else
    for (int ph = 0; ph < NPH; ++ph) {
        const int r = ph == 0 ? -1 : (ph - 1) % 7, L = ph == 0 ? 0 : (ph - 1) / 7;
        a.ph_lo = ph; a.ph_hi = ph + 1;
        if (r == 1) { a.ph_lo = L; hipLaunchKernelGGL(k_mix1_naive, dim3(grid), dim3(NTHREADS), LDS_BYTES, stream, a); }
        else if (r == 2) { a.ph_lo = L; hipLaunchKernelGGL(k_mix2_naive, dim3(grid), dim3(NTHREADS), LDS_BYTES, stream, a); }
        else if (r == 3) { a.ph_lo = L; hipLaunchKernelGGL(k_mix3_naive, dim3(grid), dim3(NTHREADS), LDS_BYTES, stream, a); }
        else hipLaunchKernelGGL(fwd, dim3(grid), dim3(NTHREADS), LDS_BYTES, stream, a);
    }
#endif
}
```

```cpp
#include <hip/hip_runtime.h>
#include <cstdio>
#include <cstdint>
#define PROBE_REP 0


namespace pg8 {
#define PG8_LAS __attribute__((address_space(3)))
#define PG8_GAS __attribute__((address_space(1)))
typedef unsigned short bf16_t;
typedef short bf16x8 __attribute__((ext_vector_type(8)));
typedef float f32x4 __attribute__((ext_vector_type(4)));
typedef unsigned u32x4 __attribute__((ext_vector_type(4)));
constexpr int BM = 256, BK = 64, HALF = 128, HTB = HALF * BK * 2  , STAGE_BYTES = 8 * HTB, NXCD = 8, WGM = 8;

__host__ __device__ __forceinline__ int lds_byte(int r, int c) { const int st = (r >> 4) * 2 + (c >> 5), rr = r & 15, cc = c & 31, ob = rr * 64 + cc * 2; return st * 1024 + (ob ^ (((ob >> 9) & 1) << 5)); }
__host__ __device__ __forceinline__ void stage_rc(int b, int& R, int& C) { const int st = b / 1024, sb = b % 1024, swz = sb ^ (((sb >> 9) & 1) << 5); R = (st >> 1) * 16 + swz / 64; C = (st & 1) * 32 + (swz % 64) / 2; }
__host__ __device__ __forceinline__ int perm32(int rho) { const int n = rho >> 4, i = rho & 15; return 8 * (i >> 2) + 4 * n + (i & 3); }

struct Unit { int pm, pn; };
struct Gemm { const PG8_GAS bf16_t* A; const PG8_GAS bf16_t* Bt; int M, N, K, lda; };

struct StaticOrder {
    int nM, nN, nwg, G, c;
    __host__ __device__ void init(int M, int N, int G_, int c_) { nM = M / BM; nN = N / BM; nwg = nM * nN; G = G_; c = c_; }
    __host__ __device__ bool next(int i, Unit& u) const {
        const long L = (long)i * G + c; if (L >= nwg) return false;
        int wgid = (int)L; { const int q = nwg / NXCD, r = nwg % NXCD, xcd = wgid % NXCD, off = wgid / NXCD; wgid = (xcd < r ? xcd * (q + 1) : r * (q + 1) + (xcd - r) * q) + off; }
        const int nig = WGM * nN, gid = wgid / nig, fm = gid * WGM, gsz = (nM - fm) < WGM ? (nM - fm) : WGM;
        u.pm = fm + ((wgid % nig) % gsz); u.pn = (wgid % nig) / gsz; return true;
    }
    __device__ __forceinline__ void a_ready(const Unit&) const {}
    __device__ __forceinline__ void done(const Unit&) const {}
};

struct GroupOrder {
    int nN, li;
    __host__ __device__ void init(int N, int li_) { nN = N / BM; li = li_; }
    __host__ __device__ bool next(int i, Unit& u) const { const int T = i * 32 + li; if (T >= 8 * nN) return false; u.pm = T & 7; u.pn = T >> 3; return true; }
    __device__ __forceinline__ void a_ready(const Unit&) const {}
    __device__ __forceinline__ void done(const Unit&) const {}
};

__device__ __forceinline__ float shx(float v, int k, int lane) { return __builtin_bit_cast(float, __builtin_amdgcn_ds_bpermute((lane ^ k) << 2, __builtin_bit_cast(int, v))); }
__device__ __forceinline__ unsigned cvt_pk_bf16(float lo, float hi) { unsigned r; asm volatile("v_cvt_pk_bf16_f32 %0, %1, %2" : "=v"(r) : "v"(lo), "v"(hi)); return r; }

constexpr int PROJ_PITCH = 2304, DT_TILE = 9;
struct EpiProj {
    static constexpr bool PERM = true, AFTER_DRAIN = false;
    PG8_GAS bf16_t* O; PG8_GAS float* dtraw; const PG8_LAS float* rstd;
    __device__ __forceinline__ void operator()(const f32x4 (&acc)[2][2][4][2], const Unit& u, int ui, int wr, int wc, int fr, int fq) const {
        int rt0 = wr * 64 + fr; asm volatile("" : "+v"(rt0));
        if (u.pn == DT_TILE) {
            if (wc == 0 && fq == 0) {
#pragma unroll
                for (int ai = 0; ai < 2; ++ai)
#pragma unroll
                    for (int m = 0; m < 4; ++m) { const int rt = ai * HALF + rt0 + m * 16; const float rs = rstd[ui * BM + rt]; PG8_GAS float* p = dtraw + (size_t)(u.pm * BM + rt) * 8;
                        *(PG8_GAS f32x4*)p = acc[ai][0][m][0] * rs; *(PG8_GAS f32x4*)(p + 4) = acc[ai][0][m][1] * rs; }
            }
            return;
        }
        const int col0 = u.pn * BM + wc * 32 + 8 * fq;
#pragma unroll
        for (int ai = 0; ai < 2; ++ai)
#pragma unroll
            for (int m = 0; m < 4; ++m) { const int rt = ai * HALF + rt0 + m * 16; const float rs = rstd[ui * BM + rt]; PG8_GAS bf16_t* rowp = O + (size_t)(u.pm * BM + rt) * PROJ_PITCH + col0;
#pragma unroll
                for (int bj = 0; bj < 2; ++bj) { const f32x4 v0 = acc[ai][bj][m][0] * rs, v1 = acc[ai][bj][m][1] * rs;
                    u32x4 w; w.x = cvt_pk_bf16(v0[0], v0[1]); w.y = cvt_pk_bf16(v0[2], v0[3]); w.z = cvt_pk_bf16(v1[0], v1[1]); w.w = cvt_pk_bf16(v1[2], v1[3]);
                    *(PG8_GAS u32x4*)(rowp + bj * HALF) = w; } }
    }
};
struct EpiUp {
    static constexpr bool PERM = true, AFTER_DRAIN = false;
    PG8_GAS bf16_t* O; int ldc; const PG8_LAS float* rstd;
    __device__ __forceinline__ void operator()(const f32x4 (&acc)[2][2][4][2], const Unit& u, int ui, int wr, int wc, int fr, int fq) const {
        int rt0 = wr * 64 + fr; asm volatile("" : "+v"(rt0)); const int col0 = u.pn * BM + wc * 32 + 8 * fq;
#pragma unroll
        for (int ai = 0; ai < 2; ++ai)
#pragma unroll
            for (int m = 0; m < 4; ++m) { const int rt = ai * HALF + rt0 + m * 16; const float rs = rstd[ui * BM + rt]; PG8_GAS bf16_t* rowp = O + (size_t)(u.pm * BM + rt) * ldc + col0;
#pragma unroll
                for (int bj = 0; bj < 2; ++bj) { f32x4 v0 = acc[ai][bj][m][0] * rs, v1 = acc[ai][bj][m][1] * rs;
#pragma unroll
                    for (int e = 0; e < 4; ++e) { const float a = fmaxf(v0[e], 0.f), b = fmaxf(v1[e], 0.f); v0[e] = a * a; v1[e] = b * b; }
                    u32x4 w; w.x = cvt_pk_bf16(v0[0], v0[1]); w.y = cvt_pk_bf16(v0[2], v0[3]); w.z = cvt_pk_bf16(v1[0], v1[1]); w.w = cvt_pk_bf16(v1[2], v1[3]);
                    *(PG8_GAS u32x4*)(rowp + bj * HALF) = w; } }
    }
};
template <bool FINAL> struct EpiRes {
    static constexpr bool PERM = true, AFTER_DRAIN = false;
    PG8_GAS bf16_t* xb; PG8_GAS float* ssq; PG8_GAS float* out;
    __device__ __forceinline__ void operator()(const f32x4 (&acc)[2][2][4][2], const Unit& u, int ui, int wr, int wc, int fr, int fq) const {
        int rt0 = wr * 64 + fr; asm volatile("" : "+v"(rt0)); const int col0 = u.pn * BM + wc * 32 + 8 * fq;
#pragma unroll
        for (int ai = 0; ai < 2; ++ai)
#pragma unroll
            for (int m = 0; m < 4; ++m) { const int row = u.pm * BM + ai * HALF + rt0 + m * 16; const size_t off = (size_t)row * 1024 + col0; float s = 0.f;
#pragma unroll
                for (int bj = 0; bj < 2; ++bj) { const u32x4 rw = *(const PG8_GAS u32x4*)(xb + off + bj * HALF);
                    f32x4 v0, v1;
                    v0[0] = __uint_as_float(rw.x << 16) + acc[ai][bj][m][0][0]; v0[1] = __uint_as_float(rw.x & 0xffff0000u) + acc[ai][bj][m][0][1];
                    v0[2] = __uint_as_float(rw.y << 16) + acc[ai][bj][m][0][2]; v0[3] = __uint_as_float(rw.y & 0xffff0000u) + acc[ai][bj][m][0][3];
                    v1[0] = __uint_as_float(rw.z << 16) + acc[ai][bj][m][1][0]; v1[1] = __uint_as_float(rw.z & 0xffff0000u) + acc[ai][bj][m][1][1];
                    v1[2] = __uint_as_float(rw.w << 16) + acc[ai][bj][m][1][2]; v1[3] = __uint_as_float(rw.w & 0xffff0000u) + acc[ai][bj][m][1][3];
                    if (FINAL) { *(PG8_GAS f32x4*)(out + off + bj * HALF) = v0; *(PG8_GAS f32x4*)(out + off + bj * HALF + 4) = v1; }
                    else { u32x4 w; w.x = cvt_pk_bf16(v0[0], v0[1]); w.y = cvt_pk_bf16(v0[2], v0[3]); w.z = cvt_pk_bf16(v1[0], v1[1]); w.w = cvt_pk_bf16(v1[2], v1[3]);
                        *(PG8_GAS u32x4*)(xb + off + bj * HALF) = w;
                        s += (v0[0] * v0[0] + v0[1] * v0[1]) + (v0[2] * v0[2] + v0[3] * v0[3]) + (v1[0] * v1[0] + v1[1] * v1[1]) + (v1[2] * v1[2] + v1[3] * v1[3]); } }
                if (!FINAL) { const int ln = fq * 16 + fr; s += shx(s, 16, ln); s += shx(s, 32, ln);
                    if (fq == 0) ssq[(size_t)row * 16 + u.pn * 4 + wc] = s; } }
    }
};

template <class Epi, class Sched, bool ALIGN_EPI = false, bool SP2 = false>
__device__ __forceinline__ void gemm_phase(PG8_LAS unsigned char* lds, const Gemm g, const Sched& S, const Epi& E) {
    int tid_ = threadIdx.x; asm volatile("" : "+v"(tid_));
    const int tid = tid_, wid = __builtin_amdgcn_readfirstlane(tid >> 6), lane = tid & 63, wr = wid >> 2, wc = wid & 3, fr = lane & 15, fq = lane >> 4;
    const int K = g.K, nt = K / BK;
    unsigned voffA[2], voffB[2];
#pragma unroll
    for (int i = 0; i < 2; ++i) { int R, C; stage_rc(tid * 16 + i * 8192, R, C); const int Rb = Epi::PERM ? ((R & ~31) + perm32(R & 31)) : R;
        voffA[i] = (unsigned)(R * g.lda + C) * 2u; voffB[i] = (unsigned)(Rb * K + C) * 2u; }
    const size_t kstep = (size_t)(BK * 2);
    const size_t hstepA = (size_t)HALF * g.lda * 2, hstepB = (size_t)HALF * K * 2;
    const size_t tstepA = 2 * hstepA, tstepB = 2 * hstepB;
    const unsigned ldsw = (unsigned)wid * 1024u;
    const int aoff = lds_byte(wr * 64 + fr, fq * 8), boff = lds_byte(wc * 32 + fr, fq * 8);
#define PG8_SA(b, h) (((b) * 2 + (h)) * HTB)
#define PG8_SB(b, h) ((4 + (b) * 2 + (h)) * HTB)
#define PG8_STAGE(bufoff, gbase, voff) do { _Pragma("unroll") for (int _i = 0; _i < 2; ++_i) \
        __builtin_amdgcn_global_load_lds((const unsigned*)((const char*)(gbase) + (voff)[_i]), (PG8_LAS unsigned*)(lds + (bufoff) + ldsw + _i * 8192), 16, 0, 0); } while (0)
#define PG8_LDA(dst, b, h) do { _Pragma("unroll") for (int m = 0; m < 4; ++m) _Pragma("unroll") for (int k = 0; k < 2; ++k) dst[m][k] = *(const PG8_LAS bf16x8*)(lds + PG8_SA(b, h) + aoff + m * 2048 + k * 1024); } while (0)
#define PG8_LDB(dst, b, h) do { _Pragma("unroll") for (int n = 0; n < 2; ++n) _Pragma("unroll") for (int k = 0; k < 2; ++k) dst[n][k] = *(const PG8_LAS bf16x8*)(lds + PG8_SB(b, h) + boff + n * 2048 + k * 1024); } while (0)
#define PG8_MMA(ai, bj, At, Bt) do { __builtin_amdgcn_s_setprio(1); _Pragma("unroll") for (int m = 0; m < 4; ++m) _Pragma("unroll") for (int n = 0; n < 2; ++n) _Pragma("unroll") for (int k = 0; k < 2; ++k) \
        acc[ai][bj][m][n] = __builtin_amdgcn_mfma_f32_16x16x32_bf16(Bt[n][k], At[m][k], acc[ai][bj][m][n], 0, 0, 0); __builtin_amdgcn_s_setprio(0); } while (0)
#define PG8_WAIT_V(n) asm volatile("s_waitcnt vmcnt(" #n ")" ::: "memory")
#define PG8_WAIT_L(n) asm volatile("s_waitcnt lgkmcnt(" #n ")" ::: "memory")
#define PG8_BAR __builtin_amdgcn_s_barrier()
#define PG8_SCHED __builtin_amdgcn_sched_barrier(0)
    Unit cur, nxt; int ui = 0;
    if (!S.next(0, cur)) return;
    f32x4 acc[2][2][4][2];
#pragma unroll
    for (int a = 0; a < 2; ++a)
#pragma unroll
        for (int b = 0; b < 2; ++b)
#pragma unroll
            for (int m = 0; m < 4; ++m)
#pragma unroll
                for (int n = 0; n < 2; ++n) acc[a][b][m][n] = (f32x4){0.f, 0.f, 0.f, 0.f};
    bf16x8 At[4][2], B0[2][2], B1[2][2];
    const char* cA = (const char*)g.A + (size_t)cur.pm * tstepA; const char* cB = (const char*)g.Bt + (size_t)cur.pn * tstepB;
    S.a_ready(cur);
    if constexpr (SP2) {
        PG8_STAGE(PG8_SB(0, 0), cB, voffB); PG8_STAGE(PG8_SB(0, 1), cB + hstepB, voffB); PG8_STAGE(PG8_SA(0, 0), cA, voffA); PG8_STAGE(PG8_SA(0, 1), cA + hstepA, voffA);
        if (wr == 1) PG8_BAR;
        PG8_WAIT_V(2); PG8_BAR;
        PG8_STAGE(PG8_SB(1, 0), cB + kstep, voffB); PG8_STAGE(PG8_SA(1, 0), cA + kstep, voffA); PG8_STAGE(PG8_SB(1, 1), cB + hstepB + kstep, voffB);
        PG8_WAIT_V(6); PG8_BAR;
    } else {
        PG8_STAGE(PG8_SB(0, 0), cB, voffB); PG8_STAGE(PG8_SA(0, 0), cA, voffA); PG8_STAGE(PG8_SB(0, 1), cB + hstepB, voffB); PG8_STAGE(PG8_SA(0, 1), cA + hstepA, voffA);
        if (wr == 1) PG8_BAR;
        PG8_WAIT_V(4); PG8_BAR;
        PG8_STAGE(PG8_SB(1, 0), cB + kstep, voffB); PG8_STAGE(PG8_SA(1, 0), cA + kstep, voffA); PG8_STAGE(PG8_SB(1, 1), cB + hstepB + kstep, voffB);
        PG8_WAIT_V(6); PG8_BAR;
    }
    for (;;) {
        const bool has_next = S.next(ui + 1, nxt);
        const char* nA = has_next ? (const char*)g.A + (size_t)nxt.pm * tstepA : cA; const char* nB = has_next ? (const char*)g.Bt + (size_t)nxt.pn * tstepB : cB;
        for (int t = 0; t < nt; t += 2) {
            const bool last = (t == nt - 2);
            const char* a1 = cA + (size_t)(t + 1) * kstep;
            const char* a2 = last ? nA : cA + (size_t)(t + 2) * kstep; const char* b2 = last ? nB : cB + (size_t)(t + 2) * kstep;
            const char* a3 = a2 + kstep; const char* b3 = b2 + kstep;
            if (last && has_next) S.a_ready(nxt);
            if constexpr (SP2) {
            PG8_LDB(B0, 0, 0); PG8_LDB(B1, 0, 1); PG8_SCHED; PG8_LDA(At, 0, 0); PG8_STAGE(PG8_SA(1, 1), a1 + hstepA, voffA);
            PG8_WAIT_V(8); PG8_WAIT_L(0); PG8_BAR; PG8_MMA(0, 0, At, B0); PG8_MMA(0, 1, At, B1); PG8_BAR; PG8_SCHED;
            PG8_LDA(At, 0, 1); PG8_STAGE(PG8_SB(0, 0), b2, voffB); PG8_STAGE(PG8_SB(0, 1), b2 + hstepB, voffB); PG8_STAGE(PG8_SA(0, 0), a2, voffA);
            PG8_WAIT_V(8); PG8_WAIT_L(0); PG8_BAR; PG8_MMA(1, 0, At, B0); PG8_MMA(1, 1, At, B1); PG8_BAR; PG8_SCHED;
            PG8_LDB(B0, 1, 0); PG8_LDB(B1, 1, 1); PG8_SCHED; PG8_LDA(At, 1, 0); PG8_STAGE(PG8_SA(0, 1), a2 + hstepA, voffA);
            PG8_WAIT_V(8); PG8_WAIT_L(0); PG8_BAR; PG8_MMA(0, 0, At, B0); PG8_MMA(0, 1, At, B1); PG8_BAR; PG8_SCHED;
            PG8_LDA(At, 1, 1); PG8_STAGE(PG8_SB(1, 0), b3, voffB); PG8_STAGE(PG8_SB(1, 1), b3 + hstepB, voffB); PG8_STAGE(PG8_SA(1, 0), a3, voffA);
            PG8_WAIT_V(8); PG8_WAIT_L(0); PG8_BAR; PG8_MMA(1, 0, At, B0); PG8_MMA(1, 1, At, B1); PG8_BAR; PG8_SCHED;
            } else {
            PG8_LDB(B0, 0, 0); PG8_SCHED; PG8_LDA(At, 0, 0); PG8_STAGE(PG8_SA(1, 1), a1 + hstepA, voffA);
            PG8_WAIT_L(8); PG8_BAR; PG8_WAIT_L(0); PG8_MMA(0, 0, At, B0); PG8_BAR; PG8_SCHED;
            PG8_LDB(B1, 0, 1); PG8_STAGE(PG8_SB(0, 0), b2, voffB);
            PG8_BAR; PG8_WAIT_L(0); PG8_MMA(0, 1, At, B1); PG8_BAR;
            PG8_LDA(At, 0, 1); PG8_STAGE(PG8_SA(0, 0), a2, voffA);
            PG8_BAR; PG8_WAIT_L(0); PG8_MMA(1, 0, At, B0); PG8_BAR; PG8_SCHED;
            PG8_STAGE(PG8_SB(0, 1), b2 + hstepB, voffB);
            PG8_WAIT_V(6); PG8_BAR; PG8_MMA(1, 1, At, B1); PG8_BAR;
            PG8_LDB(B0, 1, 0); PG8_SCHED; PG8_LDA(At, 1, 0); PG8_STAGE(PG8_SA(0, 1), a2 + hstepA, voffA);
            PG8_WAIT_L(8); PG8_BAR; PG8_WAIT_L(0); PG8_MMA(0, 0, At, B0); PG8_BAR; PG8_SCHED;
            PG8_LDB(B1, 1, 1); PG8_STAGE(PG8_SB(1, 0), b3, voffB);
            PG8_BAR; PG8_WAIT_L(0); PG8_MMA(0, 1, At, B1); PG8_BAR;
            PG8_LDA(At, 1, 1); PG8_STAGE(PG8_SA(1, 0), a3, voffA);
            PG8_BAR; PG8_WAIT_L(0); PG8_MMA(1, 0, At, B0); PG8_BAR; PG8_SCHED;
            PG8_STAGE(PG8_SB(1, 1), b3 + hstepB, voffB);
            PG8_WAIT_V(6); PG8_BAR; PG8_MMA(1, 1, At, B1); PG8_BAR;
            }
        }
        if constexpr (ALIGN_EPI) { if (wr == 0) PG8_BAR; }
        if constexpr (!Epi::AFTER_DRAIN) { E(acc, cur, ui, wr, wc, fr, fq); S.done(cur); }
        if (!has_next) break;
#pragma unroll
        for (int a = 0; a < 2; ++a)
#pragma unroll
            for (int b = 0; b < 2; ++b)
#pragma unroll
                for (int m = 0; m < 4; ++m)
#pragma unroll
                    for (int n = 0; n < 2; ++n) acc[a][b][m][n] = (f32x4){0.f, 0.f, 0.f, 0.f};
        cur = nxt; cA = nA; cB = nB; ++ui;
        if constexpr (ALIGN_EPI) { if (wr == 1) PG8_BAR; }
    }
    PG8_WAIT_V(0);
    if constexpr (!ALIGN_EPI) { if (wr == 0) PG8_BAR; }
    PG8_BAR;

#undef PG8_SA
#undef PG8_SB
#undef PG8_STAGE
#undef PG8_LDA
#undef PG8_LDB
#undef PG8_MMA
#undef PG8_WAIT_V
#undef PG8_WAIT_L
#undef PG8_BAR
#undef PG8_SCHED
}
}

constexpr int NWAVES = 8, NTHREADS = NWAVES * 64;
constexpr int BATCH = 8, SEQ = 2048, D = 1024, M = BATCH * SEQ, FF = 4096, DEPTH = 2;
constexpr int D_IN = 2312, NPROJ = 2560, PP = pg8::PROJ_PITCH;
constexpr int CQ = 0, CZ = 512, CK = 1024, CV = 1152, CX = 1280, CBM = 1792, CCM = 2048;
constexpr float EPS = 1e-6f;
constexpr int GRID = 256, NGRP = 8, GRP = GRID / NGRP;

constexpr size_t MiB = 1u << 20;
constexpr size_t WS_CTL = 0, CTL_ZERO_BYTES = 1 * MiB;
constexpr size_t WS_SSQ = 1 * MiB;
constexpr size_t WS_DTRAW = 2 * MiB;
constexpr size_t WS_ACS = 2 * MiB + 512 * 1024, WS_CHDEC = 3 * MiB;
constexpr size_t WS_WIN = 4 * MiB, WS_WOUT = 14 * MiB, WS_WUP = 18 * MiB, WS_WDOWN = 34 * MiB;
constexpr size_t WS_XB = 50 * MiB;
constexpr size_t WS_BATCH0 = 82 * MiB, BATCH_STRIDE = 20 * MiB;
constexpr size_t BO_PROJ = 0;
constexpr size_t BO_STATES = 9 * MiB;
constexpr size_t BO_PREV = 13 * MiB;
constexpr size_t BO_YPART = 15 * MiB;
constexpr size_t BO_CC = 19 * MiB;
constexpr size_t BO_HID = 0;
constexpr size_t WS_END = WS_BATCH0 + BATCH * BATCH_STRIDE;
static_assert(WS_END <= 256 * MiB, "d_ws map");
constexpr int CW_BAR = 4096, CW_GRP = 16384, GRP_BAR_STRIDE = 4096;

constexpr int RING_OFF = 0, RING_BYTES = 131072;
constexpr int LDSCTL_OFF = RING_BYTES, MISC_OFF = LDSCTL_OFF + 320, RSTD_OFF = LDSCTL_OFF + 512, PTR_OFF = RSTD_OFF + 4096;
constexpr int LDS_BYTES = 147456;
static_assert(PTR_OFF + 512 <= LDS_BYTES, "LDS map");

#define GAS __attribute__((address_space(1)))
#define LAS __attribute__((address_space(3)))
typedef unsigned short bf16;
typedef unsigned v4u __attribute__((ext_vector_type(4)));
typedef unsigned v2u __attribute__((ext_vector_type(2)));
typedef float f32x4 __attribute__((ext_vector_type(4)));
#define LDS_WAIT() asm volatile("s_waitcnt lgkmcnt(0)" ::: "memory")
#define VM_WAIT() asm volatile("s_waitcnt vmcnt(0)" ::: "memory")
__device__ __forceinline__ unsigned f2bf(float f) { unsigned u = __builtin_bit_cast(unsigned, f); return (u + 0x7fffu + ((u >> 16) & 1u)) >> 16; }
__device__ __forceinline__ unsigned pk2(float lo, float hi) { return f2bf(lo) | (f2bf(hi) << 16); }
__device__ __forceinline__ float bflo(unsigned w) { return __uint_as_float(w << 16); }
__device__ __forceinline__ float bfhi(unsigned w) { return __uint_as_float(w & 0xffff0000u); }
__device__ __forceinline__ float silu_f(float v) { return v / (1.f + expf(-v)); }
__device__ __forceinline__ float softplus_f(float v) { return fmaxf(v, 0.f) + log1pf(expf(-fabsf(v))); }

#define XB_TMO      128
#define XB_XCNT(j)  (256  + 64 * (j))
#define XB_XSUB(j)  (1280 + 64 * (j))
#define XB_XGEN(j)  (2304 + 64 * (j))
#define XB_TOP      3328
#define XB_TOPGEN   3392
#define XCD_BAR_WORDS 3456
#define XB_SPIN_CAP (1u << 22)
__device__ __forceinline__ unsigned xb_ld(unsigned* p)              { return __hip_atomic_load(p, __ATOMIC_RELAXED, __HIP_MEMORY_SCOPE_AGENT); }
__device__ __forceinline__ unsigned xb_add(unsigned* p, unsigned v) { return __hip_atomic_fetch_add(p, v, __ATOMIC_RELAXED, __HIP_MEMORY_SCOPE_AGENT); }
__device__ __forceinline__ unsigned xb_xcc_id() { return (unsigned)__builtin_amdgcn_s_getreg((3 << 11) | 20) & 0xFu; }
#define XB_SPIN(cond, bar) do { unsigned _sp = 0; while (cond) { __builtin_amdgcn_s_sleep(1); \
    if ((++_sp & 255u) == 0u) { if (xb_ld(&(bar)[XB_TMO])) break; if (_sp > XB_SPIN_CAP) { atomicAdd(&(bar)[XB_TMO], 1u); break; } } } } while (0)
struct XcdBarrier { unsigned* bar; unsigned x; unsigned total; volatile LAS unsigned* st; };
__device__ __forceinline__ XcdBarrier xcd_barrier_post(unsigned* bar, volatile LAS unsigned* st, unsigned total) {
    XcdBarrier b; b.bar = bar; b.x = xb_xcc_id(); b.total = total; b.st = st;
    if (threadIdx.x == 0) (void)xb_add(&bar[XB_XCNT(b.x)], 1u);
    return b;
}
__device__ __forceinline__ void xcd_barrier_complete(unsigned* bar, unsigned x, unsigned G, unsigned& nloc, unsigned& nx) {
    unsigned sum, cnt, mine, sp = 0u;
    for (;;) {
        sum = 0u; cnt = 0u; mine = 0u;
#pragma unroll
        for (unsigned j = 0; j < 16; ++j) { const unsigned c = xb_ld(&bar[XB_XCNT(j)]); sum += c; cnt += (c > 0u) ? 1u : 0u; mine = (j == x) ? c : mine; }
        if (sum == G) break;
        __builtin_amdgcn_s_sleep(1);
        if ((++sp & 255u) == 0u) { if (xb_ld(&bar[XB_TMO])) break; if (sp > XB_SPIN_CAP) { atomicAdd(&bar[XB_TMO], 1u); break; } }
    }
    nloc = mine > 0u ? mine : 1u; nx = cnt > 0u ? cnt : 1u;
}
__device__ __forceinline__ void xcd_barrier(const XcdBarrier& b) {
    asm volatile("s_waitcnt vmcnt(0)" ::: "memory");
    __syncthreads();
    if (threadIdx.x == 0) {
        unsigned* bar = b.bar;
        __builtin_amdgcn_s_waitcnt(0);
        unsigned nloc = b.st[0], nx = b.st[1];
        if (nloc == 0u) { xcd_barrier_complete(bar, b.x, b.total, nloc, nx); b.st[0] = nloc; b.st[1] = nx; }
        const unsigned old = xb_add(&bar[XB_XSUB(b.x)], 1u);
        const unsigned gen = old / nloc;
        if (old + 1u == (gen + 1u) * nloc) {
            __builtin_amdgcn_fence(__ATOMIC_RELEASE, "agent");
            asm volatile("s_waitcnt vmcnt(0)" ::: "memory");
            const unsigned og = xb_add(&bar[XB_TOP], 1u);
            const unsigned tg = og / nx;
            if (og + 1u == (tg + 1u) * nx) xb_add(&bar[XB_TOPGEN], 1u);
            else XB_SPIN(xb_ld(&bar[XB_TOPGEN]) == tg, bar);
            __builtin_amdgcn_fence(__ATOMIC_ACQUIRE, "agent");
            xb_add(&bar[XB_XGEN(b.x)], 1u);
            asm volatile("s_waitcnt vmcnt(0)" ::: "memory");
        } else {
            XB_SPIN(xb_ld(&bar[XB_XGEN(b.x)]) == gen, bar);
            __builtin_amdgcn_fence(__ATOMIC_ACQUIRE, "agent");
            asm volatile("s_waitcnt vmcnt(0)" ::: "memory");
        }
    }
    __syncthreads();
}

struct Frame {
    LAS unsigned char* lds;
    int tid, lane, wave, bid, G;
    int b, li;
};
enum { I_X = 0, I_MIXG, I_WIN, I_QG, I_KG, I_SINK, I_RELB, I_CONVW, I_CONVB, I_DTB, I_ALOG, I_DSKIP, I_SSMG, I_WOUT, I_MLPG, I_WUP, I_WDOWN, I_OUT, I_WS, I_NPTR };
__device__ __forceinline__ GAS unsigned char* ptr_at(const Frame& F, int i) {
    const LAS unsigned* t = (const LAS unsigned*)(F.lds + PTR_OFF) + 2 * i;
    const unsigned lo = __builtin_amdgcn_readfirstlane(t[0]), hi = __builtin_amdgcn_readfirstlane(t[1]);
    return (GAS unsigned char*)(((unsigned long long)hi << 32) | lo);
}
#define FIN(i) ((const GAS float*)ptr_at(F, (i)))
#define FWS(off) (ptr_at(F, I_WS) + (off))
#define FB(off) (ptr_at(F, I_WS) + (WS_BATCH0 + (size_t)F.b * BATCH_STRIDE + (off)))
using pg8::shx;
__device__ __forceinline__ float shup(float v, int o, int lane) { return __builtin_bit_cast(float, __builtin_amdgcn_ds_bpermute(((lane - o) & 63) << 2, __builtin_bit_cast(int, v))); }
__device__ __forceinline__ float wave_sum(float v, int lane) {
#pragma unroll
    for (int o = 1; o < 64; o <<= 1) v += shx(v, o, lane);
    return v;
}

__device__ __forceinline__ void tr_item(const GAS float* W, int Nsrc, int nsrc0, int nvalid, int K, const GAS float* gain, GAS bf16* WT, int ndst0, int k0, LAS float* scr, int lane) {
    const int n = lane & 31;
#pragma unroll 8
    for (int i = 0; i < 32; ++i) { const int kk = 2 * i + (lane >> 5); float v = 0.f;
        if (n < nvalid) { v = W[(size_t)(k0 + kk) * Nsrc + nsrc0 + n]; if (gain) v *= gain[k0 + kk]; }
        scr[kk * 33 + n] = v; }
    LDS_WAIT(); asm volatile("" ::: "memory");
    const int c = lane & 7;
#pragma unroll
    for (int j = 0; j < 4; ++j) { const int nn = (lane >> 3) + 8 * j; const LAS float* s = scr + (8 * c) * 33 + nn;
        v4u o; o.x = pk2(s[0 * 33], s[1 * 33]); o.y = pk2(s[2 * 33], s[3 * 33]); o.z = pk2(s[4 * 33], s[5 * 33]); o.w = pk2(s[6 * 33], s[7 * 33]);
        *(GAS v4u*)(WT + (size_t)(ndst0 + nn) * K + k0 + 8 * c) = o; }
    LDS_WAIT(); asm volatile("" ::: "memory");
}
__device__ __forceinline__ void p0_prologue(Frame& F) {
    LAS float* scr = (LAS float*)(F.lds + RING_OFF + F.wave * 16384);
    const int gw = F.bid * NWAVES + F.wave, NGW = F.G * NWAVES;
    constexpr int I_IN = 16 * 80, I_OUT = 16 * 32, I_UP = 16 * 128, I_DN = 64 * 32, I_L = I_IN + I_OUT + I_UP + I_DN;
    {
    const GAS float *w_in = FIN(I_WIN), *mix_g = FIN(I_MIXG), *w_out = FIN(I_WOUT), *w_up = FIN(I_WUP), *mlp_g = FIN(I_MLPG), *w_down = FIN(I_WDOWN);
    GAS bf16 *WIN = (GAS bf16*)FWS(WS_WIN), *WOUT = (GAS bf16*)FWS(WS_WOUT), *WUP = (GAS bf16*)FWS(WS_WUP), *WDOWN = (GAS bf16*)FWS(WS_WDOWN);
    for (int it = gw; it < DEPTH * I_L; it += NGW) {
        const int L = it / I_L; int r = it % I_L;
        if (r < I_IN) {
            const int kb = r / 80, nb = r % 80; int src, nv = 32;
            if (nb < 16) src = nb * 32; else if (nb < 32) src = 768 + (nb - 16) * 32; else if (nb < 36) src = 512 + (nb - 32) * 32; else if (nb < 40) src = 640 + (nb - 36) * 32;
            else if (nb < 72) src = nb * 32; else if (nb == 72) { src = 2304; nv = 8; } else { src = 0; nv = 0; }
            tr_item(w_in + (size_t)L * D * D_IN, D_IN, src, nv, D, mix_g + L * D, WIN + (size_t)L * NPROJ * D, nb * 32, kb * 64, scr, F.lane); continue; }
        r -= I_IN;
        if (r < I_OUT) { const int kb = r / 32, nb = r % 32; tr_item(w_out + (size_t)L * D * D, D, nb * 32, 32, D, nullptr, WOUT + (size_t)L * D * D, nb * 32, kb * 64, scr, F.lane); continue; }
        r -= I_OUT;
        if (r < I_UP) { const int kb = r / 128, nb = r % 128; tr_item(w_up + (size_t)L * D * FF, FF, nb * 32, 32, D, mlp_g + L * D, WUP + (size_t)L * FF * D, nb * 32, kb * 64, scr, F.lane); continue; }
        r -= I_UP;
        { const int kb = r / 32, nb = r % 32; tr_item(w_down + (size_t)L * FF * D, D, nb * 32, 32, FF, nullptr, WDOWN + (size_t)L * D * FF, nb * 32, kb * 64, scr, F.lane); }
    }
    }
    const GAS float* x = FIN(I_X); GAS bf16* XB = (GAS bf16*)FWS(WS_XB); GAS float* SSQ = (GAS float*)FWS(WS_SSQ);
    for (int m = gw; m < M; m += NGW) {
        const GAS f32x4* xr = (const GAS f32x4*)(x + (size_t)m * D) + F.lane;
        f32x4 v[4]; float s = 0.f;
#pragma unroll
        for (int j = 0; j < 4; ++j) { v[j] = xr[64 * j]; s += (v[j].x * v[j].x + v[j].y * v[j].y) + (v[j].z * v[j].z + v[j].w * v[j].w); }
        s = wave_sum(s, F.lane);
        GAS v2u* o8 = (GAS v2u*)(XB + (size_t)m * D) + F.lane;
#pragma unroll
        for (int j = 0; j < 4; ++j) { v2u o; o.x = pk2(v[j].x, v[j].y); o.y = pk2(v[j].z, v[j].w); o8[64 * j] = o; }
        if (F.lane < 16) SSQ[(size_t)m * 16 + F.lane] = (F.lane == 0) ? s : 0.f;
    }
}
__device__ __forceinline__ void rstd_prepass(Frame& F, const pg8::GroupOrder& S, LAS float* tab) {
    const GAS float* SSQ = (const GAS float*)FWS(WS_SSQ) + (size_t)F.b * SEQ * 16;
    pg8::Unit u;
    for (int i = 0; i < 4 && S.next(i, u); ++i) {
        const int r = F.tid >> 1, h = F.tid & 1;
        const GAS f32x4* p = (const GAS f32x4*)(SSQ + (size_t)(u.pm * 256 + r) * 16 + h * 8);
        const f32x4 a = p[0], b = p[1];
        float s = (a.x + a.y) + (a.z + a.w) + (b.x + b.y) + (b.z + b.w);
        s += shx(s, 1, F.lane);
        if (h == 0) tab[i * 256 + r] = 1.0f / sqrtf(s * (1.0f / D) + EPS);
    }
    LDS_WAIT(); __syncthreads();
}
__device__ __forceinline__ int t5_bucket(int d) {
    if (d < 16) return d;
    return 16 + (d >= 19) + (d >= 21) + (d >= 24) + (d >= 27) + (d >= 31) + (d >= 35) + (d >= 40) + (d >= 46) + (d >= 52) + (d >= 59) + (d >= 67) + (d >= 77) + (d >= 87) + (d >= 99) + (d >= 113);
}
__device__ __forceinline__ void ld8(const GAS bf16* p, float (&v)[8]) {
    const v4u w = *(const GAS v4u*)p;
    v[0] = bflo(w.x); v[1] = bfhi(w.x); v[2] = bflo(w.y); v[3] = bfhi(w.y); v[4] = bflo(w.z); v[5] = bfhi(w.z); v[6] = bflo(w.w); v[7] = bfhi(w.w);
}
typedef short bf16x8_t __attribute__((ext_vector_type(8)));
typedef float f32x16 __attribute__((ext_vector_type(16)));
constexpr float LOG2E = 1.4426950408889634f;
constexpr int AT_KS = 0, AT_KSTRIDE = 144, AT_VT = 36864, AT_VSTRIDE = 520, AT_BIAS = AT_VT + 64 * AT_VSTRIDE, AT_END = AT_BIAS + 2048;
static_assert(AT_END <= RING_BYTES, "attention LDS");
__device__ __forceinline__ unsigned pkbf(float lo, float hi) { return pg8::cvt_pk_bf16(lo, hi); }
__device__ __forceinline__ void attn_fast(Frame& F, int L, bool dummy = false, int cut = 0) {
    GAS bf16* PROJ = (GAS bf16*)FB(BO_PROJ);
    const GAS float* qg = FIN(I_QG) + L * 64; const GAS float* kg = FIN(I_KG) + L * 64; const GAS float* sinks = FIN(I_SINK) + L * 8; const GAS float* rel_bias = FIN(I_RELB);
    LAS unsigned char* Ks = F.lds + AT_KS; LAS unsigned char* Vt = F.lds + AT_VT; LAS float* biasT = (LAS float*)(F.lds + AT_BIAS);
    const int tid = F.tid, lane = F.lane, wave = F.wave, q = lane & 31, hh = lane >> 5;
    for (int unit = F.li; unit < 32; unit += GRP) {
        const int kvh = unit >> 4, qb = unit & 15;
        const int m0 = qb * 128;
        __syncthreads();
        { const int gi = tid >> 7, dist = tid & 127; biasT[tid] = rel_bias[t5_bucket(dist) * 8 + kvh * 4 + gi] * LOG2E; }
#pragma unroll
        for (int i = 0; i < 4; ++i) {
            const int c = tid + NTHREADS * i, key = c >> 3, part = c & 7;
            const bool valid = (qb > 0) || (key >= 128);
            v4u kw = {0u, 0u, 0u, 0u}, vw = {0u, 0u, 0u, 0u};
            if (valid) { const GAS bf16* kp = PROJ + (m0 + key - 128) * PP + CK + kvh * 64 + part * 8; kw = *(const GAS v4u*)kp; vw = *(const GAS v4u*)(kp + (CV - CK)); }
            float kv[8]; kv[0] = bflo(kw.x); kv[1] = bfhi(kw.x); kv[2] = bflo(kw.y); kv[3] = bfhi(kw.y); kv[4] = bflo(kw.z); kv[5] = bfhi(kw.z); kv[6] = bflo(kw.w); kv[7] = bfhi(kw.w);
            float ss = 0.f;
#pragma unroll
            for (int e = 0; e < 8; ++e) ss += kv[e] * kv[e];
            ss += shx(ss, 1, lane); ss += shx(ss, 2, lane); ss += shx(ss, 4, lane);
            const float rk = 1.0f / sqrtf(ss * (1.0f / 64.0f) + EPS);
            const f32x4 g0 = *(const GAS f32x4*)(kg + part * 8), g1 = *(const GAS f32x4*)(kg + part * 8 + 4);
            v4u ko; ko.x = pkbf(kv[0] * rk * g0.x, kv[1] * rk * g0.y); ko.y = pkbf(kv[2] * rk * g0.z, kv[3] * rk * g0.w); ko.z = pkbf(kv[4] * rk * g1.x, kv[5] * rk * g1.y); ko.w = pkbf(kv[6] * rk * g1.z, kv[7] * rk * g1.w);
            *(LAS v4u*)(Ks + key * AT_KSTRIDE + part * 16) = ko;
            LAS unsigned short* vt = (LAS unsigned short*)(Vt + (part * 8) * AT_VSTRIDE + key * 2);
            vt[0 * (AT_VSTRIDE / 2)] = (unsigned short)(vw.x & 0xffffu); vt[1 * (AT_VSTRIDE / 2)] = (unsigned short)(vw.x >> 16);
            vt[2 * (AT_VSTRIDE / 2)] = (unsigned short)(vw.y & 0xffffu); vt[3 * (AT_VSTRIDE / 2)] = (unsigned short)(vw.y >> 16);
            vt[4 * (AT_VSTRIDE / 2)] = (unsigned short)(vw.z & 0xffffu); vt[5 * (AT_VSTRIDE / 2)] = (unsigned short)(vw.z >> 16);
            vt[6 * (AT_VSTRIDE / 2)] = (unsigned short)(vw.w & 0xffffu); vt[7 * (AT_VSTRIDE / 2)] = (unsigned short)(vw.w >> 16);
        }
        LDS_WAIT(); __syncthreads();
        if (cut == 1) continue;
        const int gi = wave >> 1, qh = wave & 1, hq = kvh * 4 + gi;
        const float sink2 = sinks[hq] * LOG2E;
#pragma unroll 1
        for (int s = 0; s < 2; ++s) {
            const int a = 64 * qh + 32 * s;
            GAS bf16* qrow = PROJ + (m0 + a + q) * PP + CQ + hq * 64;
            float qv[4][8]; float ss = 0.f;
#pragma unroll
            for (int d0 = 0; d0 < 4; ++d0) { ld8(qrow + d0 * 16 + hh * 8, qv[d0]);
#pragma unroll
                for (int e = 0; e < 8; ++e) ss += qv[d0][e] * qv[d0][e]; }
            ss += shx(ss, 32, lane);
            const float rq = (1.0f / sqrtf(ss * (1.0f / 64.0f) + EPS)) * (0.125f * LOG2E);
            bf16x8_t qf[4];
#pragma unroll
            for (int d0 = 0; d0 < 4; ++d0) { const f32x4 g0 = *(const GAS f32x4*)(qg + d0 * 16 + hh * 8), g1 = *(const GAS f32x4*)(qg + d0 * 16 + hh * 8 + 4);
                v4u w; w.x = pkbf(qv[d0][0] * rq * g0.x, qv[d0][1] * rq * g0.y); w.y = pkbf(qv[d0][2] * rq * g0.z, qv[d0][3] * rq * g0.w);
                w.z = pkbf(qv[d0][4] * rq * g1.x, qv[d0][5] * rq * g1.y); w.w = pkbf(qv[d0][6] * rq * g1.z, qv[d0][7] * rq * g1.w);
                qf[d0] = __builtin_bit_cast(bf16x8_t, w); }
            f32x16 S[5];
#pragma unroll
            for (int kt = 0; kt < 5; ++kt) { f32x16 acc = {};
#pragma unroll
                for (int d0 = 0; d0 < 4; ++d0) { const bf16x8_t kf = *(const LAS bf16x8_t*)(Ks + (a + 32 * kt + q) * AT_KSTRIDE + d0 * 32 + hh * 16);
                    acc = __builtin_amdgcn_mfma_f32_32x32x16_bf16(kf, qf[d0], acc, 0, 0, 0); }
                S[kt] = acc; }
            float mx = sink2;
#pragma unroll
            for (int kt = 0; kt < 5; ++kt)
#pragma unroll
                for (int i = 0; i < 16; ++i) { const int cr = (i & 3) + 8 * (i >> 2) + 4 * hh, dist = 128 + q - 32 * kt - cr, kidx = a + 32 * kt + cr;
                    const bool ok = (dist >= 0) && (dist < 128) && ((qb > 0) || (kidx >= 128));
                    const float v = ok ? S[kt][i] + biasT[gi * 128 + (dist & 127)] : -INFINITY;
                    S[kt][i] = v; mx = fmaxf(mx, v); }
            mx = fmaxf(mx, shx(mx, 32, lane));
            float lsum = 0.f; bf16x8_t pf[5][2];
#pragma unroll
            for (int kt = 0; kt < 5; ++kt) {
#pragma unroll
                for (int i = 0; i < 16; ++i) { const float p = __builtin_amdgcn_exp2f(S[kt][i] - mx); S[kt][i] = p; lsum += p; }
#pragma unroll
                for (int s2 = 0; s2 < 2; ++s2) { v4u w; w.x = pkbf(S[kt][8 * s2 + 0], S[kt][8 * s2 + 1]); w.y = pkbf(S[kt][8 * s2 + 2], S[kt][8 * s2 + 3]);
                    w.z = pkbf(S[kt][8 * s2 + 4], S[kt][8 * s2 + 5]); w.w = pkbf(S[kt][8 * s2 + 6], S[kt][8 * s2 + 7]); pf[kt][s2] = __builtin_bit_cast(bf16x8_t, w); } }
            lsum += shx(lsum, 32, lane);
            lsum += __builtin_amdgcn_exp2f(sink2 - mx);
            if (cut == 2) { if (lsum == 12345.f) qrow[0] = (bf16)pf[0][0][0]; continue; }
            f32x16 O[2] = {{}, {}};
#pragma unroll
            for (int kt = 0; kt < 5; ++kt)
#pragma unroll
                for (int s2 = 0; s2 < 2; ++s2)
#pragma unroll
                    for (int db = 0; db < 2; ++db) { const LAS unsigned char* vb = Vt + (32 * db + q) * AT_VSTRIDE + (a + 32 * kt + 16 * s2 + 4 * hh) * 2;
                        const v2u lo = *(const LAS v2u*)vb, hi2 = *(const LAS v2u*)(vb + 16); v4u w; w.x = lo.x; w.y = lo.y; w.z = hi2.x; w.w = hi2.y;
                        O[db] = __builtin_amdgcn_mfma_f32_32x32x16_bf16(__builtin_bit_cast(bf16x8_t, w), pf[kt][s2], O[db], 0, 0, 0); }
            const float inv = 1.0f / lsum;
#pragma unroll
            for (int db = 0; db < 2; ++db)
#pragma unroll
                for (int g4 = 0; g4 < 4; ++g4) { v2u w; w.x = pkbf(O[db][4 * g4] * inv, O[db][4 * g4 + 1] * inv); w.y = pkbf(O[db][4 * g4 + 2] * inv, O[db][4 * g4 + 3] * inv);
                    GAS bf16* orow = dummy ? (GAS bf16*)FB(BO_YPART) + (m0 + a + q) * 512 + hq * 64 : qrow;
                    *(GAS v2u*)(orow + 32 * db + 8 * g4 + 4 * hh) = w; }
        }
    }
}

constexpr int SD_CM = 0, SD_BM = 34816, SD_BMT = 69632, SD_DT = 104448, SD_ACS = SD_DT + 2048, SD_WT = SD_ACS + 2048, SD_END = SD_WT + 64;
constexpr int SD_ROW = 272, SD_XT = 264, SD_HIMG = 64 * SD_XT + 64 * SD_ROW;
static_assert(2 * SD_HIMG <= SD_BMT && SD_END <= RING_BYTES, "SSD LDS map");
__device__ __forceinline__ int crow32(int i, int hh) { return (i & 3) + 8 * (i >> 2) + 4 * hh; }
__device__ __forceinline__ void conv8x4(const GAS bf16* PROJ, size_t m0, int c, int l0, int col0, const GAS float* cw, const GAS float* cbias, float (&out)[4][8]) {
    float w[4][8], bs[8], u[7][8];
#pragma unroll
    for (int k = 0; k < 4; ++k) { const f32x4 a = *(const GAS f32x4*)(cw + k * 1024), b = *(const GAS f32x4*)(cw + k * 1024 + 4); w[k][0] = a.x; w[k][1] = a.y; w[k][2] = a.z; w[k][3] = a.w; w[k][4] = b.x; w[k][5] = b.y; w[k][6] = b.z; w[k][7] = b.w; }
    { const f32x4 a = *(const GAS f32x4*)cbias, b = *(const GAS f32x4*)(cbias + 4); bs[0] = a.x; bs[1] = a.y; bs[2] = a.z; bs[3] = a.w; bs[4] = b.x; bs[5] = b.y; bs[6] = b.z; bs[7] = b.w; }
#pragma unroll
    for (int i = 0; i < 7; ++i) { const int row = l0 - 3 + i;
        if (c > 0 || row >= 0) ld8(PROJ + (size_t)((long)m0 + row) * PP + col0, u[i]);
        else {
#pragma unroll
            for (int e = 0; e < 8; ++e) u[i][e] = 0.f; } }
#pragma unroll
    for (int r = 0; r < 4; ++r)
#pragma unroll
        for (int e = 0; e < 8; ++e) out[r][e] = silu_f(bs[e] + w[0][e] * u[r][e] + w[1][e] * u[r + 1][e] + w[2][e] * u[r + 2][e] + w[3][e] * u[r + 3][e]);
}
__device__ __forceinline__ void ssd1_fast(Frame& F, int L) {
    const GAS bf16* PROJ = (const GAS bf16*)FB(BO_PROJ);
    const GAS float* conv_w = FIN(I_CONVW) + (size_t)L * 4 * 1024; const GAS float* conv_b = FIN(I_CONVB) + L * 1024;
    const GAS float* dt_bias = FIN(I_DTB) + L * 8; const GAS float* a_log = FIN(I_ALOG) + L * 8; const GAS float* d_skip = FIN(I_DSKIP) + L * 8;
    const GAS float* DTRAW = (const GAS float*)FWS(WS_DTRAW) + (size_t)F.b * SEQ * 8; GAS float* ACS = (GAS float*)FWS(WS_ACS) + (size_t)F.b * SEQ * 8; GAS float* CHDEC = (GAS float*)FWS(WS_CHDEC) + F.b * 128;
    GAS float* STATES = (GAS float*)FB(BO_STATES); GAS float* YPART = (GAS float*)FB(BO_YPART); GAS bf16* CC = (GAS bf16*)FB(BO_CC);
    LAS unsigned char* Cm = F.lds + SD_CM; LAS unsigned char* Bm = F.lds + SD_BM; LAS unsigned char* BmT = F.lds + SD_BMT;
    LAS float* dt_l = (LAS float*)(F.lds + SD_DT); LAS float* acs_l = (LAS float*)(F.lds + SD_ACS); LAS float* wt = (LAS float*)(F.lds + SD_WT);
    const int wave = F.wave;
    for (int unit = F.li; unit < 32; unit += GRP) {
        const int c = unit >> 1, g = unit & 1;
        const size_t m0 = (size_t)c * 128;
        int tid = F.tid; asm volatile("" : "+v"(tid));
        int lane = tid & 63, q = lane & 31, hh = lane >> 5;
        __syncthreads();
        { const int r = tid >> 7, l = tid & 127, head = 4 * g + r;
          const float dtv = softplus_f(DTRAW[(m0 + l) * 8 + head] + dt_bias[head]);
          float v = dtv * (-expf(a_log[head]));
#pragma unroll
          for (int o = 1; o < 64; o <<= 1) { const float t = shup(v, o, lane); if (lane >= o) v += t; }
          if (lane == 63) wt[wave] = v;
          LDS_WAIT(); __syncthreads();
          if (wave & 1) v += wt[wave - 1];
          dt_l[tid] = dtv; acs_l[tid] = v; ACS[(m0 + l) * 8 + head] = v;
          if (l == 127) CHDEC[c * 8 + head] = expf(v); }
#pragma unroll 1
        for (int it = tid; it < 1024; it += NTHREADS) {
            const int cg = it & 31, rg = it >> 5, isC = cg >> 4, n0 = (cg & 15) * 8, col0 = (isC ? CCM : CBM) + g * 128 + n0, l0 = 4 * rg;
            float o[4][8];
            conv8x4(PROJ, m0, c, l0, col0, conv_w + (col0 - CX), conv_b + (col0 - CX), o);
#pragma unroll
            for (int r = 0; r < 4; ++r) { const int l = l0 + r;
                v4u pk; pk.x = pkbf(o[r][0], o[r][1]); pk.y = pkbf(o[r][2], o[r][3]); pk.z = pkbf(o[r][4], o[r][5]); pk.w = pkbf(o[r][6], o[r][7]);
                *(LAS v4u*)((isC ? Cm : Bm) + l * SD_ROW + n0 * 2) = pk;
                if (isC) *(GAS v4u*)(CC + (m0 + l) * 256 + g * 128 + n0) = pk;
                else { LAS unsigned short* t = (LAS unsigned short*)(BmT + n0 * SD_ROW + l * 2);
                    t[0 * (SD_ROW / 2)] = (unsigned short)(pk.x & 0xffffu); t[1 * (SD_ROW / 2)] = (unsigned short)(pk.x >> 16); t[2 * (SD_ROW / 2)] = (unsigned short)(pk.y & 0xffffu); t[3 * (SD_ROW / 2)] = (unsigned short)(pk.y >> 16);
                    t[4 * (SD_ROW / 2)] = (unsigned short)(pk.z & 0xffffu); t[5 * (SD_ROW / 2)] = (unsigned short)(pk.z >> 16); t[6 * (SD_ROW / 2)] = (unsigned short)(pk.w & 0xffffu); t[7 * (SD_ROW / 2)] = (unsigned short)(pk.w >> 16); } }
        }
        LDS_WAIT(); __syncthreads();
        asm volatile("" : "+v"(tid)); lane = tid & 63; q = lane & 31; hh = lane >> 5;
        const int j = (wave < 4) ? (wave & 3) : 3 - (wave & 3);
        f32x16 cbT[4];
        { bf16x8_t cf[8];
#pragma unroll
          for (int ks = 0; ks < 8; ++ks) cf[ks] = *(const LAS bf16x8_t*)(Cm + (32 * j + q) * SD_ROW + (16 * ks + 8 * hh) * 2);
#pragma unroll
          for (int i = 0; i < 4; ++i) { f32x16 acc = {};
              if (i <= j) {
#pragma unroll
                  for (int ks = 0; ks < 8; ++ks) { const bf16x8_t bfr = *(const LAS bf16x8_t*)(Bm + (32 * i + q) * SD_ROW + (16 * ks + 8 * hh) * 2);
                      acc = __builtin_amdgcn_mfma_f32_32x32x16_bf16(bfr, cf[ks], acc, 0, 0, 0); } }
              cbT[i] = acc; } }
#pragma unroll 1
        for (int hp = 0; hp < 2; ++hp) {
            __syncthreads();
            asm volatile("" : "+v"(tid)); lane = tid & 63; q = lane & 31; hh = lane >> 5;
            { const int cg = tid & 15, rg = tid >> 4, h2 = cg >> 3, p0 = (cg & 7) * 8, r = 2 * hp + h2, col0 = CX + (4 * g + r) * 64 + p0, l0 = 4 * rg;
              float o[4][8];
              conv8x4(PROJ, m0, c, l0, col0, conv_w + (col0 - CX), conv_b + (col0 - CX), o);
              LAS unsigned char* T1 = F.lds + h2 * SD_HIMG; LAS unsigned char* T2 = T1 + 64 * SD_XT;
              const float aend = acs_l[r * 128 + 127];
#pragma unroll
              for (int rr = 0; rr < 4; ++rr) { const int l = l0 + rr; const float dtv = dt_l[r * 128 + l], wl = expf(aend - acs_l[r * 128 + l]);
#pragma unroll
                  for (int e = 0; e < 8; ++e) { const float xd = o[rr][e] * dtv;
                      *(LAS unsigned short*)(T1 + (p0 + e) * SD_XT + l * 2) = (unsigned short)f2bf(xd);
                      *(LAS unsigned short*)(T2 + (p0 + e) * SD_ROW + l * 2) = (unsigned short)f2bf(xd * wl); } } }
            LDS_WAIT(); __syncthreads();
            asm volatile("" : "+v"(tid)); lane = tid & 63; q = lane & 31; hh = lane >> 5;
            const int h2 = wave >> 2, r = 2 * hp + h2, head = 4 * g + r;
            const LAS unsigned char* T1 = F.lds + h2 * SD_HIMG; const LAS unsigned char* T2 = T1 + 64 * SD_XT;
            {
              const float acl = acs_l[r * 128 + 32 * j + q], diag = d_skip[head] / dt_l[r * 128 + 32 * j + q];
              f32x16 O[2] = {{}, {}};
#pragma unroll
              for (int i = 0; i < 4; ++i) { if (i <= j) {
                  int qq = q; asm volatile("" : "+v"(qq));
                  float xv[16];
#pragma unroll
                  for (int e = 0; e < 16; ++e) { const int cr = crow32(e, hh); const float dec = __builtin_amdgcn_exp2f((acl - acs_l[r * 128 + 32 * i + cr]) * LOG2E);
                      const bool ok = (i < j) || (cr <= qq);
                      float v = ok ? cbT[i][e] * dec : 0.f;
                      if (i == j && cr == qq) v += diag;
                      xv[e] = v; }
#pragma unroll
                  for (int s2 = 0; s2 < 2; ++s2) { v4u w; w.x = pkbf(xv[8 * s2 + 0], xv[8 * s2 + 1]); w.y = pkbf(xv[8 * s2 + 2], xv[8 * s2 + 3]); w.z = pkbf(xv[8 * s2 + 4], xv[8 * s2 + 5]); w.w = pkbf(xv[8 * s2 + 6], xv[8 * s2 + 7]);
                      const bf16x8_t xf = __builtin_bit_cast(bf16x8_t, w);
#pragma unroll
                      for (int pt = 0; pt < 2; ++pt) { const LAS unsigned char* ab = T1 + (32 * pt + q) * SD_XT + (32 * i + 16 * s2 + 4 * hh) * 2;
                          const v2u lo = *(const LAS v2u*)ab, hi2 = *(const LAS v2u*)(ab + 16); v4u aw; aw.x = lo.x; aw.y = lo.y; aw.z = hi2.x; aw.w = hi2.y;
                          O[pt] = __builtin_amdgcn_mfma_f32_32x32x16_bf16(__builtin_bit_cast(bf16x8_t, aw), xf, O[pt], 0, 0, 0); } } } }
              GAS float* yp = YPART + (m0 + 32 * j + q) * 512 + head * 64;
#pragma unroll
              for (int pt = 0; pt < 2; ++pt)
#pragma unroll
                  for (int g4 = 0; g4 < 4; ++g4) { f32x4 v; v.x = O[pt][4 * g4]; v.y = O[pt][4 * g4 + 1]; v.z = O[pt][4 * g4 + 2]; v.w = O[pt][4 * g4 + 3];
                      *(GAS f32x4*)(yp + 32 * pt + 8 * g4 + 4 * hh) = v; } }
            asm volatile("" : "+v"(tid)); lane = tid & 63; q = lane & 31; hh = lane >> 5;
            {
              const int nt = wave & 3;
              f32x16 St[2] = {{}, {}};
#pragma unroll
              for (int ks = 0; ks < 8; ++ks) { const bf16x8_t bfr = *(const LAS bf16x8_t*)(BmT + (32 * nt + q) * SD_ROW + (16 * ks + 8 * hh) * 2);
#pragma unroll
                  for (int pt = 0; pt < 2; ++pt) { const bf16x8_t af = *(const LAS bf16x8_t*)(T2 + (32 * pt + q) * SD_ROW + (16 * ks + 8 * hh) * 2);
                      St[pt] = __builtin_amdgcn_mfma_f32_32x32x16_bf16(af, bfr, St[pt], 0, 0, 0); } }
              GAS float* sp = STATES + ((size_t)c * 8 + head) * 8192 + 32 * nt + q;
#pragma unroll
              for (int pt = 0; pt < 2; ++pt)
#pragma unroll
                  for (int e = 0; e < 16; ++e) sp[(32 * pt + crow32(e, hh)) * 128] = St[pt][e]; }
        }
    }
}
__device__ __forceinline__ void ssd2_scan(Frame& F, int L) {
    const GAS float* STATES = (const GAS float*)FB(BO_STATES); const GAS float* CHDEC = (const GAS float*)FWS(WS_CHDEC) + F.b * 128; GAS bf16* PREV = (GAS bf16*)FB(BO_PREV);
    for (int idx = F.li * NTHREADS + F.tid; idx < 8 * 64 * 32; idx += GRP * NTHREADS) {
        const int n4 = idx & 31, p = (idx >> 5) & 63, head = idx >> 11;
        f32x4 s[16]; float dec[16];
#pragma unroll
        for (int c = 0; c < 16; ++c) { const size_t o = ((size_t)c * 8 + head) * 8192 + p * 128 + 4 * n4; s[c] = *(const GAS f32x4*)(STATES + o); dec[c] = CHDEC[c * 8 + head]; }
        f32x4 h = {0.f, 0.f, 0.f, 0.f};
#pragma unroll
        for (int c = 0; c < 16; ++c) { const size_t o = ((size_t)c * 8 + head) * 8192 + p * 128 + 4 * n4;
            v2u w; w.x = pkbf(h.x, h.y); w.y = pkbf(h.z, h.w); *(GAS v2u*)(PREV + o) = w;
            h = h * dec[c] + s[c]; }
    }
}
__device__ __forceinline__ void ssd3_fast(Frame& F, int L, bool dummy = false) {
    GAS bf16* PROJ = (GAS bf16*)FB(BO_PROJ); const GAS bf16* PREV = (const GAS bf16*)FB(BO_PREV); const GAS bf16* CC = (const GAS bf16*)FB(BO_CC);
    const GAS float* YPART = (const GAS float*)FB(BO_YPART); const GAS float* ACS = (const GAS float*)FWS(WS_ACS) + (size_t)F.b * SEQ * 8; const GAS float* ssm_g = FIN(I_SSMG) + L * 512;
    LAS float* exch = (LAS float*)(F.lds);
    const int lane = F.lane, wave = F.wave, q = lane & 31, hh = lane >> 5;
    for (int unit = F.li; unit < 32; unit += GRP) {
        const int c = unit >> 1, g = unit & 1;
        const size_t m0 = (size_t)c * 128;
        const int j = wave & 3, hp = wave >> 2;
        const size_t row = m0 + 32 * j + q;
        bf16x8_t cf[8];
#pragma unroll
        for (int ks = 0; ks < 8; ++ks) cf[ks] = *(const GAS bf16x8_t*)(CC + row * 256 + g * 128 + 16 * ks + 8 * hh);
        float v[2][2][16]; float ss = 0.f;
#pragma unroll
        for (int h2 = 0; h2 < 2; ++h2) { const int head = 4 * g + 2 * hp + h2;
            const GAS bf16* pv = PREV + ((size_t)c * 8 + head) * 8192;
            f32x16 O[2] = {{}, {}};
#pragma unroll
            for (int ks = 0; ks < 8; ++ks)
#pragma unroll
                for (int pt = 0; pt < 2; ++pt) { const bf16x8_t af = *(const GAS bf16x8_t*)(pv + (32 * pt + q) * 128 + 16 * ks + 8 * hh);
                    O[pt] = __builtin_amdgcn_mfma_f32_32x32x16_bf16(af, cf[ks], O[pt], 0, 0, 0); }
            const float ea = expf(ACS[row * 8 + head]);
#pragma unroll
            for (int pt = 0; pt < 2; ++pt)
#pragma unroll
                for (int g4 = 0; g4 < 4; ++g4) { const int p = 32 * pt + 8 * g4 + 4 * hh;
                    const f32x4 yp = *(const GAS f32x4*)(YPART + row * 512 + head * 64 + p);
                    const v2u zw = *(const GAS v2u*)(PROJ + row * PP + CZ + head * 64 + p);
                    const float y0 = yp.x + ea * O[pt][4 * g4], y1 = yp.y + ea * O[pt][4 * g4 + 1], y2 = yp.z + ea * O[pt][4 * g4 + 2], y3 = yp.w + ea * O[pt][4 * g4 + 3];
                    const float u0 = y0 * silu_f(bflo(zw.x)), u1 = y1 * silu_f(bfhi(zw.x)), u2 = y2 * silu_f(bflo(zw.y)), u3 = y3 * silu_f(bfhi(zw.y));
                    v[h2][pt][4 * g4] = u0; v[h2][pt][4 * g4 + 1] = u1; v[h2][pt][4 * g4 + 2] = u2; v[h2][pt][4 * g4 + 3] = u3;
                    ss += (u0 * u0 + u1 * u1) + (u2 * u2 + u3 * u3); } }
        ss += shx(ss, 32, lane);
        __syncthreads();
        if (hh == 0) exch[hp * 128 + 32 * j + q] = ss;
        LDS_WAIT(); __syncthreads();
        const float tot = exch[32 * j + q] + exch[128 + 32 * j + q];
        const float rn = 1.0f / sqrtf(tot * (1.0f / 256.0f) + EPS);
#pragma unroll
        for (int h2 = 0; h2 < 2; ++h2) { const int head = 4 * g + 2 * hp + h2;
#pragma unroll
            for (int pt = 0; pt < 2; ++pt)
#pragma unroll
                for (int g4 = 0; g4 < 4; ++g4) { const int p = 32 * pt + 8 * g4 + 4 * hh;
                    const f32x4 ng = *(const GAS f32x4*)(ssm_g + head * 64 + p);
                    v2u w; w.x = pkbf(v[h2][pt][4 * g4] * rn * ng.x, v[h2][pt][4 * g4 + 1] * rn * ng.y); w.y = pkbf(v[h2][pt][4 * g4 + 2] * rn * ng.z, v[h2][pt][4 * g4 + 3] * rn * ng.w);
                    GAS bf16* orow = dummy ? (GAS bf16*)FB(BO_STATES) + row * 512 : PROJ + row * PP + CZ;
                    *(GAS v2u*)(orow + head * 64 + p) = w; } }
    }
}

__device__ __forceinline__ void ph_inproj(Frame& F, int L) {
    LAS float* rstd_tab = (LAS float*)(F.lds + RSTD_OFF);
    int li_ = F.li; asm volatile("" : "+s"(li_)); pg8::GroupOrder S; S.init(NPROJ, li_);
    rstd_prepass(F, S, rstd_tab);
    pg8::Gemm g{(const GAS bf16*)FWS(WS_XB) + (size_t)F.b * SEQ * D, (const GAS bf16*)FWS(WS_WIN) + (size_t)L * NPROJ * D, SEQ, NPROJ, D, D};
    pg8::EpiProj E{(GAS bf16*)FB(BO_PROJ), (GAS float*)FWS(WS_DTRAW) + (size_t)F.b * SEQ * 8, (const LAS float*)rstd_tab};
    pg8::gemm_phase<pg8::EpiProj, pg8::GroupOrder, true, true>(F.lds + RING_OFF, g, S, E);
}
__device__ __forceinline__ void ph_outproj(Frame& F, int L) {
    int li_ = F.li; asm volatile("" : "+s"(li_)); pg8::GroupOrder S; S.init(D, li_);
    pg8::Gemm g{(const GAS bf16*)FB(BO_PROJ), (const GAS bf16*)FWS(WS_WOUT) + (size_t)L * D * D, SEQ, D, D, PP};
    pg8::EpiRes<false> E{(GAS bf16*)FWS(WS_XB) + (size_t)F.b * SEQ * D, (GAS float*)FWS(WS_SSQ) + (size_t)F.b * SEQ * 16, nullptr};
    pg8::gemm_phase<pg8::EpiRes<false>, pg8::GroupOrder, false, true>(F.lds + RING_OFF, g, S, E);
}
__device__ __forceinline__ void ph_up(Frame& F, int L) {
    LAS float* rstd_tab = (LAS float*)(F.lds + RSTD_OFF);
    int li_ = F.li; asm volatile("" : "+s"(li_)); pg8::GroupOrder S; S.init(FF, li_);
    rstd_prepass(F, S, rstd_tab);
    pg8::Gemm g{(const GAS bf16*)FWS(WS_XB) + (size_t)F.b * SEQ * D, (const GAS bf16*)FWS(WS_WUP) + (size_t)L * FF * D, SEQ, FF, D, D};
    pg8::EpiUp E{(GAS bf16*)FB(BO_HID), FF, (const LAS float*)rstd_tab};
    pg8::gemm_phase<pg8::EpiUp, pg8::GroupOrder, true, true>(F.lds + RING_OFF, g, S, E);
}
__device__ __forceinline__ void ph_down(Frame& F, int L) {
    int li_ = F.li; asm volatile("" : "+s"(li_)); pg8::GroupOrder S; S.init(D, li_);
    pg8::Gemm g{(const GAS bf16*)FB(BO_HID), (const GAS bf16*)FWS(WS_WDOWN) + (size_t)L * D * FF, SEQ, D, FF, FF};
    GAS bf16* XBb = (GAS bf16*)FWS(WS_XB) + (size_t)F.b * SEQ * D; GAS float* SSQb = (GAS float*)FWS(WS_SSQ) + (size_t)F.b * SEQ * 16;
    if (L == DEPTH - 1) { pg8::EpiRes<true> E{XBb, SSQb, (GAS float*)ptr_at(F, I_OUT) + (size_t)F.b * SEQ * D};
        pg8::gemm_phase<pg8::EpiRes<true>, pg8::GroupOrder, false, true>(F.lds + RING_OFF, g, S, E); }
    else { pg8::EpiRes<false> E{XBb, SSQb, nullptr};
        pg8::gemm_phase<pg8::EpiRes<false>, pg8::GroupOrder, false, true>(F.lds + RING_OFF, g, S, E); }
}

#ifndef PROBE_REP
#define PROBE_REP 0
#endif
struct Args { const float* in[17]; float* out; unsigned char* ws; int pad0, pad1; };
__global__ void __launch_bounds__(NTHREADS, 2) fwd(Args args) {
    extern __shared__ __attribute__((aligned(16))) unsigned char lds[];
    Frame F;
    F.lds = (LAS unsigned char*)lds;
    F.tid = threadIdx.x; F.lane = F.tid & 63; F.wave = __builtin_amdgcn_readfirstlane(F.tid >> 6); F.bid = blockIdx.x; F.G = gridDim.x; F.b = F.bid & 7; F.li = F.bid >> 3;
    for (int u = F.tid; u < (LDS_BYTES - LDSCTL_OFF) / 4; u += NTHREADS) ((LAS unsigned*)(F.lds + LDSCTL_OFF))[u] = 0u;
    __syncthreads();
    if (F.tid < I_NPTR) { const unsigned long long p = F.tid < 17 ? (unsigned long long)args.in[F.tid < 17 ? F.tid : 0] : (F.tid == I_OUT ? (unsigned long long)args.out : (unsigned long long)args.ws);
        LAS unsigned* t = (LAS unsigned*)(F.lds + PTR_OFF) + 2 * F.tid; t[0] = (unsigned)p; t[1] = (unsigned)(p >> 32); }
    LDS_WAIT(); __syncthreads();
    if (F.G != GRID) return;
#define GBAR_OBJ() XcdBarrier{(unsigned*)(unsigned char*)FWS(WS_CTL) + CW_BAR, xb_xcc_id(), (unsigned)GRID, (volatile LAS unsigned*)(F.lds + MISC_OFF) + 8}
#define GRP_OBJ()  XcdBarrier{(unsigned*)(unsigned char*)FWS(WS_CTL) + CW_GRP + (blockIdx.x & 7) * GRP_BAR_STRIDE, xb_xcc_id(), (unsigned)GRP, (volatile LAS unsigned*)(F.lds + MISC_OFF) + 12}
    (void)xcd_barrier_post((unsigned*)(unsigned char*)FWS(WS_CTL) + CW_BAR, (volatile LAS unsigned*)(F.lds + MISC_OFF) + 8, GRID);
    (void)xcd_barrier_post((unsigned*)(unsigned char*)FWS(WS_CTL) + CW_GRP + (blockIdx.x & 7) * GRP_BAR_STRIDE, (volatile LAS unsigned*)(F.lds + MISC_OFF) + 12, GRP);
#define RELAUNDER() do { int t_ = threadIdx.x; asm volatile("" : "+v"(t_)); F.tid = t_; F.lane = t_ & 63; F.wave = __builtin_amdgcn_readfirstlane(t_ >> 6); \
    int b_ = blockIdx.x; asm volatile("" : "+s"(b_)); F.bid = b_; F.b = b_ & 7; F.li = b_ >> 3; } while (0)
#define GRP_BAR() do { const XcdBarrier gb_ = GRP_OBJ(); xcd_barrier(gb_); } while (0)
#define GRID_BAR() do { const XcdBarrier gb_ = GBAR_OBJ(); xcd_barrier(gb_); } while (0)

    p0_prologue(F);
    if (PROBE_REP == 1) { GRID_BAR(); RELAUNDER(); p0_prologue(F); }
    GRID_BAR();
    for (int L = 0; L < DEPTH; ++L) {
        RELAUNDER(); ph_inproj(F, L); if (PROBE_REP == 2) { GRP_BAR(); RELAUNDER(); ph_inproj(F, L); } GRP_BAR();
        RELAUNDER(); attn_fast(F, L); ssd1_fast(F, L); GRP_BAR();
        RELAUNDER(); ssd2_scan(F, L); GRP_BAR();
        RELAUNDER(); ssd3_fast(F, L); GRP_BAR();
        RELAUNDER(); ph_outproj(F, L); GRP_BAR();
        RELAUNDER(); ph_up(F, L); if (PROBE_REP == 5) { GRP_BAR(); RELAUNDER(); ph_up(F, L); } GRP_BAR();
        RELAUNDER(); ph_down(F, L); if (L + 1 < DEPTH) GRP_BAR();
    }
}

extern "C" void kernel_launch(void* const* d_in, const int* in_sizes, int n_in, void* d_out, int out_size, void* d_ws, size_t ws_size, hipStream_t stream) {
    static int grid = 0;
    if (grid == 0) {
        if (n_in != 17 || in_sizes[0] != M * D || out_size != M * D || ws_size < WS_END) { fprintf(stderr, "kernel_launch: unexpected shapes (n_in %d, in0 %d, out %d, ws %zu)\n", n_in, n_in > 0 ? in_sizes[0] : -1, out_size, ws_size); grid = -1; return; }
        int dev = 0, cus = 0, per_cu = 0;
        if (hipGetDevice(&dev) != hipSuccess || hipDeviceGetAttribute(&cus, hipDeviceAttributeMultiprocessorCount, dev) != hipSuccess) { grid = -1; return; }
        if (hipFuncSetAttribute((const void*)fwd, hipFuncAttributeMaxDynamicSharedMemorySize, LDS_BYTES) != hipSuccess) { fprintf(stderr, "kernel_launch: hipFuncSetAttribute failed\n"); grid = -1; return; }
        if (hipOccupancyMaxActiveBlocksPerMultiprocessor(&per_cu, (const void*)fwd, NTHREADS, LDS_BYTES) != hipSuccess || per_cu < 1) { fprintf(stderr, "kernel_launch: occupancy query says %d\n", per_cu); per_cu = 0; }
        (void)hipGetLastError();
        if (cus * per_cu < GRID) { fprintf(stderr, "kernel_launch: this kernel needs %d co-resident workgroups (one per CU of a 256-CU device); the device admits %d x %d; nothing launched\n", GRID, cus, per_cu); grid = -1; return; }
        grid = GRID;
    }
    if (grid < 0) return;
    (void)hipMemsetAsync((char*)d_ws + WS_CTL, 0, CTL_ZERO_BYTES, stream);
    Args a{};
    for (int i = 0; i < 17; ++i) a.in[i] = (const float*)d_in[i];
    a.out = (float*)d_out; a.ws = (unsigned char*)d_ws;
    void* kargs[] = {&a};
    hipError_t e = hipLaunchCooperativeKernel((const void*)fwd, dim3(grid), dim3(NTHREADS), kargs, LDS_BYTES, stream);
    if (e != hipSuccess) fprintf(stderr, "kernel_launch: cooperative launch failed: %s (grid %d)\n", hipGetErrorString(e), grid);
}
```

```cpp
#include <hip/hip_runtime.h>
#include <cstdio>
#include <cstdint>
#define PROBE_REP 0


namespace pg8 {
#define PG8_LAS __attribute__((address_space(3)))
#define PG8_GAS __attribute__((address_space(1)))
typedef unsigned short bf16_t;
typedef short bf16x8 __attribute__((ext_vector_type(8)));
typedef float f32x4 __attribute__((ext_vector_type(4)));
typedef unsigned u32x4 __attribute__((ext_vector_type(4)));
constexpr int BM = 256, BK = 64, HALF = 128, HTB = HALF * BK * 2  , STAGE_BYTES = 8 * HTB, NXCD = 8, WGM = 8;

__host__ __device__ __forceinline__ int lds_byte(int r, int c) { const int st = (r >> 4) * 2 + (c >> 5), rr = r & 15, cc = c & 31, ob = rr * 64 + cc * 2; return st * 1024 + (ob ^ (((ob >> 9) & 1) << 5)); }
__host__ __device__ __forceinline__ void stage_rc(int b, int& R, int& C) { const int st = b / 1024, sb = b % 1024, swz = sb ^ (((sb >> 9) & 1) << 5); R = (st >> 1) * 16 + swz / 64; C = (st & 1) * 32 + (swz % 64) / 2; }
__host__ __device__ __forceinline__ int perm32(int rho) { const int n = rho >> 4, i = rho & 15; return 8 * (i >> 2) + 4 * n + (i & 3); }

struct Unit { int pm, pn; };
struct Gemm { const PG8_GAS bf16_t* A; const PG8_GAS bf16_t* Bt; int M, N, K, lda; };

struct StaticOrder {
    int nM, nN, nwg, G, c;
    __host__ __device__ void init(int M, int N, int G_, int c_) { nM = M / BM; nN = N / BM; nwg = nM * nN; G = G_; c = c_; }
    __host__ __device__ bool next(int i, Unit& u) const {
        const long L = (long)i * G + c; if (L >= nwg) return false;
        int wgid = (int)L; { const int q = nwg / NXCD, r = nwg % NXCD, xcd = wgid % NXCD, off = wgid / NXCD; wgid = (xcd < r ? xcd * (q + 1) : r * (q + 1) + (xcd - r) * q) + off; }
        const int nig = WGM * nN, gid = wgid / nig, fm = gid * WGM, gsz = (nM - fm) < WGM ? (nM - fm) : WGM;
        u.pm = fm + ((wgid % nig) % gsz); u.pn = (wgid % nig) / gsz; return true;
    }
    __device__ __forceinline__ void a_ready(const Unit&) const {}
    __device__ __forceinline__ void done(const Unit&) const {}
};

struct GroupOrder {
    int nN, li;
    __host__ __device__ void init(int N, int li_) { nN = N / BM; li = li_; }
    __host__ __device__ bool next(int i, Unit& u) const { const int T = i * 32 + li; if (T >= 8 * nN) return false; u.pm = T & 7; u.pn = T >> 3; return true; }
    __device__ __forceinline__ void a_ready(const Unit&) const {}
    __device__ __forceinline__ void done(const Unit&) const {}
};

__device__ __forceinline__ float shx(float v, int k, int lane) { return __builtin_bit_cast(float, __builtin_amdgcn_ds_bpermute((lane ^ k) << 2, __builtin_bit_cast(int, v))); }
__device__ __forceinline__ unsigned cvt_pk_bf16(float lo, float hi) { unsigned r; asm volatile("v_cvt_pk_bf16_f32 %0, %1, %2" : "=v"(r) : "v"(lo), "v"(hi)); return r; }

constexpr int PROJ_PITCH = 2304, DT_TILE = 9;
struct EpiProj {
    static constexpr bool PERM = true, AFTER_DRAIN = false;
    PG8_GAS bf16_t* O; PG8_GAS float* dtraw; const PG8_LAS float* rstd;
    __device__ __forceinline__ void operator()(const f32x4 (&acc)[2][2][4][2], const Unit& u, int ui, int wr, int wc, int fr, int fq) const {
        int rt0 = wr * 64 + fr; asm volatile("" : "+v"(rt0));
        if (u.pn == DT_TILE) {
            if (wc == 0 && fq == 0) {
#pragma unroll
                for (int ai = 0; ai < 2; ++ai)
#pragma unroll
                    for (int m = 0; m < 4; ++m) { const int rt = ai * HALF + rt0 + m * 16; const float rs = rstd[ui * BM + rt]; PG8_GAS float* p = dtraw + (size_t)(u.pm * BM + rt) * 8;
                        *(PG8_GAS f32x4*)p = acc[ai][0][m][0] * rs; *(PG8_GAS f32x4*)(p + 4) = acc[ai][0][m][1] * rs; }
            }
            return;
        }
        const int col0 = u.pn * BM + wc * 32 + 8 * fq;
#pragma unroll
        for (int ai = 0; ai < 2; ++ai)
#pragma unroll
            for (int m = 0; m < 4; ++m) { const int rt = ai * HALF + rt0 + m * 16; const float rs = rstd[ui * BM + rt]; PG8_GAS bf16_t* rowp = O + (size_t)(u.pm * BM + rt) * PROJ_PITCH + col0;
#pragma unroll
                for (int bj = 0; bj < 2; ++bj) { const f32x4 v0 = acc[ai][bj][m][0] * rs, v1 = acc[ai][bj][m][1] * rs;
                    u32x4 w; w.x = cvt_pk_bf16(v0[0], v0[1]); w.y = cvt_pk_bf16(v0[2], v0[3]); w.z = cvt_pk_bf16(v1[0], v1[1]); w.w = cvt_pk_bf16(v1[2], v1[3]);
                    *(PG8_GAS u32x4*)(rowp + bj * HALF) = w; } }
    }
};
struct EpiUp {
    static constexpr bool PERM = true, AFTER_DRAIN = false;
    PG8_GAS bf16_t* O; int ldc; const PG8_LAS float* rstd;
    __device__ __forceinline__ void operator()(const f32x4 (&acc)[2][2][4][2], const Unit& u, int ui, int wr, int wc, int fr, int fq) const {
        int rt0 = wr * 64 + fr; asm volatile("" : "+v"(rt0)); const int col0 = u.pn * BM + wc * 32 + 8 * fq;
#pragma unroll
        for (int ai = 0; ai < 2; ++ai)
#pragma unroll
            for (int m = 0; m < 4; ++m) { const int rt = ai * HALF + rt0 + m * 16; const float rs = rstd[ui * BM + rt]; PG8_GAS bf16_t* rowp = O + (size_t)(u.pm * BM + rt) * ldc + col0;
#pragma unroll
                for (int bj = 0; bj < 2; ++bj) { f32x4 v0 = acc[ai][bj][m][0] * rs, v1 = acc[ai][bj][m][1] * rs;
#pragma unroll
                    for (int e = 0; e < 4; ++e) { const float a = fmaxf(v0[e], 0.f), b = fmaxf(v1[e], 0.f); v0[e] = a * a; v1[e] = b * b; }
                    u32x4 w; w.x = cvt_pk_bf16(v0[0], v0[1]); w.y = cvt_pk_bf16(v0[2], v0[3]); w.z = cvt_pk_bf16(v1[0], v1[1]); w.w = cvt_pk_bf16(v1[2], v1[3]);
                    *(PG8_GAS u32x4*)(rowp + bj * HALF) = w; } }
    }
};
template <bool FINAL> struct EpiRes {
    static constexpr bool PERM = true, AFTER_DRAIN = false;
    PG8_GAS bf16_t* xb; PG8_GAS float* ssq; PG8_GAS float* out;
    __device__ __forceinline__ void operator()(const f32x4 (&acc)[2][2][4][2], const Unit& u, int ui, int wr, int wc, int fr, int fq) const {
        int rt0 = wr * 64 + fr; asm volatile("" : "+v"(rt0)); const int col0 = u.pn * BM + wc * 32 + 8 * fq;
#pragma unroll
        for (int ai = 0; ai < 2; ++ai)
#pragma unroll
            for (int m = 0; m < 4; ++m) { const int row = u.pm * BM + ai * HALF + rt0 + m * 16; const size_t off = (size_t)row * 1024 + col0; float s = 0.f;
#pragma unroll
                for (int bj = 0; bj < 2; ++bj) { const u32x4 rw = *(const PG8_GAS u32x4*)(xb + off + bj * HALF);
                    f32x4 v0, v1;
                    v0[0] = __uint_as_float(rw.x << 16) + acc[ai][bj][m][0][0]; v0[1] = __uint_as_float(rw.x & 0xffff0000u) + acc[ai][bj][m][0][1];
                    v0[2] = __uint_as_float(rw.y << 16) + acc[ai][bj][m][0][2]; v0[3] = __uint_as_float(rw.y & 0xffff0000u) + acc[ai][bj][m][0][3];
                    v1[0] = __uint_as_float(rw.z << 16) + acc[ai][bj][m][1][0]; v1[1] = __uint_as_float(rw.z & 0xffff0000u) + acc[ai][bj][m][1][1];
                    v1[2] = __uint_as_float(rw.w << 16) + acc[ai][bj][m][1][2]; v1[3] = __uint_as_float(rw.w & 0xffff0000u) + acc[ai][bj][m][1][3];
                    if (FINAL) { *(PG8_GAS f32x4*)(out + off + bj * HALF) = v0; *(PG8_GAS f32x4*)(out + off + bj * HALF + 4) = v1; }
                    else { u32x4 w; w.x = cvt_pk_bf16(v0[0], v0[1]); w.y = cvt_pk_bf16(v0[2], v0[3]); w.z = cvt_pk_bf16(v1[0], v1[1]); w.w = cvt_pk_bf16(v1[2], v1[3]);
                        *(PG8_GAS u32x4*)(xb + off + bj * HALF) = w;
                        s += (v0[0] * v0[0] + v0[1] * v0[1]) + (v0[2] * v0[2] + v0[3] * v0[3]) + (v1[0] * v1[0] + v1[1] * v1[1]) + (v1[2] * v1[2] + v1[3] * v1[3]); } }
                if (!FINAL) { const int ln = fq * 16 + fr; s += shx(s, 16, ln); s += shx(s, 32, ln);
                    if (fq == 0) ssq[(size_t)row * 16 + u.pn * 4 + wc] = s; } }
    }
};

template <class Epi, class Sched, bool ALIGN_EPI = false, bool SP2 = false>
__device__ __forceinline__ void gemm_phase(PG8_LAS unsigned char* lds, const Gemm g, const Sched& S, const Epi& E) {
    int tid_ = threadIdx.x; asm volatile("" : "+v"(tid_));
    const int tid = tid_, wid = __builtin_amdgcn_readfirstlane(tid >> 6), lane = tid & 63, wr = wid >> 2, wc = wid & 3, fr = lane & 15, fq = lane >> 4;
    const int K = g.K, nt = K / BK;
    unsigned voffA[2], voffB[2];
#pragma unroll
    for (int i = 0; i < 2; ++i) { int R, C; stage_rc(tid * 16 + i * 8192, R, C); const int Rb = Epi::PERM ? ((R & ~31) + perm32(R & 31)) : R;
        voffA[i] = (unsigned)(R * g.lda + C) * 2u; voffB[i] = (unsigned)(Rb * K + C) * 2u; }
    const size_t kstep = (size_t)(BK * 2);
    const size_t hstepA = (size_t)HALF * g.lda * 2, hstepB = (size_t)HALF * K * 2;
    const size_t tstepA = 2 * hstepA, tstepB = 2 * hstepB;
    const unsigned ldsw = (unsigned)wid * 1024u;
    const int aoff = lds_byte(wr * 64 + fr, fq * 8), boff = lds_byte(wc * 32 + fr, fq * 8);
#define PG8_SA(b, h) (((b) * 2 + (h)) * HTB)
#define PG8_SB(b, h) ((4 + (b) * 2 + (h)) * HTB)
#define PG8_STAGE(bufoff, gbase, voff) do { _Pragma("unroll") for (int _i = 0; _i < 2; ++_i) \
        __builtin_amdgcn_global_load_lds((const unsigned*)((const char*)(gbase) + (voff)[_i]), (PG8_LAS unsigned*)(lds + (bufoff) + ldsw + _i * 8192), 16, 0, 0); } while (0)
#define PG8_LDA(dst, b, h) do { _Pragma("unroll") for (int m = 0; m < 4; ++m) _Pragma("unroll") for (int k = 0; k < 2; ++k) dst[m][k] = *(const PG8_LAS bf16x8*)(lds + PG8_SA(b, h) + aoff + m * 2048 + k * 1024); } while (0)
#define PG8_LDB(dst, b, h) do { _Pragma("unroll") for (int n = 0; n < 2; ++n) _Pragma("unroll") for (int k = 0; k < 2; ++k) dst[n][k] = *(const PG8_LAS bf16x8*)(lds + PG8_SB(b, h) + boff + n * 2048 + k * 1024); } while (0)
#define PG8_MMA(ai, bj, At, Bt) do { __builtin_amdgcn_s_setprio(1); _Pragma("unroll") for (int m = 0; m < 4; ++m) _Pragma("unroll") for (int n = 0; n < 2; ++n) _Pragma("unroll") for (int k = 0; k < 2; ++k) \
        acc[ai][bj][m][n] = __builtin_amdgcn_mfma_f32_16x16x32_bf16(Bt[n][k], At[m][k], acc[ai][bj][m][n], 0, 0, 0); __builtin_amdgcn_s_setprio(0); } while (0)
#define PG8_WAIT_V(n) asm volatile("s_waitcnt vmcnt(" #n ")" ::: "memory")
#define PG8_WAIT_L(n) asm volatile("s_waitcnt lgkmcnt(" #n ")" ::: "memory")
#define PG8_BAR __builtin_amdgcn_s_barrier()
#define PG8_SCHED __builtin_amdgcn_sched_barrier(0)
    Unit cur, nxt; int ui = 0;
    if (!S.next(0, cur)) return;
    f32x4 acc[2][2][4][2];
#pragma unroll
    for (int a = 0; a < 2; ++a)
#pragma unroll
        for (int b = 0; b < 2; ++b)
#pragma unroll
            for (int m = 0; m < 4; ++m)
#pragma unroll
                for (int n = 0; n < 2; ++n) acc[a][b][m][n] = (f32x4){0.f, 0.f, 0.f, 0.f};
    bf16x8 At[4][2], B0[2][2], B1[2][2];
    const char* cA = (const char*)g.A + (size_t)cur.pm * tstepA; const char* cB = (const char*)g.Bt + (size_t)cur.pn * tstepB;
    S.a_ready(cur);
    if constexpr (SP2) {
        PG8_STAGE(PG8_SB(0, 0), cB, voffB); PG8_STAGE(PG8_SB(0, 1), cB + hstepB, voffB); PG8_STAGE(PG8_SA(0, 0), cA, voffA); PG8_STAGE(PG8_SA(0, 1), cA + hstepA, voffA);
        if (wr == 1) PG8_BAR;
        PG8_WAIT_V(2); PG8_BAR;
        PG8_STAGE(PG8_SB(1, 0), cB + kstep, voffB); PG8_STAGE(PG8_SA(1, 0), cA + kstep, voffA); PG8_STAGE(PG8_SB(1, 1), cB + hstepB + kstep, voffB);
        PG8_WAIT_V(6); PG8_BAR;
    } else {
        PG8_STAGE(PG8_SB(0, 0), cB, voffB); PG8_STAGE(PG8_SA(0, 0), cA, voffA); PG8_STAGE(PG8_SB(0, 1), cB + hstepB, voffB); PG8_STAGE(PG8_SA(0, 1), cA + hstepA, voffA);
        if (wr == 1) PG8_BAR;
        PG8_WAIT_V(4); PG8_BAR;
        PG8_STAGE(PG8_SB(1, 0), cB + kstep, voffB); PG8_STAGE(PG8_SA(1, 0), cA + kstep, voffA); PG8_STAGE(PG8_SB(1, 1), cB + hstepB + kstep, voffB);
        PG8_WAIT_V(6); PG8_BAR;
    }
    for (;;) {
        const bool has_next = S.next(ui + 1, nxt);
        const char* nA = has_next ? (const char*)g.A + (size_t)nxt.pm * tstepA : cA; const char* nB = has_next ? (const char*)g.Bt + (size_t)nxt.pn * tstepB : cB;
        for (int t = 0; t < nt; t += 2) {
            const bool last = (t == nt - 2);
            const char* a1 = cA + (size_t)(t + 1) * kstep;
            const char* a2 = last ? nA : cA + (size_t)(t + 2) * kstep; const char* b2 = last ? nB : cB + (size_t)(t + 2) * kstep;
            const char* a3 = a2 + kstep; const char* b3 = b2 + kstep;
            if (last && has_next) S.a_ready(nxt);
            if constexpr (SP2) {
            PG8_LDB(B0, 0, 0); PG8_LDB(B1, 0, 1); PG8_SCHED; PG8_LDA(At, 0, 0); PG8_STAGE(PG8_SA(1, 1), a1 + hstepA, voffA);
            PG8_WAIT_V(8); PG8_WAIT_L(0); PG8_BAR; PG8_MMA(0, 0, At, B0); PG8_MMA(0, 1, At, B1); PG8_BAR; PG8_SCHED;
            PG8_LDA(At, 0, 1); PG8_STAGE(PG8_SB(0, 0), b2, voffB); PG8_STAGE(PG8_SB(0, 1), b2 + hstepB, voffB); PG8_STAGE(PG8_SA(0, 0), a2, voffA);
            PG8_WAIT_V(8); PG8_WAIT_L(0); PG8_BAR; PG8_MMA(1, 0, At, B0); PG8_MMA(1, 1, At, B1); PG8_BAR; PG8_SCHED;
            PG8_LDB(B0, 1, 0); PG8_LDB(B1, 1, 1); PG8_SCHED; PG8_LDA(At, 1, 0); PG8_STAGE(PG8_SA(0, 1), a2 + hstepA, voffA);
            PG8_WAIT_V(8); PG8_WAIT_L(0); PG8_BAR; PG8_MMA(0, 0, At, B0); PG8_MMA(0, 1, At, B1); PG8_BAR; PG8_SCHED;
            PG8_LDA(At, 1, 1); PG8_STAGE(PG8_SB(1, 0), b3, voffB); PG8_STAGE(PG8_SB(1, 1), b3 + hstepB, voffB); PG8_STAGE(PG8_SA(1, 0), a3, voffA);
            PG8_WAIT_V(8); PG8_WAIT_L(0); PG8_BAR; PG8_MMA(1, 0, At, B0); PG8_MMA(1, 1, At, B1); PG8_BAR; PG8_SCHED;
            } else {
            PG8_LDB(B0, 0, 0); PG8_SCHED; PG8_LDA(At, 0, 0); PG8_STAGE(PG8_SA(1, 1), a1 + hstepA, voffA);
            PG8_WAIT_L(8); PG8_BAR; PG8_WAIT_L(0); PG8_MMA(0, 0, At, B0); PG8_BAR; PG8_SCHED;
            PG8_LDB(B1, 0, 1); PG8_STAGE(PG8_SB(0, 0), b2, voffB);
            PG8_BAR; PG8_WAIT_L(0); PG8_MMA(0, 1, At, B1); PG8_BAR;
            PG8_LDA(At, 0, 1); PG8_STAGE(PG8_SA(0, 0), a2, voffA);
            PG8_BAR; PG8_WAIT_L(0); PG8_MMA(1, 0, At, B0); PG8_BAR; PG8_SCHED;
            PG8_STAGE(PG8_SB(0, 1), b2 + hstepB, voffB);
            PG8_WAIT_V(6); PG8_BAR; PG8_MMA(1, 1, At, B1); PG8_BAR;
            PG8_LDB(B0, 1, 0); PG8_SCHED; PG8_LDA(At, 1, 0); PG8_STAGE(PG8_SA(0, 1), a2 + hstepA, voffA);
            PG8_WAIT_L(8); PG8_BAR; PG8_WAIT_L(0); PG8_MMA(0, 0, At, B0); PG8_BAR; PG8_SCHED;
            PG8_LDB(B1, 1, 1); PG8_STAGE(PG8_SB(1, 0), b3, voffB);
            PG8_BAR; PG8_WAIT_L(0); PG8_MMA(0, 1, At, B1); PG8_BAR;
            PG8_LDA(At, 1, 1); PG8_STAGE(PG8_SA(1, 0), a3, voffA);
            PG8_BAR; PG8_WAIT_L(0); PG8_MMA(1, 0, At, B0); PG8_BAR; PG8_SCHED;
            PG8_STAGE(PG8_SB(1, 1), b3 + hstepB, voffB);
            PG8_WAIT_V(6); PG8_BAR; PG8_MMA(1, 1, At, B1); PG8_BAR;
            }
        }
        if constexpr (ALIGN_EPI) { if (wr == 0) PG8_BAR; }
        if constexpr (!Epi::AFTER_DRAIN) { E(acc, cur, ui, wr, wc, fr, fq); S.done(cur); }
        if (!has_next) break;
#pragma unroll
        for (int a = 0; a < 2; ++a)
#pragma unroll
            for (int b = 0; b < 2; ++b)
#pragma unroll
                for (int m = 0; m < 4; ++m)
#pragma unroll
                    for (int n = 0; n < 2; ++n) acc[a][b][m][n] = (f32x4){0.f, 0.f, 0.f, 0.f};
        cur = nxt; cA = nA; cB = nB; ++ui;
        if constexpr (ALIGN_EPI) { if (wr == 1) PG8_BAR; }
    }
    PG8_WAIT_V(0);
    if constexpr (!ALIGN_EPI) { if (wr == 0) PG8_BAR; }
    PG8_BAR;

#undef PG8_SA
#undef PG8_SB
#undef PG8_STAGE
#undef PG8_LDA
#undef PG8_LDB
#undef PG8_MMA
#undef PG8_WAIT_V
#undef PG8_WAIT_L
#undef PG8_BAR
#undef PG8_SCHED
}
}

constexpr int NWAVES = 8, NTHREADS = NWAVES * 64;
constexpr int BATCH = 8, SEQ = 2048, D = 1024, M = BATCH * SEQ, FF = 4096, DEPTH = 2;
constexpr int D_IN = 2312, NPROJ = 2560, PP = pg8::PROJ_PITCH;
constexpr int CQ = 0, CZ = 512, CK = 1024, CV = 1152, CX = 1280, CBM = 1792, CCM = 2048;
constexpr float EPS = 1e-6f;
constexpr int GRID = 256, NGRP = 8, GRP = GRID / NGRP;

constexpr size_t MiB = 1u << 20;
constexpr size_t WS_CTL = 0, CTL_ZERO_BYTES = 1 * MiB;
constexpr size_t WS_SSQ = 1 * MiB;
constexpr size_t WS_DTRAW = 2 * MiB;
constexpr size_t WS_ACS = 2 * MiB + 512 * 1024, WS_CHDEC = 3 * MiB;
constexpr size_t WS_WIN = 4 * MiB, WS_WOUT = 14 * MiB, WS_WUP = 18 * MiB, WS_WDOWN = 34 * MiB;
constexpr size_t WS_XB = 50 * MiB;
constexpr size_t WS_BATCH0 = 82 * MiB, BATCH_STRIDE = 20 * MiB;
constexpr size_t BO_PROJ = 0;
constexpr size_t BO_STATES = 9 * MiB;
constexpr size_t BO_PREV = 13 * MiB;
constexpr size_t BO_YPART = 15 * MiB;
constexpr size_t BO_CC = 19 * MiB;
constexpr size_t BO_HID = 0;
constexpr size_t WS_END = WS_BATCH0 + BATCH * BATCH_STRIDE;
static_assert(WS_END <= 256 * MiB, "d_ws map");
constexpr int CW_BAR = 4096, CW_GRP = 16384, GRP_BAR_STRIDE = 4096;

constexpr int RING_OFF = 0, RING_BYTES = 131072;
constexpr int LDSCTL_OFF = RING_BYTES, MISC_OFF = LDSCTL_OFF + 320, RSTD_OFF = LDSCTL_OFF + 512, PTR_OFF = RSTD_OFF + 4096;
constexpr int LDS_BYTES = 147456;
static_assert(PTR_OFF + 512 <= LDS_BYTES, "LDS map");

#define GAS __attribute__((address_space(1)))
#define LAS __attribute__((address_space(3)))
typedef unsigned short bf16;
typedef unsigned v4u __attribute__((ext_vector_type(4)));
typedef unsigned v2u __attribute__((ext_vector_type(2)));
typedef float f32x4 __attribute__((ext_vector_type(4)));
#define LDS_WAIT() asm volatile("s_waitcnt lgkmcnt(0)" ::: "memory")
#define VM_WAIT() asm volatile("s_waitcnt vmcnt(0)" ::: "memory")
__device__ __forceinline__ unsigned f2bf(float f) { unsigned u = __builtin_bit_cast(unsigned, f); return (u + 0x7fffu + ((u >> 16) & 1u)) >> 16; }
__device__ __forceinline__ unsigned pk2(float lo, float hi) { return f2bf(lo) | (f2bf(hi) << 16); }
__device__ __forceinline__ float bflo(unsigned w) { return __uint_as_float(w << 16); }
__device__ __forceinline__ float bfhi(unsigned w) { return __uint_as_float(w & 0xffff0000u); }
__device__ __forceinline__ float silu_f(float v) { return v / (1.f + expf(-v)); }
__device__ __forceinline__ float softplus_f(float v) { return fmaxf(v, 0.f) + log1pf(expf(-fabsf(v))); }

#define XB_TMO      128
#define XB_XCNT(j)  (256  + 64 * (j))
#define XB_XSUB(j)  (1280 + 64 * (j))
#define XB_XGEN(j)  (2304 + 64 * (j))
#define XB_TOP      3328
#define XB_TOPGEN   3392
#define XCD_BAR_WORDS 3456
#define XB_SPIN_CAP (1u << 22)
__device__ __forceinline__ unsigned xb_ld(unsigned* p)              { return __hip_atomic_load(p, __ATOMIC_RELAXED, __HIP_MEMORY_SCOPE_AGENT); }
__device__ __forceinline__ unsigned xb_add(unsigned* p, unsigned v) { return __hip_atomic_fetch_add(p, v, __ATOMIC_RELAXED, __HIP_MEMORY_SCOPE_AGENT); }
__device__ __forceinline__ unsigned xb_xcc_id() { return (unsigned)__builtin_amdgcn_s_getreg((3 << 11) | 20) & 0xFu; }
#define XB_SPIN(cond, bar) do { unsigned _sp = 0; while (cond) { __builtin_amdgcn_s_sleep(1); \
    if ((++_sp & 255u) == 0u) { if (xb_ld(&(bar)[XB_TMO])) break; if (_sp > XB_SPIN_CAP) { atomicAdd(&(bar)[XB_TMO], 1u); break; } } } } while (0)
struct XcdBarrier { unsigned* bar; unsigned x; unsigned total; volatile LAS unsigned* st; };
__device__ __forceinline__ XcdBarrier xcd_barrier_post(unsigned* bar, volatile LAS unsigned* st, unsigned total) {
    XcdBarrier b; b.bar = bar; b.x = xb_xcc_id(); b.total = total; b.st = st;
    if (threadIdx.x == 0) (void)xb_add(&bar[XB_XCNT(b.x)], 1u);
    return b;
}
__device__ __forceinline__ void xcd_barrier_complete(unsigned* bar, unsigned x, unsigned G, unsigned& nloc, unsigned& nx) {
    unsigned sum, cnt, mine, sp = 0u;
    for (;;) {
        sum = 0u; cnt = 0u; mine = 0u;
#pragma unroll
        for (unsigned j = 0; j < 16; ++j) { const unsigned c = xb_ld(&bar[XB_XCNT(j)]); sum += c; cnt += (c > 0u) ? 1u : 0u; mine = (j == x) ? c : mine; }
        if (sum == G) break;
        __builtin_amdgcn_s_sleep(1);
        if ((++sp & 255u) == 0u) { if (xb_ld(&bar[XB_TMO])) break; if (sp > XB_SPIN_CAP) { atomicAdd(&bar[XB_TMO], 1u); break; } }
    }
    nloc = mine > 0u ? mine : 1u; nx = cnt > 0u ? cnt : 1u;
}
__device__ __forceinline__ void xcd_barrier(const XcdBarrier& b) {
    asm volatile("s_waitcnt vmcnt(0)" ::: "memory");
    __syncthreads();
    if (threadIdx.x == 0) {
        unsigned* bar = b.bar;
        __builtin_amdgcn_s_waitcnt(0);
        unsigned nloc = b.st[0], nx = b.st[1];
        if (nloc == 0u) { xcd_barrier_complete(bar, b.x, b.total, nloc, nx); b.st[0] = nloc; b.st[1] = nx; }
        const unsigned old = xb_add(&bar[XB_XSUB(b.x)], 1u);
        const unsigned gen = old / nloc;
        if (old + 1u == (gen + 1u) * nloc) {
            __builtin_amdgcn_fence(__ATOMIC_RELEASE, "agent");
            asm volatile("s_waitcnt vmcnt(0)" ::: "memory");
            const unsigned og = xb_add(&bar[XB_TOP], 1u);
            const unsigned tg = og / nx;
            if (og + 1u == (tg + 1u) * nx) xb_add(&bar[XB_TOPGEN], 1u);
            else XB_SPIN(xb_ld(&bar[XB_TOPGEN]) == tg, bar);
            __builtin_amdgcn_fence(__ATOMIC_ACQUIRE, "agent");
            xb_add(&bar[XB_XGEN(b.x)], 1u);
            asm volatile("s_waitcnt vmcnt(0)" ::: "memory");
        } else {
            XB_SPIN(xb_ld(&bar[XB_XGEN(b.x)]) == gen, bar);
            __builtin_amdgcn_fence(__ATOMIC_ACQUIRE, "agent");
            asm volatile("s_waitcnt vmcnt(0)" ::: "memory");
        }
    }
    __syncthreads();
}

struct Frame {
    LAS unsigned char* lds;
    int tid, lane, wave, bid, G;
    int b, li;
};
enum { I_X = 0, I_MIXG, I_WIN, I_QG, I_KG, I_SINK, I_RELB, I_CONVW, I_CONVB, I_DTB, I_ALOG, I_DSKIP, I_SSMG, I_WOUT, I_MLPG, I_WUP, I_WDOWN, I_OUT, I_WS, I_NPTR };
__device__ __forceinline__ GAS unsigned char* ptr_at(const Frame& F, int i) {
    const LAS unsigned* t = (const LAS unsigned*)(F.lds + PTR_OFF) + 2 * i;
    const unsigned lo = __builtin_amdgcn_readfirstlane(t[0]), hi = __builtin_amdgcn_readfirstlane(t[1]);
    return (GAS unsigned char*)(((unsigned long long)hi << 32) | lo);
}
#define FIN(i) ((const GAS float*)ptr_at(F, (i)))
#define FWS(off) (ptr_at(F, I_WS) + (off))
#define FB(off) (ptr_at(F, I_WS) + (WS_BATCH0 + (size_t)F.b * BATCH_STRIDE + (off)))
using pg8::shx;
__device__ __forceinline__ float shup(float v, int o, int lane) { return __builtin_bit_cast(float, __builtin_amdgcn_ds_bpermute(((lane - o) & 63) << 2, __builtin_bit_cast(int, v))); }
__device__ __forceinline__ float wave_sum(float v, int lane) {
#pragma unroll
    for (int o = 1; o < 64; o <<= 1) v += shx(v, o, lane);
    return v;
}

__device__ __forceinline__ void tr_item(const GAS float* W, int Nsrc, int nsrc0, int nvalid, int K, const GAS float* gain, GAS bf16* WT, int ndst0, int k0, LAS float* scr, int lane) {
    const int n = lane & 31;
#pragma unroll 8
    for (int i = 0; i < 32; ++i) { const int kk = 2 * i + (lane >> 5); float v = 0.f;
        if (n < nvalid) { v = W[(size_t)(k0 + kk) * Nsrc + nsrc0 + n]; if (gain) v *= gain[k0 + kk]; }
        scr[kk * 33 + n] = v; }
    LDS_WAIT(); asm volatile("" ::: "memory");
    const int c = lane & 7;
#pragma unroll
    for (int j = 0; j < 4; ++j) { const int nn = (lane >> 3) + 8 * j; const LAS float* s = scr + (8 * c) * 33 + nn;
        v4u o; o.x = pk2(s[0 * 33], s[1 * 33]); o.y = pk2(s[2 * 33], s[3 * 33]); o.z = pk2(s[4 * 33], s[5 * 33]); o.w = pk2(s[6 * 33], s[7 * 33]);
        *(GAS v4u*)(WT + (size_t)(ndst0 + nn) * K + k0 + 8 * c) = o; }
    LDS_WAIT(); asm volatile("" ::: "memory");
}
__device__ __forceinline__ void p0_prologue(Frame& F) {
    LAS float* scr = (LAS float*)(F.lds + RING_OFF + F.wave * 16384);
    const int gw = F.bid * NWAVES + F.wave, NGW = F.G * NWAVES;
    constexpr int I_IN = 16 * 80, I_OUT = 16 * 32, I_UP = 16 * 128, I_DN = 64 * 32, I_L = I_IN + I_OUT + I_UP + I_DN;
    {
    const GAS float *w_in = FIN(I_WIN), *mix_g = FIN(I_MIXG), *w_out = FIN(I_WOUT), *w_up = FIN(I_WUP), *mlp_g = FIN(I_MLPG), *w_down = FIN(I_WDOWN);
    GAS bf16 *WIN = (GAS bf16*)FWS(WS_WIN), *WOUT = (GAS bf16*)FWS(WS_WOUT), *WUP = (GAS bf16*)FWS(WS_WUP), *WDOWN = (GAS bf16*)FWS(WS_WDOWN);
    for (int it = gw; it < DEPTH * I_L; it += NGW) {
        const int L = it / I_L; int r = it % I_L;
        if (r < I_IN) {
            const int kb = r / 80, nb = r % 80; int src, nv = 32;
            if (nb < 16) src = nb * 32; else if (nb < 32) src = 768 + (nb - 16) * 32; else if (nb < 36) src = 512 + (nb - 32) * 32; else if (nb < 40) src = 640 + (nb - 36) * 32;
            else if (nb < 72) src = nb * 32; else if (nb == 72) { src = 2304; nv = 8; } else { src = 0; nv = 0; }
            tr_item(w_in + (size_t)L * D * D_IN, D_IN, src, nv, D, mix_g + L * D, WIN + (size_t)L * NPROJ * D, nb * 32, kb * 64, scr, F.lane); continue; }
        r -= I_IN;
        if (r < I_OUT) { const int kb = r / 32, nb = r % 32; tr_item(w_out + (size_t)L * D * D, D, nb * 32, 32, D, nullptr, WOUT + (size_t)L * D * D, nb * 32, kb * 64, scr, F.lane); continue; }
        r -= I_OUT;
        if (r < I_UP) { const int kb = r / 128, nb = r % 128; tr_item(w_up + (size_t)L * D * FF, FF, nb * 32, 32, D, mlp_g + L * D, WUP + (size_t)L * FF * D, nb * 32, kb * 64, scr, F.lane); continue; }
        r -= I_UP;
        { const int kb = r / 32, nb = r % 32; tr_item(w_down + (size_t)L * FF * D, D, nb * 32, 32, FF, nullptr, WDOWN + (size_t)L * D * FF, nb * 32, kb * 64, scr, F.lane); }
    }
    }
    const GAS float* x = FIN(I_X); GAS bf16* XB = (GAS bf16*)FWS(WS_XB); GAS float* SSQ = (GAS float*)FWS(WS_SSQ);
    for (int m = gw; m < M; m += NGW) {
        const GAS f32x4* xr = (const GAS f32x4*)(x + (size_t)m * D) + F.lane;
        f32x4 v[4]; float s = 0.f;
#pragma unroll
        for (int j = 0; j < 4; ++j) { v[j] = xr[64 * j]; s += (v[j].x * v[j].x + v[j].y * v[j].y) + (v[j].z * v[j].z + v[j].w * v[j].w); }
        s = wave_sum(s, F.lane);
        GAS v2u* o8 = (GAS v2u*)(XB + (size_t)m * D) + F.lane;
#pragma unroll
        for (int j = 0; j < 4; ++j) { v2u o; o.x = pk2(v[j].x, v[j].y); o.y = pk2(v[j].z, v[j].w); o8[64 * j] = o; }
        if (F.lane < 16) SSQ[(size_t)m * 16 + F.lane] = (F.lane == 0) ? s : 0.f;
    }
}
__device__ __forceinline__ void rstd_prepass(Frame& F, const pg8::GroupOrder& S, LAS float* tab) {
    const GAS float* SSQ = (const GAS float*)FWS(WS_SSQ) + (size_t)F.b * SEQ * 16;
    pg8::Unit u;
    for (int i = 0; i < 4 && S.next(i, u); ++i) {
        const int r = F.tid >> 1, h = F.tid & 1;
        const GAS f32x4* p = (const GAS f32x4*)(SSQ + (size_t)(u.pm * 256 + r) * 16 + h * 8);
        const f32x4 a = p[0], b = p[1];
        float s = (a.x + a.y) + (a.z + a.w) + (b.x + b.y) + (b.z + b.w);
        s += shx(s, 1, F.lane);
        if (h == 0) tab[i * 256 + r] = 1.0f / sqrtf(s * (1.0f / D) + EPS);
    }
    LDS_WAIT(); __syncthreads();
}
__device__ __forceinline__ int t5_bucket(int d) {
    if (d < 16) return d;
    return 16 + (d >= 19) + (d >= 21) + (d >= 24) + (d >= 27) + (d >= 31) + (d >= 35) + (d >= 40) + (d >= 46) + (d >= 52) + (d >= 59) + (d >= 67) + (d >= 77) + (d >= 87) + (d >= 99) + (d >= 113);
}
__device__ __forceinline__ void ld8(const GAS bf16* p, float (&v)[8]) {
    const v4u w = *(const GAS v4u*)p;
    v[0] = bflo(w.x); v[1] = bfhi(w.x); v[2] = bflo(w.y); v[3] = bfhi(w.y); v[4] = bflo(w.z); v[5] = bfhi(w.z); v[6] = bflo(w.w); v[7] = bfhi(w.w);
}
typedef short bf16x8_t __attribute__((ext_vector_type(8)));
typedef float f32x16 __attribute__((ext_vector_type(16)));
constexpr float LOG2E = 1.4426950408889634f;
__device__ __forceinline__ unsigned pkbf(float lo, float hi) { return pg8::cvt_pk_bf16(lo, hi); }
__device__ __forceinline__ int crow32(int i, int hh) { return (i & 3) + 8 * (i >> 2) + 4 * hh; }
__device__ __forceinline__ float silu_fast(float v) { return v * __builtin_amdgcn_rcpf(1.0f + __builtin_amdgcn_exp2f(-v * LOG2E)); }
__device__ __forceinline__ void unpk8(const v4u w, float (&v)[8]) {
    v[0] = bflo(w.x); v[1] = bfhi(w.x); v[2] = bflo(w.y); v[3] = bfhi(w.y); v[4] = bflo(w.z); v[5] = bfhi(w.z); v[6] = bflo(w.w); v[7] = bfhi(w.w);
}

constexpr int AT_KS = 0, AT_KSTRIDE = 144, AT_VT = 36864, AT_VSTRIDE = 520, AT_BIAS = AT_VT + 64 * AT_VSTRIDE, AT_BN = 192, AT_END = AT_BIAS + 4 * AT_BN * 4;
static_assert(AT_END <= RING_BYTES, "attention LDS");
__device__ __forceinline__ void attn_fast(Frame& F, int L) {
    GAS bf16* PROJ = (GAS bf16*)FB(BO_PROJ);
    const GAS float* qg = FIN(I_QG) + L * 64; const GAS float* kg = FIN(I_KG) + L * 64; const GAS float* sinks = FIN(I_SINK) + L * 8; const GAS float* rel_bias = FIN(I_RELB);
    LAS unsigned char* Ks = F.lds + AT_KS; LAS unsigned char* Vt = F.lds + AT_VT; LAS float* biasR = (LAS float*)(F.lds + AT_BIAS);
    const int tid = F.tid, lane = F.lane, wave = F.wave, q = lane & 31, hh = lane >> 5;
    const int unit = F.li, kvh = unit >> 4, qb = unit & 15, m0 = qb * 128;
    const int gi = wave >> 1, qh = wave & 1, hq = kvh * 4 + gi;
    v4u qraw[2][4];
#pragma unroll
    for (int s = 0; s < 2; ++s)
#pragma unroll
        for (int d0 = 0; d0 < 4; ++d0) qraw[s][d0] = *(const GAS v4u*)(PROJ + (size_t)(m0 + 64 * qh + 32 * s + q) * PP + CQ + hq * 64 + d0 * 16 + hh * 8);
    __syncthreads();
    for (int x = tid; x < 4 * AT_BN; x += NTHREADS) { const int g_ = x / AT_BN, xx = x - g_ * AT_BN;
        biasR[x] = (xx >= 32 && xx < 160) ? rel_bias[t5_bucket(159 - xx) * 8 + kvh * 4 + g_] * LOG2E : 0.f; }
#pragma unroll
    for (int i = 0; i < 4; ++i) {
        const int c = tid + NTHREADS * i, key = c >> 3, part = c & 7;
        const bool valid = (qb > 0) || (key >= 128);
        v4u kw = {0u, 0u, 0u, 0u}, vw = {0u, 0u, 0u, 0u};
        if (valid) { const GAS bf16* kp = PROJ + (size_t)(m0 + key - 128) * PP + CK + kvh * 64 + part * 8; kw = *(const GAS v4u*)kp; vw = *(const GAS v4u*)(kp + (CV - CK)); }
        float kv[8]; unpk8(kw, kv);
        float ss = 0.f;
#pragma unroll
        for (int e = 0; e < 8; ++e) ss += kv[e] * kv[e];
        ss += shx(ss, 1, lane); ss += shx(ss, 2, lane); ss += shx(ss, 4, lane);
        const float rk = __builtin_amdgcn_rsqf(ss * (1.0f / 64.0f) + EPS);
        const f32x4 g0 = *(const GAS f32x4*)(kg + part * 8), g1 = *(const GAS f32x4*)(kg + part * 8 + 4);
        v4u ko; ko.x = pkbf(kv[0] * rk * g0.x, kv[1] * rk * g0.y); ko.y = pkbf(kv[2] * rk * g0.z, kv[3] * rk * g0.w); ko.z = pkbf(kv[4] * rk * g1.x, kv[5] * rk * g1.y); ko.w = pkbf(kv[6] * rk * g1.z, kv[7] * rk * g1.w);
        *(LAS v4u*)(Ks + key * AT_KSTRIDE + part * 16) = ko;
        LAS unsigned short* vt = (LAS unsigned short*)(Vt + (part * 8) * AT_VSTRIDE + key * 2);
        vt[0 * (AT_VSTRIDE / 2)] = (unsigned short)(vw.x & 0xffffu); vt[1 * (AT_VSTRIDE / 2)] = (unsigned short)(vw.x >> 16);
        vt[2 * (AT_VSTRIDE / 2)] = (unsigned short)(vw.y & 0xffffu); vt[3 * (AT_VSTRIDE / 2)] = (unsigned short)(vw.y >> 16);
        vt[4 * (AT_VSTRIDE / 2)] = (unsigned short)(vw.z & 0xffffu); vt[5 * (AT_VSTRIDE / 2)] = (unsigned short)(vw.z >> 16);
        vt[6 * (AT_VSTRIDE / 2)] = (unsigned short)(vw.w & 0xffffu); vt[7 * (AT_VSTRIDE / 2)] = (unsigned short)(vw.w >> 16);
    }
    LDS_WAIT(); __syncthreads();
    const float sink2 = sinks[hq] * LOG2E;
    const LAS float* bb = biasR + gi * AT_BN + 31 - q + 4 * hh;
    const int qm = q - 4 * hh;
#pragma unroll
    for (int s = 0; s < 2; ++s) {
        const int a = 64 * qh + 32 * s;
        GAS bf16* qrow = PROJ + (size_t)(m0 + a + q) * PP + CQ + hq * 64;
        float qv[4][8]; float ss = 0.f;
#pragma unroll
        for (int d0 = 0; d0 < 4; ++d0) { unpk8(qraw[s][d0], qv[d0]);
#pragma unroll
            for (int e = 0; e < 8; ++e) ss += qv[d0][e] * qv[d0][e]; }
        ss += shx(ss, 32, lane);
        const float rq = __builtin_amdgcn_rsqf(ss * (1.0f / 64.0f) + EPS) * (0.125f * LOG2E);
        bf16x8_t qf[4];
#pragma unroll
        for (int d0 = 0; d0 < 4; ++d0) { const f32x4 g0 = *(const GAS f32x4*)(qg + d0 * 16 + hh * 8), g1 = *(const GAS f32x4*)(qg + d0 * 16 + hh * 8 + 4);
            v4u w; w.x = pkbf(qv[d0][0] * rq * g0.x, qv[d0][1] * rq * g0.y); w.y = pkbf(qv[d0][2] * rq * g0.z, qv[d0][3] * rq * g0.w);
            w.z = pkbf(qv[d0][4] * rq * g1.x, qv[d0][5] * rq * g1.y); w.w = pkbf(qv[d0][6] * rq * g1.z, qv[d0][7] * rq * g1.w);
            qf[d0] = __builtin_bit_cast(bf16x8_t, w); }
        const int kt_lo = (qb == 0) ? 4 - (a >> 5) : 0;
        f32x16 S[5]; float mx = sink2;
#pragma unroll
        for (int kt = 0; kt < 5; ++kt) { f32x16 acc = {};
#pragma unroll
            for (int d0 = 0; d0 < 4; ++d0) { const bf16x8_t kf = *(const LAS bf16x8_t*)(Ks + (a + 32 * kt + q) * AT_KSTRIDE + d0 * 32 + hh * 16);
                acc = __builtin_amdgcn_mfma_f32_32x32x16_bf16(kf, qf[d0], acc, 0, 0, 0); }
            if (kt < kt_lo) {
#pragma unroll
                for (int i = 0; i < 16; ++i) acc[i] = -INFINITY;
            } else {
#pragma unroll
                for (int i = 0; i < 16; ++i) { const int t0 = (i & 3) + 8 * (i >> 2); float v = acc[i] + bb[32 * kt + t0];
                    if (kt == 0) v = (t0 > qm) ? v : -INFINITY;
                    if (kt == 4) v = (t0 <= qm) ? v : -INFINITY;
                    acc[i] = v; mx = fmaxf(mx, v); } }
            S[kt] = acc; }
        mx = fmaxf(mx, shx(mx, 32, lane));
        float lsum = 0.f; bf16x8_t pf[5][2];
#pragma unroll
        for (int kt = 0; kt < 5; ++kt) {
#pragma unroll
            for (int i = 0; i < 16; ++i) { const float p = __builtin_amdgcn_exp2f(S[kt][i] - mx); S[kt][i] = p; lsum += p; }
#pragma unroll
            for (int s2 = 0; s2 < 2; ++s2) { v4u w; w.x = pkbf(S[kt][8 * s2 + 0], S[kt][8 * s2 + 1]); w.y = pkbf(S[kt][8 * s2 + 2], S[kt][8 * s2 + 3]);
                w.z = pkbf(S[kt][8 * s2 + 4], S[kt][8 * s2 + 5]); w.w = pkbf(S[kt][8 * s2 + 6], S[kt][8 * s2 + 7]); pf[kt][s2] = __builtin_bit_cast(bf16x8_t, w); } }
        lsum += shx(lsum, 32, lane);
        lsum += __builtin_amdgcn_exp2f(sink2 - mx);
        f32x16 O[2] = {{}, {}};
#pragma unroll
        for (int kt = 0; kt < 5; ++kt)
#pragma unroll
            for (int s2 = 0; s2 < 2; ++s2)
#pragma unroll
                for (int db = 0; db < 2; ++db) { const LAS unsigned char* vb = Vt + (32 * db + q) * AT_VSTRIDE + (a + 32 * kt + 16 * s2 + 4 * hh) * 2;
                    const v2u lo = *(const LAS v2u*)vb, hi2 = *(const LAS v2u*)(vb + 16); v4u w; w.x = lo.x; w.y = lo.y; w.z = hi2.x; w.w = hi2.y;
                    O[db] = __builtin_amdgcn_mfma_f32_32x32x16_bf16(__builtin_bit_cast(bf16x8_t, w), pf[kt][s2], O[db], 0, 0, 0); }
        const float inv = __builtin_amdgcn_rcpf(lsum);
#pragma unroll
        for (int db = 0; db < 2; ++db)
#pragma unroll
            for (int g4 = 0; g4 < 4; ++g4) { v2u w; w.x = pkbf(O[db][4 * g4] * inv, O[db][4 * g4 + 1] * inv); w.y = pkbf(O[db][4 * g4 + 2] * inv, O[db][4 * g4 + 3] * inv);
                *(GAS v2u*)(qrow + 32 * db + 8 * g4 + 4 * hh) = w; }
    }
}

constexpr size_t WS_DTV = 3 * MiB + 512 * 1024;
constexpr int SD_ROW = 272, SD_XT = 264;
__device__ __forceinline__ void conv8x4(const GAS bf16* PROJ, int m0, int c, int l0, int col0, const GAS float* cw, const GAS float* cbias, float (&out)[4][8]) {
    float w[4][8], bs[8], u[7][8];
#pragma unroll
    for (int i = 0; i < 7; ++i) { const int row = l0 - 3 + i;
        if (c > 0 || row >= 0) ld8(PROJ + (size_t)(m0 + row) * PP + col0, u[i]);
        else {
#pragma unroll
            for (int e = 0; e < 8; ++e) u[i][e] = 0.f; } }
#pragma unroll
    for (int k = 0; k < 4; ++k) { const f32x4 a = *(const GAS f32x4*)(cw + k * 1024), b = *(const GAS f32x4*)(cw + k * 1024 + 4); w[k][0] = a.x; w[k][1] = a.y; w[k][2] = a.z; w[k][3] = a.w; w[k][4] = b.x; w[k][5] = b.y; w[k][6] = b.z; w[k][7] = b.w; }
    { const f32x4 a = *(const GAS f32x4*)cbias, b = *(const GAS f32x4*)(cbias + 4); bs[0] = a.x; bs[1] = a.y; bs[2] = a.z; bs[3] = a.w; bs[4] = b.x; bs[5] = b.y; bs[6] = b.z; bs[7] = b.w; }
#pragma unroll
    for (int r = 0; r < 4; ++r)
#pragma unroll
        for (int e = 0; e < 8; ++e) out[r][e] = silu_fast(bs[e] + w[0][e] * u[r][e] + w[1][e] * u[r + 1][e] + w[2][e] * u[r + 2][e] + w[3][e] * u[r + 3][e]);
}
__device__ __forceinline__ void conv4x4(const GAS bf16* PROJ, int m0, int c, int l0, int col0, const GAS float* cw, const GAS float* cbias, float (&out)[4][4]) {
    float w[4][4], bs[4], u[7][4];
#pragma unroll
    for (int i = 0; i < 7; ++i) { const int row = l0 - 3 + i; v2u x = {0u, 0u};
        if (c > 0 || row >= 0) x = *(const GAS v2u*)(PROJ + (size_t)(m0 + row) * PP + col0);
        u[i][0] = bflo(x.x); u[i][1] = bfhi(x.x); u[i][2] = bflo(x.y); u[i][3] = bfhi(x.y); }
#pragma unroll
    for (int k = 0; k < 4; ++k) { const f32x4 a = *(const GAS f32x4*)(cw + k * 1024); w[k][0] = a.x; w[k][1] = a.y; w[k][2] = a.z; w[k][3] = a.w; }
    { const f32x4 a = *(const GAS f32x4*)cbias; bs[0] = a.x; bs[1] = a.y; bs[2] = a.z; bs[3] = a.w; }
#pragma unroll
    for (int r = 0; r < 4; ++r)
#pragma unroll
        for (int e = 0; e < 4; ++e) out[r][e] = silu_fast(bs[e] + w[0][e] * u[r][e] + w[1][e] * u[r + 1][e] + w[2][e] * u[r + 2][e] + w[3][e] * u[r + 3][e]);
}
constexpr int S1_BMT = 0, S1_XW = 34816, S1_DT = S1_XW + 4 * 64 * SD_ROW, S1_ACS = S1_DT + 2048, S1_WT = S1_ACS + 2048, S1_END = S1_WT + 64;
static_assert(S1_END <= RING_BYTES, "SSD part 1 LDS");
__device__ __forceinline__ void ssd_states(Frame& F, int L) {
    const GAS bf16* PROJ = (const GAS bf16*)FB(BO_PROJ);
    const GAS float* conv_w = FIN(I_CONVW) + (size_t)L * 4 * 1024; const GAS float* conv_b = FIN(I_CONVB) + L * 1024;
    const GAS float* dt_bias = FIN(I_DTB) + L * 8; const GAS float* a_log = FIN(I_ALOG) + L * 8;
    const GAS float* DTRAW = (const GAS float*)FWS(WS_DTRAW) + (size_t)F.b * SEQ * 8; GAS float* ACS = (GAS float*)FWS(WS_ACS) + (size_t)F.b * SEQ * 8;
    GAS float* DTV = (GAS float*)FWS(WS_DTV) + (size_t)F.b * SEQ * 8; GAS float* CHDEC = (GAS float*)FWS(WS_CHDEC) + F.b * 128;
    GAS float* STATES = (GAS float*)FB(BO_STATES);
    LAS unsigned char* BmT = F.lds + S1_BMT; LAS unsigned char* XW = F.lds + S1_XW;
    LAS float* dt_l = (LAS float*)(F.lds + S1_DT); LAS float* acs_l = (LAS float*)(F.lds + S1_ACS); LAS float* wt = (LAS float*)(F.lds + S1_WT);
    const int wave = F.wave, unit = F.li, c = unit >> 1, g = unit & 1, m0 = c * 128;
    int tid = F.tid; asm volatile("" : "+v"(tid));
    int lane = tid & 63, q = lane & 31, hh = lane >> 5;
    __syncthreads();
    { const int r = tid >> 7, l = tid & 127, head = 4 * g + r;
      const float dtv = softplus_f(DTRAW[(size_t)(m0 + l) * 8 + head] + dt_bias[head]);
      float v = dtv * (-expf(a_log[head]));
#pragma unroll
      for (int o = 1; o < 64; o <<= 1) { const float t = shup(v, o, lane); if (lane >= o) v += t; }
      if (lane == 63) wt[wave] = v;
      LDS_WAIT(); __syncthreads();
      if (wave & 1) v += wt[wave - 1];
      dt_l[tid] = dtv; acs_l[tid] = v; ACS[(size_t)(m0 + l) * 8 + head] = v; DTV[(size_t)(m0 + l) * 8 + head] = dtv;
      if (l == 127) CHDEC[c * 8 + head] = expf(v); }
    LDS_WAIT(); __syncthreads();
#pragma unroll 1
    for (int it = tid; it < 1536; it += NTHREADS) {
        const int cg = it % 48, rg = it / 48, l0 = 4 * rg;
        const int isX = cg >= 16, n0 = isX ? (cg - 16) * 8 : cg * 8, col0 = isX ? CX + g * 256 + n0 : CBM + g * 128 + n0;
        float o[4][8];
        conv8x4(PROJ, m0, c, l0, col0, conv_w + (col0 - CX), conv_b + (col0 - CX), o);
        if (!isX) {
#pragma unroll
            for (int r = 0; r < 4; ++r)
#pragma unroll
                for (int e = 0; e < 8; ++e) *(LAS unsigned short*)(BmT + (n0 + e) * SD_ROW + (l0 + r) * 2) = (unsigned short)f2bf(o[r][e]);
        } else { const int r4 = n0 >> 6, p0 = n0 & 63; const float aend = acs_l[r4 * 128 + 127];
#pragma unroll
            for (int r = 0; r < 4; ++r) { const int l = l0 + r; const float sc = dt_l[r4 * 128 + l] * __builtin_amdgcn_exp2f((aend - acs_l[r4 * 128 + l]) * LOG2E);
#pragma unroll
                for (int e = 0; e < 8; ++e) *(LAS unsigned short*)(XW + (r4 * 64 + p0 + e) * SD_ROW + l * 2) = (unsigned short)f2bf(o[r][e] * sc); } }
    }
    LDS_WAIT(); __syncthreads();
    asm volatile("" : "+v"(tid)); lane = tid & 63; q = lane & 31; hh = lane >> 5;
    { const int r4 = wave >> 1, nt0 = (wave & 1) * 2, head = 4 * g + r4;
      f32x16 St[2][2] = {{{}, {}}, {{}, {}}};
#pragma unroll
      for (int ks = 0; ks < 8; ++ks) { bf16x8_t af[2], bfr[2];
#pragma unroll
          for (int pt = 0; pt < 2; ++pt) af[pt] = *(const LAS bf16x8_t*)(XW + (r4 * 64 + 32 * pt + q) * SD_ROW + (16 * ks + 8 * hh) * 2);
#pragma unroll
          for (int nn = 0; nn < 2; ++nn) bfr[nn] = *(const LAS bf16x8_t*)(BmT + (32 * (nt0 + nn) + q) * SD_ROW + (16 * ks + 8 * hh) * 2);
#pragma unroll
          for (int pt = 0; pt < 2; ++pt)
#pragma unroll
              for (int nn = 0; nn < 2; ++nn) St[pt][nn] = __builtin_amdgcn_mfma_f32_32x32x16_bf16(af[pt], bfr[nn], St[pt][nn], 0, 0, 0); }
      GAS float* sp = STATES + ((size_t)c * 8 + head) * 8192 + 32 * nt0 + q;
#pragma unroll
      for (int pt = 0; pt < 2; ++pt)
#pragma unroll
          for (int nn = 0; nn < 2; ++nn)
#pragma unroll
              for (int e = 0; e < 16; ++e) sp[(32 * pt + crow32(e, hh)) * 128 + 32 * nn] = St[pt][nn][e]; }
}
__device__ __forceinline__ void ssd_scan(Frame& F, int L) {
    const GAS float* STATES = (const GAS float*)FB(BO_STATES); const GAS float* CHDEC = (const GAS float*)FWS(WS_CHDEC) + F.b * 128; GAS bf16* PREV = (GAS bf16*)FB(BO_PREV);
    for (int idx = F.li * NTHREADS + F.tid; idx < 8 * 64 * 32; idx += GRP * NTHREADS) {
        const int n4 = idx & 31, p = (idx >> 5) & 63, head = idx >> 11;
        f32x4 s[16]; float dec[16];
#pragma unroll
        for (int c = 0; c < 16; ++c) { const size_t o = ((size_t)c * 8 + head) * 8192 + p * 128 + 4 * n4; s[c] = *(const GAS f32x4*)(STATES + o); dec[c] = CHDEC[c * 8 + head]; }
        f32x4 h = {0.f, 0.f, 0.f, 0.f};
#pragma unroll
        for (int c = 0; c < 16; ++c) { const size_t o = ((size_t)c * 8 + head) * 8192 + p * 128 + 4 * n4;
            v2u w; w.x = pkbf(h.x, h.y); w.y = pkbf(h.z, h.w); *(GAS v2u*)(PREV + o) = w;
            h = h * dec[c] + s[c]; }
    }
}
constexpr int S3_CM = 0, S3_BM = 34816, S3_HIMG = 64 * SD_XT + 64 * SD_ROW, S3_Z = 69632, S3_DT = S3_Z + 128 * SD_ROW, S3_ACS = S3_DT + 2048, S3_RSS = S3_ACS + 2048, S3_END = S3_RSS + 2048;
static_assert(2 * S3_HIMG <= S3_Z && S3_END <= RING_BYTES && 128 * 528 <= S3_DT, "SSD part 3 LDS");
__device__ __forceinline__ void ssd_out(Frame& F, int L) {
    GAS bf16* PROJ = (GAS bf16*)FB(BO_PROJ); const GAS bf16* PREV = (const GAS bf16*)FB(BO_PREV);
    const GAS float* conv_w = FIN(I_CONVW) + (size_t)L * 4 * 1024; const GAS float* conv_b = FIN(I_CONVB) + L * 1024;
    const GAS float* d_skip = FIN(I_DSKIP) + L * 8; const GAS float* ssm_g = FIN(I_SSMG) + L * 512;
    const GAS float* ACS = (const GAS float*)FWS(WS_ACS) + (size_t)F.b * SEQ * 8; const GAS float* DTV = (const GAS float*)FWS(WS_DTV) + (size_t)F.b * SEQ * 8;
    LAS unsigned char* Cm = F.lds + S3_CM; LAS unsigned char* Bm = F.lds + S3_BM; LAS unsigned char* Zt = F.lds + S3_Z;
    LAS float* dt_l = (LAS float*)(F.lds + S3_DT); LAS float* acs_l = (LAS float*)(F.lds + S3_ACS); LAS float* rss = (LAS float*)(F.lds + S3_RSS);
    const int wave = F.wave, unit = F.li, c = unit >> 1, g = unit & 1, m0 = c * 128;
    int tid = F.tid; asm volatile("" : "+v"(tid));
    int lane = tid & 63, q = lane & 31, hh = lane >> 5;
    __syncthreads();
    { const int r = tid >> 7, l = tid & 127; dt_l[tid] = DTV[(size_t)(m0 + l) * 8 + 4 * g + r]; acs_l[tid] = ACS[(size_t)(m0 + l) * 8 + 4 * g + r]; }
#pragma unroll 1
    for (int it = tid; it < 1024; it += NTHREADS) {
        const int cg = it & 31, rg = it >> 5, isC = cg >> 4, n0 = (cg & 15) * 8, col0 = (isC ? CCM : CBM) + g * 128 + n0, l0 = 4 * rg;
        float o[4][8];
        conv8x4(PROJ, m0, c, l0, col0, conv_w + (col0 - CX), conv_b + (col0 - CX), o);
#pragma unroll
        for (int r = 0; r < 4; ++r) { v4u pk; pk.x = pkbf(o[r][0], o[r][1]); pk.y = pkbf(o[r][2], o[r][3]); pk.z = pkbf(o[r][4], o[r][5]); pk.w = pkbf(o[r][6], o[r][7]);
            *(LAS v4u*)((isC ? Cm : Bm) + (l0 + r) * SD_ROW + n0 * 2) = pk; }
    }
    LDS_WAIT(); __syncthreads();
    asm volatile("" : "+v"(tid)); lane = tid & 63; q = lane & 31; hh = lane >> 5;
    const int j = (wave < 4) ? (wave & 3) : 3 - (wave & 3), h2 = wave >> 2;
    f32x16 cbT[4]; bf16x8_t cf[8];
#pragma unroll
    for (int ks = 0; ks < 8; ++ks) cf[ks] = *(const LAS bf16x8_t*)(Cm + (32 * j + q) * SD_ROW + (16 * ks + 8 * hh) * 2);
#pragma unroll
    for (int i = 0; i < 4; ++i) { f32x16 acc = {};
        if (i <= j) {
#pragma unroll
            for (int ks = 0; ks < 8; ++ks) { const bf16x8_t bfr = *(const LAS bf16x8_t*)(Bm + (32 * i + q) * SD_ROW + (16 * ks + 8 * hh) * 2);
                acc = __builtin_amdgcn_mfma_f32_32x32x16_bf16(bfr, cf[ks], acc, 0, 0, 0); } }
        cbT[i] = acc; }
    unsigned vk[2][16];
    float sspart[2];
#pragma unroll
    for (int hp = 0; hp < 2; ++hp) {
        __syncthreads();
        asm volatile("" : "+v"(tid)); lane = tid & 63; q = lane & 31; hh = lane >> 5;
        {
          v4u pw[4], zw[4];
#pragma unroll
          for (int k = 0; k < 4; ++k) { const int ch = tid + NTHREADS * k;
              { const int hd = ch >> 10, rem = ch & 1023, p = rem >> 4, n8 = rem & 15; pw[k] = *(const GAS v4u*)(PREV + ((size_t)c * 8 + 4 * g + 2 * hp + hd) * 8192 + p * 128 + n8 * 8); }
              { const int l = ch >> 4, c8 = ch & 15; zw[k] = *(const GAS v4u*)(PROJ + (size_t)(m0 + l) * PP + CZ + (4 * g + 2 * hp) * 64 + c8 * 8); } }
#pragma unroll 1
          for (int it = tid; it < 1024; it += NTHREADS) {
              const int cg = it & 31, rg = it >> 5, hx = cg >> 4, p0 = (cg & 15) * 4, r = 2 * hp + hx, col0 = CX + (4 * g + r) * 64 + p0, l0 = 4 * rg;
              float o[4][4];
              conv4x4(PROJ, m0, c, l0, col0, conv_w + (col0 - CX), conv_b + (col0 - CX), o);
              LAS unsigned char* T1 = F.lds + hx * S3_HIMG;
#pragma unroll
              for (int rr = 0; rr < 4; ++rr) { const int l = l0 + rr; const float dtv = dt_l[r * 128 + l];
#pragma unroll
                  for (int e = 0; e < 4; ++e) *(LAS unsigned short*)(T1 + (p0 + e) * SD_XT + l * 2) = (unsigned short)f2bf(o[rr][e] * dtv); } }
#pragma unroll
          for (int k = 0; k < 4; ++k) { const int ch = tid + NTHREADS * k;
              { const int hd = ch >> 10, rem = ch & 1023, p = rem >> 4, n8 = rem & 15; *(LAS v4u*)(F.lds + hd * S3_HIMG + 64 * SD_XT + p * SD_ROW + n8 * 16) = pw[k]; }
              { const int l = ch >> 4, c8 = ch & 15; *(LAS v4u*)(Zt + l * SD_ROW + c8 * 16) = zw[k]; } } }
        LDS_WAIT(); __syncthreads();
        asm volatile("" : "+v"(tid)); lane = tid & 63; q = lane & 31; hh = lane >> 5;
        const int r = 2 * hp + h2, head = 4 * g + r;
        const LAS unsigned char* T1 = F.lds + h2 * S3_HIMG; const LAS unsigned char* P1 = T1 + 64 * SD_XT;
        f32x16 O[2] = {{}, {}};
#pragma unroll
        for (int ks = 0; ks < 8; ++ks)
#pragma unroll
            for (int pt = 0; pt < 2; ++pt) { const bf16x8_t af = *(const LAS bf16x8_t*)(P1 + (32 * pt + q) * SD_ROW + (16 * ks + 8 * hh) * 2);
                O[pt] = __builtin_amdgcn_mfma_f32_32x32x16_bf16(af, cf[ks], O[pt], 0, 0, 0); }
        const float acl = acs_l[r * 128 + 32 * j + q], diag = d_skip[head] * __builtin_amdgcn_rcpf(dt_l[r * 128 + 32 * j + q]);
        { const float ea = __builtin_amdgcn_exp2f(acl * LOG2E);
#pragma unroll
          for (int pt = 0; pt < 2; ++pt)
#pragma unroll
              for (int e = 0; e < 16; ++e) O[pt][e] *= ea; }
#pragma unroll
        for (int i = 0; i < 4; ++i) { if (i <= j) {
            int qq = q; asm volatile("" : "+v"(qq));
            float xv[16];
#pragma unroll
            for (int e = 0; e < 16; ++e) { const int cr = crow32(e, hh); const float dec = __builtin_amdgcn_exp2f((acl - acs_l[r * 128 + 32 * i + cr]) * LOG2E);
                const bool ok = (i < j) || (cr <= qq);
                float v = ok ? cbT[i][e] * dec : 0.f;
                if (i == j && cr == qq) v += diag;
                xv[e] = v; }
#pragma unroll
            for (int s2 = 0; s2 < 2; ++s2) { v4u w; w.x = pkbf(xv[8 * s2 + 0], xv[8 * s2 + 1]); w.y = pkbf(xv[8 * s2 + 2], xv[8 * s2 + 3]); w.z = pkbf(xv[8 * s2 + 4], xv[8 * s2 + 5]); w.w = pkbf(xv[8 * s2 + 6], xv[8 * s2 + 7]);
                const bf16x8_t xf = __builtin_bit_cast(bf16x8_t, w);
#pragma unroll
                for (int pt = 0; pt < 2; ++pt) { const LAS unsigned char* ab = T1 + (32 * pt + q) * SD_XT + (32 * i + 16 * s2 + 4 * hh) * 2;
                    const v2u lo = *(const LAS v2u*)ab, hi2 = *(const LAS v2u*)(ab + 16); v4u aw; aw.x = lo.x; aw.y = lo.y; aw.z = hi2.x; aw.w = hi2.y;
                    O[pt] = __builtin_amdgcn_mfma_f32_32x32x16_bf16(__builtin_bit_cast(bf16x8_t, aw), xf, O[pt], 0, 0, 0); } } } }
        float ss = 0.f;
#pragma unroll
        for (int pt = 0; pt < 2; ++pt)
#pragma unroll
            for (int g4 = 0; g4 < 4; ++g4) { const int p = 32 * pt + 8 * g4 + 4 * hh;
                const v2u zw = *(const LAS v2u*)(Zt + (32 * j + q) * SD_ROW + (64 * h2 + p) * 2);
                const float u0 = O[pt][4 * g4] * silu_fast(bflo(zw.x)), u1 = O[pt][4 * g4 + 1] * silu_fast(bfhi(zw.x)), u2 = O[pt][4 * g4 + 2] * silu_fast(bflo(zw.y)), u3 = O[pt][4 * g4 + 3] * silu_fast(bfhi(zw.y));
                ss += (u0 * u0 + u1 * u1) + (u2 * u2 + u3 * u3);
                vk[hp][pt * 8 + g4 * 2] = pkbf(u0, u1); vk[hp][pt * 8 + g4 * 2 + 1] = pkbf(u2, u3); }
        ss += shx(ss, 32, lane);
        sspart[hp] = ss;
        if (hh == 0) rss[r * 128 + 32 * j + q] = ss;
    }
    LDS_WAIT(); __syncthreads();
    asm volatile("" : "+v"(tid)); lane = tid & 63; q = lane & 31; hh = lane >> 5;
    { const int l = 32 * j + q; const float tot = (rss[l] + rss[128 + l]) + (rss[256 + l] + rss[384 + l]);
      const float rn = __builtin_amdgcn_rsqf(tot * (1.0f / 256.0f) + EPS);
      LAS unsigned char* Ot = F.lds;
#pragma unroll
      for (int hp = 0; hp < 2; ++hp) { const int r = 2 * hp + h2, head = 4 * g + r;
#pragma unroll
          for (int pt = 0; pt < 2; ++pt)
#pragma unroll
              for (int g4 = 0; g4 < 4; ++g4) { const int p = 32 * pt + 8 * g4 + 4 * hh;
                  const f32x4 ng = *(const GAS f32x4*)(ssm_g + head * 64 + p);
                  const unsigned w0 = vk[hp][pt * 8 + g4 * 2], w1 = vk[hp][pt * 8 + g4 * 2 + 1];
                  v2u w; w.x = pkbf(bflo(w0) * rn * ng.x, bfhi(w0) * rn * ng.y); w.y = pkbf(bflo(w1) * rn * ng.z, bfhi(w1) * rn * ng.w);
                  *(LAS v2u*)(Ot + l * 528 + (r * 64 + p) * 2) = w; } } }
    (void)sspart;
    LDS_WAIT(); __syncthreads();
#pragma unroll
    for (int k = 0; k < 8; ++k) { const int ch = tid + NTHREADS * k, l = ch >> 5, c8 = ch & 31;
        const v4u w = *(const LAS v4u*)(F.lds + l * 528 + c8 * 16);
        *(GAS v4u*)(PROJ + (size_t)(m0 + l) * PP + CZ + g * 256 + c8 * 8) = w; }
}

__device__ __forceinline__ void ph_inproj(Frame& F, int L) {
    LAS float* rstd_tab = (LAS float*)(F.lds + RSTD_OFF);
    int li_ = F.li; asm volatile("" : "+s"(li_)); pg8::GroupOrder S; S.init(NPROJ, li_);
    rstd_prepass(F, S, rstd_tab);
    pg8::Gemm g{(const GAS bf16*)FWS(WS_XB) + (size_t)F.b * SEQ * D, (const GAS bf16*)FWS(WS_WIN) + (size_t)L * NPROJ * D, SEQ, NPROJ, D, D};
    pg8::EpiProj E{(GAS bf16*)FB(BO_PROJ), (GAS float*)FWS(WS_DTRAW) + (size_t)F.b * SEQ * 8, (const LAS float*)rstd_tab};
    pg8::gemm_phase<pg8::EpiProj, pg8::GroupOrder, true, true>(F.lds + RING_OFF, g, S, E);
}
__device__ __forceinline__ void ph_outproj(Frame& F, int L) {
    int li_ = F.li; asm volatile("" : "+s"(li_)); pg8::GroupOrder S; S.init(D, li_);
    pg8::Gemm g{(const GAS bf16*)FB(BO_PROJ), (const GAS bf16*)FWS(WS_WOUT) + (size_t)L * D * D, SEQ, D, D, PP};
    pg8::EpiRes<false> E{(GAS bf16*)FWS(WS_XB) + (size_t)F.b * SEQ * D, (GAS float*)FWS(WS_SSQ) + (size_t)F.b * SEQ * 16, nullptr};
    pg8::gemm_phase<pg8::EpiRes<false>, pg8::GroupOrder, false, true>(F.lds + RING_OFF, g, S, E);
}
__device__ __forceinline__ void ph_up(Frame& F, int L) {
    LAS float* rstd_tab = (LAS float*)(F.lds + RSTD_OFF);
    int li_ = F.li; asm volatile("" : "+s"(li_)); pg8::GroupOrder S; S.init(FF, li_);
    rstd_prepass(F, S, rstd_tab);
    pg8::Gemm g{(const GAS bf16*)FWS(WS_XB) + (size_t)F.b * SEQ * D, (const GAS bf16*)FWS(WS_WUP) + (size_t)L * FF * D, SEQ, FF, D, D};
    pg8::EpiUp E{(GAS bf16*)FB(BO_HID), FF, (const LAS float*)rstd_tab};
    pg8::gemm_phase<pg8::EpiUp, pg8::GroupOrder, true, true>(F.lds + RING_OFF, g, S, E);
}
__device__ __forceinline__ void ph_down(Frame& F, int L) {
    int li_ = F.li; asm volatile("" : "+s"(li_)); pg8::GroupOrder S; S.init(D, li_);
    pg8::Gemm g{(const GAS bf16*)FB(BO_HID), (const GAS bf16*)FWS(WS_WDOWN) + (size_t)L * D * FF, SEQ, D, FF, FF};
    GAS bf16* XBb = (GAS bf16*)FWS(WS_XB) + (size_t)F.b * SEQ * D; GAS float* SSQb = (GAS float*)FWS(WS_SSQ) + (size_t)F.b * SEQ * 16;
    if (L == DEPTH - 1) { pg8::EpiRes<true> E{XBb, SSQb, (GAS float*)ptr_at(F, I_OUT) + (size_t)F.b * SEQ * D};
        pg8::gemm_phase<pg8::EpiRes<true>, pg8::GroupOrder, false, true>(F.lds + RING_OFF, g, S, E); }
    else { pg8::EpiRes<false> E{XBb, SSQb, nullptr};
        pg8::gemm_phase<pg8::EpiRes<false>, pg8::GroupOrder, false, true>(F.lds + RING_OFF, g, S, E); }
}

#ifndef PROBE_REP
#define PROBE_REP 0
#endif
struct Args { const float* in[17]; float* out; unsigned char* ws; int pad0, pad1; };
__global__ void __launch_bounds__(NTHREADS, 2) fwd(Args args) {
    extern __shared__ __attribute__((aligned(16))) unsigned char lds[];
    Frame F;
    F.lds = (LAS unsigned char*)lds;
    F.tid = threadIdx.x; F.lane = F.tid & 63; F.wave = __builtin_amdgcn_readfirstlane(F.tid >> 6); F.bid = blockIdx.x; F.G = gridDim.x; F.b = F.bid & 7; F.li = F.bid >> 3;
    for (int u = F.tid; u < (LDS_BYTES - LDSCTL_OFF) / 4; u += NTHREADS) ((LAS unsigned*)(F.lds + LDSCTL_OFF))[u] = 0u;
    __syncthreads();
    if (F.tid < I_NPTR) { const unsigned long long p = F.tid < 17 ? (unsigned long long)args.in[F.tid < 17 ? F.tid : 0] : (F.tid == I_OUT ? (unsigned long long)args.out : (unsigned long long)args.ws);
        LAS unsigned* t = (LAS unsigned*)(F.lds + PTR_OFF) + 2 * F.tid; t[0] = (unsigned)p; t[1] = (unsigned)(p >> 32); }
    LDS_WAIT(); __syncthreads();
    if (F.G != GRID) return;
#define GBAR_OBJ() XcdBarrier{(unsigned*)(unsigned char*)FWS(WS_CTL) + CW_BAR, xb_xcc_id(), (unsigned)GRID, (volatile LAS unsigned*)(F.lds + MISC_OFF) + 8}
#define GRP_OBJ()  XcdBarrier{(unsigned*)(unsigned char*)FWS(WS_CTL) + CW_GRP + (blockIdx.x & 7) * GRP_BAR_STRIDE, xb_xcc_id(), (unsigned)GRP, (volatile LAS unsigned*)(F.lds + MISC_OFF) + 12}
    (void)xcd_barrier_post((unsigned*)(unsigned char*)FWS(WS_CTL) + CW_BAR, (volatile LAS unsigned*)(F.lds + MISC_OFF) + 8, GRID);
    (void)xcd_barrier_post((unsigned*)(unsigned char*)FWS(WS_CTL) + CW_GRP + (blockIdx.x & 7) * GRP_BAR_STRIDE, (volatile LAS unsigned*)(F.lds + MISC_OFF) + 12, GRP);
#define RELAUNDER() do { int t_ = threadIdx.x; asm volatile("" : "+v"(t_)); F.tid = t_; F.lane = t_ & 63; F.wave = __builtin_amdgcn_readfirstlane(t_ >> 6); \
    int b_ = blockIdx.x; asm volatile("" : "+s"(b_)); F.bid = b_; F.b = b_ & 7; F.li = b_ >> 3; } while (0)
#define GRP_BAR() do { const XcdBarrier gb_ = GRP_OBJ(); xcd_barrier(gb_); } while (0)
#define GRID_BAR() do { const XcdBarrier gb_ = GBAR_OBJ(); xcd_barrier(gb_); } while (0)

    p0_prologue(F);
    if (PROBE_REP == 1) { GRID_BAR(); RELAUNDER(); p0_prologue(F); }
    GRID_BAR();
    for (int L = 0; L < DEPTH; ++L) {
        RELAUNDER(); ph_inproj(F, L); if (PROBE_REP == 2) { GRP_BAR(); RELAUNDER(); ph_inproj(F, L); } GRP_BAR();
        RELAUNDER(); attn_fast(F, L); ssd_states(F, L); GRP_BAR();
        RELAUNDER(); ssd_scan(F, L); GRP_BAR();
        RELAUNDER(); ssd_out(F, L); GRP_BAR();
        RELAUNDER(); ph_outproj(F, L); GRP_BAR();
        RELAUNDER(); ph_up(F, L); if (PROBE_REP == 5) { GRP_BAR(); RELAUNDER(); ph_up(F, L); } GRP_BAR();
        RELAUNDER(); ph_down(F, L); if (L + 1 < DEPTH) GRP_BAR();
    }
}

extern "C" void kernel_launch(void* const* d_in, const int* in_sizes, int n_in, void* d_out, int out_size, void* d_ws, size_t ws_size, hipStream_t stream) {
    static int grid = 0;
    if (grid == 0) {
        if (n_in != 17 || in_sizes[0] != M * D || out_size != M * D || ws_size < WS_END) { fprintf(stderr, "kernel_launch: unexpected shapes (n_in %d, in0 %d, out %d, ws %zu)\n", n_in, n_in > 0 ? in_sizes[0] : -1, out_size, ws_size); grid = -1; return; }
        int dev = 0, cus = 0, per_cu = 0;
        if (hipGetDevice(&dev) != hipSuccess || hipDeviceGetAttribute(&cus, hipDeviceAttributeMultiprocessorCount, dev) != hipSuccess) { grid = -1; return; }
        if (hipFuncSetAttribute((const void*)fwd, hipFuncAttributeMaxDynamicSharedMemorySize, LDS_BYTES) != hipSuccess) { fprintf(stderr, "kernel_launch: hipFuncSetAttribute failed\n"); grid = -1; return; }
        if (hipOccupancyMaxActiveBlocksPerMultiprocessor(&per_cu, (const void*)fwd, NTHREADS, LDS_BYTES) != hipSuccess || per_cu < 1) { fprintf(stderr, "kernel_launch: occupancy query says %d\n", per_cu); per_cu = 0; }
        (void)hipGetLastError();
        if (cus * per_cu < GRID) { fprintf(stderr, "kernel_launch: this kernel needs %d co-resident workgroups (one per CU of a 256-CU device); the device admits %d x %d; nothing launched\n", GRID, cus, per_cu); grid = -1; return; }
        grid = GRID;
    }
    if (grid < 0) return;
    (void)hipMemsetAsync((char*)d_ws + WS_CTL, 0, CTL_ZERO_BYTES, stream);
    Args a{};
    for (int i = 0; i < 17; ++i) a.in[i] = (const float*)d_in[i];
    a.out = (float*)d_out; a.ws = (unsigned char*)d_ws;
    void* kargs[] = {&a};
    hipError_t e = hipLaunchCooperativeKernel((const void*)fwd, dim3(grid), dim3(NTHREADS), kargs, LDS_BYTES, stream);
    if (e != hipSuccess) fprintf(stderr, "kernel_launch: cooperative launch failed: %s (grid %d)\n", hipGetErrorString(e), grid);
}
```

```cpp
#include <hip/hip_runtime.h>
#include <cstdio>
#include <cstdint>
#define PROBE_REP 0


namespace pg8 {
#define PG8_LAS __attribute__((address_space(3)))
#define PG8_GAS __attribute__((address_space(1)))
typedef unsigned short bf16_t;
typedef short bf16x8 __attribute__((ext_vector_type(8)));
typedef float f32x4 __attribute__((ext_vector_type(4)));
typedef unsigned u32x4 __attribute__((ext_vector_type(4)));
constexpr int BM = 256, BK = 64, HALF = 128, HTB = HALF * BK * 2  , STAGE_BYTES = 8 * HTB, NXCD = 8, WGM = 8;

__host__ __device__ __forceinline__ int lds_byte(int r, int c) { const int st = (r >> 4) * 2 + (c >> 5), rr = r & 15, cc = c & 31, ob = rr * 64 + cc * 2; return st * 1024 + (ob ^ (((ob >> 9) & 1) << 5)); }
__host__ __device__ __forceinline__ void stage_rc(int b, int& R, int& C) { const int st = b / 1024, sb = b % 1024, swz = sb ^ (((sb >> 9) & 1) << 5); R = (st >> 1) * 16 + swz / 64; C = (st & 1) * 32 + (swz % 64) / 2; }
__host__ __device__ __forceinline__ int perm32(int rho) { const int n = rho >> 4, i = rho & 15; return 8 * (i >> 2) + 4 * n + (i & 3); }

struct Unit { int pm, pn; };
struct Gemm { const PG8_GAS bf16_t* A; const PG8_GAS bf16_t* Bt; int M, N, K, lda; };

struct StaticOrder {
    int nM, nN, nwg, G, c;
    __host__ __device__ void init(int M, int N, int G_, int c_) { nM = M / BM; nN = N / BM; nwg = nM * nN; G = G_; c = c_; }
    __host__ __device__ bool next(int i, Unit& u) const {
        const long L = (long)i * G + c; if (L >= nwg) return false;
        int wgid = (int)L; { const int q = nwg / NXCD, r = nwg % NXCD, xcd = wgid % NXCD, off = wgid / NXCD; wgid = (xcd < r ? xcd * (q + 1) : r * (q + 1) + (xcd - r) * q) + off; }
        const int nig = WGM * nN, gid = wgid / nig, fm = gid * WGM, gsz = (nM - fm) < WGM ? (nM - fm) : WGM;
        u.pm = fm + ((wgid % nig) % gsz); u.pn = (wgid % nig) / gsz; return true;
    }
    __device__ __forceinline__ void a_ready(const Unit&) const {}
    __device__ __forceinline__ void done(const Unit&) const {}
};

struct GroupOrder {
    int nN, li;
    __host__ __device__ void init(int N, int li_) { nN = N / BM; li = li_; }
    __host__ __device__ bool next(int i, Unit& u) const { const int T = i * 32 + li; if (T >= 8 * nN) return false; u.pm = T & 7; u.pn = T >> 3; return true; }
    __device__ __forceinline__ void a_ready(const Unit&) const {}
    __device__ __forceinline__ void done(const Unit&) const {}
};

__device__ __forceinline__ float shx(float v, int k, int lane) { return __builtin_bit_cast(float, __builtin_amdgcn_ds_bpermute((lane ^ k) << 2, __builtin_bit_cast(int, v))); }
typedef float f32x2_t __attribute__((ext_vector_type(2))); typedef __bf16 bf16x2_t __attribute__((ext_vector_type(2)));
__device__ __forceinline__ unsigned cvt_pk_bf16(float lo, float hi) { f32x2_t v = {lo, hi}; bf16x2_t b = __builtin_convertvector(v, bf16x2_t); return __builtin_bit_cast(unsigned, b); }

constexpr int PROJ_PITCH = 2304, DT_TILE = 9;
struct EpiProj {
    static constexpr bool PERM = true, AFTER_DRAIN = false, ACC_INIT = false, PRE_HOOK = true;
    PG8_GAS bf16_t* O; PG8_GAS float* dtraw; PG8_LAS float* rstd; f32x4 pa, pb;
    __device__ __forceinline__ void pre(int tid) const {
        float s = (pa[0] + pa[1]) + (pa[2] + pa[3]) + (pb[0] + pb[1]) + (pb[2] + pb[3]);
        s += shx(s, 1, tid & 63);
        if ((tid & 1) == 0) rstd[tid >> 1] = 1.0f / sqrtf(s * (1.0f / 1024.0f) + 1e-6f);
    }
    __device__ __forceinline__ void operator()(const f32x4 (&acc)[2][2][4][2], const Unit& u, int ui, int wr, int wc, int fr, int fq) const {
        int rt0 = wr * 64 + fr; asm volatile("" : "+v"(rt0));
        if (u.pn == DT_TILE) {
            if (wc == 0 && fq == 0) {
#pragma unroll
                for (int ai = 0; ai < 2; ++ai)
#pragma unroll
                    for (int m = 0; m < 4; ++m) { const int rt = ai * HALF + rt0 + m * 16; const float rs = rstd[rt]; PG8_GAS float* p = dtraw + (size_t)(u.pm * BM + rt) * 8;
                        *(PG8_GAS f32x4*)p = acc[ai][0][m][0] * rs; *(PG8_GAS f32x4*)(p + 4) = acc[ai][0][m][1] * rs; }
            }
            return;
        }
        const int col0 = u.pn * BM + wc * 32 + 8 * fq;
#pragma unroll
        for (int ai = 0; ai < 2; ++ai)
#pragma unroll
            for (int m = 0; m < 4; ++m) { const int rt = ai * HALF + rt0 + m * 16; const float rs = rstd[rt]; PG8_GAS bf16_t* rowp = O + (size_t)(u.pm * BM + rt) * PROJ_PITCH + col0;
#pragma unroll
                for (int bj = 0; bj < 2; ++bj) { const f32x4 v0 = acc[ai][bj][m][0] * rs, v1 = acc[ai][bj][m][1] * rs;
                    u32x4 w; w.x = cvt_pk_bf16(v0[0], v0[1]); w.y = cvt_pk_bf16(v0[2], v0[3]); w.z = cvt_pk_bf16(v1[0], v1[1]); w.w = cvt_pk_bf16(v1[2], v1[3]);
                    *(PG8_GAS u32x4*)(rowp + bj * HALF) = w; } }
    }
};
struct EpiUp {
    static constexpr bool PERM = true, AFTER_DRAIN = false, ACC_INIT = false, PRE_HOOK = true;
    PG8_GAS bf16_t* O; int ldc; PG8_LAS float* rstd; f32x4 pa, pb;
    __device__ __forceinline__ void pre(int tid) const {
        float s = (pa[0] + pa[1]) + (pa[2] + pa[3]) + (pb[0] + pb[1]) + (pb[2] + pb[3]);
        s += shx(s, 1, tid & 63);
        if ((tid & 1) == 0) rstd[tid >> 1] = 1.0f / sqrtf(s * (1.0f / 1024.0f) + 1e-6f);
    }
    __device__ __forceinline__ void operator()(const f32x4 (&acc)[2][2][4][2], const Unit& u, int ui, int wr, int wc, int fr, int fq) const {
        int rt0 = wr * 64 + fr; asm volatile("" : "+v"(rt0)); const int col0 = u.pn * BM + wc * 32 + 8 * fq;
#pragma unroll
        for (int ai = 0; ai < 2; ++ai)
#pragma unroll
            for (int m = 0; m < 4; ++m) { const int rt = ai * HALF + rt0 + m * 16; const float rs = rstd[rt]; PG8_GAS bf16_t* rowp = O + (size_t)(u.pm * BM + rt) * ldc + col0;
#pragma unroll
                for (int bj = 0; bj < 2; ++bj) { f32x4 v0 = acc[ai][bj][m][0] * rs, v1 = acc[ai][bj][m][1] * rs;
#pragma unroll
                    for (int e = 0; e < 4; ++e) { const float a = fmaxf(v0[e], 0.f), b = fmaxf(v1[e], 0.f); v0[e] = a * a; v1[e] = b * b; }
                    u32x4 w; w.x = cvt_pk_bf16(v0[0], v0[1]); w.y = cvt_pk_bf16(v0[2], v0[3]); w.z = cvt_pk_bf16(v1[0], v1[1]); w.w = cvt_pk_bf16(v1[2], v1[3]);
                    *(PG8_GAS u32x4*)(rowp + bj * HALF) = w; } }
    }
};
template <bool FINAL> struct EpiRes {
    static constexpr bool PERM = true, AFTER_DRAIN = false, ACC_INIT = true, PRE_HOOK = false;
    PG8_GAS bf16_t* xb; PG8_GAS float* ssq; PG8_GAS float* out; PG8_GAS bf16_t* xdst;
    __device__ __forceinline__ void init(f32x4 (&acc)[2][2][4][2], const Unit& u, int wr, int wc, int fr, int fq) const {
        const int rt0 = wr * 64 + fr, col0 = u.pn * BM + wc * 32 + 8 * fq;
#pragma unroll
        for (int ai = 0; ai < 2; ++ai)
#pragma unroll
            for (int m = 0; m < 4; ++m) { const int row = u.pm * BM + ai * HALF + rt0 + m * 16; const size_t off = (size_t)row * 1024 + col0;
#pragma unroll
                for (int bj = 0; bj < 2; ++bj) { const u32x4 rw = *(const PG8_GAS u32x4*)(xb + off + bj * HALF);
                    acc[ai][bj][m][0] = (f32x4){__uint_as_float(rw.x << 16), __uint_as_float(rw.x & 0xffff0000u), __uint_as_float(rw.y << 16), __uint_as_float(rw.y & 0xffff0000u)};
                    acc[ai][bj][m][1] = (f32x4){__uint_as_float(rw.z << 16), __uint_as_float(rw.z & 0xffff0000u), __uint_as_float(rw.w << 16), __uint_as_float(rw.w & 0xffff0000u)}; } }
    }
    __device__ __forceinline__ void operator()(const f32x4 (&acc)[2][2][4][2], const Unit& u, int ui, int wr, int wc, int fr, int fq) const {
        int rt0 = wr * 64 + fr; asm volatile("" : "+v"(rt0)); const int col0 = u.pn * BM + wc * 32 + 8 * fq;
#pragma unroll
        for (int ai = 0; ai < 2; ++ai)
#pragma unroll
            for (int m = 0; m < 4; ++m) { const int row = u.pm * BM + ai * HALF + rt0 + m * 16; const size_t off = (size_t)row * 1024 + col0; float s = 0.f;
#pragma unroll
                for (int bj = 0; bj < 2; ++bj) { const f32x4 v0 = acc[ai][bj][m][0], v1 = acc[ai][bj][m][1];
                    if (FINAL) { *(PG8_GAS f32x4*)(out + off + bj * HALF) = v0; *(PG8_GAS f32x4*)(out + off + bj * HALF + 4) = v1; }
                    else { u32x4 w; w.x = cvt_pk_bf16(v0[0], v0[1]); w.y = cvt_pk_bf16(v0[2], v0[3]); w.z = cvt_pk_bf16(v1[0], v1[1]); w.w = cvt_pk_bf16(v1[2], v1[3]);
                        *(PG8_GAS u32x4*)(xdst + off + bj * HALF) = w;
                        s += (v0[0] * v0[0] + v0[1] * v0[1]) + (v0[2] * v0[2] + v0[3] * v0[3]) + (v1[0] * v1[0] + v1[1] * v1[1]) + (v1[2] * v1[2] + v1[3] * v1[3]); } }
                if (!FINAL) { const int ln = fq * 16 + fr; s += shx(s, 16, ln); s += shx(s, 32, ln);
                    if (fq == 0) ssq[(size_t)row * 16 + u.pn * 4 + wc] = s; } }
    }
};

template <class Epi, class Sched, bool ALIGN_EPI = false, bool SP2 = false>
__device__ __forceinline__ void gemm_phase(PG8_LAS unsigned char* lds, const Gemm g, const Sched& S, const Epi& E) {
    int tid_ = threadIdx.x; asm volatile("" : "+v"(tid_));
    const int tid = tid_, wid = __builtin_amdgcn_readfirstlane(tid >> 6), lane = tid & 63, wr = wid >> 2, wc = wid & 3, fr = lane & 15, fq = lane >> 4;
    const int K = g.K, nt = K / BK;
    unsigned voffA[2], voffB[2];
#pragma unroll
    for (int i = 0; i < 2; ++i) { int R, C; stage_rc(tid * 16 + i * 8192, R, C); const int Rb = Epi::PERM ? ((R & ~31) + perm32(R & 31)) : R;
        voffA[i] = (unsigned)(R * g.lda + C) * 2u; voffB[i] = (unsigned)(Rb * K + C) * 2u; }
    const size_t kstep = (size_t)(BK * 2);
    const size_t hstepA = (size_t)HALF * g.lda * 2, hstepB = (size_t)HALF * K * 2;
    const size_t tstepA = 2 * hstepA, tstepB = 2 * hstepB;
    const unsigned ldsw = (unsigned)wid * 1024u;
    const int aoff = lds_byte(wr * 64 + fr, fq * 8), boff = lds_byte(wc * 32 + fr, fq * 8);
#define PG8_SA(b, h) (((b) * 2 + (h)) * HTB)
#define PG8_SB(b, h) ((4 + (b) * 2 + (h)) * HTB)
#define PG8_STAGE(bufoff, gbase, voff) do { _Pragma("unroll") for (int _i = 0; _i < 2; ++_i) \
        __builtin_amdgcn_global_load_lds((const unsigned*)((const char*)(gbase) + (voff)[_i]), (PG8_LAS unsigned*)(lds + (bufoff) + ldsw + _i * 8192), 16, 0, 0); } while (0)
#define PG8_LDA(dst, b, h) do { _Pragma("unroll") for (int m = 0; m < 4; ++m) _Pragma("unroll") for (int k = 0; k < 2; ++k) dst[m][k] = *(const PG8_LAS bf16x8*)(lds + PG8_SA(b, h) + aoff + m * 2048 + k * 1024); } while (0)
#define PG8_LDB(dst, b, h) do { _Pragma("unroll") for (int n = 0; n < 2; ++n) _Pragma("unroll") for (int k = 0; k < 2; ++k) dst[n][k] = *(const PG8_LAS bf16x8*)(lds + PG8_SB(b, h) + boff + n * 2048 + k * 1024); } while (0)
#define PG8_MMA(ai, bj, At, Bt) do { __builtin_amdgcn_s_setprio(1); _Pragma("unroll") for (int m = 0; m < 4; ++m) _Pragma("unroll") for (int n = 0; n < 2; ++n) _Pragma("unroll") for (int k = 0; k < 2; ++k) \
        acc[ai][bj][m][n] = __builtin_amdgcn_mfma_f32_16x16x32_bf16(Bt[n][k], At[m][k], acc[ai][bj][m][n], 0, 0, 0); __builtin_amdgcn_s_setprio(0); } while (0)
#define PG8_WAIT_V(n) asm volatile("s_waitcnt vmcnt(" #n ")" ::: "memory")
#define PG8_WAIT_L(n) asm volatile("s_waitcnt lgkmcnt(" #n ")" ::: "memory")
#define PG8_BAR __builtin_amdgcn_s_barrier()
#define PG8_SCHED __builtin_amdgcn_sched_barrier(0)
    Unit cur, nxt; int ui = 0;
    if (!S.next(0, cur)) return;
    f32x4 acc[2][2][4][2];
#pragma unroll
    for (int a = 0; a < 2; ++a)
#pragma unroll
        for (int b = 0; b < 2; ++b)
#pragma unroll
            for (int m = 0; m < 4; ++m)
#pragma unroll
                for (int n = 0; n < 2; ++n) acc[a][b][m][n] = (f32x4){0.f, 0.f, 0.f, 0.f};
    if constexpr (Epi::ACC_INIT) E.init(acc, cur, wr, wc, fr, fq);
    bf16x8 At[4][2], B0[2][2], B1[2][2];
    const char* cA = (const char*)g.A + (size_t)cur.pm * tstepA; const char* cB = (const char*)g.Bt + (size_t)cur.pn * tstepB;
    S.a_ready(cur);
    if constexpr (SP2) {
        PG8_STAGE(PG8_SB(0, 0), cB, voffB); PG8_STAGE(PG8_SB(0, 1), cB + hstepB, voffB); PG8_STAGE(PG8_SA(0, 0), cA, voffA); PG8_STAGE(PG8_SA(0, 1), cA + hstepA, voffA);
        if constexpr (Epi::PRE_HOOK) E.pre(tid);
        if (wr == 1) PG8_BAR;
        PG8_WAIT_V(2); PG8_BAR;
        PG8_STAGE(PG8_SB(1, 0), cB + kstep, voffB); PG8_STAGE(PG8_SA(1, 0), cA + kstep, voffA); PG8_STAGE(PG8_SB(1, 1), cB + hstepB + kstep, voffB);
        PG8_WAIT_V(6); PG8_BAR;
    } else {
        PG8_STAGE(PG8_SB(0, 0), cB, voffB); PG8_STAGE(PG8_SA(0, 0), cA, voffA); PG8_STAGE(PG8_SB(0, 1), cB + hstepB, voffB); PG8_STAGE(PG8_SA(0, 1), cA + hstepA, voffA);
        if (wr == 1) PG8_BAR;
        PG8_WAIT_V(4); PG8_BAR;
        PG8_STAGE(PG8_SB(1, 0), cB + kstep, voffB); PG8_STAGE(PG8_SA(1, 0), cA + kstep, voffA); PG8_STAGE(PG8_SB(1, 1), cB + hstepB + kstep, voffB);
        PG8_WAIT_V(6); PG8_BAR;
    }
    for (;;) {
        const bool has_next = S.next(ui + 1, nxt);
        const char* nA = has_next ? (const char*)g.A + (size_t)nxt.pm * tstepA : cA; const char* nB = has_next ? (const char*)g.Bt + (size_t)nxt.pn * tstepB : cB;
        for (int t = 0; t < nt; t += 2) {
            const bool last = (t == nt - 2);
            const char* a1 = cA + (size_t)(t + 1) * kstep;
            const char* a2 = last ? nA : cA + (size_t)(t + 2) * kstep; const char* b2 = last ? nB : cB + (size_t)(t + 2) * kstep;
            const char* a3 = a2 + kstep; const char* b3 = b2 + kstep;
            if (last && has_next) S.a_ready(nxt);
            if constexpr (SP2) {
            PG8_LDB(B0, 0, 0); PG8_LDB(B1, 0, 1); PG8_SCHED; PG8_LDA(At, 0, 0); PG8_STAGE(PG8_SA(1, 1), a1 + hstepA, voffA);
            PG8_WAIT_V(8); PG8_WAIT_L(0); PG8_BAR; PG8_MMA(0, 0, At, B0); PG8_MMA(0, 1, At, B1); PG8_BAR; PG8_SCHED;
            PG8_LDA(At, 0, 1); PG8_STAGE(PG8_SB(0, 0), b2, voffB); PG8_STAGE(PG8_SB(0, 1), b2 + hstepB, voffB); PG8_STAGE(PG8_SA(0, 0), a2, voffA);
            PG8_WAIT_V(8); PG8_WAIT_L(0); PG8_BAR; PG8_MMA(1, 0, At, B0); PG8_MMA(1, 1, At, B1); PG8_BAR; PG8_SCHED;
            PG8_LDB(B0, 1, 0); PG8_LDB(B1, 1, 1); PG8_SCHED; PG8_LDA(At, 1, 0); PG8_STAGE(PG8_SA(0, 1), a2 + hstepA, voffA);
            PG8_WAIT_V(8); PG8_WAIT_L(0); PG8_BAR; PG8_MMA(0, 0, At, B0); PG8_MMA(0, 1, At, B1); PG8_BAR; PG8_SCHED;
            PG8_LDA(At, 1, 1); PG8_STAGE(PG8_SB(1, 0), b3, voffB); PG8_STAGE(PG8_SB(1, 1), b3 + hstepB, voffB); PG8_STAGE(PG8_SA(1, 0), a3, voffA);
            PG8_WAIT_V(8); PG8_WAIT_L(0); PG8_BAR; PG8_MMA(1, 0, At, B0); PG8_MMA(1, 1, At, B1); PG8_BAR; PG8_SCHED;
            } else {
            PG8_LDB(B0, 0, 0); PG8_SCHED; PG8_LDA(At, 0, 0); PG8_STAGE(PG8_SA(1, 1), a1 + hstepA, voffA);
            PG8_WAIT_L(8); PG8_BAR; PG8_WAIT_L(0); PG8_MMA(0, 0, At, B0); PG8_BAR; PG8_SCHED;
            PG8_LDB(B1, 0, 1); PG8_STAGE(PG8_SB(0, 0), b2, voffB);
            PG8_BAR; PG8_WAIT_L(0); PG8_MMA(0, 1, At, B1); PG8_BAR;
            PG8_LDA(At, 0, 1); PG8_STAGE(PG8_SA(0, 0), a2, voffA);
            PG8_BAR; PG8_WAIT_L(0); PG8_MMA(1, 0, At, B0); PG8_BAR; PG8_SCHED;
            PG8_STAGE(PG8_SB(0, 1), b2 + hstepB, voffB);
            PG8_WAIT_V(6); PG8_BAR; PG8_MMA(1, 1, At, B1); PG8_BAR;
            PG8_LDB(B0, 1, 0); PG8_SCHED; PG8_LDA(At, 1, 0); PG8_STAGE(PG8_SA(0, 1), a2 + hstepA, voffA);
            PG8_WAIT_L(8); PG8_BAR; PG8_WAIT_L(0); PG8_MMA(0, 0, At, B0); PG8_BAR; PG8_SCHED;
            PG8_LDB(B1, 1, 1); PG8_STAGE(PG8_SB(1, 0), b3, voffB);
            PG8_BAR; PG8_WAIT_L(0); PG8_MMA(0, 1, At, B1); PG8_BAR;
            PG8_LDA(At, 1, 1); PG8_STAGE(PG8_SA(1, 0), a3, voffA);
            PG8_BAR; PG8_WAIT_L(0); PG8_MMA(1, 0, At, B0); PG8_BAR; PG8_SCHED;
            PG8_STAGE(PG8_SB(1, 1), b3 + hstepB, voffB);
            PG8_WAIT_V(6); PG8_BAR; PG8_MMA(1, 1, At, B1); PG8_BAR;
            }
        }
        if constexpr (ALIGN_EPI) { if (wr == 0) PG8_BAR; }
        if constexpr (!Epi::AFTER_DRAIN) { E(acc, cur, ui, wr, wc, fr, fq); S.done(cur); }
        if (!has_next) break;
#pragma unroll
        for (int a = 0; a < 2; ++a)
#pragma unroll
            for (int b = 0; b < 2; ++b)
#pragma unroll
                for (int m = 0; m < 4; ++m)
#pragma unroll
                    for (int n = 0; n < 2; ++n) acc[a][b][m][n] = (f32x4){0.f, 0.f, 0.f, 0.f};
        cur = nxt; cA = nA; cB = nB; ++ui;
        if constexpr (ALIGN_EPI) { if (wr == 1) PG8_BAR; }
    }
    PG8_WAIT_V(0);
    if constexpr (!ALIGN_EPI) { if (wr == 0) PG8_BAR; }
    PG8_BAR;

#undef PG8_SA
#undef PG8_SB
#undef PG8_STAGE
#undef PG8_LDA
#undef PG8_LDB
#undef PG8_MMA
#undef PG8_WAIT_V
#undef PG8_WAIT_L
#undef PG8_BAR
#undef PG8_SCHED
}
}

constexpr int NWAVES = 8, NTHREADS = NWAVES * 64;
constexpr int BATCH = 8, SEQ = 2048, D = 1024, M = BATCH * SEQ, FF = 4096, DEPTH = 2;
constexpr int D_IN = 2312, NPROJ = 2560, PP = pg8::PROJ_PITCH;
constexpr int CQ = 0, CZ = 512, CK = 1024, CV = 1152, CX = 1280, CBM = 1792, CCM = 2048;
constexpr float EPS = 1e-6f;
constexpr int GRID = 256, NGRP = 8, GRP = GRID / NGRP;

constexpr size_t MiB = 1u << 20;
constexpr size_t WS_CTL = 0, CTL_ZERO_BYTES = 1 * MiB;
constexpr size_t WS_SSQ = 1 * MiB;
constexpr size_t WS_DTRAW = 2 * MiB;
constexpr size_t WS_ACS = 2 * MiB + 512 * 1024, WS_CHDEC = 3 * MiB;
constexpr size_t WS_WIN = 4 * MiB, WS_WOUT = 14 * MiB, WS_WUP = 18 * MiB, WS_WDOWN = 34 * MiB;
constexpr size_t WS_XB = 50 * MiB;
constexpr size_t WS_BATCH0 = 82 * MiB, BATCH_STRIDE = 20 * MiB;
constexpr size_t BO_PROJ = 0;
constexpr size_t BO_STATES = 9 * MiB;
constexpr size_t BO_PREV = 13 * MiB;
constexpr size_t BO_YPART = 15 * MiB;
constexpr size_t BO_CC = 19 * MiB;
constexpr size_t BO_HID = 0;
constexpr size_t WS_END = WS_BATCH0 + BATCH * BATCH_STRIDE;
static_assert(WS_END <= 256 * MiB, "d_ws map");
constexpr int CW_BAR = 4096, CW_GRP = 16384, GRP_BAR_STRIDE = 4096;

constexpr int RING_OFF = 0, RING_BYTES = 131072;
constexpr int LDSCTL_OFF = RING_BYTES, MISC_OFF = LDSCTL_OFF + 320, RSTD_OFF = LDSCTL_OFF + 512, PTR_OFF = RSTD_OFF + 4096;
constexpr int LDS_BYTES = 147456;
static_assert(PTR_OFF + 512 <= LDS_BYTES, "LDS map");

#define GAS __attribute__((address_space(1)))
#define LAS __attribute__((address_space(3)))
typedef unsigned short bf16;
typedef unsigned v4u __attribute__((ext_vector_type(4)));
typedef unsigned v2u __attribute__((ext_vector_type(2)));
typedef float f32x4 __attribute__((ext_vector_type(4)));
#define LDS_WAIT() asm volatile("s_waitcnt lgkmcnt(0)" ::: "memory")
#define VM_WAIT() asm volatile("s_waitcnt vmcnt(0)" ::: "memory")
__device__ __forceinline__ unsigned f2bf(float f) { unsigned u = __builtin_bit_cast(unsigned, f); return (u + 0x7fffu + ((u >> 16) & 1u)) >> 16; }
__device__ __forceinline__ unsigned pk2(float lo, float hi) { return f2bf(lo) | (f2bf(hi) << 16); }
__device__ __forceinline__ float bflo(unsigned w) { return __uint_as_float(w << 16); }
__device__ __forceinline__ float bfhi(unsigned w) { return __uint_as_float(w & 0xffff0000u); }
__device__ __forceinline__ float silu_f(float v) { return v / (1.f + expf(-v)); }
__device__ __forceinline__ float softplus_f(float v) { return fmaxf(v, 0.f) + log1pf(expf(-fabsf(v))); }

#define XB_TMO      128
#define XB_XCNT(j)  (256  + 64 * (j))
#define XB_XSUB(j)  (1280 + 64 * (j))
#define XB_XGEN(j)  (2304 + 64 * (j))
#define XB_TOP      3328
#define XB_TOPGEN   3392
#define XCD_BAR_WORDS 3456
#define XB_SPIN_CAP (1u << 22)
__device__ __forceinline__ unsigned xb_ld(unsigned* p)              { return __hip_atomic_load(p, __ATOMIC_RELAXED, __HIP_MEMORY_SCOPE_AGENT); }
__device__ __forceinline__ unsigned xb_add(unsigned* p, unsigned v) { return __hip_atomic_fetch_add(p, v, __ATOMIC_RELAXED, __HIP_MEMORY_SCOPE_AGENT); }
__device__ __forceinline__ unsigned xb_xcc_id() { return (unsigned)__builtin_amdgcn_s_getreg((3 << 11) | 20) & 0xFu; }
#define XB_SPIN(cond, bar) do { unsigned _sp = 0; while (cond) { __builtin_amdgcn_s_sleep(1); \
    if ((++_sp & 255u) == 0u) { if (xb_ld(&(bar)[XB_TMO])) break; if (_sp > XB_SPIN_CAP) { atomicAdd(&(bar)[XB_TMO], 1u); break; } } } } while (0)
struct XcdBarrier { unsigned* bar; unsigned x; unsigned total; volatile LAS unsigned* st; };
__device__ __forceinline__ XcdBarrier xcd_barrier_post(unsigned* bar, volatile LAS unsigned* st, unsigned total) {
    XcdBarrier b; b.bar = bar; b.x = xb_xcc_id(); b.total = total; b.st = st;
    if (threadIdx.x == 0) (void)xb_add(&bar[XB_XCNT(b.x)], 1u);
    return b;
}
__device__ __forceinline__ void xcd_barrier_complete(unsigned* bar, unsigned x, unsigned G, unsigned& nloc, unsigned& nx) {
    unsigned sum, cnt, mine, sp = 0u;
    for (;;) {
        sum = 0u; cnt = 0u; mine = 0u;
#pragma unroll
        for (unsigned j = 0; j < 16; ++j) { const unsigned c = xb_ld(&bar[XB_XCNT(j)]); sum += c; cnt += (c > 0u) ? 1u : 0u; mine = (j == x) ? c : mine; }
        if (sum == G) break;
        __builtin_amdgcn_s_sleep(1);
        if ((++sp & 255u) == 0u) { if (xb_ld(&bar[XB_TMO])) break; if (sp > XB_SPIN_CAP) { atomicAdd(&bar[XB_TMO], 1u); break; } }
    }
    nloc = mine > 0u ? mine : 1u; nx = cnt > 0u ? cnt : 1u;
}
__device__ __forceinline__ void xcd_barrier(const XcdBarrier& b) {
    asm volatile("s_waitcnt vmcnt(0)" ::: "memory");
    __syncthreads();
    if (threadIdx.x == 0) {
        unsigned* bar = b.bar;
        __builtin_amdgcn_s_waitcnt(0);
        unsigned nloc = b.st[0], nx = b.st[1];
        if (nloc == 0u) { xcd_barrier_complete(bar, b.x, b.total, nloc, nx); b.st[0] = nloc; b.st[1] = nx; }
        const unsigned old = xb_add(&bar[XB_XSUB(b.x)], 1u);
        const unsigned gen = old / nloc;
        if (nx == 1u) {
            XB_SPIN(xb_ld(&bar[XB_XSUB(b.x)]) < (gen + 1u) * nloc, bar);
            __builtin_amdgcn_fence(__ATOMIC_ACQUIRE, "agent");
            asm volatile("s_waitcnt vmcnt(0)" ::: "memory");
        } else if (old + 1u == (gen + 1u) * nloc) {
            __builtin_amdgcn_fence(__ATOMIC_RELEASE, "agent");
            asm volatile("s_waitcnt vmcnt(0)" ::: "memory");
            const unsigned og = xb_add(&bar[XB_TOP], 1u);
            const unsigned tg = og / nx;
            if (og + 1u == (tg + 1u) * nx) xb_add(&bar[XB_TOPGEN], 1u);
            else XB_SPIN(xb_ld(&bar[XB_TOPGEN]) == tg, bar);
            __builtin_amdgcn_fence(__ATOMIC_ACQUIRE, "agent");
            xb_add(&bar[XB_XGEN(b.x)], 1u);
            asm volatile("s_waitcnt vmcnt(0)" ::: "memory");
        } else {
            XB_SPIN(xb_ld(&bar[XB_XGEN(b.x)]) == gen, bar);
            __builtin_amdgcn_fence(__ATOMIC_ACQUIRE, "agent");
            asm volatile("s_waitcnt vmcnt(0)" ::: "memory");
        }
    }
    __syncthreads();
}

struct Frame {
    LAS unsigned char* lds;
    int tid, lane, wave, bid, G;
    int b, li;
};
enum { I_X = 0, I_MIXG, I_WIN, I_QG, I_KG, I_SINK, I_RELB, I_CONVW, I_CONVB, I_DTB, I_ALOG, I_DSKIP, I_SSMG, I_WOUT, I_MLPG, I_WUP, I_WDOWN, I_OUT, I_WS, I_NPTR };
__device__ __forceinline__ GAS unsigned char* ptr_at(const Frame& F, int i) {
    const LAS unsigned* t = (const LAS unsigned*)(F.lds + PTR_OFF) + 2 * i;
    const unsigned lo = __builtin_amdgcn_readfirstlane(t[0]), hi = __builtin_amdgcn_readfirstlane(t[1]);
    return (GAS unsigned char*)(((unsigned long long)hi << 32) | lo);
}
#define FIN(i) ((const GAS float*)ptr_at(F, (i)))
#define FWS(off) (ptr_at(F, I_WS) + (off))
#define FB(off) (ptr_at(F, I_WS) + (WS_BATCH0 + (size_t)F.b * BATCH_STRIDE + (off)))
using pg8::shx;
__device__ __forceinline__ float shup(float v, int o, int lane) { return __builtin_bit_cast(float, __builtin_amdgcn_ds_bpermute(((lane - o) & 63) << 2, __builtin_bit_cast(int, v))); }
__device__ __forceinline__ float wave_sum(float v, int lane) {
#pragma unroll
    for (int o = 1; o < 64; o <<= 1) v += shx(v, o, lane);
    return v;
}

__device__ __forceinline__ void tr_item(const GAS float* W, int Nsrc, int nsrc0, int nvalid, int K, const GAS float* gain, GAS bf16* WT, int ndst0, int k0, LAS float* scr, int lane) {
    const int n = lane & 31;
    float tv[32];
#pragma unroll
    for (int i = 0; i < 32; ++i) { const int kk = 2 * i + (lane >> 5); tv[i] = W[(size_t)(k0 + kk) * Nsrc + nsrc0 + (n < nvalid ? n : 0)]; }
#pragma unroll
    for (int i = 0; i < 32; ++i) { const int kk = 2 * i + (lane >> 5); float v = (n < nvalid) ? tv[i] : 0.f; if (gain) v *= gain[k0 + kk];
        scr[kk * 33 + n] = v; }
    LDS_WAIT(); asm volatile("" ::: "memory");
    const int c = lane & 7;
#pragma unroll
    for (int j = 0; j < 4; ++j) { const int nn = (lane >> 3) + 8 * j; const LAS float* s = scr + (8 * c) * 33 + nn;
        v4u o; o.x = pk2(s[0 * 33], s[1 * 33]); o.y = pk2(s[2 * 33], s[3 * 33]); o.z = pk2(s[4 * 33], s[5 * 33]); o.w = pk2(s[6 * 33], s[7 * 33]);
        *(GAS v4u*)(WT + (size_t)(ndst0 + nn) * K + k0 + 8 * c) = o; }
    LDS_WAIT(); asm volatile("" ::: "memory");
}
__device__ __forceinline__ void win_item(Frame& F, int L, int r, LAS float* scr);
__device__ __forceinline__ void p0_prologue(Frame& F) {
    LAS float* scr = (LAS float*)(F.lds + RING_OFF + F.wave * 16384);
    const int gw = F.bid * NWAVES + F.wave, NGW = F.G * NWAVES;
    constexpr int I_IN = 16 * 80, I_OUT = 16 * 32, I_UP = 16 * 128, I_DN = 64 * 32, I_L = I_IN + I_OUT + I_UP + I_DN;
    for (int it = gw; it < I_IN; it += NGW) win_item(F, 0, it, scr);
    const GAS float* x = FIN(I_X) + (size_t)F.b * SEQ * D; GAS bf16* XB = (GAS bf16*)FWS(WS_XB) + (size_t)F.b * SEQ * D; GAS float* SSQ = (GAS float*)FWS(WS_SSQ) + (size_t)F.b * SEQ * 16;
    for (int m = F.li * NWAVES + F.wave; m < SEQ; m += 2 * GRP * NWAVES) {
        const int m2 = m + GRP * NWAVES;
        const GAS f32x4* xr = (const GAS f32x4*)(x + (size_t)m * D) + F.lane; const GAS f32x4* xr2 = (const GAS f32x4*)(x + (size_t)m2 * D) + F.lane;
        f32x4 v[4], w[4]; float s = 0.f, s2 = 0.f;
#pragma unroll
        for (int j = 0; j < 4; ++j) { v[j] = xr[64 * j]; w[j] = xr2[64 * j]; }
#pragma unroll
        for (int j = 0; j < 4; ++j) { s += (v[j].x * v[j].x + v[j].y * v[j].y) + (v[j].z * v[j].z + v[j].w * v[j].w); s2 += (w[j].x * w[j].x + w[j].y * w[j].y) + (w[j].z * w[j].z + w[j].w * w[j].w); }
        s = wave_sum(s, F.lane); s2 = wave_sum(s2, F.lane);
        GAS v2u* o8 = (GAS v2u*)(XB + (size_t)m * D) + F.lane; GAS v2u* o82 = (GAS v2u*)(XB + (size_t)m2 * D) + F.lane;
#pragma unroll
        for (int j = 0; j < 4; ++j) { v2u o; o.x = pk2(v[j].x, v[j].y); o.y = pk2(v[j].z, v[j].w); o8[64 * j] = o; v2u o2; o2.x = pk2(w[j].x, w[j].y); o2.y = pk2(w[j].z, w[j].w); o82[64 * j] = o2; }
        if (F.lane < 16) { SSQ[(size_t)m * 16 + F.lane] = (F.lane == 0) ? s : 0.f; SSQ[(size_t)m2 * 16 + F.lane] = (F.lane == 0) ? s2 : 0.f; }
    }
}
constexpr int CW_WCNT = 8192, N_CONVERTERS = NGRP * (GRP - 16);
__device__ __forceinline__ void win_item(Frame& F, int L, int r, LAS float* scr) {
    const int kb = r / 80, nb = r % 80; int src, nv = 32;
    if (nb < 16) src = nb * 32; else if (nb < 32) src = 768 + (nb - 16) * 32; else if (nb < 36) src = 512 + (nb - 32) * 32; else if (nb < 40) src = 640 + (nb - 36) * 32;
    else if (nb < 72) src = nb * 32; else if (nb == 72) { src = 2304; nv = 8; } else { src = 0; nv = 0; }
    tr_item(FIN(I_WIN) + (size_t)L * D * D_IN, D_IN, src, nv, D, FIN(I_MIXG) + L * D, (GAS bf16*)FWS(WS_WIN) + (size_t)L * NPROJ * D, nb * 32, kb * 64, scr, F.lane);
}
__device__ __forceinline__ void convert_rest(Frame& F, int slot) {
    LAS float* scr = (LAS float*)(F.lds + RING_OFF + F.wave * 16384);
    constexpr int I_IN = 16 * 80, I_OUT = 16 * 32, I_UP = 16 * 128, I_DN = 64 * 32, NCW = N_CONVERTERS * NWAVES;
    const GAS float *w_out = FIN(I_WOUT), *w_up = FIN(I_WUP), *mlp_g = FIN(I_MLPG), *w_down = FIN(I_WDOWN);
    GAS bf16 *WOUT = (GAS bf16*)FWS(WS_WOUT), *WUP = (GAS bf16*)FWS(WS_WUP), *WDOWN = (GAS bf16*)FWS(WS_WDOWN);
    const int L = slot, n_items = I_UP + I_DN + (slot == 0 ? 2 * I_OUT + I_IN : 0);
    for (int it = (F.b * (GRP - 16) + (F.li - 16)) * NWAVES + F.wave; it < n_items; it += NCW) {
        int r = it;
        if (slot == 0) {
            if (r < I_OUT) { const int kb = r / 32, nb = r % 32; tr_item(w_out, D, nb * 32, 32, D, nullptr, WOUT, nb * 32, kb * 64, scr, F.lane); continue; }
            r -= I_OUT; }
        if (r < I_UP) { const int kb = r / 128, nb = r % 128; tr_item(w_up + (size_t)L * D * FF, FF, nb * 32, 32, D, mlp_g + L * D, WUP + (size_t)L * FF * D, nb * 32, kb * 64, scr, F.lane); continue; }
        r -= I_UP;
        if (r < I_DN) { const int kb = r / 32, nb = r % 32; tr_item(w_down + (size_t)L * FF * D, D, nb * 32, 32, FF, nullptr, WDOWN + (size_t)L * D * FF, nb * 32, kb * 64, scr, F.lane); continue; }
        r -= I_DN;
        if (r < I_OUT) { const int kb = r / 32, nb = r % 32; tr_item(w_out + (size_t)1 * D * D, D, nb * 32, 32, D, nullptr, WOUT + (size_t)1 * D * D, nb * 32, kb * 64, scr, F.lane); continue; }
        r -= I_OUT;
        win_item(F, 1, r, scr);
    }
    asm volatile("s_waitcnt vmcnt(0)" ::: "memory");
    __syncthreads();
    if (F.tid == 0) { __builtin_amdgcn_fence(__ATOMIC_RELEASE, "agent"); asm volatile("s_waitcnt vmcnt(0)" ::: "memory");
        (void)xb_add((unsigned*)(unsigned char*)FWS(WS_CTL) + CW_WCNT + 64 * slot, 1u); }
}
__device__ __forceinline__ void wait_weights(Frame& F, int part) {
    if (F.tid == 0) { unsigned* wc = (unsigned*)(unsigned char*)FWS(WS_CTL) + CW_WCNT + 64 * part; unsigned sp = 0u;
        while (xb_ld(wc) < (unsigned)N_CONVERTERS) { __builtin_amdgcn_s_sleep(2); if (++sp > (1u << 22)) break; }
        __builtin_amdgcn_fence(__ATOMIC_ACQUIRE, "agent"); asm volatile("s_waitcnt vmcnt(0)" ::: "memory"); }
    __syncthreads();
}
__device__ __forceinline__ void rstd_prepass(Frame& F, const pg8::GroupOrder& S, LAS float* tab) {
    const GAS float* SSQ = (const GAS float*)FWS(WS_SSQ) + (size_t)F.b * SEQ * 16;
    pg8::Unit u;
    for (int i = 0; i < 4 && S.next(i, u); ++i) {
        const int r = F.tid >> 1, h = F.tid & 1;
        const GAS f32x4* p = (const GAS f32x4*)(SSQ + (size_t)(u.pm * 256 + r) * 16 + h * 8);
        const f32x4 a = p[0], b = p[1];
        float s = (a.x + a.y) + (a.z + a.w) + (b.x + b.y) + (b.z + b.w);
        s += shx(s, 1, F.lane);
        if (h == 0) tab[i * 256 + r] = 1.0f / sqrtf(s * (1.0f / D) + EPS);
    }
    LDS_WAIT(); __syncthreads();
}
__device__ __forceinline__ int t5_bucket(int d) {
    if (d < 16) return d;
    return 16 + (d >= 19) + (d >= 21) + (d >= 24) + (d >= 27) + (d >= 31) + (d >= 35) + (d >= 40) + (d >= 46) + (d >= 52) + (d >= 59) + (d >= 67) + (d >= 77) + (d >= 87) + (d >= 99) + (d >= 113);
}
__device__ __forceinline__ void ld8(const GAS bf16* p, float (&v)[8]) {
    const v4u w = *(const GAS v4u*)p;
    v[0] = bflo(w.x); v[1] = bfhi(w.x); v[2] = bflo(w.y); v[3] = bfhi(w.y); v[4] = bflo(w.z); v[5] = bfhi(w.z); v[6] = bflo(w.w); v[7] = bfhi(w.w);
}
typedef short bf16x8_t __attribute__((ext_vector_type(8)));
typedef float f32x16 __attribute__((ext_vector_type(16)));
constexpr float LOG2E = 1.4426950408889634f;
__device__ __forceinline__ unsigned pkbf(float lo, float hi) { return pg8::cvt_pk_bf16(lo, hi); }
__device__ __forceinline__ int crow32(int i, int hh) { return (i & 3) + 8 * (i >> 2) + 4 * hh; }
__device__ __forceinline__ float silu_fast(float v) { return v * __builtin_amdgcn_rcpf(1.0f + __builtin_amdgcn_exp2f(-v * LOG2E)); }
__device__ __forceinline__ void unpk8(const v4u w, float (&v)[8]) {
    v[0] = bflo(w.x); v[1] = bfhi(w.x); v[2] = bflo(w.y); v[3] = bfhi(w.y); v[4] = bflo(w.z); v[5] = bfhi(w.z); v[6] = bflo(w.w); v[7] = bfhi(w.w);
}

constexpr int AT_KS = 0, AT_KSTRIDE = 144, AT_VT = 36864, AT_VSTRIDE = 520, AT_BIAS = AT_VT + 64 * AT_VSTRIDE, AT_BN = 192, AT_END = AT_BIAS + 4 * AT_BN * 4;
static_assert(AT_END <= RING_BYTES, "attention LDS");
__device__ __forceinline__ void attn_fast(Frame& F, int L, bool dummy = false) {
    GAS bf16* PROJ = (GAS bf16*)FB(BO_PROJ);
    const GAS float* qg = FIN(I_QG) + L * 64; const GAS float* kg = FIN(I_KG) + L * 64; const GAS float* sinks = FIN(I_SINK) + L * 8; const GAS float* rel_bias = FIN(I_RELB);
    LAS unsigned char* Ks = F.lds + AT_KS; LAS unsigned char* Vt = F.lds + AT_VT; LAS float* biasR = (LAS float*)(F.lds + AT_BIAS);
    const int tid = F.tid, lane = F.lane, wave = F.wave, q = lane & 31, hh = lane >> 5;
    const int unit = F.li, kvh = unit >> 4, qb = unit & 15, m0 = qb * 128;
    const int gi = wave >> 1, qh = wave & 1, hq = kvh * 4 + gi;
    v4u qraw[2][4];
#pragma unroll
    for (int s = 0; s < 2; ++s)
#pragma unroll
        for (int d0 = 0; d0 < 4; ++d0) qraw[s][d0] = *(const GAS v4u*)(PROJ + (size_t)(m0 + 64 * qh + 32 * s + q) * PP + CQ + hq * 64 + d0 * 16 + hh * 8);
    v4u kwv[4], vwv[4];
#pragma unroll
    for (int i = 0; i < 4; ++i) { const int c = tid + NTHREADS * i, key = c >> 3, part = c & 7; const bool valid = (qb > 0) || (key >= 128); const unsigned msk = valid ? 0xffffffffu : 0u;
        const GAS bf16* kp = PROJ + (size_t)(valid ? m0 + key - 128 : 0) * PP + CK + kvh * 64 + part * 8;
        v4u a_ = *(const GAS v4u*)kp, b_ = *(const GAS v4u*)(kp + (CV - CK));
        a_.x &= msk; a_.y &= msk; a_.z &= msk; a_.w &= msk; b_.x &= msk; b_.y &= msk; b_.z &= msk; b_.w &= msk; kwv[i] = a_; vwv[i] = b_; }
    const f32x4 kg0 = *(const GAS f32x4*)(kg + (tid & 7) * 8), kg1 = *(const GAS f32x4*)(kg + (tid & 7) * 8 + 4);
    f32x4 qgv[4][2];
#pragma unroll
    for (int d0 = 0; d0 < 4; ++d0) { qgv[d0][0] = *(const GAS f32x4*)(qg + d0 * 16 + hh * 8); qgv[d0][1] = *(const GAS f32x4*)(qg + d0 * 16 + hh * 8 + 4); }
    const float sinkv = sinks[hq];
    float bent[2];
#pragma unroll
    for (int k = 0; k < 2; ++k) { const int x = tid + NTHREADS * k, g_ = x / AT_BN, xx = x - g_ * AT_BN; const bool ok = (x < 4 * AT_BN) && (xx >= 32) && (xx < 160);
        const float v = rel_bias[t5_bucket(ok ? 159 - xx : 0) * 8 + kvh * 4 + (ok ? g_ : 0)]; bent[k] = ok ? v * LOG2E : 0.f; }
    __syncthreads();
    biasR[tid] = bent[0]; if (tid + NTHREADS < 4 * AT_BN) biasR[tid + NTHREADS] = bent[1];
#pragma unroll
    for (int i = 0; i < 4; ++i) {
        const int c = tid + NTHREADS * i, key = c >> 3, part = c & 7;
        const v4u kw = kwv[i], vw = vwv[i];
        float kv[8]; unpk8(kw, kv);
        float ss = 0.f;
#pragma unroll
        for (int e = 0; e < 8; ++e) ss += kv[e] * kv[e];
        ss += shx(ss, 1, lane); ss += shx(ss, 2, lane); ss += shx(ss, 4, lane);
        const float rk = __builtin_amdgcn_rsqf(ss * (1.0f / 64.0f) + EPS);
        const f32x4 g0 = kg0, g1 = kg1;
        v4u ko; ko.x = pkbf(kv[0] * rk * g0.x, kv[1] * rk * g0.y); ko.y = pkbf(kv[2] * rk * g0.z, kv[3] * rk * g0.w); ko.z = pkbf(kv[4] * rk * g1.x, kv[5] * rk * g1.y); ko.w = pkbf(kv[6] * rk * g1.z, kv[7] * rk * g1.w);
        *(LAS v4u*)(Ks + key * AT_KSTRIDE + part * 16) = ko;
        LAS unsigned short* vt = (LAS unsigned short*)(Vt + (part * 8) * AT_VSTRIDE + key * 2);
        vt[0 * (AT_VSTRIDE / 2)] = (unsigned short)(vw.x & 0xffffu); vt[1 * (AT_VSTRIDE / 2)] = (unsigned short)(vw.x >> 16);
        vt[2 * (AT_VSTRIDE / 2)] = (unsigned short)(vw.y & 0xffffu); vt[3 * (AT_VSTRIDE / 2)] = (unsigned short)(vw.y >> 16);
        vt[4 * (AT_VSTRIDE / 2)] = (unsigned short)(vw.z & 0xffffu); vt[5 * (AT_VSTRIDE / 2)] = (unsigned short)(vw.z >> 16);
        vt[6 * (AT_VSTRIDE / 2)] = (unsigned short)(vw.w & 0xffffu); vt[7 * (AT_VSTRIDE / 2)] = (unsigned short)(vw.w >> 16);
    }
    LDS_WAIT(); __syncthreads();
    const float sink2 = sinkv * LOG2E;
    const LAS float* bb = biasR + gi * AT_BN + 31 - q + 4 * hh;
    const int qm = q - 4 * hh;
#pragma unroll
    for (int s = 0; s < 2; ++s) {
        const int a = 64 * qh + 32 * s;
        GAS bf16* qrow = PROJ + (size_t)(m0 + a + q) * PP + CQ + hq * 64;
        float qv[4][8]; float ss = 0.f;
#pragma unroll
        for (int d0 = 0; d0 < 4; ++d0) { unpk8(qraw[s][d0], qv[d0]);
#pragma unroll
            for (int e = 0; e < 8; ++e) ss += qv[d0][e] * qv[d0][e]; }
        ss += shx(ss, 32, lane);
        const float rq = __builtin_amdgcn_rsqf(ss * (1.0f / 64.0f) + EPS) * (0.125f * LOG2E);
        bf16x8_t qf[4];
#pragma unroll
        for (int d0 = 0; d0 < 4; ++d0) { const f32x4 g0 = qgv[d0][0], g1 = qgv[d0][1];
            v4u w; w.x = pkbf(qv[d0][0] * rq * g0.x, qv[d0][1] * rq * g0.y); w.y = pkbf(qv[d0][2] * rq * g0.z, qv[d0][3] * rq * g0.w);
            w.z = pkbf(qv[d0][4] * rq * g1.x, qv[d0][5] * rq * g1.y); w.w = pkbf(qv[d0][6] * rq * g1.z, qv[d0][7] * rq * g1.w);
            qf[d0] = __builtin_bit_cast(bf16x8_t, w); }
        const int kt_lo = (qb == 0) ? 4 - (a >> 5) : 0;
        f32x16 S[5]; float mx = sink2;
#pragma unroll
        for (int kt = 0; kt < 5; ++kt) { f32x16 acc = {};
#pragma unroll
            for (int d0 = 0; d0 < 4; ++d0) { const bf16x8_t kf = *(const LAS bf16x8_t*)(Ks + (a + 32 * kt + q) * AT_KSTRIDE + d0 * 32 + hh * 16);
                acc = __builtin_amdgcn_mfma_f32_32x32x16_bf16(kf, qf[d0], acc, 0, 0, 0); }
            if (kt < kt_lo) {
#pragma unroll
                for (int i = 0; i < 16; ++i) acc[i] = -INFINITY;
            } else {
#pragma unroll
                for (int i = 0; i < 16; ++i) { const int t0 = (i & 3) + 8 * (i >> 2); float v = acc[i] + bb[32 * kt + t0];
                    if (kt == 0) v = fminf(v, (t0 > qm) ? INFINITY : -INFINITY);
                    if (kt == 4) v = fminf(v, (t0 <= qm) ? INFINITY : -INFINITY);
                    acc[i] = v; mx = fmaxf(mx, v); } }
            S[kt] = acc; }
        mx = fmaxf(mx, shx(mx, 32, lane));
        float lsum = 0.f; bf16x8_t pf[5][2];
#pragma unroll
        for (int kt = 0; kt < 5; ++kt) {
#pragma unroll
            for (int i = 0; i < 16; ++i) { const float p = __builtin_amdgcn_exp2f(S[kt][i] - mx); S[kt][i] = p; lsum += p; }
#pragma unroll
            for (int s2 = 0; s2 < 2; ++s2) { v4u w; w.x = pkbf(S[kt][8 * s2 + 0], S[kt][8 * s2 + 1]); w.y = pkbf(S[kt][8 * s2 + 2], S[kt][8 * s2 + 3]);
                w.z = pkbf(S[kt][8 * s2 + 4], S[kt][8 * s2 + 5]); w.w = pkbf(S[kt][8 * s2 + 6], S[kt][8 * s2 + 7]); pf[kt][s2] = __builtin_bit_cast(bf16x8_t, w); } }
        lsum += shx(lsum, 32, lane);
        lsum += __builtin_amdgcn_exp2f(sink2 - mx);
        f32x16 O[2] = {{}, {}};
#pragma unroll
        for (int kt = 0; kt < 5; ++kt)
#pragma unroll
            for (int s2 = 0; s2 < 2; ++s2)
#pragma unroll
                for (int db = 0; db < 2; ++db) { const LAS unsigned char* vb = Vt + (32 * db + q) * AT_VSTRIDE + (a + 32 * kt + 16 * s2 + 4 * hh) * 2;
                    const v2u lo = *(const LAS v2u*)vb, hi2 = *(const LAS v2u*)(vb + 16); v4u w; w.x = lo.x; w.y = lo.y; w.z = hi2.x; w.w = hi2.y;
                    O[db] = __builtin_amdgcn_mfma_f32_32x32x16_bf16(__builtin_bit_cast(bf16x8_t, w), pf[kt][s2], O[db], 0, 0, 0); }
        const float inv = __builtin_amdgcn_rcpf(lsum);
#pragma unroll
        for (int db = 0; db < 2; ++db)
#pragma unroll
            for (int g4 = 0; g4 < 4; ++g4) { v2u w; w.x = pkbf(O[db][4 * g4] * inv, O[db][4 * g4 + 1] * inv); w.y = pkbf(O[db][4 * g4 + 2] * inv, O[db][4 * g4 + 3] * inv);
                GAS bf16* orow = dummy ? (GAS bf16*)FB(BO_PREV) + (size_t)(m0 + a + q) * 512 + hq * 64 : qrow;
                *(GAS v2u*)(orow + 32 * db + 8 * g4 + 4 * hh) = w; }
    }
}

constexpr size_t WS_DTV = 3 * MiB + 512 * 1024;
constexpr int SD_ROW = 272, SD_XT = 264;
template <int NR> struct Raw8 { v4u u[NR + 3]; };
template <int NR> struct Raw4 { v2u u[NR + 3]; };
struct ConvW8 { f32x4 w[4][2], b[2]; };
struct ConvW4 { f32x4 w[4], b; };
template <int NR> __device__ __forceinline__ void conv_load(Raw8<NR>& R, const GAS bf16* PROJ, int m0, int c, int l0, int col0) {
#pragma unroll
    for (int i = 0; i < NR + 3; ++i) { const int row = l0 - 3 + i; const bool ok = (c > 0) || (row >= 0); const unsigned msk = ok ? 0xffffffffu : 0u;
        v4u x = *(const GAS v4u*)(PROJ + (size_t)(m0 + (ok ? row : 0)) * PP + col0); x.x &= msk; x.y &= msk; x.z &= msk; x.w &= msk; R.u[i] = x; }
}
template <int NR> __device__ __forceinline__ void conv_load(Raw4<NR>& R, const GAS bf16* PROJ, int m0, int c, int l0, int col0) {
#pragma unroll
    for (int i = 0; i < NR + 3; ++i) { const int row = l0 - 3 + i; const bool ok = (c > 0) || (row >= 0); const unsigned msk = ok ? 0xffffffffu : 0u;
        v2u x = *(const GAS v2u*)(PROJ + (size_t)(m0 + (ok ? row : 0)) * PP + col0); x.x &= msk; x.y &= msk; R.u[i] = x; }
}
__device__ __forceinline__ void convw_load(ConvW8& W, const GAS float* cw, const GAS float* cb) {
#pragma unroll
    for (int k = 0; k < 4; ++k) { W.w[k][0] = *(const GAS f32x4*)(cw + k * 1024); W.w[k][1] = *(const GAS f32x4*)(cw + k * 1024 + 4); }
    W.b[0] = *(const GAS f32x4*)cb; W.b[1] = *(const GAS f32x4*)(cb + 4);
}
__device__ __forceinline__ void convw_load(ConvW4& W, const GAS float* cw, const GAS float* cb) {
#pragma unroll
    for (int k = 0; k < 4; ++k) W.w[k] = *(const GAS f32x4*)(cw + k * 1024);
    W.b = *(const GAS f32x4*)cb;
}
template <int NR> __device__ __forceinline__ void conv_row(const Raw8<NR>& R, const ConvW8& W, int r, float (&out)[8]) {
    float acc[8];
#pragma unroll
    for (int e = 0; e < 8; ++e) acc[e] = W.b[e >> 2][e & 3];
#pragma unroll
    for (int k = 0; k < 4; ++k) { float u[8]; unpk8(R.u[r + k], u);
#pragma unroll
        for (int e = 0; e < 8; ++e) acc[e] += W.w[k][e >> 2][e & 3] * u[e]; }
#pragma unroll
    for (int e = 0; e < 8; ++e) out[e] = silu_fast(acc[e]);
}
template <int NR> __device__ __forceinline__ void conv_row(const Raw4<NR>& R, const ConvW4& W, int r, float (&out)[4]) {
    float acc[4];
#pragma unroll
    for (int e = 0; e < 4; ++e) acc[e] = W.b[e];
#pragma unroll
    for (int k = 0; k < 4; ++k) { const v2u x = R.u[r + k]; const float u[4] = {bflo(x.x), bfhi(x.x), bflo(x.y), bfhi(x.y)};
#pragma unroll
        for (int e = 0; e < 4; ++e) acc[e] += W.w[k][e] * u[e]; }
#pragma unroll
    for (int e = 0; e < 4; ++e) out[e] = silu_fast(acc[e]);
}
constexpr int S1_BMT = 0, S1_XW = 34816, S1_DT = S1_XW + 4 * 64 * SD_ROW, S1_ACS = S1_DT + 2048, S1_WT = S1_ACS + 2048, S1_END = S1_WT + 64;
static_assert(S1_END <= RING_BYTES, "SSD part 1 LDS");
__device__ __forceinline__ void ssd_states(Frame& F, int L) {
    const GAS bf16* PROJ = (const GAS bf16*)FB(BO_PROJ);
    const GAS float* conv_w = FIN(I_CONVW) + (size_t)L * 4 * 1024; const GAS float* conv_b = FIN(I_CONVB) + L * 1024;
    const GAS float* dt_bias = FIN(I_DTB) + L * 8; const GAS float* a_log = FIN(I_ALOG) + L * 8;
    const GAS float* DTRAW = (const GAS float*)FWS(WS_DTRAW) + (size_t)F.b * SEQ * 8; GAS float* ACS = (GAS float*)FWS(WS_ACS) + (size_t)F.b * SEQ * 8;
    GAS float* DTV = (GAS float*)FWS(WS_DTV) + (size_t)F.b * SEQ * 8; GAS float* CHDEC = (GAS float*)FWS(WS_CHDEC) + F.b * 128;
    GAS float* STATES = (GAS float*)FB(BO_STATES);
    LAS unsigned char* BmT = F.lds + S1_BMT; LAS unsigned char* XW = F.lds + S1_XW;
    LAS float* dt_l = (LAS float*)(F.lds + S1_DT); LAS float* acs_l = (LAS float*)(F.lds + S1_ACS); LAS float* wt = (LAS float*)(F.lds + S1_WT);
    const int wave = F.wave, unit = F.li, c = unit >> 1, g = unit & 1, m0 = c * 128;
    int tid = F.tid; asm volatile("" : "+v"(tid));
    int lane = tid & 63, q = lane & 31, hh = lane >> 5;
    const int xcg = tid & 31, xl0 = (tid >> 5) * 8, xcol = CX + g * 256 + xcg * 8;
    const int bcg = tid & 15, bl0 = (tid >> 4) * 4, bcol = CBM + g * 128 + bcg * 8;
    Raw8<8> xr; ConvW8 xw; Raw8<4> br; ConvW8 bw;
    conv_load(xr, PROJ, m0, c, xl0, xcol); convw_load(xw, conv_w + (xcol - CX), conv_b + (xcol - CX));
    conv_load(br, PROJ, m0, c, bl0, bcol); convw_load(bw, conv_w + (bcol - CX), conv_b + (bcol - CX));
    const int ar = tid >> 7, al = tid & 127, ahead = 4 * g + ar;
    const float dtraw = DTRAW[(size_t)(m0 + al) * 8 + ahead], dtb = dt_bias[ahead], alog = a_log[ahead];
    __syncthreads();
    { const float dtv = softplus_f(dtraw + dtb);
      float v = dtv * (-expf(alog));
#pragma unroll
      for (int o = 1; o < 64; o <<= 1) { const float t = shup(v, o, lane); if (lane >= o) v += t; }
      if (lane == 63) wt[wave] = v;
      LDS_WAIT(); __syncthreads();
      if (wave & 1) v += wt[wave - 1];
      dt_l[tid] = dtv; acs_l[tid] = v; ACS[(size_t)(m0 + al) * 8 + ahead] = v; DTV[(size_t)(m0 + al) * 8 + ahead] = dtv;
      if (al == 127) CHDEC[c * 8 + ahead] = expf(v); }
#pragma unroll
    for (int r = 0; r < 4; ++r) { float o[8]; conv_row(br, bw, r, o);
#pragma unroll
        for (int e = 0; e < 8; e += 2) { const unsigned w = pkbf(o[e], o[e + 1]);
            *(LAS unsigned short*)(BmT + (bcg * 8 + e) * SD_ROW + (bl0 + r) * 2) = (unsigned short)(w & 0xffffu); *(LAS unsigned short*)(BmT + (bcg * 8 + e + 1) * SD_ROW + (bl0 + r) * 2) = (unsigned short)(w >> 16); } }
    LDS_WAIT(); __syncthreads();
    { const int r4 = xcg >> 3, p0 = (xcg & 7) * 8; const float aend = acs_l[r4 * 128 + 127];
#pragma unroll
      for (int r = 0; r < 8; ++r) { float o[8]; conv_row(xr, xw, r, o); const int l = xl0 + r;
          const float sc = dt_l[r4 * 128 + l] * __builtin_amdgcn_exp2f((aend - acs_l[r4 * 128 + l]) * LOG2E);
#pragma unroll
          for (int e = 0; e < 8; e += 2) { const unsigned w = pkbf(o[e] * sc, o[e + 1] * sc);
              *(LAS unsigned short*)(XW + (r4 * 64 + p0 + e) * SD_ROW + l * 2) = (unsigned short)(w & 0xffffu); *(LAS unsigned short*)(XW + (r4 * 64 + p0 + e + 1) * SD_ROW + l * 2) = (unsigned short)(w >> 16); } } }
    LDS_WAIT(); __syncthreads();
    asm volatile("" : "+v"(tid)); lane = tid & 63; q = lane & 31; hh = lane >> 5;
    { const int r4 = wave >> 1, nt0 = (wave & 1) * 2, head = 4 * g + r4;
      f32x16 St[2][2] = {{{}, {}}, {{}, {}}};
#pragma unroll
      for (int ks = 0; ks < 8; ++ks) { bf16x8_t af[2], bfr[2];
#pragma unroll
          for (int pt = 0; pt < 2; ++pt) af[pt] = *(const LAS bf16x8_t*)(XW + (r4 * 64 + 32 * pt + q) * SD_ROW + (16 * ks + 8 * hh) * 2);
#pragma unroll
          for (int nn = 0; nn < 2; ++nn) bfr[nn] = *(const LAS bf16x8_t*)(BmT + (32 * (nt0 + nn) + q) * SD_ROW + (16 * ks + 8 * hh) * 2);
#pragma unroll
          for (int pt = 0; pt < 2; ++pt)
#pragma unroll
              for (int nn = 0; nn < 2; ++nn) St[pt][nn] = __builtin_amdgcn_mfma_f32_32x32x16_bf16(af[pt], bfr[nn], St[pt][nn], 0, 0, 0); }
      GAS float* sp = STATES + ((size_t)c * 8 + head) * 8192 + 32 * nt0 + q;
#pragma unroll
      for (int pt = 0; pt < 2; ++pt)
#pragma unroll
          for (int nn = 0; nn < 2; ++nn)
#pragma unroll
              for (int e = 0; e < 16; ++e) sp[(32 * pt + crow32(e, hh)) * 128 + 32 * nn] = St[pt][nn][e]; }
}
__device__ __forceinline__ void ssd_scan(Frame& F, int L) {
    const GAS float* STATES = (const GAS float*)FB(BO_STATES); const GAS float* CHDEC = (const GAS float*)FWS(WS_CHDEC) + F.b * 128; GAS bf16* PREV = (GAS bf16*)FB(BO_PREV);
    for (int idx = F.li * NTHREADS + F.tid; idx < 8 * 64 * 32; idx += GRP * NTHREADS) {
        const int n4 = idx & 31, p = (idx >> 5) & 63, head = idx >> 11;
        f32x4 s[16]; float dec[16];
#pragma unroll
        for (int c = 0; c < 16; ++c) { const size_t o = ((size_t)c * 8 + head) * 8192 + p * 128 + 4 * n4; s[c] = *(const GAS f32x4*)(STATES + o); dec[c] = CHDEC[c * 8 + head]; }
        f32x4 h = {0.f, 0.f, 0.f, 0.f};
#pragma unroll
        for (int c = 0; c < 16; ++c) { const size_t o = ((size_t)c * 8 + head) * 8192 + p * 128 + 4 * n4;
            v2u w; w.x = pkbf(h.x, h.y); w.y = pkbf(h.z, h.w); *(GAS v2u*)(PREV + o) = w;
            h = h * dec[c] + s[c]; }
    }
}
constexpr int S3_CM = 0, S3_BM = 34816, S3_HIMG = 64 * SD_XT + 64 * SD_ROW, S3_Z = 69632, S3_DT = S3_Z + 128 * SD_ROW, S3_ACS = S3_DT + 2048, S3_RSS = S3_ACS + 2048, S3_END = S3_RSS + 2048;
static_assert(2 * S3_HIMG <= S3_Z && S3_END <= RING_BYTES && 128 * 528 <= S3_DT, "SSD part 3 LDS");
__device__ __forceinline__ void ssd_out(Frame& F, int L, bool dummy = false) {
    GAS bf16* PROJ = (GAS bf16*)FB(BO_PROJ); const GAS bf16* PREV = (const GAS bf16*)FB(BO_PREV);
    const GAS float* conv_w = FIN(I_CONVW) + (size_t)L * 4 * 1024; const GAS float* conv_b = FIN(I_CONVB) + L * 1024;
    const GAS float* d_skip = FIN(I_DSKIP) + L * 8; const GAS float* ssm_g = FIN(I_SSMG) + L * 512;
    const GAS float* ACS = (const GAS float*)FWS(WS_ACS) + (size_t)F.b * SEQ * 8; const GAS float* DTV = (const GAS float*)FWS(WS_DTV) + (size_t)F.b * SEQ * 8;
    LAS unsigned char* Cm = F.lds + S3_CM; LAS unsigned char* Bm = F.lds + S3_BM; LAS unsigned char* Zt = F.lds + S3_Z;
    LAS float* dt_l = (LAS float*)(F.lds + S3_DT); LAS float* acs_l = (LAS float*)(F.lds + S3_ACS); LAS float* rss = (LAS float*)(F.lds + S3_RSS);
    const int wave = F.wave, unit = F.li, c = unit >> 1, g = unit & 1, m0 = c * 128;
    int tid = F.tid; asm volatile("" : "+v"(tid));
    int lane = tid & 63, q = lane & 31, hh = lane >> 5;
    const int bcg = tid & 31, bl0 = (tid >> 5) * 8, isC = bcg >> 4, bn0 = (bcg & 15) * 8, bcol = (isC ? CCM : CBM) + g * 128 + bn0;
    Raw8<8> br; ConvW8 bw;
    conv_load(br, PROJ, m0, c, bl0, bcol); convw_load(bw, conv_w + (bcol - CX), conv_b + (bcol - CX));
    const float dt_in = DTV[(size_t)(m0 + (tid & 127)) * 8 + 4 * g + (tid >> 7)], acs_in = ACS[(size_t)(m0 + (tid & 127)) * 8 + 4 * g + (tid >> 7)];
    __syncthreads();
    dt_l[tid] = dt_in; acs_l[tid] = acs_in * LOG2E;
#pragma unroll
    for (int r = 0; r < 8; ++r) { float o[8]; conv_row(br, bw, r, o);
        v4u pk; pk.x = pkbf(o[0], o[1]); pk.y = pkbf(o[2], o[3]); pk.z = pkbf(o[4], o[5]); pk.w = pkbf(o[6], o[7]);
        *(LAS v4u*)((isC ? Cm : Bm) + (bl0 + r) * SD_ROW + bn0 * 2) = pk; }
    v4u pw[4], zw[4]; Raw4<8> xr; ConvW4 xw;
    const int xcg = tid & 31, xl0 = (tid >> 5) * 8, xh = xcg >> 4, xp0 = (xcg & 15) * 4;
#define S3_D1_LOAD_PZ(hp_) do { \
        _Pragma("unroll") for (int k = 0; k < 4; ++k) { const int ch = tid + NTHREADS * k; \
            { const int hd = ch >> 10, rem = ch & 1023, p = rem >> 4, n8 = rem & 15; pw[k] = *(const GAS v4u*)(PREV + ((size_t)c * 8 + 4 * g + 2 * (hp_) + hd) * 8192 + p * 128 + n8 * 8); } \
            { const int l = ch >> 4, c8 = ch & 15; zw[k] = *(const GAS v4u*)(PROJ + (size_t)(m0 + l) * PP + CZ + (4 * g + 2 * (hp_)) * 64 + c8 * 8); } } } while (0)
#define S3_D1_LOAD_X(hp_) do { \
        const int col0 = CX + (4 * g + 2 * (hp_) + xh) * 64 + xp0; conv_load(xr, PROJ, m0, c, xl0, col0); convw_load(xw, conv_w + (col0 - CX), conv_b + (col0 - CX)); } while (0)
    S3_D1_LOAD_PZ(0); S3_D1_LOAD_X(0);
    LDS_WAIT(); __syncthreads();
    asm volatile("" : "+v"(tid)); lane = tid & 63; q = lane & 31; hh = lane >> 5;
    const int j = (wave < 4) ? (wave & 3) : 3 - (wave & 3), h2 = wave >> 2;
    f32x16 cbT[4]; bf16x8_t cf[8];
#pragma unroll
    for (int ks = 0; ks < 8; ++ks) cf[ks] = *(const LAS bf16x8_t*)(Cm + (32 * j + q) * SD_ROW + (16 * ks + 8 * hh) * 2);
#pragma unroll
    for (int i = 0; i < 4; ++i) { f32x16 acc = {};
        if (i <= j) {
#pragma unroll
            for (int ks = 0; ks < 8; ++ks) { const bf16x8_t bfr = *(const LAS bf16x8_t*)(Bm + (32 * i + q) * SD_ROW + (16 * ks + 8 * hh) * 2);
                acc = __builtin_amdgcn_mfma_f32_32x32x16_bf16(bfr, cf[ks], acc, 0, 0, 0); } }
        cbT[i] = acc; }
    unsigned vk[2][16];
#pragma unroll
    for (int hp = 0; hp < 2; ++hp) {
        if (hp == 1) S3_D1_LOAD_X(1);
        __syncthreads();
        {
          const int r = 2 * hp + xh;
          LAS unsigned char* T1 = F.lds + xh * S3_HIMG;
#pragma unroll
          for (int rr = 0; rr < 8; ++rr) { float o[4]; conv_row(xr, xw, rr, o); const int l = xl0 + rr; const float dtv = dt_l[r * 128 + l];
#pragma unroll
              for (int e = 0; e < 4; e += 2) { const unsigned w = pkbf(o[e] * dtv, o[e + 1] * dtv);
                  *(LAS unsigned short*)(T1 + (xp0 + e) * SD_XT + l * 2) = (unsigned short)(w & 0xffffu); *(LAS unsigned short*)(T1 + (xp0 + e + 1) * SD_XT + l * 2) = (unsigned short)(w >> 16); } }
#pragma unroll
          for (int k = 0; k < 4; ++k) { const int ch = tid + NTHREADS * k;
              { const int hd = ch >> 10, rem = ch & 1023, p = rem >> 4, n8 = rem & 15; *(LAS v4u*)(F.lds + hd * S3_HIMG + 64 * SD_XT + p * SD_ROW + n8 * 16) = pw[k]; }
              { const int l = ch >> 4, c8 = ch & 15; *(LAS v4u*)(Zt + l * SD_ROW + c8 * 16) = zw[k]; } } }
        LDS_WAIT(); __syncthreads();
        asm volatile("" : "+v"(tid)); lane = tid & 63; q = lane & 31; hh = lane >> 5;
        const int r = 2 * hp + h2, head = 4 * g + r;
        const LAS unsigned char* T1 = F.lds + h2 * S3_HIMG; const LAS unsigned char* P1 = T1 + 64 * SD_XT;
        f32x16 O[2] = {{}, {}};
#pragma unroll
        for (int ks = 0; ks < 8; ++ks)
#pragma unroll
            for (int pt = 0; pt < 2; ++pt) { const bf16x8_t af = *(const LAS bf16x8_t*)(P1 + (32 * pt + q) * SD_ROW + (16 * ks + 8 * hh) * 2);
                O[pt] = __builtin_amdgcn_mfma_f32_32x32x16_bf16(af, cf[ks], O[pt], 0, 0, 0); }
        const float acl = acs_l[r * 128 + 32 * j + q], diag = d_skip[head] * __builtin_amdgcn_rcpf(dt_l[r * 128 + 32 * j + q]);
        { const float ea = __builtin_amdgcn_exp2f(acl);
#pragma unroll
          for (int pt = 0; pt < 2; ++pt)
#pragma unroll
              for (int e = 0; e < 16; ++e) O[pt][e] *= ea; }
        const int qm = q - 4 * hh;
#pragma unroll
        for (int i = 0; i < 4; ++i) { if (i <= j) {
            float xv[16];
            const LAS float* ap = acs_l + r * 128 + 32 * i + 4 * hh;
            float av[16];
#pragma unroll
            for (int e = 0; e < 16; ++e) av[e] = ap[(e & 3) + 8 * (e >> 2)];
            if (i < j) {
#pragma unroll
                for (int e = 0; e < 16; ++e) xv[e] = cbT[i][e] * __builtin_amdgcn_exp2f(acl - av[e]);
            } else {
#pragma unroll
                for (int e = 0; e < 16; ++e) { const int t0 = (e & 3) + 8 * (e >> 2);
                    const float m01 = (t0 <= qm) ? 1.0f : 0.0f, dg = (t0 == qm) ? diag : 0.0f;
                    xv[e] = cbT[i][e] * __builtin_amdgcn_exp2f(fminf(acl - av[e], 0.f)) * m01 + dg; } }
#pragma unroll
            for (int s2 = 0; s2 < 2; ++s2) { v4u w; w.x = pkbf(xv[8 * s2 + 0], xv[8 * s2 + 1]); w.y = pkbf(xv[8 * s2 + 2], xv[8 * s2 + 3]); w.z = pkbf(xv[8 * s2 + 4], xv[8 * s2 + 5]); w.w = pkbf(xv[8 * s2 + 6], xv[8 * s2 + 7]);
                const bf16x8_t xf = __builtin_bit_cast(bf16x8_t, w);
#pragma unroll
                for (int pt = 0; pt < 2; ++pt) { const LAS unsigned char* ab = T1 + (32 * pt + q) * SD_XT + (32 * i + 16 * s2 + 4 * hh) * 2;
                    const v2u lo = *(const LAS v2u*)ab, hi2 = *(const LAS v2u*)(ab + 16); v4u aw; aw.x = lo.x; aw.y = lo.y; aw.z = hi2.x; aw.w = hi2.y;
                    O[pt] = __builtin_amdgcn_mfma_f32_32x32x16_bf16(__builtin_bit_cast(bf16x8_t, aw), xf, O[pt], 0, 0, 0); } } } }
        if (hp == 0) S3_D1_LOAD_PZ(1);
        float ss = 0.f;
#pragma unroll
        for (int pt = 0; pt < 2; ++pt)
#pragma unroll
            for (int g4 = 0; g4 < 4; ++g4) { const int p = 32 * pt + 8 * g4 + 4 * hh;
                const v2u zz = *(const LAS v2u*)(Zt + (32 * j + q) * SD_ROW + (64 * h2 + p) * 2);
                const float u0 = O[pt][4 * g4] * silu_fast(bflo(zz.x)), u1 = O[pt][4 * g4 + 1] * silu_fast(bfhi(zz.x)), u2 = O[pt][4 * g4 + 2] * silu_fast(bflo(zz.y)), u3 = O[pt][4 * g4 + 3] * silu_fast(bfhi(zz.y));
                ss += (u0 * u0 + u1 * u1) + (u2 * u2 + u3 * u3);
                vk[hp][pt * 8 + g4 * 2] = pkbf(u0, u1); vk[hp][pt * 8 + g4 * 2 + 1] = pkbf(u2, u3); }
        ss += shx(ss, 32, lane);
        if (hh == 0) rss[r * 128 + 32 * j + q] = ss;
    }
#undef S3_D1_LOAD_PZ
#undef S3_D1_LOAD_X
    LDS_WAIT(); __syncthreads();
    asm volatile("" : "+v"(tid)); lane = tid & 63; q = lane & 31; hh = lane >> 5;
    { const int l = 32 * j + q; const float tot = (rss[l] + rss[128 + l]) + (rss[256 + l] + rss[384 + l]);
      const float rn = __builtin_amdgcn_rsqf(tot * (1.0f / 256.0f) + EPS);
      LAS unsigned char* Ot = F.lds;
#pragma unroll
      for (int hp = 0; hp < 2; ++hp) { const int r = 2 * hp + h2, head = 4 * g + r;
#pragma unroll
          for (int pt = 0; pt < 2; ++pt)
#pragma unroll
              for (int g4 = 0; g4 < 4; ++g4) { const int p = 32 * pt + 8 * g4 + 4 * hh;
                  const f32x4 ng = *(const GAS f32x4*)(ssm_g + head * 64 + p);
                  const unsigned w0 = vk[hp][pt * 8 + g4 * 2], w1 = vk[hp][pt * 8 + g4 * 2 + 1];
                  v2u w; w.x = pkbf(bflo(w0) * rn * ng.x, bfhi(w0) * rn * ng.y); w.y = pkbf(bflo(w1) * rn * ng.z, bfhi(w1) * rn * ng.w);
                  *(LAS v2u*)(Ot + l * 528 + (r * 64 + p) * 2) = w; } } }
    LDS_WAIT(); __syncthreads();
    asm volatile("" : "+v"(tid));
#pragma unroll
    for (int k = 0; k < 8; ++k) { const int ch = tid + NTHREADS * k, l = ch >> 5, c8 = ch & 31;
        const v4u w = *(const LAS v4u*)(F.lds + l * 528 + c8 * 16);
        GAS bf16* orow = dummy ? (GAS bf16*)FB(BO_STATES) + (size_t)(m0 + l) * 512 : PROJ + (size_t)(m0 + l) * PP + CZ;
        *(GAS v4u*)(orow + g * 256 + c8 * 8) = w; }
}

__device__ __forceinline__ void ph_inproj(Frame& F, int L) {
    LAS float* rstd_tab = (LAS float*)(F.lds + RSTD_OFF);
    int li_ = F.li; asm volatile("" : "+s"(li_)); pg8::GroupOrder S; S.init(NPROJ, li_);
    const GAS f32x4* sp = (const GAS f32x4*)((const GAS float*)FWS(WS_SSQ) + ((size_t)F.b * SEQ + (li_ & 7) * 256 + (F.tid >> 1)) * 16 + (F.tid & 1) * 8);
    pg8::Gemm g{(const GAS bf16*)FWS(WS_XB) + (size_t)F.b * SEQ * D, (const GAS bf16*)FWS(WS_WIN) + (size_t)L * NPROJ * D, SEQ, NPROJ, D, D};
    pg8::EpiProj E{(GAS bf16*)FB(BO_PROJ), (GAS float*)FWS(WS_DTRAW) + (size_t)F.b * SEQ * 8, rstd_tab, sp[0], sp[1]};
    pg8::gemm_phase<pg8::EpiProj, pg8::GroupOrder, true, true>(F.lds + RING_OFF, g, S, E);
}
__device__ __forceinline__ void ph_outproj(Frame& F, int L, bool dummy = false) {
    int li_ = F.li; asm volatile("" : "+s"(li_)); pg8::GroupOrder S; S.init(D, li_);
    pg8::Gemm g{(const GAS bf16*)FB(BO_PROJ), (const GAS bf16*)FWS(WS_WOUT) + (size_t)L * D * D, SEQ, D, D, PP};
    GAS bf16* XBb = (GAS bf16*)FWS(WS_XB) + (size_t)F.b * SEQ * D;
    pg8::EpiRes<false> E{XBb, (GAS float*)FWS(WS_SSQ) + (size_t)F.b * SEQ * 16, nullptr, dummy ? (GAS bf16*)FB(BO_YPART) : XBb};
    pg8::gemm_phase<pg8::EpiRes<false>, pg8::GroupOrder, false, true>(F.lds + RING_OFF, g, S, E);
}
__device__ __forceinline__ void ph_up(Frame& F, int L) {
    LAS float* rstd_tab = (LAS float*)(F.lds + RSTD_OFF);
    int li_ = F.li; asm volatile("" : "+s"(li_)); pg8::GroupOrder S; S.init(FF, li_);
    const GAS f32x4* sp = (const GAS f32x4*)((const GAS float*)FWS(WS_SSQ) + ((size_t)F.b * SEQ + (li_ & 7) * 256 + (F.tid >> 1)) * 16 + (F.tid & 1) * 8);
    pg8::Gemm g{(const GAS bf16*)FWS(WS_XB) + (size_t)F.b * SEQ * D, (const GAS bf16*)FWS(WS_WUP) + (size_t)L * FF * D, SEQ, FF, D, D};
    pg8::EpiUp E{(GAS bf16*)FB(BO_HID), FF, rstd_tab, sp[0], sp[1]};
    pg8::gemm_phase<pg8::EpiUp, pg8::GroupOrder, true, true>(F.lds + RING_OFF, g, S, E);
}
__device__ __forceinline__ void ph_down(Frame& F, int L, bool dummy = false) {
    int li_ = F.li; asm volatile("" : "+s"(li_)); pg8::GroupOrder S; S.init(D, li_);
    pg8::Gemm g{(const GAS bf16*)FB(BO_HID), (const GAS bf16*)FWS(WS_WDOWN) + (size_t)L * D * FF, SEQ, D, FF, FF};
    GAS bf16* XBb = (GAS bf16*)FWS(WS_XB) + (size_t)F.b * SEQ * D; GAS float* SSQb = (GAS float*)FWS(WS_SSQ) + (size_t)F.b * SEQ * 16;
    if (L == DEPTH - 1 && !dummy) { pg8::EpiRes<true> E{XBb, SSQb, (GAS float*)ptr_at(F, I_OUT) + (size_t)F.b * SEQ * D, XBb};
        pg8::gemm_phase<pg8::EpiRes<true>, pg8::GroupOrder, false, true>(F.lds + RING_OFF, g, S, E); }
    else { pg8::EpiRes<false> E{XBb, SSQb, nullptr, dummy ? (GAS bf16*)FB(16 * MiB) : XBb};
        pg8::gemm_phase<pg8::EpiRes<false>, pg8::GroupOrder, false, true>(F.lds + RING_OFF, g, S, E); }
}

#ifndef PROBE_REP
#define PROBE_REP 0
#endif
struct Args { const float* in[17]; float* out; unsigned char* ws; int pad0, pad1; };
__global__ void __launch_bounds__(NTHREADS, 2) fwd(Args args) {
    extern __shared__ __attribute__((aligned(16))) unsigned char lds[];
    Frame F;
    F.lds = (LAS unsigned char*)lds;
    F.tid = threadIdx.x; F.lane = F.tid & 63; F.wave = __builtin_amdgcn_readfirstlane(F.tid >> 6); F.bid = blockIdx.x; F.G = gridDim.x; F.b = F.bid & 7; F.li = F.bid >> 3;
    for (int u = F.tid; u < (LDS_BYTES - LDSCTL_OFF) / 4; u += NTHREADS) ((LAS unsigned*)(F.lds + LDSCTL_OFF))[u] = 0u;
    __syncthreads();
    if (F.tid < I_NPTR) { const unsigned long long p = F.tid < 17 ? (unsigned long long)args.in[F.tid < 17 ? F.tid : 0] : (F.tid == I_OUT ? (unsigned long long)args.out : (unsigned long long)args.ws);
        LAS unsigned* t = (LAS unsigned*)(F.lds + PTR_OFF) + 2 * F.tid; t[0] = (unsigned)p; t[1] = (unsigned)(p >> 32); }
    LDS_WAIT(); __syncthreads();
    if (F.G != GRID) return;
#define GBAR_OBJ() XcdBarrier{(unsigned*)(unsigned char*)FWS(WS_CTL) + CW_BAR, xb_xcc_id(), (unsigned)GRID, (volatile LAS unsigned*)(F.lds + MISC_OFF) + 8}
#define GRP_OBJ()  XcdBarrier{(unsigned*)(unsigned char*)FWS(WS_CTL) + CW_GRP + (blockIdx.x & 7) * GRP_BAR_STRIDE, xb_xcc_id(), (unsigned)GRP, (volatile LAS unsigned*)(F.lds + MISC_OFF) + 12}
    (void)xcd_barrier_post((unsigned*)(unsigned char*)FWS(WS_CTL) + CW_BAR, (volatile LAS unsigned*)(F.lds + MISC_OFF) + 8, GRID);
    (void)xcd_barrier_post((unsigned*)(unsigned char*)FWS(WS_CTL) + CW_GRP + (blockIdx.x & 7) * GRP_BAR_STRIDE, (volatile LAS unsigned*)(F.lds + MISC_OFF) + 12, GRP);
#define RELAUNDER() do { int t_ = threadIdx.x; asm volatile("" : "+v"(t_)); F.tid = t_; F.lane = t_ & 63; F.wave = __builtin_amdgcn_readfirstlane(t_ >> 6); \
    int b_ = blockIdx.x; asm volatile("" : "+s"(b_)); F.bid = b_; F.b = b_ & 7; F.li = b_ >> 3; } while (0)
#define GRP_BAR() do { const XcdBarrier gb_ = GRP_OBJ(); xcd_barrier(gb_); } while (0)
#define GRID_BAR() do { const XcdBarrier gb_ = GBAR_OBJ(); xcd_barrier(gb_); } while (0)

    p0_prologue(F);
    if (PROBE_REP == 1) { GRID_BAR(); RELAUNDER(); p0_prologue(F); }
    GRID_BAR();
    for (int L = 0; L < DEPTH; ++L) {
        RELAUNDER(); ph_inproj(F, L); if (PROBE_REP == 2) { GRP_BAR(); RELAUNDER(); ph_inproj(F, L); }
        if (F.li >= 16) { RELAUNDER(); convert_rest(F, L); }
        GRP_BAR();
        RELAUNDER(); if (PROBE_REP == 20) { attn_fast(F, L, true); GRP_BAR(); RELAUNDER(); }
        if (PROBE_REP == 25) {
#pragma unroll 1
            for (int rep = 0; rep < 2; ++rep) { attn_fast(F, L, rep == 0); if (rep == 0) { GRP_BAR(); RELAUNDER(); } } }
        else attn_fast(F, L);
        ssd_states(F, L); if (PROBE_REP == 21) { GRP_BAR(); RELAUNDER(); ssd_states(F, L); } GRP_BAR();
        RELAUNDER(); ssd_scan(F, L); if (PROBE_REP == 22) { GRP_BAR(); RELAUNDER(); ssd_scan(F, L); } if (PROBE_REP == 24) { for (int k = 0; k < 8; ++k) GRP_BAR(); } GRP_BAR();
        RELAUNDER(); if (PROBE_REP == 23) { ssd_out(F, L, true); GRP_BAR(); RELAUNDER(); } ssd_out(F, L); GRP_BAR();
        RELAUNDER(); if (L == 0) wait_weights(F, 0); if (PROBE_REP == 30) { ph_outproj(F, L, true); GRP_BAR(); RELAUNDER(); } ph_outproj(F, L); GRP_BAR();
        RELAUNDER(); if (L == 1) wait_weights(F, 1); ph_up(F, L); if (PROBE_REP == 5) { GRP_BAR(); RELAUNDER(); ph_up(F, L); } GRP_BAR();
        RELAUNDER(); if (PROBE_REP == 31) { ph_down(F, L, true); GRP_BAR(); RELAUNDER(); } ph_down(F, L); if (L + 1 < DEPTH) GRP_BAR();
    }
}

extern "C" void kernel_launch(void* const* d_in, const int* in_sizes, int n_in, void* d_out, int out_size, void* d_ws, size_t ws_size, hipStream_t stream) {
    static int grid = 0;
    if (grid == 0) {
        if (n_in != 17 || in_sizes[0] != M * D || out_size != M * D || ws_size < WS_END) { fprintf(stderr, "kernel_launch: unexpected shapes (n_in %d, in0 %d, out %d, ws %zu)\n", n_in, n_in > 0 ? in_sizes[0] : -1, out_size, ws_size); grid = -1; return; }
        int dev = 0, cus = 0, per_cu = 0;
        if (hipGetDevice(&dev) != hipSuccess || hipDeviceGetAttribute(&cus, hipDeviceAttributeMultiprocessorCount, dev) != hipSuccess) { grid = -1; return; }
        if (hipFuncSetAttribute((const void*)fwd, hipFuncAttributeMaxDynamicSharedMemorySize, LDS_BYTES) != hipSuccess) { fprintf(stderr, "kernel_launch: hipFuncSetAttribute failed\n"); grid = -1; return; }
        if (hipOccupancyMaxActiveBlocksPerMultiprocessor(&per_cu, (const void*)fwd, NTHREADS, LDS_BYTES) != hipSuccess || per_cu < 1) { fprintf(stderr, "kernel_launch: occupancy query says %d\n", per_cu); per_cu = 0; }
        (void)hipGetLastError();
        if (cus * per_cu < GRID) { fprintf(stderr, "kernel_launch: this kernel needs %d co-resident workgroups (one per CU of a 256-CU device); the device admits %d x %d; nothing launched\n", GRID, cus, per_cu); grid = -1; return; }
        grid = GRID;
    }
    if (grid < 0) return;
    (void)hipMemsetAsync((char*)d_ws + WS_CTL, 0, CTL_ZERO_BYTES, stream);
    Args a{};
    for (int i = 0; i < 17; ++i) a.in[i] = (const float*)d_in[i];
    a.out = (float*)d_out; a.ws = (unsigned char*)d_ws;
    void* kargs[] = {&a};
    hipError_t e = hipLaunchCooperativeKernel((const void*)fwd, dim3(grid), dim3(NTHREADS), kargs, LDS_BYTES, stream);
    if (e != hipSuccess) fprintf(stderr, "kernel_launch: cooperative launch failed: %s (grid %d)\n", hipGetErrorString(e), grid);
}
```

```cpp
#include <hip/hip_runtime.h>
#include <cstdio>
#include <cstdint>
#define PROBE_REP 0


namespace pg8 {
#define PG8_LAS __attribute__((address_space(3)))
#define PG8_GAS __attribute__((address_space(1)))
typedef unsigned short bf16_t;
typedef short bf16x8 __attribute__((ext_vector_type(8)));
typedef float f32x4 __attribute__((ext_vector_type(4)));
typedef unsigned u32x4 __attribute__((ext_vector_type(4)));
constexpr int BM = 256, BK = 64, HALF = 128, HTB = HALF * BK * 2  , STAGE_BYTES = 8 * HTB, NXCD = 8, WGM = 8;

__host__ __device__ __forceinline__ int lds_byte(int r, int c) { const int st = (r >> 4) * 2 + (c >> 5), rr = r & 15, cc = c & 31, ob = rr * 64 + cc * 2; return st * 1024 + (ob ^ (((ob >> 9) & 1) << 5)); }
__host__ __device__ __forceinline__ void stage_rc(int b, int& R, int& C) { const int st = b / 1024, sb = b % 1024, swz = sb ^ (((sb >> 9) & 1) << 5); R = (st >> 1) * 16 + swz / 64; C = (st & 1) * 32 + (swz % 64) / 2; }
__host__ __device__ __forceinline__ int perm32(int rho) { const int n = rho >> 4, i = rho & 15; return 8 * (i >> 2) + 4 * n + (i & 3); }

struct Unit { int pm, pn; };
struct Gemm { const PG8_GAS bf16_t* A; const PG8_GAS bf16_t* Bt; int M, N, K, lda; };

struct StaticOrder {
    int nM, nN, nwg, G, c;
    __host__ __device__ void init(int M, int N, int G_, int c_) { nM = M / BM; nN = N / BM; nwg = nM * nN; G = G_; c = c_; }
    __host__ __device__ bool next(int i, Unit& u) const {
        const long L = (long)i * G + c; if (L >= nwg) return false;
        int wgid = (int)L; { const int q = nwg / NXCD, r = nwg % NXCD, xcd = wgid % NXCD, off = wgid / NXCD; wgid = (xcd < r ? xcd * (q + 1) : r * (q + 1) + (xcd - r) * q) + off; }
        const int nig = WGM * nN, gid = wgid / nig, fm = gid * WGM, gsz = (nM - fm) < WGM ? (nM - fm) : WGM;
        u.pm = fm + ((wgid % nig) % gsz); u.pn = (wgid % nig) / gsz; return true;
    }
    __device__ __forceinline__ void a_ready(const Unit&) const {}
    __device__ __forceinline__ void done(const Unit&) const {}
};

struct GroupOrder {
    int nN, li;
    __host__ __device__ void init(int N, int li_) { nN = N / BM; li = li_; }
    __host__ __device__ bool next(int i, Unit& u) const { const int T = i * 32 + li; if (T >= 8 * nN) return false; u.pm = T & 7; u.pn = T >> 3; return true; }
    __device__ __forceinline__ void a_ready(const Unit&) const {}
    __device__ __forceinline__ void done(const Unit&) const {}
};

__device__ __forceinline__ float shx(float v, int k, int lane) { return __builtin_bit_cast(float, __builtin_amdgcn_ds_bpermute((lane ^ k) << 2, __builtin_bit_cast(int, v))); }
typedef float f32x2_t __attribute__((ext_vector_type(2))); typedef __bf16 bf16x2_t __attribute__((ext_vector_type(2)));
__device__ __forceinline__ unsigned cvt_pk_bf16(float lo, float hi) { f32x2_t v = {lo, hi}; bf16x2_t b = __builtin_convertvector(v, bf16x2_t); return __builtin_bit_cast(unsigned, b); }

constexpr int PROJ_PITCH = 2304, DT_TILE = 9;
struct EpiProj {
    static constexpr bool PERM = true, AFTER_DRAIN = false, ACC_INIT = false, PRE_HOOK = true;
    PG8_GAS bf16_t* O; PG8_GAS float* dtraw; PG8_LAS float* rstd; f32x4 pa, pb;
    __device__ __forceinline__ void pre(int tid) const {
        float s = (pa[0] + pa[1]) + (pa[2] + pa[3]) + (pb[0] + pb[1]) + (pb[2] + pb[3]);
        s += shx(s, 1, tid & 63);
        if ((tid & 1) == 0) rstd[tid >> 1] = 1.0f / sqrtf(s * (1.0f / 1024.0f) + 1e-6f);
    }
    __device__ __forceinline__ void operator()(const f32x4 (&acc)[2][2][4][2], const Unit& u, int ui, int wr, int wc, int fr, int fq) const {
        int rt0 = wr * 64 + fr; asm volatile("" : "+v"(rt0));
        if (u.pn == DT_TILE) {
            if (wc == 0 && fq == 0) {
#pragma unroll
                for (int ai = 0; ai < 2; ++ai)
#pragma unroll
                    for (int m = 0; m < 4; ++m) { const int rt = ai * HALF + rt0 + m * 16; const float rs = rstd[rt]; PG8_GAS float* p = dtraw + (size_t)(u.pm * BM + rt) * 8;
                        *(PG8_GAS f32x4*)p = acc[ai][0][m][0] * rs; *(PG8_GAS f32x4*)(p + 4) = acc[ai][0][m][1] * rs; }
            }
            return;
        }
        const int col0 = u.pn * BM + wc * 32 + 8 * fq;
#pragma unroll
        for (int ai = 0; ai < 2; ++ai)
#pragma unroll
            for (int m = 0; m < 4; ++m) { const int rt = ai * HALF + rt0 + m * 16; const float rs = rstd[rt]; PG8_GAS bf16_t* rowp = O + (size_t)(u.pm * BM + rt) * PROJ_PITCH + col0;
#pragma unroll
                for (int bj = 0; bj < 2; ++bj) { const f32x4 v0 = acc[ai][bj][m][0] * rs, v1 = acc[ai][bj][m][1] * rs;
                    u32x4 w; w.x = cvt_pk_bf16(v0[0], v0[1]); w.y = cvt_pk_bf16(v0[2], v0[3]); w.z = cvt_pk_bf16(v1[0], v1[1]); w.w = cvt_pk_bf16(v1[2], v1[3]);
                    *(PG8_GAS u32x4*)(rowp + bj * HALF) = w; } }
    }
};
struct EpiUp {
    static constexpr bool PERM = true, AFTER_DRAIN = false, ACC_INIT = false, PRE_HOOK = true;
    PG8_GAS bf16_t* O; int ldc; PG8_LAS float* rstd; f32x4 pa, pb;
    __device__ __forceinline__ void pre(int tid) const {
        float s = (pa[0] + pa[1]) + (pa[2] + pa[3]) + (pb[0] + pb[1]) + (pb[2] + pb[3]);
        s += shx(s, 1, tid & 63);
        if ((tid & 1) == 0) rstd[tid >> 1] = 1.0f / sqrtf(s * (1.0f / 1024.0f) + 1e-6f);
    }
    __device__ __forceinline__ void operator()(const f32x4 (&acc)[2][2][4][2], const Unit& u, int ui, int wr, int wc, int fr, int fq) const {
        int rt0 = wr * 64 + fr; asm volatile("" : "+v"(rt0)); const int col0 = u.pn * BM + wc * 32 + 8 * fq;
#pragma unroll
        for (int ai = 0; ai < 2; ++ai)
#pragma unroll
            for (int m = 0; m < 4; ++m) { const int rt = ai * HALF + rt0 + m * 16; const float rs = rstd[rt]; PG8_GAS bf16_t* rowp = O + (size_t)(u.pm * BM + rt) * ldc + col0;
#pragma unroll
                for (int bj = 0; bj < 2; ++bj) { f32x4 v0 = acc[ai][bj][m][0] * rs, v1 = acc[ai][bj][m][1] * rs;
#pragma unroll
                    for (int e = 0; e < 4; ++e) { const float a = fmaxf(v0[e], 0.f), b = fmaxf(v1[e], 0.f); v0[e] = a * a; v1[e] = b * b; }
                    u32x4 w; w.x = cvt_pk_bf16(v0[0], v0[1]); w.y = cvt_pk_bf16(v0[2], v0[3]); w.z = cvt_pk_bf16(v1[0], v1[1]); w.w = cvt_pk_bf16(v1[2], v1[3]);
                    *(PG8_GAS u32x4*)(rowp + bj * HALF) = w; } }
    }
};
template <bool FINAL> struct EpiRes {
    static constexpr bool PERM = true, AFTER_DRAIN = false, ACC_INIT = true, PRE_HOOK = false;
    PG8_GAS bf16_t* xb; PG8_GAS float* ssq; PG8_GAS float* out; PG8_GAS bf16_t* xdst;
    __device__ __forceinline__ void init(f32x4 (&acc)[2][2][4][2], const Unit& u, int wr, int wc, int fr, int fq) const {
        const int rt0 = wr * 64 + fr, col0 = u.pn * BM + wc * 32 + 8 * fq;
#pragma unroll
        for (int ai = 0; ai < 2; ++ai)
#pragma unroll
            for (int m = 0; m < 4; ++m) { const int row = u.pm * BM + ai * HALF + rt0 + m * 16; const size_t off = (size_t)row * 1024 + col0;
#pragma unroll
                for (int bj = 0; bj < 2; ++bj) { const u32x4 rw = *(const PG8_GAS u32x4*)(xb + off + bj * HALF);
                    acc[ai][bj][m][0] = (f32x4){__uint_as_float(rw.x << 16), __uint_as_float(rw.x & 0xffff0000u), __uint_as_float(rw.y << 16), __uint_as_float(rw.y & 0xffff0000u)};
                    acc[ai][bj][m][1] = (f32x4){__uint_as_float(rw.z << 16), __uint_as_float(rw.z & 0xffff0000u), __uint_as_float(rw.w << 16), __uint_as_float(rw.w & 0xffff0000u)}; } }
    }
    __device__ __forceinline__ void operator()(const f32x4 (&acc)[2][2][4][2], const Unit& u, int ui, int wr, int wc, int fr, int fq) const {
        int rt0 = wr * 64 + fr; asm volatile("" : "+v"(rt0)); const int col0 = u.pn * BM + wc * 32 + 8 * fq;
#pragma unroll
        for (int ai = 0; ai < 2; ++ai)
#pragma unroll
            for (int m = 0; m < 4; ++m) { const int row = u.pm * BM + ai * HALF + rt0 + m * 16; const size_t off = (size_t)row * 1024 + col0; float s = 0.f;
#pragma unroll
                for (int bj = 0; bj < 2; ++bj) { const f32x4 v0 = acc[ai][bj][m][0], v1 = acc[ai][bj][m][1];
                    if (FINAL) { *(PG8_GAS f32x4*)(out + off + bj * HALF) = v0; *(PG8_GAS f32x4*)(out + off + bj * HALF + 4) = v1; }
                    else { u32x4 w; w.x = cvt_pk_bf16(v0[0], v0[1]); w.y = cvt_pk_bf16(v0[2], v0[3]); w.z = cvt_pk_bf16(v1[0], v1[1]); w.w = cvt_pk_bf16(v1[2], v1[3]);
                        *(PG8_GAS u32x4*)(xdst + off + bj * HALF) = w;
                        s += (v0[0] * v0[0] + v0[1] * v0[1]) + (v0[2] * v0[2] + v0[3] * v0[3]) + (v1[0] * v1[0] + v1[1] * v1[1]) + (v1[2] * v1[2] + v1[3] * v1[3]); } }
                if (!FINAL) { const int ln = fq * 16 + fr; s += shx(s, 16, ln); s += shx(s, 32, ln);
                    if (fq == 0) ssq[(size_t)row * 16 + u.pn * 4 + wc] = s; } }
    }
};

template <class Epi, class Sched, bool ALIGN_EPI = false, bool SP2 = false>
__device__ __forceinline__ void gemm_phase(PG8_LAS unsigned char* lds, const Gemm g, const Sched& S, const Epi& E) {
    int tid_ = threadIdx.x; asm volatile("" : "+v"(tid_));
    const int tid = tid_, wid = __builtin_amdgcn_readfirstlane(tid >> 6), lane = tid & 63, wr = wid >> 2, wc = wid & 3, fr = lane & 15, fq = lane >> 4;
    const int K = g.K, nt = K / BK;
    unsigned voffA[2], voffB[2];
#pragma unroll
    for (int i = 0; i < 2; ++i) { int R, C; stage_rc(tid * 16 + i * 8192, R, C); const int Rb = Epi::PERM ? ((R & ~31) + perm32(R & 31)) : R;
        voffA[i] = (unsigned)(R * g.lda + C) * 2u; voffB[i] = (unsigned)(Rb * K + C) * 2u; }
    const size_t kstep = (size_t)(BK * 2);
    const size_t hstepA = (size_t)HALF * g.lda * 2, hstepB = (size_t)HALF * K * 2;
    const size_t tstepA = 2 * hstepA, tstepB = 2 * hstepB;
    const unsigned ldsw = (unsigned)wid * 1024u;
    const int aoff = lds_byte(wr * 64 + fr, fq * 8), boff = lds_byte(wc * 32 + fr, fq * 8);
#define PG8_SA(b, h) (((b) * 2 + (h)) * HTB)
#define PG8_SB(b, h) ((4 + (b) * 2 + (h)) * HTB)
#define PG8_STAGE(bufoff, gbase, voff) do { _Pragma("unroll") for (int _i = 0; _i < 2; ++_i) \
        __builtin_amdgcn_global_load_lds((const unsigned*)((const char*)(gbase) + (voff)[_i]), (PG8_LAS unsigned*)(lds + (bufoff) + ldsw + _i * 8192), 16, 0, 0); } while (0)
#define PG8_LDA(dst, b, h) do { _Pragma("unroll") for (int m = 0; m < 4; ++m) _Pragma("unroll") for (int k = 0; k < 2; ++k) dst[m][k] = *(const PG8_LAS bf16x8*)(lds + PG8_SA(b, h) + aoff + m * 2048 + k * 1024); } while (0)
#define PG8_LDB(dst, b, h) do { _Pragma("unroll") for (int n = 0; n < 2; ++n) _Pragma("unroll") for (int k = 0; k < 2; ++k) dst[n][k] = *(const PG8_LAS bf16x8*)(lds + PG8_SB(b, h) + boff + n * 2048 + k * 1024); } while (0)
#define PG8_MMA(ai, bj, At, Bt) do { __builtin_amdgcn_s_setprio(1); _Pragma("unroll") for (int m = 0; m < 4; ++m) _Pragma("unroll") for (int n = 0; n < 2; ++n) _Pragma("unroll") for (int k = 0; k < 2; ++k) \
        acc[ai][bj][m][n] = __builtin_amdgcn_mfma_f32_16x16x32_bf16(Bt[n][k], At[m][k], acc[ai][bj][m][n], 0, 0, 0); __builtin_amdgcn_s_setprio(0); } while (0)
#define PG8_WAIT_V(n) asm volatile("s_waitcnt vmcnt(" #n ")" ::: "memory")
#define PG8_WAIT_L(n) asm volatile("s_waitcnt lgkmcnt(" #n ")" ::: "memory")
#define PG8_BAR __builtin_amdgcn_s_barrier()
#define PG8_SCHED __builtin_amdgcn_sched_barrier(0)
    Unit cur, nxt; int ui = 0;
    if (!S.next(0, cur)) return;
    f32x4 acc[2][2][4][2];
#pragma unroll
    for (int a = 0; a < 2; ++a)
#pragma unroll
        for (int b = 0; b < 2; ++b)
#pragma unroll
            for (int m = 0; m < 4; ++m)
#pragma unroll
                for (int n = 0; n < 2; ++n) acc[a][b][m][n] = (f32x4){0.f, 0.f, 0.f, 0.f};
    if constexpr (Epi::ACC_INIT) E.init(acc, cur, wr, wc, fr, fq);
    bf16x8 At[4][2], B0[2][2], B1[2][2];
    const char* cA = (const char*)g.A + (size_t)cur.pm * tstepA; const char* cB = (const char*)g.Bt + (size_t)cur.pn * tstepB;
    S.a_ready(cur);
    if constexpr (SP2) {
        PG8_STAGE(PG8_SB(0, 0), cB, voffB); PG8_STAGE(PG8_SB(0, 1), cB + hstepB, voffB); PG8_STAGE(PG8_SA(0, 0), cA, voffA); PG8_STAGE(PG8_SA(0, 1), cA + hstepA, voffA);
        if constexpr (Epi::PRE_HOOK) E.pre(tid);
        if (wr == 1) PG8_BAR;
        PG8_WAIT_V(2); PG8_BAR;
        PG8_STAGE(PG8_SB(1, 0), cB + kstep, voffB); PG8_STAGE(PG8_SA(1, 0), cA + kstep, voffA); PG8_STAGE(PG8_SB(1, 1), cB + hstepB + kstep, voffB);
        PG8_WAIT_V(6); PG8_BAR;
    } else {
        PG8_STAGE(PG8_SB(0, 0), cB, voffB); PG8_STAGE(PG8_SA(0, 0), cA, voffA); PG8_STAGE(PG8_SB(0, 1), cB + hstepB, voffB); PG8_STAGE(PG8_SA(0, 1), cA + hstepA, voffA);
        if (wr == 1) PG8_BAR;
        PG8_WAIT_V(4); PG8_BAR;
        PG8_STAGE(PG8_SB(1, 0), cB + kstep, voffB); PG8_STAGE(PG8_SA(1, 0), cA + kstep, voffA); PG8_STAGE(PG8_SB(1, 1), cB + hstepB + kstep, voffB);
        PG8_WAIT_V(6); PG8_BAR;
    }
    for (;;) {
        const bool has_next = S.next(ui + 1, nxt);
        const char* nA = has_next ? (const char*)g.A + (size_t)nxt.pm * tstepA : cA; const char* nB = has_next ? (const char*)g.Bt + (size_t)nxt.pn * tstepB : cB;
        for (int t = 0; t < nt; t += 2) {
            const bool last = (t == nt - 2);
            const char* a1 = cA + (size_t)(t + 1) * kstep;
            const char* a2 = last ? nA : cA + (size_t)(t + 2) * kstep; const char* b2 = last ? nB : cB + (size_t)(t + 2) * kstep;
            const char* a3 = a2 + kstep; const char* b3 = b2 + kstep;
            if (last && has_next) S.a_ready(nxt);
            if constexpr (SP2) {
            PG8_LDB(B0, 0, 0); PG8_LDB(B1, 0, 1); PG8_SCHED; PG8_LDA(At, 0, 0); PG8_STAGE(PG8_SA(1, 1), a1 + hstepA, voffA);
            PG8_WAIT_V(8); PG8_WAIT_L(0); PG8_BAR; PG8_MMA(0, 0, At, B0); PG8_MMA(0, 1, At, B1); PG8_BAR; PG8_SCHED;
            PG8_LDA(At, 0, 1); PG8_STAGE(PG8_SB(0, 0), b2, voffB); PG8_STAGE(PG8_SB(0, 1), b2 + hstepB, voffB); PG8_STAGE(PG8_SA(0, 0), a2, voffA);
            PG8_WAIT_V(8); PG8_WAIT_L(0); PG8_BAR; PG8_MMA(1, 0, At, B0); PG8_MMA(1, 1, At, B1); PG8_BAR; PG8_SCHED;
            PG8_LDB(B0, 1, 0); PG8_LDB(B1, 1, 1); PG8_SCHED; PG8_LDA(At, 1, 0); PG8_STAGE(PG8_SA(0, 1), a2 + hstepA, voffA);
            PG8_WAIT_V(8); PG8_WAIT_L(0); PG8_BAR; PG8_MMA(0, 0, At, B0); PG8_MMA(0, 1, At, B1); PG8_BAR; PG8_SCHED;
            PG8_LDA(At, 1, 1); PG8_STAGE(PG8_SB(1, 0), b3, voffB); PG8_STAGE(PG8_SB(1, 1), b3 + hstepB, voffB); PG8_STAGE(PG8_SA(1, 0), a3, voffA);
            PG8_WAIT_V(8); PG8_WAIT_L(0); PG8_BAR; PG8_MMA(1, 0, At, B0); PG8_MMA(1, 1, At, B1); PG8_BAR; PG8_SCHED;
            } else {
            PG8_LDB(B0, 0, 0); PG8_SCHED; PG8_LDA(At, 0, 0); PG8_STAGE(PG8_SA(1, 1), a1 + hstepA, voffA);
            PG8_WAIT_L(8); PG8_BAR; PG8_WAIT_L(0); PG8_MMA(0, 0, At, B0); PG8_BAR; PG8_SCHED;
            PG8_LDB(B1, 0, 1); PG8_STAGE(PG8_SB(0, 0), b2, voffB);
            PG8_BAR; PG8_WAIT_L(0); PG8_MMA(0, 1, At, B1); PG8_BAR;
            PG8_LDA(At, 0, 1); PG8_STAGE(PG8_SA(0, 0), a2, voffA);
            PG8_BAR; PG8_WAIT_L(0); PG8_MMA(1, 0, At, B0); PG8_BAR; PG8_SCHED;
            PG8_STAGE(PG8_SB(0, 1), b2 + hstepB, voffB);
            PG8_WAIT_V(6); PG8_BAR; PG8_MMA(1, 1, At, B1); PG8_BAR;
            PG8_LDB(B0, 1, 0); PG8_SCHED; PG8_LDA(At, 1, 0); PG8_STAGE(PG8_SA(0, 1), a2 + hstepA, voffA);
            PG8_WAIT_L(8); PG8_BAR; PG8_WAIT_L(0); PG8_MMA(0, 0, At, B0); PG8_BAR; PG8_SCHED;
            PG8_LDB(B1, 1, 1); PG8_STAGE(PG8_SB(1, 0), b3, voffB);
            PG8_BAR; PG8_WAIT_L(0); PG8_MMA(0, 1, At, B1); PG8_BAR;
            PG8_LDA(At, 1, 1); PG8_STAGE(PG8_SA(1, 0), a3, voffA);
            PG8_BAR; PG8_WAIT_L(0); PG8_MMA(1, 0, At, B0); PG8_BAR; PG8_SCHED;
            PG8_STAGE(PG8_SB(1, 1), b3 + hstepB, voffB);
            PG8_WAIT_V(6); PG8_BAR; PG8_MMA(1, 1, At, B1); PG8_BAR;
            }
        }
        if constexpr (ALIGN_EPI) { if (wr == 0) PG8_BAR; }
        if constexpr (!Epi::AFTER_DRAIN) { E(acc, cur, ui, wr, wc, fr, fq); S.done(cur); }
        if (!has_next) break;
#pragma unroll
        for (int a = 0; a < 2; ++a)
#pragma unroll
            for (int b = 0; b < 2; ++b)
#pragma unroll
                for (int m = 0; m < 4; ++m)
#pragma unroll
                    for (int n = 0; n < 2; ++n) acc[a][b][m][n] = (f32x4){0.f, 0.f, 0.f, 0.f};
        cur = nxt; cA = nA; cB = nB; ++ui;
        if constexpr (ALIGN_EPI) { if (wr == 1) PG8_BAR; }
    }
    PG8_WAIT_V(0);
    if constexpr (!ALIGN_EPI) { if (wr == 0) PG8_BAR; }
    PG8_BAR;

#undef PG8_SA
#undef PG8_SB
#undef PG8_STAGE
#undef PG8_LDA
#undef PG8_LDB
#undef PG8_MMA
#undef PG8_WAIT_V
#undef PG8_WAIT_L
#undef PG8_BAR
#undef PG8_SCHED
}
}

constexpr int NWAVES = 8, NTHREADS = NWAVES * 64;
constexpr int BATCH = 8, SEQ = 2048, D = 1024, M = BATCH * SEQ, FF = 4096, DEPTH = 2;
constexpr int D_IN = 2312, NPROJ = 2560, PP = pg8::PROJ_PITCH;
constexpr int CQ = 0, CZ = 512, CK = 1024, CV = 1152, CX = 1280, CBM = 1792, CCM = 2048;
constexpr float EPS = 1e-6f;
constexpr int GRID = 256, NGRP = 8, GRP = GRID / NGRP;

constexpr size_t MiB = 1u << 20;
constexpr size_t WS_CTL = 0, CTL_ZERO_BYTES = 1 * MiB;
constexpr size_t WS_SSQ = 1 * MiB;
constexpr size_t WS_DTRAW = 2 * MiB;
constexpr size_t WS_ACS = 2 * MiB + 512 * 1024, WS_CHDEC = 3 * MiB;
constexpr size_t WS_WIN = 4 * MiB, WS_WOUT = 14 * MiB, WS_WUP = 18 * MiB, WS_WDOWN = 34 * MiB;
constexpr size_t WS_XB = 50 * MiB;
constexpr size_t WS_BATCH0 = 82 * MiB, BATCH_STRIDE = 20 * MiB;
constexpr size_t BO_PROJ = 0;
constexpr size_t BO_STATES = 9 * MiB;
constexpr size_t BO_PREV = 13 * MiB;
constexpr size_t BO_YPART = 15 * MiB;
constexpr size_t BO_CC = 19 * MiB;
constexpr size_t BO_HID = 0;
constexpr size_t WS_END = WS_BATCH0 + BATCH * BATCH_STRIDE;
static_assert(WS_END <= 256 * MiB, "d_ws map");
constexpr int CW_BAR = 4096, CW_GRP = 16384, GRP_BAR_STRIDE = 4096;

constexpr int RING_OFF = 0, RING_BYTES = 131072;
constexpr int LDSCTL_OFF = RING_BYTES, MISC_OFF = LDSCTL_OFF + 320, RSTD_OFF = LDSCTL_OFF + 512, PTR_OFF = RSTD_OFF + 4096;
constexpr int LDS_BYTES = 147456;
static_assert(PTR_OFF + 512 <= LDS_BYTES, "LDS map");

#define GAS __attribute__((address_space(1)))
#define LAS __attribute__((address_space(3)))
typedef unsigned short bf16;
typedef unsigned v4u __attribute__((ext_vector_type(4)));
typedef unsigned v2u __attribute__((ext_vector_type(2)));
typedef float f32x4 __attribute__((ext_vector_type(4)));
#define LDS_WAIT() asm volatile("s_waitcnt lgkmcnt(0)" ::: "memory")
#define VM_WAIT() asm volatile("s_waitcnt vmcnt(0)" ::: "memory")
__device__ __forceinline__ unsigned f2bf(float f) { unsigned u = __builtin_bit_cast(unsigned, f); return (u + 0x7fffu + ((u >> 16) & 1u)) >> 16; }
__device__ __forceinline__ unsigned pk2(float lo, float hi) { return f2bf(lo) | (f2bf(hi) << 16); }
__device__ __forceinline__ float bflo(unsigned w) { return __uint_as_float(w << 16); }
__device__ __forceinline__ float bfhi(unsigned w) { return __uint_as_float(w & 0xffff0000u); }
__device__ __forceinline__ float silu_f(float v) { return v / (1.f + expf(-v)); }
__device__ __forceinline__ float softplus_f(float v) { return fmaxf(v, 0.f) + log1pf(expf(-fabsf(v))); }

#define XB_TMO      128
#define XB_XCNT(j)  (256  + 64 * (j))
#define XB_XSUB(j)  (1280 + 64 * (j))
#define XB_XGEN(j)  (2304 + 64 * (j))
#define XB_TOP      3328
#define XB_TOPGEN   3392
#define XCD_BAR_WORDS 3456
#define XB_SPIN_CAP (1u << 22)
__device__ __forceinline__ unsigned xb_ld(unsigned* p)              { return __hip_atomic_load(p, __ATOMIC_RELAXED, __HIP_MEMORY_SCOPE_AGENT); }
__device__ __forceinline__ unsigned xb_add(unsigned* p, unsigned v) { return __hip_atomic_fetch_add(p, v, __ATOMIC_RELAXED, __HIP_MEMORY_SCOPE_AGENT); }
__device__ __forceinline__ unsigned xb_xcc_id() { return (unsigned)__builtin_amdgcn_s_getreg((3 << 11) | 20) & 0xFu; }
#define XB_SPIN(cond, bar) do { unsigned _sp = 0; while (cond) { __builtin_amdgcn_s_sleep(1); \
    if ((++_sp & 255u) == 0u) { if (xb_ld(&(bar)[XB_TMO])) break; if (_sp > XB_SPIN_CAP) { atomicAdd(&(bar)[XB_TMO], 1u); break; } } } } while (0)
struct XcdBarrier { unsigned* bar; unsigned x; unsigned total; volatile LAS unsigned* st; };
__device__ __forceinline__ XcdBarrier xcd_barrier_post(unsigned* bar, volatile LAS unsigned* st, unsigned total) {
    XcdBarrier b; b.bar = bar; b.x = xb_xcc_id(); b.total = total; b.st = st;
    if (threadIdx.x == 0) (void)xb_add(&bar[XB_XCNT(b.x)], 1u);
    return b;
}
__device__ __forceinline__ void xcd_barrier_complete(unsigned* bar, unsigned x, unsigned G, unsigned& nloc, unsigned& nx) {
    unsigned sum, cnt, mine, sp = 0u;
    for (;;) {
        sum = 0u; cnt = 0u; mine = 0u;
#pragma unroll
        for (unsigned j = 0; j < 16; ++j) { const unsigned c = xb_ld(&bar[XB_XCNT(j)]); sum += c; cnt += (c > 0u) ? 1u : 0u; mine = (j == x) ? c : mine; }
        if (sum == G) break;
        __builtin_amdgcn_s_sleep(1);
        if ((++sp & 255u) == 0u) { if (xb_ld(&bar[XB_TMO])) break; if (sp > XB_SPIN_CAP) { atomicAdd(&bar[XB_TMO], 1u); break; } }
    }
    nloc = mine > 0u ? mine : 1u; nx = cnt > 0u ? cnt : 1u;
}
__device__ __forceinline__ void xcd_barrier(const XcdBarrier& b) {
    asm volatile("s_waitcnt vmcnt(0)" ::: "memory");
    __syncthreads();
    if (threadIdx.x == 0) {
        unsigned* bar = b.bar;
        __builtin_amdgcn_s_waitcnt(0);
        unsigned nloc = b.st[0], nx = b.st[1];
        if (nloc == 0u) { xcd_barrier_complete(bar, b.x, b.total, nloc, nx); b.st[0] = nloc; b.st[1] = nx; }
        const unsigned old = xb_add(&bar[XB_XSUB(b.x)], 1u);
        const unsigned gen = old / nloc;
        if (nx == 1u) {
            XB_SPIN(xb_ld(&bar[XB_XSUB(b.x)]) < (gen + 1u) * nloc, bar);
            __builtin_amdgcn_fence(__ATOMIC_ACQUIRE, "agent");
            asm volatile("s_waitcnt vmcnt(0)" ::: "memory");
        } else if (old + 1u == (gen + 1u) * nloc) {
            __builtin_amdgcn_fence(__ATOMIC_RELEASE, "agent");
            asm volatile("s_waitcnt vmcnt(0)" ::: "memory");
            const unsigned og = xb_add(&bar[XB_TOP], 1u);
            const unsigned tg = og / nx;
            if (og + 1u == (tg + 1u) * nx) xb_add(&bar[XB_TOPGEN], 1u);
            else XB_SPIN(xb_ld(&bar[XB_TOPGEN]) == tg, bar);
            __builtin_amdgcn_fence(__ATOMIC_ACQUIRE, "agent");
            xb_add(&bar[XB_XGEN(b.x)], 1u);
            asm volatile("s_waitcnt vmcnt(0)" ::: "memory");
        } else {
            XB_SPIN(xb_ld(&bar[XB_XGEN(b.x)]) == gen, bar);
            __builtin_amdgcn_fence(__ATOMIC_ACQUIRE, "agent");
            asm volatile("s_waitcnt vmcnt(0)" ::: "memory");
        }
    }
    __syncthreads();
}

struct Frame {
    LAS unsigned char* lds;
    int tid, lane, wave, bid, G;
    int b, li;
};
enum { I_X = 0, I_MIXG, I_WIN, I_QG, I_KG, I_SINK, I_RELB, I_CONVW, I_CONVB, I_DTB, I_ALOG, I_DSKIP, I_SSMG, I_WOUT, I_MLPG, I_WUP, I_WDOWN, I_OUT, I_WS, I_NPTR };
__device__ __forceinline__ GAS unsigned char* ptr_at(const Frame& F, int i) {
    const LAS unsigned* t = (const LAS unsigned*)(F.lds + PTR_OFF) + 2 * i;
    const unsigned lo = __builtin_amdgcn_readfirstlane(t[0]), hi = __builtin_amdgcn_readfirstlane(t[1]);
    return (GAS unsigned char*)(((unsigned long long)hi << 32) | lo);
}
#define FIN(i) ((const GAS float*)ptr_at(F, (i)))
#define FWS(off) (ptr_at(F, I_WS) + (off))
#define FB(off) (ptr_at(F, I_WS) + (WS_BATCH0 + (size_t)F.b * BATCH_STRIDE + (off)))
using pg8::shx;
__device__ __forceinline__ float shup(float v, int o, int lane) { return __builtin_bit_cast(float, __builtin_amdgcn_ds_bpermute(((lane - o) & 63) << 2, __builtin_bit_cast(int, v))); }
__device__ __forceinline__ float wave_sum(float v, int lane) {
#pragma unroll
    for (int o = 1; o < 64; o <<= 1) v += shx(v, o, lane);
    return v;
}

__device__ __forceinline__ void tr_item(const GAS float* W, int Nsrc, int nsrc0, int nvalid, int K, const GAS float* gain, GAS bf16* WT, int ndst0, int k0, LAS float* scr, int lane) {
    const int n = lane & 31;
    float tv[32];
#pragma unroll
    for (int i = 0; i < 32; ++i) { const int kk = 2 * i + (lane >> 5); tv[i] = W[(size_t)(k0 + kk) * Nsrc + nsrc0 + (n < nvalid ? n : 0)]; }
#pragma unroll
    for (int i = 0; i < 32; ++i) { const int kk = 2 * i + (lane >> 5); float v = (n < nvalid) ? tv[i] : 0.f; if (gain) v *= gain[k0 + kk];
        scr[kk * 33 + n] = v; }
    LDS_WAIT(); asm volatile("" ::: "memory");
    const int c = lane & 7;
#pragma unroll
    for (int j = 0; j < 4; ++j) { const int nn = (lane >> 3) + 8 * j; const LAS float* s = scr + (8 * c) * 33 + nn;
        v4u o; o.x = pk2(s[0 * 33], s[1 * 33]); o.y = pk2(s[2 * 33], s[3 * 33]); o.z = pk2(s[4 * 33], s[5 * 33]); o.w = pk2(s[6 * 33], s[7 * 33]);
        *(GAS v4u*)(WT + (size_t)(ndst0 + nn) * K + k0 + 8 * c) = o; }
    LDS_WAIT(); asm volatile("" ::: "memory");
}
__device__ __forceinline__ void win_item(Frame& F, int L, int r, LAS float* scr);
__device__ __forceinline__ void p0_prologue(Frame& F) {
    LAS float* scr = (LAS float*)(F.lds + RING_OFF + F.wave * 16384);
    const int gw = F.bid * NWAVES + F.wave, NGW = F.G * NWAVES;
    constexpr int I_IN = 16 * 80, I_OUT = 16 * 32, I_UP = 16 * 128, I_DN = 64 * 32, I_L = I_IN + I_OUT + I_UP + I_DN;
    for (int it = gw; it < I_IN; it += NGW) win_item(F, 0, it, scr);
    const GAS float* x = FIN(I_X) + (size_t)F.b * SEQ * D; GAS bf16* XB = (GAS bf16*)FWS(WS_XB) + (size_t)F.b * SEQ * D; GAS float* SSQ = (GAS float*)FWS(WS_SSQ) + (size_t)F.b * SEQ * 16;
    for (int m = F.li * NWAVES + F.wave; m < SEQ; m += 2 * GRP * NWAVES) {
        const int m2 = m + GRP * NWAVES;
        const GAS f32x4* xr = (const GAS f32x4*)(x + (size_t)m * D) + F.lane; const GAS f32x4* xr2 = (const GAS f32x4*)(x + (size_t)m2 * D) + F.lane;
        f32x4 v[4], w[4]; float s = 0.f, s2 = 0.f;
#pragma unroll
        for (int j = 0; j < 4; ++j) { v[j] = xr[64 * j]; w[j] = xr2[64 * j]; }
#pragma unroll
        for (int j = 0; j < 4; ++j) { s += (v[j].x * v[j].x + v[j].y * v[j].y) + (v[j].z * v[j].z + v[j].w * v[j].w); s2 += (w[j].x * w[j].x + w[j].y * w[j].y) + (w[j].z * w[j].z + w[j].w * w[j].w); }
        s = wave_sum(s, F.lane); s2 = wave_sum(s2, F.lane);
        GAS v2u* o8 = (GAS v2u*)(XB + (size_t)m * D) + F.lane; GAS v2u* o82 = (GAS v2u*)(XB + (size_t)m2 * D) + F.lane;
#pragma unroll
        for (int j = 0; j < 4; ++j) { v2u o; o.x = pk2(v[j].x, v[j].y); o.y = pk2(v[j].z, v[j].w); o8[64 * j] = o; v2u o2; o2.x = pk2(w[j].x, w[j].y); o2.y = pk2(w[j].z, w[j].w); o82[64 * j] = o2; }
        if (F.lane < 16) { SSQ[(size_t)m * 16 + F.lane] = (F.lane == 0) ? s : 0.f; SSQ[(size_t)m2 * 16 + F.lane] = (F.lane == 0) ? s2 : 0.f; }
    }
}
constexpr int CW_WCNT = 8192, N_CONVERTERS = NGRP * (GRP - 16);
__device__ __forceinline__ void win_item(Frame& F, int L, int r, LAS float* scr) {
    const int kb = r / 80, nb = r % 80; int src, nv = 32;
    if (nb < 16) src = nb * 32; else if (nb < 32) src = 768 + (nb - 16) * 32; else if (nb < 36) src = 512 + (nb - 32) * 32; else if (nb < 40) src = 640 + (nb - 36) * 32;
    else if (nb < 72) src = nb * 32; else if (nb == 72) { src = 2304; nv = 8; } else { src = 0; nv = 0; }
    tr_item(FIN(I_WIN) + (size_t)L * D * D_IN, D_IN, src, nv, D, FIN(I_MIXG) + L * D, (GAS bf16*)FWS(WS_WIN) + (size_t)L * NPROJ * D, nb * 32, kb * 64, scr, F.lane);
}
__device__ __forceinline__ void convert_rest(Frame& F, int slot) {
    LAS float* scr = (LAS float*)(F.lds + RING_OFF + F.wave * 16384);
    constexpr int I_IN = 16 * 80, I_OUT = 16 * 32, I_UP = 16 * 128, I_DN = 64 * 32, NCW = N_CONVERTERS * NWAVES;
    const GAS float *w_out = FIN(I_WOUT), *w_up = FIN(I_WUP), *mlp_g = FIN(I_MLPG), *w_down = FIN(I_WDOWN);
    GAS bf16 *WOUT = (GAS bf16*)FWS(WS_WOUT), *WUP = (GAS bf16*)FWS(WS_WUP), *WDOWN = (GAS bf16*)FWS(WS_WDOWN);
    const int L = slot, n_items = I_UP + I_DN + (slot == 0 ? 2 * I_OUT + I_IN : 0);
    for (int it = (F.b * (GRP - 16) + (F.li - 16)) * NWAVES + F.wave; it < n_items; it += NCW) {
        int r = it;
        if (slot == 0) {
            if (r < I_OUT) { const int kb = r / 32, nb = r % 32; tr_item(w_out, D, nb * 32, 32, D, nullptr, WOUT, nb * 32, kb * 64, scr, F.lane); continue; }
            r -= I_OUT; }
        if (r < I_UP) { const int kb = r / 128, nb = r % 128; tr_item(w_up + (size_t)L * D * FF, FF, nb * 32, 32, D, mlp_g + L * D, WUP + (size_t)L * FF * D, nb * 32, kb * 64, scr, F.lane); continue; }
        r -= I_UP;
        if (r < I_DN) { const int kb = r / 32, nb = r % 32; tr_item(w_down + (size_t)L * FF * D, D, nb * 32, 32, FF, nullptr, WDOWN + (size_t)L * D * FF, nb * 32, kb * 64, scr, F.lane); continue; }
        r -= I_DN;
        if (r < I_OUT) { const int kb = r / 32, nb = r % 32; tr_item(w_out + (size_t)1 * D * D, D, nb * 32, 32, D, nullptr, WOUT + (size_t)1 * D * D, nb * 32, kb * 64, scr, F.lane); continue; }
        r -= I_OUT;
        win_item(F, 1, r, scr);
    }
    asm volatile("s_waitcnt vmcnt(0)" ::: "memory");
    __syncthreads();
    if (F.tid == 0) { __builtin_amdgcn_fence(__ATOMIC_RELEASE, "agent"); asm volatile("s_waitcnt vmcnt(0)" ::: "memory");
        (void)xb_add((unsigned*)(unsigned char*)FWS(WS_CTL) + CW_WCNT + 64 * slot, 1u); }
}
__device__ __forceinline__ void wait_weights(Frame& F, int part) {
    if (F.tid == 0) { unsigned* wc = (unsigned*)(unsigned char*)FWS(WS_CTL) + CW_WCNT + 64 * part; unsigned sp = 0u;
        while (xb_ld(wc) < (unsigned)N_CONVERTERS) { __builtin_amdgcn_s_sleep(2); if (++sp > (1u << 22)) break; }
        __builtin_amdgcn_fence(__ATOMIC_ACQUIRE, "agent"); asm volatile("s_waitcnt vmcnt(0)" ::: "memory"); }
    __syncthreads();
}
__device__ __forceinline__ void rstd_prepass(Frame& F, const pg8::GroupOrder& S, LAS float* tab) {
    const GAS float* SSQ = (const GAS float*)FWS(WS_SSQ) + (size_t)F.b * SEQ * 16;
    pg8::Unit u;
    for (int i = 0; i < 4 && S.next(i, u); ++i) {
        const int r = F.tid >> 1, h = F.tid & 1;
        const GAS f32x4* p = (const GAS f32x4*)(SSQ + (size_t)(u.pm * 256 + r) * 16 + h * 8);
        const f32x4 a = p[0], b = p[1];
        float s = (a.x + a.y) + (a.z + a.w) + (b.x + b.y) + (b.z + b.w);
        s += shx(s, 1, F.lane);
        if (h == 0) tab[i * 256 + r] = 1.0f / sqrtf(s * (1.0f / D) + EPS);
    }
    LDS_WAIT(); __syncthreads();
}
__device__ __forceinline__ int t5_bucket(int d) {
    if (d < 16) return d;
    return 16 + (d >= 19) + (d >= 21) + (d >= 24) + (d >= 27) + (d >= 31) + (d >= 35) + (d >= 40) + (d >= 46) + (d >= 52) + (d >= 59) + (d >= 67) + (d >= 77) + (d >= 87) + (d >= 99) + (d >= 113);
}
__device__ __forceinline__ void ld8(const GAS bf16* p, float (&v)[8]) {
    const v4u w = *(const GAS v4u*)p;
    v[0] = bflo(w.x); v[1] = bfhi(w.x); v[2] = bflo(w.y); v[3] = bfhi(w.y); v[4] = bflo(w.z); v[5] = bfhi(w.z); v[6] = bflo(w.w); v[7] = bfhi(w.w);
}
typedef short bf16x8_t __attribute__((ext_vector_type(8)));
typedef float f32x16 __attribute__((ext_vector_type(16)));
constexpr float LOG2E = 1.4426950408889634f;
__device__ __forceinline__ unsigned pkbf(float lo, float hi) { return pg8::cvt_pk_bf16(lo, hi); }
__device__ __forceinline__ int crow32(int i, int hh) { return (i & 3) + 8 * (i >> 2) + 4 * hh; }
__device__ __forceinline__ float silu_fast(float v) { return v * __builtin_amdgcn_rcpf(1.0f + __builtin_amdgcn_exp2f(-v * LOG2E)); }
__device__ __forceinline__ void unpk8(const v4u w, float (&v)[8]) {
    v[0] = bflo(w.x); v[1] = bfhi(w.x); v[2] = bflo(w.y); v[3] = bfhi(w.y); v[4] = bflo(w.z); v[5] = bfhi(w.z); v[6] = bflo(w.w); v[7] = bfhi(w.w);
}

typedef short v4i16_t __attribute__((ext_vector_type(4)));
template <int RH, int RSEC> __device__ __forceinline__ bf16x8_t tr_frag(const LAS unsigned char* img, int stride, int rbase, int cbase, int lane) {
    const LAS unsigned char* p = img + (rbase + RH * (lane >> 5) + ((lane & 15) >> 2)) * stride + (cbase + 16 * ((lane >> 4) & 1) + 4 * (lane & 3)) * 2;
    const v4i16_t a = __builtin_amdgcn_ds_read_tr16_b64_v4i16((LAS v4i16_t*)p), b = __builtin_amdgcn_ds_read_tr16_b64_v4i16((LAS v4i16_t*)(p + RSEC * stride));
    return (bf16x8_t){a[0], a[1], a[2], a[3], b[0], b[1], b[2], b[3]};
}
constexpr int AT_KS = 0, AT_KSTRIDE = 144, AT_VT = 36864, AT_VSTRIDE = 192, AT_BIAS = AT_VT + 256 * AT_VSTRIDE;
constexpr int AT_BN = 192, AT_END = AT_BIAS + 4 * AT_BN * 4;
static_assert(AT_END <= RING_BYTES, "attention LDS");
__device__ __forceinline__ void attn_fast(Frame& F, int L, bool dummy = false) {
    GAS bf16* PROJ = (GAS bf16*)FB(BO_PROJ);
    const GAS float* qg = FIN(I_QG) + L * 64; const GAS float* kg = FIN(I_KG) + L * 64; const GAS float* sinks = FIN(I_SINK) + L * 8; const GAS float* rel_bias = FIN(I_RELB);
    LAS unsigned char* Ks = F.lds + AT_KS; LAS unsigned char* Vt = F.lds + AT_VT; LAS float* biasR = (LAS float*)(F.lds + AT_BIAS);
    const int tid = F.tid, lane = F.lane, wave = F.wave, q = lane & 31, hh = lane >> 5;
    const int unit = F.li, kvh = unit >> 4, qb = unit & 15, m0 = qb * 128;
    const int gi = wave >> 1, qh = wave & 1, hq = kvh * 4 + gi;
    v4u qraw[2][4];
#pragma unroll
    for (int s = 0; s < 2; ++s)
#pragma unroll
        for (int d0 = 0; d0 < 4; ++d0) qraw[s][d0] = *(const GAS v4u*)(PROJ + (size_t)(m0 + 64 * qh + 32 * s + q) * PP + CQ + hq * 64 + d0 * 16 + hh * 8);
    v4u kwv[4], vwv[4];
#pragma unroll
    for (int i = 0; i < 4; ++i) { const int c = tid + NTHREADS * i, key = c >> 3, part = c & 7; const bool valid = (qb > 0) || (key >= 128); const unsigned msk = valid ? 0xffffffffu : 0u;
        const GAS bf16* kp = PROJ + (size_t)(valid ? m0 + key - 128 : 0) * PP + CK + kvh * 64 + part * 8;
        v4u a_ = *(const GAS v4u*)kp, b_ = *(const GAS v4u*)(kp + (CV - CK));
        a_.x &= msk; a_.y &= msk; a_.z &= msk; a_.w &= msk; b_.x &= msk; b_.y &= msk; b_.z &= msk; b_.w &= msk; kwv[i] = a_; vwv[i] = b_; }
    const f32x4 kg0 = *(const GAS f32x4*)(kg + (tid & 7) * 8), kg1 = *(const GAS f32x4*)(kg + (tid & 7) * 8 + 4);
    f32x4 qgv[4][2];
#pragma unroll
    for (int d0 = 0; d0 < 4; ++d0) { qgv[d0][0] = *(const GAS f32x4*)(qg + d0 * 16 + hh * 8); qgv[d0][1] = *(const GAS f32x4*)(qg + d0 * 16 + hh * 8 + 4); }
    const float sinkv = sinks[hq];
    float bent[2];
#pragma unroll
    for (int k = 0; k < 2; ++k) { const int x = tid + NTHREADS * k, g_ = x / AT_BN, xx = x - g_ * AT_BN; const bool ok = (x < 4 * AT_BN) && (xx >= 32) && (xx < 160);
        const float v = rel_bias[t5_bucket(ok ? 159 - xx : 0) * 8 + kvh * 4 + (ok ? g_ : 0)]; bent[k] = ok ? v * LOG2E : 0.f; }
    __syncthreads();
    biasR[tid] = bent[0]; if (tid + NTHREADS < 4 * AT_BN) biasR[tid + NTHREADS] = bent[1];
#pragma unroll
    for (int i = 0; i < 4; ++i) {
        const int c = tid + NTHREADS * i, key = c >> 3, part = c & 7;
        const v4u kw = kwv[i], vw = vwv[i];
        float kv[8]; unpk8(kw, kv);
        float ss = 0.f;
#pragma unroll
        for (int e = 0; e < 8; ++e) ss += kv[e] * kv[e];
        ss += shx(ss, 1, lane); ss += shx(ss, 2, lane); ss += shx(ss, 4, lane);
        const float rk = __builtin_amdgcn_rsqf(ss * (1.0f / 64.0f) + EPS);
        const f32x4 g0 = kg0, g1 = kg1;
        v4u ko; ko.x = pkbf(kv[0] * rk * g0.x, kv[1] * rk * g0.y); ko.y = pkbf(kv[2] * rk * g0.z, kv[3] * rk * g0.w); ko.z = pkbf(kv[4] * rk * g1.x, kv[5] * rk * g1.y); ko.w = pkbf(kv[6] * rk * g1.z, kv[7] * rk * g1.w);
        *(LAS v4u*)(Ks + key * AT_KSTRIDE + part * 16) = ko;
        *(LAS v4u*)(Vt + key * AT_VSTRIDE + part * 16) = vw;
    }
    LDS_WAIT(); __syncthreads();
    const float sink2 = sinkv * LOG2E;
    const LAS float* bb = biasR + gi * AT_BN + 31 - q + 4 * hh;
    const int qm = q - 4 * hh;
#pragma unroll
    for (int s = 0; s < 2; ++s) {
        const int a = 64 * qh + 32 * s;
        GAS bf16* qrow = PROJ + (size_t)(m0 + a + q) * PP + CQ + hq * 64;
        float qv[4][8]; float ss = 0.f;
#pragma unroll
        for (int d0 = 0; d0 < 4; ++d0) { unpk8(qraw[s][d0], qv[d0]);
#pragma unroll
            for (int e = 0; e < 8; ++e) ss += qv[d0][e] * qv[d0][e]; }
        ss += shx(ss, 32, lane);
        const float rq = __builtin_amdgcn_rsqf(ss * (1.0f / 64.0f) + EPS) * (0.125f * LOG2E);
        bf16x8_t qf[4];
#pragma unroll
        for (int d0 = 0; d0 < 4; ++d0) { const f32x4 g0 = qgv[d0][0], g1 = qgv[d0][1];
            v4u w; w.x = pkbf(qv[d0][0] * rq * g0.x, qv[d0][1] * rq * g0.y); w.y = pkbf(qv[d0][2] * rq * g0.z, qv[d0][3] * rq * g0.w);
            w.z = pkbf(qv[d0][4] * rq * g1.x, qv[d0][5] * rq * g1.y); w.w = pkbf(qv[d0][6] * rq * g1.z, qv[d0][7] * rq * g1.w);
            qf[d0] = __builtin_bit_cast(bf16x8_t, w); }
        const int kt_lo = (qb == 0) ? 4 - (a >> 5) : 0;
        f32x16 S[5]; float mx = sink2;
#pragma unroll
        for (int kt = 0; kt < 5; ++kt) { f32x16 acc = {};
#pragma unroll
            for (int d0 = 0; d0 < 4; ++d0) { const bf16x8_t kf = *(const LAS bf16x8_t*)(Ks + (a + 32 * kt + q) * AT_KSTRIDE + d0 * 32 + hh * 16);
                acc = __builtin_amdgcn_mfma_f32_32x32x16_bf16(kf, qf[d0], acc, 0, 0, 0); }
            if (kt < kt_lo) {
#pragma unroll
                for (int i = 0; i < 16; ++i) acc[i] = -INFINITY;
            } else {
#pragma unroll
                for (int i = 0; i < 16; ++i) { const int t0 = (i & 3) + 8 * (i >> 2); float v = acc[i] + bb[32 * kt + t0];
                    if (kt == 0) v = fminf(v, (t0 > qm) ? INFINITY : -INFINITY);
                    if (kt == 4) v = fminf(v, (t0 <= qm) ? INFINITY : -INFINITY);
                    acc[i] = v; mx = fmaxf(mx, v); } }
            S[kt] = acc; }
        mx = fmaxf(mx, shx(mx, 32, lane));
        float lsum = 0.f; bf16x8_t pf[5][2];
#pragma unroll
        for (int kt = 0; kt < 5; ++kt) {
#pragma unroll
            for (int i = 0; i < 16; ++i) { const float p = __builtin_amdgcn_exp2f(S[kt][i] - mx); S[kt][i] = p; lsum += p; }
#pragma unroll
            for (int s2 = 0; s2 < 2; ++s2) { v4u w; w.x = pkbf(S[kt][8 * s2 + 0], S[kt][8 * s2 + 1]); w.y = pkbf(S[kt][8 * s2 + 2], S[kt][8 * s2 + 3]);
                w.z = pkbf(S[kt][8 * s2 + 4], S[kt][8 * s2 + 5]); w.w = pkbf(S[kt][8 * s2 + 6], S[kt][8 * s2 + 7]); pf[kt][s2] = __builtin_bit_cast(bf16x8_t, w); } }
        lsum += shx(lsum, 32, lane);
        lsum += __builtin_amdgcn_exp2f(sink2 - mx);
        f32x16 O[2] = {{}, {}};
#pragma unroll
        for (int kt = 0; kt < 5; ++kt)
#pragma unroll
            for (int s2 = 0; s2 < 2; ++s2)
#pragma unroll
                for (int db = 0; db < 2; ++db)
                    O[db] = __builtin_amdgcn_mfma_f32_32x32x16_bf16(tr_frag<4, 8>(Vt, AT_VSTRIDE, a + 32 * kt + 16 * s2, 32 * db, lane), pf[kt][s2], O[db], 0, 0, 0);
        const float inv = __builtin_amdgcn_rcpf(lsum);
#pragma unroll
        for (int db = 0; db < 2; ++db)
#pragma unroll
            for (int g4 = 0; g4 < 4; ++g4) { v2u w; w.x = pkbf(O[db][4 * g4] * inv, O[db][4 * g4 + 1] * inv); w.y = pkbf(O[db][4 * g4 + 2] * inv, O[db][4 * g4 + 3] * inv);
                GAS bf16* orow = dummy ? (GAS bf16*)FB(BO_PREV) + (size_t)(m0 + a + q) * 512 + hq * 64 : qrow;
                *(GAS v2u*)(orow + 32 * db + 8 * g4 + 4 * hh) = w; }
    }
}

constexpr size_t WS_DTV = 3 * MiB + 512 * 1024;
constexpr int SD_ROW = 272, SD_XT = 264;
template <int NR> struct Raw8 { v4u u[NR + 3]; };
template <int NR> struct Raw4 { v2u u[NR + 3]; };
struct ConvW8 { f32x4 w[4][2], b[2]; };
struct ConvW4 { f32x4 w[4], b; };
template <int NR> __device__ __forceinline__ void conv_load(Raw8<NR>& R, const GAS bf16* PROJ, int m0, int c, int l0, int col0) {
#pragma unroll
    for (int i = 0; i < NR + 3; ++i) { const int row = l0 - 3 + i; const bool ok = (c > 0) || (row >= 0); const unsigned msk = ok ? 0xffffffffu : 0u;
        v4u x = *(const GAS v4u*)(PROJ + (size_t)(m0 + (ok ? row : 0)) * PP + col0); x.x &= msk; x.y &= msk; x.z &= msk; x.w &= msk; R.u[i] = x; }
}
template <int NR> __device__ __forceinline__ void conv_load(Raw4<NR>& R, const GAS bf16* PROJ, int m0, int c, int l0, int col0) {
#pragma unroll
    for (int i = 0; i < NR + 3; ++i) { const int row = l0 - 3 + i; const bool ok = (c > 0) || (row >= 0); const unsigned msk = ok ? 0xffffffffu : 0u;
        v2u x = *(const GAS v2u*)(PROJ + (size_t)(m0 + (ok ? row : 0)) * PP + col0); x.x &= msk; x.y &= msk; R.u[i] = x; }
}
__device__ __forceinline__ void convw_load(ConvW8& W, const GAS float* cw, const GAS float* cb) {
#pragma unroll
    for (int k = 0; k < 4; ++k) { W.w[k][0] = *(const GAS f32x4*)(cw + k * 1024); W.w[k][1] = *(const GAS f32x4*)(cw + k * 1024 + 4); }
    W.b[0] = *(const GAS f32x4*)cb; W.b[1] = *(const GAS f32x4*)(cb + 4);
}
__device__ __forceinline__ void convw_load(ConvW4& W, const GAS float* cw, const GAS float* cb) {
#pragma unroll
    for (int k = 0; k < 4; ++k) W.w[k] = *(const GAS f32x4*)(cw + k * 1024);
    W.b = *(const GAS f32x4*)cb;
}
template <int NR> __device__ __forceinline__ void conv_row(const Raw8<NR>& R, const ConvW8& W, int r, float (&out)[8]) {
    float acc[8];
#pragma unroll
    for (int e = 0; e < 8; ++e) acc[e] = W.b[e >> 2][e & 3];
#pragma unroll
    for (int k = 0; k < 4; ++k) { float u[8]; unpk8(R.u[r + k], u);
#pragma unroll
        for (int e = 0; e < 8; ++e) acc[e] += W.w[k][e >> 2][e & 3] * u[e]; }
#pragma unroll
    for (int e = 0; e < 8; ++e) out[e] = silu_fast(acc[e]);
}
template <int NR> __device__ __forceinline__ void conv_row(const Raw4<NR>& R, const ConvW4& W, int r, float (&out)[4]) {
    float acc[4];
#pragma unroll
    for (int e = 0; e < 4; ++e) acc[e] = W.b[e];
#pragma unroll
    for (int k = 0; k < 4; ++k) { const v2u x = R.u[r + k]; const float u[4] = {bflo(x.x), bfhi(x.x), bflo(x.y), bfhi(x.y)};
#pragma unroll
        for (int e = 0; e < 4; ++e) acc[e] += W.w[k][e] * u[e]; }
#pragma unroll
    for (int e = 0; e < 4; ++e) out[e] = silu_fast(acc[e]);
}
constexpr int S1_BSTR = 320, S1_XSTR = 576, S1_BMT = 0, S1_XW = 128 * S1_BSTR, S1_DT = S1_XW + 128 * S1_XSTR, S1_ACS = S1_DT + 2048, S1_WT = S1_ACS + 2048, S1_END = S1_WT + 64;
static_assert(S1_END <= RING_BYTES, "SSD part 1 LDS");
__device__ __forceinline__ void ssd_states(Frame& F, int L) {
    const GAS bf16* PROJ = (const GAS bf16*)FB(BO_PROJ);
    const GAS float* conv_w = FIN(I_CONVW) + (size_t)L * 4 * 1024; const GAS float* conv_b = FIN(I_CONVB) + L * 1024;
    const GAS float* dt_bias = FIN(I_DTB) + L * 8; const GAS float* a_log = FIN(I_ALOG) + L * 8;
    const GAS float* DTRAW = (const GAS float*)FWS(WS_DTRAW) + (size_t)F.b * SEQ * 8; GAS float* ACS = (GAS float*)FWS(WS_ACS) + (size_t)F.b * SEQ * 8;
    GAS float* DTV = (GAS float*)FWS(WS_DTV) + (size_t)F.b * SEQ * 8; GAS float* CHDEC = (GAS float*)FWS(WS_CHDEC) + F.b * 128;
    GAS float* STATES = (GAS float*)FB(BO_STATES);
    LAS unsigned char* BmT = F.lds + S1_BMT; LAS unsigned char* XW = F.lds + S1_XW;
    LAS float* dt_l = (LAS float*)(F.lds + S1_DT); LAS float* acs_l = (LAS float*)(F.lds + S1_ACS); LAS float* wt = (LAS float*)(F.lds + S1_WT);
    const int wave = F.wave, unit = F.li, c = unit >> 1, g = unit & 1, m0 = c * 128;
    int tid = F.tid; asm volatile("" : "+v"(tid));
    int lane = tid & 63, q = lane & 31, hh = lane >> 5;
    const int xcg = tid & 31, xl0 = (tid >> 5) * 8, xcol = CX + g * 256 + xcg * 8;
    const int bcg = tid & 15, bl0 = (tid >> 4) * 4, bcol = CBM + g * 128 + bcg * 8;
    Raw8<8> xr; ConvW8 xw; Raw8<4> br; ConvW8 bw;
    conv_load(xr, PROJ, m0, c, xl0, xcol); convw_load(xw, conv_w + (xcol - CX), conv_b + (xcol - CX));
    conv_load(br, PROJ, m0, c, bl0, bcol); convw_load(bw, conv_w + (bcol - CX), conv_b + (bcol - CX));
    const int ar = tid >> 7, al = tid & 127, ahead = 4 * g + ar;
    const float dtraw = DTRAW[(size_t)(m0 + al) * 8 + ahead], dtb = dt_bias[ahead], alog = a_log[ahead];
    __syncthreads();
    { const float dtv = softplus_f(dtraw + dtb);
      float v = dtv * (-expf(alog));
#pragma unroll
      for (int o = 1; o < 64; o <<= 1) { const float t = shup(v, o, lane); if (lane >= o) v += t; }
      if (lane == 63) wt[wave] = v;
      LDS_WAIT(); __syncthreads();
      if (wave & 1) v += wt[wave - 1];
      dt_l[tid] = dtv; acs_l[tid] = v; ACS[(size_t)(m0 + al) * 8 + ahead] = v; DTV[(size_t)(m0 + al) * 8 + ahead] = dtv;
      if (al == 127) CHDEC[c * 8 + ahead] = expf(v); }
#pragma unroll
    for (int r = 0; r < 4; ++r) { float o[8]; conv_row(br, bw, r, o);
        v4u pk; pk.x = pkbf(o[0], o[1]); pk.y = pkbf(o[2], o[3]); pk.z = pkbf(o[4], o[5]); pk.w = pkbf(o[6], o[7]);
        *(LAS v4u*)(BmT + (bl0 + r) * S1_BSTR + bcg * 16) = pk; }
    LDS_WAIT(); __syncthreads();
    { const int r4 = xcg >> 3; const float aend = acs_l[r4 * 128 + 127];
#pragma unroll
      for (int r = 0; r < 8; ++r) { float o[8]; conv_row(xr, xw, r, o); const int l = xl0 + r;
          const float sc = dt_l[r4 * 128 + l] * __builtin_amdgcn_exp2f((aend - acs_l[r4 * 128 + l]) * LOG2E);
          v4u pk; pk.x = pkbf(o[0] * sc, o[1] * sc); pk.y = pkbf(o[2] * sc, o[3] * sc); pk.z = pkbf(o[4] * sc, o[5] * sc); pk.w = pkbf(o[6] * sc, o[7] * sc);
          *(LAS v4u*)(XW + l * S1_XSTR + xcg * 16) = pk; } }
    LDS_WAIT(); __syncthreads();
    asm volatile("" : "+v"(tid)); lane = tid & 63; q = lane & 31; hh = lane >> 5;
    { const int r4 = wave >> 1, nt0 = (wave & 1) * 2, head = 4 * g + r4;
      f32x16 St[2][2] = {{{}, {}}, {{}, {}}};
#pragma unroll
      for (int ks = 0; ks < 8; ++ks) { bf16x8_t af[2], bfr[2];
#pragma unroll
          for (int pt = 0; pt < 2; ++pt) af[pt] = tr_frag<8, 4>(XW, S1_XSTR, 16 * ks, r4 * 64 + 32 * pt, lane);
#pragma unroll
          for (int nn = 0; nn < 2; ++nn) bfr[nn] = tr_frag<8, 4>(BmT, S1_BSTR, 16 * ks, 32 * (nt0 + nn), lane);
#pragma unroll
          for (int pt = 0; pt < 2; ++pt)
#pragma unroll
              for (int nn = 0; nn < 2; ++nn) St[pt][nn] = __builtin_amdgcn_mfma_f32_32x32x16_bf16(af[pt], bfr[nn], St[pt][nn], 0, 0, 0); }
      GAS float* sp = STATES + ((size_t)c * 8 + head) * 8192 + 32 * nt0 + q;
#pragma unroll
      for (int pt = 0; pt < 2; ++pt)
#pragma unroll
          for (int nn = 0; nn < 2; ++nn)
#pragma unroll
              for (int e = 0; e < 16; ++e) sp[(32 * pt + crow32(e, hh)) * 128 + 32 * nn] = St[pt][nn][e]; }
}
__device__ __forceinline__ void ssd_scan(Frame& F, int L) {
    const GAS float* STATES = (const GAS float*)FB(BO_STATES); const GAS float* CHDEC = (const GAS float*)FWS(WS_CHDEC) + F.b * 128; GAS bf16* PREV = (GAS bf16*)FB(BO_PREV);
    for (int idx = F.li * NTHREADS + F.tid; idx < 8 * 64 * 32; idx += GRP * NTHREADS) {
        const int n4 = idx & 31, p = (idx >> 5) & 63, head = idx >> 11;
        f32x4 s[16]; float dec[16];
#pragma unroll
        for (int c = 0; c < 16; ++c) { const size_t o = ((size_t)c * 8 + head) * 8192 + p * 128 + 4 * n4; s[c] = *(const GAS f32x4*)(STATES + o); dec[c] = CHDEC[c * 8 + head]; }
        f32x4 h = {0.f, 0.f, 0.f, 0.f};
#pragma unroll
        for (int c = 0; c < 16; ++c) { const size_t o = ((size_t)c * 8 + head) * 8192 + p * 128 + 4 * n4;
            v2u w; w.x = pkbf(h.x, h.y); w.y = pkbf(h.z, h.w); *(GAS v2u*)(PREV + o) = w;
            h = h * dec[c] + s[c]; }
    }
}
constexpr int S3_XSTR = 320, S3_CM = 0, S3_BM = 34816, S3_XD = 0, S3_PV = 128 * S3_XSTR, S3_PVH = 64 * SD_ROW, S3_Z = S3_PV + 2 * S3_PVH;
constexpr int S3_DT = S3_Z + 128 * SD_ROW, S3_ACS = S3_DT + 2048, S3_RSS = S3_ACS + 2048, S3_NG = S3_RSS + 2048, S3_END = S3_NG + 1024;
static_assert(S3_BM + 34816 <= S3_DT && S3_END <= RING_BYTES && 128 * 528 <= S3_DT, "SSD part 3 LDS");
__device__ __forceinline__ void ssd_out(Frame& F, int L, bool dummy = false) {
    GAS bf16* PROJ = (GAS bf16*)FB(BO_PROJ); const GAS bf16* PREV = (const GAS bf16*)FB(BO_PREV);
    const GAS float* conv_w = FIN(I_CONVW) + (size_t)L * 4 * 1024; const GAS float* conv_b = FIN(I_CONVB) + L * 1024;
    const GAS float* d_skip = FIN(I_DSKIP) + L * 8; const GAS float* ssm_g = FIN(I_SSMG) + L * 512;
    const GAS float* ACS = (const GAS float*)FWS(WS_ACS) + (size_t)F.b * SEQ * 8; const GAS float* DTV = (const GAS float*)FWS(WS_DTV) + (size_t)F.b * SEQ * 8;
    LAS unsigned char* Cm = F.lds + S3_CM; LAS unsigned char* Bm = F.lds + S3_BM; LAS unsigned char* Zt = F.lds + S3_Z;
    LAS float* dt_l = (LAS float*)(F.lds + S3_DT); LAS float* acs_l = (LAS float*)(F.lds + S3_ACS); LAS float* rss = (LAS float*)(F.lds + S3_RSS);
    const int wave = F.wave, unit = F.li, c = unit >> 1, g = unit & 1, m0 = c * 128;
    int tid = F.tid; asm volatile("" : "+v"(tid));
    int lane = tid & 63, q = lane & 31, hh = lane >> 5;
    const int bcg = tid & 31, bl0 = (tid >> 5) * 8, isC = bcg >> 4, bn0 = (bcg & 15) * 8, bcol = (isC ? CCM : CBM) + g * 128 + bn0;
    Raw8<8> br; ConvW8 bw;
    conv_load(br, PROJ, m0, c, bl0, bcol); convw_load(bw, conv_w + (bcol - CX), conv_b + (bcol - CX));
    const float dt_in = DTV[(size_t)(m0 + (tid & 127)) * 8 + 4 * g + (tid >> 7)], acs_in = ACS[(size_t)(m0 + (tid & 127)) * 8 + 4 * g + (tid >> 7)];
    const float ng_in = ssm_g[g * 256 + (tid & 255)];
    LAS float* ng_l = (LAS float*)(F.lds + S3_NG);
    __syncthreads();
    dt_l[tid] = dt_in; acs_l[tid] = acs_in * LOG2E;
    if (tid < 256) ng_l[tid] = ng_in;
#pragma unroll
    for (int r = 0; r < 8; ++r) { float o[8]; conv_row(br, bw, r, o);
        v4u pk; pk.x = pkbf(o[0], o[1]); pk.y = pkbf(o[2], o[3]); pk.z = pkbf(o[4], o[5]); pk.w = pkbf(o[6], o[7]);
        *(LAS v4u*)((isC ? Cm : Bm) + (bl0 + r) * SD_ROW + bn0 * 2) = pk; }
    v4u pw[4], zw[4]; Raw4<8> xr; ConvW4 xw;
    const int xcg = tid & 31, xl0 = (tid >> 5) * 8, xh = xcg >> 4, xp0 = (xcg & 15) * 4;
#define S3_D1_LOAD_PZ(hp_) do { \
        _Pragma("unroll") for (int k = 0; k < 4; ++k) { const int ch = tid + NTHREADS * k; \
            { const int hd = ch >> 10, rem = ch & 1023, p = rem >> 4, n8 = rem & 15; pw[k] = *(const GAS v4u*)(PREV + ((size_t)c * 8 + 4 * g + 2 * (hp_) + hd) * 8192 + p * 128 + n8 * 8); } \
            { const int l = ch >> 4, c8 = ch & 15; zw[k] = *(const GAS v4u*)(PROJ + (size_t)(m0 + l) * PP + CZ + (4 * g + 2 * (hp_)) * 64 + c8 * 8); } } } while (0)
#define S3_D1_LOAD_X(hp_) do { \
        const int col0 = CX + (4 * g + 2 * (hp_) + xh) * 64 + xp0; conv_load(xr, PROJ, m0, c, xl0, col0); convw_load(xw, conv_w + (col0 - CX), conv_b + (col0 - CX)); } while (0)
    S3_D1_LOAD_PZ(0); S3_D1_LOAD_X(0);
    LDS_WAIT(); __syncthreads();
    asm volatile("" : "+v"(tid)); lane = tid & 63; q = lane & 31; hh = lane >> 5;
    const int j = (wave < 4) ? (wave & 3) : 3 - (wave & 3), h2 = wave >> 2;
    f32x16 cbT[4]; bf16x8_t cf[8];
#pragma unroll
    for (int ks = 0; ks < 8; ++ks) cf[ks] = *(const LAS bf16x8_t*)(Cm + (32 * j + q) * SD_ROW + (16 * ks + 8 * hh) * 2);
#pragma unroll
    for (int i = 0; i < 4; ++i) { f32x16 acc = {};
        if (i <= j) {
#pragma unroll
            for (int ks = 0; ks < 8; ++ks) { const bf16x8_t bfr = *(const LAS bf16x8_t*)(Bm + (32 * i + q) * SD_ROW + (16 * ks + 8 * hh) * 2);
                acc = __builtin_amdgcn_mfma_f32_32x32x16_bf16(bfr, cf[ks], acc, 0, 0, 0); } }
        cbT[i] = acc; }
    unsigned vk[2][16];
#pragma unroll
    for (int hp = 0; hp < 2; ++hp) {
        if (hp == 1) S3_D1_LOAD_X(1);
        __syncthreads();
        {
          const int r = 2 * hp + xh;
#pragma unroll
          for (int rr = 0; rr < 8; ++rr) { float o[4]; conv_row(xr, xw, rr, o); const int l = xl0 + rr; const float dtv = dt_l[r * 128 + l];
              v2u pk; pk.x = pkbf(o[0] * dtv, o[1] * dtv); pk.y = pkbf(o[2] * dtv, o[3] * dtv);
              *(LAS v2u*)(F.lds + S3_XD + l * S3_XSTR + (xh * 64 + xp0) * 2) = pk; }
#pragma unroll
          for (int k = 0; k < 4; ++k) { const int ch = tid + NTHREADS * k;
              { const int hd = ch >> 10, rem = ch & 1023, p = rem >> 4, n8 = rem & 15; *(LAS v4u*)(F.lds + S3_PV + hd * S3_PVH + p * SD_ROW + n8 * 16) = pw[k]; }
              { const int l = ch >> 4, c8 = ch & 15; *(LAS v4u*)(Zt + l * SD_ROW + c8 * 16) = zw[k]; } } }
        LDS_WAIT(); __syncthreads();
        asm volatile("" : "+v"(tid)); lane = tid & 63; q = lane & 31; hh = lane >> 5;
        const int r = 2 * hp + h2, head = 4 * g + r;
        const LAS unsigned char* XD = F.lds + S3_XD; const LAS unsigned char* P1 = F.lds + S3_PV + h2 * S3_PVH;
        f32x16 O[2] = {{}, {}};
#pragma unroll
        for (int ks = 0; ks < 8; ++ks)
#pragma unroll
            for (int pt = 0; pt < 2; ++pt) { const bf16x8_t af = *(const LAS bf16x8_t*)(P1 + (32 * pt + q) * SD_ROW + (16 * ks + 8 * hh) * 2);
                O[pt] = __builtin_amdgcn_mfma_f32_32x32x16_bf16(af, cf[ks], O[pt], 0, 0, 0); }
        const float acl = acs_l[r * 128 + 32 * j + q], diag = d_skip[head] * __builtin_amdgcn_rcpf(dt_l[r * 128 + 32 * j + q]);
        { const float ea = __builtin_amdgcn_exp2f(acl);
#pragma unroll
          for (int pt = 0; pt < 2; ++pt)
#pragma unroll
              for (int e = 0; e < 16; ++e) O[pt][e] *= ea; }
        const int qm = q - 4 * hh;
#pragma unroll
        for (int i = 0; i < 4; ++i) { if (i <= j) {
            float xv[16];
            const LAS float* ap = acs_l + r * 128 + 32 * i + 4 * hh;
            float av[16];
#pragma unroll
            for (int e = 0; e < 16; ++e) av[e] = ap[(e & 3) + 8 * (e >> 2)];
            if (i < j) {
#pragma unroll
                for (int e = 0; e < 16; ++e) xv[e] = cbT[i][e] * __builtin_amdgcn_exp2f(acl - av[e]);
            } else {
#pragma unroll
                for (int e = 0; e < 16; ++e) { const int t0 = (e & 3) + 8 * (e >> 2);
                    const float m01 = (t0 <= qm) ? 1.0f : 0.0f, dg = (t0 == qm) ? diag : 0.0f;
                    xv[e] = cbT[i][e] * __builtin_amdgcn_exp2f(fminf(acl - av[e], 0.f)) * m01 + dg; } }
#pragma unroll
            for (int s2 = 0; s2 < 2; ++s2) { v4u w; w.x = pkbf(xv[8 * s2 + 0], xv[8 * s2 + 1]); w.y = pkbf(xv[8 * s2 + 2], xv[8 * s2 + 3]); w.z = pkbf(xv[8 * s2 + 4], xv[8 * s2 + 5]); w.w = pkbf(xv[8 * s2 + 6], xv[8 * s2 + 7]);
                const bf16x8_t xf = __builtin_bit_cast(bf16x8_t, w);
#pragma unroll
                for (int pt = 0; pt < 2; ++pt)
                    O[pt] = __builtin_amdgcn_mfma_f32_32x32x16_bf16(tr_frag<4, 8>(XD, S3_XSTR, 32 * i + 16 * s2, 64 * h2 + 32 * pt, lane), xf, O[pt], 0, 0, 0); } } }
        if (hp == 0) S3_D1_LOAD_PZ(1);
        float ss = 0.f;
#pragma unroll
        for (int pt = 0; pt < 2; ++pt)
#pragma unroll
            for (int g4 = 0; g4 < 4; ++g4) { const int p = 32 * pt + 8 * g4 + 4 * hh;
                const v2u zz = *(const LAS v2u*)(Zt + (32 * j + q) * SD_ROW + (64 * h2 + p) * 2);
                const float u0 = O[pt][4 * g4] * silu_fast(bflo(zz.x)), u1 = O[pt][4 * g4 + 1] * silu_fast(bfhi(zz.x)), u2 = O[pt][4 * g4 + 2] * silu_fast(bflo(zz.y)), u3 = O[pt][4 * g4 + 3] * silu_fast(bfhi(zz.y));
                ss += (u0 * u0 + u1 * u1) + (u2 * u2 + u3 * u3);
                vk[hp][pt * 8 + g4 * 2] = pkbf(u0, u1); vk[hp][pt * 8 + g4 * 2 + 1] = pkbf(u2, u3); }
        ss += shx(ss, 32, lane);
        if (hh == 0) rss[r * 128 + 32 * j + q] = ss;
    }
#undef S3_D1_LOAD_PZ
#undef S3_D1_LOAD_X
    LDS_WAIT(); __syncthreads();
    asm volatile("" : "+v"(tid)); lane = tid & 63; q = lane & 31; hh = lane >> 5;
    { const int l = 32 * j + q; const float tot = (rss[l] + rss[128 + l]) + (rss[256 + l] + rss[384 + l]);
      const float rn = __builtin_amdgcn_rsqf(tot * (1.0f / 256.0f) + EPS);
      LAS unsigned char* Ot = F.lds;
#pragma unroll
      for (int hp = 0; hp < 2; ++hp) { const int r = 2 * hp + h2, head = 4 * g + r;
#pragma unroll
          for (int pt = 0; pt < 2; ++pt)
#pragma unroll
              for (int g4 = 0; g4 < 4; ++g4) { const int p = 32 * pt + 8 * g4 + 4 * hh;
                  const f32x4 ng = *(const LAS f32x4*)(ng_l + r * 64 + p);
                  const unsigned w0 = vk[hp][pt * 8 + g4 * 2], w1 = vk[hp][pt * 8 + g4 * 2 + 1];
                  v2u w; w.x = pkbf(bflo(w0) * rn * ng.x, bfhi(w0) * rn * ng.y); w.y = pkbf(bflo(w1) * rn * ng.z, bfhi(w1) * rn * ng.w);
                  *(LAS v2u*)(Ot + l * 528 + (r * 64 + p) * 2) = w; } } }
    LDS_WAIT(); __syncthreads();
    asm volatile("" : "+v"(tid));
#pragma unroll
    for (int k = 0; k < 8; ++k) { const int ch = tid + NTHREADS * k, l = ch >> 5, c8 = ch & 31;
        const v4u w = *(const LAS v4u*)(F.lds + l * 528 + c8 * 16);
        GAS bf16* orow = dummy ? (GAS bf16*)FB(BO_STATES) + (size_t)(m0 + l) * 512 : PROJ + (size_t)(m0 + l) * PP + CZ;
        *(GAS v4u*)(orow + g * 256 + c8 * 8) = w; }
}

__device__ __forceinline__ void ph_inproj(Frame& F, int L) {
    LAS float* rstd_tab = (LAS float*)(F.lds + RSTD_OFF);
    int li_ = F.li; asm volatile("" : "+s"(li_)); pg8::GroupOrder S; S.init(NPROJ, li_);
    const GAS f32x4* sp = (const GAS f32x4*)((const GAS float*)FWS(WS_SSQ) + ((size_t)F.b * SEQ + (li_ & 7) * 256 + (F.tid >> 1)) * 16 + (F.tid & 1) * 8);
    pg8::Gemm g{(const GAS bf16*)FWS(WS_XB) + (size_t)F.b * SEQ * D, (const GAS bf16*)FWS(WS_WIN) + (size_t)L * NPROJ * D, SEQ, NPROJ, D, D};
    pg8::EpiProj E{(GAS bf16*)FB(BO_PROJ), (GAS float*)FWS(WS_DTRAW) + (size_t)F.b * SEQ * 8, rstd_tab, sp[0], sp[1]};
    pg8::gemm_phase<pg8::EpiProj, pg8::GroupOrder, true, true>(F.lds + RING_OFF, g, S, E);
}
__device__ __forceinline__ void ph_outproj(Frame& F, int L, bool dummy = false) {
    int li_ = F.li; asm volatile("" : "+s"(li_)); pg8::GroupOrder S; S.init(D, li_);
    pg8::Gemm g{(const GAS bf16*)FB(BO_PROJ), (const GAS bf16*)FWS(WS_WOUT) + (size_t)L * D * D, SEQ, D, D, PP};
    GAS bf16* XBb = (GAS bf16*)FWS(WS_XB) + (size_t)F.b * SEQ * D;
    pg8::EpiRes<false> E{XBb, (GAS float*)FWS(WS_SSQ) + (size_t)F.b * SEQ * 16, nullptr, dummy ? (GAS bf16*)FB(BO_YPART) : XBb};
    pg8::gemm_phase<pg8::EpiRes<false>, pg8::GroupOrder, false, true>(F.lds + RING_OFF, g, S, E);
}
__device__ __forceinline__ void ph_up(Frame& F, int L) {
    LAS float* rstd_tab = (LAS float*)(F.lds + RSTD_OFF);
    int li_ = F.li; asm volatile("" : "+s"(li_)); pg8::GroupOrder S; S.init(FF, li_);
    const GAS f32x4* sp = (const GAS f32x4*)((const GAS float*)FWS(WS_SSQ) + ((size_t)F.b * SEQ + (li_ & 7) * 256 + (F.tid >> 1)) * 16 + (F.tid & 1) * 8);
    pg8::Gemm g{(const GAS bf16*)FWS(WS_XB) + (size_t)F.b * SEQ * D, (const GAS bf16*)FWS(WS_WUP) + (size_t)L * FF * D, SEQ, FF, D, D};
    pg8::EpiUp E{(GAS bf16*)FB(BO_HID), FF, rstd_tab, sp[0], sp[1]};
    pg8::gemm_phase<pg8::EpiUp, pg8::GroupOrder, true, true>(F.lds + RING_OFF, g, S, E);
}
__device__ __forceinline__ void ph_down(Frame& F, int L, bool dummy = false) {
    int li_ = F.li; asm volatile("" : "+s"(li_)); pg8::GroupOrder S; S.init(D, li_);
    pg8::Gemm g{(const GAS bf16*)FB(BO_HID), (const GAS bf16*)FWS(WS_WDOWN) + (size_t)L * D * FF, SEQ, D, FF, FF};
    GAS bf16* XBb = (GAS bf16*)FWS(WS_XB) + (size_t)F.b * SEQ * D; GAS float* SSQb = (GAS float*)FWS(WS_SSQ) + (size_t)F.b * SEQ * 16;
    if (L == DEPTH - 1 && !dummy) { pg8::EpiRes<true> E{XBb, SSQb, (GAS float*)ptr_at(F, I_OUT) + (size_t)F.b * SEQ * D, XBb};
        pg8::gemm_phase<pg8::EpiRes<true>, pg8::GroupOrder, false, true>(F.lds + RING_OFF, g, S, E); }
    else { pg8::EpiRes<false> E{XBb, SSQb, nullptr, dummy ? (GAS bf16*)FB(16 * MiB) : XBb};
        pg8::gemm_phase<pg8::EpiRes<false>, pg8::GroupOrder, false, true>(F.lds + RING_OFF, g, S, E); }
}

#ifndef PROBE_REP
#define PROBE_REP 0
#endif
struct Args { const float* in[17]; float* out; unsigned char* ws; int pad0, pad1; };
__global__ void __launch_bounds__(NTHREADS, 2) fwd(Args args) {
    extern __shared__ __attribute__((aligned(16))) unsigned char lds[];
    Frame F;
    F.lds = (LAS unsigned char*)lds;
    F.tid = threadIdx.x; F.lane = F.tid & 63; F.wave = __builtin_amdgcn_readfirstlane(F.tid >> 6); F.bid = blockIdx.x; F.G = gridDim.x; F.b = F.bid & 7; F.li = F.bid >> 3;
    for (int u = F.tid; u < (LDS_BYTES - LDSCTL_OFF) / 4; u += NTHREADS) ((LAS unsigned*)(F.lds + LDSCTL_OFF))[u] = 0u;
    __syncthreads();
    if (F.tid < I_NPTR) { const unsigned long long p = F.tid < 17 ? (unsigned long long)args.in[F.tid < 17 ? F.tid : 0] : (F.tid == I_OUT ? (unsigned long long)args.out : (unsigned long long)args.ws);
        LAS unsigned* t = (LAS unsigned*)(F.lds + PTR_OFF) + 2 * F.tid; t[0] = (unsigned)p; t[1] = (unsigned)(p >> 32); }
    LDS_WAIT(); __syncthreads();
    if (F.G != GRID) return;
#define GBAR_OBJ() XcdBarrier{(unsigned*)(unsigned char*)FWS(WS_CTL) + CW_BAR, xb_xcc_id(), (unsigned)GRID, (volatile LAS unsigned*)(F.lds + MISC_OFF) + 8}
#define GRP_OBJ()  XcdBarrier{(unsigned*)(unsigned char*)FWS(WS_CTL) + CW_GRP + (blockIdx.x & 7) * GRP_BAR_STRIDE, xb_xcc_id(), (unsigned)GRP, (volatile LAS unsigned*)(F.lds + MISC_OFF) + 12}
    (void)xcd_barrier_post((unsigned*)(unsigned char*)FWS(WS_CTL) + CW_BAR, (volatile LAS unsigned*)(F.lds + MISC_OFF) + 8, GRID);
    (void)xcd_barrier_post((unsigned*)(unsigned char*)FWS(WS_CTL) + CW_GRP + (blockIdx.x & 7) * GRP_BAR_STRIDE, (volatile LAS unsigned*)(F.lds + MISC_OFF) + 12, GRP);
#define RELAUNDER() do { int t_ = threadIdx.x; asm volatile("" : "+v"(t_)); F.tid = t_; F.lane = t_ & 63; F.wave = __builtin_amdgcn_readfirstlane(t_ >> 6); \
    int b_ = blockIdx.x; asm volatile("" : "+s"(b_)); F.bid = b_; F.b = b_ & 7; F.li = b_ >> 3; } while (0)
#define GRP_BAR() do { const XcdBarrier gb_ = GRP_OBJ(); xcd_barrier(gb_); } while (0)
#define GRID_BAR() do { const XcdBarrier gb_ = GBAR_OBJ(); xcd_barrier(gb_); } while (0)

    p0_prologue(F);
    if (PROBE_REP == 1) { GRID_BAR(); RELAUNDER(); p0_prologue(F); }
    GRID_BAR();
    for (int L = 0; L < DEPTH; ++L) {
        RELAUNDER(); ph_inproj(F, L); if (PROBE_REP == 2) { GRP_BAR(); RELAUNDER(); ph_inproj(F, L); }
        if (F.li >= 16) { RELAUNDER(); convert_rest(F, L); }
        GRP_BAR();
        RELAUNDER(); if (PROBE_REP == 20) { attn_fast(F, L, true); GRP_BAR(); RELAUNDER(); }
        if (PROBE_REP == 25) {
#pragma unroll 1
            for (int rep = 0; rep < 2; ++rep) { attn_fast(F, L, rep == 0); if (rep == 0) { GRP_BAR(); RELAUNDER(); } } }
        else attn_fast(F, L);
        ssd_states(F, L); if (PROBE_REP == 21) { GRP_BAR(); RELAUNDER(); ssd_states(F, L); } GRP_BAR();
        RELAUNDER(); ssd_scan(F, L); if (PROBE_REP == 22) { GRP_BAR(); RELAUNDER(); ssd_scan(F, L); } if (PROBE_REP == 24) { for (int k = 0; k < 8; ++k) GRP_BAR(); } GRP_BAR();
        RELAUNDER(); if (PROBE_REP == 23) { ssd_out(F, L, true); GRP_BAR(); RELAUNDER(); } ssd_out(F, L); GRP_BAR();
        RELAUNDER(); if (L == 0) wait_weights(F, 0); if (PROBE_REP == 30) { ph_outproj(F, L, true); GRP_BAR(); RELAUNDER(); } ph_outproj(F, L); GRP_BAR();
        RELAUNDER(); if (L == 1) wait_weights(F, 1); ph_up(F, L); if (PROBE_REP == 5) { GRP_BAR(); RELAUNDER(); ph_up(F, L); } GRP_BAR();
        RELAUNDER(); if (PROBE_REP == 31) { ph_down(F, L, true); GRP_BAR(); RELAUNDER(); } ph_down(F, L); if (L + 1 < DEPTH) GRP_BAR();
    }
}

extern "C" void kernel_launch(void* const* d_in, const int* in_sizes, int n_in, void* d_out, int out_size, void* d_ws, size_t ws_size, hipStream_t stream) {
    static int grid = 0;
    if (grid == 0) {
        if (n_in != 17 || in_sizes[0] != M * D || out_size != M * D || ws_size < WS_END) { fprintf(stderr, "kernel_launch: unexpected shapes (n_in %d, in0 %d, out %d, ws %zu)\n", n_in, n_in > 0 ? in_sizes[0] : -1, out_size, ws_size); grid = -1; return; }
        int dev = 0, cus = 0, per_cu = 0;
        if (hipGetDevice(&dev) != hipSuccess || hipDeviceGetAttribute(&cus, hipDeviceAttributeMultiprocessorCount, dev) != hipSuccess) { grid = -1; return; }
        if (hipFuncSetAttribute((const void*)fwd, hipFuncAttributeMaxDynamicSharedMemorySize, LDS_BYTES) != hipSuccess) { fprintf(stderr, "kernel_launch: hipFuncSetAttribute failed\n"); grid = -1; return; }
        if (hipOccupancyMaxActiveBlocksPerMultiprocessor(&per_cu, (const void*)fwd, NTHREADS, LDS_BYTES) != hipSuccess || per_cu < 1) { fprintf(stderr, "kernel_launch: occupancy query says %d\n", per_cu); per_cu = 0; }
        (void)hipGetLastError();
        if (cus * per_cu < GRID) { fprintf(stderr, "kernel_launch: this kernel needs %d co-resident workgroups (one per CU of a 256-CU device); the device admits %d x %d; nothing launched\n", GRID, cus, per_cu); grid = -1; return; }
        grid = GRID;
    }
    if (grid < 0) return;
    (void)hipMemsetAsync((char*)d_ws + WS_CTL, 0, CTL_ZERO_BYTES, stream);
    Args a{};
    for (int i = 0; i < 17; ++i) a.in[i] = (const float*)d_in[i];
    a.out = (float*)d_out; a.ws = (unsigned char*)d_ws;
    void* kargs[] = {&a};
    hipError_t e = hipLaunchCooperativeKernel((const void*)fwd, dim3(grid), dim3(NTHREADS), kargs, LDS_BYTES, stream);
    if (e != hipSuccess) fprintf(stderr, "kernel_launch: cooperative launch failed: %s (grid %d)\n", hipGetErrorString(e), grid);
}
```

```cpp
#include <hip/hip_runtime.h>
#include <cstdio>
#include <cstdint>
#define PROBE_REP 0


namespace pg8 {
#define PG8_LAS __attribute__((address_space(3)))
#define PG8_GAS __attribute__((address_space(1)))
typedef unsigned short bf16_t;
typedef short bf16x8 __attribute__((ext_vector_type(8)));
typedef float f32x4 __attribute__((ext_vector_type(4)));
typedef unsigned u32x4 __attribute__((ext_vector_type(4)));
constexpr int BM = 256, BK = 64, HALF = 128, HTB = HALF * BK * 2  , STAGE_BYTES = 8 * HTB, NXCD = 8, WGM = 8;

__host__ __device__ __forceinline__ int lds_byte(int r, int c) { const int st = (r >> 4) * 2 + (c >> 5), rr = r & 15, cc = c & 31, ob = rr * 64 + cc * 2; return st * 1024 + (ob ^ (((ob >> 9) & 1) << 5)); }
__host__ __device__ __forceinline__ void stage_rc(int b, int& R, int& C) { const int st = b / 1024, sb = b % 1024, swz = sb ^ (((sb >> 9) & 1) << 5); R = (st >> 1) * 16 + swz / 64; C = (st & 1) * 32 + (swz % 64) / 2; }
__host__ __device__ __forceinline__ int perm32(int rho) { const int n = rho >> 4, i = rho & 15; return 8 * (i >> 2) + 4 * n + (i & 3); }

struct Unit { int pm, pn; };
struct Gemm { const PG8_GAS bf16_t* A; const PG8_GAS bf16_t* Bt; int M, N, K, lda; };

struct StaticOrder {
    int nM, nN, nwg, G, c;
    __host__ __device__ void init(int M, int N, int G_, int c_) { nM = M / BM; nN = N / BM; nwg = nM * nN; G = G_; c = c_; }
    __host__ __device__ bool next(int i, Unit& u) const {
        const long L = (long)i * G + c; if (L >= nwg) return false;
        int wgid = (int)L; { const int q = nwg / NXCD, r = nwg % NXCD, xcd = wgid % NXCD, off = wgid / NXCD; wgid = (xcd < r ? xcd * (q + 1) : r * (q + 1) + (xcd - r) * q) + off; }
        const int nig = WGM * nN, gid = wgid / nig, fm = gid * WGM, gsz = (nM - fm) < WGM ? (nM - fm) : WGM;
        u.pm = fm + ((wgid % nig) % gsz); u.pn = (wgid % nig) / gsz; return true;
    }
    __device__ __forceinline__ void a_ready(const Unit&) const {}
    __device__ __forceinline__ void done(const Unit&) const {}
};

struct GroupOrder {
    int nN, li;
    __host__ __device__ void init(int N, int li_) { nN = N / BM; li = li_; }
    __host__ __device__ bool next(int i, Unit& u) const { const int T = i * 32 + li; if (T >= 8 * nN) return false; u.pm = T & 7; u.pn = T >> 3; return true; }
    __device__ __forceinline__ void a_ready(const Unit&) const {}
    __device__ __forceinline__ void done(const Unit&) const {}
};

__device__ __forceinline__ float shx(float v, int k, int lane) { return __builtin_bit_cast(float, __builtin_amdgcn_ds_bpermute((lane ^ k) << 2, __builtin_bit_cast(int, v))); }
typedef float f32x2_t __attribute__((ext_vector_type(2))); typedef __bf16 bf16x2_t __attribute__((ext_vector_type(2)));
__device__ __forceinline__ unsigned cvt_pk_bf16(float lo, float hi) { f32x2_t v = {lo, hi}; bf16x2_t b = __builtin_convertvector(v, bf16x2_t); return __builtin_bit_cast(unsigned, b); }

constexpr int PROJ_PITCH = 2304, DT_TILE = 9;
struct EpiProj {
    static constexpr bool PERM = true, AFTER_DRAIN = false, ACC_INIT = false, PRE_HOOK = true;
    PG8_GAS bf16_t* O; PG8_GAS float* dtraw; PG8_LAS float* rstd; f32x4 pa, pb;
    __device__ __forceinline__ void pre(int tid) const {
        float s = (pa[0] + pa[1]) + (pa[2] + pa[3]) + (pb[0] + pb[1]) + (pb[2] + pb[3]);
        s += shx(s, 1, tid & 63);
        if ((tid & 1) == 0) rstd[tid >> 1] = 1.0f / sqrtf(s * (1.0f / 1024.0f) + 1e-6f);
    }
    __device__ __forceinline__ void operator()(const f32x4 (&acc)[2][2][4][2], const Unit& u, int ui, int wr, int wc, int fr, int fq) const {
        int rt0 = wr * 64 + fr; asm volatile("" : "+v"(rt0));
        if (u.pn == DT_TILE) {
            if (wc == 0 && fq == 0) {
#pragma unroll
                for (int ai = 0; ai < 2; ++ai)
#pragma unroll
                    for (int m = 0; m < 4; ++m) { const int rt = ai * HALF + rt0 + m * 16; const float rs = rstd[rt]; PG8_GAS float* p = dtraw + (size_t)(u.pm * BM + rt) * 8;
                        *(PG8_GAS f32x4*)p = acc[ai][0][m][0] * rs; *(PG8_GAS f32x4*)(p + 4) = acc[ai][0][m][1] * rs; }
            }
            return;
        }
        const int col0 = u.pn * BM + wc * 32 + 8 * fq;
#pragma unroll
        for (int ai = 0; ai < 2; ++ai)
#pragma unroll
            for (int m = 0; m < 4; ++m) { const int rt = ai * HALF + rt0 + m * 16; const float rs = rstd[rt]; PG8_GAS bf16_t* rowp = O + (size_t)(u.pm * BM + rt) * PROJ_PITCH + col0;
#pragma unroll
                for (int bj = 0; bj < 2; ++bj) { const f32x4 v0 = acc[ai][bj][m][0] * rs, v1 = acc[ai][bj][m][1] * rs;
                    u32x4 w; w.x = cvt_pk_bf16(v0[0], v0[1]); w.y = cvt_pk_bf16(v0[2], v0[3]); w.z = cvt_pk_bf16(v1[0], v1[1]); w.w = cvt_pk_bf16(v1[2], v1[3]);
                    *(PG8_GAS u32x4*)(rowp + bj * HALF) = w; } }
    }
};
struct EpiUp {
    static constexpr bool PERM = true, AFTER_DRAIN = false, ACC_INIT = false, PRE_HOOK = true;
    PG8_GAS bf16_t* O; int ldc; PG8_LAS float* rstd; f32x4 pa, pb;
    __device__ __forceinline__ void pre(int tid) const {
        float s = (pa[0] + pa[1]) + (pa[2] + pa[3]) + (pb[0] + pb[1]) + (pb[2] + pb[3]);
        s += shx(s, 1, tid & 63);
        if ((tid & 1) == 0) rstd[tid >> 1] = 1.0f / sqrtf(s * (1.0f / 1024.0f) + 1e-6f);
    }
    __device__ __forceinline__ void operator()(const f32x4 (&acc)[2][2][4][2], const Unit& u, int ui, int wr, int wc, int fr, int fq) const {
        int rt0 = wr * 64 + fr; asm volatile("" : "+v"(rt0)); const int col0 = u.pn * BM + wc * 32 + 8 * fq;
#pragma unroll
        for (int ai = 0; ai < 2; ++ai)
#pragma unroll
            for (int m = 0; m < 4; ++m) { const int rt = ai * HALF + rt0 + m * 16; const float rs = rstd[rt]; PG8_GAS bf16_t* rowp = O + (size_t)(u.pm * BM + rt) * ldc + col0;
#pragma unroll
                for (int bj = 0; bj < 2; ++bj) { f32x4 v0 = acc[ai][bj][m][0] * rs, v1 = acc[ai][bj][m][1] * rs;
#pragma unroll
                    for (int e = 0; e < 4; ++e) { const float a = fmaxf(v0[e], 0.f), b = fmaxf(v1[e], 0.f); v0[e] = a * a; v1[e] = b * b; }
                    u32x4 w; w.x = cvt_pk_bf16(v0[0], v0[1]); w.y = cvt_pk_bf16(v0[2], v0[3]); w.z = cvt_pk_bf16(v1[0], v1[1]); w.w = cvt_pk_bf16(v1[2], v1[3]);
                    *(PG8_GAS u32x4*)(rowp + bj * HALF) = w; } }
    }
};
template <bool FINAL> struct EpiRes {
    static constexpr bool PERM = true, AFTER_DRAIN = false, ACC_INIT = true, PRE_HOOK = false;
    PG8_GAS bf16_t* xb; PG8_GAS float* ssq; PG8_GAS float* out; PG8_GAS bf16_t* xdst;
    __device__ __forceinline__ void init(f32x4 (&acc)[2][2][4][2], const Unit& u, int wr, int wc, int fr, int fq) const {
        const int rt0 = wr * 64 + fr, col0 = u.pn * BM + wc * 32 + 8 * fq;
#pragma unroll
        for (int ai = 0; ai < 2; ++ai)
#pragma unroll
            for (int m = 0; m < 4; ++m) { const int row = u.pm * BM + ai * HALF + rt0 + m * 16; const size_t off = (size_t)row * 1024 + col0;
#pragma unroll
                for (int bj = 0; bj < 2; ++bj) { const u32x4 rw = *(const PG8_GAS u32x4*)(xb + off + bj * HALF);
                    acc[ai][bj][m][0] = (f32x4){__uint_as_float(rw.x << 16), __uint_as_float(rw.x & 0xffff0000u), __uint_as_float(rw.y << 16), __uint_as_float(rw.y & 0xffff0000u)};
                    acc[ai][bj][m][1] = (f32x4){__uint_as_float(rw.z << 16), __uint_as_float(rw.z & 0xffff0000u), __uint_as_float(rw.w << 16), __uint_as_float(rw.w & 0xffff0000u)}; } }
    }
    __device__ __forceinline__ void operator()(const f32x4 (&acc)[2][2][4][2], const Unit& u, int ui, int wr, int wc, int fr, int fq) const {
        int rt0 = wr * 64 + fr; asm volatile("" : "+v"(rt0)); const int col0 = u.pn * BM + wc * 32 + 8 * fq;
#pragma unroll
        for (int ai = 0; ai < 2; ++ai)
#pragma unroll
            for (int m = 0; m < 4; ++m) { const int row = u.pm * BM + ai * HALF + rt0 + m * 16; const size_t off = (size_t)row * 1024 + col0; float s = 0.f;
#pragma unroll
                for (int bj = 0; bj < 2; ++bj) { const f32x4 v0 = acc[ai][bj][m][0], v1 = acc[ai][bj][m][1];
                    if (FINAL) { *(PG8_GAS f32x4*)(out + off + bj * HALF) = v0; *(PG8_GAS f32x4*)(out + off + bj * HALF + 4) = v1; }
                    else { u32x4 w; w.x = cvt_pk_bf16(v0[0], v0[1]); w.y = cvt_pk_bf16(v0[2], v0[3]); w.z = cvt_pk_bf16(v1[0], v1[1]); w.w = cvt_pk_bf16(v1[2], v1[3]);
                        *(PG8_GAS u32x4*)(xdst + off + bj * HALF) = w;
                        s += (v0[0] * v0[0] + v0[1] * v0[1]) + (v0[2] * v0[2] + v0[3] * v0[3]) + (v1[0] * v1[0] + v1[1] * v1[1]) + (v1[2] * v1[2] + v1[3] * v1[3]); } }
                if (!FINAL) { const int ln = fq * 16 + fr; s += shx(s, 16, ln); s += shx(s, 32, ln);
                    if (fq == 0) ssq[(size_t)row * 16 + u.pn * 4 + wc] = s; } }
    }
};

template <class Epi, class Sched, bool ALIGN_EPI = false, bool SP2 = false>
__device__ __forceinline__ void gemm_phase(PG8_LAS unsigned char* lds, const Gemm g, const Sched& S, const Epi& E) {
    int tid_ = threadIdx.x; asm volatile("" : "+v"(tid_));
    const int tid = tid_, wid = __builtin_amdgcn_readfirstlane(tid >> 6), lane = tid & 63, wr = wid >> 2, wc = wid & 3, fr = lane & 15, fq = lane >> 4;
    const int K = g.K, nt = K / BK;
    unsigned voffA[2], voffB[2];
#pragma unroll
    for (int i = 0; i < 2; ++i) { int R, C; stage_rc(tid * 16 + i * 8192, R, C); const int Rb = Epi::PERM ? ((R & ~31) + perm32(R & 31)) : R;
        voffA[i] = (unsigned)(R * g.lda + C) * 2u; voffB[i] = (unsigned)(Rb * K + C) * 2u; }
    const size_t kstep = (size_t)(BK * 2);
    const size_t hstepA = (size_t)HALF * g.lda * 2, hstepB = (size_t)HALF * K * 2;
    const size_t tstepA = 2 * hstepA, tstepB = 2 * hstepB;
    const unsigned ldsw = (unsigned)wid * 1024u;
    const int aoff = lds_byte(wr * 64 + fr, fq * 8), boff = lds_byte(wc * 32 + fr, fq * 8);
#define PG8_SA(b, h) (((b) * 2 + (h)) * HTB)
#define PG8_SB(b, h) ((4 + (b) * 2 + (h)) * HTB)
#define PG8_STAGE(bufoff, gbase, voff) do { _Pragma("unroll") for (int _i = 0; _i < 2; ++_i) \
        __builtin_amdgcn_global_load_lds((const unsigned*)((const char*)(gbase) + (voff)[_i]), (PG8_LAS unsigned*)(lds + (bufoff) + ldsw + _i * 8192), 16, 0, 0); } while (0)
#define PG8_LDA(dst, b, h) do { _Pragma("unroll") for (int m = 0; m < 4; ++m) _Pragma("unroll") for (int k = 0; k < 2; ++k) dst[m][k] = *(const PG8_LAS bf16x8*)(lds + PG8_SA(b, h) + aoff + m * 2048 + k * 1024); } while (0)
#define PG8_LDB(dst, b, h) do { _Pragma("unroll") for (int n = 0; n < 2; ++n) _Pragma("unroll") for (int k = 0; k < 2; ++k) dst[n][k] = *(const PG8_LAS bf16x8*)(lds + PG8_SB(b, h) + boff + n * 2048 + k * 1024); } while (0)
#define PG8_MMA(ai, bj, At, Bt) do { __builtin_amdgcn_s_setprio(1); _Pragma("unroll") for (int m = 0; m < 4; ++m) _Pragma("unroll") for (int n = 0; n < 2; ++n) _Pragma("unroll") for (int k = 0; k < 2; ++k) \
        acc[ai][bj][m][n] = __builtin_amdgcn_mfma_f32_16x16x32_bf16(Bt[n][k], At[m][k], acc[ai][bj][m][n], 0, 0, 0); __builtin_amdgcn_s_setprio(0); } while (0)
#define PG8_WAIT_V(n) asm volatile("s_waitcnt vmcnt(" #n ")" ::: "memory")
#define PG8_WAIT_L(n) asm volatile("s_waitcnt lgkmcnt(" #n ")" ::: "memory")
#define PG8_BAR __builtin_amdgcn_s_barrier()
#define PG8_SCHED __builtin_amdgcn_sched_barrier(0)
    Unit cur, nxt; int ui = 0;
    if (!S.next(0, cur)) return;
    f32x4 acc[2][2][4][2];
#pragma unroll
    for (int a = 0; a < 2; ++a)
#pragma unroll
        for (int b = 0; b < 2; ++b)
#pragma unroll
            for (int m = 0; m < 4; ++m)
#pragma unroll
                for (int n = 0; n < 2; ++n) acc[a][b][m][n] = (f32x4){0.f, 0.f, 0.f, 0.f};
    if constexpr (Epi::ACC_INIT) E.init(acc, cur, wr, wc, fr, fq);
    bf16x8 At[4][2], B0[2][2], B1[2][2];
    const char* cA = (const char*)g.A + (size_t)cur.pm * tstepA; const char* cB = (const char*)g.Bt + (size_t)cur.pn * tstepB;
    S.a_ready(cur);
    if constexpr (SP2) {
        PG8_STAGE(PG8_SB(0, 0), cB, voffB); PG8_STAGE(PG8_SB(0, 1), cB + hstepB, voffB); PG8_STAGE(PG8_SA(0, 0), cA, voffA); PG8_STAGE(PG8_SA(0, 1), cA + hstepA, voffA);
        if constexpr (Epi::PRE_HOOK) E.pre(tid);
        if (wr == 1) PG8_BAR;
        PG8_WAIT_V(2); PG8_BAR;
        PG8_STAGE(PG8_SB(1, 0), cB + kstep, voffB); PG8_STAGE(PG8_SA(1, 0), cA + kstep, voffA); PG8_STAGE(PG8_SB(1, 1), cB + hstepB + kstep, voffB);
        PG8_WAIT_V(6); PG8_BAR;
    } else {
        PG8_STAGE(PG8_SB(0, 0), cB, voffB); PG8_STAGE(PG8_SA(0, 0), cA, voffA); PG8_STAGE(PG8_SB(0, 1), cB + hstepB, voffB); PG8_STAGE(PG8_SA(0, 1), cA + hstepA, voffA);
        if (wr == 1) PG8_BAR;
        PG8_WAIT_V(4); PG8_BAR;
        PG8_STAGE(PG8_SB(1, 0), cB + kstep, voffB); PG8_STAGE(PG8_SA(1, 0), cA + kstep, voffA); PG8_STAGE(PG8_SB(1, 1), cB + hstepB + kstep, voffB);
        PG8_WAIT_V(6); PG8_BAR;
    }
    for (;;) {
        const bool has_next = S.next(ui + 1, nxt);
        const char* nA = has_next ? (const char*)g.A + (size_t)nxt.pm * tstepA : cA; const char* nB = has_next ? (const char*)g.Bt + (size_t)nxt.pn * tstepB : cB;
        for (int t = 0; t < nt; t += 2) {
            const bool last = (t == nt - 2);
            const char* a1 = cA + (size_t)(t + 1) * kstep;
            const char* a2 = last ? nA : cA + (size_t)(t + 2) * kstep; const char* b2 = last ? nB : cB + (size_t)(t + 2) * kstep;
            const char* a3 = a2 + kstep; const char* b3 = b2 + kstep;
            if (last && has_next) S.a_ready(nxt);
            if constexpr (SP2) {
            PG8_LDB(B0, 0, 0); PG8_LDB(B1, 0, 1); PG8_SCHED; PG8_LDA(At, 0, 0); PG8_STAGE(PG8_SA(1, 1), a1 + hstepA, voffA);
            PG8_WAIT_V(8); PG8_WAIT_L(0); PG8_BAR; PG8_MMA(0, 0, At, B0); PG8_MMA(0, 1, At, B1); PG8_BAR; PG8_SCHED;
            PG8_LDA(At, 0, 1); PG8_STAGE(PG8_SB(0, 0), b2, voffB); PG8_STAGE(PG8_SB(0, 1), b2 + hstepB, voffB); PG8_STAGE(PG8_SA(0, 0), a2, voffA);
            PG8_WAIT_V(8); PG8_WAIT_L(0); PG8_BAR; PG8_MMA(1, 0, At, B0); PG8_MMA(1, 1, At, B1); PG8_BAR; PG8_SCHED;
            PG8_LDB(B0, 1, 0); PG8_LDB(B1, 1, 1); PG8_SCHED; PG8_LDA(At, 1, 0); PG8_STAGE(PG8_SA(0, 1), a2 + hstepA, voffA);
            PG8_WAIT_V(8); PG8_WAIT_L(0); PG8_BAR; PG8_MMA(0, 0, At, B0); PG8_MMA(0, 1, At, B1); PG8_BAR; PG8_SCHED;
            PG8_LDA(At, 1, 1); PG8_STAGE(PG8_SB(1, 0), b3, voffB); PG8_STAGE(PG8_SB(1, 1), b3 + hstepB, voffB); PG8_STAGE(PG8_SA(1, 0), a3, voffA);
            PG8_WAIT_V(8); PG8_WAIT_L(0); PG8_BAR; PG8_MMA(1, 0, At, B0); PG8_MMA(1, 1, At, B1); PG8_BAR; PG8_SCHED;
            } else {
            PG8_LDB(B0, 0, 0); PG8_SCHED; PG8_LDA(At, 0, 0); PG8_STAGE(PG8_SA(1, 1), a1 + hstepA, voffA);
            PG8_WAIT_L(8); PG8_BAR; PG8_WAIT_L(0); PG8_MMA(0, 0, At, B0); PG8_BAR; PG8_SCHED;
            PG8_LDB(B1, 0, 1); PG8_STAGE(PG8_SB(0, 0), b2, voffB);
            PG8_BAR; PG8_WAIT_L(0); PG8_MMA(0, 1, At, B1); PG8_BAR;
            PG8_LDA(At, 0, 1); PG8_STAGE(PG8_SA(0, 0), a2, voffA);
            PG8_BAR; PG8_WAIT_L(0); PG8_MMA(1, 0, At, B0); PG8_BAR; PG8_SCHED;
            PG8_STAGE(PG8_SB(0, 1), b2 + hstepB, voffB);
            PG8_WAIT_V(6); PG8_BAR; PG8_MMA(1, 1, At, B1); PG8_BAR;
            PG8_LDB(B0, 1, 0); PG8_SCHED; PG8_LDA(At, 1, 0); PG8_STAGE(PG8_SA(0, 1), a2 + hstepA, voffA);
            PG8_WAIT_L(8); PG8_BAR; PG8_WAIT_L(0); PG8_MMA(0, 0, At, B0); PG8_BAR; PG8_SCHED;
            PG8_LDB(B1, 1, 1); PG8_STAGE(PG8_SB(1, 0), b3, voffB);
            PG8_BAR; PG8_WAIT_L(0); PG8_MMA(0, 1, At, B1); PG8_BAR;
            PG8_LDA(At, 1, 1); PG8_STAGE(PG8_SA(1, 0), a3, voffA);
            PG8_BAR; PG8_WAIT_L(0); PG8_MMA(1, 0, At, B0); PG8_BAR; PG8_SCHED;
            PG8_STAGE(PG8_SB(1, 1), b3 + hstepB, voffB);
            PG8_WAIT_V(6); PG8_BAR; PG8_MMA(1, 1, At, B1); PG8_BAR;
            }
        }
        if constexpr (ALIGN_EPI) { if (wr == 0) PG8_BAR; }
        if constexpr (!Epi::AFTER_DRAIN) { E(acc, cur, ui, wr, wc, fr, fq); S.done(cur); }
        if (!has_next) break;
#pragma unroll
        for (int a = 0; a < 2; ++a)
#pragma unroll
            for (int b = 0; b < 2; ++b)
#pragma unroll
                for (int m = 0; m < 4; ++m)
#pragma unroll
                    for (int n = 0; n < 2; ++n) acc[a][b][m][n] = (f32x4){0.f, 0.f, 0.f, 0.f};
        cur = nxt; cA = nA; cB = nB; ++ui;
        if constexpr (ALIGN_EPI) { if (wr == 1) PG8_BAR; }
    }
    PG8_WAIT_V(0);
    if constexpr (!ALIGN_EPI) { if (wr == 0) PG8_BAR; }
    PG8_BAR;

#undef PG8_SA
#undef PG8_SB
#undef PG8_STAGE
#undef PG8_LDA
#undef PG8_LDB
#undef PG8_MMA
#undef PG8_WAIT_V
#undef PG8_WAIT_L
#undef PG8_BAR
#undef PG8_SCHED
}
}

constexpr int NWAVES = 8, NTHREADS = NWAVES * 64;
constexpr int BATCH = 8, SEQ = 2048, D = 1024, M = BATCH * SEQ, FF = 4096, DEPTH = 2;
constexpr int D_IN = 2312, NPROJ = 2560, PP = pg8::PROJ_PITCH;
constexpr int CQ = 0, CZ = 512, CK = 1024, CV = 1152, CX = 1280, CBM = 1792, CCM = 2048;
constexpr float EPS = 1e-6f;
constexpr int GRID = 256, NGRP = 8, GRP = GRID / NGRP;

constexpr size_t MiB = 1u << 20;
constexpr size_t WS_CTL = 0, CTL_ZERO_BYTES = 1 * MiB;
constexpr size_t WS_SSQ = 1 * MiB;
constexpr size_t WS_DTRAW = 2 * MiB;
constexpr size_t WS_ACS = 2 * MiB + 512 * 1024, WS_CHDEC = 3 * MiB;
constexpr size_t WS_WIN = 4 * MiB, WS_WOUT = 14 * MiB, WS_WUP = 18 * MiB, WS_WDOWN = 34 * MiB;
constexpr size_t WS_XB = 50 * MiB;
constexpr size_t WS_BATCH0 = 82 * MiB, BATCH_STRIDE = 20 * MiB;
constexpr size_t BO_PROJ = 0;
constexpr size_t BO_STATES = 9 * MiB;
constexpr size_t BO_PREV = 13 * MiB;
constexpr size_t BO_YPART = 15 * MiB;
constexpr size_t BO_CC = 19 * MiB;
constexpr size_t BO_HID = 0;
constexpr size_t WS_END = WS_BATCH0 + BATCH * BATCH_STRIDE;
static_assert(WS_END <= 256 * MiB, "d_ws map");
constexpr int CW_BAR = 4096, CW_GRP = 16384, GRP_BAR_STRIDE = 4096;

constexpr int RING_OFF = 0, RING_BYTES = 131072;
constexpr int LDSCTL_OFF = RING_BYTES, MISC_OFF = LDSCTL_OFF + 320, RSTD_OFF = LDSCTL_OFF + 512, PTR_OFF = RSTD_OFF + 4096;
constexpr int LDS_BYTES = 147456;
static_assert(PTR_OFF + 512 <= LDS_BYTES, "LDS map");

#define GAS __attribute__((address_space(1)))
#define LAS __attribute__((address_space(3)))
typedef unsigned short bf16;
typedef unsigned v4u __attribute__((ext_vector_type(4)));
typedef unsigned v2u __attribute__((ext_vector_type(2)));
typedef float f32x4 __attribute__((ext_vector_type(4)));
#define LDS_WAIT() asm volatile("s_waitcnt lgkmcnt(0)" ::: "memory")
#define VM_WAIT() asm volatile("s_waitcnt vmcnt(0)" ::: "memory")
__device__ __forceinline__ unsigned f2bf(float f) { unsigned u = __builtin_bit_cast(unsigned, f); return (u + 0x7fffu + ((u >> 16) & 1u)) >> 16; }
__device__ __forceinline__ unsigned pk2(float lo, float hi) { return f2bf(lo) | (f2bf(hi) << 16); }
__device__ __forceinline__ float bflo(unsigned w) { return __uint_as_float(w << 16); }
__device__ __forceinline__ float bfhi(unsigned w) { return __uint_as_float(w & 0xffff0000u); }
__device__ __forceinline__ float silu_f(float v) { return v / (1.f + expf(-v)); }
__device__ __forceinline__ float softplus_f(float v) { return fmaxf(v, 0.f) + log1pf(expf(-fabsf(v))); }

#define XB_TMO      128
#define XB_XCNT(j)  (256  + 64 * (j))
#define XB_XSUB(j)  (1280 + 64 * (j))
#define XB_XGEN(j)  (2304 + 64 * (j))
#define XB_TOP      3328
#define XB_TOPGEN   3392
#define XCD_BAR_WORDS 3456
#define XB_SPIN_CAP (1u << 22)
__device__ __forceinline__ unsigned xb_ld(unsigned* p)              { return __hip_atomic_load(p, __ATOMIC_RELAXED, __HIP_MEMORY_SCOPE_AGENT); }
__device__ __forceinline__ unsigned xb_add(unsigned* p, unsigned v) { return __hip_atomic_fetch_add(p, v, __ATOMIC_RELAXED, __HIP_MEMORY_SCOPE_AGENT); }
__device__ __forceinline__ unsigned xb_xcc_id() { return (unsigned)__builtin_amdgcn_s_getreg((3 << 11) | 20) & 0xFu; }
#define XB_SPIN(cond, bar) do { unsigned _sp = 0; while (cond) { __builtin_amdgcn_s_sleep(1); \
    if ((++_sp & 255u) == 0u) { if (xb_ld(&(bar)[XB_TMO])) break; if (_sp > XB_SPIN_CAP) { atomicAdd(&(bar)[XB_TMO], 1u); break; } } } } while (0)
struct XcdBarrier { unsigned* bar; unsigned x; unsigned total; volatile LAS unsigned* st; };
__device__ __forceinline__ XcdBarrier xcd_barrier_post(unsigned* bar, volatile LAS unsigned* st, unsigned total) {
    XcdBarrier b; b.bar = bar; b.x = xb_xcc_id(); b.total = total; b.st = st;
    if (threadIdx.x == 0) (void)xb_add(&bar[XB_XCNT(b.x)], 1u);
    return b;
}
__device__ __forceinline__ void xcd_barrier_complete(unsigned* bar, unsigned x, unsigned G, unsigned& nloc, unsigned& nx) {
    unsigned sum, cnt, mine, sp = 0u;
    for (;;) {
        sum = 0u; cnt = 0u; mine = 0u;
#pragma unroll
        for (unsigned j = 0; j < 16; ++j) { const unsigned c = xb_ld(&bar[XB_XCNT(j)]); sum += c; cnt += (c > 0u) ? 1u : 0u; mine = (j == x) ? c : mine; }
        if (sum == G) break;
        __builtin_amdgcn_s_sleep(1);
        if ((++sp & 255u) == 0u) { if (xb_ld(&bar[XB_TMO])) break; if (sp > XB_SPIN_CAP) { atomicAdd(&bar[XB_TMO], 1u); break; } }
    }
    nloc = mine > 0u ? mine : 1u; nx = cnt > 0u ? cnt : 1u;
}
__device__ __forceinline__ void xcd_barrier(const XcdBarrier& b) {
    asm volatile("s_waitcnt vmcnt(0)" ::: "memory");
    __syncthreads();
    if (threadIdx.x == 0) {
        unsigned* bar = b.bar;
        __builtin_amdgcn_s_waitcnt(0);
        unsigned nloc = b.st[0], nx = b.st[1];
        if (nloc == 0u) { xcd_barrier_complete(bar, b.x, b.total, nloc, nx); b.st[0] = nloc; b.st[1] = nx; }
        const unsigned old = xb_add(&bar[XB_XSUB(b.x)], 1u);
        const unsigned gen = old / nloc;
        if (nx == 1u) {
            XB_SPIN(xb_ld(&bar[XB_XSUB(b.x)]) < (gen + 1u) * nloc, bar);
            __builtin_amdgcn_fence(__ATOMIC_ACQUIRE, "agent");
            asm volatile("s_waitcnt vmcnt(0)" ::: "memory");
        } else if (old + 1u == (gen + 1u) * nloc) {
            __builtin_amdgcn_fence(__ATOMIC_RELEASE, "agent");
            asm volatile("s_waitcnt vmcnt(0)" ::: "memory");
            const unsigned og = xb_add(&bar[XB_TOP], 1u);
            const unsigned tg = og / nx;
            if (og + 1u == (tg + 1u) * nx) xb_add(&bar[XB_TOPGEN], 1u);
            else XB_SPIN(xb_ld(&bar[XB_TOPGEN]) == tg, bar);
            __builtin_amdgcn_fence(__ATOMIC_ACQUIRE, "agent");
            xb_add(&bar[XB_XGEN(b.x)], 1u);
            asm volatile("s_waitcnt vmcnt(0)" ::: "memory");
        } else {
            XB_SPIN(xb_ld(&bar[XB_XGEN(b.x)]) == gen, bar);
            __builtin_amdgcn_fence(__ATOMIC_ACQUIRE, "agent");
            asm volatile("s_waitcnt vmcnt(0)" ::: "memory");
        }
    }
    __syncthreads();
}

struct Frame {
    LAS unsigned char* lds;
    int tid, lane, wave, bid, G;
    int b, li;
};
enum { I_X = 0, I_MIXG, I_WIN, I_QG, I_KG, I_SINK, I_RELB, I_CONVW, I_CONVB, I_DTB, I_ALOG, I_DSKIP, I_SSMG, I_WOUT, I_MLPG, I_WUP, I_WDOWN, I_OUT, I_WS, I_NPTR };
__device__ __forceinline__ GAS unsigned char* ptr_at(const Frame& F, int i) {
    const LAS unsigned* t = (const LAS unsigned*)(F.lds + PTR_OFF) + 2 * i;
    const unsigned lo = __builtin_amdgcn_readfirstlane(t[0]), hi = __builtin_amdgcn_readfirstlane(t[1]);
    return (GAS unsigned char*)(((unsigned long long)hi << 32) | lo);
}
#define FIN(i) ((const GAS float*)ptr_at(F, (i)))
#define FWS(off) (ptr_at(F, I_WS) + (off))
#define FB(off) (ptr_at(F, I_WS) + (WS_BATCH0 + (size_t)F.b * BATCH_STRIDE + (off)))
using pg8::shx;
__device__ __forceinline__ float shup(float v, int o, int lane) { return __builtin_bit_cast(float, __builtin_amdgcn_ds_bpermute(((lane - o) & 63) << 2, __builtin_bit_cast(int, v))); }
__device__ __forceinline__ float wave_sum(float v, int lane) {
#pragma unroll
    for (int o = 1; o < 64; o <<= 1) v += shx(v, o, lane);
    return v;
}

__device__ __forceinline__ void tr_item(const GAS float* W, int Nsrc, int nsrc0, int nvalid, int K, const GAS float* gain, GAS bf16* WT, int ndst0, int k0, LAS float* scr, int lane) {
    const int n = lane & 31;
    float tv[32];
#pragma unroll
    for (int i = 0; i < 32; ++i) { const int kk = 2 * i + (lane >> 5); tv[i] = W[(size_t)(k0 + kk) * Nsrc + nsrc0 + (n < nvalid ? n : 0)]; }
#pragma unroll
    for (int i = 0; i < 32; ++i) { const int kk = 2 * i + (lane >> 5); float v = (n < nvalid) ? tv[i] : 0.f; if (gain) v *= gain[k0 + kk];
        scr[kk * 33 + n] = v; }
    LDS_WAIT(); asm volatile("" ::: "memory");
    const int c = lane & 7;
#pragma unroll
    for (int j = 0; j < 4; ++j) { const int nn = (lane >> 3) + 8 * j; const LAS float* s = scr + (8 * c) * 33 + nn;
        v4u o; o.x = pk2(s[0 * 33], s[1 * 33]); o.y = pk2(s[2 * 33], s[3 * 33]); o.z = pk2(s[4 * 33], s[5 * 33]); o.w = pk2(s[6 * 33], s[7 * 33]);
        *(GAS v4u*)(WT + (size_t)(ndst0 + nn) * K + k0 + 8 * c) = o; }
    LDS_WAIT(); asm volatile("" ::: "memory");
}
__device__ __forceinline__ void win_item(Frame& F, int L, int r, LAS float* scr);
__device__ __forceinline__ void p0_prologue(Frame& F) {
    LAS float* scr = (LAS float*)(F.lds + RING_OFF + F.wave * 16384);
    const int gw = F.bid * NWAVES + F.wave, NGW = F.G * NWAVES;
    constexpr int I_IN = 16 * 80, I_OUT = 16 * 32, I_UP = 16 * 128, I_DN = 64 * 32, I_L = I_IN + I_OUT + I_UP + I_DN;
    for (int it = gw; it < I_IN; it += NGW) win_item(F, 0, it, scr);
    const GAS float* x = FIN(I_X) + (size_t)F.b * SEQ * D; GAS bf16* XB = (GAS bf16*)FWS(WS_XB) + (size_t)F.b * SEQ * D; GAS float* SSQ = (GAS float*)FWS(WS_SSQ) + (size_t)F.b * SEQ * 16;
    for (int m = F.li * NWAVES + F.wave; m < SEQ; m += 2 * GRP * NWAVES) {
        const int m2 = m + GRP * NWAVES;
        const GAS f32x4* xr = (const GAS f32x4*)(x + (size_t)m * D) + F.lane; const GAS f32x4* xr2 = (const GAS f32x4*)(x + (size_t)m2 * D) + F.lane;
        f32x4 v[4], w[4]; float s = 0.f, s2 = 0.f;
#pragma unroll
        for (int j = 0; j < 4; ++j) { v[j] = xr[64 * j]; w[j] = xr2[64 * j]; }
#pragma unroll
        for (int j = 0; j < 4; ++j) { s += (v[j].x * v[j].x + v[j].y * v[j].y) + (v[j].z * v[j].z + v[j].w * v[j].w); s2 += (w[j].x * w[j].x + w[j].y * w[j].y) + (w[j].z * w[j].z + w[j].w * w[j].w); }
        s = wave_sum(s, F.lane); s2 = wave_sum(s2, F.lane);
        GAS v2u* o8 = (GAS v2u*)(XB + (size_t)m * D) + F.lane; GAS v2u* o82 = (GAS v2u*)(XB + (size_t)m2 * D) + F.lane;
#pragma unroll
        for (int j = 0; j < 4; ++j) { v2u o; o.x = pk2(v[j].x, v[j].y); o.y = pk2(v[j].z, v[j].w); o8[64 * j] = o; v2u o2; o2.x = pk2(w[j].x, w[j].y); o2.y = pk2(w[j].z, w[j].w); o82[64 * j] = o2; }
        if (F.lane < 16) { SSQ[(size_t)m * 16 + F.lane] = (F.lane == 0) ? s : 0.f; SSQ[(size_t)m2 * 16 + F.lane] = (F.lane == 0) ? s2 : 0.f; }
    }
}
constexpr int CW_WCNT = 8192, N_CONVERTERS = NGRP * (GRP - 16);
__device__ __forceinline__ void win_item(Frame& F, int L, int r, LAS float* scr) {
    const int kb = r / 80, nb = r % 80; int src, nv = 32;
    if (nb < 16) src = nb * 32; else if (nb < 32) src = 768 + (nb - 16) * 32; else if (nb < 36) src = 512 + (nb - 32) * 32; else if (nb < 40) src = 640 + (nb - 36) * 32;
    else if (nb < 72) src = nb * 32; else if (nb == 72) { src = 2304; nv = 8; } else { src = 0; nv = 0; }
    tr_item(FIN(I_WIN) + (size_t)L * D * D_IN, D_IN, src, nv, D, FIN(I_MIXG) + L * D, (GAS bf16*)FWS(WS_WIN) + (size_t)L * NPROJ * D, nb * 32, kb * 64, scr, F.lane);
}
__device__ __forceinline__ void convert_rest(Frame& F, int slot) {
    LAS float* scr = (LAS float*)(F.lds + RING_OFF + F.wave * 16384);
    constexpr int I_IN = 16 * 80, I_OUT = 16 * 32, I_UP = 16 * 128, I_DN = 64 * 32, NCW = N_CONVERTERS * NWAVES;
    const GAS float *w_out = FIN(I_WOUT), *w_up = FIN(I_WUP), *mlp_g = FIN(I_MLPG), *w_down = FIN(I_WDOWN);
    GAS bf16 *WOUT = (GAS bf16*)FWS(WS_WOUT), *WUP = (GAS bf16*)FWS(WS_WUP), *WDOWN = (GAS bf16*)FWS(WS_WDOWN);
    const int L = slot, n_items = I_OUT + I_UP + I_DN + (slot == 0 ? I_IN : 0);
    for (int it = (F.b * (GRP - 16) + (F.li - 16)) * NWAVES + F.wave; it < n_items; it += NCW) {
        int r = it;
        if (r < I_OUT) { const int kb = r / 32, nb = r % 32; tr_item(w_out + (size_t)L * D * D, D, nb * 32, 32, D, nullptr, WOUT + (size_t)L * D * D, nb * 32, kb * 64, scr, F.lane); continue; }
        r -= I_OUT;
        if (r < I_UP) { const int kb = r / 128, nb = r % 128; tr_item(w_up + (size_t)L * D * FF, FF, nb * 32, 32, D, mlp_g + L * D, WUP + (size_t)L * FF * D, nb * 32, kb * 64, scr, F.lane); continue; }
        r -= I_UP;
        if (r < I_DN) { const int kb = r / 32, nb = r % 32; tr_item(w_down + (size_t)L * FF * D, D, nb * 32, 32, FF, nullptr, WDOWN + (size_t)L * D * FF, nb * 32, kb * 64, scr, F.lane); continue; }
        r -= I_DN;
        win_item(F, 1, r, scr);
    }
    asm volatile("s_waitcnt vmcnt(0)" ::: "memory");
    __syncthreads();
    if (F.tid == 0) { __builtin_amdgcn_fence(__ATOMIC_RELEASE, "agent"); asm volatile("s_waitcnt vmcnt(0)" ::: "memory");
        (void)xb_add((unsigned*)(unsigned char*)FWS(WS_CTL) + CW_WCNT + 64 * slot, 1u); }
}
__device__ __forceinline__ void wait_weights(Frame& F, int part) {
    if (F.tid == 0) { unsigned* wc = (unsigned*)(unsigned char*)FWS(WS_CTL) + CW_WCNT + 64 * part; unsigned sp = 0u;
        while (xb_ld(wc) < (unsigned)N_CONVERTERS) { __builtin_amdgcn_s_sleep(2); if (++sp > (1u << 22)) break; }
        __builtin_amdgcn_fence(__ATOMIC_ACQUIRE, "agent"); asm volatile("s_waitcnt vmcnt(0)" ::: "memory"); }
    __syncthreads();
}
__device__ __forceinline__ void rstd_prepass(Frame& F, const pg8::GroupOrder& S, LAS float* tab) {
    const GAS float* SSQ = (const GAS float*)FWS(WS_SSQ) + (size_t)F.b * SEQ * 16;
    pg8::Unit u;
    for (int i = 0; i < 4 && S.next(i, u); ++i) {
        const int r = F.tid >> 1, h = F.tid & 1;
        const GAS f32x4* p = (const GAS f32x4*)(SSQ + (size_t)(u.pm * 256 + r) * 16 + h * 8);
        const f32x4 a = p[0], b = p[1];
        float s = (a.x + a.y) + (a.z + a.w) + (b.x + b.y) + (b.z + b.w);
        s += shx(s, 1, F.lane);
        if (h == 0) tab[i * 256 + r] = 1.0f / sqrtf(s * (1.0f / D) + EPS);
    }
    LDS_WAIT(); __syncthreads();
}
__device__ __forceinline__ int t5_bucket(int d) {
    if (d < 16) return d;
    return 16 + (d >= 19) + (d >= 21) + (d >= 24) + (d >= 27) + (d >= 31) + (d >= 35) + (d >= 40) + (d >= 46) + (d >= 52) + (d >= 59) + (d >= 67) + (d >= 77) + (d >= 87) + (d >= 99) + (d >= 113);
}
__device__ __forceinline__ void ld8(const GAS bf16* p, float (&v)[8]) {
    const v4u w = *(const GAS v4u*)p;
    v[0] = bflo(w.x); v[1] = bfhi(w.x); v[2] = bflo(w.y); v[3] = bfhi(w.y); v[4] = bflo(w.z); v[5] = bfhi(w.z); v[6] = bflo(w.w); v[7] = bfhi(w.w);
}
typedef short bf16x8_t __attribute__((ext_vector_type(8)));
typedef float f32x16 __attribute__((ext_vector_type(16)));
constexpr float LOG2E = 1.4426950408889634f;
__device__ __forceinline__ unsigned pkbf(float lo, float hi) { return pg8::cvt_pk_bf16(lo, hi); }
__device__ __forceinline__ int crow32(int i, int hh) { return (i & 3) + 8 * (i >> 2) + 4 * hh; }
__device__ __forceinline__ float silu_fast(float v) { return v * __builtin_amdgcn_rcpf(1.0f + __builtin_amdgcn_exp2f(-v * LOG2E)); }
__device__ __forceinline__ void unpk8(const v4u w, float (&v)[8]) {
    v[0] = bflo(w.x); v[1] = bfhi(w.x); v[2] = bflo(w.y); v[3] = bfhi(w.y); v[4] = bflo(w.z); v[5] = bfhi(w.z); v[6] = bflo(w.w); v[7] = bfhi(w.w);
}

typedef short v4i16_t __attribute__((ext_vector_type(4)));
template <int RH, int RSEC> __device__ __forceinline__ bf16x8_t tr_frag(const LAS unsigned char* img, int stride, int rbase, int cbase, int lane) {
    const LAS unsigned char* p = img + (rbase + RH * (lane >> 5) + ((lane & 15) >> 2)) * stride + (cbase + 16 * ((lane >> 4) & 1) + 4 * (lane & 3)) * 2;
    const v4i16_t a = __builtin_amdgcn_ds_read_tr16_b64_v4i16((LAS v4i16_t*)p), b = __builtin_amdgcn_ds_read_tr16_b64_v4i16((LAS v4i16_t*)(p + RSEC * stride));
    return (bf16x8_t){a[0], a[1], a[2], a[3], b[0], b[1], b[2], b[3]};
}
constexpr int AT_KS = 0, AT_KSTRIDE = 144, AT_VT = 36864, AT_VSTRIDE = 192, AT_BIAS = AT_VT + 256 * AT_VSTRIDE;
constexpr int AT_BN = 192, AT_END = AT_BIAS + 4 * AT_BN * 4;
static_assert(AT_END <= RING_BYTES, "attention LDS");
__device__ __forceinline__ void attn_fast(Frame& F, int L, bool dummy = false) {
    GAS bf16* PROJ = (GAS bf16*)FB(BO_PROJ);
    const GAS float* qg = FIN(I_QG) + L * 64; const GAS float* kg = FIN(I_KG) + L * 64; const GAS float* sinks = FIN(I_SINK) + L * 8; const GAS float* rel_bias = FIN(I_RELB);
    LAS unsigned char* Ks = F.lds + AT_KS; LAS unsigned char* Vt = F.lds + AT_VT; LAS float* biasR = (LAS float*)(F.lds + AT_BIAS);
    const int tid = F.tid, lane = F.lane, wave = F.wave, q = lane & 31, hh = lane >> 5;
    const int unit = F.li, kvh = unit >> 4, qb = unit & 15, m0 = qb * 128;
    const int gi = wave >> 1, qh = wave & 1, hq = kvh * 4 + gi;
    v4u qraw[2][4];
#pragma unroll
    for (int s = 0; s < 2; ++s)
#pragma unroll
        for (int d0 = 0; d0 < 4; ++d0) qraw[s][d0] = *(const GAS v4u*)(PROJ + (size_t)(m0 + 64 * qh + 32 * s + q) * PP + CQ + hq * 64 + d0 * 16 + hh * 8);
    v4u kwv[4], vwv[4];
#pragma unroll
    for (int i = 0; i < 4; ++i) { const int c = tid + NTHREADS * i, key = c >> 3, part = c & 7; const bool valid = (qb > 0) || (key >= 128); const unsigned msk = valid ? 0xffffffffu : 0u;
        const GAS bf16* kp = PROJ + (size_t)(valid ? m0 + key - 128 : 0) * PP + CK + kvh * 64 + part * 8;
        v4u a_ = *(const GAS v4u*)kp, b_ = *(const GAS v4u*)(kp + (CV - CK));
        a_.x &= msk; a_.y &= msk; a_.z &= msk; a_.w &= msk; b_.x &= msk; b_.y &= msk; b_.z &= msk; b_.w &= msk; kwv[i] = a_; vwv[i] = b_; }
    const f32x4 kg0 = *(const GAS f32x4*)(kg + (tid & 7) * 8), kg1 = *(const GAS f32x4*)(kg + (tid & 7) * 8 + 4);
    f32x4 qgv[4][2];
#pragma unroll
    for (int d0 = 0; d0 < 4; ++d0) { qgv[d0][0] = *(const GAS f32x4*)(qg + d0 * 16 + hh * 8); qgv[d0][1] = *(const GAS f32x4*)(qg + d0 * 16 + hh * 8 + 4); }
    const float sinkv = sinks[hq];
    float bent[2];
#pragma unroll
    for (int k = 0; k < 2; ++k) { const int x = tid + NTHREADS * k, g_ = x / AT_BN, xx = x - g_ * AT_BN; const bool ok = (x < 4 * AT_BN) && (xx >= 32) && (xx < 160);
        const float v = rel_bias[t5_bucket(ok ? 159 - xx : 0) * 8 + kvh * 4 + (ok ? g_ : 0)]; bent[k] = ok ? v * LOG2E : 0.f; }
    __syncthreads();
    biasR[tid] = bent[0]; if (tid + NTHREADS < 4 * AT_BN) biasR[tid + NTHREADS] = bent[1];
#pragma unroll
    for (int i = 0; i < 4; ++i) {
        const int c = tid + NTHREADS * i, key = c >> 3, part = c & 7;
        const v4u kw = kwv[i], vw = vwv[i];
        float kv[8]; unpk8(kw, kv);
        float ss = 0.f;
#pragma unroll
        for (int e = 0; e < 8; ++e) ss += kv[e] * kv[e];
        ss += shx(ss, 1, lane); ss += shx(ss, 2, lane); ss += shx(ss, 4, lane);
        const float rk = __builtin_amdgcn_rsqf(ss * (1.0f / 64.0f) + EPS);
        const f32x4 g0 = kg0, g1 = kg1;
        v4u ko; ko.x = pkbf(kv[0] * rk * g0.x, kv[1] * rk * g0.y); ko.y = pkbf(kv[2] * rk * g0.z, kv[3] * rk * g0.w); ko.z = pkbf(kv[4] * rk * g1.x, kv[5] * rk * g1.y); ko.w = pkbf(kv[6] * rk * g1.z, kv[7] * rk * g1.w);
        *(LAS v4u*)(Ks + key * AT_KSTRIDE + part * 16) = ko;
        *(LAS v4u*)(Vt + key * AT_VSTRIDE + part * 16) = vw;
    }
    LDS_WAIT(); __syncthreads();
    const float sink2 = sinkv * LOG2E;
    const LAS float* bb = biasR + gi * AT_BN + 31 - q + 4 * hh;
    const int qm = q - 4 * hh;
#pragma unroll
    for (int s = 0; s < 2; ++s) {
        const int a = 64 * qh + 32 * s;
        GAS bf16* qrow = PROJ + (size_t)(m0 + a + q) * PP + CQ + hq * 64;
        float qv[4][8]; float ss = 0.f;
#pragma unroll
        for (int d0 = 0; d0 < 4; ++d0) { unpk8(qraw[s][d0], qv[d0]);
#pragma unroll
            for (int e = 0; e < 8; ++e) ss += qv[d0][e] * qv[d0][e]; }
        ss += shx(ss, 32, lane);
        const float rq = __builtin_amdgcn_rsqf(ss * (1.0f / 64.0f) + EPS) * (0.125f * LOG2E);
        bf16x8_t qf[4];
#pragma unroll
        for (int d0 = 0; d0 < 4; ++d0) { const f32x4 g0 = qgv[d0][0], g1 = qgv[d0][1];
            v4u w; w.x = pkbf(qv[d0][0] * rq * g0.x, qv[d0][1] * rq * g0.y); w.y = pkbf(qv[d0][2] * rq * g0.z, qv[d0][3] * rq * g0.w);
            w.z = pkbf(qv[d0][4] * rq * g1.x, qv[d0][5] * rq * g1.y); w.w = pkbf(qv[d0][6] * rq * g1.z, qv[d0][7] * rq * g1.w);
            qf[d0] = __builtin_bit_cast(bf16x8_t, w); }
        const int kt_lo = (qb == 0) ? 4 - (a >> 5) : 0;
        f32x16 S[5]; float mx = sink2;
#pragma unroll
        for (int kt = 0; kt < 5; ++kt) { f32x16 acc = {};
#pragma unroll
            for (int d0 = 0; d0 < 4; ++d0) { const bf16x8_t kf = *(const LAS bf16x8_t*)(Ks + (a + 32 * kt + q) * AT_KSTRIDE + d0 * 32 + hh * 16);
                acc = __builtin_amdgcn_mfma_f32_32x32x16_bf16(kf, qf[d0], acc, 0, 0, 0); }
            if (kt < kt_lo) {
#pragma unroll
                for (int i = 0; i < 16; ++i) acc[i] = -INFINITY;
            } else {
#pragma unroll
                for (int i = 0; i < 16; ++i) { const int t0 = (i & 3) + 8 * (i >> 2); float v = acc[i] + bb[32 * kt + t0];
                    if (kt == 0) v = fminf(v, (t0 > qm) ? INFINITY : -INFINITY);
                    if (kt == 4) v = fminf(v, (t0 <= qm) ? INFINITY : -INFINITY);
                    acc[i] = v; mx = fmaxf(mx, v); } }
            S[kt] = acc; }
        mx = fmaxf(mx, shx(mx, 32, lane));
        float lsum = 0.f; bf16x8_t pf[5][2];
#pragma unroll
        for (int kt = 0; kt < 5; ++kt) {
#pragma unroll
            for (int i = 0; i < 16; ++i) { const float p = __builtin_amdgcn_exp2f(S[kt][i] - mx); S[kt][i] = p; lsum += p; }
#pragma unroll
            for (int s2 = 0; s2 < 2; ++s2) { v4u w; w.x = pkbf(S[kt][8 * s2 + 0], S[kt][8 * s2 + 1]); w.y = pkbf(S[kt][8 * s2 + 2], S[kt][8 * s2 + 3]);
                w.z = pkbf(S[kt][8 * s2 + 4], S[kt][8 * s2 + 5]); w.w = pkbf(S[kt][8 * s2 + 6], S[kt][8 * s2 + 7]); pf[kt][s2] = __builtin_bit_cast(bf16x8_t, w); } }
        lsum += shx(lsum, 32, lane);
        lsum += __builtin_amdgcn_exp2f(sink2 - mx);
        f32x16 O[2] = {{}, {}};
#pragma unroll
        for (int kt = 0; kt < 5; ++kt)
#pragma unroll
            for (int s2 = 0; s2 < 2; ++s2)
#pragma unroll
                for (int db = 0; db < 2; ++db)
                    O[db] = __builtin_amdgcn_mfma_f32_32x32x16_bf16(tr_frag<4, 8>(Vt, AT_VSTRIDE, a + 32 * kt + 16 * s2, 32 * db, lane), pf[kt][s2], O[db], 0, 0, 0);
        const float inv = __builtin_amdgcn_rcpf(lsum);
#pragma unroll
        for (int db = 0; db < 2; ++db)
#pragma unroll
            for (int g4 = 0; g4 < 4; ++g4) { v2u w; w.x = pkbf(O[db][4 * g4] * inv, O[db][4 * g4 + 1] * inv); w.y = pkbf(O[db][4 * g4 + 2] * inv, O[db][4 * g4 + 3] * inv);
                GAS bf16* orow = dummy ? (GAS bf16*)FB(BO_PREV) + (size_t)(m0 + a + q) * 512 + hq * 64 : qrow;
                *(GAS v2u*)(orow + 32 * db + 8 * g4 + 4 * hh) = w; }
    }
}

constexpr size_t WS_DTV = 3 * MiB + 512 * 1024;
constexpr int SD_ROW = 272, SD_XT = 264;
template <int NR> struct Raw8 { v4u u[NR + 3]; };
template <int NR> struct Raw4 { v2u u[NR + 3]; };
struct ConvW8 { f32x4 w[4][2], b[2]; };
struct ConvW4 { f32x4 w[4], b; };
template <int NR> __device__ __forceinline__ void conv_load(Raw8<NR>& R, const GAS bf16* PROJ, int m0, int c, int l0, int col0) {
#pragma unroll
    for (int i = 0; i < NR + 3; ++i) { const int row = l0 - 3 + i; const bool ok = (c > 0) || (row >= 0); const unsigned msk = ok ? 0xffffffffu : 0u;
        v4u x = *(const GAS v4u*)(PROJ + (size_t)(m0 + (ok ? row : 0)) * PP + col0); x.x &= msk; x.y &= msk; x.z &= msk; x.w &= msk; R.u[i] = x; }
}
template <int NR> __device__ __forceinline__ void conv_load(Raw4<NR>& R, const GAS bf16* PROJ, int m0, int c, int l0, int col0) {
#pragma unroll
    for (int i = 0; i < NR + 3; ++i) { const int row = l0 - 3 + i; const bool ok = (c > 0) || (row >= 0); const unsigned msk = ok ? 0xffffffffu : 0u;
        v2u x = *(const GAS v2u*)(PROJ + (size_t)(m0 + (ok ? row : 0)) * PP + col0); x.x &= msk; x.y &= msk; R.u[i] = x; }
}
__device__ __forceinline__ void convw_load(ConvW8& W, const GAS float* cw, const GAS float* cb) {
#pragma unroll
    for (int k = 0; k < 4; ++k) { W.w[k][0] = *(const GAS f32x4*)(cw + k * 1024); W.w[k][1] = *(const GAS f32x4*)(cw + k * 1024 + 4); }
    W.b[0] = *(const GAS f32x4*)cb; W.b[1] = *(const GAS f32x4*)(cb + 4);
}
__device__ __forceinline__ void convw_load(ConvW4& W, const GAS float* cw, const GAS float* cb) {
#pragma unroll
    for (int k = 0; k < 4; ++k) W.w[k] = *(const GAS f32x4*)(cw + k * 1024);
    W.b = *(const GAS f32x4*)cb;
}
template <int NR> __device__ __forceinline__ void conv_row(const Raw8<NR>& R, const ConvW8& W, int r, float (&out)[8]) {
    float acc[8];
#pragma unroll
    for (int e = 0; e < 8; ++e) acc[e] = W.b[e >> 2][e & 3];
#pragma unroll
    for (int k = 0; k < 4; ++k) { float u[8]; unpk8(R.u[r + k], u);
#pragma unroll
        for (int e = 0; e < 8; ++e) acc[e] += W.w[k][e >> 2][e & 3] * u[e]; }
#pragma unroll
    for (int e = 0; e < 8; ++e) out[e] = silu_fast(acc[e]);
}
template <int NR> __device__ __forceinline__ void conv_row(const Raw4<NR>& R, const ConvW4& W, int r, float (&out)[4]) {
    float acc[4];
#pragma unroll
    for (int e = 0; e < 4; ++e) acc[e] = W.b[e];
#pragma unroll
    for (int k = 0; k < 4; ++k) { const v2u x = R.u[r + k]; const float u[4] = {bflo(x.x), bfhi(x.x), bflo(x.y), bfhi(x.y)};
#pragma unroll
        for (int e = 0; e < 4; ++e) acc[e] += W.w[k][e] * u[e]; }
#pragma unroll
    for (int e = 0; e < 4; ++e) out[e] = silu_fast(acc[e]);
}
constexpr int S1_BSTR = 320, S1_XSTR = 576, S1_BMT = 0, S1_XW = 128 * S1_BSTR, S1_DT = S1_XW + 128 * S1_XSTR, S1_ACS = S1_DT + 2048, S1_WT = S1_ACS + 2048, S1_END = S1_WT + 64;
static_assert(S1_END <= RING_BYTES, "SSD part 1 LDS");
__device__ __forceinline__ void ssd_states(Frame& F, int L) {
    const GAS bf16* PROJ = (const GAS bf16*)FB(BO_PROJ);
    const GAS float* conv_w = FIN(I_CONVW) + (size_t)L * 4 * 1024; const GAS float* conv_b = FIN(I_CONVB) + L * 1024;
    const GAS float* dt_bias = FIN(I_DTB) + L * 8; const GAS float* a_log = FIN(I_ALOG) + L * 8;
    const GAS float* DTRAW = (const GAS float*)FWS(WS_DTRAW) + (size_t)F.b * SEQ * 8; GAS float* ACS = (GAS float*)FWS(WS_ACS) + (size_t)F.b * SEQ * 8;
    GAS float* DTV = (GAS float*)FWS(WS_DTV) + (size_t)F.b * SEQ * 8; GAS float* CHDEC = (GAS float*)FWS(WS_CHDEC) + F.b * 128;
    GAS float* STATES = (GAS float*)FB(BO_STATES);
    LAS unsigned char* BmT = F.lds + S1_BMT; LAS unsigned char* XW = F.lds + S1_XW;
    LAS float* dt_l = (LAS float*)(F.lds + S1_DT); LAS float* acs_l = (LAS float*)(F.lds + S1_ACS); LAS float* wt = (LAS float*)(F.lds + S1_WT);
    const int wave = F.wave, unit = F.li, c = unit >> 1, g = unit & 1, m0 = c * 128;
    int tid = F.tid; asm volatile("" : "+v"(tid));
    int lane = tid & 63, q = lane & 31, hh = lane >> 5;
    const int xcg = tid & 31, xl0 = (tid >> 5) * 8, xcol = CX + g * 256 + xcg * 8;
    const int bcg = tid & 15, bl0 = (tid >> 4) * 4, bcol = CBM + g * 128 + bcg * 8;
    Raw8<8> xr; ConvW8 xw; Raw8<4> br; ConvW8 bw;
    conv_load(xr, PROJ, m0, c, xl0, xcol); convw_load(xw, conv_w + (xcol - CX), conv_b + (xcol - CX));
    conv_load(br, PROJ, m0, c, bl0, bcol); convw_load(bw, conv_w + (bcol - CX), conv_b + (bcol - CX));
    const int ar = tid >> 7, al = tid & 127, ahead = 4 * g + ar;
    const float dtraw = DTRAW[(size_t)(m0 + al) * 8 + ahead], dtb = dt_bias[ahead], alog = a_log[ahead];
    __syncthreads();
    { const float dtv = softplus_f(dtraw + dtb);
      float v = dtv * (-expf(alog));
#pragma unroll
      for (int o = 1; o < 64; o <<= 1) { const float t = shup(v, o, lane); if (lane >= o) v += t; }
      if (lane == 63) wt[wave] = v;
      LDS_WAIT(); __syncthreads();
      if (wave & 1) v += wt[wave - 1];
      dt_l[tid] = dtv; acs_l[tid] = v; ACS[(size_t)(m0 + al) * 8 + ahead] = v; DTV[(size_t)(m0 + al) * 8 + ahead] = dtv;
      if (al == 127) CHDEC[c * 8 + ahead] = expf(v); }
#pragma unroll
    for (int r = 0; r < 4; ++r) { float o[8]; conv_row(br, bw, r, o);
        v4u pk; pk.x = pkbf(o[0], o[1]); pk.y = pkbf(o[2], o[3]); pk.z = pkbf(o[4], o[5]); pk.w = pkbf(o[6], o[7]);
        *(LAS v4u*)(BmT + (bl0 + r) * S1_BSTR + bcg * 16) = pk; }
    LDS_WAIT(); __syncthreads();
    { const int r4 = xcg >> 3; const float aend = acs_l[r4 * 128 + 127];
#pragma unroll
      for (int r = 0; r < 8; ++r) { float o[8]; conv_row(xr, xw, r, o); const int l = xl0 + r;
          const float sc = dt_l[r4 * 128 + l] * __builtin_amdgcn_exp2f((aend - acs_l[r4 * 128 + l]) * LOG2E);
          v4u pk; pk.x = pkbf(o[0] * sc, o[1] * sc); pk.y = pkbf(o[2] * sc, o[3] * sc); pk.z = pkbf(o[4] * sc, o[5] * sc); pk.w = pkbf(o[6] * sc, o[7] * sc);
          *(LAS v4u*)(XW + l * S1_XSTR + xcg * 16) = pk; } }
    LDS_WAIT(); __syncthreads();
    asm volatile("" : "+v"(tid)); lane = tid & 63; q = lane & 31; hh = lane >> 5;
    { const int r4 = wave >> 1, nt0 = (wave & 1) * 2, head = 4 * g + r4;
      f32x16 St[2][2] = {{{}, {}}, {{}, {}}};
#pragma unroll
      for (int ks = 0; ks < 8; ++ks) { bf16x8_t af[2], bfr[2];
#pragma unroll
          for (int pt = 0; pt < 2; ++pt) af[pt] = tr_frag<8, 4>(XW, S1_XSTR, 16 * ks, r4 * 64 + 32 * pt, lane);
#pragma unroll
          for (int nn = 0; nn < 2; ++nn) bfr[nn] = tr_frag<8, 4>(BmT, S1_BSTR, 16 * ks, 32 * (nt0 + nn), lane);
#pragma unroll
          for (int pt = 0; pt < 2; ++pt)
#pragma unroll
              for (int nn = 0; nn < 2; ++nn) St[pt][nn] = __builtin_amdgcn_mfma_f32_32x32x16_bf16(af[pt], bfr[nn], St[pt][nn], 0, 0, 0); }
      GAS float* sp = STATES + ((size_t)c * 8 + head) * 8192 + 32 * nt0 + q;
#pragma unroll
      for (int pt = 0; pt < 2; ++pt)
#pragma unroll
          for (int nn = 0; nn < 2; ++nn)
#pragma unroll
              for (int e = 0; e < 16; ++e) sp[(32 * pt + crow32(e, hh)) * 128 + 32 * nn] = St[pt][nn][e]; }
}
__device__ __forceinline__ void ssd_scan(Frame& F, int L) {
    const GAS float* STATES = (const GAS float*)FB(BO_STATES); const GAS float* CHDEC = (const GAS float*)FWS(WS_CHDEC) + F.b * 128; GAS bf16* PREV = (GAS bf16*)FB(BO_PREV);
    for (int idx = F.li * NTHREADS + F.tid; idx < 8 * 64 * 32; idx += GRP * NTHREADS) {
        const int n4 = idx & 31, p = (idx >> 5) & 63, head = idx >> 11;
        f32x4 s[16]; float dec[16];
#pragma unroll
        for (int c = 0; c < 16; ++c) { const size_t o = ((size_t)c * 8 + head) * 8192 + p * 128 + 4 * n4; s[c] = *(const GAS f32x4*)(STATES + o); dec[c] = CHDEC[c * 8 + head]; }
        f32x4 h = {0.f, 0.f, 0.f, 0.f};
#pragma unroll
        for (int c = 0; c < 16; ++c) { const size_t o = ((size_t)c * 8 + head) * 8192 + p * 128 + 4 * n4;
            v2u w; w.x = pkbf(h.x, h.y); w.y = pkbf(h.z, h.w); *(GAS v2u*)(PREV + o) = w;
            h = h * dec[c] + s[c]; }
    }
}
constexpr int S3_XSTR = 320, S3_CM = 0, S3_BM = 34816, S3_XD = 0, S3_PV = 128 * S3_XSTR, S3_PVH = 64 * SD_ROW, S3_Z = S3_PV + 2 * S3_PVH;
constexpr int S3_DT = S3_Z + 128 * SD_ROW, S3_ACS = S3_DT + 2048, S3_RSS = S3_ACS + 2048, S3_NG = S3_RSS + 2048, S3_END = S3_NG + 1024;
static_assert(S3_BM + 34816 <= S3_DT && S3_END <= RING_BYTES && 128 * 528 <= S3_DT, "SSD part 3 LDS");
__device__ __forceinline__ void ssd_out(Frame& F, int L, bool dummy = false) {
    GAS bf16* PROJ = (GAS bf16*)FB(BO_PROJ); const GAS bf16* PREV = (const GAS bf16*)FB(BO_PREV);
    const GAS float* conv_w = FIN(I_CONVW) + (size_t)L * 4 * 1024; const GAS float* conv_b = FIN(I_CONVB) + L * 1024;
    const GAS float* d_skip = FIN(I_DSKIP) + L * 8; const GAS float* ssm_g = FIN(I_SSMG) + L * 512;
    const GAS float* ACS = (const GAS float*)FWS(WS_ACS) + (size_t)F.b * SEQ * 8; const GAS float* DTV = (const GAS float*)FWS(WS_DTV) + (size_t)F.b * SEQ * 8;
    LAS unsigned char* Cm = F.lds + S3_CM; LAS unsigned char* Bm = F.lds + S3_BM; LAS unsigned char* Zt = F.lds + S3_Z;
    LAS float* dt_l = (LAS float*)(F.lds + S3_DT); LAS float* acs_l = (LAS float*)(F.lds + S3_ACS); LAS float* rss = (LAS float*)(F.lds + S3_RSS);
    const int wave = F.wave, unit = F.li, c = unit >> 1, g = unit & 1, m0 = c * 128;
    int tid = F.tid; asm volatile("" : "+v"(tid));
    int lane = tid & 63, q = lane & 31, hh = lane >> 5;
    const int bcg = tid & 31, bl0 = (tid >> 5) * 8, isC = bcg >> 4, bn0 = (bcg & 15) * 8, bcol = (isC ? CCM : CBM) + g * 128 + bn0;
    Raw8<8> br; ConvW8 bw;
    conv_load(br, PROJ, m0, c, bl0, bcol); convw_load(bw, conv_w + (bcol - CX), conv_b + (bcol - CX));
    const float dt_in = DTV[(size_t)(m0 + (tid & 127)) * 8 + 4 * g + (tid >> 7)], acs_in = ACS[(size_t)(m0 + (tid & 127)) * 8 + 4 * g + (tid >> 7)];
    const float ng_in = ssm_g[g * 256 + (tid & 255)];
    LAS float* ng_l = (LAS float*)(F.lds + S3_NG);
    __syncthreads();
    dt_l[tid] = dt_in; acs_l[tid] = acs_in * LOG2E;
    if (tid < 256) ng_l[tid] = ng_in;
#pragma unroll
    for (int r = 0; r < 8; ++r) { float o[8]; conv_row(br, bw, r, o);
        v4u pk; pk.x = pkbf(o[0], o[1]); pk.y = pkbf(o[2], o[3]); pk.z = pkbf(o[4], o[5]); pk.w = pkbf(o[6], o[7]);
        *(LAS v4u*)((isC ? Cm : Bm) + (bl0 + r) * SD_ROW + bn0 * 2) = pk; }
    v4u pw[4], zw[4]; Raw4<8> xr; ConvW4 xw;
    const int xcg = tid & 31, xl0 = (tid >> 5) * 8, xh = xcg >> 4, xp0 = (xcg & 15) * 4;
#define S3_D1_LOAD_PZ(hp_) do { \
        _Pragma("unroll") for (int k = 0; k < 4; ++k) { const int ch = tid + NTHREADS * k; \
            { const int hd = ch >> 10, rem = ch & 1023, p = rem >> 4, n8 = rem & 15; pw[k] = *(const GAS v4u*)(PREV + ((size_t)c * 8 + 4 * g + 2 * (hp_) + hd) * 8192 + p * 128 + n8 * 8); } \
            { const int l = ch >> 4, c8 = ch & 15; zw[k] = *(const GAS v4u*)(PROJ + (size_t)(m0 + l) * PP + CZ + (4 * g + 2 * (hp_)) * 64 + c8 * 8); } } } while (0)
#define S3_D1_LOAD_X(hp_) do { \
        const int col0 = CX + (4 * g + 2 * (hp_) + xh) * 64 + xp0; conv_load(xr, PROJ, m0, c, xl0, col0); convw_load(xw, conv_w + (col0 - CX), conv_b + (col0 - CX)); } while (0)
    S3_D1_LOAD_PZ(0); S3_D1_LOAD_X(0);
    LDS_WAIT(); __syncthreads();
    asm volatile("" : "+v"(tid)); lane = tid & 63; q = lane & 31; hh = lane >> 5;
    const int j = (wave < 4) ? (wave & 3) : 3 - (wave & 3), h2 = wave >> 2;
    f32x16 cbT[4]; bf16x8_t cf[8];
#pragma unroll
    for (int ks = 0; ks < 8; ++ks) cf[ks] = *(const LAS bf16x8_t*)(Cm + (32 * j + q) * SD_ROW + (16 * ks + 8 * hh) * 2);
#pragma unroll
    for (int i = 0; i < 4; ++i) { f32x16 acc = {};
        if (i <= j) {
#pragma unroll
            for (int ks = 0; ks < 8; ++ks) { const bf16x8_t bfr = *(const LAS bf16x8_t*)(Bm + (32 * i + q) * SD_ROW + (16 * ks + 8 * hh) * 2);
                acc = __builtin_amdgcn_mfma_f32_32x32x16_bf16(bfr, cf[ks], acc, 0, 0, 0); } }
        cbT[i] = acc; }
    unsigned vk[2][16];
#pragma unroll
    for (int hp = 0; hp < 2; ++hp) {
        if (hp == 1) S3_D1_LOAD_X(1);
        __syncthreads();
        {
          const int r = 2 * hp + xh;
#pragma unroll
          for (int rr = 0; rr < 8; ++rr) { float o[4]; conv_row(xr, xw, rr, o); const int l = xl0 + rr; const float dtv = dt_l[r * 128 + l];
              v2u pk; pk.x = pkbf(o[0] * dtv, o[1] * dtv); pk.y = pkbf(o[2] * dtv, o[3] * dtv);
              *(LAS v2u*)(F.lds + S3_XD + l * S3_XSTR + (xh * 64 + xp0) * 2) = pk; }
#pragma unroll
          for (int k = 0; k < 4; ++k) { const int ch = tid + NTHREADS * k;
              { const int hd = ch >> 10, rem = ch & 1023, p = rem >> 4, n8 = rem & 15; *(LAS v4u*)(F.lds + S3_PV + hd * S3_PVH + p * SD_ROW + n8 * 16) = pw[k]; }
              { const int l = ch >> 4, c8 = ch & 15; *(LAS v4u*)(Zt + l * SD_ROW + c8 * 16) = zw[k]; } } }
        LDS_WAIT(); __syncthreads();
        asm volatile("" : "+v"(tid)); lane = tid & 63; q = lane & 31; hh = lane >> 5;
        const int r = 2 * hp + h2, head = 4 * g + r;
        const LAS unsigned char* XD = F.lds + S3_XD; const LAS unsigned char* P1 = F.lds + S3_PV + h2 * S3_PVH;
        f32x16 O[2] = {{}, {}};
#pragma unroll
        for (int ks = 0; ks < 8; ++ks)
#pragma unroll
            for (int pt = 0; pt < 2; ++pt) { const bf16x8_t af = *(const LAS bf16x8_t*)(P1 + (32 * pt + q) * SD_ROW + (16 * ks + 8 * hh) * 2);
                O[pt] = __builtin_amdgcn_mfma_f32_32x32x16_bf16(af, cf[ks], O[pt], 0, 0, 0); }
        const float acl = acs_l[r * 128 + 32 * j + q], diag = d_skip[head] * __builtin_amdgcn_rcpf(dt_l[r * 128 + 32 * j + q]);
        { const float ea = __builtin_amdgcn_exp2f(acl);
#pragma unroll
          for (int pt = 0; pt < 2; ++pt)
#pragma unroll
              for (int e = 0; e < 16; ++e) O[pt][e] *= ea; }
        const int qm = q - 4 * hh;
#pragma unroll
        for (int i = 0; i < 4; ++i) { if (i <= j) {
            float xv[16];
            const LAS float* ap = acs_l + r * 128 + 32 * i + 4 * hh;
            float av[16];
#pragma unroll
            for (int e = 0; e < 16; ++e) av[e] = ap[(e & 3) + 8 * (e >> 2)];
            if (i < j) {
#pragma unroll
                for (int e = 0; e < 16; ++e) xv[e] = cbT[i][e] * __builtin_amdgcn_exp2f(acl - av[e]);
            } else {
#pragma unroll
                for (int e = 0; e < 16; ++e) { const int t0 = (e & 3) + 8 * (e >> 2);
                    const float m01 = (t0 <= qm) ? 1.0f : 0.0f, dg = (t0 == qm) ? diag : 0.0f;
                    xv[e] = cbT[i][e] * __builtin_amdgcn_exp2f(fminf(acl - av[e], 0.f)) * m01 + dg; } }
#pragma unroll
            for (int s2 = 0; s2 < 2; ++s2) { v4u w; w.x = pkbf(xv[8 * s2 + 0], xv[8 * s2 + 1]); w.y = pkbf(xv[8 * s2 + 2], xv[8 * s2 + 3]); w.z = pkbf(xv[8 * s2 + 4], xv[8 * s2 + 5]); w.w = pkbf(xv[8 * s2 + 6], xv[8 * s2 + 7]);
                const bf16x8_t xf = __builtin_bit_cast(bf16x8_t, w);
#pragma unroll
                for (int pt = 0; pt < 2; ++pt)
                    O[pt] = __builtin_amdgcn_mfma_f32_32x32x16_bf16(tr_frag<4, 8>(XD, S3_XSTR, 32 * i + 16 * s2, 64 * h2 + 32 * pt, lane), xf, O[pt], 0, 0, 0); } } }
        if (hp == 0) S3_D1_LOAD_PZ(1);
        float ss = 0.f;
#pragma unroll
        for (int pt = 0; pt < 2; ++pt)
#pragma unroll
            for (int g4 = 0; g4 < 4; ++g4) { const int p = 32 * pt + 8 * g4 + 4 * hh;
                const v2u zz = *(const LAS v2u*)(Zt + (32 * j + q) * SD_ROW + (64 * h2 + p) * 2);
                const float u0 = O[pt][4 * g4] * silu_fast(bflo(zz.x)), u1 = O[pt][4 * g4 + 1] * silu_fast(bfhi(zz.x)), u2 = O[pt][4 * g4 + 2] * silu_fast(bflo(zz.y)), u3 = O[pt][4 * g4 + 3] * silu_fast(bfhi(zz.y));
                ss += (u0 * u0 + u1 * u1) + (u2 * u2 + u3 * u3);
                vk[hp][pt * 8 + g4 * 2] = pkbf(u0, u1); vk[hp][pt * 8 + g4 * 2 + 1] = pkbf(u2, u3); }
        ss += shx(ss, 32, lane);
        if (hh == 0) rss[r * 128 + 32 * j + q] = ss;
    }
#undef S3_D1_LOAD_PZ
#undef S3_D1_LOAD_X
    LDS_WAIT(); __syncthreads();
    asm volatile("" : "+v"(tid)); lane = tid & 63; q = lane & 31; hh = lane >> 5;
    { const int l = 32 * j + q; const float tot = (rss[l] + rss[128 + l]) + (rss[256 + l] + rss[384 + l]);
      const float rn = __builtin_amdgcn_rsqf(tot * (1.0f / 256.0f) + EPS);
      LAS unsigned char* Ot = F.lds;
#pragma unroll
      for (int hp = 0; hp < 2; ++hp) { const int r = 2 * hp + h2, head = 4 * g + r;
#pragma unroll
          for (int pt = 0; pt < 2; ++pt)
#pragma unroll
              for (int g4 = 0; g4 < 4; ++g4) { const int p = 32 * pt + 8 * g4 + 4 * hh;
                  const f32x4 ng = *(const LAS f32x4*)(ng_l + r * 64 + p);
                  const unsigned w0 = vk[hp][pt * 8 + g4 * 2], w1 = vk[hp][pt * 8 + g4 * 2 + 1];
                  v2u w; w.x = pkbf(bflo(w0) * rn * ng.x, bfhi(w0) * rn * ng.y); w.y = pkbf(bflo(w1) * rn * ng.z, bfhi(w1) * rn * ng.w);
                  *(LAS v2u*)(Ot + l * 528 + (r * 64 + p) * 2) = w; } } }
    LDS_WAIT(); __syncthreads();
    asm volatile("" : "+v"(tid));
#pragma unroll
    for (int k = 0; k < 8; ++k) { const int ch = tid + NTHREADS * k, l = ch >> 5, c8 = ch & 31;
        const v4u w = *(const LAS v4u*)(F.lds + l * 528 + c8 * 16);
        GAS bf16* orow = dummy ? (GAS bf16*)FB(BO_STATES) + (size_t)(m0 + l) * 512 : PROJ + (size_t)(m0 + l) * PP + CZ;
        *(GAS v4u*)(orow + g * 256 + c8 * 8) = w; }
}

__device__ __forceinline__ void ph_inproj(Frame& F, int L) {
    LAS float* rstd_tab = (LAS float*)(F.lds + RSTD_OFF);
    int li_ = F.li; asm volatile("" : "+s"(li_)); pg8::GroupOrder S; S.init(NPROJ, li_);
    const GAS f32x4* sp = (const GAS f32x4*)((const GAS float*)FWS(WS_SSQ) + ((size_t)F.b * SEQ + (li_ & 7) * 256 + (F.tid >> 1)) * 16 + (F.tid & 1) * 8);
    pg8::Gemm g{(const GAS bf16*)FWS(WS_XB) + (size_t)F.b * SEQ * D, (const GAS bf16*)FWS(WS_WIN) + (size_t)L * NPROJ * D, SEQ, NPROJ, D, D};
    pg8::EpiProj E{(GAS bf16*)FB(BO_PROJ), (GAS float*)FWS(WS_DTRAW) + (size_t)F.b * SEQ * 8, rstd_tab, sp[0], sp[1]};
    pg8::gemm_phase<pg8::EpiProj, pg8::GroupOrder, true, true>(F.lds + RING_OFF, g, S, E);
}
__device__ __forceinline__ void ph_outproj(Frame& F, int L, bool dummy = false) {
    int li_ = F.li; asm volatile("" : "+s"(li_)); pg8::GroupOrder S; S.init(D, li_);
    pg8::Gemm g{(const GAS bf16*)FB(BO_PROJ), (const GAS bf16*)FWS(WS_WOUT) + (size_t)L * D * D, SEQ, D, D, PP};
    GAS bf16* XBb = (GAS bf16*)FWS(WS_XB) + (size_t)F.b * SEQ * D;
    pg8::EpiRes<false> E{XBb, (GAS float*)FWS(WS_SSQ) + (size_t)F.b * SEQ * 16, nullptr, dummy ? (GAS bf16*)FB(BO_YPART) : XBb};
    pg8::gemm_phase<pg8::EpiRes<false>, pg8::GroupOrder, false, true>(F.lds + RING_OFF, g, S, E);
}
__device__ __forceinline__ void ph_up(Frame& F, int L) {
    LAS float* rstd_tab = (LAS float*)(F.lds + RSTD_OFF);
    int li_ = F.li; asm volatile("" : "+s"(li_)); pg8::GroupOrder S; S.init(FF, li_);
    const GAS f32x4* sp = (const GAS f32x4*)((const GAS float*)FWS(WS_SSQ) + ((size_t)F.b * SEQ + (li_ & 7) * 256 + (F.tid >> 1)) * 16 + (F.tid & 1) * 8);
    pg8::Gemm g{(const GAS bf16*)FWS(WS_XB) + (size_t)F.b * SEQ * D, (const GAS bf16*)FWS(WS_WUP) + (size_t)L * FF * D, SEQ, FF, D, D};
    pg8::EpiUp E{(GAS bf16*)FB(BO_HID), FF, rstd_tab, sp[0], sp[1]};
    pg8::gemm_phase<pg8::EpiUp, pg8::GroupOrder, true, true>(F.lds + RING_OFF, g, S, E);
}
__device__ __forceinline__ void ph_down(Frame& F, int L, bool dummy = false) {
    int li_ = F.li; asm volatile("" : "+s"(li_)); pg8::GroupOrder S; S.init(D, li_);
    pg8::Gemm g{(const GAS bf16*)FB(BO_HID), (const GAS bf16*)FWS(WS_WDOWN) + (size_t)L * D * FF, SEQ, D, FF, FF};
    GAS bf16* XBb = (GAS bf16*)FWS(WS_XB) + (size_t)F.b * SEQ * D; GAS float* SSQb = (GAS float*)FWS(WS_SSQ) + (size_t)F.b * SEQ * 16;
    if (L == DEPTH - 1 && !dummy) { pg8::EpiRes<true> E{XBb, SSQb, (GAS float*)ptr_at(F, I_OUT) + (size_t)F.b * SEQ * D, XBb};
        pg8::gemm_phase<pg8::EpiRes<true>, pg8::GroupOrder, false, true>(F.lds + RING_OFF, g, S, E); }
    else { pg8::EpiRes<false> E{XBb, SSQb, nullptr, dummy ? (GAS bf16*)FB(16 * MiB) : XBb};
        pg8::gemm_phase<pg8::EpiRes<false>, pg8::GroupOrder, false, true>(F.lds + RING_OFF, g, S, E); }
}

#ifndef PROBE_REP
#define PROBE_REP 0
#endif
struct Args { const float* in[17]; float* out; unsigned char* ws; int pad0, pad1; };
__global__ void __launch_bounds__(NTHREADS, 2) fwd(Args args) {
    extern __shared__ __attribute__((aligned(16))) unsigned char lds[];
    Frame F;
    F.lds = (LAS unsigned char*)lds;
    F.tid = threadIdx.x; F.lane = F.tid & 63; F.wave = __builtin_amdgcn_readfirstlane(F.tid >> 6); F.bid = blockIdx.x; F.G = gridDim.x; F.b = F.bid & 7; F.li = F.bid >> 3;
    for (int u = F.tid; u < (LDS_BYTES - LDSCTL_OFF) / 4; u += NTHREADS) ((LAS unsigned*)(F.lds + LDSCTL_OFF))[u] = 0u;
    __syncthreads();
    if (F.tid < I_NPTR) { const unsigned long long p = F.tid < 17 ? (unsigned long long)args.in[F.tid < 17 ? F.tid : 0] : (F.tid == I_OUT ? (unsigned long long)args.out : (unsigned long long)args.ws);
        LAS unsigned* t = (LAS unsigned*)(F.lds + PTR_OFF) + 2 * F.tid; t[0] = (unsigned)p; t[1] = (unsigned)(p >> 32); }
    LDS_WAIT(); __syncthreads();
    if (F.G != GRID) return;
#define GBAR_OBJ() XcdBarrier{(unsigned*)(unsigned char*)FWS(WS_CTL) + CW_BAR, xb_xcc_id(), (unsigned)GRID, (volatile LAS unsigned*)(F.lds + MISC_OFF) + 8}
#define GRP_OBJ()  XcdBarrier{(unsigned*)(unsigned char*)FWS(WS_CTL) + CW_GRP + (blockIdx.x & 7) * GRP_BAR_STRIDE, xb_xcc_id(), (unsigned)GRP, (volatile LAS unsigned*)(F.lds + MISC_OFF) + 12}
    (void)xcd_barrier_post((unsigned*)(unsigned char*)FWS(WS_CTL) + CW_BAR, (volatile LAS unsigned*)(F.lds + MISC_OFF) + 8, GRID);
    (void)xcd_barrier_post((unsigned*)(unsigned char*)FWS(WS_CTL) + CW_GRP + (blockIdx.x & 7) * GRP_BAR_STRIDE, (volatile LAS unsigned*)(F.lds + MISC_OFF) + 12, GRP);
#define RELAUNDER() do { int t_ = threadIdx.x; asm volatile("" : "+v"(t_)); F.tid = t_; F.lane = t_ & 63; F.wave = __builtin_amdgcn_readfirstlane(t_ >> 6); \
    int b_ = blockIdx.x; asm volatile("" : "+s"(b_)); F.bid = b_; F.b = b_ & 7; F.li = b_ >> 3; } while (0)
#define GRP_BAR() do { const XcdBarrier gb_ = GRP_OBJ(); xcd_barrier(gb_); } while (0)
#define GRID_BAR() do { const XcdBarrier gb_ = GBAR_OBJ(); xcd_barrier(gb_); } while (0)

    p0_prologue(F);
    if (PROBE_REP == 1) { GRID_BAR(); RELAUNDER(); p0_prologue(F); }
    GRID_BAR();
    for (int L = 0; L < DEPTH; ++L) {
        RELAUNDER(); ph_inproj(F, L); if (PROBE_REP == 2) { GRP_BAR(); RELAUNDER(); ph_inproj(F, L); }
        if (F.li >= 16) { RELAUNDER(); convert_rest(F, L); }
        GRP_BAR();
        RELAUNDER(); if (PROBE_REP == 20) { attn_fast(F, L, true); GRP_BAR(); RELAUNDER(); }
        if (PROBE_REP == 25) {
#pragma unroll 1
            for (int rep = 0; rep < 2; ++rep) { attn_fast(F, L, rep == 0); if (rep == 0) { GRP_BAR(); RELAUNDER(); } } }
        else attn_fast(F, L);
        ssd_states(F, L); if (PROBE_REP == 21) { GRP_BAR(); RELAUNDER(); ssd_states(F, L); } GRP_BAR();
        RELAUNDER(); ssd_scan(F, L); if (PROBE_REP == 22) { GRP_BAR(); RELAUNDER(); ssd_scan(F, L); } if (PROBE_REP == 24) { for (int k = 0; k < 8; ++k) GRP_BAR(); } GRP_BAR();
        RELAUNDER(); if (PROBE_REP == 23) { ssd_out(F, L, true); GRP_BAR(); RELAUNDER(); } ssd_out(F, L); GRP_BAR();
        RELAUNDER(); wait_weights(F, L); if (PROBE_REP == 30) { ph_outproj(F, L, true); GRP_BAR(); RELAUNDER(); } ph_outproj(F, L); GRP_BAR();
        RELAUNDER(); ph_up(F, L); if (PROBE_REP == 5) { GRP_BAR(); RELAUNDER(); ph_up(F, L); } GRP_BAR();
        RELAUNDER(); if (PROBE_REP == 31) { ph_down(F, L, true); GRP_BAR(); RELAUNDER(); } ph_down(F, L); if (L + 1 < DEPTH) GRP_BAR();
    }
}

extern "C" void kernel_launch(void* const* d_in, const int* in_sizes, int n_in, void* d_out, int out_size, void* d_ws, size_t ws_size, hipStream_t stream) {
    static int grid = 0;
    if (grid == 0) {
        if (n_in != 17 || in_sizes[0] != M * D || out_size != M * D || ws_size < WS_END) { fprintf(stderr, "kernel_launch: unexpected shapes (n_in %d, in0 %d, out %d, ws %zu)\n", n_in, n_in > 0 ? in_sizes[0] : -1, out_size, ws_size); grid = -1; return; }
        int dev = 0, cus = 0, per_cu = 0;
        if (hipGetDevice(&dev) != hipSuccess || hipDeviceGetAttribute(&cus, hipDeviceAttributeMultiprocessorCount, dev) != hipSuccess) { grid = -1; return; }
        if (hipFuncSetAttribute((const void*)fwd, hipFuncAttributeMaxDynamicSharedMemorySize, LDS_BYTES) != hipSuccess) { fprintf(stderr, "kernel_launch: hipFuncSetAttribute failed\n"); grid = -1; return; }
        if (hipOccupancyMaxActiveBlocksPerMultiprocessor(&per_cu, (const void*)fwd, NTHREADS, LDS_BYTES) != hipSuccess || per_cu < 1) { fprintf(stderr, "kernel_launch: occupancy query says %d\n", per_cu); per_cu = 0; }
        (void)hipGetLastError();
        if (cus * per_cu < GRID) { fprintf(stderr, "kernel_launch: this kernel needs %d co-resident workgroups (one per CU of a 256-CU device); the device admits %d x %d; nothing launched\n", GRID, cus, per_cu); grid = -1; return; }
        grid = GRID;
    }
    if (grid < 0) return;
    (void)hipMemsetAsync((char*)d_ws + WS_CTL, 0, CTL_ZERO_BYTES, stream);
    Args a{};
    for (int i = 0; i < 17; ++i) a.in[i] = (const float*)d_in[i];
    a.out = (float*)d_out; a.ws = (unsigned char*)d_ws;
    void* kargs[] = {&a};
    hipError_t e = hipLaunchCooperativeKernel((const void*)fwd, dim3(grid), dim3(NTHREADS), kargs, LDS_BYTES, stream);
    if (e != hipSuccess) fprintf(stderr, "kernel_launch: cooperative launch failed: %s (grid %d)\n", hipGetErrorString(e), grid);
}
```

```cpp
#include <hip/hip_runtime.h>
#include <cstdio>
#include <cstdint>
#define PROBE_REP 0


namespace pg8 {
#define PG8_LAS __attribute__((address_space(3)))
#define PG8_GAS __attribute__((address_space(1)))
typedef unsigned short bf16_t;
typedef short bf16x8 __attribute__((ext_vector_type(8)));
typedef float f32x4 __attribute__((ext_vector_type(4)));
typedef unsigned u32x4 __attribute__((ext_vector_type(4)));
constexpr int BM = 256, BK = 64, HALF = 128, HTB = HALF * BK * 2  , STAGE_BYTES = 8 * HTB, NXCD = 8, WGM = 8;

__host__ __device__ __forceinline__ int lds_byte(int r, int c) { const int st = (r >> 4) * 2 + (c >> 5), rr = r & 15, cc = c & 31, ob = rr * 64 + cc * 2; return st * 1024 + (ob ^ (((ob >> 9) & 1) << 5)); }
__host__ __device__ __forceinline__ void stage_rc(int b, int& R, int& C) { const int st = b / 1024, sb = b % 1024, swz = sb ^ (((sb >> 9) & 1) << 5); R = (st >> 1) * 16 + swz / 64; C = (st & 1) * 32 + (swz % 64) / 2; }
__host__ __device__ __forceinline__ int perm32(int rho) { const int n = rho >> 4, i = rho & 15; return 8 * (i >> 2) + 4 * n + (i & 3); }

struct Unit { int pm, pn; };
struct Gemm { const PG8_GAS bf16_t* A; const PG8_GAS bf16_t* Bt; int M, N, K, lda; };

struct StaticOrder {
    int nM, nN, nwg, G, c;
    __host__ __device__ void init(int M, int N, int G_, int c_) { nM = M / BM; nN = N / BM; nwg = nM * nN; G = G_; c = c_; }
    __host__ __device__ bool next(int i, Unit& u) const {
        const long L = (long)i * G + c; if (L >= nwg) return false;
        int wgid = (int)L; { const int q = nwg / NXCD, r = nwg % NXCD, xcd = wgid % NXCD, off = wgid / NXCD; wgid = (xcd < r ? xcd * (q + 1) : r * (q + 1) + (xcd - r) * q) + off; }
        const int nig = WGM * nN, gid = wgid / nig, fm = gid * WGM, gsz = (nM - fm) < WGM ? (nM - fm) : WGM;
        u.pm = fm + ((wgid % nig) % gsz); u.pn = (wgid % nig) / gsz; return true;
    }
    __device__ __forceinline__ void a_ready(const Unit&) const {}
    __device__ __forceinline__ void done(const Unit&) const {}
};

struct GroupOrder {
    int nN, li;
    __host__ __device__ void init(int N, int li_) { nN = N / BM; li = li_; }
    __host__ __device__ bool next(int i, Unit& u) const { const int T = i * 32 + li; if (T >= 8 * nN) return false; u.pm = T & 7; u.pn = T >> 3; return true; }
    __device__ __forceinline__ void a_ready(const Unit&) const {}
    __device__ __forceinline__ void done(const Unit&) const {}
};

__device__ __forceinline__ float shx(float v, int k, int lane) { return __builtin_bit_cast(float, __builtin_amdgcn_ds_bpermute((lane ^ k) << 2, __builtin_bit_cast(int, v))); }
typedef float f32x2_t __attribute__((ext_vector_type(2))); typedef __bf16 bf16x2_t __attribute__((ext_vector_type(2)));
__device__ __forceinline__ unsigned cvt_pk_bf16(float lo, float hi) { f32x2_t v = {lo, hi}; bf16x2_t b = __builtin_convertvector(v, bf16x2_t); return __builtin_bit_cast(unsigned, b); }

constexpr int PROJ_PITCH = 2304, DT_TILE = 9;
struct EpiProj {
    static constexpr bool PERM = true, AFTER_DRAIN = false, ACC_INIT = false, PRE_HOOK = true;
    PG8_GAS bf16_t* O; PG8_GAS float* dtraw; PG8_LAS float* rstd; f32x4 pa, pb;
    __device__ __forceinline__ void pre(int tid) const {
        float s = (pa[0] + pa[1]) + (pa[2] + pa[3]) + (pb[0] + pb[1]) + (pb[2] + pb[3]);
        s += shx(s, 1, tid & 63);
        if ((tid & 1) == 0) rstd[tid >> 1] = 1.0f / sqrtf(s * (1.0f / 1024.0f) + 1e-6f);
    }
    __device__ __forceinline__ void operator()(const f32x4 (&acc)[2][2][4][2], const Unit& u, int ui, int wr, int wc, int fr, int fq) const {
        int rt0 = wr * 64 + fr; asm volatile("" : "+v"(rt0));
        if (u.pn == DT_TILE) {
            if (wc == 0 && fq == 0) {
#pragma unroll
                for (int ai = 0; ai < 2; ++ai)
#pragma unroll
                    for (int m = 0; m < 4; ++m) { const int rt = ai * HALF + rt0 + m * 16; const float rs = rstd[rt]; PG8_GAS float* p = dtraw + (size_t)(u.pm * BM + rt) * 8;
                        *(PG8_GAS f32x4*)p = acc[ai][0][m][0] * rs; *(PG8_GAS f32x4*)(p + 4) = acc[ai][0][m][1] * rs; }
            }
            return;
        }
        const int col0 = u.pn * BM + wc * 32 + 8 * fq;
#pragma unroll
        for (int ai = 0; ai < 2; ++ai)
#pragma unroll
            for (int m = 0; m < 4; ++m) { const int rt = ai * HALF + rt0 + m * 16; const float rs = rstd[rt]; PG8_GAS bf16_t* rowp = O + (size_t)(u.pm * BM + rt) * PROJ_PITCH + col0;
#pragma unroll
                for (int bj = 0; bj < 2; ++bj) { const f32x4 v0 = acc[ai][bj][m][0] * rs, v1 = acc[ai][bj][m][1] * rs;
                    u32x4 w; w.x = cvt_pk_bf16(v0[0], v0[1]); w.y = cvt_pk_bf16(v0[2], v0[3]); w.z = cvt_pk_bf16(v1[0], v1[1]); w.w = cvt_pk_bf16(v1[2], v1[3]);
                    *(PG8_GAS u32x4*)(rowp + bj * HALF) = w; } }
    }
};
struct EpiUp {
    static constexpr bool PERM = true, AFTER_DRAIN = false, ACC_INIT = false, PRE_HOOK = true;
    PG8_GAS bf16_t* O; int ldc; PG8_LAS float* rstd; f32x4 pa, pb;
    __device__ __forceinline__ void pre(int tid) const {
        float s = (pa[0] + pa[1]) + (pa[2] + pa[3]) + (pb[0] + pb[1]) + (pb[2] + pb[3]);
        s += shx(s, 1, tid & 63);
        if ((tid & 1) == 0) rstd[tid >> 1] = 1.0f / sqrtf(s * (1.0f / 1024.0f) + 1e-6f);
    }
    __device__ __forceinline__ void operator()(const f32x4 (&acc)[2][2][4][2], const Unit& u, int ui, int wr, int wc, int fr, int fq) const {
        int rt0 = wr * 64 + fr; asm volatile("" : "+v"(rt0)); const int col0 = u.pn * BM + wc * 32 + 8 * fq;
#pragma unroll
        for (int ai = 0; ai < 2; ++ai)
#pragma unroll
            for (int m = 0; m < 4; ++m) { const int rt = ai * HALF + rt0 + m * 16; const float rs = rstd[rt]; PG8_GAS bf16_t* rowp = O + (size_t)(u.pm * BM + rt) * ldc + col0;
#pragma unroll
                for (int bj = 0; bj < 2; ++bj) { f32x4 v0 = acc[ai][bj][m][0] * rs, v1 = acc[ai][bj][m][1] * rs;
#pragma unroll
                    for (int e = 0; e < 4; ++e) { const float a = fmaxf(v0[e], 0.f), b = fmaxf(v1[e], 0.f); v0[e] = a * a; v1[e] = b * b; }
                    u32x4 w; w.x = cvt_pk_bf16(v0[0], v0[1]); w.y = cvt_pk_bf16(v0[2], v0[3]); w.z = cvt_pk_bf16(v1[0], v1[1]); w.w = cvt_pk_bf16(v1[2], v1[3]);
                    *(PG8_GAS u32x4*)(rowp + bj * HALF) = w; } }
    }
};
template <bool FINAL> struct EpiRes {
    static constexpr bool PERM = true, AFTER_DRAIN = false, ACC_INIT = true, PRE_HOOK = false;
    PG8_GAS bf16_t* xb; PG8_GAS float* ssq; PG8_GAS float* out; PG8_GAS bf16_t* xdst;
    __device__ __forceinline__ void init(f32x4 (&acc)[2][2][4][2], const Unit& u, int wr, int wc, int fr, int fq) const {
        const int rt0 = wr * 64 + fr, col0 = u.pn * BM + wc * 32 + 8 * fq;
#pragma unroll
        for (int ai = 0; ai < 2; ++ai)
#pragma unroll
            for (int m = 0; m < 4; ++m) { const int row = u.pm * BM + ai * HALF + rt0 + m * 16; const size_t off = (size_t)row * 1024 + col0;
#pragma unroll
                for (int bj = 0; bj < 2; ++bj) { const u32x4 rw = *(const PG8_GAS u32x4*)(xb + off + bj * HALF);
                    acc[ai][bj][m][0] = (f32x4){__uint_as_float(rw.x << 16), __uint_as_float(rw.x & 0xffff0000u), __uint_as_float(rw.y << 16), __uint_as_float(rw.y & 0xffff0000u)};
                    acc[ai][bj][m][1] = (f32x4){__uint_as_float(rw.z << 16), __uint_as_float(rw.z & 0xffff0000u), __uint_as_float(rw.w << 16), __uint_as_float(rw.w & 0xffff0000u)}; } }
    }
    __device__ __forceinline__ void operator()(const f32x4 (&acc)[2][2][4][2], const Unit& u, int ui, int wr, int wc, int fr, int fq) const {
        int rt0 = wr * 64 + fr; asm volatile("" : "+v"(rt0)); const int col0 = u.pn * BM + wc * 32 + 8 * fq;
#pragma unroll
        for (int ai = 0; ai < 2; ++ai)
#pragma unroll
            for (int m = 0; m < 4; ++m) { const int row = u.pm * BM + ai * HALF + rt0 + m * 16; const size_t off = (size_t)row * 1024 + col0; float s = 0.f;
#pragma unroll
                for (int bj = 0; bj < 2; ++bj) { const f32x4 v0 = acc[ai][bj][m][0], v1 = acc[ai][bj][m][1];
                    if (FINAL) { *(PG8_GAS f32x4*)(out + off + bj * HALF) = v0; *(PG8_GAS f32x4*)(out + off + bj * HALF + 4) = v1; }
                    else { u32x4 w; w.x = cvt_pk_bf16(v0[0], v0[1]); w.y = cvt_pk_bf16(v0[2], v0[3]); w.z = cvt_pk_bf16(v1[0], v1[1]); w.w = cvt_pk_bf16(v1[2], v1[3]);
                        *(PG8_GAS u32x4*)(xdst + off + bj * HALF) = w;
                        s += (v0[0] * v0[0] + v0[1] * v0[1]) + (v0[2] * v0[2] + v0[3] * v0[3]) + (v1[0] * v1[0] + v1[1] * v1[1]) + (v1[2] * v1[2] + v1[3] * v1[3]); } }
                if (!FINAL) { const int ln = fq * 16 + fr; s += shx(s, 16, ln); s += shx(s, 32, ln);
                    if (fq == 0) ssq[(size_t)row * 16 + u.pn * 4 + wc] = s; } }
    }
};

template <class Epi, class Sched, bool ALIGN_EPI = false, bool SP2 = false>
__device__ __forceinline__ void gemm_phase(PG8_LAS unsigned char* lds, const Gemm g, const Sched& S, const Epi& E) {
    int tid_ = threadIdx.x; asm volatile("" : "+v"(tid_));
    const int tid = tid_, wid = __builtin_amdgcn_readfirstlane(tid >> 6), lane = tid & 63, wr = wid >> 2, wc = wid & 3, fr = lane & 15, fq = lane >> 4;
    const int K = g.K, nt = K / BK;
    unsigned voffA[2], voffB[2];
#pragma unroll
    for (int i = 0; i < 2; ++i) { int R, C; stage_rc(tid * 16 + i * 8192, R, C); const int Rb = Epi::PERM ? ((R & ~31) + perm32(R & 31)) : R;
        voffA[i] = (unsigned)(R * g.lda + C) * 2u; voffB[i] = (unsigned)(Rb * K + C) * 2u; }
    const size_t kstep = (size_t)(BK * 2);
    const size_t hstepA = (size_t)HALF * g.lda * 2, hstepB = (size_t)HALF * K * 2;
    const size_t tstepA = 2 * hstepA, tstepB = 2 * hstepB;
    const unsigned ldsw = (unsigned)wid * 1024u;
    const int aoff = lds_byte(wr * 64 + fr, fq * 8), boff = lds_byte(wc * 32 + fr, fq * 8);
#define PG8_SA(b, h) (((b) * 2 + (h)) * HTB)
#define PG8_SB(b, h) ((4 + (b) * 2 + (h)) * HTB)
#define PG8_STAGE(bufoff, gbase, voff) do { _Pragma("unroll") for (int _i = 0; _i < 2; ++_i) \
        __builtin_amdgcn_global_load_lds((const unsigned*)((const char*)(gbase) + (voff)[_i]), (PG8_LAS unsigned*)(lds + (bufoff) + ldsw + _i * 8192), 16, 0, 0); } while (0)
#define PG8_LDA(dst, b, h) do { _Pragma("unroll") for (int m = 0; m < 4; ++m) _Pragma("unroll") for (int k = 0; k < 2; ++k) dst[m][k] = *(const PG8_LAS bf16x8*)(lds + PG8_SA(b, h) + aoff + m * 2048 + k * 1024); } while (0)
#define PG8_LDB(dst, b, h) do { _Pragma("unroll") for (int n = 0; n < 2; ++n) _Pragma("unroll") for (int k = 0; k < 2; ++k) dst[n][k] = *(const PG8_LAS bf16x8*)(lds + PG8_SB(b, h) + boff + n * 2048 + k * 1024); } while (0)
#define PG8_MMA(ai, bj, At, Bt) do { __builtin_amdgcn_s_setprio(1); _Pragma("unroll") for (int m = 0; m < 4; ++m) _Pragma("unroll") for (int n = 0; n < 2; ++n) _Pragma("unroll") for (int k = 0; k < 2; ++k) \
        acc[ai][bj][m][n] = __builtin_amdgcn_mfma_f32_16x16x32_bf16(Bt[n][k], At[m][k], acc[ai][bj][m][n], 0, 0, 0); __builtin_amdgcn_s_setprio(0); } while (0)
#define PG8_WAIT_V(n) asm volatile("s_waitcnt vmcnt(" #n ")" ::: "memory")
#define PG8_WAIT_L(n) asm volatile("s_waitcnt lgkmcnt(" #n ")" ::: "memory")
#define PG8_BAR __builtin_amdgcn_s_barrier()
#define PG8_SCHED __builtin_amdgcn_sched_barrier(0)
    Unit cur, nxt; int ui = 0;
    if (!S.next(0, cur)) return;
    f32x4 acc[2][2][4][2];
#pragma unroll
    for (int a = 0; a < 2; ++a)
#pragma unroll
        for (int b = 0; b < 2; ++b)
#pragma unroll
            for (int m = 0; m < 4; ++m)
#pragma unroll
                for (int n = 0; n < 2; ++n) acc[a][b][m][n] = (f32x4){0.f, 0.f, 0.f, 0.f};
    if constexpr (Epi::ACC_INIT) E.init(acc, cur, wr, wc, fr, fq);
    bf16x8 At[4][2], B0[2][2], B1[2][2];
    const char* cA = (const char*)g.A + (size_t)cur.pm * tstepA; const char* cB = (const char*)g.Bt + (size_t)cur.pn * tstepB;
    S.a_ready(cur);
    if constexpr (SP2) {
        PG8_STAGE(PG8_SB(0, 0), cB, voffB); PG8_STAGE(PG8_SB(0, 1), cB + hstepB, voffB); PG8_STAGE(PG8_SA(0, 0), cA, voffA); PG8_STAGE(PG8_SA(0, 1), cA + hstepA, voffA);
        if constexpr (Epi::PRE_HOOK) E.pre(tid);
        if (wr == 1) PG8_BAR;
        PG8_WAIT_V(2); PG8_BAR;
        PG8_STAGE(PG8_SB(1, 0), cB + kstep, voffB); PG8_STAGE(PG8_SA(1, 0), cA + kstep, voffA); PG8_STAGE(PG8_SB(1, 1), cB + hstepB + kstep, voffB);
        PG8_WAIT_V(6); PG8_BAR;
    } else {
        PG8_STAGE(PG8_SB(0, 0), cB, voffB); PG8_STAGE(PG8_SA(0, 0), cA, voffA); PG8_STAGE(PG8_SB(0, 1), cB + hstepB, voffB); PG8_STAGE(PG8_SA(0, 1), cA + hstepA, voffA);
        if (wr == 1) PG8_BAR;
        PG8_WAIT_V(4); PG8_BAR;
        PG8_STAGE(PG8_SB(1, 0), cB + kstep, voffB); PG8_STAGE(PG8_SA(1, 0), cA + kstep, voffA); PG8_STAGE(PG8_SB(1, 1), cB + hstepB + kstep, voffB);
        PG8_WAIT_V(6); PG8_BAR;
    }
    for (;;) {
        const bool has_next = S.next(ui + 1, nxt);
        const char* nA = has_next ? (const char*)g.A + (size_t)nxt.pm * tstepA : cA; const char* nB = has_next ? (const char*)g.Bt + (size_t)nxt.pn * tstepB : cB;
        for (int t = 0; t < nt; t += 2) {
            const bool last = (t == nt - 2);
            const char* a1 = cA + (size_t)(t + 1) * kstep;
            const char* a2 = last ? nA : cA + (size_t)(t + 2) * kstep; const char* b2 = last ? nB : cB + (size_t)(t + 2) * kstep;
            const char* a3 = a2 + kstep; const char* b3 = b2 + kstep;
            if (last && has_next) S.a_ready(nxt);
            if constexpr (SP2) {
            PG8_LDB(B0, 0, 0); PG8_LDB(B1, 0, 1); PG8_SCHED; PG8_LDA(At, 0, 0); PG8_STAGE(PG8_SA(1, 1), a1 + hstepA, voffA);
            PG8_WAIT_V(8); PG8_WAIT_L(0); PG8_BAR; PG8_MMA(0, 0, At, B0); PG8_MMA(0, 1, At, B1); PG8_BAR; PG8_SCHED;
            PG8_LDA(At, 0, 1); PG8_STAGE(PG8_SB(0, 0), b2, voffB); PG8_STAGE(PG8_SB(0, 1), b2 + hstepB, voffB); PG8_STAGE(PG8_SA(0, 0), a2, voffA);
            PG8_WAIT_V(8); PG8_WAIT_L(0); PG8_BAR; PG8_MMA(1, 0, At, B0); PG8_MMA(1, 1, At, B1); PG8_BAR; PG8_SCHED;
            PG8_LDB(B0, 1, 0); PG8_LDB(B1, 1, 1); PG8_SCHED; PG8_LDA(At, 1, 0); PG8_STAGE(PG8_SA(0, 1), a2 + hstepA, voffA);
            PG8_WAIT_V(8); PG8_WAIT_L(0); PG8_BAR; PG8_MMA(0, 0, At, B0); PG8_MMA(0, 1, At, B1); PG8_BAR; PG8_SCHED;
            PG8_LDA(At, 1, 1); PG8_STAGE(PG8_SB(1, 0), b3, voffB); PG8_STAGE(PG8_SB(1, 1), b3 + hstepB, voffB); PG8_STAGE(PG8_SA(1, 0), a3, voffA);
            PG8_WAIT_V(8); PG8_WAIT_L(0); PG8_BAR; PG8_MMA(1, 0, At, B0); PG8_MMA(1, 1, At, B1); PG8_BAR; PG8_SCHED;
            } else {
            PG8_LDB(B0, 0, 0); PG8_SCHED; PG8_LDA(At, 0, 0); PG8_STAGE(PG8_SA(1, 1), a1 + hstepA, voffA);
            PG8_WAIT_L(8); PG8_BAR; PG8_WAIT_L(0); PG8_MMA(0, 0, At, B0); PG8_BAR; PG8_SCHED;
            PG8_LDB(B1, 0, 1); PG8_STAGE(PG8_SB(0, 0), b2, voffB);
            PG8_BAR; PG8_WAIT_L(0); PG8_MMA(0, 1, At, B1); PG8_BAR;
            PG8_LDA(At, 0, 1); PG8_STAGE(PG8_SA(0, 0), a2, voffA);
            PG8_BAR; PG8_WAIT_L(0); PG8_MMA(1, 0, At, B0); PG8_BAR; PG8_SCHED;
            PG8_STAGE(PG8_SB(0, 1), b2 + hstepB, voffB);
            PG8_WAIT_V(6); PG8_BAR; PG8_MMA(1, 1, At, B1); PG8_BAR;
            PG8_LDB(B0, 1, 0); PG8_SCHED; PG8_LDA(At, 1, 0); PG8_STAGE(PG8_SA(0, 1), a2 + hstepA, voffA);
            PG8_WAIT_L(8); PG8_BAR; PG8_WAIT_L(0); PG8_MMA(0, 0, At, B0); PG8_BAR; PG8_SCHED;
            PG8_LDB(B1, 1, 1); PG8_STAGE(PG8_SB(1, 0), b3, voffB);
            PG8_BAR; PG8_WAIT_L(0); PG8_MMA(0, 1, At, B1); PG8_BAR;
            PG8_LDA(At, 1, 1); PG8_STAGE(PG8_SA(1, 0), a3, voffA);
            PG8_BAR; PG8_WAIT_L(0); PG8_MMA(1, 0, At, B0); PG8_BAR; PG8_SCHED;
            PG8_STAGE(PG8_SB(1, 1), b3 + hstepB, voffB);
            PG8_WAIT_V(6); PG8_BAR; PG8_MMA(1, 1, At, B1); PG8_BAR;
            }
        }
        if constexpr (ALIGN_EPI) { if (wr == 0) PG8_BAR; }
        if constexpr (!Epi::AFTER_DRAIN) { E(acc, cur, ui, wr, wc, fr, fq); S.done(cur); }
        if (!has_next) break;
#pragma unroll
        for (int a = 0; a < 2; ++a)
#pragma unroll
            for (int b = 0; b < 2; ++b)
#pragma unroll
                for (int m = 0; m < 4; ++m)
#pragma unroll
                    for (int n = 0; n < 2; ++n) acc[a][b][m][n] = (f32x4){0.f, 0.f, 0.f, 0.f};
        cur = nxt; cA = nA; cB = nB; ++ui;
        if constexpr (ALIGN_EPI) { if (wr == 1) PG8_BAR; }
    }
    PG8_WAIT_V(0);
    if constexpr (!ALIGN_EPI) { if (wr == 0) PG8_BAR; }
    PG8_BAR;

#undef PG8_SA
#undef PG8_SB
#undef PG8_STAGE
#undef PG8_LDA
#undef PG8_LDB
#undef PG8_MMA
#undef PG8_WAIT_V
#undef PG8_WAIT_L
#undef PG8_BAR
#undef PG8_SCHED
}
}

constexpr int NWAVES = 8, NTHREADS = NWAVES * 64;
constexpr int BATCH = 8, SEQ = 2048, D = 1024, M = BATCH * SEQ, FF = 4096, DEPTH = 2;
constexpr int D_IN = 2312, NPROJ = 2560, PP = pg8::PROJ_PITCH;
constexpr int CQ = 0, CZ = 512, CK = 1024, CV = 1152, CX = 1280, CBM = 1792, CCM = 2048;
constexpr float EPS = 1e-6f;
constexpr int GRID = 256, NGRP = 8, GRP = GRID / NGRP;

constexpr size_t MiB = 1u << 20;
constexpr size_t WS_CTL = 0, CTL_ZERO_BYTES = 1 * MiB;
constexpr size_t WS_SSQ = 1 * MiB;
constexpr size_t WS_DTRAW = 2 * MiB;
constexpr size_t WS_ACS = 2 * MiB + 512 * 1024, WS_CHDEC = 3 * MiB;
constexpr size_t WS_WIN = 4 * MiB, WS_WOUT = 14 * MiB, WS_WUP = 18 * MiB, WS_WDOWN = 34 * MiB;
constexpr size_t WS_XB = 50 * MiB;
constexpr size_t WS_BATCH0 = 82 * MiB, BATCH_STRIDE = 20 * MiB;
constexpr size_t BO_PROJ = 0;
constexpr size_t BO_STATES = 9 * MiB;
constexpr size_t BO_PREV = 13 * MiB;
constexpr size_t BO_YPART = 15 * MiB;
constexpr size_t BO_CC = 19 * MiB;
constexpr size_t BO_HID = 0;
constexpr size_t WS_END = WS_BATCH0 + BATCH * BATCH_STRIDE;
static_assert(WS_END <= 256 * MiB, "d_ws map");
constexpr int CW_BAR = 4096, CW_GRP = 16384, GRP_BAR_STRIDE = 4096;

constexpr int RING_OFF = 0, RING_BYTES = 131072;
constexpr int MIX_BYTES = 155648;
constexpr int LDSCTL_OFF = MIX_BYTES, MISC_OFF = LDSCTL_OFF + 320, RSTD_OFF = LDSCTL_OFF + 512, PTR_OFF = RSTD_OFF + 4096;
constexpr int LDS_BYTES = 163840;
static_assert(PTR_OFF + 512 <= LDS_BYTES && RING_BYTES <= MIX_BYTES, "LDS map");

#define GAS __attribute__((address_space(1)))
#define LAS __attribute__((address_space(3)))
typedef unsigned short bf16;
typedef unsigned v4u __attribute__((ext_vector_type(4)));
typedef unsigned v2u __attribute__((ext_vector_type(2)));
typedef float f32x4 __attribute__((ext_vector_type(4)));
#define LDS_WAIT() asm volatile("s_waitcnt lgkmcnt(0)" ::: "memory")
#define VM_WAIT() asm volatile("s_waitcnt vmcnt(0)" ::: "memory")
__device__ __forceinline__ unsigned f2bf(float f) { unsigned u = __builtin_bit_cast(unsigned, f); return (u + 0x7fffu + ((u >> 16) & 1u)) >> 16; }
__device__ __forceinline__ unsigned pk2(float lo, float hi) { return f2bf(lo) | (f2bf(hi) << 16); }
__device__ __forceinline__ float bflo(unsigned w) { return __uint_as_float(w << 16); }
__device__ __forceinline__ float bfhi(unsigned w) { return __uint_as_float(w & 0xffff0000u); }
__device__ __forceinline__ float silu_f(float v) { return v / (1.f + expf(-v)); }
__device__ __forceinline__ float softplus_f(float v) { return fmaxf(v, 0.f) + log1pf(expf(-fabsf(v))); }

#define XB_TMO      128
#define XB_XCNT(j)  (256  + 64 * (j))
#define XB_XSUB(j)  (1280 + 64 * (j))
#define XB_XGEN(j)  (2304 + 64 * (j))
#define XB_TOP      3328
#define XB_TOPGEN   3392
#define XCD_BAR_WORDS 3456
#define XB_SPIN_CAP (1u << 22)
__device__ __forceinline__ unsigned xb_ld(unsigned* p)              { return __hip_atomic_load(p, __ATOMIC_RELAXED, __HIP_MEMORY_SCOPE_AGENT); }
__device__ __forceinline__ unsigned xb_add(unsigned* p, unsigned v) { return __hip_atomic_fetch_add(p, v, __ATOMIC_RELAXED, __HIP_MEMORY_SCOPE_AGENT); }
__device__ __forceinline__ unsigned xb_xcc_id() { return (unsigned)__builtin_amdgcn_s_getreg((3 << 11) | 20) & 0xFu; }
#define XB_SPIN(cond, bar) do { unsigned _sp = 0; while (cond) { __builtin_amdgcn_s_sleep(1); \
    if ((++_sp & 255u) == 0u) { if (xb_ld(&(bar)[XB_TMO])) break; if (_sp > XB_SPIN_CAP) { atomicAdd(&(bar)[XB_TMO], 1u); break; } } } } while (0)
struct XcdBarrier { unsigned* bar; unsigned x; unsigned total; volatile LAS unsigned* st; };
__device__ __forceinline__ XcdBarrier xcd_barrier_post(unsigned* bar, volatile LAS unsigned* st, unsigned total) {
    XcdBarrier b; b.bar = bar; b.x = xb_xcc_id(); b.total = total; b.st = st;
    if (threadIdx.x == 0) (void)xb_add(&bar[XB_XCNT(b.x)], 1u);
    return b;
}
__device__ __forceinline__ void xcd_barrier_complete(unsigned* bar, unsigned x, unsigned G, unsigned& nloc, unsigned& nx) {
    unsigned sum, cnt, mine, sp = 0u;
    for (;;) {
        sum = 0u; cnt = 0u; mine = 0u;
#pragma unroll
        for (unsigned j = 0; j < 16; ++j) { const unsigned c = xb_ld(&bar[XB_XCNT(j)]); sum += c; cnt += (c > 0u) ? 1u : 0u; mine = (j == x) ? c : mine; }
        if (sum == G) break;
        __builtin_amdgcn_s_sleep(1);
        if ((++sp & 255u) == 0u) { if (xb_ld(&bar[XB_TMO])) break; if (sp > XB_SPIN_CAP) { atomicAdd(&bar[XB_TMO], 1u); break; } }
    }
    nloc = mine > 0u ? mine : 1u; nx = cnt > 0u ? cnt : 1u;
}
__device__ __forceinline__ void xcd_barrier(const XcdBarrier& b) {
    asm volatile("s_waitcnt vmcnt(0)" ::: "memory");
    __syncthreads();
    if (threadIdx.x == 0) {
        unsigned* bar = b.bar;
        __builtin_amdgcn_s_waitcnt(0);
        unsigned nloc = b.st[0], nx = b.st[1];
        if (nloc == 0u) { xcd_barrier_complete(bar, b.x, b.total, nloc, nx); b.st[0] = nloc; b.st[1] = nx; }
        const unsigned old = xb_add(&bar[XB_XSUB(b.x)], 1u);
        const unsigned gen = old / nloc;
        if (nx == 1u) {
            XB_SPIN(xb_ld(&bar[XB_XSUB(b.x)]) < (gen + 1u) * nloc, bar);
            __builtin_amdgcn_fence(__ATOMIC_ACQUIRE, "agent");
            asm volatile("s_waitcnt vmcnt(0)" ::: "memory");
        } else if (old + 1u == (gen + 1u) * nloc) {
            __builtin_amdgcn_fence(__ATOMIC_RELEASE, "agent");
            asm volatile("s_waitcnt vmcnt(0)" ::: "memory");
            const unsigned og = xb_add(&bar[XB_TOP], 1u);
            const unsigned tg = og / nx;
            if (og + 1u == (tg + 1u) * nx) xb_add(&bar[XB_TOPGEN], 1u);
            else XB_SPIN(xb_ld(&bar[XB_TOPGEN]) == tg, bar);
            __builtin_amdgcn_fence(__ATOMIC_ACQUIRE, "agent");
            xb_add(&bar[XB_XGEN(b.x)], 1u);
            asm volatile("s_waitcnt vmcnt(0)" ::: "memory");
        } else {
            XB_SPIN(xb_ld(&bar[XB_XGEN(b.x)]) == gen, bar);
            __builtin_amdgcn_fence(__ATOMIC_ACQUIRE, "agent");
            asm volatile("s_waitcnt vmcnt(0)" ::: "memory");
        }
    }
    __syncthreads();
}

struct Frame {
    LAS unsigned char* lds;
    int tid, lane, wave, bid, G;
    int b, li;
};
enum { I_X = 0, I_MIXG, I_WIN, I_QG, I_KG, I_SINK, I_RELB, I_CONVW, I_CONVB, I_DTB, I_ALOG, I_DSKIP, I_SSMG, I_WOUT, I_MLPG, I_WUP, I_WDOWN, I_OUT, I_WS, I_NPTR };
__device__ __forceinline__ GAS unsigned char* ptr_at(const Frame& F, int i) {
    const LAS unsigned* t = (const LAS unsigned*)(F.lds + PTR_OFF) + 2 * i;
    const unsigned lo = __builtin_amdgcn_readfirstlane(t[0]), hi = __builtin_amdgcn_readfirstlane(t[1]);
    return (GAS unsigned char*)(((unsigned long long)hi << 32) | lo);
}
#define FIN(i) ((const GAS float*)ptr_at(F, (i)))
#define FWS(off) (ptr_at(F, I_WS) + (off))
#define FB(off) (ptr_at(F, I_WS) + (WS_BATCH0 + (size_t)F.b * BATCH_STRIDE + (off)))
using pg8::shx;
__device__ __forceinline__ float shup(float v, int o, int lane) { return __builtin_bit_cast(float, __builtin_amdgcn_ds_bpermute(((lane - o) & 63) << 2, __builtin_bit_cast(int, v))); }
__device__ __forceinline__ float wave_sum(float v, int lane) {
#pragma unroll
    for (int o = 1; o < 64; o <<= 1) v += shx(v, o, lane);
    return v;
}

__device__ __forceinline__ void tr_item(const GAS float* W, int Nsrc, int nsrc0, int nvalid, int K, const GAS float* gain, GAS bf16* WT, int ndst0, int k0, LAS float* scr, int lane) {
    const int n = lane & 31;
    float tv[32];
#pragma unroll
    for (int i = 0; i < 32; ++i) { const int kk = 2 * i + (lane >> 5); tv[i] = W[(size_t)(k0 + kk) * Nsrc + nsrc0 + (n < nvalid ? n : 0)]; }
#pragma unroll
    for (int i = 0; i < 32; ++i) { const int kk = 2 * i + (lane >> 5); float v = (n < nvalid) ? tv[i] : 0.f; if (gain) v *= gain[k0 + kk];
        scr[kk * 33 + n] = v; }
    LDS_WAIT(); asm volatile("" ::: "memory");
    const int c = lane & 7;
#pragma unroll
    for (int j = 0; j < 4; ++j) { const int nn = (lane >> 3) + 8 * j; const LAS float* s = scr + (8 * c) * 33 + nn;
        v4u o; o.x = pk2(s[0 * 33], s[1 * 33]); o.y = pk2(s[2 * 33], s[3 * 33]); o.z = pk2(s[4 * 33], s[5 * 33]); o.w = pk2(s[6 * 33], s[7 * 33]);
        *(GAS v4u*)(WT + (size_t)(ndst0 + nn) * K + k0 + 8 * c) = o; }
    LDS_WAIT(); asm volatile("" ::: "memory");
}
__device__ __forceinline__ void win_item(Frame& F, int L, int r, LAS float* scr);
__device__ __forceinline__ void p0_prologue(Frame& F) {
    LAS float* scr = (LAS float*)(F.lds + RING_OFF + F.wave * 16384);
    const int gw = F.bid * NWAVES + F.wave, NGW = F.G * NWAVES;
    constexpr int I_IN = 16 * 80, I_OUT = 16 * 32, I_UP = 16 * 128, I_DN = 64 * 32, I_L = I_IN + I_OUT + I_UP + I_DN;
    for (int it = gw; it < I_IN; it += NGW) win_item(F, 0, it, scr);
    const GAS float* x = FIN(I_X) + (size_t)F.b * SEQ * D; GAS bf16* XB = (GAS bf16*)FWS(WS_XB) + (size_t)F.b * SEQ * D; GAS float* SSQ = (GAS float*)FWS(WS_SSQ) + (size_t)F.b * SEQ * 16;
    for (int m = F.li * NWAVES + F.wave; m < SEQ; m += 2 * GRP * NWAVES) {
        const int m2 = m + GRP * NWAVES;
        const GAS f32x4* xr = (const GAS f32x4*)(x + (size_t)m * D) + F.lane; const GAS f32x4* xr2 = (const GAS f32x4*)(x + (size_t)m2 * D) + F.lane;
        f32x4 v[4], w[4]; float s = 0.f, s2 = 0.f;
#pragma unroll
        for (int j = 0; j < 4; ++j) { v[j] = xr[64 * j]; w[j] = xr2[64 * j]; }
#pragma unroll
        for (int j = 0; j < 4; ++j) { s += (v[j].x * v[j].x + v[j].y * v[j].y) + (v[j].z * v[j].z + v[j].w * v[j].w); s2 += (w[j].x * w[j].x + w[j].y * w[j].y) + (w[j].z * w[j].z + w[j].w * w[j].w); }
        s = wave_sum(s, F.lane); s2 = wave_sum(s2, F.lane);
        GAS v2u* o8 = (GAS v2u*)(XB + (size_t)m * D) + F.lane; GAS v2u* o82 = (GAS v2u*)(XB + (size_t)m2 * D) + F.lane;
#pragma unroll
        for (int j = 0; j < 4; ++j) { v2u o; o.x = pk2(v[j].x, v[j].y); o.y = pk2(v[j].z, v[j].w); o8[64 * j] = o; v2u o2; o2.x = pk2(w[j].x, w[j].y); o2.y = pk2(w[j].z, w[j].w); o82[64 * j] = o2; }
        if (F.lane < 16) { SSQ[(size_t)m * 16 + F.lane] = (F.lane == 0) ? s : 0.f; SSQ[(size_t)m2 * 16 + F.lane] = (F.lane == 0) ? s2 : 0.f; }
    }
}
constexpr int CW_WCNT = 8192, N_CONVERTERS = NGRP * (GRP - 16);
__device__ __forceinline__ void win_item(Frame& F, int L, int r, LAS float* scr) {
    const int kb = r / 80, nb = r % 80; int src, nv = 32;
    if (nb < 16) src = nb * 32; else if (nb < 32) src = 768 + (nb - 16) * 32; else if (nb < 36) src = 512 + (nb - 32) * 32; else if (nb < 40) src = 640 + (nb - 36) * 32;
    else if (nb < 72) src = nb * 32; else if (nb == 72) { src = 2304; nv = 8; } else { src = 0; nv = 0; }
    tr_item(FIN(I_WIN) + (size_t)L * D * D_IN, D_IN, src, nv, D, FIN(I_MIXG) + L * D, (GAS bf16*)FWS(WS_WIN) + (size_t)L * NPROJ * D, nb * 32, kb * 64, scr, F.lane);
}
__device__ __forceinline__ void convert_rest(Frame& F, int slot) {
    LAS float* scr = (LAS float*)(F.lds + RING_OFF + F.wave * 16384);
    constexpr int I_IN = 16 * 80, I_OUT = 16 * 32, I_UP = 16 * 128, I_DN = 64 * 32, NCW = N_CONVERTERS * NWAVES;
    const GAS float *w_out = FIN(I_WOUT), *w_up = FIN(I_WUP), *mlp_g = FIN(I_MLPG), *w_down = FIN(I_WDOWN);
    GAS bf16 *WOUT = (GAS bf16*)FWS(WS_WOUT), *WUP = (GAS bf16*)FWS(WS_WUP), *WDOWN = (GAS bf16*)FWS(WS_WDOWN);
    const int L = slot, n_items = I_OUT + I_UP + I_DN + (slot == 0 ? I_IN : 0);
    for (int it = (F.b * (GRP - 16) + (F.li - 16)) * NWAVES + F.wave; it < n_items; it += NCW) {
        int r = it;
        if (r < I_OUT) { const int kb = r / 32, nb = r % 32; tr_item(w_out + (size_t)L * D * D, D, nb * 32, 32, D, nullptr, WOUT + (size_t)L * D * D, nb * 32, kb * 64, scr, F.lane); continue; }
        r -= I_OUT;
        if (r < I_UP) { const int kb = r / 128, nb = r % 128; tr_item(w_up + (size_t)L * D * FF, FF, nb * 32, 32, D, mlp_g + L * D, WUP + (size_t)L * FF * D, nb * 32, kb * 64, scr, F.lane); continue; }
        r -= I_UP;
        if (r < I_DN) { const int kb = r / 32, nb = r % 32; tr_item(w_down + (size_t)L * FF * D, D, nb * 32, 32, FF, nullptr, WDOWN + (size_t)L * D * FF, nb * 32, kb * 64, scr, F.lane); continue; }
        r -= I_DN;
        win_item(F, 1, r, scr);
    }
    asm volatile("s_waitcnt vmcnt(0)" ::: "memory");
    __syncthreads();
    if (F.tid == 0) { __builtin_amdgcn_fence(__ATOMIC_RELEASE, "agent"); asm volatile("s_waitcnt vmcnt(0)" ::: "memory");
        (void)xb_add((unsigned*)(unsigned char*)FWS(WS_CTL) + CW_WCNT + 64 * slot, 1u); }
}
__device__ __forceinline__ void wait_weights(Frame& F, int part) {
    if (F.tid == 0) { unsigned* wc = (unsigned*)(unsigned char*)FWS(WS_CTL) + CW_WCNT + 64 * part; unsigned sp = 0u;
        while (xb_ld(wc) < (unsigned)N_CONVERTERS) { __builtin_amdgcn_s_sleep(2); if (++sp > (1u << 22)) break; }
        __builtin_amdgcn_fence(__ATOMIC_ACQUIRE, "agent"); asm volatile("s_waitcnt vmcnt(0)" ::: "memory"); }
    __syncthreads();
}
__device__ __forceinline__ void rstd_prepass(Frame& F, const pg8::GroupOrder& S, LAS float* tab) {
    const GAS float* SSQ = (const GAS float*)FWS(WS_SSQ) + (size_t)F.b * SEQ * 16;
    pg8::Unit u;
    for (int i = 0; i < 4 && S.next(i, u); ++i) {
        const int r = F.tid >> 1, h = F.tid & 1;
        const GAS f32x4* p = (const GAS f32x4*)(SSQ + (size_t)(u.pm * 256 + r) * 16 + h * 8);
        const f32x4 a = p[0], b = p[1];
        float s = (a.x + a.y) + (a.z + a.w) + (b.x + b.y) + (b.z + b.w);
        s += shx(s, 1, F.lane);
        if (h == 0) tab[i * 256 + r] = 1.0f / sqrtf(s * (1.0f / D) + EPS);
    }
    LDS_WAIT(); __syncthreads();
}
__device__ __forceinline__ int t5_bucket(int d) {
    if (d < 16) return d;
    return 16 + (d >= 19) + (d >= 21) + (d >= 24) + (d >= 27) + (d >= 31) + (d >= 35) + (d >= 40) + (d >= 46) + (d >= 52) + (d >= 59) + (d >= 67) + (d >= 77) + (d >= 87) + (d >= 99) + (d >= 113);
}
__device__ __forceinline__ void ld8(const GAS bf16* p, float (&v)[8]) {
    const v4u w = *(const GAS v4u*)p;
    v[0] = bflo(w.x); v[1] = bfhi(w.x); v[2] = bflo(w.y); v[3] = bfhi(w.y); v[4] = bflo(w.z); v[5] = bfhi(w.z); v[6] = bflo(w.w); v[7] = bfhi(w.w);
}
typedef short bf16x8_t __attribute__((ext_vector_type(8)));
typedef float f32x16 __attribute__((ext_vector_type(16)));
constexpr float LOG2E = 1.4426950408889634f;
__device__ __forceinline__ unsigned pkbf(float lo, float hi) { return pg8::cvt_pk_bf16(lo, hi); }
__device__ __forceinline__ int crow32(int i, int hh) { return (i & 3) + 8 * (i >> 2) + 4 * hh; }
__device__ __forceinline__ float silu_fast(float v) { return v * __builtin_amdgcn_rcpf(1.0f + __builtin_amdgcn_exp2f(-v * LOG2E)); }
__device__ __forceinline__ void unpk8(const v4u w, float (&v)[8]) {
    v[0] = bflo(w.x); v[1] = bfhi(w.x); v[2] = bflo(w.y); v[3] = bfhi(w.y); v[4] = bflo(w.z); v[5] = bfhi(w.z); v[6] = bflo(w.w); v[7] = bfhi(w.w);
}

typedef short v4i16_t __attribute__((ext_vector_type(4)));
template <int RH, int RSEC> __device__ __forceinline__ bf16x8_t tr_frag(const LAS unsigned char* img, int stride, int rbase, int cbase, int lane) {
    const LAS unsigned char* p = img + (rbase + RH * (lane >> 5) + ((lane & 15) >> 2)) * stride + (cbase + 16 * ((lane >> 4) & 1) + 4 * (lane & 3)) * 2;
    const v4i16_t a = __builtin_amdgcn_ds_read_tr16_b64_v4i16((LAS v4i16_t*)p), b = __builtin_amdgcn_ds_read_tr16_b64_v4i16((LAS v4i16_t*)(p + RSEC * stride));
    return (bf16x8_t){a[0], a[1], a[2], a[3], b[0], b[1], b[2], b[3]};
}
constexpr int AT_KS = 0, AT_KSTRIDE = 144, AT_VT = 36864, AT_VSTRIDE = 192, AT_BIAS = AT_VT + 256 * AT_VSTRIDE;
constexpr int AT_BN = 192, AT_END = AT_BIAS + 4 * AT_BN * 4;
static_assert(AT_END <= MIX_BYTES, "attention LDS");
__device__ __forceinline__ void attn_fast(Frame& F, int L, bool dummy = false) {
    GAS bf16* PROJ = (GAS bf16*)FB(BO_PROJ);
    const GAS float* qg = FIN(I_QG) + L * 64; const GAS float* kg = FIN(I_KG) + L * 64; const GAS float* sinks = FIN(I_SINK) + L * 8; const GAS float* rel_bias = FIN(I_RELB);
    LAS unsigned char* Ks = F.lds + AT_KS; LAS unsigned char* Vt = F.lds + AT_VT; LAS float* biasR = (LAS float*)(F.lds + AT_BIAS);
    const int tid = F.tid, lane = F.lane, wave = F.wave, q = lane & 31, hh = lane >> 5;
    const int unit = F.li, kvh = unit >> 4, qb = unit & 15, m0 = qb * 128;
    const int gi = wave >> 1, qh = wave & 1, hq = kvh * 4 + gi;
    v4u qraw[2][4];
#pragma unroll
    for (int s = 0; s < 2; ++s)
#pragma unroll
        for (int d0 = 0; d0 < 4; ++d0) qraw[s][d0] = *(const GAS v4u*)(PROJ + (size_t)(m0 + 64 * qh + 32 * s + q) * PP + CQ + hq * 64 + d0 * 16 + hh * 8);
    v4u kwv[4], vwv[4];
#pragma unroll
    for (int i = 0; i < 4; ++i) { const int c = tid + NTHREADS * i, key = c >> 3, part = c & 7; const bool valid = (qb > 0) || (key >= 128); const unsigned msk = valid ? 0xffffffffu : 0u;
        const GAS bf16* kp = PROJ + (size_t)(valid ? m0 + key - 128 : 0) * PP + CK + kvh * 64 + part * 8;
        v4u a_ = *(const GAS v4u*)kp, b_ = *(const GAS v4u*)(kp + (CV - CK));
        a_.x &= msk; a_.y &= msk; a_.z &= msk; a_.w &= msk; b_.x &= msk; b_.y &= msk; b_.z &= msk; b_.w &= msk; kwv[i] = a_; vwv[i] = b_; }
    const f32x4 kg0 = *(const GAS f32x4*)(kg + (tid & 7) * 8), kg1 = *(const GAS f32x4*)(kg + (tid & 7) * 8 + 4);
    f32x4 qgv[4][2];
#pragma unroll
    for (int d0 = 0; d0 < 4; ++d0) { qgv[d0][0] = *(const GAS f32x4*)(qg + d0 * 16 + hh * 8); qgv[d0][1] = *(const GAS f32x4*)(qg + d0 * 16 + hh * 8 + 4); }
    const float sinkv = sinks[hq];
    float bent[2];
#pragma unroll
    for (int k = 0; k < 2; ++k) { const int x = tid + NTHREADS * k, g_ = x / AT_BN, xx = x - g_ * AT_BN; const bool ok = (x < 4 * AT_BN) && (xx >= 32) && (xx < 160);
        const float v = rel_bias[t5_bucket(ok ? 159 - xx : 0) * 8 + kvh * 4 + (ok ? g_ : 0)]; bent[k] = ok ? v * LOG2E : 0.f; }
    __syncthreads();
    biasR[tid] = bent[0]; if (tid + NTHREADS < 4 * AT_BN) biasR[tid + NTHREADS] = bent[1];
#pragma unroll
    for (int i = 0; i < 4; ++i) {
        const int c = tid + NTHREADS * i, key = c >> 3, part = c & 7;
        const v4u kw = kwv[i], vw = vwv[i];
        float kv[8]; unpk8(kw, kv);
        float ss = 0.f;
#pragma unroll
        for (int e = 0; e < 8; ++e) ss += kv[e] * kv[e];
        ss += shx(ss, 1, lane); ss += shx(ss, 2, lane); ss += shx(ss, 4, lane);
        const float rk = __builtin_amdgcn_rsqf(ss * (1.0f / 64.0f) + EPS);
        const f32x4 g0 = kg0, g1 = kg1;
        v4u ko; ko.x = pkbf(kv[0] * rk * g0.x, kv[1] * rk * g0.y); ko.y = pkbf(kv[2] * rk * g0.z, kv[3] * rk * g0.w); ko.z = pkbf(kv[4] * rk * g1.x, kv[5] * rk * g1.y); ko.w = pkbf(kv[6] * rk * g1.z, kv[7] * rk * g1.w);
        *(LAS v4u*)(Ks + key * AT_KSTRIDE + part * 16) = ko;
        *(LAS v4u*)(Vt + key * AT_VSTRIDE + part * 16) = vw;
    }
    LDS_WAIT(); __syncthreads();
    const float sink2 = sinkv * LOG2E;
    const LAS float* bb = biasR + gi * AT_BN + 31 - q + 4 * hh;
    const int qm = q - 4 * hh;
#pragma unroll
    for (int s = 0; s < 2; ++s) {
        const int a = 64 * qh + 32 * s;
        GAS bf16* qrow = PROJ + (size_t)(m0 + a + q) * PP + CQ + hq * 64;
        float qv[4][8]; float ss = 0.f;
#pragma unroll
        for (int d0 = 0; d0 < 4; ++d0) { unpk8(qraw[s][d0], qv[d0]);
#pragma unroll
            for (int e = 0; e < 8; ++e) ss += qv[d0][e] * qv[d0][e]; }
        ss += shx(ss, 32, lane);
        const float rq = __builtin_amdgcn_rsqf(ss * (1.0f / 64.0f) + EPS) * (0.125f * LOG2E);
        bf16x8_t qf[4];
#pragma unroll
        for (int d0 = 0; d0 < 4; ++d0) { const f32x4 g0 = qgv[d0][0], g1 = qgv[d0][1];
            v4u w; w.x = pkbf(qv[d0][0] * rq * g0.x, qv[d0][1] * rq * g0.y); w.y = pkbf(qv[d0][2] * rq * g0.z, qv[d0][3] * rq * g0.w);
            w.z = pkbf(qv[d0][4] * rq * g1.x, qv[d0][5] * rq * g1.y); w.w = pkbf(qv[d0][6] * rq * g1.z, qv[d0][7] * rq * g1.w);
            qf[d0] = __builtin_bit_cast(bf16x8_t, w); }
        const int kt_lo = (qb == 0) ? 4 - (a >> 5) : 0;
        f32x16 S[5]; float mx = sink2;
#pragma unroll
        for (int kt = 0; kt < 5; ++kt) { f32x16 acc = {};
#pragma unroll
            for (int d0 = 0; d0 < 4; ++d0) { const bf16x8_t kf = *(const LAS bf16x8_t*)(Ks + (a + 32 * kt + q) * AT_KSTRIDE + d0 * 32 + hh * 16);
                acc = __builtin_amdgcn_mfma_f32_32x32x16_bf16(kf, qf[d0], acc, 0, 0, 0); }
            if (kt < kt_lo) {
#pragma unroll
                for (int i = 0; i < 16; ++i) acc[i] = -INFINITY;
            } else {
#pragma unroll
                for (int i = 0; i < 16; ++i) { const int t0 = (i & 3) + 8 * (i >> 2); float v = acc[i] + bb[32 * kt + t0];
                    if (kt == 0) v = fminf(v, (t0 > qm) ? INFINITY : -INFINITY);
                    if (kt == 4) v = fminf(v, (t0 <= qm) ? INFINITY : -INFINITY);
                    acc[i] = v; mx = fmaxf(mx, v); } }
            S[kt] = acc; }
        mx = fmaxf(mx, shx(mx, 32, lane));
        float lsum = 0.f; bf16x8_t pf[5][2];
#pragma unroll
        for (int kt = 0; kt < 5; ++kt) {
#pragma unroll
            for (int i = 0; i < 16; ++i) { const float p = __builtin_amdgcn_exp2f(S[kt][i] - mx); S[kt][i] = p; lsum += p; }
#pragma unroll
            for (int s2 = 0; s2 < 2; ++s2) { v4u w; w.x = pkbf(S[kt][8 * s2 + 0], S[kt][8 * s2 + 1]); w.y = pkbf(S[kt][8 * s2 + 2], S[kt][8 * s2 + 3]);
                w.z = pkbf(S[kt][8 * s2 + 4], S[kt][8 * s2 + 5]); w.w = pkbf(S[kt][8 * s2 + 6], S[kt][8 * s2 + 7]); pf[kt][s2] = __builtin_bit_cast(bf16x8_t, w); } }
        lsum += shx(lsum, 32, lane);
        lsum += __builtin_amdgcn_exp2f(sink2 - mx);
        f32x16 O[2] = {{}, {}};
#pragma unroll
        for (int kt = 0; kt < 5; ++kt)
#pragma unroll
            for (int s2 = 0; s2 < 2; ++s2)
#pragma unroll
                for (int db = 0; db < 2; ++db)
                    O[db] = __builtin_amdgcn_mfma_f32_32x32x16_bf16(tr_frag<4, 8>(Vt, AT_VSTRIDE, a + 32 * kt + 16 * s2, 32 * db, lane), pf[kt][s2], O[db], 0, 0, 0);
        const float inv = __builtin_amdgcn_rcpf(lsum);
#pragma unroll
        for (int db = 0; db < 2; ++db)
#pragma unroll
            for (int g4 = 0; g4 < 4; ++g4) { v2u w; w.x = pkbf(O[db][4 * g4] * inv, O[db][4 * g4 + 1] * inv); w.y = pkbf(O[db][4 * g4 + 2] * inv, O[db][4 * g4 + 3] * inv);
                GAS bf16* orow = dummy ? (GAS bf16*)FB(BO_PREV) + (size_t)(m0 + a + q) * 512 + hq * 64 : qrow;
                *(GAS v2u*)(orow + 32 * db + 8 * g4 + 4 * hh) = w; }
    }
}

constexpr size_t WS_DTV = 3 * MiB + 512 * 1024;
constexpr int SD_ROW = 272, SD_XT = 264;
template <int NR> struct Raw8 { v4u u[NR + 3]; };
template <int NR> struct Raw4 { v2u u[NR + 3]; };
struct ConvW8 { f32x4 w[4][2], b[2]; };
struct ConvW4 { f32x4 w[4], b; };
template <int NR> __device__ __forceinline__ void conv_load(Raw8<NR>& R, const GAS bf16* PROJ, int m0, int c, int l0, int col0) {
#pragma unroll
    for (int i = 0; i < NR + 3; ++i) { const int row = l0 - 3 + i; const bool ok = (c > 0) || (row >= 0); const unsigned msk = ok ? 0xffffffffu : 0u;
        v4u x = *(const GAS v4u*)(PROJ + (size_t)(m0 + (ok ? row : 0)) * PP + col0); x.x &= msk; x.y &= msk; x.z &= msk; x.w &= msk; R.u[i] = x; }
}
template <int NR> __device__ __forceinline__ void conv_load(Raw4<NR>& R, const GAS bf16* PROJ, int m0, int c, int l0, int col0) {
#pragma unroll
    for (int i = 0; i < NR + 3; ++i) { const int row = l0 - 3 + i; const bool ok = (c > 0) || (row >= 0); const unsigned msk = ok ? 0xffffffffu : 0u;
        v2u x = *(const GAS v2u*)(PROJ + (size_t)(m0 + (ok ? row : 0)) * PP + col0); x.x &= msk; x.y &= msk; R.u[i] = x; }
}
__device__ __forceinline__ void convw_load(ConvW8& W, const GAS float* cw, const GAS float* cb) {
#pragma unroll
    for (int k = 0; k < 4; ++k) { W.w[k][0] = *(const GAS f32x4*)(cw + k * 1024); W.w[k][1] = *(const GAS f32x4*)(cw + k * 1024 + 4); }
    W.b[0] = *(const GAS f32x4*)cb; W.b[1] = *(const GAS f32x4*)(cb + 4);
}
__device__ __forceinline__ void convw_load(ConvW4& W, const GAS float* cw, const GAS float* cb) {
#pragma unroll
    for (int k = 0; k < 4; ++k) W.w[k] = *(const GAS f32x4*)(cw + k * 1024);
    W.b = *(const GAS f32x4*)cb;
}
template <int NR> __device__ __forceinline__ void conv_row(const Raw8<NR>& R, const ConvW8& W, int r, float (&out)[8]) {
    float acc[8];
#pragma unroll
    for (int e = 0; e < 8; ++e) acc[e] = W.b[e >> 2][e & 3];
#pragma unroll
    for (int k = 0; k < 4; ++k) { float u[8]; unpk8(R.u[r + k], u);
#pragma unroll
        for (int e = 0; e < 8; ++e) acc[e] += W.w[k][e >> 2][e & 3] * u[e]; }
#pragma unroll
    for (int e = 0; e < 8; ++e) out[e] = silu_fast(acc[e]);
}
template <int NR> __device__ __forceinline__ void conv_row(const Raw4<NR>& R, const ConvW4& W, int r, float (&out)[4]) {
    float acc[4];
#pragma unroll
    for (int e = 0; e < 4; ++e) acc[e] = W.b[e];
#pragma unroll
    for (int k = 0; k < 4; ++k) { const v2u x = R.u[r + k]; const float u[4] = {bflo(x.x), bfhi(x.x), bflo(x.y), bfhi(x.y)};
#pragma unroll
        for (int e = 0; e < 4; ++e) acc[e] += W.w[k][e] * u[e]; }
#pragma unroll
    for (int e = 0; e < 4; ++e) out[e] = silu_fast(acc[e]);
}
constexpr int P_XSTR = 576, P_BSTR = 304, P_XD = 0, P_BM = P_XD + 128 * P_XSTR, P_CM = P_BM + 128 * P_BSTR, P_FREE = P_CM + 128 * SD_ROW, P_DT = MIX_BYTES - 4096, P_ACS = P_DT + 2048;
static_assert(P_FREE + 4096 <= P_DT, "SSD LDS map");
__device__ __forceinline__ bf16x8_t scale_frag(bf16x8_t f, const f32x4 s0, const f32x4 s1) {
    const v4u w = __builtin_bit_cast(v4u, f); v4u o;
    o.x = pkbf(bflo(w.x) * s0.x, bfhi(w.x) * s0.y); o.y = pkbf(bflo(w.y) * s0.z, bfhi(w.y) * s0.w); o.z = pkbf(bflo(w.z) * s1.x, bfhi(w.z) * s1.y); o.w = pkbf(bflo(w.w) * s1.z, bfhi(w.w) * s1.w);
    return __builtin_bit_cast(bf16x8_t, o);
}
constexpr int S1_W = P_CM, S1_WT = S1_W + 2048;
__device__ __forceinline__ void ssd_states(Frame& F, int L) {
    const GAS bf16* PROJ = (const GAS bf16*)FB(BO_PROJ);
    const GAS float* conv_w = FIN(I_CONVW) + (size_t)L * 4 * 1024; const GAS float* conv_b = FIN(I_CONVB) + L * 1024;
    const GAS float* dt_bias = FIN(I_DTB) + L * 8; const GAS float* a_log = FIN(I_ALOG) + L * 8;
    const GAS float* DTRAW = (const GAS float*)FWS(WS_DTRAW) + (size_t)F.b * SEQ * 8; GAS float* CHDEC = (GAS float*)FWS(WS_CHDEC) + F.b * 128;
    GAS float* STATES = (GAS float*)FB(BO_STATES);
    LAS unsigned char* XD = F.lds + P_XD; LAS unsigned char* BM = F.lds + P_BM;
    LAS float* dt_l = (LAS float*)(F.lds + P_DT); LAS float* acs_l = (LAS float*)(F.lds + P_ACS); LAS float* w_l = (LAS float*)(F.lds + S1_W); LAS float* wt = (LAS float*)(F.lds + S1_WT);
    const int wave = F.wave, unit = F.li, c = unit >> 1, g = unit & 1, m0 = c * 128;
    int tid = F.tid; asm volatile("" : "+v"(tid));
    int lane = tid & 63, q = lane & 31, hh = lane >> 5;
    const int xcg = tid & 31, xl0 = (tid >> 5) * 8, xcol = CX + g * 256 + xcg * 8;
    const int bcg = tid & 15, bl0 = (tid >> 4) * 4, bcol = CBM + g * 128 + bcg * 8;
    Raw8<8> xr; ConvW8 xw; Raw8<4> br; ConvW8 bw;
    conv_load(xr, PROJ, m0, c, xl0, xcol); convw_load(xw, conv_w + (xcol - CX), conv_b + (xcol - CX));
    conv_load(br, PROJ, m0, c, bl0, bcol); convw_load(bw, conv_w + (bcol - CX), conv_b + (bcol - CX));
    const int ar = tid >> 7, al = tid & 127, ahead = 4 * g + ar;
    const float dtraw = DTRAW[(size_t)(m0 + al) * 8 + ahead], dtb = dt_bias[ahead], alog = a_log[ahead];
    __syncthreads();
    float acs_v;
    { const float dtv = softplus_f(dtraw + dtb);
      float v = dtv * (-expf(alog));
#pragma unroll
      for (int o = 1; o < 64; o <<= 1) { const float t = shup(v, o, lane); if (lane >= o) v += t; }
      if (lane == 63) wt[wave] = v;
      LDS_WAIT(); __syncthreads();
      if (wave & 1) v += wt[wave - 1];
      dt_l[tid] = dtv; acs_l[tid] = v * LOG2E; acs_v = v * LOG2E;
      if (al == 127) CHDEC[c * 8 + ahead] = expf(v); }
#pragma unroll
    for (int r = 0; r < 4; ++r) { float o[8]; conv_row(br, bw, r, o);
        v4u pk; pk.x = pkbf(o[0], o[1]); pk.y = pkbf(o[2], o[3]); pk.z = pkbf(o[4], o[5]); pk.w = pkbf(o[6], o[7]);
        *(LAS v4u*)(BM + (bl0 + r) * P_BSTR + bcg * 16) = pk; }
    LDS_WAIT(); __syncthreads();
    w_l[tid] = __builtin_amdgcn_exp2f(acs_l[ar * 128 + 127] - acs_v);
    { const int r4 = xcg >> 3;
#pragma unroll
      for (int r = 0; r < 8; ++r) { float o[8]; conv_row(xr, xw, r, o); const int l = xl0 + r; const float sc = dt_l[r4 * 128 + l];
          v4u pk; pk.x = pkbf(o[0] * sc, o[1] * sc); pk.y = pkbf(o[2] * sc, o[3] * sc); pk.z = pkbf(o[4] * sc, o[5] * sc); pk.w = pkbf(o[6] * sc, o[7] * sc);
          *(LAS v4u*)(XD + l * P_XSTR + xcg * 16) = pk; } }
    LDS_WAIT(); __syncthreads();
    asm volatile("" : "+v"(tid)); lane = tid & 63; q = lane & 31; hh = lane >> 5;
    { const int r4 = wave >> 1, nt0 = (wave & 1) * 2, head = 4 * g + r4;
      f32x16 St[2][2] = {{{}, {}}, {{}, {}}};
#pragma unroll
      for (int ks = 0; ks < 8; ++ks) { bf16x8_t af[2], bfr[2];
          const f32x4 w0 = *(const LAS f32x4*)(w_l + r4 * 128 + 16 * ks + 8 * hh), w1 = *(const LAS f32x4*)(w_l + r4 * 128 + 16 * ks + 8 * hh + 4);
#pragma unroll
          for (int pt = 0; pt < 2; ++pt) af[pt] = tr_frag<8, 4>(XD, P_XSTR, 16 * ks, r4 * 64 + 32 * pt, lane);
#pragma unroll
          for (int nn = 0; nn < 2; ++nn) bfr[nn] = scale_frag(tr_frag<8, 4>(BM, P_BSTR, 16 * ks, 32 * (nt0 + nn), lane), w0, w1);
#pragma unroll
          for (int pt = 0; pt < 2; ++pt)
#pragma unroll
              for (int nn = 0; nn < 2; ++nn) St[pt][nn] = __builtin_amdgcn_mfma_f32_32x32x16_bf16(af[pt], bfr[nn], St[pt][nn], 0, 0, 0); }
      GAS float* sp = STATES + ((size_t)c * 8 + head) * 8192 + 32 * nt0 + q;
#pragma unroll
      for (int pt = 0; pt < 2; ++pt)
#pragma unroll
          for (int nn = 0; nn < 2; ++nn)
#pragma unroll
              for (int e = 0; e < 16; ++e) sp[(32 * pt + crow32(e, hh)) * 128 + 32 * nn] = St[pt][nn][e]; }
}
__device__ __forceinline__ void ssd_scan(Frame& F, int L) {
    const GAS float* STATES = (const GAS float*)FB(BO_STATES); const GAS float* CHDEC = (const GAS float*)FWS(WS_CHDEC) + F.b * 128; GAS bf16* PREV = (GAS bf16*)FB(BO_PREV);
    for (int idx = F.li * NTHREADS + F.tid; idx < 8 * 64 * 32; idx += GRP * NTHREADS) {
        const int n4 = idx & 31, p = (idx >> 5) & 63, head = idx >> 11;
        f32x4 s[16]; float dec[16];
#pragma unroll
        for (int c = 0; c < 16; ++c) { const size_t o = ((size_t)c * 8 + head) * 8192 + p * 128 + 4 * n4; s[c] = *(const GAS f32x4*)(STATES + o); dec[c] = CHDEC[c * 8 + head]; }
        f32x4 h = {0.f, 0.f, 0.f, 0.f};
#pragma unroll
        for (int c = 0; c < 16; ++c) { const size_t o = ((size_t)c * 8 + head) * 8192 + p * 128 + 4 * n4;
            v2u w; w.x = pkbf(h.x, h.y); w.y = pkbf(h.z, h.w); *(GAS v2u*)(PREV + o) = w;
            h = h * dec[c] + s[c]; }
    }
}
constexpr int S3_PV = P_BM, S3_PVH = 64 * SD_ROW, S3_Z = S3_PV + 2 * S3_PVH, S3_NG = P_FREE, S3_RSS = S3_NG + 1024;
static_assert(S3_Z + 128 * SD_ROW <= P_FREE && S3_RSS + 2048 <= P_DT && 128 * 528 <= P_DT, "SSD part 3 LDS");
__device__ __forceinline__ void ssd_out(Frame& F, int L, bool dummy = false) {
    GAS bf16* PROJ = (GAS bf16*)FB(BO_PROJ); const GAS bf16* PREV = (const GAS bf16*)FB(BO_PREV);
    const GAS float* conv_w = FIN(I_CONVW) + (size_t)L * 4 * 1024; const GAS float* conv_b = FIN(I_CONVB) + L * 1024;
    const GAS float* d_skip = FIN(I_DSKIP) + L * 8; const GAS float* ssm_g = FIN(I_SSMG) + L * 512;
    LAS unsigned char* Cm = F.lds + P_CM; LAS unsigned char* Bm = F.lds + P_BM; LAS unsigned char* Zt = F.lds + S3_Z; const LAS unsigned char* XD = F.lds + P_XD;
    LAS float* dt_l = (LAS float*)(F.lds + P_DT); LAS float* acs_l = (LAS float*)(F.lds + P_ACS); LAS float* rss = (LAS float*)(F.lds + S3_RSS); LAS float* ng_l = (LAS float*)(F.lds + S3_NG);
    const int wave = F.wave, unit = F.li, c = unit >> 1, g = unit & 1, m0 = c * 128;
    int tid = F.tid; asm volatile("" : "+v"(tid));
    int lane = tid & 63, q = lane & 31, hh = lane >> 5;
    const int ccg = tid & 15, cl0 = (tid >> 4) * 4, ccol = CCM + g * 128 + ccg * 8;
    Raw8<4> cr; ConvW8 cw;
    conv_load(cr, PROJ, m0, c, cl0, ccol); convw_load(cw, conv_w + (ccol - CX), conv_b + (ccol - CX));
    const float ng_in = ssm_g[g * 256 + (tid & 255)];
    v4u pw[4], zw[4];
#define S3_D1_LOAD_PZ(hp_) do { \
        _Pragma("unroll") for (int k = 0; k < 4; ++k) { const int ch = tid + NTHREADS * k; \
            { const int hd = ch >> 10, rem = ch & 1023, p = rem >> 4, n8 = rem & 15; pw[k] = *(const GAS v4u*)(PREV + ((size_t)c * 8 + 4 * g + 2 * (hp_) + hd) * 8192 + p * 128 + n8 * 8); } \
            { const int l = ch >> 4, c8 = ch & 15; zw[k] = *(const GAS v4u*)(PROJ + (size_t)(m0 + l) * PP + CZ + (4 * g + 2 * (hp_)) * 64 + c8 * 8); } } } while (0)
    S3_D1_LOAD_PZ(0);
#pragma unroll
    for (int r = 0; r < 4; ++r) { float o[8]; conv_row(cr, cw, r, o);
        v4u pk; pk.x = pkbf(o[0], o[1]); pk.y = pkbf(o[2], o[3]); pk.z = pkbf(o[4], o[5]); pk.w = pkbf(o[6], o[7]);
        *(LAS v4u*)(Cm + (cl0 + r) * SD_ROW + ccg * 16) = pk; }
    if (tid < 256) ng_l[tid] = ng_in;
    LDS_WAIT(); __syncthreads();
    asm volatile("" : "+v"(tid)); lane = tid & 63; q = lane & 31; hh = lane >> 5;
    const int j = (wave < 4) ? (wave & 3) : 3 - (wave & 3), h2 = wave >> 2;
    f32x16 cbT[4]; bf16x8_t cf[8];
#pragma unroll
    for (int ks = 0; ks < 8; ++ks) cf[ks] = *(const LAS bf16x8_t*)(Cm + (32 * j + q) * SD_ROW + (16 * ks + 8 * hh) * 2);
#pragma unroll
    for (int i = 0; i < 4; ++i) { f32x16 acc = {};
        if (i <= j) {
#pragma unroll
            for (int ks = 0; ks < 8; ++ks) { const bf16x8_t bfr = *(const LAS bf16x8_t*)(Bm + (32 * i + q) * P_BSTR + (16 * ks + 8 * hh) * 2);
                acc = __builtin_amdgcn_mfma_f32_32x32x16_bf16(bfr, cf[ks], acc, 0, 0, 0); } }
        cbT[i] = acc; }
    unsigned vk[2][16];
#pragma unroll
    for (int hp = 0; hp < 2; ++hp) {
        __syncthreads();
        {
#pragma unroll
          for (int k = 0; k < 4; ++k) { const int ch = tid + NTHREADS * k;
              { const int hd = ch >> 10, rem = ch & 1023, p = rem >> 4, n8 = rem & 15; *(LAS v4u*)(F.lds + S3_PV + hd * S3_PVH + p * SD_ROW + n8 * 16) = pw[k]; }
              { const int l = ch >> 4, c8 = ch & 15; *(LAS v4u*)(Zt + l * SD_ROW + c8 * 16) = zw[k]; } } }
        LDS_WAIT(); __syncthreads();
        asm volatile("" : "+v"(tid)); lane = tid & 63; q = lane & 31; hh = lane >> 5;
        const int r = 2 * hp + h2, head = 4 * g + r;
        const LAS unsigned char* P1 = F.lds + S3_PV + h2 * S3_PVH;
        f32x16 O[2] = {{}, {}};
#pragma unroll
        for (int ks = 0; ks < 8; ++ks)
#pragma unroll
            for (int pt = 0; pt < 2; ++pt) { const bf16x8_t af = *(const LAS bf16x8_t*)(P1 + (32 * pt + q) * SD_ROW + (16 * ks + 8 * hh) * 2);
                O[pt] = __builtin_amdgcn_mfma_f32_32x32x16_bf16(af, cf[ks], O[pt], 0, 0, 0); }
        const float acl = acs_l[r * 128 + 32 * j + q], diag = d_skip[head] * __builtin_amdgcn_rcpf(dt_l[r * 128 + 32 * j + q]);
        { const float ea = __builtin_amdgcn_exp2f(acl);
#pragma unroll
          for (int pt = 0; pt < 2; ++pt)
#pragma unroll
              for (int e = 0; e < 16; ++e) O[pt][e] *= ea; }
        const int qm = q - 4 * hh;
#pragma unroll
        for (int i = 0; i < 4; ++i) { if (i <= j) {
            float xv[16];
            const LAS float* ap = acs_l + r * 128 + 32 * i + 4 * hh;
            float av[16];
#pragma unroll
            for (int e = 0; e < 16; ++e) av[e] = ap[(e & 3) + 8 * (e >> 2)];
            if (i < j) {
#pragma unroll
                for (int e = 0; e < 16; ++e) xv[e] = cbT[i][e] * __builtin_amdgcn_exp2f(acl - av[e]);
            } else {
#pragma unroll
                for (int e = 0; e < 16; ++e) { const int t0 = (e & 3) + 8 * (e >> 2);
                    const float m01 = (t0 <= qm) ? 1.0f : 0.0f, dg = (t0 == qm) ? diag : 0.0f;
                    xv[e] = cbT[i][e] * __builtin_amdgcn_exp2f(fminf(acl - av[e], 0.f)) * m01 + dg; } }
#pragma unroll
            for (int s2 = 0; s2 < 2; ++s2) { v4u w; w.x = pkbf(xv[8 * s2 + 0], xv[8 * s2 + 1]); w.y = pkbf(xv[8 * s2 + 2], xv[8 * s2 + 3]); w.z = pkbf(xv[8 * s2 + 4], xv[8 * s2 + 5]); w.w = pkbf(xv[8 * s2 + 6], xv[8 * s2 + 7]);
                const bf16x8_t xf = __builtin_bit_cast(bf16x8_t, w);
#pragma unroll
                for (int pt = 0; pt < 2; ++pt)
                    O[pt] = __builtin_amdgcn_mfma_f32_32x32x16_bf16(tr_frag<4, 8>(XD, P_XSTR, 32 * i + 16 * s2, 64 * r + 32 * pt, lane), xf, O[pt], 0, 0, 0); } } }
        if (hp == 0) S3_D1_LOAD_PZ(1);
        float ss = 0.f;
#pragma unroll
        for (int pt = 0; pt < 2; ++pt)
#pragma unroll
            for (int g4 = 0; g4 < 4; ++g4) { const int p = 32 * pt + 8 * g4 + 4 * hh;
                const v2u zz = *(const LAS v2u*)(Zt + (32 * j + q) * SD_ROW + (64 * h2 + p) * 2);
                const float u0 = O[pt][4 * g4] * silu_fast(bflo(zz.x)), u1 = O[pt][4 * g4 + 1] * silu_fast(bfhi(zz.x)), u2 = O[pt][4 * g4 + 2] * silu_fast(bflo(zz.y)), u3 = O[pt][4 * g4 + 3] * silu_fast(bfhi(zz.y));
                ss += (u0 * u0 + u1 * u1) + (u2 * u2 + u3 * u3);
                vk[hp][pt * 8 + g4 * 2] = pkbf(u0, u1); vk[hp][pt * 8 + g4 * 2 + 1] = pkbf(u2, u3); }
        ss += shx(ss, 32, lane);
        if (hh == 0) rss[r * 128 + 32 * j + q] = ss;
    }
#undef S3_D1_LOAD_PZ
    LDS_WAIT(); __syncthreads();
    asm volatile("" : "+v"(tid)); lane = tid & 63; q = lane & 31; hh = lane >> 5;
    { const int l = 32 * j + q; const float tot = (rss[l] + rss[128 + l]) + (rss[256 + l] + rss[384 + l]);
      const float rn = __builtin_amdgcn_rsqf(tot * (1.0f / 256.0f) + EPS);
      LAS unsigned char* Ot = F.lds;
#pragma unroll
      for (int hp = 0; hp < 2; ++hp) { const int r = 2 * hp + h2;
#pragma unroll
          for (int pt = 0; pt < 2; ++pt)
#pragma unroll
              for (int g4 = 0; g4 < 4; ++g4) { const int p = 32 * pt + 8 * g4 + 4 * hh;
                  const f32x4 ng = *(const LAS f32x4*)(ng_l + r * 64 + p);
                  const unsigned w0 = vk[hp][pt * 8 + g4 * 2], w1 = vk[hp][pt * 8 + g4 * 2 + 1];
                  v2u w; w.x = pkbf(bflo(w0) * rn * ng.x, bfhi(w0) * rn * ng.y); w.y = pkbf(bflo(w1) * rn * ng.z, bfhi(w1) * rn * ng.w);
                  *(LAS v2u*)(Ot + l * 528 + (r * 64 + p) * 2) = w; } } }
    LDS_WAIT(); __syncthreads();
    asm volatile("" : "+v"(tid));
#pragma unroll
    for (int k = 0; k < 8; ++k) { const int ch = tid + NTHREADS * k, l = ch >> 5, c8 = ch & 31;
        const v4u w = *(const LAS v4u*)(F.lds + l * 528 + c8 * 16);
        GAS bf16* orow = dummy ? (GAS bf16*)FB(BO_STATES) + (size_t)(m0 + l) * 512 : PROJ + (size_t)(m0 + l) * PP + CZ;
        *(GAS v4u*)(orow + g * 256 + c8 * 8) = w; }
}

__device__ __forceinline__ void ph_inproj(Frame& F, int L) {
    LAS float* rstd_tab = (LAS float*)(F.lds + RSTD_OFF);
    int li_ = F.li; asm volatile("" : "+s"(li_)); pg8::GroupOrder S; S.init(NPROJ, li_);
    const GAS f32x4* sp = (const GAS f32x4*)((const GAS float*)FWS(WS_SSQ) + ((size_t)F.b * SEQ + (li_ & 7) * 256 + (F.tid >> 1)) * 16 + (F.tid & 1) * 8);
    pg8::Gemm g{(const GAS bf16*)FWS(WS_XB) + (size_t)F.b * SEQ * D, (const GAS bf16*)FWS(WS_WIN) + (size_t)L * NPROJ * D, SEQ, NPROJ, D, D};
    pg8::EpiProj E{(GAS bf16*)FB(BO_PROJ), (GAS float*)FWS(WS_DTRAW) + (size_t)F.b * SEQ * 8, rstd_tab, sp[0], sp[1]};
    pg8::gemm_phase<pg8::EpiProj, pg8::GroupOrder, true, true>(F.lds + RING_OFF, g, S, E);
}
__device__ __forceinline__ void ph_outproj(Frame& F, int L, bool dummy = false) {
    int li_ = F.li; asm volatile("" : "+s"(li_)); pg8::GroupOrder S; S.init(D, li_);
    pg8::Gemm g{(const GAS bf16*)FB(BO_PROJ), (const GAS bf16*)FWS(WS_WOUT) + (size_t)L * D * D, SEQ, D, D, PP};
    GAS bf16* XBb = (GAS bf16*)FWS(WS_XB) + (size_t)F.b * SEQ * D;
    pg8::EpiRes<false> E{XBb, (GAS float*)FWS(WS_SSQ) + (size_t)F.b * SEQ * 16, nullptr, dummy ? (GAS bf16*)FB(BO_YPART) : XBb};
    pg8::gemm_phase<pg8::EpiRes<false>, pg8::GroupOrder, false, true>(F.lds + RING_OFF, g, S, E);
}
__device__ __forceinline__ void ph_up(Frame& F, int L) {
    LAS float* rstd_tab = (LAS float*)(F.lds + RSTD_OFF);
    int li_ = F.li; asm volatile("" : "+s"(li_)); pg8::GroupOrder S; S.init(FF, li_);
    const GAS f32x4* sp = (const GAS f32x4*)((const GAS float*)FWS(WS_SSQ) + ((size_t)F.b * SEQ + (li_ & 7) * 256 + (F.tid >> 1)) * 16 + (F.tid & 1) * 8);
    pg8::Gemm g{(const GAS bf16*)FWS(WS_XB) + (size_t)F.b * SEQ * D, (const GAS bf16*)FWS(WS_WUP) + (size_t)L * FF * D, SEQ, FF, D, D};
    pg8::EpiUp E{(GAS bf16*)FB(BO_HID), FF, rstd_tab, sp[0], sp[1]};
    pg8::gemm_phase<pg8::EpiUp, pg8::GroupOrder, true, true>(F.lds + RING_OFF, g, S, E);
}
__device__ __forceinline__ void ph_down(Frame& F, int L, bool dummy = false) {
    int li_ = F.li; asm volatile("" : "+s"(li_)); pg8::GroupOrder S; S.init(D, li_);
    pg8::Gemm g{(const GAS bf16*)FB(BO_HID), (const GAS bf16*)FWS(WS_WDOWN) + (size_t)L * D * FF, SEQ, D, FF, FF};
    GAS bf16* XBb = (GAS bf16*)FWS(WS_XB) + (size_t)F.b * SEQ * D; GAS float* SSQb = (GAS float*)FWS(WS_SSQ) + (size_t)F.b * SEQ * 16;
    if (L == DEPTH - 1 && !dummy) { pg8::EpiRes<true> E{XBb, SSQb, (GAS float*)ptr_at(F, I_OUT) + (size_t)F.b * SEQ * D, XBb};
        pg8::gemm_phase<pg8::EpiRes<true>, pg8::GroupOrder, false, true>(F.lds + RING_OFF, g, S, E); }
    else { pg8::EpiRes<false> E{XBb, SSQb, nullptr, dummy ? (GAS bf16*)FB(16 * MiB) : XBb};
        pg8::gemm_phase<pg8::EpiRes<false>, pg8::GroupOrder, false, true>(F.lds + RING_OFF, g, S, E); }
}

#ifndef PROBE_REP
#define PROBE_REP 0
#endif
struct Args { const float* in[17]; float* out; unsigned char* ws; int pad0, pad1; };
__global__ void __launch_bounds__(NTHREADS, 2) fwd(Args args) {
    extern __shared__ __attribute__((aligned(16))) unsigned char lds[];
    Frame F;
    F.lds = (LAS unsigned char*)lds;
    F.tid = threadIdx.x; F.lane = F.tid & 63; F.wave = __builtin_amdgcn_readfirstlane(F.tid >> 6); F.bid = blockIdx.x; F.G = gridDim.x; F.b = F.bid & 7; F.li = F.bid >> 3;
    for (int u = F.tid; u < (LDS_BYTES - LDSCTL_OFF) / 4; u += NTHREADS) ((LAS unsigned*)(F.lds + LDSCTL_OFF))[u] = 0u;
    __syncthreads();
    if (F.tid < I_NPTR) { const unsigned long long p = F.tid < 17 ? (unsigned long long)args.in[F.tid < 17 ? F.tid : 0] : (F.tid == I_OUT ? (unsigned long long)args.out : (unsigned long long)args.ws);
        LAS unsigned* t = (LAS unsigned*)(F.lds + PTR_OFF) + 2 * F.tid; t[0] = (unsigned)p; t[1] = (unsigned)(p >> 32); }
    LDS_WAIT(); __syncthreads();
    if (F.G != GRID) return;
#define GBAR_OBJ() XcdBarrier{(unsigned*)(unsigned char*)FWS(WS_CTL) + CW_BAR, xb_xcc_id(), (unsigned)GRID, (volatile LAS unsigned*)(F.lds + MISC_OFF) + 8}
#define GRP_OBJ()  XcdBarrier{(unsigned*)(unsigned char*)FWS(WS_CTL) + CW_GRP + (blockIdx.x & 7) * GRP_BAR_STRIDE, xb_xcc_id(), (unsigned)GRP, (volatile LAS unsigned*)(F.lds + MISC_OFF) + 12}
    (void)xcd_barrier_post((unsigned*)(unsigned char*)FWS(WS_CTL) + CW_BAR, (volatile LAS unsigned*)(F.lds + MISC_OFF) + 8, GRID);
    (void)xcd_barrier_post((unsigned*)(unsigned char*)FWS(WS_CTL) + CW_GRP + (blockIdx.x & 7) * GRP_BAR_STRIDE, (volatile LAS unsigned*)(F.lds + MISC_OFF) + 12, GRP);
#define RELAUNDER() do { int t_ = threadIdx.x; asm volatile("" : "+v"(t_)); F.tid = t_; F.lane = t_ & 63; F.wave = __builtin_amdgcn_readfirstlane(t_ >> 6); \
    int b_ = blockIdx.x; asm volatile("" : "+s"(b_)); F.bid = b_; F.b = b_ & 7; F.li = b_ >> 3; } while (0)
#define GRP_BAR() do { const XcdBarrier gb_ = GRP_OBJ(); xcd_barrier(gb_); } while (0)
#define GRID_BAR() do { const XcdBarrier gb_ = GBAR_OBJ(); xcd_barrier(gb_); } while (0)

    p0_prologue(F);
    if (PROBE_REP == 1) { GRID_BAR(); RELAUNDER(); p0_prologue(F); }
    GRID_BAR();
    for (int L = 0; L < DEPTH; ++L) {
        RELAUNDER(); ph_inproj(F, L); if (PROBE_REP == 2) { GRP_BAR(); RELAUNDER(); ph_inproj(F, L); }
        if (F.li >= 16) { RELAUNDER(); convert_rest(F, L); }
        GRP_BAR();
        RELAUNDER(); if (PROBE_REP == 20) { attn_fast(F, L, true); GRP_BAR(); RELAUNDER(); }
        if (PROBE_REP == 25) {
#pragma unroll 1
            for (int rep = 0; rep < 2; ++rep) { attn_fast(F, L, rep == 0); if (rep == 0) { GRP_BAR(); RELAUNDER(); } } }
        else attn_fast(F, L);
        ssd_states(F, L); if (PROBE_REP == 21) { GRP_BAR(); RELAUNDER(); ssd_states(F, L); } GRP_BAR();
        RELAUNDER(); ssd_scan(F, L); if (PROBE_REP == 22) { GRP_BAR(); RELAUNDER(); ssd_scan(F, L); } if (PROBE_REP == 24) { for (int k = 0; k < 8; ++k) GRP_BAR(); } GRP_BAR();
        RELAUNDER(); if (PROBE_REP == 23) { ssd_out(F, L, true); GRP_BAR(); RELAUNDER(); } ssd_out(F, L); GRP_BAR();
        RELAUNDER(); wait_weights(F, L); if (PROBE_REP == 30) { ph_outproj(F, L, true); GRP_BAR(); RELAUNDER(); } ph_outproj(F, L); GRP_BAR();
        RELAUNDER(); ph_up(F, L); if (PROBE_REP == 5) { GRP_BAR(); RELAUNDER(); ph_up(F, L); } GRP_BAR();
        RELAUNDER(); if (PROBE_REP == 31) { ph_down(F, L, true); GRP_BAR(); RELAUNDER(); } ph_down(F, L); if (L + 1 < DEPTH) GRP_BAR();
    }
}

extern "C" void kernel_launch(void* const* d_in, const int* in_sizes, int n_in, void* d_out, int out_size, void* d_ws, size_t ws_size, hipStream_t stream) {
    static int grid = 0;
    if (grid == 0) {
        if (n_in != 17 || in_sizes[0] != M * D || out_size != M * D || ws_size < WS_END) { fprintf(stderr, "kernel_launch: unexpected shapes (n_in %d, in0 %d, out %d, ws %zu)\n", n_in, n_in > 0 ? in_sizes[0] : -1, out_size, ws_size); grid = -1; return; }
        int dev = 0, cus = 0, per_cu = 0;
        if (hipGetDevice(&dev) != hipSuccess || hipDeviceGetAttribute(&cus, hipDeviceAttributeMultiprocessorCount, dev) != hipSuccess) { grid = -1; return; }
        if (hipFuncSetAttribute((const void*)fwd, hipFuncAttributeMaxDynamicSharedMemorySize, LDS_BYTES) != hipSuccess) { fprintf(stderr, "kernel_launch: hipFuncSetAttribute failed\n"); grid = -1; return; }
        if (hipOccupancyMaxActiveBlocksPerMultiprocessor(&per_cu, (const void*)fwd, NTHREADS, LDS_BYTES) != hipSuccess || per_cu < 1) { fprintf(stderr, "kernel_launch: occupancy query says %d\n", per_cu); per_cu = 0; }
        (void)hipGetLastError();
        if (cus * per_cu < GRID) { fprintf(stderr, "kernel_launch: this kernel needs %d co-resident workgroups (one per CU of a 256-CU device); the device admits %d x %d; nothing launched\n", GRID, cus, per_cu); grid = -1; return; }
        grid = GRID;
    }
    if (grid < 0) return;
    (void)hipMemsetAsync((char*)d_ws + WS_CTL, 0, CTL_ZERO_BYTES, stream);
    Args a{};
    for (int i = 0; i < 17; ++i) a.in[i] = (const float*)d_in[i];
    a.out = (float*)d_out; a.ws = (unsigned char*)d_ws;
    void* kargs[] = {&a};
    hipError_t e = hipLaunchCooperativeKernel((const void*)fwd, dim3(grid), dim3(NTHREADS), kargs, LDS_BYTES, stream);
    if (e != hipSuccess) fprintf(stderr, "kernel_launch: cooperative launch failed: %s (grid %d)\n", hipGetErrorString(e), grid);
}
```

```cpp
#include <hip/hip_runtime.h>
#include <cstdio>
#include <cstdint>
#define PROBE_REP 0


namespace pg8 {
#define PG8_LAS __attribute__((address_space(3)))
#define PG8_GAS __attribute__((address_space(1)))
typedef unsigned short bf16_t;
typedef short bf16x8 __attribute__((ext_vector_type(8)));
typedef float f32x4 __attribute__((ext_vector_type(4)));
typedef unsigned u32x4 __attribute__((ext_vector_type(4)));
constexpr int BM = 256, BK = 64, HALF = 128, HTB = HALF * BK * 2  , STAGE_BYTES = 8 * HTB, NXCD = 8, WGM = 8;

__host__ __device__ __forceinline__ int lds_byte(int r, int c) { const int st = (r >> 4) * 2 + (c >> 5), rr = r & 15, cc = c & 31, ob = rr * 64 + cc * 2; return st * 1024 + (ob ^ (((ob >> 9) & 1) << 5)); }
__host__ __device__ __forceinline__ void stage_rc(int b, int& R, int& C) { const int st = b / 1024, sb = b % 1024, swz = sb ^ (((sb >> 9) & 1) << 5); R = (st >> 1) * 16 + swz / 64; C = (st & 1) * 32 + (swz % 64) / 2; }
__host__ __device__ __forceinline__ int perm32(int rho) { const int n = rho >> 4, i = rho & 15; return 8 * (i >> 2) + 4 * n + (i & 3); }

struct Unit { int pm, pn; };
struct Gemm { const PG8_GAS bf16_t* A; const PG8_GAS bf16_t* Bt; int M, N, K, lda; };

struct StaticOrder {
    int nM, nN, nwg, G, c;
    __host__ __device__ void init(int M, int N, int G_, int c_) { nM = M / BM; nN = N / BM; nwg = nM * nN; G = G_; c = c_; }
    __host__ __device__ bool next(int i, Unit& u) const {
        const long L = (long)i * G + c; if (L >= nwg) return false;
        int wgid = (int)L; { const int q = nwg / NXCD, r = nwg % NXCD, xcd = wgid % NXCD, off = wgid / NXCD; wgid = (xcd < r ? xcd * (q + 1) : r * (q + 1) + (xcd - r) * q) + off; }
        const int nig = WGM * nN, gid = wgid / nig, fm = gid * WGM, gsz = (nM - fm) < WGM ? (nM - fm) : WGM;
        u.pm = fm + ((wgid % nig) % gsz); u.pn = (wgid % nig) / gsz; return true;
    }
    __device__ __forceinline__ void a_ready(const Unit&) const {}
    __device__ __forceinline__ void done(const Unit&) const {}
};

struct GroupOrder {
    int nN, li;
    __host__ __device__ void init(int N, int li_) { nN = N / BM; li = li_; }
    __host__ __device__ bool next(int i, Unit& u) const { const int T = i * 32 + li; if (T >= 8 * nN) return false; u.pm = T & 7; u.pn = T >> 3; return true; }
    __device__ __forceinline__ void a_ready(const Unit&) const {}
    __device__ __forceinline__ void done(const Unit&) const {}
};

__device__ __forceinline__ float shx(float v, int k, int lane) { return __builtin_bit_cast(float, __builtin_amdgcn_ds_bpermute((lane ^ k) << 2, __builtin_bit_cast(int, v))); }
typedef float f32x2_t __attribute__((ext_vector_type(2))); typedef __bf16 bf16x2_t __attribute__((ext_vector_type(2)));
__device__ __forceinline__ unsigned cvt_pk_bf16(float lo, float hi) { f32x2_t v = {lo, hi}; bf16x2_t b = __builtin_convertvector(v, bf16x2_t); return __builtin_bit_cast(unsigned, b); }

constexpr int PROJ_PITCH = 2304, DT_TILE = 9;
struct EpiProj {
    static constexpr bool PERM = true, AFTER_DRAIN = false, ACC_INIT = false, PRE_HOOK = true;
    PG8_GAS bf16_t* O; PG8_GAS float* dtraw; PG8_LAS float* rstd; f32x4 pa, pb;
    __device__ __forceinline__ void pre(int tid) const {
        float s = (pa[0] + pa[1]) + (pa[2] + pa[3]) + (pb[0] + pb[1]) + (pb[2] + pb[3]);
        s += shx(s, 1, tid & 63);
        if ((tid & 1) == 0) rstd[tid >> 1] = 1.0f / sqrtf(s * (1.0f / 1024.0f) + 1e-6f);
    }
    __device__ __forceinline__ void operator()(const f32x4 (&acc)[2][2][4][2], const Unit& u, int ui, int wr, int wc, int fr, int fq) const {
        int rt0 = wr * 64 + fr; asm volatile("" : "+v"(rt0));
        if (u.pn == DT_TILE) {
            if (wc == 0 && fq == 0) {
#pragma unroll
                for (int ai = 0; ai < 2; ++ai)
#pragma unroll
                    for (int m = 0; m < 4; ++m) { const int rt = ai * HALF + rt0 + m * 16; const float rs = rstd[rt]; PG8_GAS float* p = dtraw + (size_t)(u.pm * BM + rt) * 8;
                        *(PG8_GAS f32x4*)p = acc[ai][0][m][0] * rs; *(PG8_GAS f32x4*)(p + 4) = acc[ai][0][m][1] * rs; }
            }
            return;
        }
        const int col0 = u.pn * BM + wc * 32 + 8 * fq;
#pragma unroll
        for (int ai = 0; ai < 2; ++ai)
#pragma unroll
            for (int m = 0; m < 4; ++m) { const int rt = ai * HALF + rt0 + m * 16; const float rs = rstd[rt]; PG8_GAS bf16_t* rowp = O + (size_t)(u.pm * BM + rt) * PROJ_PITCH + col0;
#pragma unroll
                for (int bj = 0; bj < 2; ++bj) { const f32x4 v0 = acc[ai][bj][m][0] * rs, v1 = acc[ai][bj][m][1] * rs;
                    u32x4 w; w.x = cvt_pk_bf16(v0[0], v0[1]); w.y = cvt_pk_bf16(v0[2], v0[3]); w.z = cvt_pk_bf16(v1[0], v1[1]); w.w = cvt_pk_bf16(v1[2], v1[3]);
                    *(PG8_GAS u32x4*)(rowp + bj * HALF) = w; } }
    }
};
struct EpiUp {
    static constexpr bool PERM = true, AFTER_DRAIN = false, ACC_INIT = false, PRE_HOOK = true;
    PG8_GAS bf16_t* O; int ldc; PG8_LAS float* rstd; f32x4 pa, pb;
    __device__ __forceinline__ void pre(int tid) const {
        float s = (pa[0] + pa[1]) + (pa[2] + pa[3]) + (pb[0] + pb[1]) + (pb[2] + pb[3]);
        s += shx(s, 1, tid & 63);
        if ((tid & 1) == 0) rstd[tid >> 1] = 1.0f / sqrtf(s * (1.0f / 1024.0f) + 1e-6f);
    }
    __device__ __forceinline__ void operator()(const f32x4 (&acc)[2][2][4][2], const Unit& u, int ui, int wr, int wc, int fr, int fq) const {
        int rt0 = wr * 64 + fr; asm volatile("" : "+v"(rt0)); const int col0 = u.pn * BM + wc * 32 + 8 * fq;
#pragma unroll
        for (int ai = 0; ai < 2; ++ai)
#pragma unroll
            for (int m = 0; m < 4; ++m) { const int rt = ai * HALF + rt0 + m * 16; const float rs = rstd[rt]; PG8_GAS bf16_t* rowp = O + (size_t)(u.pm * BM + rt) * ldc + col0;
#pragma unroll
                for (int bj = 0; bj < 2; ++bj) { f32x4 v0 = acc[ai][bj][m][0] * rs, v1 = acc[ai][bj][m][1] * rs;
#pragma unroll
                    for (int e = 0; e < 4; ++e) { const float a = fmaxf(v0[e], 0.f), b = fmaxf(v1[e], 0.f); v0[e] = a * a; v1[e] = b * b; }
                    u32x4 w; w.x = cvt_pk_bf16(v0[0], v0[1]); w.y = cvt_pk_bf16(v0[2], v0[3]); w.z = cvt_pk_bf16(v1[0], v1[1]); w.w = cvt_pk_bf16(v1[2], v1[3]);
                    *(PG8_GAS u32x4*)(rowp + bj * HALF) = w; } }
    }
};
template <bool FINAL> struct EpiRes {
    static constexpr bool PERM = true, AFTER_DRAIN = false, ACC_INIT = true, PRE_HOOK = false;
    PG8_GAS bf16_t* xb; PG8_GAS float* ssq; PG8_GAS float* out; PG8_GAS bf16_t* xdst;
    __device__ __forceinline__ void init(f32x4 (&acc)[2][2][4][2], const Unit& u, int wr, int wc, int fr, int fq) const {
        const int rt0 = wr * 64 + fr, col0 = u.pn * BM + wc * 32 + 8 * fq;
#pragma unroll
        for (int ai = 0; ai < 2; ++ai)
#pragma unroll
            for (int m = 0; m < 4; ++m) { const int row = u.pm * BM + ai * HALF + rt0 + m * 16; const size_t off = (size_t)row * 1024 + col0;
#pragma unroll
                for (int bj = 0; bj < 2; ++bj) { const u32x4 rw = *(const PG8_GAS u32x4*)(xb + off + bj * HALF);
                    acc[ai][bj][m][0] = (f32x4){__uint_as_float(rw.x << 16), __uint_as_float(rw.x & 0xffff0000u), __uint_as_float(rw.y << 16), __uint_as_float(rw.y & 0xffff0000u)};
                    acc[ai][bj][m][1] = (f32x4){__uint_as_float(rw.z << 16), __uint_as_float(rw.z & 0xffff0000u), __uint_as_float(rw.w << 16), __uint_as_float(rw.w & 0xffff0000u)}; } }
    }
    __device__ __forceinline__ void operator()(const f32x4 (&acc)[2][2][4][2], const Unit& u, int ui, int wr, int wc, int fr, int fq) const {
        int rt0 = wr * 64 + fr; asm volatile("" : "+v"(rt0)); const int col0 = u.pn * BM + wc * 32 + 8 * fq;
#pragma unroll
        for (int ai = 0; ai < 2; ++ai)
#pragma unroll
            for (int m = 0; m < 4; ++m) { const int row = u.pm * BM + ai * HALF + rt0 + m * 16; const size_t off = (size_t)row * 1024 + col0; float s = 0.f;
#pragma unroll
                for (int bj = 0; bj < 2; ++bj) { const f32x4 v0 = acc[ai][bj][m][0], v1 = acc[ai][bj][m][1];
                    if (FINAL) { *(PG8_GAS f32x4*)(out + off + bj * HALF) = v0; *(PG8_GAS f32x4*)(out + off + bj * HALF + 4) = v1; }
                    else { u32x4 w; w.x = cvt_pk_bf16(v0[0], v0[1]); w.y = cvt_pk_bf16(v0[2], v0[3]); w.z = cvt_pk_bf16(v1[0], v1[1]); w.w = cvt_pk_bf16(v1[2], v1[3]);
                        *(PG8_GAS u32x4*)(xdst + off + bj * HALF) = w;
                        s += (v0[0] * v0[0] + v0[1] * v0[1]) + (v0[2] * v0[2] + v0[3] * v0[3]) + (v1[0] * v1[0] + v1[1] * v1[1]) + (v1[2] * v1[2] + v1[3] * v1[3]); } }
                if (!FINAL) { const int ln = fq * 16 + fr; s += shx(s, 16, ln); s += shx(s, 32, ln);
                    if (fq == 0) ssq[(size_t)row * 16 + u.pn * 4 + wc] = s; } }
    }
};

template <class Epi, class Sched, bool ALIGN_EPI = false, bool SP2 = false>
__device__ __forceinline__ void gemm_phase(PG8_LAS unsigned char* lds, const Gemm g, const Sched& S, const Epi& E) {
    int tid_ = threadIdx.x; asm volatile("" : "+v"(tid_));
    const int tid = tid_, wid = __builtin_amdgcn_readfirstlane(tid >> 6), lane = tid & 63, wr = wid >> 2, wc = wid & 3, fr = lane & 15, fq = lane >> 4;
    const int K = g.K, nt = K / BK;
    unsigned voffA[2], voffB[2];
#pragma unroll
    for (int i = 0; i < 2; ++i) { int R, C; stage_rc(tid * 16 + i * 8192, R, C); const int Rb = Epi::PERM ? ((R & ~31) + perm32(R & 31)) : R;
        voffA[i] = (unsigned)(R * g.lda + C) * 2u; voffB[i] = (unsigned)(Rb * K + C) * 2u; }
    const size_t kstep = (size_t)(BK * 2);
    const size_t hstepA = (size_t)HALF * g.lda * 2, hstepB = (size_t)HALF * K * 2;
    const size_t tstepA = 2 * hstepA, tstepB = 2 * hstepB;
    const unsigned ldsw = (unsigned)wid * 1024u;
    const int aoff = lds_byte(wr * 64 + fr, fq * 8), boff = lds_byte(wc * 32 + fr, fq * 8);
#define PG8_SA(b, h) (((b) * 2 + (h)) * HTB)
#define PG8_SB(b, h) ((4 + (b) * 2 + (h)) * HTB)
#define PG8_STAGE(bufoff, gbase, voff) do { _Pragma("unroll") for (int _i = 0; _i < 2; ++_i) \
        __builtin_amdgcn_global_load_lds((const unsigned*)((const char*)(gbase) + (voff)[_i]), (PG8_LAS unsigned*)(lds + (bufoff) + ldsw + _i * 8192), 16, 0, 0); } while (0)
#define PG8_LDA(dst, b, h) do { _Pragma("unroll") for (int m = 0; m < 4; ++m) _Pragma("unroll") for (int k = 0; k < 2; ++k) dst[m][k] = *(const PG8_LAS bf16x8*)(lds + PG8_SA(b, h) + aoff + m * 2048 + k * 1024); } while (0)
#define PG8_LDB(dst, b, h) do { _Pragma("unroll") for (int n = 0; n < 2; ++n) _Pragma("unroll") for (int k = 0; k < 2; ++k) dst[n][k] = *(const PG8_LAS bf16x8*)(lds + PG8_SB(b, h) + boff + n * 2048 + k * 1024); } while (0)
#define PG8_MMA(ai, bj, At, Bt) do { __builtin_amdgcn_s_setprio(1); _Pragma("unroll") for (int m = 0; m < 4; ++m) _Pragma("unroll") for (int n = 0; n < 2; ++n) _Pragma("unroll") for (int k = 0; k < 2; ++k) \
        acc[ai][bj][m][n] = __builtin_amdgcn_mfma_f32_16x16x32_bf16(Bt[n][k], At[m][k], acc[ai][bj][m][n], 0, 0, 0); __builtin_amdgcn_s_setprio(0); } while (0)
#define PG8_WAIT_V(n) asm volatile("s_waitcnt vmcnt(" #n ")" ::: "memory")
#define PG8_WAIT_L(n) asm volatile("s_waitcnt lgkmcnt(" #n ")" ::: "memory")
#define PG8_BAR __builtin_amdgcn_s_barrier()
#define PG8_SCHED __builtin_amdgcn_sched_barrier(0)
    Unit cur, nxt; int ui = 0;
    if (!S.next(0, cur)) return;
    f32x4 acc[2][2][4][2];
#pragma unroll
    for (int a = 0; a < 2; ++a)
#pragma unroll
        for (int b = 0; b < 2; ++b)
#pragma unroll
            for (int m = 0; m < 4; ++m)
#pragma unroll
                for (int n = 0; n < 2; ++n) acc[a][b][m][n] = (f32x4){0.f, 0.f, 0.f, 0.f};
    if constexpr (Epi::ACC_INIT) E.init(acc, cur, wr, wc, fr, fq);
    bf16x8 At[4][2], B0[2][2], B1[2][2];
    const char* cA = (const char*)g.A + (size_t)cur.pm * tstepA; const char* cB = (const char*)g.Bt + (size_t)cur.pn * tstepB;
    S.a_ready(cur);
    if constexpr (SP2) {
        PG8_STAGE(PG8_SB(0, 0), cB, voffB); PG8_STAGE(PG8_SB(0, 1), cB + hstepB, voffB); PG8_STAGE(PG8_SA(0, 0), cA, voffA); PG8_STAGE(PG8_SA(0, 1), cA + hstepA, voffA);
        if constexpr (Epi::PRE_HOOK) E.pre(tid);
        if (wr == 1) PG8_BAR;
        PG8_WAIT_V(2); PG8_BAR;
        PG8_STAGE(PG8_SB(1, 0), cB + kstep, voffB); PG8_STAGE(PG8_SA(1, 0), cA + kstep, voffA); PG8_STAGE(PG8_SB(1, 1), cB + hstepB + kstep, voffB);
        PG8_WAIT_V(6); PG8_BAR;
    } else {
        PG8_STAGE(PG8_SB(0, 0), cB, voffB); PG8_STAGE(PG8_SA(0, 0), cA, voffA); PG8_STAGE(PG8_SB(0, 1), cB + hstepB, voffB); PG8_STAGE(PG8_SA(0, 1), cA + hstepA, voffA);
        if (wr == 1) PG8_BAR;
        PG8_WAIT_V(4); PG8_BAR;
        PG8_STAGE(PG8_SB(1, 0), cB + kstep, voffB); PG8_STAGE(PG8_SA(1, 0), cA + kstep, voffA); PG8_STAGE(PG8_SB(1, 1), cB + hstepB + kstep, voffB);
        PG8_WAIT_V(6); PG8_BAR;
    }
    for (;;) {
        const bool has_next = S.next(ui + 1, nxt);
        const char* nA = has_next ? (const char*)g.A + (size_t)nxt.pm * tstepA : cA; const char* nB = has_next ? (const char*)g.Bt + (size_t)nxt.pn * tstepB : cB;
        for (int t = 0; t < nt; t += 2) {
            const bool last = (t == nt - 2);
            const char* a1 = cA + (size_t)(t + 1) * kstep;
            const char* a2 = last ? nA : cA + (size_t)(t + 2) * kstep; const char* b2 = last ? nB : cB + (size_t)(t + 2) * kstep;
            const char* a3 = a2 + kstep; const char* b3 = b2 + kstep;
            if (last && has_next) S.a_ready(nxt);
            if constexpr (SP2) {
            PG8_LDB(B0, 0, 0); PG8_LDB(B1, 0, 1); PG8_SCHED; PG8_LDA(At, 0, 0); PG8_STAGE(PG8_SA(1, 1), a1 + hstepA, voffA);
            PG8_WAIT_V(8); PG8_WAIT_L(0); PG8_BAR; PG8_MMA(0, 0, At, B0); PG8_MMA(0, 1, At, B1); PG8_BAR; PG8_SCHED;
            PG8_LDA(At, 0, 1); PG8_STAGE(PG8_SB(0, 0), b2, voffB); PG8_STAGE(PG8_SB(0, 1), b2 + hstepB, voffB); PG8_STAGE(PG8_SA(0, 0), a2, voffA);
            PG8_WAIT_V(8); PG8_WAIT_L(0); PG8_BAR; PG8_MMA(1, 0, At, B0); PG8_MMA(1, 1, At, B1); PG8_BAR; PG8_SCHED;
            PG8_LDB(B0, 1, 0); PG8_LDB(B1, 1, 1); PG8_SCHED; PG8_LDA(At, 1, 0); PG8_STAGE(PG8_SA(0, 1), a2 + hstepA, voffA);
            PG8_WAIT_V(8); PG8_WAIT_L(0); PG8_BAR; PG8_MMA(0, 0, At, B0); PG8_MMA(0, 1, At, B1); PG8_BAR; PG8_SCHED;
            PG8_LDA(At, 1, 1); PG8_STAGE(PG8_SB(1, 0), b3, voffB); PG8_STAGE(PG8_SB(1, 1), b3 + hstepB, voffB); PG8_STAGE(PG8_SA(1, 0), a3, voffA);
            PG8_WAIT_V(8); PG8_WAIT_L(0); PG8_BAR; PG8_MMA(1, 0, At, B0); PG8_MMA(1, 1, At, B1); PG8_BAR; PG8_SCHED;
            } else {
            PG8_LDB(B0, 0, 0); PG8_SCHED; PG8_LDA(At, 0, 0); PG8_STAGE(PG8_SA(1, 1), a1 + hstepA, voffA);
            PG8_WAIT_L(8); PG8_BAR; PG8_WAIT_L(0); PG8_MMA(0, 0, At, B0); PG8_BAR; PG8_SCHED;
            PG8_LDB(B1, 0, 1); PG8_STAGE(PG8_SB(0, 0), b2, voffB);
            PG8_BAR; PG8_WAIT_L(0); PG8_MMA(0, 1, At, B1); PG8_BAR;
            PG8_LDA(At, 0, 1); PG8_STAGE(PG8_SA(0, 0), a2, voffA);
            PG8_BAR; PG8_WAIT_L(0); PG8_MMA(1, 0, At, B0); PG8_BAR; PG8_SCHED;
            PG8_STAGE(PG8_SB(0, 1), b2 + hstepB, voffB);
            PG8_WAIT_V(6); PG8_BAR; PG8_MMA(1, 1, At, B1); PG8_BAR;
            PG8_LDB(B0, 1, 0); PG8_SCHED; PG8_LDA(At, 1, 0); PG8_STAGE(PG8_SA(0, 1), a2 + hstepA, voffA);
            PG8_WAIT_L(8); PG8_BAR; PG8_WAIT_L(0); PG8_MMA(0, 0, At, B0); PG8_BAR; PG8_SCHED;
            PG8_LDB(B1, 1, 1); PG8_STAGE(PG8_SB(1, 0), b3, voffB);
            PG8_BAR; PG8_WAIT_L(0); PG8_MMA(0, 1, At, B1); PG8_BAR;
            PG8_LDA(At, 1, 1); PG8_STAGE(PG8_SA(1, 0), a3, voffA);
            PG8_BAR; PG8_WAIT_L(0); PG8_MMA(1, 0, At, B0); PG8_BAR; PG8_SCHED;
            PG8_STAGE(PG8_SB(1, 1), b3 + hstepB, voffB);
            PG8_WAIT_V(6); PG8_BAR; PG8_MMA(1, 1, At, B1); PG8_BAR;
            }
        }
        if constexpr (ALIGN_EPI) { if (wr == 0) PG8_BAR; }
        if constexpr (!Epi::AFTER_DRAIN) { E(acc, cur, ui, wr, wc, fr, fq); S.done(cur); }
        if (!has_next) break;
#pragma unroll
        for (int a = 0; a < 2; ++a)
#pragma unroll
            for (int b = 0; b < 2; ++b)
#pragma unroll
                for (int m = 0; m < 4; ++m)
#pragma unroll
                    for (int n = 0; n < 2; ++n) acc[a][b][m][n] = (f32x4){0.f, 0.f, 0.f, 0.f};
        cur = nxt; cA = nA; cB = nB; ++ui;
        if constexpr (ALIGN_EPI) { if (wr == 1) PG8_BAR; }
    }
    PG8_WAIT_V(0);
    if constexpr (!ALIGN_EPI) { if (wr == 0) PG8_BAR; }
    PG8_BAR;

#undef PG8_SA
#undef PG8_SB
#undef PG8_STAGE
#undef PG8_LDA
#undef PG8_LDB
#undef PG8_MMA
#undef PG8_WAIT_V
#undef PG8_WAIT_L
#undef PG8_BAR
#undef PG8_SCHED
}
}

constexpr int NWAVES = 8, NTHREADS = NWAVES * 64;
constexpr int BATCH = 8, SEQ = 2048, D = 1024, M = BATCH * SEQ, FF = 4096, DEPTH = 2;
constexpr int D_IN = 2312, NPROJ = 2560, PP = pg8::PROJ_PITCH;
constexpr int CQ = 0, CZ = 512, CK = 1024, CV = 1152, CX = 1280, CBM = 1792, CCM = 2048;
constexpr float EPS = 1e-6f;
constexpr int GRID = 256, NGRP = 8, GRP = GRID / NGRP;

constexpr size_t MiB = 1u << 20;
constexpr size_t WS_CTL = 0, CTL_ZERO_BYTES = 1 * MiB;
constexpr size_t WS_SSQ = 1 * MiB;
constexpr size_t WS_DTRAW = 2 * MiB;
constexpr size_t WS_ACS = 2 * MiB + 512 * 1024, WS_CHDEC = 3 * MiB;
constexpr size_t WS_WIN = 4 * MiB, WS_WOUT = 14 * MiB, WS_WUP = 18 * MiB, WS_WDOWN = 34 * MiB;
constexpr size_t WS_XB = 50 * MiB;
constexpr size_t WS_BATCH0 = 82 * MiB, BATCH_STRIDE = 20 * MiB;
constexpr size_t BO_PROJ = 0;
constexpr size_t BO_STATES = 9 * MiB;
constexpr size_t BO_PREV = 13 * MiB;
constexpr size_t BO_YPART = 15 * MiB;
constexpr size_t BO_CC = 19 * MiB;
constexpr size_t BO_HID = 0;
constexpr size_t WS_END = WS_BATCH0 + BATCH * BATCH_STRIDE;
static_assert(WS_END <= 256 * MiB, "d_ws map");
constexpr int CW_BAR = 4096, CW_GRP = 16384, GRP_BAR_STRIDE = 4096;

constexpr int RING_OFF = 0, RING_BYTES = 131072;
constexpr int MIX_BYTES = 155648;
constexpr int LDSCTL_OFF = MIX_BYTES, MISC_OFF = LDSCTL_OFF + 320, RSTD_OFF = LDSCTL_OFF + 512, PTR_OFF = RSTD_OFF + 4096;
constexpr int LDS_BYTES = 163840;
static_assert(PTR_OFF + 512 <= LDS_BYTES && RING_BYTES <= MIX_BYTES, "LDS map");

#define GAS __attribute__((address_space(1)))
#define LAS __attribute__((address_space(3)))
typedef unsigned short bf16;
typedef unsigned v4u __attribute__((ext_vector_type(4)));
typedef unsigned v2u __attribute__((ext_vector_type(2)));
typedef float f32x4 __attribute__((ext_vector_type(4)));
#define LDS_WAIT() asm volatile("s_waitcnt lgkmcnt(0)" ::: "memory")
#define VM_WAIT() asm volatile("s_waitcnt vmcnt(0)" ::: "memory")
__device__ __forceinline__ unsigned f2bf(float f) { unsigned u = __builtin_bit_cast(unsigned, f); return (u + 0x7fffu + ((u >> 16) & 1u)) >> 16; }
__device__ __forceinline__ unsigned pk2(float lo, float hi) { return f2bf(lo) | (f2bf(hi) << 16); }
__device__ __forceinline__ float bflo(unsigned w) { return __uint_as_float(w << 16); }
__device__ __forceinline__ float bfhi(unsigned w) { return __uint_as_float(w & 0xffff0000u); }
__device__ __forceinline__ float silu_f(float v) { return v / (1.f + expf(-v)); }
__device__ __forceinline__ float softplus_f(float v) { return fmaxf(v, 0.f) + log1pf(expf(-fabsf(v))); }

#define XB_TMO      128
#define XB_XCNT(j)  (256  + 64 * (j))
#define XB_XSUB(j)  (1280 + 64 * (j))
#define XB_XGEN(j)  (2304 + 64 * (j))
#define XB_TOP      3328
#define XB_TOPGEN   3392
#define XCD_BAR_WORDS 3456
#define XB_SPIN_CAP (1u << 22)
__device__ __forceinline__ unsigned xb_ld(unsigned* p)              { return __hip_atomic_load(p, __ATOMIC_RELAXED, __HIP_MEMORY_SCOPE_AGENT); }
__device__ __forceinline__ unsigned xb_add(unsigned* p, unsigned v) { return __hip_atomic_fetch_add(p, v, __ATOMIC_RELAXED, __HIP_MEMORY_SCOPE_AGENT); }
__device__ __forceinline__ unsigned xb_xcc_id() { return (unsigned)__builtin_amdgcn_s_getreg((3 << 11) | 20) & 0xFu; }
#define XB_SPIN(cond, bar) do { unsigned _sp = 0; while (cond) { __builtin_amdgcn_s_sleep(1); \
    if ((++_sp & 255u) == 0u) { if (xb_ld(&(bar)[XB_TMO])) break; if (_sp > XB_SPIN_CAP) { atomicAdd(&(bar)[XB_TMO], 1u); break; } } } } while (0)
struct XcdBarrier { unsigned* bar; unsigned x; unsigned total; volatile LAS unsigned* st; };
__device__ __forceinline__ XcdBarrier xcd_barrier_post(unsigned* bar, volatile LAS unsigned* st, unsigned total) {
    XcdBarrier b; b.bar = bar; b.x = xb_xcc_id(); b.total = total; b.st = st;
    if (threadIdx.x == 0) (void)xb_add(&bar[XB_XCNT(b.x)], 1u);
    return b;
}
__device__ __forceinline__ void xcd_barrier_complete(unsigned* bar, unsigned x, unsigned G, unsigned& nloc, unsigned& nx) {
    unsigned sum, cnt, mine, sp = 0u;
    for (;;) {
        sum = 0u; cnt = 0u; mine = 0u;
#pragma unroll
        for (unsigned j = 0; j < 16; ++j) { const unsigned c = xb_ld(&bar[XB_XCNT(j)]); sum += c; cnt += (c > 0u) ? 1u : 0u; mine = (j == x) ? c : mine; }
        if (sum == G) break;
        __builtin_amdgcn_s_sleep(1);
        if ((++sp & 255u) == 0u) { if (xb_ld(&bar[XB_TMO])) break; if (sp > XB_SPIN_CAP) { atomicAdd(&bar[XB_TMO], 1u); break; } }
    }
    nloc = mine > 0u ? mine : 1u; nx = cnt > 0u ? cnt : 1u;
}
__device__ __forceinline__ void xcd_barrier(const XcdBarrier& b) {
    asm volatile("s_waitcnt vmcnt(0)" ::: "memory");
    __syncthreads();
    if (threadIdx.x == 0) {
        unsigned* bar = b.bar;
        __builtin_amdgcn_s_waitcnt(0);
        unsigned nloc = b.st[0], nx = b.st[1];
        if (nloc == 0u) { xcd_barrier_complete(bar, b.x, b.total, nloc, nx); b.st[0] = nloc; b.st[1] = nx; }
        const unsigned old = xb_add(&bar[XB_XSUB(b.x)], 1u);
        const unsigned gen = old / nloc;
        if (nx == 1u) {
            XB_SPIN(xb_ld(&bar[XB_XSUB(b.x)]) < (gen + 1u) * nloc, bar);
            __builtin_amdgcn_fence(__ATOMIC_ACQUIRE, "agent");
            asm volatile("s_waitcnt vmcnt(0)" ::: "memory");
        } else if (old + 1u == (gen + 1u) * nloc) {
            __builtin_amdgcn_fence(__ATOMIC_RELEASE, "agent");
            asm volatile("s_waitcnt vmcnt(0)" ::: "memory");
            const unsigned og = xb_add(&bar[XB_TOP], 1u);
            const unsigned tg = og / nx;
            if (og + 1u == (tg + 1u) * nx) xb_add(&bar[XB_TOPGEN], 1u);
            else XB_SPIN(xb_ld(&bar[XB_TOPGEN]) == tg, bar);
            __builtin_amdgcn_fence(__ATOMIC_ACQUIRE, "agent");
            xb_add(&bar[XB_XGEN(b.x)], 1u);
            asm volatile("s_waitcnt vmcnt(0)" ::: "memory");
        } else {
            XB_SPIN(xb_ld(&bar[XB_XGEN(b.x)]) == gen, bar);
            __builtin_amdgcn_fence(__ATOMIC_ACQUIRE, "agent");
            asm volatile("s_waitcnt vmcnt(0)" ::: "memory");
        }
    }
    __syncthreads();
}

struct Frame {
    LAS unsigned char* lds;
    int tid, lane, wave, bid, G;
    int b, li;
};
enum { I_X = 0, I_MIXG, I_WIN, I_QG, I_KG, I_SINK, I_RELB, I_CONVW, I_CONVB, I_DTB, I_ALOG, I_DSKIP, I_SSMG, I_WOUT, I_MLPG, I_WUP, I_WDOWN, I_OUT, I_WS, I_NPTR };
__device__ __forceinline__ GAS unsigned char* ptr_at(const Frame& F, int i) {
    const LAS unsigned* t = (const LAS unsigned*)(F.lds + PTR_OFF) + 2 * i;
    const unsigned lo = __builtin_amdgcn_readfirstlane(t[0]), hi = __builtin_amdgcn_readfirstlane(t[1]);
    return (GAS unsigned char*)(((unsigned long long)hi << 32) | lo);
}
#define FIN(i) ((const GAS float*)ptr_at(F, (i)))
#define FWS(off) (ptr_at(F, I_WS) + (off))
#define FB(off) (ptr_at(F, I_WS) + (WS_BATCH0 + (size_t)F.b * BATCH_STRIDE + (off)))
using pg8::shx;
__device__ __forceinline__ float shup(float v, int o, int lane) { return __builtin_bit_cast(float, __builtin_amdgcn_ds_bpermute(((lane - o) & 63) << 2, __builtin_bit_cast(int, v))); }
__device__ __forceinline__ float wave_sum(float v, int lane) {
#pragma unroll
    for (int o = 1; o < 64; o <<= 1) v += shx(v, o, lane);
    return v;
}

__device__ __forceinline__ void tr_item(const GAS float* W, int Nsrc, int nsrc0, int nvalid, int K, const GAS float* gain, GAS bf16* WT, int ndst0, int k0, LAS float* scr, int lane) {
    const int n = lane & 31;
    float tv[32];
#pragma unroll
    for (int i = 0; i < 32; ++i) { const int kk = 2 * i + (lane >> 5); tv[i] = W[(size_t)(k0 + kk) * Nsrc + nsrc0 + (n < nvalid ? n : 0)]; }
#pragma unroll
    for (int i = 0; i < 32; ++i) { const int kk = 2 * i + (lane >> 5); float v = (n < nvalid) ? tv[i] : 0.f; if (gain) v *= gain[k0 + kk];
        scr[kk * 33 + n] = v; }
    LDS_WAIT(); asm volatile("" ::: "memory");
    const int c = lane & 7;
#pragma unroll
    for (int j = 0; j < 4; ++j) { const int nn = (lane >> 3) + 8 * j; const LAS float* s = scr + (8 * c) * 33 + nn;
        v4u o; o.x = pk2(s[0 * 33], s[1 * 33]); o.y = pk2(s[2 * 33], s[3 * 33]); o.z = pk2(s[4 * 33], s[5 * 33]); o.w = pk2(s[6 * 33], s[7 * 33]);
        *(GAS v4u*)(WT + (size_t)(ndst0 + nn) * K + k0 + 8 * c) = o; }
    LDS_WAIT(); asm volatile("" ::: "memory");
}
__device__ __forceinline__ void win_item(Frame& F, int L, int r, LAS float* scr);
__device__ __forceinline__ void p0_prologue(Frame& F) {
    LAS float* scr = (LAS float*)(F.lds + RING_OFF + F.wave * 16384);
    const int gw = F.bid * NWAVES + F.wave, NGW = F.G * NWAVES;
    constexpr int I_IN = 16 * 80, I_OUT = 16 * 32, I_UP = 16 * 128, I_DN = 64 * 32, I_L = I_IN + I_OUT + I_UP + I_DN;
    for (int it = gw; it < I_IN; it += NGW) win_item(F, 0, it, scr);
    const GAS float* x = FIN(I_X) + (size_t)F.b * SEQ * D; GAS bf16* XB = (GAS bf16*)FWS(WS_XB) + (size_t)F.b * SEQ * D; GAS float* SSQ = (GAS float*)FWS(WS_SSQ) + (size_t)F.b * SEQ * 16;
    for (int m = F.li * NWAVES + F.wave; m < SEQ; m += 2 * GRP * NWAVES) {
        const int m2 = m + GRP * NWAVES;
        const GAS f32x4* xr = (const GAS f32x4*)(x + (size_t)m * D) + F.lane; const GAS f32x4* xr2 = (const GAS f32x4*)(x + (size_t)m2 * D) + F.lane;
        f32x4 v[4], w[4]; float s = 0.f, s2 = 0.f;
#pragma unroll
        for (int j = 0; j < 4; ++j) { v[j] = xr[64 * j]; w[j] = xr2[64 * j]; }
#pragma unroll
        for (int j = 0; j < 4; ++j) { s += (v[j].x * v[j].x + v[j].y * v[j].y) + (v[j].z * v[j].z + v[j].w * v[j].w); s2 += (w[j].x * w[j].x + w[j].y * w[j].y) + (w[j].z * w[j].z + w[j].w * w[j].w); }
        s = wave_sum(s, F.lane); s2 = wave_sum(s2, F.lane);
        GAS v2u* o8 = (GAS v2u*)(XB + (size_t)m * D) + F.lane; GAS v2u* o82 = (GAS v2u*)(XB + (size_t)m2 * D) + F.lane;
#pragma unroll
        for (int j = 0; j < 4; ++j) { v2u o; o.x = pk2(v[j].x, v[j].y); o.y = pk2(v[j].z, v[j].w); o8[64 * j] = o; v2u o2; o2.x = pk2(w[j].x, w[j].y); o2.y = pk2(w[j].z, w[j].w); o82[64 * j] = o2; }
        if (F.lane < 16) { SSQ[(size_t)m * 16 + F.lane] = (F.lane == 0) ? s : 0.f; SSQ[(size_t)m2 * 16 + F.lane] = (F.lane == 0) ? s2 : 0.f; }
    }
}
constexpr int CW_WCNT = 8192, N_CONVERTERS = NGRP * (GRP - 16);
__device__ __forceinline__ void win_item(Frame& F, int L, int r, LAS float* scr) {
    const int kb = r / 80, nb = r % 80; int src, nv = 32;
    if (nb < 16) src = nb * 32; else if (nb < 32) src = 768 + (nb - 16) * 32; else if (nb < 36) src = 512 + (nb - 32) * 32; else if (nb < 40) src = 640 + (nb - 36) * 32;
    else if (nb < 72) src = nb * 32; else if (nb == 72) { src = 2304; nv = 8; } else { src = 0; nv = 0; }
    tr_item(FIN(I_WIN) + (size_t)L * D * D_IN, D_IN, src, nv, D, FIN(I_MIXG) + L * D, (GAS bf16*)FWS(WS_WIN) + (size_t)L * NPROJ * D, nb * 32, kb * 64, scr, F.lane);
}
__device__ __forceinline__ void convert_rest(Frame& F, int slot) {
    LAS float* scr = (LAS float*)(F.lds + RING_OFF + F.wave * 16384);
    constexpr int I_IN = 16 * 80, I_OUT = 16 * 32, I_UP = 16 * 128, I_DN = 64 * 32, NCW = N_CONVERTERS * NWAVES;
    const GAS float *w_out = FIN(I_WOUT), *w_up = FIN(I_WUP), *mlp_g = FIN(I_MLPG), *w_down = FIN(I_WDOWN);
    GAS bf16 *WOUT = (GAS bf16*)FWS(WS_WOUT), *WUP = (GAS bf16*)FWS(WS_WUP), *WDOWN = (GAS bf16*)FWS(WS_WDOWN);
    const int L = slot, n_items = I_OUT + I_UP + I_DN + (slot == 0 ? I_IN : 0);
    for (int it = (F.b * (GRP - 16) + (F.li - 16)) * NWAVES + F.wave; it < n_items; it += NCW) {
        int r = it;
        if (r < I_OUT) { const int kb = r / 32, nb = r % 32; tr_item(w_out + (size_t)L * D * D, D, nb * 32, 32, D, nullptr, WOUT + (size_t)L * D * D, nb * 32, kb * 64, scr, F.lane); continue; }
        r -= I_OUT;
        if (r < I_UP) { const int kb = r / 128, nb = r % 128; tr_item(w_up + (size_t)L * D * FF, FF, nb * 32, 32, D, mlp_g + L * D, WUP + (size_t)L * FF * D, nb * 32, kb * 64, scr, F.lane); continue; }
        r -= I_UP;
        if (r < I_DN) { const int kb = r / 32, nb = r % 32; tr_item(w_down + (size_t)L * FF * D, D, nb * 32, 32, FF, nullptr, WDOWN + (size_t)L * D * FF, nb * 32, kb * 64, scr, F.lane); continue; }
        r -= I_DN;
        win_item(F, 1, r, scr);
    }
    asm volatile("s_waitcnt vmcnt(0)" ::: "memory");
    __syncthreads();
    if (F.tid == 0) { __builtin_amdgcn_fence(__ATOMIC_RELEASE, "agent"); asm volatile("s_waitcnt vmcnt(0)" ::: "memory");
        (void)xb_add((unsigned*)(unsigned char*)FWS(WS_CTL) + CW_WCNT + 64 * slot, 1u); }
}
__device__ __forceinline__ void wait_weights(Frame& F, int part) {
    if (F.tid == 0) { unsigned* wc = (unsigned*)(unsigned char*)FWS(WS_CTL) + CW_WCNT + 64 * part; unsigned sp = 0u;
        while (xb_ld(wc) < (unsigned)N_CONVERTERS) { __builtin_amdgcn_s_sleep(2); if (++sp > (1u << 22)) break; }
        __builtin_amdgcn_fence(__ATOMIC_ACQUIRE, "agent"); asm volatile("s_waitcnt vmcnt(0)" ::: "memory"); }
    __syncthreads();
}
__device__ __forceinline__ void rstd_prepass(Frame& F, const pg8::GroupOrder& S, LAS float* tab) {
    const GAS float* SSQ = (const GAS float*)FWS(WS_SSQ) + (size_t)F.b * SEQ * 16;
    pg8::Unit u;
    for (int i = 0; i < 4 && S.next(i, u); ++i) {
        const int r = F.tid >> 1, h = F.tid & 1;
        const GAS f32x4* p = (const GAS f32x4*)(SSQ + (size_t)(u.pm * 256 + r) * 16 + h * 8);
        const f32x4 a = p[0], b = p[1];
        float s = (a.x + a.y) + (a.z + a.w) + (b.x + b.y) + (b.z + b.w);
        s += shx(s, 1, F.lane);
        if (h == 0) tab[i * 256 + r] = 1.0f / sqrtf(s * (1.0f / D) + EPS);
    }
    LDS_WAIT(); __syncthreads();
}
__device__ __forceinline__ int t5_bucket(int d) {
    if (d < 16) return d;
    return 16 + (d >= 19) + (d >= 21) + (d >= 24) + (d >= 27) + (d >= 31) + (d >= 35) + (d >= 40) + (d >= 46) + (d >= 52) + (d >= 59) + (d >= 67) + (d >= 77) + (d >= 87) + (d >= 99) + (d >= 113);
}
__device__ __forceinline__ void ld8(const GAS bf16* p, float (&v)[8]) {
    const v4u w = *(const GAS v4u*)p;
    v[0] = bflo(w.x); v[1] = bfhi(w.x); v[2] = bflo(w.y); v[3] = bfhi(w.y); v[4] = bflo(w.z); v[5] = bfhi(w.z); v[6] = bflo(w.w); v[7] = bfhi(w.w);
}
typedef short bf16x8_t __attribute__((ext_vector_type(8)));
typedef float f32x16 __attribute__((ext_vector_type(16)));
constexpr float LOG2E = 1.4426950408889634f;
__device__ __forceinline__ unsigned pkbf(float lo, float hi) { return pg8::cvt_pk_bf16(lo, hi); }
__device__ __forceinline__ int crow32(int i, int hh) { return (i & 3) + 8 * (i >> 2) + 4 * hh; }
__device__ __forceinline__ float silu_fast(float v) { return v * __builtin_amdgcn_rcpf(1.0f + __builtin_amdgcn_exp2f(-v * LOG2E)); }
__device__ __forceinline__ void unpk8(const v4u w, float (&v)[8]) {
    v[0] = bflo(w.x); v[1] = bfhi(w.x); v[2] = bflo(w.y); v[3] = bfhi(w.y); v[4] = bflo(w.z); v[5] = bfhi(w.z); v[6] = bflo(w.w); v[7] = bfhi(w.w);
}

typedef short v4i16_t __attribute__((ext_vector_type(4)));
template <int RH, int RSEC> __device__ __forceinline__ bf16x8_t tr_frag(const LAS unsigned char* img, int stride, int rbase, int cbase, int lane) {
    const LAS unsigned char* p = img + (rbase + RH * (lane >> 5) + ((lane & 15) >> 2)) * stride + (cbase + 16 * ((lane >> 4) & 1) + 4 * (lane & 3)) * 2;
    const v4i16_t a = __builtin_amdgcn_ds_read_tr16_b64_v4i16((LAS v4i16_t*)p), b = __builtin_amdgcn_ds_read_tr16_b64_v4i16((LAS v4i16_t*)(p + RSEC * stride));
    return (bf16x8_t){a[0], a[1], a[2], a[3], b[0], b[1], b[2], b[3]};
}
constexpr int AT_KS = 0, AT_KSTRIDE = 144, AT_VT = 36864, AT_VSTRIDE = 192, AT_BIAS = AT_VT + 256 * AT_VSTRIDE;
constexpr int AT_BN = 192, AT_END = AT_BIAS + 4 * AT_BN * 4;
static_assert(AT_END <= MIX_BYTES, "attention LDS");
__device__ __forceinline__ void attn_fast(Frame& F, int L, bool dummy = false) {
    GAS bf16* PROJ = (GAS bf16*)FB(BO_PROJ);
    const GAS float* qg = FIN(I_QG) + L * 64; const GAS float* kg = FIN(I_KG) + L * 64; const GAS float* sinks = FIN(I_SINK) + L * 8; const GAS float* rel_bias = FIN(I_RELB);
    LAS unsigned char* Ks = F.lds + AT_KS; LAS unsigned char* Vt = F.lds + AT_VT; LAS float* biasR = (LAS float*)(F.lds + AT_BIAS);
    const int tid = F.tid, lane = F.lane, wave = F.wave, q = lane & 31, hh = lane >> 5;
    const int unit = F.li, kvh = unit >> 4, qb = unit & 15, m0 = qb * 128;
    const int gi = wave >> 1, qh = wave & 1, hq = kvh * 4 + gi;
    v4u qraw[2][4];
#pragma unroll
    for (int s = 0; s < 2; ++s)
#pragma unroll
        for (int d0 = 0; d0 < 4; ++d0) qraw[s][d0] = *(const GAS v4u*)(PROJ + (size_t)(m0 + 64 * qh + 32 * s + q) * PP + CQ + hq * 64 + d0 * 16 + hh * 8);
    v4u kwv[4], vwv[4];
#pragma unroll
    for (int i = 0; i < 4; ++i) { const int c = tid + NTHREADS * i, key = c >> 3, part = c & 7; const bool valid = (qb > 0) || (key >= 128); const unsigned msk = valid ? 0xffffffffu : 0u;
        const GAS bf16* kp = PROJ + (size_t)(valid ? m0 + key - 128 : 0) * PP + CK + kvh * 64 + part * 8;
        v4u a_ = *(const GAS v4u*)kp, b_ = *(const GAS v4u*)(kp + (CV - CK));
        a_.x &= msk; a_.y &= msk; a_.z &= msk; a_.w &= msk; b_.x &= msk; b_.y &= msk; b_.z &= msk; b_.w &= msk; kwv[i] = a_; vwv[i] = b_; }
    const f32x4 kg0 = *(const GAS f32x4*)(kg + (tid & 7) * 8), kg1 = *(const GAS f32x4*)(kg + (tid & 7) * 8 + 4);
    f32x4 qgv[4][2];
#pragma unroll
    for (int d0 = 0; d0 < 4; ++d0) { qgv[d0][0] = *(const GAS f32x4*)(qg + d0 * 16 + hh * 8); qgv[d0][1] = *(const GAS f32x4*)(qg + d0 * 16 + hh * 8 + 4); }
    const float sinkv = sinks[hq];
    float bent[2];
#pragma unroll
    for (int k = 0; k < 2; ++k) { const int x = tid + NTHREADS * k, g_ = x / AT_BN, xx = x - g_ * AT_BN; const bool ok = (x < 4 * AT_BN) && (xx >= 32) && (xx < 160);
        const float v = rel_bias[t5_bucket(ok ? 159 - xx : 0) * 8 + kvh * 4 + (ok ? g_ : 0)]; bent[k] = ok ? v * LOG2E : 0.f; }
    __syncthreads();
    biasR[tid] = bent[0]; if (tid + NTHREADS < 4 * AT_BN) biasR[tid + NTHREADS] = bent[1];
#pragma unroll
    for (int i = 0; i < 4; ++i) {
        const int c = tid + NTHREADS * i, key = c >> 3, part = c & 7;
        const v4u kw = kwv[i], vw = vwv[i];
        float kv[8]; unpk8(kw, kv);
        float ss = 0.f;
#pragma unroll
        for (int e = 0; e < 8; ++e) ss += kv[e] * kv[e];
        ss += shx(ss, 1, lane); ss += shx(ss, 2, lane); ss += shx(ss, 4, lane);
        const float rk = __builtin_amdgcn_rsqf(ss * (1.0f / 64.0f) + EPS);
        const f32x4 g0 = kg0, g1 = kg1;
        v4u ko; ko.x = pkbf(kv[0] * rk * g0.x, kv[1] * rk * g0.y); ko.y = pkbf(kv[2] * rk * g0.z, kv[3] * rk * g0.w); ko.z = pkbf(kv[4] * rk * g1.x, kv[5] * rk * g1.y); ko.w = pkbf(kv[6] * rk * g1.z, kv[7] * rk * g1.w);
        *(LAS v4u*)(Ks + key * AT_KSTRIDE + part * 16) = ko;
        *(LAS v4u*)(Vt + key * AT_VSTRIDE + part * 16) = vw;
    }
    LDS_WAIT(); __syncthreads();
    const float sink2 = sinkv * LOG2E;
    const LAS float* bb = biasR + gi * AT_BN + 31 - q + 4 * hh;
    const int qm = q - 4 * hh;
#pragma unroll
    for (int s = 0; s < 2; ++s) {
        const int a = 64 * qh + 32 * s;
        GAS bf16* qrow = PROJ + (size_t)(m0 + a + q) * PP + CQ + hq * 64;
        float qv[4][8]; float ss = 0.f;
#pragma unroll
        for (int d0 = 0; d0 < 4; ++d0) { unpk8(qraw[s][d0], qv[d0]);
#pragma unroll
            for (int e = 0; e < 8; ++e) ss += qv[d0][e] * qv[d0][e]; }
        ss += shx(ss, 32, lane);
        const float rq = __builtin_amdgcn_rsqf(ss * (1.0f / 64.0f) + EPS) * (0.125f * LOG2E);
        bf16x8_t qf[4];
#pragma unroll
        for (int d0 = 0; d0 < 4; ++d0) { const f32x4 g0 = qgv[d0][0], g1 = qgv[d0][1];
            v4u w; w.x = pkbf(qv[d0][0] * rq * g0.x, qv[d0][1] * rq * g0.y); w.y = pkbf(qv[d0][2] * rq * g0.z, qv[d0][3] * rq * g0.w);
            w.z = pkbf(qv[d0][4] * rq * g1.x, qv[d0][5] * rq * g1.y); w.w = pkbf(qv[d0][6] * rq * g1.z, qv[d0][7] * rq * g1.w);
            qf[d0] = __builtin_bit_cast(bf16x8_t, w); }
        const int kt_lo = (qb == 0) ? 4 - (a >> 5) : 0;
        f32x16 S[5]; float mx = sink2;
#pragma unroll
        for (int kt = 0; kt < 5; ++kt) { f32x16 acc = {};
#pragma unroll
            for (int d0 = 0; d0 < 4; ++d0) { const bf16x8_t kf = *(const LAS bf16x8_t*)(Ks + (a + 32 * kt + q) * AT_KSTRIDE + d0 * 32 + hh * 16);
                acc = __builtin_amdgcn_mfma_f32_32x32x16_bf16(kf, qf[d0], acc, 0, 0, 0); }
            if (kt < kt_lo) {
#pragma unroll
                for (int i = 0; i < 16; ++i) acc[i] = -INFINITY;
            } else {
#pragma unroll
                for (int i = 0; i < 16; ++i) { const int t0 = (i & 3) + 8 * (i >> 2); float v = acc[i] + bb[32 * kt + t0];
                    if (kt == 0) v = fminf(v, (t0 > qm) ? INFINITY : -INFINITY);
                    if (kt == 4) v = fminf(v, (t0 <= qm) ? INFINITY : -INFINITY);
                    acc[i] = v; mx = fmaxf(mx, v); } }
            S[kt] = acc; }
        mx = fmaxf(mx, shx(mx, 32, lane));
        float lsum = 0.f; bf16x8_t pf[5][2];
#pragma unroll
        for (int kt = 0; kt < 5; ++kt) {
#pragma unroll
            for (int i = 0; i < 16; ++i) { const float p = __builtin_amdgcn_exp2f(S[kt][i] - mx); S[kt][i] = p; lsum += p; }
#pragma unroll
            for (int s2 = 0; s2 < 2; ++s2) { v4u w; w.x = pkbf(S[kt][8 * s2 + 0], S[kt][8 * s2 + 1]); w.y = pkbf(S[kt][8 * s2 + 2], S[kt][8 * s2 + 3]);
                w.z = pkbf(S[kt][8 * s2 + 4], S[kt][8 * s2 + 5]); w.w = pkbf(S[kt][8 * s2 + 6], S[kt][8 * s2 + 7]); pf[kt][s2] = __builtin_bit_cast(bf16x8_t, w); } }
        lsum += shx(lsum, 32, lane);
        lsum += __builtin_amdgcn_exp2f(sink2 - mx);
        f32x16 O[2] = {{}, {}};
#pragma unroll
        for (int kt = 0; kt < 5; ++kt)
#pragma unroll
            for (int s2 = 0; s2 < 2; ++s2)
#pragma unroll
                for (int db = 0; db < 2; ++db)
                    O[db] = __builtin_amdgcn_mfma_f32_32x32x16_bf16(tr_frag<4, 8>(Vt, AT_VSTRIDE, a + 32 * kt + 16 * s2, 32 * db, lane), pf[kt][s2], O[db], 0, 0, 0);
        const float inv = __builtin_amdgcn_rcpf(lsum);
#pragma unroll
        for (int db = 0; db < 2; ++db)
#pragma unroll
            for (int g4 = 0; g4 < 4; ++g4) { v2u w; w.x = pkbf(O[db][4 * g4] * inv, O[db][4 * g4 + 1] * inv); w.y = pkbf(O[db][4 * g4 + 2] * inv, O[db][4 * g4 + 3] * inv);
                GAS bf16* orow = dummy ? (GAS bf16*)FB(BO_PREV) + (size_t)(m0 + a + q) * 512 + hq * 64 : qrow;
                *(GAS v2u*)(orow + 32 * db + 8 * g4 + 4 * hh) = w; }
    }
}

constexpr size_t WS_DTV = 3 * MiB + 512 * 1024;
constexpr int SD_ROW = 272, SD_XT = 264;
template <int NR> struct Raw8 { v4u u[NR + 3]; };
template <int NR> struct Raw4 { v2u u[NR + 3]; };
struct ConvW8 { f32x4 w[4][2], b[2]; };
struct ConvW4 { f32x4 w[4], b; };
template <int NR> __device__ __forceinline__ void conv_load(Raw8<NR>& R, const GAS bf16* PROJ, int m0, int c, int l0, int col0) {
#pragma unroll
    for (int i = 0; i < NR + 3; ++i) { const int row = l0 - 3 + i; const bool ok = (c > 0) || (row >= 0); const unsigned msk = ok ? 0xffffffffu : 0u;
        v4u x = *(const GAS v4u*)(PROJ + (size_t)(m0 + (ok ? row : 0)) * PP + col0); x.x &= msk; x.y &= msk; x.z &= msk; x.w &= msk; R.u[i] = x; }
}
template <int NR> __device__ __forceinline__ void conv_load(Raw4<NR>& R, const GAS bf16* PROJ, int m0, int c, int l0, int col0) {
#pragma unroll
    for (int i = 0; i < NR + 3; ++i) { const int row = l0 - 3 + i; const bool ok = (c > 0) || (row >= 0); const unsigned msk = ok ? 0xffffffffu : 0u;
        v2u x = *(const GAS v2u*)(PROJ + (size_t)(m0 + (ok ? row : 0)) * PP + col0); x.x &= msk; x.y &= msk; R.u[i] = x; }
}
__device__ __forceinline__ void convw_load(ConvW8& W, const GAS float* cw, const GAS float* cb) {
#pragma unroll
    for (int k = 0; k < 4; ++k) { W.w[k][0] = *(const GAS f32x4*)(cw + k * 1024); W.w[k][1] = *(const GAS f32x4*)(cw + k * 1024 + 4); }
    W.b[0] = *(const GAS f32x4*)cb; W.b[1] = *(const GAS f32x4*)(cb + 4);
}
__device__ __forceinline__ void convw_load(ConvW4& W, const GAS float* cw, const GAS float* cb) {
#pragma unroll
    for (int k = 0; k < 4; ++k) W.w[k] = *(const GAS f32x4*)(cw + k * 1024);
    W.b = *(const GAS f32x4*)cb;
}
template <int NR> __device__ __forceinline__ void conv_row(const Raw8<NR>& R, const ConvW8& W, int r, float (&out)[8]) {
    float acc[8];
#pragma unroll
    for (int e = 0; e < 8; ++e) acc[e] = W.b[e >> 2][e & 3];
#pragma unroll
    for (int k = 0; k < 4; ++k) { float u[8]; unpk8(R.u[r + k], u);
#pragma unroll
        for (int e = 0; e < 8; ++e) acc[e] += W.w[k][e >> 2][e & 3] * u[e]; }
#pragma unroll
    for (int e = 0; e < 8; ++e) out[e] = silu_fast(acc[e]);
}
template <int NR> __device__ __forceinline__ void conv_row(const Raw4<NR>& R, const ConvW4& W, int r, float (&out)[4]) {
    float acc[4];
#pragma unroll
    for (int e = 0; e < 4; ++e) acc[e] = W.b[e];
#pragma unroll
    for (int k = 0; k < 4; ++k) { const v2u x = R.u[r + k]; const float u[4] = {bflo(x.x), bfhi(x.x), bflo(x.y), bfhi(x.y)};
#pragma unroll
        for (int e = 0; e < 4; ++e) acc[e] += W.w[k][e] * u[e]; }
#pragma unroll
    for (int e = 0; e < 4; ++e) out[e] = silu_fast(acc[e]);
}
constexpr int P_XSTR = 576, P_BSTR = 304, P_XD = 0, P_BM = P_XD + 128 * P_XSTR, P_CM = P_BM + 128 * P_BSTR, P_FREE = P_CM + 128 * SD_ROW, P_DT = MIX_BYTES - 4096, P_ACS = P_DT + 2048;
static_assert(P_FREE + 4096 <= P_DT, "SSD LDS map");
__device__ __forceinline__ bf16x8_t scale_frag(bf16x8_t f, const f32x4 s0, const f32x4 s1) {
    const v4u w = __builtin_bit_cast(v4u, f); v4u o;
    o.x = pkbf(bflo(w.x) * s0.x, bfhi(w.x) * s0.y); o.y = pkbf(bflo(w.y) * s0.z, bfhi(w.y) * s0.w); o.z = pkbf(bflo(w.z) * s1.x, bfhi(w.z) * s1.y); o.w = pkbf(bflo(w.w) * s1.z, bfhi(w.w) * s1.w);
    return __builtin_bit_cast(bf16x8_t, o);
}
constexpr int S1_W = P_FREE, S1_WT = S1_W + 2048;
__device__ __forceinline__ void ssd_states(Frame& F, int L) {
    const GAS bf16* PROJ = (const GAS bf16*)FB(BO_PROJ);
    const GAS float* conv_w = FIN(I_CONVW) + (size_t)L * 4 * 1024; const GAS float* conv_b = FIN(I_CONVB) + L * 1024;
    const GAS float* dt_bias = FIN(I_DTB) + L * 8; const GAS float* a_log = FIN(I_ALOG) + L * 8;
    const GAS float* DTRAW = (const GAS float*)FWS(WS_DTRAW) + (size_t)F.b * SEQ * 8; GAS float* CHDEC = (GAS float*)FWS(WS_CHDEC) + F.b * 128;
    GAS float* STATES = (GAS float*)FB(BO_STATES);
    LAS unsigned char* XD = F.lds + P_XD; LAS unsigned char* BM = F.lds + P_BM;
    LAS float* dt_l = (LAS float*)(F.lds + P_DT); LAS float* acs_l = (LAS float*)(F.lds + P_ACS); LAS float* w_l = (LAS float*)(F.lds + S1_W); LAS float* wt = (LAS float*)(F.lds + S1_WT);
    const int wave = F.wave, unit = F.li, c = unit >> 1, g = unit & 1, m0 = c * 128;
    int tid = F.tid; asm volatile("" : "+v"(tid));
    int lane = tid & 63, q = lane & 31, hh = lane >> 5;
    const int xcg = tid & 31, xl0 = (tid >> 5) * 8, xcol = CX + g * 256 + xcg * 8;
    const int bcg = tid & 31, bl0 = (tid >> 5) * 8, isC = bcg >> 4, bn0 = (bcg & 15) * 8, bcol = (isC ? CCM : CBM) + g * 128 + bn0;
    Raw8<8> xr; ConvW8 xw; Raw8<8> br; ConvW8 bw;
    conv_load(xr, PROJ, m0, c, xl0, xcol); convw_load(xw, conv_w + (xcol - CX), conv_b + (xcol - CX));
    conv_load(br, PROJ, m0, c, bl0, bcol); convw_load(bw, conv_w + (bcol - CX), conv_b + (bcol - CX));
    const int ar = tid >> 7, al = tid & 127, ahead = 4 * g + ar;
    const float dtraw = DTRAW[(size_t)(m0 + al) * 8 + ahead], dtb = dt_bias[ahead], alog = a_log[ahead];
    __syncthreads();
    float acs_v;
    { const float dtv = softplus_f(dtraw + dtb);
      float v = dtv * (-expf(alog));
#pragma unroll
      for (int o = 1; o < 64; o <<= 1) { const float t = shup(v, o, lane); if (lane >= o) v += t; }
      if (lane == 63) wt[wave] = v;
      LDS_WAIT(); __syncthreads();
      if (wave & 1) v += wt[wave - 1];
      dt_l[tid] = dtv; acs_l[tid] = v * LOG2E; acs_v = v * LOG2E;
      if (al == 127) CHDEC[c * 8 + ahead] = expf(v); }
#pragma unroll
    for (int r = 0; r < 8; ++r) { float o[8]; conv_row(br, bw, r, o);
        v4u pk; pk.x = pkbf(o[0], o[1]); pk.y = pkbf(o[2], o[3]); pk.z = pkbf(o[4], o[5]); pk.w = pkbf(o[6], o[7]);
        *(LAS v4u*)(isC ? F.lds + P_CM + (bl0 + r) * SD_ROW + bn0 * 2 : BM + (bl0 + r) * P_BSTR + bn0 * 2) = pk; }
    LDS_WAIT(); __syncthreads();
    w_l[tid] = __builtin_amdgcn_exp2f(acs_l[ar * 128 + 127] - acs_v);
    { const int r4 = xcg >> 3;
#pragma unroll
      for (int r = 0; r < 8; ++r) { float o[8]; conv_row(xr, xw, r, o); const int l = xl0 + r; const float sc = dt_l[r4 * 128 + l];
          v4u pk; pk.x = pkbf(o[0] * sc, o[1] * sc); pk.y = pkbf(o[2] * sc, o[3] * sc); pk.z = pkbf(o[4] * sc, o[5] * sc); pk.w = pkbf(o[6] * sc, o[7] * sc);
          *(LAS v4u*)(XD + l * P_XSTR + xcg * 16) = pk; } }
    LDS_WAIT(); __syncthreads();
    asm volatile("" : "+v"(tid)); lane = tid & 63; q = lane & 31; hh = lane >> 5;
    { const int r4 = wave >> 1, nt0 = (wave & 1) * 2, head = 4 * g + r4;
      f32x16 St[2][2] = {{{}, {}}, {{}, {}}};
#pragma unroll
      for (int ks = 0; ks < 8; ++ks) { bf16x8_t af[2], bfr[2];
          const f32x4 w0 = *(const LAS f32x4*)(w_l + r4 * 128 + 16 * ks + 8 * hh), w1 = *(const LAS f32x4*)(w_l + r4 * 128 + 16 * ks + 8 * hh + 4);
#pragma unroll
          for (int pt = 0; pt < 2; ++pt) af[pt] = tr_frag<8, 4>(XD, P_XSTR, 16 * ks, r4 * 64 + 32 * pt, lane);
#pragma unroll
          for (int nn = 0; nn < 2; ++nn) bfr[nn] = scale_frag(tr_frag<8, 4>(BM, P_BSTR, 16 * ks, 32 * (nt0 + nn), lane), w0, w1);
#pragma unroll
          for (int pt = 0; pt < 2; ++pt)
#pragma unroll
              for (int nn = 0; nn < 2; ++nn) St[pt][nn] = __builtin_amdgcn_mfma_f32_32x32x16_bf16(af[pt], bfr[nn], St[pt][nn], 0, 0, 0); }
      GAS float* sp = STATES + ((size_t)c * 8 + head) * 8192 + 32 * nt0 + q;
#pragma unroll
      for (int pt = 0; pt < 2; ++pt)
#pragma unroll
          for (int nn = 0; nn < 2; ++nn)
#pragma unroll
              for (int e = 0; e < 16; ++e) sp[(32 * pt + crow32(e, hh)) * 128 + 32 * nn] = St[pt][nn][e]; }
}
__device__ __forceinline__ void ssd_scan(Frame& F, int L) {
    const GAS float* STATES = (const GAS float*)FB(BO_STATES); const GAS float* CHDEC = (const GAS float*)FWS(WS_CHDEC) + F.b * 128; GAS bf16* PREV = (GAS bf16*)FB(BO_PREV);
    for (int idx = F.li * NTHREADS + F.tid; idx < 8 * 64 * 32; idx += GRP * NTHREADS) {
        const int n4 = idx & 31, p = (idx >> 5) & 63, head = idx >> 11;
        f32x4 s[16]; float dec[16];
#pragma unroll
        for (int c = 0; c < 16; ++c) { const size_t o = ((size_t)c * 8 + head) * 8192 + p * 128 + 4 * n4; s[c] = *(const GAS f32x4*)(STATES + o); dec[c] = CHDEC[c * 8 + head]; }
        f32x4 h = {0.f, 0.f, 0.f, 0.f};
#pragma unroll
        for (int c = 0; c < 16; ++c) { const size_t o = ((size_t)c * 8 + head) * 8192 + p * 128 + 4 * n4;
            v2u w; w.x = pkbf(h.x, h.y); w.y = pkbf(h.z, h.w); *(GAS v2u*)(PREV + o) = w;
            h = h * dec[c] + s[c]; }
    }
}
constexpr int S3_PV = P_BM, S3_PVH = 64 * SD_ROW, S3_Z = S3_PV + 2 * S3_PVH, S3_NG = P_FREE, S3_RSS = S3_NG + 1024;
static_assert(S3_Z + 128 * SD_ROW <= P_FREE && S3_RSS + 2048 <= P_DT && 128 * 528 <= P_DT, "SSD part 3 LDS");
__device__ __forceinline__ void ssd_out(Frame& F, int L, bool dummy = false) {
    GAS bf16* PROJ = (GAS bf16*)FB(BO_PROJ); const GAS bf16* PREV = (const GAS bf16*)FB(BO_PREV);
    const GAS float* d_skip = FIN(I_DSKIP) + L * 8; const GAS float* ssm_g = FIN(I_SSMG) + L * 512;
    LAS unsigned char* Cm = F.lds + P_CM; LAS unsigned char* Bm = F.lds + P_BM; LAS unsigned char* Zt = F.lds + S3_Z; const LAS unsigned char* XD = F.lds + P_XD;
    LAS float* dt_l = (LAS float*)(F.lds + P_DT); LAS float* acs_l = (LAS float*)(F.lds + P_ACS); LAS float* rss = (LAS float*)(F.lds + S3_RSS); LAS float* ng_l = (LAS float*)(F.lds + S3_NG);
    const int wave = F.wave, unit = F.li, c = unit >> 1, g = unit & 1, m0 = c * 128;
    int tid = F.tid; asm volatile("" : "+v"(tid));
    int lane = tid & 63, q = lane & 31, hh = lane >> 5;
    const float ng_in = ssm_g[g * 256 + (tid & 255)];
    v4u pw[4], zw[4];
#define S3_D1_LOAD_PZ(hp_) do { \
        _Pragma("unroll") for (int k = 0; k < 4; ++k) { const int ch = tid + NTHREADS * k; \
            { const int hd = ch >> 10, rem = ch & 1023, p = rem >> 4, n8 = rem & 15; pw[k] = *(const GAS v4u*)(PREV + ((size_t)c * 8 + 4 * g + 2 * (hp_) + hd) * 8192 + p * 128 + n8 * 8); } \
            { const int l = ch >> 4, c8 = ch & 15; zw[k] = *(const GAS v4u*)(PROJ + (size_t)(m0 + l) * PP + CZ + (4 * g + 2 * (hp_)) * 64 + c8 * 8); } } } while (0)
    S3_D1_LOAD_PZ(0);
    if (tid < 256) ng_l[tid] = ng_in;
    const int j = (wave < 4) ? (wave & 3) : 3 - (wave & 3), h2 = wave >> 2;
    f32x16 cbT[4]; bf16x8_t cf[8];
#pragma unroll
    for (int ks = 0; ks < 8; ++ks) cf[ks] = *(const LAS bf16x8_t*)(Cm + (32 * j + q) * SD_ROW + (16 * ks + 8 * hh) * 2);
#pragma unroll
    for (int i = 0; i < 4; ++i) { f32x16 acc = {};
        if (i <= j) {
#pragma unroll
            for (int ks = 0; ks < 8; ++ks) { const bf16x8_t bfr = *(const LAS bf16x8_t*)(Bm + (32 * i + q) * P_BSTR + (16 * ks + 8 * hh) * 2);
                acc = __builtin_amdgcn_mfma_f32_32x32x16_bf16(bfr, cf[ks], acc, 0, 0, 0); } }
        cbT[i] = acc; }
    unsigned vk[2][16];
#pragma unroll
    for (int hp = 0; hp < 2; ++hp) {
        __syncthreads();
        {
#pragma unroll
          for (int k = 0; k < 4; ++k) { const int ch = tid + NTHREADS * k;
              { const int hd = ch >> 10, rem = ch & 1023, p = rem >> 4, n8 = rem & 15; *(LAS v4u*)(F.lds + S3_PV + hd * S3_PVH + p * SD_ROW + n8 * 16) = pw[k]; }
              { const int l = ch >> 4, c8 = ch & 15; *(LAS v4u*)(Zt + l * SD_ROW + c8 * 16) = zw[k]; } } }
        LDS_WAIT(); __syncthreads();
        asm volatile("" : "+v"(tid)); lane = tid & 63; q = lane & 31; hh = lane >> 5;
        const int r = 2 * hp + h2, head = 4 * g + r;
        const LAS unsigned char* P1 = F.lds + S3_PV + h2 * S3_PVH;
        f32x16 O[2] = {{}, {}};
#pragma unroll
        for (int ks = 0; ks < 8; ++ks)
#pragma unroll
            for (int pt = 0; pt < 2; ++pt) { const bf16x8_t af = *(const LAS bf16x8_t*)(P1 + (32 * pt + q) * SD_ROW + (16 * ks + 8 * hh) * 2);
                O[pt] = __builtin_amdgcn_mfma_f32_32x32x16_bf16(af, cf[ks], O[pt], 0, 0, 0); }
        const float acl = acs_l[r * 128 + 32 * j + q], diag = d_skip[head] * __builtin_amdgcn_rcpf(dt_l[r * 128 + 32 * j + q]);
        { const float ea = __builtin_amdgcn_exp2f(acl);
#pragma unroll
          for (int pt = 0; pt < 2; ++pt)
#pragma unroll
              for (int e = 0; e < 16; ++e) O[pt][e] *= ea; }
        const int qm = q - 4 * hh;
#pragma unroll
        for (int i = 0; i < 4; ++i) { if (i <= j) {
            float xv[16];
            const LAS float* ap = acs_l + r * 128 + 32 * i + 4 * hh;
            float av[16];
#pragma unroll
            for (int e = 0; e < 16; ++e) av[e] = ap[(e & 3) + 8 * (e >> 2)];
            if (i < j) {
#pragma unroll
                for (int e = 0; e < 16; ++e) xv[e] = cbT[i][e] * __builtin_amdgcn_exp2f(acl - av[e]);
            } else {
#pragma unroll
                for (int e = 0; e < 16; ++e) { const int t0 = (e & 3) + 8 * (e >> 2);
                    const float m01 = (t0 <= qm) ? 1.0f : 0.0f, dg = (t0 == qm) ? diag : 0.0f;
                    xv[e] = cbT[i][e] * __builtin_amdgcn_exp2f(fminf(acl - av[e], 0.f)) * m01 + dg; } }
#pragma unroll
            for (int s2 = 0; s2 < 2; ++s2) { v4u w; w.x = pkbf(xv[8 * s2 + 0], xv[8 * s2 + 1]); w.y = pkbf(xv[8 * s2 + 2], xv[8 * s2 + 3]); w.z = pkbf(xv[8 * s2 + 4], xv[8 * s2 + 5]); w.w = pkbf(xv[8 * s2 + 6], xv[8 * s2 + 7]);
                const bf16x8_t xf = __builtin_bit_cast(bf16x8_t, w);
#pragma unroll
                for (int pt = 0; pt < 2; ++pt)
                    O[pt] = __builtin_amdgcn_mfma_f32_32x32x16_bf16(tr_frag<4, 8>(XD, P_XSTR, 32 * i + 16 * s2, 64 * r + 32 * pt, lane), xf, O[pt], 0, 0, 0); } } }
        if (hp == 0) S3_D1_LOAD_PZ(1);
        float ss = 0.f;
#pragma unroll
        for (int pt = 0; pt < 2; ++pt)
#pragma unroll
            for (int g4 = 0; g4 < 4; ++g4) { const int p = 32 * pt + 8 * g4 + 4 * hh;
                const v2u zz = *(const LAS v2u*)(Zt + (32 * j + q) * SD_ROW + (64 * h2 + p) * 2);
                const float u0 = O[pt][4 * g4] * silu_fast(bflo(zz.x)), u1 = O[pt][4 * g4 + 1] * silu_fast(bfhi(zz.x)), u2 = O[pt][4 * g4 + 2] * silu_fast(bflo(zz.y)), u3 = O[pt][4 * g4 + 3] * silu_fast(bfhi(zz.y));
                ss += (u0 * u0 + u1 * u1) + (u2 * u2 + u3 * u3);
                vk[hp][pt * 8 + g4 * 2] = pkbf(u0, u1); vk[hp][pt * 8 + g4 * 2 + 1] = pkbf(u2, u3); }
        ss += shx(ss, 32, lane);
        if (hh == 0) rss[r * 128 + 32 * j + q] = ss;
    }
#undef S3_D1_LOAD_PZ
    LDS_WAIT(); __syncthreads();
    asm volatile("" : "+v"(tid)); lane = tid & 63; q = lane & 31; hh = lane >> 5;
    { const int l = 32 * j + q; const float tot = (rss[l] + rss[128 + l]) + (rss[256 + l] + rss[384 + l]);
      const float rn = __builtin_amdgcn_rsqf(tot * (1.0f / 256.0f) + EPS);
      LAS unsigned char* Ot = F.lds;
#pragma unroll
      for (int hp = 0; hp < 2; ++hp) { const int r = 2 * hp + h2;
#pragma unroll
          for (int pt = 0; pt < 2; ++pt)
#pragma unroll
              for (int g4 = 0; g4 < 4; ++g4) { const int p = 32 * pt + 8 * g4 + 4 * hh;
                  const f32x4 ng = *(const LAS f32x4*)(ng_l + r * 64 + p);
                  const unsigned w0 = vk[hp][pt * 8 + g4 * 2], w1 = vk[hp][pt * 8 + g4 * 2 + 1];
                  v2u w; w.x = pkbf(bflo(w0) * rn * ng.x, bfhi(w0) * rn * ng.y); w.y = pkbf(bflo(w1) * rn * ng.z, bfhi(w1) * rn * ng.w);
                  *(LAS v2u*)(Ot + l * 528 + (r * 64 + p) * 2) = w; } } }
    LDS_WAIT(); __syncthreads();
    asm volatile("" : "+v"(tid));
#pragma unroll
    for (int k = 0; k < 8; ++k) { const int ch = tid + NTHREADS * k, l = ch >> 5, c8 = ch & 31;
        const v4u w = *(const LAS v4u*)(F.lds + l * 528 + c8 * 16);
        GAS bf16* orow = dummy ? (GAS bf16*)FB(BO_STATES) + (size_t)(m0 + l) * 512 : PROJ + (size_t)(m0 + l) * PP + CZ;
        *(GAS v4u*)(orow + g * 256 + c8 * 8) = w; }
}

__device__ __forceinline__ void ph_inproj(Frame& F, int L) {
    LAS float* rstd_tab = (LAS float*)(F.lds + RSTD_OFF);
    int li_ = F.li; asm volatile("" : "+s"(li_)); pg8::GroupOrder S; S.init(NPROJ, li_);
    const GAS f32x4* sp = (const GAS f32x4*)((const GAS float*)FWS(WS_SSQ) + ((size_t)F.b * SEQ + (li_ & 7) * 256 + (F.tid >> 1)) * 16 + (F.tid & 1) * 8);
    pg8::Gemm g{(const GAS bf16*)FWS(WS_XB) + (size_t)F.b * SEQ * D, (const GAS bf16*)FWS(WS_WIN) + (size_t)L * NPROJ * D, SEQ, NPROJ, D, D};
    pg8::EpiProj E{(GAS bf16*)FB(BO_PROJ), (GAS float*)FWS(WS_DTRAW) + (size_t)F.b * SEQ * 8, rstd_tab, sp[0], sp[1]};
    pg8::gemm_phase<pg8::EpiProj, pg8::GroupOrder, true, true>(F.lds + RING_OFF, g, S, E);
}
__device__ __forceinline__ void ph_outproj(Frame& F, int L, bool dummy = false) {
    int li_ = F.li; asm volatile("" : "+s"(li_)); pg8::GroupOrder S; S.init(D, li_);
    pg8::Gemm g{(const GAS bf16*)FB(BO_PROJ), (const GAS bf16*)FWS(WS_WOUT) + (size_t)L * D * D, SEQ, D, D, PP};
    GAS bf16* XBb = (GAS bf16*)FWS(WS_XB) + (size_t)F.b * SEQ * D;
    pg8::EpiRes<false> E{XBb, (GAS float*)FWS(WS_SSQ) + (size_t)F.b * SEQ * 16, nullptr, dummy ? (GAS bf16*)FB(BO_YPART) : XBb};
    pg8::gemm_phase<pg8::EpiRes<false>, pg8::GroupOrder, false, true>(F.lds + RING_OFF, g, S, E);
}
__device__ __forceinline__ void ph_up(Frame& F, int L) {
    LAS float* rstd_tab = (LAS float*)(F.lds + RSTD_OFF);
    int li_ = F.li; asm volatile("" : "+s"(li_)); pg8::GroupOrder S; S.init(FF, li_);
    const GAS f32x4* sp = (const GAS f32x4*)((const GAS float*)FWS(WS_SSQ) + ((size_t)F.b * SEQ + (li_ & 7) * 256 + (F.tid >> 1)) * 16 + (F.tid & 1) * 8);
    pg8::Gemm g{(const GAS bf16*)FWS(WS_XB) + (size_t)F.b * SEQ * D, (const GAS bf16*)FWS(WS_WUP) + (size_t)L * FF * D, SEQ, FF, D, D};
    pg8::EpiUp E{(GAS bf16*)FB(BO_HID), FF, rstd_tab, sp[0], sp[1]};
    pg8::gemm_phase<pg8::EpiUp, pg8::GroupOrder, true, true>(F.lds + RING_OFF, g, S, E);
}
__device__ __forceinline__ void ph_down(Frame& F, int L, bool dummy = false) {
    int li_ = F.li; asm volatile("" : "+s"(li_)); pg8::GroupOrder S; S.init(D, li_);
    pg8::Gemm g{(const GAS bf16*)FB(BO_HID), (const GAS bf16*)FWS(WS_WDOWN) + (size_t)L * D * FF, SEQ, D, FF, FF};
    GAS bf16* XBb = (GAS bf16*)FWS(WS_XB) + (size_t)F.b * SEQ * D; GAS float* SSQb = (GAS float*)FWS(WS_SSQ) + (size_t)F.b * SEQ * 16;
    if (L == DEPTH - 1 && !dummy) { pg8::EpiRes<true> E{XBb, SSQb, (GAS float*)ptr_at(F, I_OUT) + (size_t)F.b * SEQ * D, XBb};
        pg8::gemm_phase<pg8::EpiRes<true>, pg8::GroupOrder, false, true>(F.lds + RING_OFF, g, S, E); }
    else { pg8::EpiRes<false> E{XBb, SSQb, nullptr, dummy ? (GAS bf16*)FB(16 * MiB) : XBb};
        pg8::gemm_phase<pg8::EpiRes<false>, pg8::GroupOrder, false, true>(F.lds + RING_OFF, g, S, E); }
}

#ifndef PROBE_REP
#define PROBE_REP 0
#endif
struct Args { const float* in[17]; float* out; unsigned char* ws; int pad0, pad1; };
__global__ void __launch_bounds__(NTHREADS, 2) fwd(Args args) {
    extern __shared__ __attribute__((aligned(16))) unsigned char lds[];
    Frame F;
    F.lds = (LAS unsigned char*)lds;
    F.tid = threadIdx.x; F.lane = F.tid & 63; F.wave = __builtin_amdgcn_readfirstlane(F.tid >> 6); F.bid = blockIdx.x; F.G = gridDim.x; F.b = F.bid & 7; F.li = F.bid >> 3;
    for (int u = F.tid; u < (LDS_BYTES - LDSCTL_OFF) / 4; u += NTHREADS) ((LAS unsigned*)(F.lds + LDSCTL_OFF))[u] = 0u;
    __syncthreads();
    if (F.tid < I_NPTR) { const unsigned long long p = F.tid < 17 ? (unsigned long long)args.in[F.tid < 17 ? F.tid : 0] : (F.tid == I_OUT ? (unsigned long long)args.out : (unsigned long long)args.ws);
        LAS unsigned* t = (LAS unsigned*)(F.lds + PTR_OFF) + 2 * F.tid; t[0] = (unsigned)p; t[1] = (unsigned)(p >> 32); }
    LDS_WAIT(); __syncthreads();
    if (F.G != GRID) return;
#define GBAR_OBJ() XcdBarrier{(unsigned*)(unsigned char*)FWS(WS_CTL) + CW_BAR, xb_xcc_id(), (unsigned)GRID, (volatile LAS unsigned*)(F.lds + MISC_OFF) + 8}
#define GRP_OBJ()  XcdBarrier{(unsigned*)(unsigned char*)FWS(WS_CTL) + CW_GRP + (blockIdx.x & 7) * GRP_BAR_STRIDE, xb_xcc_id(), (unsigned)GRP, (volatile LAS unsigned*)(F.lds + MISC_OFF) + 12}
    (void)xcd_barrier_post((unsigned*)(unsigned char*)FWS(WS_CTL) + CW_BAR, (volatile LAS unsigned*)(F.lds + MISC_OFF) + 8, GRID);
    (void)xcd_barrier_post((unsigned*)(unsigned char*)FWS(WS_CTL) + CW_GRP + (blockIdx.x & 7) * GRP_BAR_STRIDE, (volatile LAS unsigned*)(F.lds + MISC_OFF) + 12, GRP);
#define RELAUNDER() do { int t_ = threadIdx.x; asm volatile("" : "+v"(t_)); F.tid = t_; F.lane = t_ & 63; F.wave = __builtin_amdgcn_readfirstlane(t_ >> 6); \
    int b_ = blockIdx.x; asm volatile("" : "+s"(b_)); F.bid = b_; F.b = b_ & 7; F.li = b_ >> 3; } while (0)
#define GRP_BAR() do { const XcdBarrier gb_ = GRP_OBJ(); xcd_barrier(gb_); } while (0)
#define GRID_BAR() do { const XcdBarrier gb_ = GBAR_OBJ(); xcd_barrier(gb_); } while (0)

    p0_prologue(F);
    if (PROBE_REP == 1) { GRID_BAR(); RELAUNDER(); p0_prologue(F); }
    GRID_BAR();
    for (int L = 0; L < DEPTH; ++L) {
        RELAUNDER(); ph_inproj(F, L); if (PROBE_REP == 2) { GRP_BAR(); RELAUNDER(); ph_inproj(F, L); }
        if (F.li >= 16) { RELAUNDER(); convert_rest(F, L); }
        GRP_BAR();
        RELAUNDER(); if (PROBE_REP == 20) { attn_fast(F, L, true); GRP_BAR(); RELAUNDER(); }
        if (PROBE_REP == 25) {
#pragma unroll 1
            for (int rep = 0; rep < 2; ++rep) { attn_fast(F, L, rep == 0); if (rep == 0) { GRP_BAR(); RELAUNDER(); } } }
        else attn_fast(F, L);
        ssd_states(F, L); if (PROBE_REP == 21) { GRP_BAR(); RELAUNDER(); ssd_states(F, L); } GRP_BAR();
        RELAUNDER(); ssd_scan(F, L); if (PROBE_REP == 22) { GRP_BAR(); RELAUNDER(); ssd_scan(F, L); } if (PROBE_REP == 24) { for (int k = 0; k < 8; ++k) GRP_BAR(); } GRP_BAR();
        RELAUNDER(); if (PROBE_REP == 23) { ssd_out(F, L, true); GRP_BAR(); RELAUNDER(); } ssd_out(F, L); GRP_BAR();
        RELAUNDER(); wait_weights(F, L); if (PROBE_REP == 30) { ph_outproj(F, L, true); GRP_BAR(); RELAUNDER(); } ph_outproj(F, L); GRP_BAR();
        RELAUNDER(); ph_up(F, L); if (PROBE_REP == 5) { GRP_BAR(); RELAUNDER(); ph_up(F, L); } GRP_BAR();
        RELAUNDER(); if (PROBE_REP == 31) { ph_down(F, L, true); GRP_BAR(); RELAUNDER(); } ph_down(F, L); if (L + 1 < DEPTH) GRP_BAR();
    }
}

extern "C" void kernel_launch(void* const* d_in, const int* in_sizes, int n_in, void* d_out, int out_size, void* d_ws, size_t ws_size, hipStream_t stream) {
    static int grid = 0;
    if (grid == 0) {
        if (n_in != 17 || in_sizes[0] != M * D || out_size != M * D || ws_size < WS_END) { fprintf(stderr, "kernel_launch: unexpected shapes (n_in %d, in0 %d, out %d, ws %zu)\n", n_in, n_in > 0 ? in_sizes[0] : -1, out_size, ws_size); grid = -1; return; }
        int dev = 0, cus = 0, per_cu = 0;
        if (hipGetDevice(&dev) != hipSuccess || hipDeviceGetAttribute(&cus, hipDeviceAttributeMultiprocessorCount, dev) != hipSuccess) { grid = -1; return; }
        if (hipFuncSetAttribute((const void*)fwd, hipFuncAttributeMaxDynamicSharedMemorySize, LDS_BYTES) != hipSuccess) { fprintf(stderr, "kernel_launch: hipFuncSetAttribute failed\n"); grid = -1; return; }
        if (hipOccupancyMaxActiveBlocksPerMultiprocessor(&per_cu, (const void*)fwd, NTHREADS, LDS_BYTES) != hipSuccess || per_cu < 1) { fprintf(stderr, "kernel_launch: occupancy query says %d\n", per_cu); per_cu = 0; }
        (void)hipGetLastError();
        if (cus * per_cu < GRID) { fprintf(stderr, "kernel_launch: this kernel needs %d co-resident workgroups (one per CU of a 256-CU device); the device admits %d x %d; nothing launched\n", GRID, cus, per_cu); grid = -1; return; }
        grid = GRID;
    }
    if (grid < 0) return;
    (void)hipMemsetAsync((char*)d_ws + WS_CTL, 0, CTL_ZERO_BYTES, stream);
    Args a{};
    for (int i = 0; i < 17; ++i) a.in[i] = (const float*)d_in[i];
    a.out = (float*)d_out; a.ws = (unsigned char*)d_ws;
    void* kargs[] = {&a};
    hipError_t e = hipLaunchCooperativeKernel((const void*)fwd, dim3(grid), dim3(NTHREADS), kargs, LDS_BYTES, stream);
    if (e != hipSuccess) fprintf(stderr, "kernel_launch: cooperative launch failed: %s (grid %d)\n", hipGetErrorString(e), grid);
}
```

```cpp
#include <hip/hip_runtime.h>
#include <cstdio>
#include <cstdint>
#define PROBE_REP 0


namespace pg8 {
#define PG8_LAS __attribute__((address_space(3)))
#define PG8_GAS __attribute__((address_space(1)))
typedef unsigned short bf16_t;
typedef short bf16x8 __attribute__((ext_vector_type(8)));
typedef float f32x4 __attribute__((ext_vector_type(4)));
typedef unsigned u32x4 __attribute__((ext_vector_type(4)));
constexpr int BM = 256, BK = 64, HALF = 128, HTB = HALF * BK * 2  , STAGE_BYTES = 8 * HTB, NXCD = 8, WGM = 8;

__host__ __device__ __forceinline__ int lds_byte(int r, int c) { const int st = (r >> 4) * 2 + (c >> 5), rr = r & 15, cc = c & 31, ob = rr * 64 + cc * 2; return st * 1024 + (ob ^ (((ob >> 9) & 1) << 5)); }
__host__ __device__ __forceinline__ void stage_rc(int b, int& R, int& C) { const int st = b / 1024, sb = b % 1024, swz = sb ^ (((sb >> 9) & 1) << 5); R = (st >> 1) * 16 + swz / 64; C = (st & 1) * 32 + (swz % 64) / 2; }
__host__ __device__ __forceinline__ int perm32(int rho) { const int n = rho >> 4, i = rho & 15; return 8 * (i >> 2) + 4 * n + (i & 3); }

struct Unit { int pm, pn; };
struct Gemm { const PG8_GAS bf16_t* A; const PG8_GAS bf16_t* Bt; int M, N, K, lda; };

struct StaticOrder {
    int nM, nN, nwg, G, c;
    __host__ __device__ void init(int M, int N, int G_, int c_) { nM = M / BM; nN = N / BM; nwg = nM * nN; G = G_; c = c_; }
    __host__ __device__ bool next(int i, Unit& u) const {
        const long L = (long)i * G + c; if (L >= nwg) return false;
        int wgid = (int)L; { const int q = nwg / NXCD, r = nwg % NXCD, xcd = wgid % NXCD, off = wgid / NXCD; wgid = (xcd < r ? xcd * (q + 1) : r * (q + 1) + (xcd - r) * q) + off; }
        const int nig = WGM * nN, gid = wgid / nig, fm = gid * WGM, gsz = (nM - fm) < WGM ? (nM - fm) : WGM;
        u.pm = fm + ((wgid % nig) % gsz); u.pn = (wgid % nig) / gsz; return true;
    }
    __device__ __forceinline__ void a_ready(const Unit&) const {}
    __device__ __forceinline__ void done(const Unit&) const {}
};

struct GroupOrder {
    int nN, li;
    __host__ __device__ void init(int N, int li_) { nN = N / BM; li = li_; }
    __host__ __device__ bool next(int i, Unit& u) const { const int T = i * 32 + li; if (T >= 8 * nN) return false; u.pm = T & 7; u.pn = T >> 3; return true; }
    __device__ __forceinline__ void a_ready(const Unit&) const {}
    __device__ __forceinline__ void done(const Unit&) const {}
};

__device__ __forceinline__ float shx(float v, int k, int lane) { return __builtin_bit_cast(float, __builtin_amdgcn_ds_bpermute((lane ^ k) << 2, __builtin_bit_cast(int, v))); }
typedef float f32x2_t __attribute__((ext_vector_type(2))); typedef __bf16 bf16x2_t __attribute__((ext_vector_type(2)));
__device__ __forceinline__ unsigned cvt_pk_bf16(float lo, float hi) { f32x2_t v = {lo, hi}; bf16x2_t b = __builtin_convertvector(v, bf16x2_t); return __builtin_bit_cast(unsigned, b); }

constexpr int PROJ_PITCH = 2304, DT_TILE = 9;
struct EpiProj {
    static constexpr bool PERM = true, AFTER_DRAIN = false, ACC_INIT = false, PRE_HOOK = true;
    PG8_GAS bf16_t* O; PG8_GAS float* dtraw; PG8_LAS float* rstd; f32x4 pa, pb;
    __device__ __forceinline__ void pre(int tid) const {
        float s = (pa[0] + pa[1]) + (pa[2] + pa[3]) + (pb[0] + pb[1]) + (pb[2] + pb[3]);
        s += shx(s, 1, tid & 63);
        if ((tid & 1) == 0) rstd[tid >> 1] = 1.0f / sqrtf(s * (1.0f / 1024.0f) + 1e-6f);
    }
    __device__ __forceinline__ void operator()(const f32x4 (&acc)[2][2][4][2], const Unit& u, int ui, int wr, int wc, int fr, int fq) const {
        int rt0 = wr * 64 + fr; asm volatile("" : "+v"(rt0));
        if (u.pn == DT_TILE) {
            if (wc == 0 && fq == 0) {
#pragma unroll
                for (int ai = 0; ai < 2; ++ai)
#pragma unroll
                    for (int m = 0; m < 4; ++m) { const int rt = ai * HALF + rt0 + m * 16; const float rs = rstd[rt]; PG8_GAS float* p = dtraw + (size_t)(u.pm * BM + rt) * 8;
                        *(PG8_GAS f32x4*)p = acc[ai][0][m][0] * rs; *(PG8_GAS f32x4*)(p + 4) = acc[ai][0][m][1] * rs; }
            }
            return;
        }
        const int col0 = u.pn * BM + wc * 32 + 8 * fq;
#pragma unroll
        for (int ai = 0; ai < 2; ++ai)
#pragma unroll
            for (int m = 0; m < 4; ++m) { const int rt = ai * HALF + rt0 + m * 16; const float rs = rstd[rt]; PG8_GAS bf16_t* rowp = O + (size_t)(u.pm * BM + rt) * PROJ_PITCH + col0;
#pragma unroll
                for (int bj = 0; bj < 2; ++bj) { const f32x4 v0 = acc[ai][bj][m][0] * rs, v1 = acc[ai][bj][m][1] * rs;
                    u32x4 w; w.x = cvt_pk_bf16(v0[0], v0[1]); w.y = cvt_pk_bf16(v0[2], v0[3]); w.z = cvt_pk_bf16(v1[0], v1[1]); w.w = cvt_pk_bf16(v1[2], v1[3]);
                    *(PG8_GAS u32x4*)(rowp + bj * HALF) = w; } }
    }
};
struct EpiUp {
    static constexpr bool PERM = true, AFTER_DRAIN = false, ACC_INIT = false, PRE_HOOK = true;
    PG8_GAS bf16_t* O; int ldc; PG8_LAS float* rstd; f32x4 pa, pb;
    __device__ __forceinline__ void pre(int tid) const {
        float s = (pa[0] + pa[1]) + (pa[2] + pa[3]) + (pb[0] + pb[1]) + (pb[2] + pb[3]);
        s += shx(s, 1, tid & 63);
        if ((tid & 1) == 0) rstd[tid >> 1] = 1.0f / sqrtf(s * (1.0f / 1024.0f) + 1e-6f);
    }
    __device__ __forceinline__ void operator()(const f32x4 (&acc)[2][2][4][2], const Unit& u, int ui, int wr, int wc, int fr, int fq) const {
        int rt0 = wr * 64 + fr; asm volatile("" : "+v"(rt0)); const int col0 = u.pn * BM + wc * 32 + 8 * fq;
#pragma unroll
        for (int ai = 0; ai < 2; ++ai)
#pragma unroll
            for (int m = 0; m < 4; ++m) { const int rt = ai * HALF + rt0 + m * 16; const float rs = rstd[rt]; PG8_GAS bf16_t* rowp = O + (size_t)(u.pm * BM + rt) * ldc + col0;
#pragma unroll
                for (int bj = 0; bj < 2; ++bj) { f32x4 v0 = acc[ai][bj][m][0] * rs, v1 = acc[ai][bj][m][1] * rs;
#pragma unroll
                    for (int e = 0; e < 4; ++e) { const float a = fmaxf(v0[e], 0.f), b = fmaxf(v1[e], 0.f); v0[e] = a * a; v1[e] = b * b; }
                    u32x4 w; w.x = cvt_pk_bf16(v0[0], v0[1]); w.y = cvt_pk_bf16(v0[2], v0[3]); w.z = cvt_pk_bf16(v1[0], v1[1]); w.w = cvt_pk_bf16(v1[2], v1[3]);
                    *(PG8_GAS u32x4*)(rowp + bj * HALF) = w; } }
    }
};
template <bool FINAL> struct EpiRes {
    static constexpr bool PERM = true, AFTER_DRAIN = false, ACC_INIT = true, PRE_HOOK = false;
    PG8_GAS bf16_t* xb; PG8_GAS float* ssq; PG8_GAS float* out; PG8_GAS bf16_t* xdst;
    __device__ __forceinline__ void init(f32x4 (&acc)[2][2][4][2], const Unit& u, int wr, int wc, int fr, int fq) const {
        const int rt0 = wr * 64 + fr, col0 = u.pn * BM + wc * 32 + 8 * fq;
#pragma unroll
        for (int ai = 0; ai < 2; ++ai)
#pragma unroll
            for (int m = 0; m < 4; ++m) { const int row = u.pm * BM + ai * HALF + rt0 + m * 16; const size_t off = (size_t)row * 1024 + col0;
#pragma unroll
                for (int bj = 0; bj < 2; ++bj) { const u32x4 rw = *(const PG8_GAS u32x4*)(xb + off + bj * HALF);
                    acc[ai][bj][m][0] = (f32x4){__uint_as_float(rw.x << 16), __uint_as_float(rw.x & 0xffff0000u), __uint_as_float(rw.y << 16), __uint_as_float(rw.y & 0xffff0000u)};
                    acc[ai][bj][m][1] = (f32x4){__uint_as_float(rw.z << 16), __uint_as_float(rw.z & 0xffff0000u), __uint_as_float(rw.w << 16), __uint_as_float(rw.w & 0xffff0000u)}; } }
    }
    __device__ __forceinline__ void operator()(const f32x4 (&acc)[2][2][4][2], const Unit& u, int ui, int wr, int wc, int fr, int fq) const {
        int rt0 = wr * 64 + fr; asm volatile("" : "+v"(rt0)); const int col0 = u.pn * BM + wc * 32 + 8 * fq;
#pragma unroll
        for (int ai = 0; ai < 2; ++ai)
#pragma unroll
            for (int m = 0; m < 4; ++m) { const int row = u.pm * BM + ai * HALF + rt0 + m * 16; const size_t off = (size_t)row * 1024 + col0; float s = 0.f;
#pragma unroll
                for (int bj = 0; bj < 2; ++bj) { const f32x4 v0 = acc[ai][bj][m][0], v1 = acc[ai][bj][m][1];
                    if (FINAL) { *(PG8_GAS f32x4*)(out + off + bj * HALF) = v0; *(PG8_GAS f32x4*)(out + off + bj * HALF + 4) = v1; }
                    else { u32x4 w; w.x = cvt_pk_bf16(v0[0], v0[1]); w.y = cvt_pk_bf16(v0[2], v0[3]); w.z = cvt_pk_bf16(v1[0], v1[1]); w.w = cvt_pk_bf16(v1[2], v1[3]);
                        *(PG8_GAS u32x4*)(xdst + off + bj * HALF) = w;
                        s += (v0[0] * v0[0] + v0[1] * v0[1]) + (v0[2] * v0[2] + v0[3] * v0[3]) + (v1[0] * v1[0] + v1[1] * v1[1]) + (v1[2] * v1[2] + v1[3] * v1[3]); } }
                if (!FINAL) { const int ln = fq * 16 + fr; s += shx(s, 16, ln); s += shx(s, 32, ln);
                    if (fq == 0) ssq[(size_t)row * 16 + u.pn * 4 + wc] = s; } }
    }
};

template <class Epi, class Sched, bool ALIGN_EPI = false, bool SP2 = false>
__device__ __forceinline__ void gemm_phase(PG8_LAS unsigned char* lds, const Gemm g, const Sched& S, const Epi& E) {
    int tid_ = threadIdx.x; asm volatile("" : "+v"(tid_));
    const int tid = tid_, wid = __builtin_amdgcn_readfirstlane(tid >> 6), lane = tid & 63, wr = wid >> 2, wc = wid & 3, fr = lane & 15, fq = lane >> 4;
    const int K = g.K, nt = K / BK;
    unsigned voffA[2], voffB[2];
#pragma unroll
    for (int i = 0; i < 2; ++i) { int R, C; stage_rc(tid * 16 + i * 8192, R, C); const int Rb = Epi::PERM ? ((R & ~31) + perm32(R & 31)) : R;
        voffA[i] = (unsigned)(R * g.lda + C) * 2u; voffB[i] = (unsigned)(Rb * K + C) * 2u; }
    const size_t kstep = (size_t)(BK * 2);
    const size_t hstepA = (size_t)HALF * g.lda * 2, hstepB = (size_t)HALF * K * 2;
    const size_t tstepA = 2 * hstepA, tstepB = 2 * hstepB;
    const unsigned ldsw = (unsigned)wid * 1024u;
    const int aoff = lds_byte(wr * 64 + fr, fq * 8), boff = lds_byte(wc * 32 + fr, fq * 8);
#define PG8_SA(b, h) (((b) * 2 + (h)) * HTB)
#define PG8_SB(b, h) ((4 + (b) * 2 + (h)) * HTB)
#define PG8_STAGE(bufoff, gbase, voff) do { _Pragma("unroll") for (int _i = 0; _i < 2; ++_i) \
        __builtin_amdgcn_global_load_lds((const unsigned*)((const char*)(gbase) + (voff)[_i]), (PG8_LAS unsigned*)(lds + (bufoff) + ldsw + _i * 8192), 16, 0, 0); } while (0)
#define PG8_LDA(dst, b, h) do { _Pragma("unroll") for (int m = 0; m < 4; ++m) _Pragma("unroll") for (int k = 0; k < 2; ++k) dst[m][k] = *(const PG8_LAS bf16x8*)(lds + PG8_SA(b, h) + aoff + m * 2048 + k * 1024); } while (0)
#define PG8_LDB(dst, b, h) do { _Pragma("unroll") for (int n = 0; n < 2; ++n) _Pragma("unroll") for (int k = 0; k < 2; ++k) dst[n][k] = *(const PG8_LAS bf16x8*)(lds + PG8_SB(b, h) + boff + n * 2048 + k * 1024); } while (0)
#define PG8_MMA(ai, bj, At, Bt) do { __builtin_amdgcn_s_setprio(1); _Pragma("unroll") for (int m = 0; m < 4; ++m) _Pragma("unroll") for (int n = 0; n < 2; ++n) _Pragma("unroll") for (int k = 0; k < 2; ++k) \
        acc[ai][bj][m][n] = __builtin_amdgcn_mfma_f32_16x16x32_bf16(Bt[n][k], At[m][k], acc[ai][bj][m][n], 0, 0, 0); __builtin_amdgcn_s_setprio(0); } while (0)
#define PG8_WAIT_V(n) asm volatile("s_waitcnt vmcnt(" #n ")" ::: "memory")
#define PG8_WAIT_L(n) asm volatile("s_waitcnt lgkmcnt(" #n ")" ::: "memory")
#define PG8_BAR __builtin_amdgcn_s_barrier()
#define PG8_SCHED __builtin_amdgcn_sched_barrier(0)
    Unit cur, nxt; int ui = 0;
    if (!S.next(0, cur)) return;
    f32x4 acc[2][2][4][2];
#pragma unroll
    for (int a = 0; a < 2; ++a)
#pragma unroll
        for (int b = 0; b < 2; ++b)
#pragma unroll
            for (int m = 0; m < 4; ++m)
#pragma unroll
                for (int n = 0; n < 2; ++n) acc[a][b][m][n] = (f32x4){0.f, 0.f, 0.f, 0.f};
    if constexpr (Epi::ACC_INIT) E.init(acc, cur, wr, wc, fr, fq);
    bf16x8 At[4][2], B0[2][2], B1[2][2];
    const char* cA = (const char*)g.A + (size_t)cur.pm * tstepA; const char* cB = (const char*)g.Bt + (size_t)cur.pn * tstepB;
    S.a_ready(cur);
    if constexpr (SP2) {
        PG8_STAGE(PG8_SB(0, 0), cB, voffB); PG8_STAGE(PG8_SB(0, 1), cB + hstepB, voffB); PG8_STAGE(PG8_SA(0, 0), cA, voffA); PG8_STAGE(PG8_SA(0, 1), cA + hstepA, voffA);
        if constexpr (Epi::PRE_HOOK) E.pre(tid);
        if (wr == 1) PG8_BAR;
        PG8_WAIT_V(2); PG8_BAR;
        PG8_STAGE(PG8_SB(1, 0), cB + kstep, voffB); PG8_STAGE(PG8_SA(1, 0), cA + kstep, voffA); PG8_STAGE(PG8_SB(1, 1), cB + hstepB + kstep, voffB);
        PG8_WAIT_V(6); PG8_BAR;
    } else {
        PG8_STAGE(PG8_SB(0, 0), cB, voffB); PG8_STAGE(PG8_SA(0, 0), cA, voffA); PG8_STAGE(PG8_SB(0, 1), cB + hstepB, voffB); PG8_STAGE(PG8_SA(0, 1), cA + hstepA, voffA);
        if (wr == 1) PG8_BAR;
        PG8_WAIT_V(4); PG8_BAR;
        PG8_STAGE(PG8_SB(1, 0), cB + kstep, voffB); PG8_STAGE(PG8_SA(1, 0), cA + kstep, voffA); PG8_STAGE(PG8_SB(1, 1), cB + hstepB + kstep, voffB);
        PG8_WAIT_V(6); PG8_BAR;
    }
    for (;;) {
        const bool has_next = S.next(ui + 1, nxt);
        const char* nA = has_next ? (const char*)g.A + (size_t)nxt.pm * tstepA : cA; const char* nB = has_next ? (const char*)g.Bt + (size_t)nxt.pn * tstepB : cB;
        for (int t = 0; t < nt; t += 2) {
            const bool last = (t == nt - 2);
            const char* a1 = cA + (size_t)(t + 1) * kstep;
            const char* a2 = last ? nA : cA + (size_t)(t + 2) * kstep; const char* b2 = last ? nB : cB + (size_t)(t + 2) * kstep;
            const char* a3 = a2 + kstep; const char* b3 = b2 + kstep;
            if (last && has_next) S.a_ready(nxt);
            if constexpr (SP2) {
            PG8_LDB(B0, 0, 0); PG8_LDB(B1, 0, 1); PG8_SCHED; PG8_LDA(At, 0, 0); PG8_STAGE(PG8_SA(1, 1), a1 + hstepA, voffA);
            PG8_WAIT_V(8); PG8_WAIT_L(0); PG8_BAR; PG8_MMA(0, 0, At, B0); PG8_MMA(0, 1, At, B1); PG8_BAR; PG8_SCHED;
            PG8_LDA(At, 0, 1); PG8_STAGE(PG8_SB(0, 0), b2, voffB); PG8_STAGE(PG8_SB(0, 1), b2 + hstepB, voffB); PG8_STAGE(PG8_SA(0, 0), a2, voffA);
            PG8_WAIT_V(8); PG8_WAIT_L(0); PG8_BAR; PG8_MMA(1, 0, At, B0); PG8_MMA(1, 1, At, B1); PG8_BAR; PG8_SCHED;
            PG8_LDB(B0, 1, 0); PG8_LDB(B1, 1, 1); PG8_SCHED; PG8_LDA(At, 1, 0); PG8_STAGE(PG8_SA(0, 1), a2 + hstepA, voffA);
            PG8_WAIT_V(8); PG8_WAIT_L(0); PG8_BAR; PG8_MMA(0, 0, At, B0); PG8_MMA(0, 1, At, B1); PG8_BAR; PG8_SCHED;
            PG8_LDA(At, 1, 1); PG8_STAGE(PG8_SB(1, 0), b3, voffB); PG8_STAGE(PG8_SB(1, 1), b3 + hstepB, voffB); PG8_STAGE(PG8_SA(1, 0), a3, voffA);
            PG8_WAIT_V(8); PG8_WAIT_L(0); PG8_BAR; PG8_MMA(1, 0, At, B0); PG8_MMA(1, 1, At, B1); PG8_BAR; PG8_SCHED;
            } else {
            PG8_LDB(B0, 0, 0); PG8_SCHED; PG8_LDA(At, 0, 0); PG8_STAGE(PG8_SA(1, 1), a1 + hstepA, voffA);
            PG8_WAIT_L(8); PG8_BAR; PG8_WAIT_L(0); PG8_MMA(0, 0, At, B0); PG8_BAR; PG8_SCHED;
            PG8_LDB(B1, 0, 1); PG8_STAGE(PG8_SB(0, 0), b2, voffB);
            PG8_BAR; PG8_WAIT_L(0); PG8_MMA(0, 1, At, B1); PG8_BAR;
            PG8_LDA(At, 0, 1); PG8_STAGE(PG8_SA(0, 0), a2, voffA);
            PG8_BAR; PG8_WAIT_L(0); PG8_MMA(1, 0, At, B0); PG8_BAR; PG8_SCHED;
            PG8_STAGE(PG8_SB(0, 1), b2 + hstepB, voffB);
            PG8_WAIT_V(6); PG8_BAR; PG8_MMA(1, 1, At, B1); PG8_BAR;
            PG8_LDB(B0, 1, 0); PG8_SCHED; PG8_LDA(At, 1, 0); PG8_STAGE(PG8_SA(0, 1), a2 + hstepA, voffA);
            PG8_WAIT_L(8); PG8_BAR; PG8_WAIT_L(0); PG8_MMA(0, 0, At, B0); PG8_BAR; PG8_SCHED;
            PG8_LDB(B1, 1, 1); PG8_STAGE(PG8_SB(1, 0), b3, voffB);
            PG8_BAR; PG8_WAIT_L(0); PG8_MMA(0, 1, At, B1); PG8_BAR;
            PG8_LDA(At, 1, 1); PG8_STAGE(PG8_SA(1, 0), a3, voffA);
            PG8_BAR; PG8_WAIT_L(0); PG8_MMA(1, 0, At, B0); PG8_BAR; PG8_SCHED;
            PG8_STAGE(PG8_SB(1, 1), b3 + hstepB, voffB);
            PG8_WAIT_V(6); PG8_BAR; PG8_MMA(1, 1, At, B1); PG8_BAR;
            }
        }
        if constexpr (ALIGN_EPI) { if (wr == 0) PG8_BAR; }
        if constexpr (!Epi::AFTER_DRAIN) { E(acc, cur, ui, wr, wc, fr, fq); S.done(cur); }
        if (!has_next) break;
#pragma unroll
        for (int a = 0; a < 2; ++a)
#pragma unroll
            for (int b = 0; b < 2; ++b)
#pragma unroll
                for (int m = 0; m < 4; ++m)
#pragma unroll
                    for (int n = 0; n < 2; ++n) acc[a][b][m][n] = (f32x4){0.f, 0.f, 0.f, 0.f};
        cur = nxt; cA = nA; cB = nB; ++ui;
        if constexpr (ALIGN_EPI) { if (wr == 1) PG8_BAR; }
    }
    PG8_WAIT_V(0);
    if constexpr (!ALIGN_EPI) { if (wr == 0) PG8_BAR; }
    PG8_BAR;

#undef PG8_SA
#undef PG8_SB
#undef PG8_STAGE
#undef PG8_LDA
#undef PG8_LDB
#undef PG8_MMA
#undef PG8_WAIT_V
#undef PG8_WAIT_L
#undef PG8_BAR
#undef PG8_SCHED
}
}

constexpr int NWAVES = 8, NTHREADS = NWAVES * 64;
constexpr int BATCH = 8, SEQ = 2048, D = 1024, M = BATCH * SEQ, FF = 4096, DEPTH = 2;
constexpr int D_IN = 2312, NPROJ = 2560, PP = pg8::PROJ_PITCH;
constexpr int CQ = 0, CZ = 512, CK = 1024, CV = 1152, CX = 1280, CBM = 1792, CCM = 2048;
constexpr float EPS = 1e-6f;
constexpr int GRID = 256, NGRP = 8, GRP = GRID / NGRP;

constexpr size_t MiB = 1u << 20;
constexpr size_t WS_CTL = 0, CTL_ZERO_BYTES = 1 * MiB;
constexpr size_t WS_SSQ = 1 * MiB;
constexpr size_t WS_DTRAW = 2 * MiB;
constexpr size_t WS_ACS = 2 * MiB + 512 * 1024, WS_CHDEC = 3 * MiB;
constexpr size_t WS_WIN = 4 * MiB, WS_WOUT = 14 * MiB, WS_WUP = 18 * MiB, WS_WDOWN = 34 * MiB;
constexpr size_t WS_XB = 50 * MiB;
constexpr size_t WS_BATCH0 = 82 * MiB, BATCH_STRIDE = 20 * MiB;
constexpr size_t BO_PROJ = 0;
constexpr size_t BO_STATES = 9 * MiB;
constexpr size_t BO_PREV = 13 * MiB;
constexpr size_t BO_YPART = 15 * MiB;
constexpr size_t BO_CC = 19 * MiB;
constexpr size_t BO_HID = 0;
constexpr size_t WS_END = WS_BATCH0 + BATCH * BATCH_STRIDE;
static_assert(WS_END <= 256 * MiB, "d_ws map");
constexpr int CW_BAR = 4096, CW_GRP = 16384, GRP_BAR_STRIDE = 4096;

constexpr int RING_OFF = 0, RING_BYTES = 131072;
constexpr int MIX_BYTES = 155648;
constexpr int LDSCTL_OFF = MIX_BYTES, MISC_OFF = LDSCTL_OFF + 320, RSTD_OFF = LDSCTL_OFF + 512, PTR_OFF = RSTD_OFF + 4096;
constexpr int LDS_BYTES = 163840;
static_assert(PTR_OFF + 512 <= LDS_BYTES && RING_BYTES <= MIX_BYTES, "LDS map");

#define GAS __attribute__((address_space(1)))
#define LAS __attribute__((address_space(3)))
typedef unsigned short bf16;
typedef unsigned v4u __attribute__((ext_vector_type(4)));
typedef unsigned v2u __attribute__((ext_vector_type(2)));
typedef float f32x4 __attribute__((ext_vector_type(4)));
#define LDS_WAIT() asm volatile("s_waitcnt lgkmcnt(0)" ::: "memory")
#define VM_WAIT() asm volatile("s_waitcnt vmcnt(0)" ::: "memory")
__device__ __forceinline__ unsigned f2bf(float f) { unsigned u = __builtin_bit_cast(unsigned, f); return (u + 0x7fffu + ((u >> 16) & 1u)) >> 16; }
__device__ __forceinline__ unsigned pk2(float lo, float hi) { return f2bf(lo) | (f2bf(hi) << 16); }
__device__ __forceinline__ float bflo(unsigned w) { return __uint_as_float(w << 16); }
__device__ __forceinline__ float bfhi(unsigned w) { return __uint_as_float(w & 0xffff0000u); }
__device__ __forceinline__ float silu_f(float v) { return v / (1.f + expf(-v)); }
__device__ __forceinline__ float softplus_f(float v) { return fmaxf(v, 0.f) + log1pf(expf(-fabsf(v))); }

#define XB_TMO      128
#define XB_XCNT(j)  (256  + 64 * (j))
#define XB_XSUB(j)  (1280 + 64 * (j))
#define XB_XGEN(j)  (2304 + 64 * (j))
#define XB_TOP      3328
#define XB_TOPGEN   3392
#define XCD_BAR_WORDS 3456
#define XB_SPIN_CAP (1u << 22)
__device__ __forceinline__ unsigned xb_ld(unsigned* p)              { return __hip_atomic_load(p, __ATOMIC_RELAXED, __HIP_MEMORY_SCOPE_AGENT); }
__device__ __forceinline__ unsigned xb_add(unsigned* p, unsigned v) { return __hip_atomic_fetch_add(p, v, __ATOMIC_RELAXED, __HIP_MEMORY_SCOPE_AGENT); }
__device__ __forceinline__ unsigned xb_xcc_id() { return (unsigned)__builtin_amdgcn_s_getreg((3 << 11) | 20) & 0xFu; }
#define XB_SPIN(cond, bar) do { unsigned _sp = 0; while (cond) { __builtin_amdgcn_s_sleep(1); \
    if ((++_sp & 255u) == 0u) { if (xb_ld(&(bar)[XB_TMO])) break; if (_sp > XB_SPIN_CAP) { atomicAdd(&(bar)[XB_TMO], 1u); break; } } } } while (0)
struct XcdBarrier { unsigned* bar; unsigned x; unsigned total; volatile LAS unsigned* st; };
__device__ __forceinline__ XcdBarrier xcd_barrier_post(unsigned* bar, volatile LAS unsigned* st, unsigned total) {
    XcdBarrier b; b.bar = bar; b.x = xb_xcc_id(); b.total = total; b.st = st;
    if (threadIdx.x == 0) (void)xb_add(&bar[XB_XCNT(b.x)], 1u);
    return b;
}
__device__ __forceinline__ void xcd_barrier_complete(unsigned* bar, unsigned x, unsigned G, unsigned& nloc, unsigned& nx) {
    unsigned sum, cnt, mine, sp = 0u;
    for (;;) {
        sum = 0u; cnt = 0u; mine = 0u;
#pragma unroll
        for (unsigned j = 0; j < 16; ++j) { const unsigned c = xb_ld(&bar[XB_XCNT(j)]); sum += c; cnt += (c > 0u) ? 1u : 0u; mine = (j == x) ? c : mine; }
        if (sum == G) break;
        __builtin_amdgcn_s_sleep(1);
        if ((++sp & 255u) == 0u) { if (xb_ld(&bar[XB_TMO])) break; if (sp > XB_SPIN_CAP) { atomicAdd(&bar[XB_TMO], 1u); break; } }
    }
    nloc = mine > 0u ? mine : 1u; nx = cnt > 0u ? cnt : 1u;
}
__device__ __forceinline__ void xcd_barrier(const XcdBarrier& b) {
    asm volatile("s_waitcnt vmcnt(0)" ::: "memory");
    __syncthreads();
    if (threadIdx.x == 0) {
        unsigned* bar = b.bar;
        __builtin_amdgcn_s_waitcnt(0);
        unsigned nloc = b.st[0], nx = b.st[1];
        if (nloc == 0u) { xcd_barrier_complete(bar, b.x, b.total, nloc, nx); b.st[0] = nloc; b.st[1] = nx; }
        const unsigned old = xb_add(&bar[XB_XSUB(b.x)], 1u);
        const unsigned gen = old / nloc;
        if (nx == 1u) {
            XB_SPIN(xb_ld(&bar[XB_XSUB(b.x)]) < (gen + 1u) * nloc, bar);
            __builtin_amdgcn_fence(__ATOMIC_ACQUIRE, "agent");
            asm volatile("s_waitcnt vmcnt(0)" ::: "memory");
        } else if (old + 1u == (gen + 1u) * nloc) {
            __builtin_amdgcn_fence(__ATOMIC_RELEASE, "agent");
            asm volatile("s_waitcnt vmcnt(0)" ::: "memory");
            const unsigned og = xb_add(&bar[XB_TOP], 1u);
            const unsigned tg = og / nx;
            if (og + 1u == (tg + 1u) * nx) xb_add(&bar[XB_TOPGEN], 1u);
            else XB_SPIN(xb_ld(&bar[XB_TOPGEN]) == tg, bar);
            __builtin_amdgcn_fence(__ATOMIC_ACQUIRE, "agent");
            xb_add(&bar[XB_XGEN(b.x)], 1u);
            asm volatile("s_waitcnt vmcnt(0)" ::: "memory");
        } else {
            XB_SPIN(xb_ld(&bar[XB_XGEN(b.x)]) == gen, bar);
            __builtin_amdgcn_fence(__ATOMIC_ACQUIRE, "agent");
            asm volatile("s_waitcnt vmcnt(0)" ::: "memory");
        }
    }
    __syncthreads();
}

struct Frame {
    LAS unsigned char* lds;
    int tid, lane, wave, bid, G;
    int b, li;
};
enum { I_X = 0, I_MIXG, I_WIN, I_QG, I_KG, I_SINK, I_RELB, I_CONVW, I_CONVB, I_DTB, I_ALOG, I_DSKIP, I_SSMG, I_WOUT, I_MLPG, I_WUP, I_WDOWN, I_OUT, I_WS, I_NPTR };
__device__ __forceinline__ GAS unsigned char* ptr_at(const Frame& F, int i) {
    const LAS unsigned* t = (const LAS unsigned*)(F.lds + PTR_OFF) + 2 * i;
    const unsigned lo = __builtin_amdgcn_readfirstlane(t[0]), hi = __builtin_amdgcn_readfirstlane(t[1]);
    return (GAS unsigned char*)(((unsigned long long)hi << 32) | lo);
}
#define FIN(i) ((const GAS float*)ptr_at(F, (i)))
#define FWS(off) (ptr_at(F, I_WS) + (off))
#define FB(off) (ptr_at(F, I_WS) + (WS_BATCH0 + (size_t)F.b * BATCH_STRIDE + (off)))
using pg8::shx;
__device__ __forceinline__ float shup(float v, int o, int lane) { return __builtin_bit_cast(float, __builtin_amdgcn_ds_bpermute(((lane - o) & 63) << 2, __builtin_bit_cast(int, v))); }
__device__ __forceinline__ float wave_sum(float v, int lane) {
#pragma unroll
    for (int o = 1; o < 64; o <<= 1) v += shx(v, o, lane);
    return v;
}

__device__ __forceinline__ void tr_item(const GAS float* W, int Nsrc, int nsrc0, int nvalid, int K, const GAS float* gain, GAS bf16* WT, int ndst0, int k0, LAS float* scr, int lane) {
    const int n = lane & 31;
    float tv[32];
#pragma unroll
    for (int i = 0; i < 32; ++i) { const int kk = 2 * i + (lane >> 5); tv[i] = W[(size_t)(k0 + kk) * Nsrc + nsrc0 + (n < nvalid ? n : 0)]; }
#pragma unroll
    for (int i = 0; i < 32; ++i) { const int kk = 2 * i + (lane >> 5); float v = (n < nvalid) ? tv[i] : 0.f; if (gain) v *= gain[k0 + kk];
        scr[kk * 33 + n] = v; }
    LDS_WAIT(); asm volatile("" ::: "memory");
    const int c = lane & 7;
#pragma unroll
    for (int j = 0; j < 4; ++j) { const int nn = (lane >> 3) + 8 * j; const LAS float* s = scr + (8 * c) * 33 + nn;
        v4u o; o.x = pk2(s[0 * 33], s[1 * 33]); o.y = pk2(s[2 * 33], s[3 * 33]); o.z = pk2(s[4 * 33], s[5 * 33]); o.w = pk2(s[6 * 33], s[7 * 33]);
        *(GAS v4u*)(WT + (size_t)(ndst0 + nn) * K + k0 + 8 * c) = o; }
    LDS_WAIT(); asm volatile("" ::: "memory");
}
__device__ __forceinline__ void win_item(Frame& F, int L, int r, LAS float* scr);
__device__ __forceinline__ void p0_prologue(Frame& F) {
    LAS float* scr = (LAS float*)(F.lds + RING_OFF + F.wave * 16384);
    const int gw = F.bid * NWAVES + F.wave, NGW = F.G * NWAVES;
    constexpr int I_IN = 16 * 80, I_OUT = 16 * 32, I_UP = 16 * 128, I_DN = 64 * 32, I_L = I_IN + I_OUT + I_UP + I_DN;
    for (int it = gw; it < I_IN; it += NGW) win_item(F, 0, it, scr);
    const GAS float* x = FIN(I_X) + (size_t)F.b * SEQ * D; GAS bf16* XB = (GAS bf16*)FWS(WS_XB) + (size_t)F.b * SEQ * D; GAS float* SSQ = (GAS float*)FWS(WS_SSQ) + (size_t)F.b * SEQ * 16;
    for (int m = F.li * NWAVES + F.wave; m < SEQ; m += 2 * GRP * NWAVES) {
        const int m2 = m + GRP * NWAVES;
        const GAS f32x4* xr = (const GAS f32x4*)(x + (size_t)m * D) + F.lane; const GAS f32x4* xr2 = (const GAS f32x4*)(x + (size_t)m2 * D) + F.lane;
        f32x4 v[4], w[4]; float s = 0.f, s2 = 0.f;
#pragma unroll
        for (int j = 0; j < 4; ++j) { v[j] = xr[64 * j]; w[j] = xr2[64 * j]; }
#pragma unroll
        for (int j = 0; j < 4; ++j) { s += (v[j].x * v[j].x + v[j].y * v[j].y) + (v[j].z * v[j].z + v[j].w * v[j].w); s2 += (w[j].x * w[j].x + w[j].y * w[j].y) + (w[j].z * w[j].z + w[j].w * w[j].w); }
        s = wave_sum(s, F.lane); s2 = wave_sum(s2, F.lane);
        GAS v2u* o8 = (GAS v2u*)(XB + (size_t)m * D) + F.lane; GAS v2u* o82 = (GAS v2u*)(XB + (size_t)m2 * D) + F.lane;
#pragma unroll
        for (int j = 0; j < 4; ++j) { v2u o; o.x = pk2(v[j].x, v[j].y); o.y = pk2(v[j].z, v[j].w); o8[64 * j] = o; v2u o2; o2.x = pk2(w[j].x, w[j].y); o2.y = pk2(w[j].z, w[j].w); o82[64 * j] = o2; }
        if (F.lane < 16) { SSQ[(size_t)m * 16 + F.lane] = (F.lane == 0) ? s : 0.f; SSQ[(size_t)m2 * 16 + F.lane] = (F.lane == 0) ? s2 : 0.f; }
    }
}
constexpr int CW_WCNT = 8192, N_CONVERTERS = NGRP * (GRP - 16);
__device__ __forceinline__ void win_item(Frame& F, int L, int r, LAS float* scr) {
    const int kb = r / 80, nb = r % 80; int src, nv = 32;
    if (nb < 16) src = nb * 32; else if (nb < 32) src = 768 + (nb - 16) * 32; else if (nb < 36) src = 512 + (nb - 32) * 32; else if (nb < 40) src = 640 + (nb - 36) * 32;
    else if (nb < 72) src = nb * 32; else if (nb == 72) { src = 2304; nv = 8; } else { src = 0; nv = 0; }
    tr_item(FIN(I_WIN) + (size_t)L * D * D_IN, D_IN, src, nv, D, FIN(I_MIXG) + L * D, (GAS bf16*)FWS(WS_WIN) + (size_t)L * NPROJ * D, nb * 32, kb * 64, scr, F.lane);
}
__device__ __forceinline__ void convert_rest(Frame& F, int slot) {
    LAS float* scr = (LAS float*)(F.lds + RING_OFF + F.wave * 16384);
    constexpr int I_IN = 16 * 80, I_OUT = 16 * 32, I_UP = 16 * 128, I_DN = 64 * 32, NCW = N_CONVERTERS * NWAVES;
    const GAS float *w_out = FIN(I_WOUT), *w_up = FIN(I_WUP), *mlp_g = FIN(I_MLPG), *w_down = FIN(I_WDOWN);
    GAS bf16 *WOUT = (GAS bf16*)FWS(WS_WOUT), *WUP = (GAS bf16*)FWS(WS_WUP), *WDOWN = (GAS bf16*)FWS(WS_WDOWN);
    const int L = slot, n_items = I_OUT + I_UP + I_DN + (slot == 0 ? I_IN : 0);
    for (int it = (F.b * (GRP - 16) + (F.li - 16)) * NWAVES + F.wave; it < n_items; it += NCW) {
        int r = it;
        if (r < I_OUT) { const int kb = r / 32, nb = r % 32; tr_item(w_out + (size_t)L * D * D, D, nb * 32, 32, D, nullptr, WOUT + (size_t)L * D * D, nb * 32, kb * 64, scr, F.lane); continue; }
        r -= I_OUT;
        if (r < I_UP) { const int kb = r / 128, nb = r % 128; tr_item(w_up + (size_t)L * D * FF, FF, nb * 32, 32, D, mlp_g + L * D, WUP + (size_t)L * FF * D, nb * 32, kb * 64, scr, F.lane); continue; }
        r -= I_UP;
        if (r < I_DN) { const int kb = r / 32, nb = r % 32; tr_item(w_down + (size_t)L * FF * D, D, nb * 32, 32, FF, nullptr, WDOWN + (size_t)L * D * FF, nb * 32, kb * 64, scr, F.lane); continue; }
        r -= I_DN;
        win_item(F, 1, r, scr);
    }
    asm volatile("s_waitcnt vmcnt(0)" ::: "memory");
    __syncthreads();
    if (F.tid == 0) { __builtin_amdgcn_fence(__ATOMIC_RELEASE, "agent"); asm volatile("s_waitcnt vmcnt(0)" ::: "memory");
        (void)xb_add((unsigned*)(unsigned char*)FWS(WS_CTL) + CW_WCNT + 64 * slot, 1u); }
}
__device__ __forceinline__ void wait_weights(Frame& F, int part) {
    if (F.tid == 0) { unsigned* wc = (unsigned*)(unsigned char*)FWS(WS_CTL) + CW_WCNT + 64 * part; unsigned sp = 0u;
        while (xb_ld(wc) < (unsigned)N_CONVERTERS) { __builtin_amdgcn_s_sleep(2); if (++sp > (1u << 22)) break; }
        __builtin_amdgcn_fence(__ATOMIC_ACQUIRE, "agent"); asm volatile("s_waitcnt vmcnt(0)" ::: "memory"); }
    __syncthreads();
}
__device__ __forceinline__ void rstd_prepass(Frame& F, const pg8::GroupOrder& S, LAS float* tab) {
    const GAS float* SSQ = (const GAS float*)FWS(WS_SSQ) + (size_t)F.b * SEQ * 16;
    pg8::Unit u;
    for (int i = 0; i < 4 && S.next(i, u); ++i) {
        const int r = F.tid >> 1, h = F.tid & 1;
        const GAS f32x4* p = (const GAS f32x4*)(SSQ + (size_t)(u.pm * 256 + r) * 16 + h * 8);
        const f32x4 a = p[0], b = p[1];
        float s = (a.x + a.y) + (a.z + a.w) + (b.x + b.y) + (b.z + b.w);
        s += shx(s, 1, F.lane);
        if (h == 0) tab[i * 256 + r] = 1.0f / sqrtf(s * (1.0f / D) + EPS);
    }
    LDS_WAIT(); __syncthreads();
}
__device__ __forceinline__ int t5_bucket(int d) {
    if (d < 16) return d;
    return 16 + (d >= 19) + (d >= 21) + (d >= 24) + (d >= 27) + (d >= 31) + (d >= 35) + (d >= 40) + (d >= 46) + (d >= 52) + (d >= 59) + (d >= 67) + (d >= 77) + (d >= 87) + (d >= 99) + (d >= 113);
}
__device__ __forceinline__ void ld8(const GAS bf16* p, float (&v)[8]) {
    const v4u w = *(const GAS v4u*)p;
    v[0] = bflo(w.x); v[1] = bfhi(w.x); v[2] = bflo(w.y); v[3] = bfhi(w.y); v[4] = bflo(w.z); v[5] = bfhi(w.z); v[6] = bflo(w.w); v[7] = bfhi(w.w);
}
typedef short bf16x8_t __attribute__((ext_vector_type(8)));
typedef float f32x16 __attribute__((ext_vector_type(16)));
constexpr float LOG2E = 1.4426950408889634f;
__device__ __forceinline__ unsigned pkbf(float lo, float hi) { return pg8::cvt_pk_bf16(lo, hi); }
__device__ __forceinline__ int crow32(int i, int hh) { return (i & 3) + 8 * (i >> 2) + 4 * hh; }
__device__ __forceinline__ float silu_fast(float v) { return v * __builtin_amdgcn_rcpf(1.0f + __builtin_amdgcn_exp2f(-v * LOG2E)); }
__device__ __forceinline__ void unpk8(const v4u w, float (&v)[8]) {
    v[0] = bflo(w.x); v[1] = bfhi(w.x); v[2] = bflo(w.y); v[3] = bfhi(w.y); v[4] = bflo(w.z); v[5] = bfhi(w.z); v[6] = bflo(w.w); v[7] = bfhi(w.w);
}

typedef short v4i16_t __attribute__((ext_vector_type(4)));
template <int RH, int RSEC> __device__ __forceinline__ bf16x8_t tr_frag(const LAS unsigned char* img, int stride, int rbase, int cbase, int lane) {
    const LAS unsigned char* p = img + (rbase + RH * (lane >> 5) + ((lane & 15) >> 2)) * stride + (cbase + 16 * ((lane >> 4) & 1) + 4 * (lane & 3)) * 2;
    const v4i16_t a = __builtin_amdgcn_ds_read_tr16_b64_v4i16((LAS v4i16_t*)p), b = __builtin_amdgcn_ds_read_tr16_b64_v4i16((LAS v4i16_t*)(p + RSEC * stride));
    return (bf16x8_t){a[0], a[1], a[2], a[3], b[0], b[1], b[2], b[3]};
}
constexpr int AT_KS = 0, AT_KSTRIDE = 144, AT_VT = 36864, AT_VSTRIDE = 192, AT_BIAS = AT_VT + 256 * AT_VSTRIDE;
constexpr int AT_BN = 192, AT_END = AT_BIAS + 4 * AT_BN * 4;
static_assert(AT_END <= MIX_BYTES, "attention LDS");
__device__ __forceinline__ void attn_fast(Frame& F, int L, bool dummy = false) {
    GAS bf16* PROJ = (GAS bf16*)FB(BO_PROJ);
    const GAS float* qg = FIN(I_QG) + L * 64; const GAS float* kg = FIN(I_KG) + L * 64; const GAS float* sinks = FIN(I_SINK) + L * 8; const GAS float* rel_bias = FIN(I_RELB);
    LAS unsigned char* Ks = F.lds + AT_KS; LAS unsigned char* Vt = F.lds + AT_VT; LAS float* biasR = (LAS float*)(F.lds + AT_BIAS);
    const int tid = F.tid, lane = F.lane, wave = F.wave, q = lane & 31, hh = lane >> 5;
    const int unit = F.li, kvh = unit >> 4, qb = unit & 15, m0 = qb * 128;
    const int gi = wave >> 1, qh = wave & 1, hq = kvh * 4 + gi;
    v4u qraw[2][4];
#pragma unroll
    for (int s = 0; s < 2; ++s)
#pragma unroll
        for (int d0 = 0; d0 < 4; ++d0) qraw[s][d0] = *(const GAS v4u*)(PROJ + (size_t)(m0 + 64 * qh + 32 * s + q) * PP + CQ + hq * 64 + d0 * 16 + hh * 8);
    v4u kwv[4], vwv[4];
#pragma unroll
    for (int i = 0; i < 4; ++i) { const int c = tid + NTHREADS * i, key = c >> 3, part = c & 7; const bool valid = (qb > 0) || (key >= 128); const unsigned msk = valid ? 0xffffffffu : 0u;
        const GAS bf16* kp = PROJ + (size_t)(valid ? m0 + key - 128 : 0) * PP + CK + kvh * 64 + part * 8;
        v4u a_ = *(const GAS v4u*)kp, b_ = *(const GAS v4u*)(kp + (CV - CK));
        a_.x &= msk; a_.y &= msk; a_.z &= msk; a_.w &= msk; b_.x &= msk; b_.y &= msk; b_.z &= msk; b_.w &= msk; kwv[i] = a_; vwv[i] = b_; }
    const f32x4 kg0 = *(const GAS f32x4*)(kg + (tid & 7) * 8), kg1 = *(const GAS f32x4*)(kg + (tid & 7) * 8 + 4);
    f32x4 qgv[4][2];
#pragma unroll
    for (int d0 = 0; d0 < 4; ++d0) { qgv[d0][0] = *(const GAS f32x4*)(qg + d0 * 16 + hh * 8); qgv[d0][1] = *(const GAS f32x4*)(qg + d0 * 16 + hh * 8 + 4); }
    const float sinkv = sinks[hq];
    float bent[2];
#pragma unroll
    for (int k = 0; k < 2; ++k) { const int x = tid + NTHREADS * k, g_ = x / AT_BN, xx = x - g_ * AT_BN; const bool ok = (x < 4 * AT_BN) && (xx >= 32) && (xx < 160);
        const float v = rel_bias[t5_bucket(ok ? 159 - xx : 0) * 8 + kvh * 4 + (ok ? g_ : 0)]; bent[k] = ok ? v * LOG2E : 0.f; }
    __syncthreads();
    biasR[tid] = bent[0]; if (tid + NTHREADS < 4 * AT_BN) biasR[tid + NTHREADS] = bent[1];
#pragma unroll
    for (int i = 0; i < 4; ++i) {
        const int c = tid + NTHREADS * i, key = c >> 3, part = c & 7;
        const v4u kw = kwv[i], vw = vwv[i];
        float kv[8]; unpk8(kw, kv);
        float ss = 0.f;
#pragma unroll
        for (int e = 0; e < 8; ++e) ss += kv[e] * kv[e];
        ss += shx(ss, 1, lane); ss += shx(ss, 2, lane); ss += shx(ss, 4, lane);
        const float rk = __builtin_amdgcn_rsqf(ss * (1.0f / 64.0f) + EPS);
        const f32x4 g0 = kg0, g1 = kg1;
        v4u ko; ko.x = pkbf(kv[0] * rk * g0.x, kv[1] * rk * g0.y); ko.y = pkbf(kv[2] * rk * g0.z, kv[3] * rk * g0.w); ko.z = pkbf(kv[4] * rk * g1.x, kv[5] * rk * g1.y); ko.w = pkbf(kv[6] * rk * g1.z, kv[7] * rk * g1.w);
        *(LAS v4u*)(Ks + key * AT_KSTRIDE + part * 16) = ko;
        *(LAS v4u*)(Vt + key * AT_VSTRIDE + part * 16) = vw;
    }
    LDS_WAIT(); __syncthreads();
    const float sink2 = sinkv * LOG2E;
    const LAS float* bb = biasR + gi * AT_BN + 31 - q + 4 * hh;
    const int qm = q - 4 * hh;
#pragma unroll
    for (int s = 0; s < 2; ++s) {
        const int a = 64 * qh + 32 * s;
        GAS bf16* qrow = PROJ + (size_t)(m0 + a + q) * PP + CQ + hq * 64;
        float qv[4][8]; float ss = 0.f;
#pragma unroll
        for (int d0 = 0; d0 < 4; ++d0) { unpk8(qraw[s][d0], qv[d0]);
#pragma unroll
            for (int e = 0; e < 8; ++e) ss += qv[d0][e] * qv[d0][e]; }
        ss += shx(ss, 32, lane);
        const float rq = __builtin_amdgcn_rsqf(ss * (1.0f / 64.0f) + EPS) * (0.125f * LOG2E);
        bf16x8_t qf[4];
#pragma unroll
        for (int d0 = 0; d0 < 4; ++d0) { const f32x4 g0 = qgv[d0][0], g1 = qgv[d0][1];
            v4u w; w.x = pkbf(qv[d0][0] * rq * g0.x, qv[d0][1] * rq * g0.y); w.y = pkbf(qv[d0][2] * rq * g0.z, qv[d0][3] * rq * g0.w);
            w.z = pkbf(qv[d0][4] * rq * g1.x, qv[d0][5] * rq * g1.y); w.w = pkbf(qv[d0][6] * rq * g1.z, qv[d0][7] * rq * g1.w);
            qf[d0] = __builtin_bit_cast(bf16x8_t, w); }
        const int kt_lo = (qb == 0) ? 4 - (a >> 5) : 0;
        f32x16 S[5]; float mx = sink2;
#pragma unroll
        for (int kt = 0; kt < 5; ++kt) { f32x16 acc = {};
#pragma unroll
            for (int d0 = 0; d0 < 4; ++d0) { const bf16x8_t kf = *(const LAS bf16x8_t*)(Ks + (a + 32 * kt + q) * AT_KSTRIDE + d0 * 32 + hh * 16);
                acc = __builtin_amdgcn_mfma_f32_32x32x16_bf16(kf, qf[d0], acc, 0, 0, 0); }
            if (kt < kt_lo) {
#pragma unroll
                for (int i = 0; i < 16; ++i) acc[i] = -INFINITY;
            } else {
#pragma unroll
                for (int i = 0; i < 16; ++i) { const int t0 = (i & 3) + 8 * (i >> 2); float v = acc[i] + bb[32 * kt + t0];
                    if (kt == 0) v = fminf(v, (t0 > qm) ? INFINITY : -INFINITY);
                    if (kt == 4) v = fminf(v, (t0 <= qm) ? INFINITY : -INFINITY);
                    acc[i] = v; mx = fmaxf(mx, v); } }
            S[kt] = acc; }
        mx = fmaxf(mx, shx(mx, 32, lane));
        float lsum = 0.f; bf16x8_t pf[5][2];
#pragma unroll
        for (int kt = 0; kt < 5; ++kt) {
#pragma unroll
            for (int i = 0; i < 16; ++i) { const float p = __builtin_amdgcn_exp2f(S[kt][i] - mx); S[kt][i] = p; lsum += p; }
#pragma unroll
            for (int s2 = 0; s2 < 2; ++s2) { v4u w; w.x = pkbf(S[kt][8 * s2 + 0], S[kt][8 * s2 + 1]); w.y = pkbf(S[kt][8 * s2 + 2], S[kt][8 * s2 + 3]);
                w.z = pkbf(S[kt][8 * s2 + 4], S[kt][8 * s2 + 5]); w.w = pkbf(S[kt][8 * s2 + 6], S[kt][8 * s2 + 7]); pf[kt][s2] = __builtin_bit_cast(bf16x8_t, w); } }
        lsum += shx(lsum, 32, lane);
        lsum += __builtin_amdgcn_exp2f(sink2 - mx);
        f32x16 O[2] = {{}, {}};
#pragma unroll
        for (int kt = 0; kt < 5; ++kt)
#pragma unroll
            for (int s2 = 0; s2 < 2; ++s2)
#pragma unroll
                for (int db = 0; db < 2; ++db)
                    O[db] = __builtin_amdgcn_mfma_f32_32x32x16_bf16(tr_frag<4, 8>(Vt, AT_VSTRIDE, a + 32 * kt + 16 * s2, 32 * db, lane), pf[kt][s2], O[db], 0, 0, 0);
        const float inv = __builtin_amdgcn_rcpf(lsum);
#pragma unroll
        for (int db = 0; db < 2; ++db)
#pragma unroll
            for (int g4 = 0; g4 < 4; ++g4) { v2u w; w.x = pkbf(O[db][4 * g4] * inv, O[db][4 * g4 + 1] * inv); w.y = pkbf(O[db][4 * g4 + 2] * inv, O[db][4 * g4 + 3] * inv);
                GAS bf16* orow = dummy ? (GAS bf16*)FB(BO_PREV) + (size_t)(m0 + a + q) * 512 + hq * 64 : qrow;
                *(GAS v2u*)(orow + 32 * db + 8 * g4 + 4 * hh) = w; }
    }
}

constexpr size_t WS_DTV = 3 * MiB + 512 * 1024;
constexpr int SD_ROW = 272, SD_XT = 264;
template <int NR> struct Raw8 { v4u u[NR + 3]; };
template <int NR> struct Raw4 { v2u u[NR + 3]; };
struct ConvW8 { f32x4 w[4][2], b[2]; };
struct ConvW4 { f32x4 w[4], b; };
template <int NR> __device__ __forceinline__ void conv_load(Raw8<NR>& R, const GAS bf16* PROJ, int m0, int c, int l0, int col0) {
#pragma unroll
    for (int i = 0; i < NR + 3; ++i) { const int row = l0 - 3 + i; const bool ok = (c > 0) || (row >= 0); const unsigned msk = ok ? 0xffffffffu : 0u;
        v4u x = *(const GAS v4u*)(PROJ + (size_t)(m0 + (ok ? row : 0)) * PP + col0); x.x &= msk; x.y &= msk; x.z &= msk; x.w &= msk; R.u[i] = x; }
}
template <int NR> __device__ __forceinline__ void conv_load(Raw4<NR>& R, const GAS bf16* PROJ, int m0, int c, int l0, int col0) {
#pragma unroll
    for (int i = 0; i < NR + 3; ++i) { const int row = l0 - 3 + i; const bool ok = (c > 0) || (row >= 0); const unsigned msk = ok ? 0xffffffffu : 0u;
        v2u x = *(const GAS v2u*)(PROJ + (size_t)(m0 + (ok ? row : 0)) * PP + col0); x.x &= msk; x.y &= msk; R.u[i] = x; }
}
__device__ __forceinline__ void convw_load(ConvW8& W, const GAS float* cw, const GAS float* cb) {
#pragma unroll
    for (int k = 0; k < 4; ++k) { W.w[k][0] = *(const GAS f32x4*)(cw + k * 1024); W.w[k][1] = *(const GAS f32x4*)(cw + k * 1024 + 4); }
    W.b[0] = *(const GAS f32x4*)cb; W.b[1] = *(const GAS f32x4*)(cb + 4);
}
__device__ __forceinline__ void convw_load(ConvW4& W, const GAS float* cw, const GAS float* cb) {
#pragma unroll
    for (int k = 0; k < 4; ++k) W.w[k] = *(const GAS f32x4*)(cw + k * 1024);
    W.b = *(const GAS f32x4*)cb;
}
template <int NR> __device__ __forceinline__ void conv_row(const Raw8<NR>& R, const ConvW8& W, int r, float (&out)[8]) {
    float acc[8];
#pragma unroll
    for (int e = 0; e < 8; ++e) acc[e] = W.b[e >> 2][e & 3];
#pragma unroll
    for (int k = 0; k < 4; ++k) { float u[8]; unpk8(R.u[r + k], u);
#pragma unroll
        for (int e = 0; e < 8; ++e) acc[e] += W.w[k][e >> 2][e & 3] * u[e]; }
#pragma unroll
    for (int e = 0; e < 8; ++e) out[e] = silu_fast(acc[e]);
}
template <int NR> __device__ __forceinline__ void conv_row(const Raw4<NR>& R, const ConvW4& W, int r, float (&out)[4]) {
    float acc[4];
#pragma unroll
    for (int e = 0; e < 4; ++e) acc[e] = W.b[e];
#pragma unroll
    for (int k = 0; k < 4; ++k) { const v2u x = R.u[r + k]; const float u[4] = {bflo(x.x), bfhi(x.x), bflo(x.y), bfhi(x.y)};
#pragma unroll
        for (int e = 0; e < 4; ++e) acc[e] += W.w[k][e] * u[e]; }
#pragma unroll
    for (int e = 0; e < 4; ++e) out[e] = silu_fast(acc[e]);
}
constexpr int P_XSTR = 576, P_BSTR = 304, P_XD = 0, P_BM = P_XD + 128 * P_XSTR, P_CM = P_BM + 128 * P_BSTR, P_FREE = P_CM + 128 * SD_ROW, P_DT = MIX_BYTES - 4096, P_ACS = P_DT + 2048;
static_assert(P_FREE + 4096 <= P_DT, "SSD LDS map");
__device__ __forceinline__ bf16x8_t scale_frag(bf16x8_t f, const f32x4 s0, const f32x4 s1) {
    const v4u w = __builtin_bit_cast(v4u, f); v4u o;
    o.x = pkbf(bflo(w.x) * s0.x, bfhi(w.x) * s0.y); o.y = pkbf(bflo(w.y) * s0.z, bfhi(w.y) * s0.w); o.z = pkbf(bflo(w.z) * s1.x, bfhi(w.z) * s1.y); o.w = pkbf(bflo(w.w) * s1.z, bfhi(w.w) * s1.w);
    return __builtin_bit_cast(bf16x8_t, o);
}
constexpr int S1_W = P_FREE, S1_WT = S1_W + 2048;
__device__ __forceinline__ void ssd_states(Frame& F, int L) {
    const GAS bf16* PROJ = (const GAS bf16*)FB(BO_PROJ);
    const GAS float* conv_w = FIN(I_CONVW) + (size_t)L * 4 * 1024; const GAS float* conv_b = FIN(I_CONVB) + L * 1024;
    const GAS float* dt_bias = FIN(I_DTB) + L * 8; const GAS float* a_log = FIN(I_ALOG) + L * 8;
    const GAS float* DTRAW = (const GAS float*)FWS(WS_DTRAW) + (size_t)F.b * SEQ * 8; GAS float* CHDEC = (GAS float*)FWS(WS_CHDEC) + F.b * 128;
    GAS bf16* STATES = (GAS bf16*)FB(BO_STATES);
    LAS unsigned char* XD = F.lds + P_XD; LAS unsigned char* BM = F.lds + P_BM;
    LAS float* dt_l = (LAS float*)(F.lds + P_DT); LAS float* acs_l = (LAS float*)(F.lds + P_ACS); LAS float* w_l = (LAS float*)(F.lds + S1_W); LAS float* wt = (LAS float*)(F.lds + S1_WT);
    const int wave = F.wave, unit = F.li, c = unit >> 1, g = unit & 1, m0 = c * 128;
    int tid = F.tid; asm volatile("" : "+v"(tid));
    int lane = tid & 63, q = lane & 31, hh = lane >> 5;
    const int xcg = tid & 31, xl0 = (tid >> 5) * 8, xcol = CX + g * 256 + xcg * 8;
    const int bcg = tid & 31, bl0 = (tid >> 5) * 8, isC = bcg >> 4, bn0 = (bcg & 15) * 8, bcol = (isC ? CCM : CBM) + g * 128 + bn0;
    Raw8<8> xr; ConvW8 xw; Raw8<8> br; ConvW8 bw;
    conv_load(xr, PROJ, m0, c, xl0, xcol); convw_load(xw, conv_w + (xcol - CX), conv_b + (xcol - CX));
    conv_load(br, PROJ, m0, c, bl0, bcol); convw_load(bw, conv_w + (bcol - CX), conv_b + (bcol - CX));
    const int ar = tid >> 7, al = tid & 127, ahead = 4 * g + ar;
    const float dtraw = DTRAW[(size_t)(m0 + al) * 8 + ahead], dtb = dt_bias[ahead], alog = a_log[ahead];
    __syncthreads();
    float acs_v;
    { const float dtv = softplus_f(dtraw + dtb);
      float v = dtv * (-expf(alog));
#pragma unroll
      for (int o = 1; o < 64; o <<= 1) { const float t = shup(v, o, lane); if (lane >= o) v += t; }
      if (lane == 63) wt[wave] = v;
      LDS_WAIT(); __syncthreads();
      if (wave & 1) v += wt[wave - 1];
      dt_l[tid] = dtv; acs_l[tid] = v * LOG2E; acs_v = v * LOG2E;
      if (al == 127) CHDEC[c * 8 + ahead] = expf(v); }
#pragma unroll
    for (int r = 0; r < 8; ++r) { float o[8]; conv_row(br, bw, r, o);
        v4u pk; pk.x = pkbf(o[0], o[1]); pk.y = pkbf(o[2], o[3]); pk.z = pkbf(o[4], o[5]); pk.w = pkbf(o[6], o[7]);
        *(LAS v4u*)(isC ? F.lds + P_CM + (bl0 + r) * SD_ROW + bn0 * 2 : BM + (bl0 + r) * P_BSTR + bn0 * 2) = pk; }
    LDS_WAIT(); __syncthreads();
    w_l[tid] = __builtin_amdgcn_exp2f(acs_l[ar * 128 + 127] - acs_v);
    { const int r4 = xcg >> 3;
#pragma unroll
      for (int r = 0; r < 8; ++r) { float o[8]; conv_row(xr, xw, r, o); const int l = xl0 + r; const float sc = dt_l[r4 * 128 + l];
          v4u pk; pk.x = pkbf(o[0] * sc, o[1] * sc); pk.y = pkbf(o[2] * sc, o[3] * sc); pk.z = pkbf(o[4] * sc, o[5] * sc); pk.w = pkbf(o[6] * sc, o[7] * sc);
          *(LAS v4u*)(XD + l * P_XSTR + xcg * 16) = pk; } }
    LDS_WAIT(); __syncthreads();
    asm volatile("" : "+v"(tid)); lane = tid & 63; q = lane & 31; hh = lane >> 5;
    { const int r4 = wave >> 1, nt0 = (wave & 1) * 2, head = 4 * g + r4;
      f32x16 St[2][2] = {{{}, {}}, {{}, {}}};
#pragma unroll
      for (int ks = 0; ks < 8; ++ks) { bf16x8_t af[2], bfr[2];
          const f32x4 w0 = *(const LAS f32x4*)(w_l + r4 * 128 + 16 * ks + 8 * hh), w1 = *(const LAS f32x4*)(w_l + r4 * 128 + 16 * ks + 8 * hh + 4);
#pragma unroll
          for (int pt = 0; pt < 2; ++pt) af[pt] = tr_frag<8, 4>(XD, P_XSTR, 16 * ks, r4 * 64 + 32 * pt, lane);
#pragma unroll
          for (int nn = 0; nn < 2; ++nn) bfr[nn] = scale_frag(tr_frag<8, 4>(BM, P_BSTR, 16 * ks, 32 * (nt0 + nn), lane), w0, w1);
#pragma unroll
          for (int pt = 0; pt < 2; ++pt)
#pragma unroll
              for (int nn = 0; nn < 2; ++nn) St[pt][nn] = __builtin_amdgcn_mfma_f32_32x32x16_bf16(af[pt], bfr[nn], St[pt][nn], 0, 0, 0); }
      GAS bf16* sp = STATES + ((size_t)c * 8 + head) * 8192 + 32 * nt0 + q;
#pragma unroll
      for (int pt = 0; pt < 2; ++pt)
#pragma unroll
          for (int nn = 0; nn < 2; ++nn)
#pragma unroll
              for (int e = 0; e < 16; e += 2) { const unsigned w = pkbf(St[pt][nn][e], St[pt][nn][e + 1]);
                  sp[(32 * pt + crow32(e, hh)) * 128 + 32 * nn] = (bf16)(w & 0xffffu); sp[(32 * pt + crow32(e + 1, hh)) * 128 + 32 * nn] = (bf16)(w >> 16); } }
}
__device__ __forceinline__ void ssd_scan(Frame& F, int L) {
    const GAS bf16* STATES = (const GAS bf16*)FB(BO_STATES); const GAS float* CHDEC = (const GAS float*)FWS(WS_CHDEC) + F.b * 128; GAS bf16* PREV = (GAS bf16*)FB(BO_PREV);
    for (int idx = F.li * NTHREADS + F.tid; idx < 8 * 64 * 32; idx += GRP * NTHREADS) {
        const int n4 = idx & 31, p = (idx >> 5) & 63, head = idx >> 11;
        v2u s[16]; float dec[16];
#pragma unroll
        for (int c = 0; c < 16; ++c) { const size_t o = ((size_t)c * 8 + head) * 8192 + p * 128 + 4 * n4; s[c] = *(const GAS v2u*)(STATES + o); dec[c] = CHDEC[c * 8 + head]; }
        f32x4 h = {0.f, 0.f, 0.f, 0.f};
#pragma unroll
        for (int c = 0; c < 16; ++c) { const size_t o = ((size_t)c * 8 + head) * 8192 + p * 128 + 4 * n4;
            v2u w; w.x = pkbf(h.x, h.y); w.y = pkbf(h.z, h.w); *(GAS v2u*)(PREV + o) = w;
            const f32x4 sv = {bflo(s[c].x), bfhi(s[c].x), bflo(s[c].y), bfhi(s[c].y)};
            h = h * dec[c] + sv; }
    }
}
constexpr int S3_PV = P_BM, S3_PVH = 64 * SD_ROW, S3_Z = S3_PV + 2 * S3_PVH, S3_NG = P_FREE, S3_RSS = S3_NG + 1024;
static_assert(S3_Z + 128 * SD_ROW <= P_FREE && S3_RSS + 2048 <= P_DT && 128 * 528 <= P_DT, "SSD part 3 LDS");
__device__ __forceinline__ void ssd_out(Frame& F, int L, bool dummy = false) {
    GAS bf16* PROJ = (GAS bf16*)FB(BO_PROJ); const GAS bf16* PREV = (const GAS bf16*)FB(BO_PREV);
    const GAS float* d_skip = FIN(I_DSKIP) + L * 8; const GAS float* ssm_g = FIN(I_SSMG) + L * 512;
    LAS unsigned char* Cm = F.lds + P_CM; LAS unsigned char* Bm = F.lds + P_BM; LAS unsigned char* Zt = F.lds + S3_Z; const LAS unsigned char* XD = F.lds + P_XD;
    LAS float* dt_l = (LAS float*)(F.lds + P_DT); LAS float* acs_l = (LAS float*)(F.lds + P_ACS); LAS float* rss = (LAS float*)(F.lds + S3_RSS); LAS float* ng_l = (LAS float*)(F.lds + S3_NG);
    const int wave = F.wave, unit = F.li, c = unit >> 1, g = unit & 1, m0 = c * 128;
    int tid = F.tid; asm volatile("" : "+v"(tid));
    int lane = tid & 63, q = lane & 31, hh = lane >> 5;
    const float ng_in = ssm_g[g * 256 + (tid & 255)];
    v4u pw[4], zw[4];
#define S3_D1_LOAD_PZ(hp_) do { \
        _Pragma("unroll") for (int k = 0; k < 4; ++k) { const int ch = tid + NTHREADS * k; \
            { const int hd = ch >> 10, rem = ch & 1023, p = rem >> 4, n8 = rem & 15; pw[k] = *(const GAS v4u*)(PREV + ((size_t)c * 8 + 4 * g + 2 * (hp_) + hd) * 8192 + p * 128 + n8 * 8); } \
            { const int l = ch >> 4, c8 = ch & 15; zw[k] = *(const GAS v4u*)(PROJ + (size_t)(m0 + l) * PP + CZ + (4 * g + 2 * (hp_)) * 64 + c8 * 8); } } } while (0)
    S3_D1_LOAD_PZ(0);
    if (tid < 256) ng_l[tid] = ng_in;
    const int j = (wave < 4) ? (wave & 3) : 3 - (wave & 3), h2 = wave >> 2;
    f32x16 cbT[4]; bf16x8_t cf[8];
#pragma unroll
    for (int ks = 0; ks < 8; ++ks) cf[ks] = *(const LAS bf16x8_t*)(Cm + (32 * j + q) * SD_ROW + (16 * ks + 8 * hh) * 2);
#pragma unroll
    for (int i = 0; i < 4; ++i) { f32x16 acc = {};
        if (i <= j) {
#pragma unroll
            for (int ks = 0; ks < 8; ++ks) { const bf16x8_t bfr = *(const LAS bf16x8_t*)(Bm + (32 * i + q) * P_BSTR + (16 * ks + 8 * hh) * 2);
                acc = __builtin_amdgcn_mfma_f32_32x32x16_bf16(bfr, cf[ks], acc, 0, 0, 0); } }
        cbT[i] = acc; }
    unsigned vk[2][16];
#pragma unroll
    for (int hp = 0; hp < 2; ++hp) {
        __syncthreads();
        {
#pragma unroll
          for (int k = 0; k < 4; ++k) { const int ch = tid + NTHREADS * k;
              { const int hd = ch >> 10, rem = ch & 1023, p = rem >> 4, n8 = rem & 15; *(LAS v4u*)(F.lds + S3_PV + hd * S3_PVH + p * SD_ROW + n8 * 16) = pw[k]; }
              { const int l = ch >> 4, c8 = ch & 15; *(LAS v4u*)(Zt + l * SD_ROW + c8 * 16) = zw[k]; } } }
        LDS_WAIT(); __syncthreads();
        asm volatile("" : "+v"(tid)); lane = tid & 63; q = lane & 31; hh = lane >> 5;
        const int r = 2 * hp + h2, head = 4 * g + r;
        const LAS unsigned char* P1 = F.lds + S3_PV + h2 * S3_PVH;
        f32x16 O[2] = {{}, {}};
#pragma unroll
        for (int ks = 0; ks < 8; ++ks)
#pragma unroll
            for (int pt = 0; pt < 2; ++pt) { const bf16x8_t af = *(const LAS bf16x8_t*)(P1 + (32 * pt + q) * SD_ROW + (16 * ks + 8 * hh) * 2);
                O[pt] = __builtin_amdgcn_mfma_f32_32x32x16_bf16(af, cf[ks], O[pt], 0, 0, 0); }
        const float acl = acs_l[r * 128 + 32 * j + q], diag = d_skip[head] * __builtin_amdgcn_rcpf(dt_l[r * 128 + 32 * j + q]);
        { const float ea = __builtin_amdgcn_exp2f(acl);
#pragma unroll
          for (int pt = 0; pt < 2; ++pt)
#pragma unroll
              for (int e = 0; e < 16; ++e) O[pt][e] *= ea; }
        const int qm = q - 4 * hh;
#pragma unroll
        for (int i = 0; i < 4; ++i) { if (i <= j) {
            float xv[16];
            const LAS float* ap = acs_l + r * 128 + 32 * i + 4 * hh;
            float av[16];
#pragma unroll
            for (int e = 0; e < 16; ++e) av[e] = ap[(e & 3) + 8 * (e >> 2)];
            if (i < j) {
#pragma unroll
                for (int e = 0; e < 16; ++e) xv[e] = cbT[i][e] * __builtin_amdgcn_exp2f(acl - av[e]);
            } else {
#pragma unroll
                for (int e = 0; e < 16; ++e) { const int t0 = (e & 3) + 8 * (e >> 2);
                    const float m01 = (t0 <= qm) ? 1.0f : 0.0f, dg = (t0 == qm) ? diag : 0.0f;
                    xv[e] = cbT[i][e] * __builtin_amdgcn_exp2f(fminf(acl - av[e], 0.f)) * m01 + dg; } }
#pragma unroll
            for (int s2 = 0; s2 < 2; ++s2) { v4u w; w.x = pkbf(xv[8 * s2 + 0], xv[8 * s2 + 1]); w.y = pkbf(xv[8 * s2 + 2], xv[8 * s2 + 3]); w.z = pkbf(xv[8 * s2 + 4], xv[8 * s2 + 5]); w.w = pkbf(xv[8 * s2 + 6], xv[8 * s2 + 7]);
                const bf16x8_t xf = __builtin_bit_cast(bf16x8_t, w);
#pragma unroll
                for (int pt = 0; pt < 2; ++pt)
                    O[pt] = __builtin_amdgcn_mfma_f32_32x32x16_bf16(tr_frag<4, 8>(XD, P_XSTR, 32 * i + 16 * s2, 64 * r + 32 * pt, lane), xf, O[pt], 0, 0, 0); } } }
        if (hp == 0) S3_D1_LOAD_PZ(1);
        float ss = 0.f;
#pragma unroll
        for (int pt = 0; pt < 2; ++pt)
#pragma unroll
            for (int g4 = 0; g4 < 4; ++g4) { const int p = 32 * pt + 8 * g4 + 4 * hh;
                const v2u zz = *(const LAS v2u*)(Zt + (32 * j + q) * SD_ROW + (64 * h2 + p) * 2);
                const float u0 = O[pt][4 * g4] * silu_fast(bflo(zz.x)), u1 = O[pt][4 * g4 + 1] * silu_fast(bfhi(zz.x)), u2 = O[pt][4 * g4 + 2] * silu_fast(bflo(zz.y)), u3 = O[pt][4 * g4 + 3] * silu_fast(bfhi(zz.y));
                ss += (u0 * u0 + u1 * u1) + (u2 * u2 + u3 * u3);
                vk[hp][pt * 8 + g4 * 2] = pkbf(u0, u1); vk[hp][pt * 8 + g4 * 2 + 1] = pkbf(u2, u3); }
        ss += shx(ss, 32, lane);
        if (hh == 0) rss[r * 128 + 32 * j + q] = ss;
    }
#undef S3_D1_LOAD_PZ
    LDS_WAIT(); __syncthreads();
    asm volatile("" : "+v"(tid)); lane = tid & 63; q = lane & 31; hh = lane >> 5;
    { const int l = 32 * j + q; const float tot = (rss[l] + rss[128 + l]) + (rss[256 + l] + rss[384 + l]);
      const float rn = __builtin_amdgcn_rsqf(tot * (1.0f / 256.0f) + EPS);
      LAS unsigned char* Ot = F.lds;
#pragma unroll
      for (int hp = 0; hp < 2; ++hp) { const int r = 2 * hp + h2;
#pragma unroll
          for (int pt = 0; pt < 2; ++pt)
#pragma unroll
              for (int g4 = 0; g4 < 4; ++g4) { const int p = 32 * pt + 8 * g4 + 4 * hh;
                  const f32x4 ng = *(const LAS f32x4*)(ng_l + r * 64 + p);
                  const unsigned w0 = vk[hp][pt * 8 + g4 * 2], w1 = vk[hp][pt * 8 + g4 * 2 + 1];
                  v2u w; w.x = pkbf(bflo(w0) * rn * ng.x, bfhi(w0) * rn * ng.y); w.y = pkbf(bflo(w1) * rn * ng.z, bfhi(w1) * rn * ng.w);
                  *(LAS v2u*)(Ot + l * 528 + (r * 64 + p) * 2) = w; } } }
    LDS_WAIT(); __syncthreads();
    asm volatile("" : "+v"(tid));
#pragma unroll
    for (int k = 0; k < 8; ++k) { const int ch = tid + NTHREADS * k, l = ch >> 5, c8 = ch & 31;
        const v4u w = *(const LAS v4u*)(F.lds + l * 528 + c8 * 16);
        GAS bf16* orow = dummy ? (GAS bf16*)FB(BO_STATES) + (size_t)(m0 + l) * 512 : PROJ + (size_t)(m0 + l) * PP + CZ;
        *(GAS v4u*)(orow + g * 256 + c8 * 8) = w; }
}

__device__ __forceinline__ void ph_inproj(Frame& F, int L) {
    LAS float* rstd_tab = (LAS float*)(F.lds + RSTD_OFF);
    int li_ = F.li; asm volatile("" : "+s"(li_)); pg8::GroupOrder S; S.init(NPROJ, li_);
    const GAS f32x4* sp = (const GAS f32x4*)((const GAS float*)FWS(WS_SSQ) + ((size_t)F.b * SEQ + (li_ & 7) * 256 + (F.tid >> 1)) * 16 + (F.tid & 1) * 8);
    pg8::Gemm g{(const GAS bf16*)FWS(WS_XB) + (size_t)F.b * SEQ * D, (const GAS bf16*)FWS(WS_WIN) + (size_t)L * NPROJ * D, SEQ, NPROJ, D, D};
    pg8::EpiProj E{(GAS bf16*)FB(BO_PROJ), (GAS float*)FWS(WS_DTRAW) + (size_t)F.b * SEQ * 8, rstd_tab, sp[0], sp[1]};
    pg8::gemm_phase<pg8::EpiProj, pg8::GroupOrder, true, true>(F.lds + RING_OFF, g, S, E);
}
__device__ __forceinline__ void ph_outproj(Frame& F, int L, bool dummy = false) {
    int li_ = F.li; asm volatile("" : "+s"(li_)); pg8::GroupOrder S; S.init(D, li_);
    pg8::Gemm g{(const GAS bf16*)FB(BO_PROJ), (const GAS bf16*)FWS(WS_WOUT) + (size_t)L * D * D, SEQ, D, D, PP};
    GAS bf16* XBb = (GAS bf16*)FWS(WS_XB) + (size_t)F.b * SEQ * D;
    pg8::EpiRes<false> E{XBb, (GAS float*)FWS(WS_SSQ) + (size_t)F.b * SEQ * 16, nullptr, dummy ? (GAS bf16*)FB(BO_YPART) : XBb};
    pg8::gemm_phase<pg8::EpiRes<false>, pg8::GroupOrder, false, true>(F.lds + RING_OFF, g, S, E);
}
__device__ __forceinline__ void ph_up(Frame& F, int L) {
    LAS float* rstd_tab = (LAS float*)(F.lds + RSTD_OFF);
    int li_ = F.li; asm volatile("" : "+s"(li_)); pg8::GroupOrder S; S.init(FF, li_);
    const GAS f32x4* sp = (const GAS f32x4*)((const GAS float*)FWS(WS_SSQ) + ((size_t)F.b * SEQ + (li_ & 7) * 256 + (F.tid >> 1)) * 16 + (F.tid & 1) * 8);
    pg8::Gemm g{(const GAS bf16*)FWS(WS_XB) + (size_t)F.b * SEQ * D, (const GAS bf16*)FWS(WS_WUP) + (size_t)L * FF * D, SEQ, FF, D, D};
    pg8::EpiUp E{(GAS bf16*)FB(BO_HID), FF, rstd_tab, sp[0], sp[1]};
    pg8::gemm_phase<pg8::EpiUp, pg8::GroupOrder, true, true>(F.lds + RING_OFF, g, S, E);
}
__device__ __forceinline__ void ph_down(Frame& F, int L, bool dummy = false) {
    int li_ = F.li; asm volatile("" : "+s"(li_)); pg8::GroupOrder S; S.init(D, li_);
    pg8::Gemm g{(const GAS bf16*)FB(BO_HID), (const GAS bf16*)FWS(WS_WDOWN) + (size_t)L * D * FF, SEQ, D, FF, FF};
    GAS bf16* XBb = (GAS bf16*)FWS(WS_XB) + (size_t)F.b * SEQ * D; GAS float* SSQb = (GAS float*)FWS(WS_SSQ) + (size_t)F.b * SEQ * 16;
    if (L == DEPTH - 1 && !dummy) { pg8::EpiRes<true> E{XBb, SSQb, (GAS float*)ptr_at(F, I_OUT) + (size_t)F.b * SEQ * D, XBb};
        pg8::gemm_phase<pg8::EpiRes<true>, pg8::GroupOrder, false, true>(F.lds + RING_OFF, g, S, E); }
    else { pg8::EpiRes<false> E{XBb, SSQb, nullptr, dummy ? (GAS bf16*)FB(16 * MiB) : XBb};
        pg8::gemm_phase<pg8::EpiRes<false>, pg8::GroupOrder, false, true>(F.lds + RING_OFF, g, S, E); }
}

#ifndef PROBE_REP
#define PROBE_REP 0
#endif
struct Args { const float* in[17]; float* out; unsigned char* ws; int pad0, pad1; };
__global__ void __launch_bounds__(NTHREADS, 2) fwd(Args args) {
    extern __shared__ __attribute__((aligned(16))) unsigned char lds[];
    Frame F;
    F.lds = (LAS unsigned char*)lds;
    F.tid = threadIdx.x; F.lane = F.tid & 63; F.wave = __builtin_amdgcn_readfirstlane(F.tid >> 6); F.bid = blockIdx.x; F.G = gridDim.x; F.b = F.bid & 7; F.li = F.bid >> 3;
    for (int u = F.tid; u < (LDS_BYTES - LDSCTL_OFF) / 4; u += NTHREADS) ((LAS unsigned*)(F.lds + LDSCTL_OFF))[u] = 0u;
    __syncthreads();
    if (F.tid < I_NPTR) { const unsigned long long p = F.tid < 17 ? (unsigned long long)args.in[F.tid < 17 ? F.tid : 0] : (F.tid == I_OUT ? (unsigned long long)args.out : (unsigned long long)args.ws);
        LAS unsigned* t = (LAS unsigned*)(F.lds + PTR_OFF) + 2 * F.tid; t[0] = (unsigned)p; t[1] = (unsigned)(p >> 32); }
    LDS_WAIT(); __syncthreads();
    if (F.G != GRID) return;
#define GBAR_OBJ() XcdBarrier{(unsigned*)(unsigned char*)FWS(WS_CTL) + CW_BAR, xb_xcc_id(), (unsigned)GRID, (volatile LAS unsigned*)(F.lds + MISC_OFF) + 8}
#define GRP_OBJ()  XcdBarrier{(unsigned*)(unsigned char*)FWS(WS_CTL) + CW_GRP + (blockIdx.x & 7) * GRP_BAR_STRIDE, xb_xcc_id(), (unsigned)GRP, (volatile LAS unsigned*)(F.lds + MISC_OFF) + 12}
    (void)xcd_barrier_post((unsigned*)(unsigned char*)FWS(WS_CTL) + CW_BAR, (volatile LAS unsigned*)(F.lds + MISC_OFF) + 8, GRID);
    (void)xcd_barrier_post((unsigned*)(unsigned char*)FWS(WS_CTL) + CW_GRP + (blockIdx.x & 7) * GRP_BAR_STRIDE, (volatile LAS unsigned*)(F.lds + MISC_OFF) + 12, GRP);
#define RELAUNDER() do { int t_ = threadIdx.x; asm volatile("" : "+v"(t_)); F.tid = t_; F.lane = t_ & 63; F.wave = __builtin_amdgcn_readfirstlane(t_ >> 6); \
    int b_ = blockIdx.x; asm volatile("" : "+s"(b_)); F.bid = b_; F.b = b_ & 7; F.li = b_ >> 3; } while (0)
#define GRP_BAR() do { const XcdBarrier gb_ = GRP_OBJ(); xcd_barrier(gb_); } while (0)
#define GRID_BAR() do { const XcdBarrier gb_ = GBAR_OBJ(); xcd_barrier(gb_); } while (0)

    p0_prologue(F);
    if (PROBE_REP == 1) { GRID_BAR(); RELAUNDER(); p0_prologue(F); }
    GRID_BAR();
    for (int L = 0; L < DEPTH; ++L) {
        RELAUNDER(); ph_inproj(F, L); if (PROBE_REP == 2) { GRP_BAR(); RELAUNDER(); ph_inproj(F, L); }
        if (F.li >= 16) { RELAUNDER(); convert_rest(F, L); }
        GRP_BAR();
        RELAUNDER(); if (PROBE_REP == 20) { attn_fast(F, L, true); GRP_BAR(); RELAUNDER(); }
        if (PROBE_REP == 25) {
#pragma unroll 1
            for (int rep = 0; rep < 2; ++rep) { attn_fast(F, L, rep == 0); if (rep == 0) { GRP_BAR(); RELAUNDER(); } } }
        else attn_fast(F, L);
        ssd_states(F, L); if (PROBE_REP == 21) { GRP_BAR(); RELAUNDER(); ssd_states(F, L); } GRP_BAR();
        RELAUNDER(); ssd_scan(F, L); if (PROBE_REP == 22) { GRP_BAR(); RELAUNDER(); ssd_scan(F, L); } if (PROBE_REP == 24) { for (int k = 0; k < 8; ++k) GRP_BAR(); } GRP_BAR();
        RELAUNDER(); if (PROBE_REP == 23) { ssd_out(F, L, true); GRP_BAR(); RELAUNDER(); } ssd_out(F, L); GRP_BAR();
        RELAUNDER(); wait_weights(F, L); if (PROBE_REP == 30) { ph_outproj(F, L, true); GRP_BAR(); RELAUNDER(); } ph_outproj(F, L); GRP_BAR();
        RELAUNDER(); ph_up(F, L); if (PROBE_REP == 5) { GRP_BAR(); RELAUNDER(); ph_up(F, L); } GRP_BAR();
        RELAUNDER(); if (PROBE_REP == 31) { ph_down(F, L, true); GRP_BAR(); RELAUNDER(); } ph_down(F, L); if (L + 1 < DEPTH) GRP_BAR();
    }
}

extern "C" void kernel_launch(void* const* d_in, const int* in_sizes, int n_in, void* d_out, int out_size, void* d_ws, size_t ws_size, hipStream_t stream) {
    static int grid = 0;
    if (grid == 0) {
        if (n_in != 17 || in_sizes[0] != M * D || out_size != M * D || ws_size < WS_END) { fprintf(stderr, "kernel_launch: unexpected shapes (n_in %d, in0 %d, out %d, ws %zu)\n", n_in, n_in > 0 ? in_sizes[0] : -1, out_size, ws_size); grid = -1; return; }
        int dev = 0, cus = 0, per_cu = 0;
        if (hipGetDevice(&dev) != hipSuccess || hipDeviceGetAttribute(&cus, hipDeviceAttributeMultiprocessorCount, dev) != hipSuccess) { grid = -1; return; }
        if (hipFuncSetAttribute((const void*)fwd, hipFuncAttributeMaxDynamicSharedMemorySize, LDS_BYTES) != hipSuccess) { fprintf(stderr, "kernel_launch: hipFuncSetAttribute failed\n"); grid = -1; return; }
        if (hipOccupancyMaxActiveBlocksPerMultiprocessor(&per_cu, (const void*)fwd, NTHREADS, LDS_BYTES) != hipSuccess || per_cu < 1) { fprintf(stderr, "kernel_launch: occupancy query says %d\n", per_cu); per_cu = 0; }
        (void)hipGetLastError();
        if (cus * per_cu < GRID) { fprintf(stderr, "kernel_launch: this kernel needs %d co-resident workgroups (one per CU of a 256-CU device); the device admits %d x %d; nothing launched\n", GRID, cus, per_cu); grid = -1; return; }
        grid = GRID;
    }
    if (grid < 0) return;
    (void)hipMemsetAsync((char*)d_ws + WS_CTL, 0, CTL_ZERO_BYTES, stream);
    Args a{};
    for (int i = 0; i < 17; ++i) a.in[i] = (const float*)d_in[i];
    a.out = (float*)d_out; a.ws = (unsigned char*)d_ws;
    void* kargs[] = {&a};
    hipError_t e = hipLaunchCooperativeKernel((const void*)fwd, dim3(grid), dim3(NTHREADS), kargs, LDS_BYTES, stream);
    if (e != hipSuccess) fprintf(stderr, "kernel_launch: cooperative launch failed: %s (grid %d)\n", hipGetErrorString(e), grid);
}
```

```cpp
#include <hip/hip_runtime.h>
#include <cstdio>
#include <cstdint>
#define PROBE_REP 0


namespace pg8 {
#define PG8_LAS __attribute__((address_space(3)))
#define PG8_GAS __attribute__((address_space(1)))
typedef unsigned short bf16_t;
typedef short bf16x8 __attribute__((ext_vector_type(8)));
typedef float f32x4 __attribute__((ext_vector_type(4)));
typedef unsigned u32x4 __attribute__((ext_vector_type(4)));
constexpr int BM = 256, BK = 64, HALF = 128, HTB = HALF * BK * 2  , STAGE_BYTES = 8 * HTB, NXCD = 8, WGM = 8;

__host__ __device__ __forceinline__ int lds_byte(int r, int c) { const int st = (r >> 4) * 2 + (c >> 5), rr = r & 15, cc = c & 31, ob = rr * 64 + cc * 2; return st * 1024 + (ob ^ (((ob >> 9) & 1) << 5)); }
__host__ __device__ __forceinline__ void stage_rc(int b, int& R, int& C) { const int st = b / 1024, sb = b % 1024, swz = sb ^ (((sb >> 9) & 1) << 5); R = (st >> 1) * 16 + swz / 64; C = (st & 1) * 32 + (swz % 64) / 2; }
__host__ __device__ __forceinline__ int perm32(int rho) { const int n = rho >> 4, i = rho & 15; return 8 * (i >> 2) + 4 * n + (i & 3); }

struct Unit { int pm, pn; };
struct Gemm { const PG8_GAS bf16_t* A; const PG8_GAS bf16_t* Bt; int M, N, K, lda; };

struct StaticOrder {
    int nM, nN, nwg, G, c;
    __host__ __device__ void init(int M, int N, int G_, int c_) { nM = M / BM; nN = N / BM; nwg = nM * nN; G = G_; c = c_; }
    __host__ __device__ bool next(int i, Unit& u) const {
        const long L = (long)i * G + c; if (L >= nwg) return false;
        int wgid = (int)L; { const int q = nwg / NXCD, r = nwg % NXCD, xcd = wgid % NXCD, off = wgid / NXCD; wgid = (xcd < r ? xcd * (q + 1) : r * (q + 1) + (xcd - r) * q) + off; }
        const int nig = WGM * nN, gid = wgid / nig, fm = gid * WGM, gsz = (nM - fm) < WGM ? (nM - fm) : WGM;
        u.pm = fm + ((wgid % nig) % gsz); u.pn = (wgid % nig) / gsz; return true;
    }
    __device__ __forceinline__ void a_ready(const Unit&) const {}
    __device__ __forceinline__ void done(const Unit&) const {}
};

struct GroupOrder {
    int nN, li;
    __host__ __device__ void init(int N, int li_) { nN = N / BM; li = li_; }
    __host__ __device__ bool next(int i, Unit& u) const { const int T = i * 32 + li; if (T >= 8 * nN) return false; u.pm = T & 7; u.pn = T >> 3; return true; }
    __device__ __forceinline__ void a_ready(const Unit&) const {}
    __device__ __forceinline__ void done(const Unit&) const {}
};

__device__ __forceinline__ float shx(float v, int k, int lane) { return __builtin_bit_cast(float, __builtin_amdgcn_ds_bpermute((lane ^ k) << 2, __builtin_bit_cast(int, v))); }
typedef float f32x2_t __attribute__((ext_vector_type(2))); typedef __bf16 bf16x2_t __attribute__((ext_vector_type(2)));
__device__ __forceinline__ unsigned cvt_pk_bf16(float lo, float hi) { f32x2_t v = {lo, hi}; bf16x2_t b = __builtin_convertvector(v, bf16x2_t); return __builtin_bit_cast(unsigned, b); }

constexpr int PROJ_PITCH = 2304, DT_TILE = 9;
struct EpiProj {
    static constexpr bool PERM = true, AFTER_DRAIN = false, ACC_INIT = false, PRE_HOOK = true;
    PG8_GAS bf16_t* O; PG8_GAS float* dtraw; PG8_LAS float* rstd; f32x4 pa, pb;
    __device__ __forceinline__ void pre(int tid) const {
        float s = (pa[0] + pa[1]) + (pa[2] + pa[3]) + (pb[0] + pb[1]) + (pb[2] + pb[3]);
        s += shx(s, 1, tid & 63);
        if ((tid & 1) == 0) rstd[tid >> 1] = 1.0f / sqrtf(s * (1.0f / 1024.0f) + 1e-6f);
    }
    __device__ __forceinline__ void operator()(const f32x4 (&acc)[2][2][4][2], const Unit& u, int ui, int wr, int wc, int fr, int fq) const {
        int rt0 = wr * 64 + fr; asm volatile("" : "+v"(rt0));
        if (u.pn == DT_TILE) {
            if (wc == 0 && fq == 0) {
#pragma unroll
                for (int ai = 0; ai < 2; ++ai)
#pragma unroll
                    for (int m = 0; m < 4; ++m) { const int rt = ai * HALF + rt0 + m * 16; const float rs = rstd[rt]; PG8_GAS float* p = dtraw + (size_t)(u.pm * BM + rt) * 8;
                        *(PG8_GAS f32x4*)p = acc[ai][0][m][0] * rs; *(PG8_GAS f32x4*)(p + 4) = acc[ai][0][m][1] * rs; }
            }
            return;
        }
        const int col0 = u.pn * BM + wc * 32 + 8 * fq;
#pragma unroll
        for (int ai = 0; ai < 2; ++ai)
#pragma unroll
            for (int m = 0; m < 4; ++m) { const int rt = ai * HALF + rt0 + m * 16; const float rs = rstd[rt]; PG8_GAS bf16_t* rowp = O + (size_t)(u.pm * BM + rt) * PROJ_PITCH + col0;
#pragma unroll
                for (int bj = 0; bj < 2; ++bj) { const f32x4 v0 = acc[ai][bj][m][0] * rs, v1 = acc[ai][bj][m][1] * rs;
                    u32x4 w; w.x = cvt_pk_bf16(v0[0], v0[1]); w.y = cvt_pk_bf16(v0[2], v0[3]); w.z = cvt_pk_bf16(v1[0], v1[1]); w.w = cvt_pk_bf16(v1[2], v1[3]);
                    *(PG8_GAS u32x4*)(rowp + bj * HALF) = w; } }
    }
};
struct EpiUp {
    static constexpr bool PERM = true, AFTER_DRAIN = false, ACC_INIT = false, PRE_HOOK = true;
    PG8_GAS bf16_t* O; int ldc; PG8_LAS float* rstd; f32x4 pa, pb;
    __device__ __forceinline__ void pre(int tid) const {
        float s = (pa[0] + pa[1]) + (pa[2] + pa[3]) + (pb[0] + pb[1]) + (pb[2] + pb[3]);
        s += shx(s, 1, tid & 63);
        if ((tid & 1) == 0) rstd[tid >> 1] = 1.0f / sqrtf(s * (1.0f / 1024.0f) + 1e-6f);
    }
    __device__ __forceinline__ void operator()(const f32x4 (&acc)[2][2][4][2], const Unit& u, int ui, int wr, int wc, int fr, int fq) const {
        int rt0 = wr * 64 + fr; asm volatile("" : "+v"(rt0)); const int col0 = u.pn * BM + wc * 32 + 8 * fq;
#pragma unroll
        for (int ai = 0; ai < 2; ++ai)
#pragma unroll
            for (int m = 0; m < 4; ++m) { const int rt = ai * HALF + rt0 + m * 16; const float rs = rstd[rt]; PG8_GAS bf16_t* rowp = O + (size_t)(u.pm * BM + rt) * ldc + col0;
#pragma unroll
                for (int bj = 0; bj < 2; ++bj) { f32x4 v0 = acc[ai][bj][m][0] * rs, v1 = acc[ai][bj][m][1] * rs;
#pragma unroll
                    for (int e = 0; e < 4; ++e) { const float a = fmaxf(v0[e], 0.f), b = fmaxf(v1[e], 0.f); v0[e] = a * a; v1[e] = b * b; }
                    u32x4 w; w.x = cvt_pk_bf16(v0[0], v0[1]); w.y = cvt_pk_bf16(v0[2], v0[3]); w.z = cvt_pk_bf16(v1[0], v1[1]); w.w = cvt_pk_bf16(v1[2], v1[3]);
                    *(PG8_GAS u32x4*)(rowp + bj * HALF) = w; } }
    }
};
template <bool FINAL> struct EpiRes {
    static constexpr bool PERM = true, AFTER_DRAIN = false, ACC_INIT = true, PRE_HOOK = false;
    PG8_GAS bf16_t* xb; PG8_GAS float* ssq; PG8_GAS float* out; PG8_GAS bf16_t* xdst;
    __device__ __forceinline__ void init(f32x4 (&acc)[2][2][4][2], const Unit& u, int wr, int wc, int fr, int fq) const {
        const int rt0 = wr * 64 + fr, col0 = u.pn * BM + wc * 32 + 8 * fq;
#pragma unroll
        for (int ai = 0; ai < 2; ++ai)
#pragma unroll
            for (int m = 0; m < 4; ++m) { const int row = u.pm * BM + ai * HALF + rt0 + m * 16; const size_t off = (size_t)row * 1024 + col0;
#pragma unroll
                for (int bj = 0; bj < 2; ++bj) { const u32x4 rw = *(const PG8_GAS u32x4*)(xb + off + bj * HALF);
                    acc[ai][bj][m][0] = (f32x4){__uint_as_float(rw.x << 16), __uint_as_float(rw.x & 0xffff0000u), __uint_as_float(rw.y << 16), __uint_as_float(rw.y & 0xffff0000u)};
                    acc[ai][bj][m][1] = (f32x4){__uint_as_float(rw.z << 16), __uint_as_float(rw.z & 0xffff0000u), __uint_as_float(rw.w << 16), __uint_as_float(rw.w & 0xffff0000u)}; } }
    }
    __device__ __forceinline__ void operator()(const f32x4 (&acc)[2][2][4][2], const Unit& u, int ui, int wr, int wc, int fr, int fq) const {
        int rt0 = wr * 64 + fr; asm volatile("" : "+v"(rt0)); const int col0 = u.pn * BM + wc * 32 + 8 * fq;
#pragma unroll
        for (int ai = 0; ai < 2; ++ai)
#pragma unroll
            for (int m = 0; m < 4; ++m) { const int row = u.pm * BM + ai * HALF + rt0 + m * 16; const size_t off = (size_t)row * 1024 + col0; float s = 0.f;
#pragma unroll
                for (int bj = 0; bj < 2; ++bj) { const f32x4 v0 = acc[ai][bj][m][0], v1 = acc[ai][bj][m][1];
                    if (FINAL) { *(PG8_GAS f32x4*)(out + off + bj * HALF) = v0; *(PG8_GAS f32x4*)(out + off + bj * HALF + 4) = v1; }
                    else { u32x4 w; w.x = cvt_pk_bf16(v0[0], v0[1]); w.y = cvt_pk_bf16(v0[2], v0[3]); w.z = cvt_pk_bf16(v1[0], v1[1]); w.w = cvt_pk_bf16(v1[2], v1[3]);
                        *(PG8_GAS u32x4*)(xdst + off + bj * HALF) = w;
                        s += (v0[0] * v0[0] + v0[1] * v0[1]) + (v0[2] * v0[2] + v0[3] * v0[3]) + (v1[0] * v1[0] + v1[1] * v1[1]) + (v1[2] * v1[2] + v1[3] * v1[3]); } }
                if (!FINAL) { const int ln = fq * 16 + fr; s += shx(s, 16, ln); s += shx(s, 32, ln);
                    if (fq == 0) ssq[(size_t)row * 16 + u.pn * 4 + wc] = s; } }
    }
};

template <class Epi, class Sched, bool ALIGN_EPI = false, bool SP2 = false>
__device__ __forceinline__ void gemm_phase(PG8_LAS unsigned char* lds, const Gemm g, const Sched& S, const Epi& E) {
    int tid_ = threadIdx.x; asm volatile("" : "+v"(tid_));
    const int tid = tid_, wid = __builtin_amdgcn_readfirstlane(tid >> 6), lane = tid & 63, wr = wid >> 2, wc = wid & 3, fr = lane & 15, fq = lane >> 4;
    const int K = g.K, nt = K / BK;
    unsigned voffA[2], voffB[2];
#pragma unroll
    for (int i = 0; i < 2; ++i) { int R, C; stage_rc(tid * 16 + i * 8192, R, C); const int Rb = Epi::PERM ? ((R & ~31) + perm32(R & 31)) : R;
        voffA[i] = (unsigned)(R * g.lda + C) * 2u; voffB[i] = (unsigned)(Rb * K + C) * 2u; }
    const size_t kstep = (size_t)(BK * 2);
    const size_t hstepA = (size_t)HALF * g.lda * 2, hstepB = (size_t)HALF * K * 2;
    const size_t tstepA = 2 * hstepA, tstepB = 2 * hstepB;
    const unsigned ldsw = (unsigned)wid * 1024u;
    const int aoff = lds_byte(wr * 64 + fr, fq * 8), boff = lds_byte(wc * 32 + fr, fq * 8);
#define PG8_SA(b, h) (((b) * 2 + (h)) * HTB)
#define PG8_SB(b, h) ((4 + (b) * 2 + (h)) * HTB)
#define PG8_STAGE(bufoff, gbase, voff) do { _Pragma("unroll") for (int _i = 0; _i < 2; ++_i) \
        __builtin_amdgcn_global_load_lds((const unsigned*)((const char*)(gbase) + (voff)[_i]), (PG8_LAS unsigned*)(lds + (bufoff) + ldsw + _i * 8192), 16, 0, 0); } while (0)
#define PG8_LDA(dst, b, h) do { _Pragma("unroll") for (int m = 0; m < 4; ++m) _Pragma("unroll") for (int k = 0; k < 2; ++k) dst[m][k] = *(const PG8_LAS bf16x8*)(lds + PG8_SA(b, h) + aoff + m * 2048 + k * 1024); } while (0)
#define PG8_LDB(dst, b, h) do { _Pragma("unroll") for (int n = 0; n < 2; ++n) _Pragma("unroll") for (int k = 0; k < 2; ++k) dst[n][k] = *(const PG8_LAS bf16x8*)(lds + PG8_SB(b, h) + boff + n * 2048 + k * 1024); } while (0)
#define PG8_MMA(ai, bj, At, Bt) do { __builtin_amdgcn_s_setprio(1); _Pragma("unroll") for (int m = 0; m < 4; ++m) _Pragma("unroll") for (int n = 0; n < 2; ++n) _Pragma("unroll") for (int k = 0; k < 2; ++k) \
        acc[ai][bj][m][n] = __builtin_amdgcn_mfma_f32_16x16x32_bf16(Bt[n][k], At[m][k], acc[ai][bj][m][n], 0, 0, 0); __builtin_amdgcn_s_setprio(0); } while (0)
#define PG8_WAIT_V(n) asm volatile("s_waitcnt vmcnt(" #n ")" ::: "memory")
#define PG8_WAIT_L(n) asm volatile("s_waitcnt lgkmcnt(" #n ")" ::: "memory")
#define PG8_BAR __builtin_amdgcn_s_barrier()
#define PG8_SCHED __builtin_amdgcn_sched_barrier(0)
    Unit cur, nxt; int ui = 0;
    if (!S.next(0, cur)) return;
    f32x4 acc[2][2][4][2];
#pragma unroll
    for (int a = 0; a < 2; ++a)
#pragma unroll
        for (int b = 0; b < 2; ++b)
#pragma unroll
            for (int m = 0; m < 4; ++m)
#pragma unroll
                for (int n = 0; n < 2; ++n) acc[a][b][m][n] = (f32x4){0.f, 0.f, 0.f, 0.f};
    if constexpr (Epi::ACC_INIT) E.init(acc, cur, wr, wc, fr, fq);
    bf16x8 At[4][2], B0[2][2], B1[2][2];
    const char* cA = (const char*)g.A + (size_t)cur.pm * tstepA; const char* cB = (const char*)g.Bt + (size_t)cur.pn * tstepB;
    S.a_ready(cur);
    if constexpr (SP2) {
        PG8_STAGE(PG8_SB(0, 0), cB, voffB); PG8_STAGE(PG8_SB(0, 1), cB + hstepB, voffB); PG8_STAGE(PG8_SA(0, 0), cA, voffA); PG8_STAGE(PG8_SA(0, 1), cA + hstepA, voffA);
        if constexpr (Epi::PRE_HOOK) E.pre(tid);
        if (wr == 1) PG8_BAR;
        PG8_WAIT_V(2); PG8_BAR;
        PG8_STAGE(PG8_SB(1, 0), cB + kstep, voffB); PG8_STAGE(PG8_SA(1, 0), cA + kstep, voffA); PG8_STAGE(PG8_SB(1, 1), cB + hstepB + kstep, voffB);
        PG8_WAIT_V(6); PG8_BAR;
    } else {
        PG8_STAGE(PG8_SB(0, 0), cB, voffB); PG8_STAGE(PG8_SA(0, 0), cA, voffA); PG8_STAGE(PG8_SB(0, 1), cB + hstepB, voffB); PG8_STAGE(PG8_SA(0, 1), cA + hstepA, voffA);
        if (wr == 1) PG8_BAR;
        PG8_WAIT_V(4); PG8_BAR;
        PG8_STAGE(PG8_SB(1, 0), cB + kstep, voffB); PG8_STAGE(PG8_SA(1, 0), cA + kstep, voffA); PG8_STAGE(PG8_SB(1, 1), cB + hstepB + kstep, voffB);
        PG8_WAIT_V(6); PG8_BAR;
    }
    for (;;) {
        const bool has_next = S.next(ui + 1, nxt);
        const char* nA = has_next ? (const char*)g.A + (size_t)nxt.pm * tstepA : cA; const char* nB = has_next ? (const char*)g.Bt + (size_t)nxt.pn * tstepB : cB;
        for (int t = 0; t < nt; t += 2) {
            const bool last = (t == nt - 2);
            const char* a1 = cA + (size_t)(t + 1) * kstep;
            const char* a2 = last ? nA : cA + (size_t)(t + 2) * kstep; const char* b2 = last ? nB : cB + (size_t)(t + 2) * kstep;
            const char* a3 = a2 + kstep; const char* b3 = b2 + kstep;
            if (last && has_next) S.a_ready(nxt);
            if constexpr (SP2) {
            PG8_LDB(B0, 0, 0); PG8_LDB(B1, 0, 1); PG8_SCHED; PG8_LDA(At, 0, 0); PG8_STAGE(PG8_SA(1, 1), a1 + hstepA, voffA);
            PG8_WAIT_V(8); PG8_WAIT_L(0); PG8_BAR; PG8_MMA(0, 0, At, B0); PG8_MMA(0, 1, At, B1); PG8_BAR; PG8_SCHED;
            PG8_LDA(At, 0, 1); PG8_STAGE(PG8_SB(0, 0), b2, voffB); PG8_STAGE(PG8_SB(0, 1), b2 + hstepB, voffB); PG8_STAGE(PG8_SA(0, 0), a2, voffA);
            PG8_WAIT_V(8); PG8_WAIT_L(0); PG8_BAR; PG8_MMA(1, 0, At, B0); PG8_MMA(1, 1, At, B1); PG8_BAR; PG8_SCHED;
            PG8_LDB(B0, 1, 0); PG8_LDB(B1, 1, 1); PG8_SCHED; PG8_LDA(At, 1, 0); PG8_STAGE(PG8_SA(0, 1), a2 + hstepA, voffA);
            PG8_WAIT_V(8); PG8_WAIT_L(0); PG8_BAR; PG8_MMA(0, 0, At, B0); PG8_MMA(0, 1, At, B1); PG8_BAR; PG8_SCHED;
            PG8_LDA(At, 1, 1); PG8_STAGE(PG8_SB(1, 0), b3, voffB); PG8_STAGE(PG8_SB(1, 1), b3 + hstepB, voffB); PG8_STAGE(PG8_SA(1, 0), a3, voffA);
            PG8_WAIT_V(8); PG8_WAIT_L(0); PG8_BAR; PG8_MMA(1, 0, At, B0); PG8_MMA(1, 1, At, B1); PG8_BAR; PG8_SCHED;
            } else {
            PG8_LDB(B0, 0, 0); PG8_SCHED; PG8_LDA(At, 0, 0); PG8_STAGE(PG8_SA(1, 1), a1 + hstepA, voffA);
            PG8_WAIT_L(8); PG8_BAR; PG8_WAIT_L(0); PG8_MMA(0, 0, At, B0); PG8_BAR; PG8_SCHED;
            PG8_LDB(B1, 0, 1); PG8_STAGE(PG8_SB(0, 0), b2, voffB);
            PG8_BAR; PG8_WAIT_L(0); PG8_MMA(0, 1, At, B1); PG8_BAR;
            PG8_LDA(At, 0, 1); PG8_STAGE(PG8_SA(0, 0), a2, voffA);
            PG8_BAR; PG8_WAIT_L(0); PG8_MMA(1, 0, At, B0); PG8_BAR; PG8_SCHED;
            PG8_STAGE(PG8_SB(0, 1), b2 + hstepB, voffB);
            PG8_WAIT_V(6); PG8_BAR; PG8_MMA(1, 1, At, B1); PG8_BAR;
            PG8_LDB(B0, 1, 0); PG8_SCHED; PG8_LDA(At, 1, 0); PG8_STAGE(PG8_SA(0, 1), a2 + hstepA, voffA);
            PG8_WAIT_L(8); PG8_BAR; PG8_WAIT_L(0); PG8_MMA(0, 0, At, B0); PG8_BAR; PG8_SCHED;
            PG8_LDB(B1, 1, 1); PG8_STAGE(PG8_SB(1, 0), b3, voffB);
            PG8_BAR; PG8_WAIT_L(0); PG8_MMA(0, 1, At, B1); PG8_BAR;
            PG8_LDA(At, 1, 1); PG8_STAGE(PG8_SA(1, 0), a3, voffA);
            PG8_BAR; PG8_WAIT_L(0); PG8_MMA(1, 0, At, B0); PG8_BAR; PG8_SCHED;
            PG8_STAGE(PG8_SB(1, 1), b3 + hstepB, voffB);
            PG8_WAIT_V(6); PG8_BAR; PG8_MMA(1, 1, At, B1); PG8_BAR;
            }
        }
        if constexpr (ALIGN_EPI) { if (wr == 0) PG8_BAR; }
        if constexpr (!Epi::AFTER_DRAIN) { E(acc, cur, ui, wr, wc, fr, fq); S.done(cur); }
        if (!has_next) break;
#pragma unroll
        for (int a = 0; a < 2; ++a)
#pragma unroll
            for (int b = 0; b < 2; ++b)
#pragma unroll
                for (int m = 0; m < 4; ++m)
#pragma unroll
                    for (int n = 0; n < 2; ++n) acc[a][b][m][n] = (f32x4){0.f, 0.f, 0.f, 0.f};
        cur = nxt; cA = nA; cB = nB; ++ui;
        if constexpr (ALIGN_EPI) { if (wr == 1) PG8_BAR; }
    }
    PG8_WAIT_V(0);
    if constexpr (!ALIGN_EPI) { if (wr == 0) PG8_BAR; }
    PG8_BAR;

#undef PG8_SA
#undef PG8_SB
#undef PG8_STAGE
#undef PG8_LDA
#undef PG8_LDB
#undef PG8_MMA
#undef PG8_WAIT_V
#undef PG8_WAIT_L
#undef PG8_BAR
#undef PG8_SCHED
}
}

constexpr int NWAVES = 8, NTHREADS = NWAVES * 64;
constexpr int BATCH = 8, SEQ = 2048, D = 1024, M = BATCH * SEQ, FF = 4096, DEPTH = 2;
constexpr int D_IN = 2312, NPROJ = 2560, PP = pg8::PROJ_PITCH;
constexpr int CQ = 0, CZ = 512, CK = 1024, CV = 1152, CX = 1280, CBM = 1792, CCM = 2048;
constexpr float EPS = 1e-6f;
constexpr int GRID = 256, NGRP = 8, GRP = GRID / NGRP;

constexpr size_t MiB = 1u << 20;
constexpr size_t WS_CTL = 0, CTL_ZERO_BYTES = 1 * MiB;
constexpr size_t WS_SSQ = 1 * MiB;
constexpr size_t WS_DTRAW = 2 * MiB;
constexpr size_t WS_ACS = 2 * MiB + 512 * 1024, WS_CHDEC = 3 * MiB;
constexpr size_t WS_WIN = 4 * MiB, WS_WOUT = 14 * MiB, WS_WUP = 18 * MiB, WS_WDOWN = 34 * MiB;
constexpr size_t WS_XB = 50 * MiB;
constexpr size_t WS_BATCH0 = 82 * MiB, BATCH_STRIDE = 20 * MiB;
constexpr size_t BO_PROJ = 0;
constexpr size_t BO_STATES = 9 * MiB;
constexpr size_t BO_PREV = 13 * MiB;
constexpr size_t BO_YPART = 15 * MiB;
constexpr size_t BO_CC = 19 * MiB;
constexpr size_t BO_HID = 0;
constexpr size_t WS_END = WS_BATCH0 + BATCH * BATCH_STRIDE;
static_assert(WS_END <= 256 * MiB, "d_ws map");
constexpr int CW_BAR = 4096, CW_GRP = 16384, GRP_BAR_STRIDE = 4096;

constexpr int RING_OFF = 0, RING_BYTES = 131072;
constexpr int MIX_BYTES = 155648;
constexpr int LDSCTL_OFF = MIX_BYTES, MISC_OFF = LDSCTL_OFF + 320, RSTD_OFF = LDSCTL_OFF + 512, PTR_OFF = RSTD_OFF + 4096;
constexpr int LDS_BYTES = 163840;
static_assert(PTR_OFF + 512 <= LDS_BYTES && RING_BYTES <= MIX_BYTES, "LDS map");

#define GAS __attribute__((address_space(1)))
#define LAS __attribute__((address_space(3)))
typedef unsigned short bf16;
typedef unsigned v4u __attribute__((ext_vector_type(4)));
typedef unsigned v2u __attribute__((ext_vector_type(2)));
typedef float f32x4 __attribute__((ext_vector_type(4)));
#define LDS_WAIT() asm volatile("s_waitcnt lgkmcnt(0)" ::: "memory")
#define VM_WAIT() asm volatile("s_waitcnt vmcnt(0)" ::: "memory")
__device__ __forceinline__ unsigned f2bf(float f) { unsigned u = __builtin_bit_cast(unsigned, f); return (u + 0x7fffu + ((u >> 16) & 1u)) >> 16; }
__device__ __forceinline__ unsigned pk2(float lo, float hi) { return f2bf(lo) | (f2bf(hi) << 16); }
__device__ __forceinline__ float bflo(unsigned w) { return __uint_as_float(w << 16); }
__device__ __forceinline__ float bfhi(unsigned w) { return __uint_as_float(w & 0xffff0000u); }
__device__ __forceinline__ float silu_f(float v) { return v / (1.f + expf(-v)); }
__device__ __forceinline__ float softplus_f(float v) { return fmaxf(v, 0.f) + log1pf(expf(-fabsf(v))); }

#define XB_TMO      128
#define XB_XCNT(j)  (256  + 64 * (j))
#define XB_XSUB(j)  (1280 + 64 * (j))
#define XB_XGEN(j)  (2304 + 64 * (j))
#define XB_TOP      3328
#define XB_TOPGEN   3392
#define XCD_BAR_WORDS 3456
#define XB_SPIN_CAP (1u << 22)
__device__ __forceinline__ unsigned xb_ld(unsigned* p)              { return __hip_atomic_load(p, __ATOMIC_RELAXED, __HIP_MEMORY_SCOPE_AGENT); }
__device__ __forceinline__ unsigned xb_add(unsigned* p, unsigned v) { return __hip_atomic_fetch_add(p, v, __ATOMIC_RELAXED, __HIP_MEMORY_SCOPE_AGENT); }
__device__ __forceinline__ unsigned xb_xcc_id() { return (unsigned)__builtin_amdgcn_s_getreg((3 << 11) | 20) & 0xFu; }
#define XB_SPIN(cond, bar) do { unsigned _sp = 0; while (cond) { __builtin_amdgcn_s_sleep(1); \
    if ((++_sp & 255u) == 0u) { if (xb_ld(&(bar)[XB_TMO])) break; if (_sp > XB_SPIN_CAP) { atomicAdd(&(bar)[XB_TMO], 1u); break; } } } } while (0)
struct XcdBarrier { unsigned* bar; unsigned x; unsigned total; volatile LAS unsigned* st; };
__device__ __forceinline__ XcdBarrier xcd_barrier_post(unsigned* bar, volatile LAS unsigned* st, unsigned total) {
    XcdBarrier b; b.bar = bar; b.x = xb_xcc_id(); b.total = total; b.st = st;
    if (threadIdx.x == 0) (void)xb_add(&bar[XB_XCNT(b.x)], 1u);
    return b;
}
__device__ __forceinline__ void xcd_barrier_complete(unsigned* bar, unsigned x, unsigned G, unsigned& nloc, unsigned& nx) {
    unsigned sum, cnt, mine, sp = 0u;
    for (;;) {
        sum = 0u; cnt = 0u; mine = 0u;
#pragma unroll
        for (unsigned j = 0; j < 16; ++j) { const unsigned c = xb_ld(&bar[XB_XCNT(j)]); sum += c; cnt += (c > 0u) ? 1u : 0u; mine = (j == x) ? c : mine; }
        if (sum == G) break;
        __builtin_amdgcn_s_sleep(1);
        if ((++sp & 255u) == 0u) { if (xb_ld(&bar[XB_TMO])) break; if (sp > XB_SPIN_CAP) { atomicAdd(&bar[XB_TMO], 1u); break; } }
    }
    nloc = mine > 0u ? mine : 1u; nx = cnt > 0u ? cnt : 1u;
}
__device__ __forceinline__ void xcd_barrier(const XcdBarrier& b) {
    asm volatile("s_waitcnt vmcnt(0)" ::: "memory");
    __syncthreads();
    if (threadIdx.x == 0) {
        unsigned* bar = b.bar;
        __builtin_amdgcn_s_waitcnt(0);
        unsigned nloc = b.st[0], nx = b.st[1];
        if (nloc == 0u) { xcd_barrier_complete(bar, b.x, b.total, nloc, nx); b.st[0] = nloc; b.st[1] = nx; }
        const unsigned old = xb_add(&bar[XB_XSUB(b.x)], 1u);
        const unsigned gen = old / nloc;
        if (nx == 1u) {
            XB_SPIN(xb_ld(&bar[XB_XSUB(b.x)]) < (gen + 1u) * nloc, bar);
            __builtin_amdgcn_fence(__ATOMIC_ACQUIRE, "agent");
            asm volatile("s_waitcnt vmcnt(0)" ::: "memory");
        } else if (old + 1u == (gen + 1u) * nloc) {
            __builtin_amdgcn_fence(__ATOMIC_RELEASE, "agent");
            asm volatile("s_waitcnt vmcnt(0)" ::: "memory");
            const unsigned og = xb_add(&bar[XB_TOP], 1u);
            const unsigned tg = og / nx;
            if (og + 1u == (tg + 1u) * nx) xb_add(&bar[XB_TOPGEN], 1u);
            else XB_SPIN(xb_ld(&bar[XB_TOPGEN]) == tg, bar);
            __builtin_amdgcn_fence(__ATOMIC_ACQUIRE, "agent");
            xb_add(&bar[XB_XGEN(b.x)], 1u);
            asm volatile("s_waitcnt vmcnt(0)" ::: "memory");
        } else {
            XB_SPIN(xb_ld(&bar[XB_XGEN(b.x)]) == gen, bar);
            __builtin_amdgcn_fence(__ATOMIC_ACQUIRE, "agent");
            asm volatile("s_waitcnt vmcnt(0)" ::: "memory");
        }
    }
    __syncthreads();
}

struct Frame {
    LAS unsigned char* lds;
    int tid, lane, wave, bid, G;
    int b, li;
};
enum { I_X = 0, I_MIXG, I_WIN, I_QG, I_KG, I_SINK, I_RELB, I_CONVW, I_CONVB, I_DTB, I_ALOG, I_DSKIP, I_SSMG, I_WOUT, I_MLPG, I_WUP, I_WDOWN, I_OUT, I_WS, I_NPTR };
__device__ __forceinline__ GAS unsigned char* ptr_at(const Frame& F, int i) {
    const LAS unsigned* t = (const LAS unsigned*)(F.lds + PTR_OFF) + 2 * i;
    const unsigned lo = __builtin_amdgcn_readfirstlane(t[0]), hi = __builtin_amdgcn_readfirstlane(t[1]);
    return (GAS unsigned char*)(((unsigned long long)hi << 32) | lo);
}
#define FIN(i) ((const GAS float*)ptr_at(F, (i)))
#define FWS(off) (ptr_at(F, I_WS) + (off))
#define FB(off) (ptr_at(F, I_WS) + (WS_BATCH0 + (size_t)F.b * BATCH_STRIDE + (off)))
using pg8::shx;
__device__ __forceinline__ float shup(float v, int o, int lane) { return __builtin_bit_cast(float, __builtin_amdgcn_ds_bpermute(((lane - o) & 63) << 2, __builtin_bit_cast(int, v))); }
__device__ __forceinline__ float wave_sum(float v, int lane) {
#pragma unroll
    for (int o = 1; o < 64; o <<= 1) v += shx(v, o, lane);
    return v;
}

__device__ __forceinline__ void tr_item(const GAS float* W, int Nsrc, int nsrc0, int nvalid, int K, const GAS float* gain, GAS bf16* WT, int ndst0, int k0, LAS float* scr, int lane) {
    const int n = lane & 31;
    float tv[32];
#pragma unroll
    for (int i = 0; i < 32; ++i) { const int kk = 2 * i + (lane >> 5); tv[i] = __builtin_nontemporal_load(&W[(size_t)(k0 + kk) * Nsrc + nsrc0 + (n < nvalid ? n : 0)]); }
#pragma unroll
    for (int i = 0; i < 32; ++i) { const int kk = 2 * i + (lane >> 5); float v = (n < nvalid) ? tv[i] : 0.f; if (gain) v *= gain[k0 + kk];
        scr[kk * 33 + n] = v; }
    LDS_WAIT(); asm volatile("" ::: "memory");
    const int c = lane & 7;
#pragma unroll
    for (int j = 0; j < 4; ++j) { const int nn = (lane >> 3) + 8 * j; const LAS float* s = scr + (8 * c) * 33 + nn;
        v4u o; o.x = pk2(s[0 * 33], s[1 * 33]); o.y = pk2(s[2 * 33], s[3 * 33]); o.z = pk2(s[4 * 33], s[5 * 33]); o.w = pk2(s[6 * 33], s[7 * 33]);
        *(GAS v4u*)(WT + (size_t)(ndst0 + nn) * K + k0 + 8 * c) = o; }
    LDS_WAIT(); asm volatile("" ::: "memory");
}
__device__ __forceinline__ void win_item(Frame& F, int L, int r, LAS float* scr);
__device__ __forceinline__ void p0_prologue(Frame& F) {
    LAS float* scr = (LAS float*)(F.lds + RING_OFF + F.wave * 16384);
    const int gw = F.bid * NWAVES + F.wave, NGW = F.G * NWAVES;
    constexpr int I_IN = 16 * 80, I_OUT = 16 * 32, I_UP = 16 * 128, I_DN = 64 * 32, I_L = I_IN + I_OUT + I_UP + I_DN;
    for (int it = gw; it < I_IN; it += NGW) win_item(F, 0, it, scr);
    const GAS float* x = FIN(I_X) + (size_t)F.b * SEQ * D; GAS bf16* XB = (GAS bf16*)FWS(WS_XB) + (size_t)F.b * SEQ * D; GAS float* SSQ = (GAS float*)FWS(WS_SSQ) + (size_t)F.b * SEQ * 16;
    for (int m = F.li * NWAVES + F.wave; m < SEQ; m += 2 * GRP * NWAVES) {
        const int m2 = m + GRP * NWAVES;
        const GAS f32x4* xr = (const GAS f32x4*)(x + (size_t)m * D) + F.lane; const GAS f32x4* xr2 = (const GAS f32x4*)(x + (size_t)m2 * D) + F.lane;
        f32x4 v[4], w[4]; float s = 0.f, s2 = 0.f;
#pragma unroll
        for (int j = 0; j < 4; ++j) { v[j] = __builtin_nontemporal_load(xr + 64 * j); w[j] = __builtin_nontemporal_load(xr2 + 64 * j); }
#pragma unroll
        for (int j = 0; j < 4; ++j) { s += (v[j].x * v[j].x + v[j].y * v[j].y) + (v[j].z * v[j].z + v[j].w * v[j].w); s2 += (w[j].x * w[j].x + w[j].y * w[j].y) + (w[j].z * w[j].z + w[j].w * w[j].w); }
        s = wave_sum(s, F.lane); s2 = wave_sum(s2, F.lane);
        GAS v2u* o8 = (GAS v2u*)(XB + (size_t)m * D) + F.lane; GAS v2u* o82 = (GAS v2u*)(XB + (size_t)m2 * D) + F.lane;
#pragma unroll
        for (int j = 0; j < 4; ++j) { v2u o; o.x = pk2(v[j].x, v[j].y); o.y = pk2(v[j].z, v[j].w); o8[64 * j] = o; v2u o2; o2.x = pk2(w[j].x, w[j].y); o2.y = pk2(w[j].z, w[j].w); o82[64 * j] = o2; }
        if (F.lane < 16) { SSQ[(size_t)m * 16 + F.lane] = (F.lane == 0) ? s : 0.f; SSQ[(size_t)m2 * 16 + F.lane] = (F.lane == 0) ? s2 : 0.f; }
    }
}
constexpr int CW_WCNT = 8192, N_CONVERTERS = NGRP * (GRP - 16);
__device__ __forceinline__ void win_item(Frame& F, int L, int r, LAS float* scr) {
    const int kb = r / 80, nb = r % 80; int src, nv = 32;
    if (nb < 16) src = nb * 32; else if (nb < 32) src = 768 + (nb - 16) * 32; else if (nb < 36) src = 512 + (nb - 32) * 32; else if (nb < 40) src = 640 + (nb - 36) * 32;
    else if (nb < 72) src = nb * 32; else if (nb == 72) { src = 2304; nv = 8; } else { src = 0; nv = 0; }
    tr_item(FIN(I_WIN) + (size_t)L * D * D_IN, D_IN, src, nv, D, FIN(I_MIXG) + L * D, (GAS bf16*)FWS(WS_WIN) + (size_t)L * NPROJ * D, nb * 32, kb * 64, scr, F.lane);
}
__device__ __forceinline__ void convert_rest(Frame& F, int slot) {
    LAS float* scr = (LAS float*)(F.lds + RING_OFF + F.wave * 16384);
    constexpr int I_IN = 16 * 80, I_OUT = 16 * 32, I_UP = 16 * 128, I_DN = 64 * 32, NCW = N_CONVERTERS * NWAVES;
    const GAS float *w_out = FIN(I_WOUT), *w_up = FIN(I_WUP), *mlp_g = FIN(I_MLPG), *w_down = FIN(I_WDOWN);
    GAS bf16 *WOUT = (GAS bf16*)FWS(WS_WOUT), *WUP = (GAS bf16*)FWS(WS_WUP), *WDOWN = (GAS bf16*)FWS(WS_WDOWN);
    const int L = slot, n_items = I_OUT + I_UP + I_DN + (slot == 0 ? I_IN : 0);
    for (int it = (F.b * (GRP - 16) + (F.li - 16)) * NWAVES + F.wave; it < n_items; it += NCW) {
        int r = it;
        if (r < I_OUT) { const int kb = r / 32, nb = r % 32; tr_item(w_out + (size_t)L * D * D, D, nb * 32, 32, D, nullptr, WOUT + (size_t)L * D * D, nb * 32, kb * 64, scr, F.lane); continue; }
        r -= I_OUT;
        if (r < I_UP) { const int kb = r / 128, nb = r % 128; tr_item(w_up + (size_t)L * D * FF, FF, nb * 32, 32, D, mlp_g + L * D, WUP + (size_t)L * FF * D, nb * 32, kb * 64, scr, F.lane); continue; }
        r -= I_UP;
        if (r < I_DN) { const int kb = r / 32, nb = r % 32; tr_item(w_down + (size_t)L * FF * D, D, nb * 32, 32, FF, nullptr, WDOWN + (size_t)L * D * FF, nb * 32, kb * 64, scr, F.lane); continue; }
        r -= I_DN;
        win_item(F, 1, r, scr);
    }
    asm volatile("s_waitcnt vmcnt(0)" ::: "memory");
    __syncthreads();
    if (F.tid == 0) { __builtin_amdgcn_fence(__ATOMIC_RELEASE, "agent"); asm volatile("s_waitcnt vmcnt(0)" ::: "memory");
        (void)xb_add((unsigned*)(unsigned char*)FWS(WS_CTL) + CW_WCNT + 64 * slot, 1u); }
}
__device__ __forceinline__ void wait_weights(Frame& F, int part) {
    if (F.tid == 0) { unsigned* wc = (unsigned*)(unsigned char*)FWS(WS_CTL) + CW_WCNT + 64 * part; unsigned sp = 0u;
        while (xb_ld(wc) < (unsigned)N_CONVERTERS) { __builtin_amdgcn_s_sleep(2); if (++sp > (1u << 22)) break; }
        __builtin_amdgcn_fence(__ATOMIC_ACQUIRE, "agent"); asm volatile("s_waitcnt vmcnt(0)" ::: "memory"); }
    __syncthreads();
}
__device__ __forceinline__ void rstd_prepass(Frame& F, const pg8::GroupOrder& S, LAS float* tab) {
    const GAS float* SSQ = (const GAS float*)FWS(WS_SSQ) + (size_t)F.b * SEQ * 16;
    pg8::Unit u;
    for (int i = 0; i < 4 && S.next(i, u); ++i) {
        const int r = F.tid >> 1, h = F.tid & 1;
        const GAS f32x4* p = (const GAS f32x4*)(SSQ + (size_t)(u.pm * 256 + r) * 16 + h * 8);
        const f32x4 a = p[0], b = p[1];
        float s = (a.x + a.y) + (a.z + a.w) + (b.x + b.y) + (b.z + b.w);
        s += shx(s, 1, F.lane);
        if (h == 0) tab[i * 256 + r] = 1.0f / sqrtf(s * (1.0f / D) + EPS);
    }
    LDS_WAIT(); __syncthreads();
}
__device__ __forceinline__ int t5_bucket(int d) {
    if (d < 16) return d;
    return 16 + (d >= 19) + (d >= 21) + (d >= 24) + (d >= 27) + (d >= 31) + (d >= 35) + (d >= 40) + (d >= 46) + (d >= 52) + (d >= 59) + (d >= 67) + (d >= 77) + (d >= 87) + (d >= 99) + (d >= 113);
}
__device__ __forceinline__ void ld8(const GAS bf16* p, float (&v)[8]) {
    const v4u w = *(const GAS v4u*)p;
    v[0] = bflo(w.x); v[1] = bfhi(w.x); v[2] = bflo(w.y); v[3] = bfhi(w.y); v[4] = bflo(w.z); v[5] = bfhi(w.z); v[6] = bflo(w.w); v[7] = bfhi(w.w);
}
typedef short bf16x8_t __attribute__((ext_vector_type(8)));
typedef float f32x16 __attribute__((ext_vector_type(16)));
constexpr float LOG2E = 1.4426950408889634f;
__device__ __forceinline__ unsigned pkbf(float lo, float hi) { return pg8::cvt_pk_bf16(lo, hi); }
__device__ __forceinline__ int crow32(int i, int hh) { return (i & 3) + 8 * (i >> 2) + 4 * hh; }
__device__ __forceinline__ float silu_fast(float v) { return v * __builtin_amdgcn_rcpf(1.0f + __builtin_amdgcn_exp2f(-v * LOG2E)); }
__device__ __forceinline__ void unpk8(const v4u w, float (&v)[8]) {
    v[0] = bflo(w.x); v[1] = bfhi(w.x); v[2] = bflo(w.y); v[3] = bfhi(w.y); v[4] = bflo(w.z); v[5] = bfhi(w.z); v[6] = bflo(w.w); v[7] = bfhi(w.w);
}

typedef short v4i16_t __attribute__((ext_vector_type(4)));
template <int RH, int RSEC> __device__ __forceinline__ bf16x8_t tr_frag(const LAS unsigned char* img, int stride, int rbase, int cbase, int lane) {
    const LAS unsigned char* p = img + (rbase + RH * (lane >> 5) + ((lane & 15) >> 2)) * stride + (cbase + 16 * ((lane >> 4) & 1) + 4 * (lane & 3)) * 2;
    const v4i16_t a = __builtin_amdgcn_ds_read_tr16_b64_v4i16((LAS v4i16_t*)p), b = __builtin_amdgcn_ds_read_tr16_b64_v4i16((LAS v4i16_t*)(p + RSEC * stride));
    return (bf16x8_t){a[0], a[1], a[2], a[3], b[0], b[1], b[2], b[3]};
}
constexpr int AT_KS = 0, AT_KSTRIDE = 144, AT_VT = 36864, AT_VSTRIDE = 192, AT_BIAS = AT_VT + 256 * AT_VSTRIDE;
constexpr int AT_BN = 192, AT_END = AT_BIAS + 4 * AT_BN * 4;
static_assert(AT_END <= MIX_BYTES, "attention LDS");
__device__ __forceinline__ void attn_fast(Frame& F, int L, bool dummy = false) {
    GAS bf16* PROJ = (GAS bf16*)FB(BO_PROJ);
    const GAS float* qg = FIN(I_QG) + L * 64; const GAS float* kg = FIN(I_KG) + L * 64; const GAS float* sinks = FIN(I_SINK) + L * 8; const GAS float* rel_bias = FIN(I_RELB);
    LAS unsigned char* Ks = F.lds + AT_KS; LAS unsigned char* Vt = F.lds + AT_VT; LAS float* biasR = (LAS float*)(F.lds + AT_BIAS);
    const int tid = F.tid, lane = F.lane, wave = F.wave, q = lane & 31, hh = lane >> 5;
    const int unit = F.li, kvh = unit >> 4, qb = unit & 15, m0 = qb * 128;
    const int gi = wave >> 1, qh = wave & 1, hq = kvh * 4 + gi;
    v4u qraw[2][4];
#pragma unroll
    for (int s = 0; s < 2; ++s)
#pragma unroll
        for (int d0 = 0; d0 < 4; ++d0) qraw[s][d0] = *(const GAS v4u*)(PROJ + (size_t)(m0 + 64 * qh + 32 * s + q) * PP + CQ + hq * 64 + d0 * 16 + hh * 8);
    v4u kwv[4], vwv[4];
#pragma unroll
    for (int i = 0; i < 4; ++i) { const int c = tid + NTHREADS * i, key = c >> 3, part = c & 7; const bool valid = (qb > 0) || (key >= 128); const unsigned msk = valid ? 0xffffffffu : 0u;
        const GAS bf16* kp = PROJ + (size_t)(valid ? m0 + key - 128 : 0) * PP + CK + kvh * 64 + part * 8;
        v4u a_ = *(const GAS v4u*)kp, b_ = *(const GAS v4u*)(kp + (CV - CK));
        a_.x &= msk; a_.y &= msk; a_.z &= msk; a_.w &= msk; b_.x &= msk; b_.y &= msk; b_.z &= msk; b_.w &= msk; kwv[i] = a_; vwv[i] = b_; }
    const f32x4 kg0 = *(const GAS f32x4*)(kg + (tid & 7) * 8), kg1 = *(const GAS f32x4*)(kg + (tid & 7) * 8 + 4);
    f32x4 qgv[4][2];
#pragma unroll
    for (int d0 = 0; d0 < 4; ++d0) { qgv[d0][0] = *(const GAS f32x4*)(qg + d0 * 16 + hh * 8); qgv[d0][1] = *(const GAS f32x4*)(qg + d0 * 16 + hh * 8 + 4); }
    const float sinkv = sinks[hq];
    float bent[2];
#pragma unroll
    for (int k = 0; k < 2; ++k) { const int x = tid + NTHREADS * k, g_ = x / AT_BN, xx = x - g_ * AT_BN; const bool ok = (x < 4 * AT_BN) && (xx >= 32) && (xx < 160);
        const float v = rel_bias[t5_bucket(ok ? 159 - xx : 0) * 8 + kvh * 4 + (ok ? g_ : 0)]; bent[k] = ok ? v * LOG2E : 0.f; }
    __syncthreads();
    biasR[tid] = bent[0]; if (tid + NTHREADS < 4 * AT_BN) biasR[tid + NTHREADS] = bent[1];
#pragma unroll
    for (int i = 0; i < 4; ++i) {
        const int c = tid + NTHREADS * i, key = c >> 3, part = c & 7;
        const v4u kw = kwv[i], vw = vwv[i];
        float kv[8]; unpk8(kw, kv);
        float ss = 0.f;
#pragma unroll
        for (int e = 0; e < 8; ++e) ss += kv[e] * kv[e];
        ss += shx(ss, 1, lane); ss += shx(ss, 2, lane); ss += shx(ss, 4, lane);
        const float rk = __builtin_amdgcn_rsqf(ss * (1.0f / 64.0f) + EPS);
        const f32x4 g0 = kg0, g1 = kg1;
        v4u ko; ko.x = pkbf(kv[0] * rk * g0.x, kv[1] * rk * g0.y); ko.y = pkbf(kv[2] * rk * g0.z, kv[3] * rk * g0.w); ko.z = pkbf(kv[4] * rk * g1.x, kv[5] * rk * g1.y); ko.w = pkbf(kv[6] * rk * g1.z, kv[7] * rk * g1.w);
        *(LAS v4u*)(Ks + key * AT_KSTRIDE + part * 16) = ko;
        *(LAS v4u*)(Vt + key * AT_VSTRIDE + part * 16) = vw;
    }
    LDS_WAIT(); __syncthreads();
    const float sink2 = sinkv * LOG2E;
    const LAS float* bb = biasR + gi * AT_BN + 31 - q + 4 * hh;
    const int qm = q - 4 * hh;
#pragma unroll
    for (int s = 0; s < 2; ++s) {
        const int a = 64 * qh + 32 * s;
        GAS bf16* qrow = PROJ + (size_t)(m0 + a + q) * PP + CQ + hq * 64;
        float qv[4][8]; float ss = 0.f;
#pragma unroll
        for (int d0 = 0; d0 < 4; ++d0) { unpk8(qraw[s][d0], qv[d0]);
#pragma unroll
            for (int e = 0; e < 8; ++e) ss += qv[d0][e] * qv[d0][e]; }
        ss += shx(ss, 32, lane);
        const float rq = __builtin_amdgcn_rsqf(ss * (1.0f / 64.0f) + EPS) * (0.125f * LOG2E);
        bf16x8_t qf[4];
#pragma unroll
        for (int d0 = 0; d0 < 4; ++d0) { const f32x4 g0 = qgv[d0][0], g1 = qgv[d0][1];
            v4u w; w.x = pkbf(qv[d0][0] * rq * g0.x, qv[d0][1] * rq * g0.y); w.y = pkbf(qv[d0][2] * rq * g0.z, qv[d0][3] * rq * g0.w);
            w.z = pkbf(qv[d0][4] * rq * g1.x, qv[d0][5] * rq * g1.y); w.w = pkbf(qv[d0][6] * rq * g1.z, qv[d0][7] * rq * g1.w);
            qf[d0] = __builtin_bit_cast(bf16x8_t, w); }
        const int kt_lo = (qb == 0) ? 4 - (a >> 5) : 0;
        f32x16 S[5]; float mx = sink2;
#pragma unroll
        for (int kt = 0; kt < 5; ++kt) { f32x16 acc = {};
#pragma unroll
            for (int d0 = 0; d0 < 4; ++d0) { const bf16x8_t kf = *(const LAS bf16x8_t*)(Ks + (a + 32 * kt + q) * AT_KSTRIDE + d0 * 32 + hh * 16);
                acc = __builtin_amdgcn_mfma_f32_32x32x16_bf16(kf, qf[d0], acc, 0, 0, 0); }
            if (kt < kt_lo) {
#pragma unroll
                for (int i = 0; i < 16; ++i) acc[i] = -INFINITY;
            } else {
#pragma unroll
                for (int i = 0; i < 16; ++i) { const int t0 = (i & 3) + 8 * (i >> 2); float v = acc[i] + bb[32 * kt + t0];
                    if (kt == 0) v = fminf(v, (t0 > qm) ? INFINITY : -INFINITY);
                    if (kt == 4) v = fminf(v, (t0 <= qm) ? INFINITY : -INFINITY);
                    acc[i] = v; mx = fmaxf(mx, v); } }
            S[kt] = acc; }
        mx = fmaxf(mx, shx(mx, 32, lane));
        float lsum = 0.f; bf16x8_t pf[5][2];
#pragma unroll
        for (int kt = 0; kt < 5; ++kt) {
#pragma unroll
            for (int i = 0; i < 16; ++i) { const float p = __builtin_amdgcn_exp2f(S[kt][i] - mx); S[kt][i] = p; lsum += p; }
#pragma unroll
            for (int s2 = 0; s2 < 2; ++s2) { v4u w; w.x = pkbf(S[kt][8 * s2 + 0], S[kt][8 * s2 + 1]); w.y = pkbf(S[kt][8 * s2 + 2], S[kt][8 * s2 + 3]);
                w.z = pkbf(S[kt][8 * s2 + 4], S[kt][8 * s2 + 5]); w.w = pkbf(S[kt][8 * s2 + 6], S[kt][8 * s2 + 7]); pf[kt][s2] = __builtin_bit_cast(bf16x8_t, w); } }
        lsum += shx(lsum, 32, lane);
        lsum += __builtin_amdgcn_exp2f(sink2 - mx);
        f32x16 O[2] = {{}, {}};
#pragma unroll
        for (int kt = 0; kt < 5; ++kt)
#pragma unroll
            for (int s2 = 0; s2 < 2; ++s2)
#pragma unroll
                for (int db = 0; db < 2; ++db)
                    O[db] = __builtin_amdgcn_mfma_f32_32x32x16_bf16(tr_frag<4, 8>(Vt, AT_VSTRIDE, a + 32 * kt + 16 * s2, 32 * db, lane), pf[kt][s2], O[db], 0, 0, 0);
        const float inv = __builtin_amdgcn_rcpf(lsum);
#pragma unroll
        for (int db = 0; db < 2; ++db)
#pragma unroll
            for (int g4 = 0; g4 < 4; ++g4) { v2u w; w.x = pkbf(O[db][4 * g4] * inv, O[db][4 * g4 + 1] * inv); w.y = pkbf(O[db][4 * g4 + 2] * inv, O[db][4 * g4 + 3] * inv);
                GAS bf16* orow = dummy ? (GAS bf16*)FB(BO_PREV) + (size_t)(m0 + a + q) * 512 + hq * 64 : qrow;
                *(GAS v2u*)(orow + 32 * db + 8 * g4 + 4 * hh) = w; }
    }
}

constexpr size_t WS_DTV = 3 * MiB + 512 * 1024;
constexpr int SD_ROW = 272, SD_XT = 264;
template <int NR> struct Raw8 { v4u u[NR + 3]; };
template <int NR> struct Raw4 { v2u u[NR + 3]; };
struct ConvW8 { f32x4 w[4][2], b[2]; };
struct ConvW4 { f32x4 w[4], b; };
template <int NR> __device__ __forceinline__ void conv_load(Raw8<NR>& R, const GAS bf16* PROJ, int m0, int c, int l0, int col0) {
#pragma unroll
    for (int i = 0; i < NR + 3; ++i) { const int row = l0 - 3 + i; const bool ok = (c > 0) || (row >= 0); const unsigned msk = ok ? 0xffffffffu : 0u;
        v4u x = *(const GAS v4u*)(PROJ + (size_t)(m0 + (ok ? row : 0)) * PP + col0); x.x &= msk; x.y &= msk; x.z &= msk; x.w &= msk; R.u[i] = x; }
}
template <int NR> __device__ __forceinline__ void conv_load(Raw4<NR>& R, const GAS bf16* PROJ, int m0, int c, int l0, int col0) {
#pragma unroll
    for (int i = 0; i < NR + 3; ++i) { const int row = l0 - 3 + i; const bool ok = (c > 0) || (row >= 0); const unsigned msk = ok ? 0xffffffffu : 0u;
        v2u x = *(const GAS v2u*)(PROJ + (size_t)(m0 + (ok ? row : 0)) * PP + col0); x.x &= msk; x.y &= msk; R.u[i] = x; }
}
__device__ __forceinline__ void convw_load(ConvW8& W, const GAS float* cw, const GAS float* cb) {
#pragma unroll
    for (int k = 0; k < 4; ++k) { W.w[k][0] = *(const GAS f32x4*)(cw + k * 1024); W.w[k][1] = *(const GAS f32x4*)(cw + k * 1024 + 4); }
    W.b[0] = *(const GAS f32x4*)cb; W.b[1] = *(const GAS f32x4*)(cb + 4);
}
__device__ __forceinline__ void convw_load(ConvW4& W, const GAS float* cw, const GAS float* cb) {
#pragma unroll
    for (int k = 0; k < 4; ++k) W.w[k] = *(const GAS f32x4*)(cw + k * 1024);
    W.b = *(const GAS f32x4*)cb;
}
template <int NR> __device__ __forceinline__ void conv_row(const Raw8<NR>& R, const ConvW8& W, int r, float (&out)[8]) {
    float acc[8];
#pragma unroll
    for (int e = 0; e < 8; ++e) acc[e] = W.b[e >> 2][e & 3];
#pragma unroll
    for (int k = 0; k < 4; ++k) { float u[8]; unpk8(R.u[r + k], u);
#pragma unroll
        for (int e = 0; e < 8; ++e) acc[e] += W.w[k][e >> 2][e & 3] * u[e]; }
#pragma unroll
    for (int e = 0; e < 8; ++e) out[e] = silu_fast(acc[e]);
}
template <int NR> __device__ __forceinline__ void conv_row(const Raw4<NR>& R, const ConvW4& W, int r, float (&out)[4]) {
    float acc[4];
#pragma unroll
    for (int e = 0; e < 4; ++e) acc[e] = W.b[e];
#pragma unroll
    for (int k = 0; k < 4; ++k) { const v2u x = R.u[r + k]; const float u[4] = {bflo(x.x), bfhi(x.x), bflo(x.y), bfhi(x.y)};
#pragma unroll
        for (int e = 0; e < 4; ++e) acc[e] += W.w[k][e] * u[e]; }
#pragma unroll
    for (int e = 0; e < 4; ++e) out[e] = silu_fast(acc[e]);
}
constexpr int P_XSTR = 576, P_BSTR = 304, P_XD = 0, P_BM = P_XD + 128 * P_XSTR, P_CM = P_BM + 128 * P_BSTR, P_FREE = P_CM + 128 * SD_ROW, P_DT = MIX_BYTES - 4096, P_ACS = P_DT + 2048;
static_assert(P_FREE + 4096 <= P_DT, "SSD LDS map");
__device__ __forceinline__ bf16x8_t scale_frag(bf16x8_t f, const f32x4 s0, const f32x4 s1) {
    const v4u w = __builtin_bit_cast(v4u, f); v4u o;
    o.x = pkbf(bflo(w.x) * s0.x, bfhi(w.x) * s0.y); o.y = pkbf(bflo(w.y) * s0.z, bfhi(w.y) * s0.w); o.z = pkbf(bflo(w.z) * s1.x, bfhi(w.z) * s1.y); o.w = pkbf(bflo(w.w) * s1.z, bfhi(w.w) * s1.w);
    return __builtin_bit_cast(bf16x8_t, o);
}
constexpr int S1_W = P_FREE, S1_WT = S1_W + 2048;
__device__ __forceinline__ void ssd_states(Frame& F, int L) {
    const GAS bf16* PROJ = (const GAS bf16*)FB(BO_PROJ);
    const GAS float* conv_w = FIN(I_CONVW) + (size_t)L * 4 * 1024; const GAS float* conv_b = FIN(I_CONVB) + L * 1024;
    const GAS float* dt_bias = FIN(I_DTB) + L * 8; const GAS float* a_log = FIN(I_ALOG) + L * 8;
    const GAS float* DTRAW = (const GAS float*)FWS(WS_DTRAW) + (size_t)F.b * SEQ * 8; GAS float* CHDEC = (GAS float*)FWS(WS_CHDEC) + F.b * 128;
    GAS bf16* STATES = (GAS bf16*)FB(BO_STATES);
    LAS unsigned char* XD = F.lds + P_XD; LAS unsigned char* BM = F.lds + P_BM;
    LAS float* dt_l = (LAS float*)(F.lds + P_DT); LAS float* acs_l = (LAS float*)(F.lds + P_ACS); LAS float* w_l = (LAS float*)(F.lds + S1_W); LAS float* wt = (LAS float*)(F.lds + S1_WT);
    const int wave = F.wave, unit = F.li, c = unit >> 1, g = unit & 1, m0 = c * 128;
    int tid = F.tid; asm volatile("" : "+v"(tid));
    int lane = tid & 63, q = lane & 31, hh = lane >> 5;
    const int xcg = tid & 31, xl0 = (tid >> 5) * 8, xcol = CX + g * 256 + xcg * 8;
    const int bcg = tid & 31, bl0 = (tid >> 5) * 8, isC = bcg >> 4, bn0 = (bcg & 15) * 8, bcol = (isC ? CCM : CBM) + g * 128 + bn0;
    Raw8<8> xr; ConvW8 xw; Raw8<8> br; ConvW8 bw;
    conv_load(xr, PROJ, m0, c, xl0, xcol); convw_load(xw, conv_w + (xcol - CX), conv_b + (xcol - CX));
    conv_load(br, PROJ, m0, c, bl0, bcol); convw_load(bw, conv_w + (bcol - CX), conv_b + (bcol - CX));
    const int ar = tid >> 7, al = tid & 127, ahead = 4 * g + ar;
    const float dtraw = DTRAW[(size_t)(m0 + al) * 8 + ahead], dtb = dt_bias[ahead], alog = a_log[ahead];
    __syncthreads();
    float acs_v;
    { const float dtv = softplus_f(dtraw + dtb);
      float v = dtv * (-expf(alog));
#pragma unroll
      for (int o = 1; o < 64; o <<= 1) { const float t = shup(v, o, lane); if (lane >= o) v += t; }
      if (lane == 63) wt[wave] = v;
      LDS_WAIT(); __syncthreads();
      if (wave & 1) v += wt[wave - 1];
      dt_l[tid] = dtv; acs_l[tid] = v * LOG2E; acs_v = v * LOG2E;
      if (al == 127) CHDEC[c * 8 + ahead] = expf(v); }
#pragma unroll
    for (int r = 0; r < 8; ++r) { float o[8]; conv_row(br, bw, r, o);
        v4u pk; pk.x = pkbf(o[0], o[1]); pk.y = pkbf(o[2], o[3]); pk.z = pkbf(o[4], o[5]); pk.w = pkbf(o[6], o[7]);
        *(LAS v4u*)(isC ? F.lds + P_CM + (bl0 + r) * SD_ROW + bn0 * 2 : BM + (bl0 + r) * P_BSTR + bn0 * 2) = pk; }
    LDS_WAIT(); __syncthreads();
    w_l[tid] = __builtin_amdgcn_exp2f(acs_l[ar * 128 + 127] - acs_v);
    { const int r4 = xcg >> 3;
#pragma unroll
      for (int r = 0; r < 8; ++r) { float o[8]; conv_row(xr, xw, r, o); const int l = xl0 + r; const float sc = dt_l[r4 * 128 + l];
          v4u pk; pk.x = pkbf(o[0] * sc, o[1] * sc); pk.y = pkbf(o[2] * sc, o[3] * sc); pk.z = pkbf(o[4] * sc, o[5] * sc); pk.w = pkbf(o[6] * sc, o[7] * sc);
          *(LAS v4u*)(XD + l * P_XSTR + xcg * 16) = pk; } }
    LDS_WAIT(); __syncthreads();
    asm volatile("" : "+v"(tid)); lane = tid & 63; q = lane & 31; hh = lane >> 5;
    { const int r4 = wave >> 1, nt0 = (wave & 1) * 2, head = 4 * g + r4;
      f32x16 St[2][2] = {{{}, {}}, {{}, {}}};
#pragma unroll
      for (int ks = 0; ks < 8; ++ks) { bf16x8_t af[2], bfr[2];
          const f32x4 w0 = *(const LAS f32x4*)(w_l + r4 * 128 + 16 * ks + 8 * hh), w1 = *(const LAS f32x4*)(w_l + r4 * 128 + 16 * ks + 8 * hh + 4);
#pragma unroll
          for (int pt = 0; pt < 2; ++pt) af[pt] = tr_frag<8, 4>(XD, P_XSTR, 16 * ks, r4 * 64 + 32 * pt, lane);
#pragma unroll
          for (int nn = 0; nn < 2; ++nn) bfr[nn] = scale_frag(tr_frag<8, 4>(BM, P_BSTR, 16 * ks, 32 * (nt0 + nn), lane), w0, w1);
#pragma unroll
          for (int pt = 0; pt < 2; ++pt)
#pragma unroll
              for (int nn = 0; nn < 2; ++nn) St[pt][nn] = __builtin_amdgcn_mfma_f32_32x32x16_bf16(af[pt], bfr[nn], St[pt][nn], 0, 0, 0); }
      GAS bf16* sp = STATES + ((size_t)c * 8 + head) * 8192 + 32 * nt0 + q;
#pragma unroll
      for (int pt = 0; pt < 2; ++pt)
#pragma unroll
          for (int nn = 0; nn < 2; ++nn)
#pragma unroll
              for (int e = 0; e < 16; e += 2) { const unsigned w = pkbf(St[pt][nn][e], St[pt][nn][e + 1]);
                  sp[(32 * pt + crow32(e, hh)) * 128 + 32 * nn] = (bf16)(w & 0xffffu); sp[(32 * pt + crow32(e + 1, hh)) * 128 + 32 * nn] = (bf16)(w >> 16); } }
}
__device__ __forceinline__ void ssd_scan(Frame& F, int L) {
    const GAS bf16* STATES = (const GAS bf16*)FB(BO_STATES); const GAS float* CHDEC = (const GAS float*)FWS(WS_CHDEC) + F.b * 128; GAS bf16* PREV = (GAS bf16*)FB(BO_PREV);
    for (int idx = F.li * NTHREADS + F.tid; idx < 8 * 64 * 32; idx += GRP * NTHREADS) {
        const int n4 = idx & 31, p = (idx >> 5) & 63, head = idx >> 11;
        v2u s[16]; float dec[16];
#pragma unroll
        for (int c = 0; c < 16; ++c) { const size_t o = ((size_t)c * 8 + head) * 8192 + p * 128 + 4 * n4; s[c] = *(const GAS v2u*)(STATES + o); dec[c] = CHDEC[c * 8 + head]; }
        f32x4 h = {0.f, 0.f, 0.f, 0.f};
#pragma unroll
        for (int c = 0; c < 16; ++c) { const size_t o = ((size_t)c * 8 + head) * 8192 + p * 128 + 4 * n4;
            v2u w; w.x = pkbf(h.x, h.y); w.y = pkbf(h.z, h.w); *(GAS v2u*)(PREV + o) = w;
            const f32x4 sv = {bflo(s[c].x), bfhi(s[c].x), bflo(s[c].y), bfhi(s[c].y)};
            h = h * dec[c] + sv; }
    }
}
constexpr int S3_PV = P_BM, S3_PVH = 64 * SD_ROW, S3_Z = S3_PV + 2 * S3_PVH, S3_NG = P_FREE, S3_RSS = S3_NG + 1024;
static_assert(S3_Z + 128 * SD_ROW <= P_FREE && S3_RSS + 2048 <= P_DT && 128 * 528 <= P_DT, "SSD part 3 LDS");
__device__ __forceinline__ void ssd_out(Frame& F, int L, bool dummy = false) {
    GAS bf16* PROJ = (GAS bf16*)FB(BO_PROJ); const GAS bf16* PREV = (const GAS bf16*)FB(BO_PREV);
    const GAS float* d_skip = FIN(I_DSKIP) + L * 8; const GAS float* ssm_g = FIN(I_SSMG) + L * 512;
    LAS unsigned char* Cm = F.lds + P_CM; LAS unsigned char* Bm = F.lds + P_BM; LAS unsigned char* Zt = F.lds + S3_Z; const LAS unsigned char* XD = F.lds + P_XD;
    LAS float* dt_l = (LAS float*)(F.lds + P_DT); LAS float* acs_l = (LAS float*)(F.lds + P_ACS); LAS float* rss = (LAS float*)(F.lds + S3_RSS); LAS float* ng_l = (LAS float*)(F.lds + S3_NG);
    const int wave = F.wave, unit = F.li, c = unit >> 1, g = unit & 1, m0 = c * 128;
    int tid = F.tid; asm volatile("" : "+v"(tid));
    int lane = tid & 63, q = lane & 31, hh = lane >> 5;
    const float ng_in = ssm_g[g * 256 + (tid & 255)];
    v4u pw[4], zw[4];
#define S3_D1_LOAD_PZ(hp_) do { \
        _Pragma("unroll") for (int k = 0; k < 4; ++k) { const int ch = tid + NTHREADS * k; \
            { const int hd = ch >> 10, rem = ch & 1023, p = rem >> 4, n8 = rem & 15; pw[k] = *(const GAS v4u*)(PREV + ((size_t)c * 8 + 4 * g + 2 * (hp_) + hd) * 8192 + p * 128 + n8 * 8); } \
            { const int l = ch >> 4, c8 = ch & 15; zw[k] = *(const GAS v4u*)(PROJ + (size_t)(m0 + l) * PP + CZ + (4 * g + 2 * (hp_)) * 64 + c8 * 8); } } } while (0)
    S3_D1_LOAD_PZ(0);
    if (tid < 256) ng_l[tid] = ng_in;
    const int j = (wave < 4) ? (wave & 3) : 3 - (wave & 3), h2 = wave >> 2;
    f32x16 cbT[4]; bf16x8_t cf[8];
#pragma unroll
    for (int ks = 0; ks < 8; ++ks) cf[ks] = *(const LAS bf16x8_t*)(Cm + (32 * j + q) * SD_ROW + (16 * ks + 8 * hh) * 2);
#pragma unroll
    for (int i = 0; i < 4; ++i) { f32x16 acc = {};
        if (i <= j) {
#pragma unroll
            for (int ks = 0; ks < 8; ++ks) { const bf16x8_t bfr = *(const LAS bf16x8_t*)(Bm + (32 * i + q) * P_BSTR + (16 * ks + 8 * hh) * 2);
                acc = __builtin_amdgcn_mfma_f32_32x32x16_bf16(bfr, cf[ks], acc, 0, 0, 0); } }
        cbT[i] = acc; }
    unsigned vk[2][16];
#pragma unroll
    for (int hp = 0; hp < 2; ++hp) {
        __syncthreads();
        {
#pragma unroll
          for (int k = 0; k < 4; ++k) { const int ch = tid + NTHREADS * k;
              { const int hd = ch >> 10, rem = ch & 1023, p = rem >> 4, n8 = rem & 15; *(LAS v4u*)(F.lds + S3_PV + hd * S3_PVH + p * SD_ROW + n8 * 16) = pw[k]; }
              { const int l = ch >> 4, c8 = ch & 15; *(LAS v4u*)(Zt + l * SD_ROW + c8 * 16) = zw[k]; } } }
        LDS_WAIT(); __syncthreads();
        asm volatile("" : "+v"(tid)); lane = tid & 63; q = lane & 31; hh = lane >> 5;
        const int r = 2 * hp + h2, head = 4 * g + r;
        const LAS unsigned char* P1 = F.lds + S3_PV + h2 * S3_PVH;
        f32x16 O[2] = {{}, {}};
#pragma unroll
        for (int ks = 0; ks < 8; ++ks)
#pragma unroll
            for (int pt = 0; pt < 2; ++pt) { const bf16x8_t af = *(const LAS bf16x8_t*)(P1 + (32 * pt + q) * SD_ROW + (16 * ks + 8 * hh) * 2);
                O[pt] = __builtin_amdgcn_mfma_f32_32x32x16_bf16(af, cf[ks], O[pt], 0, 0, 0); }
        const float acl = acs_l[r * 128 + 32 * j + q], diag = d_skip[head] * __builtin_amdgcn_rcpf(dt_l[r * 128 + 32 * j + q]);
        { const float ea = __builtin_amdgcn_exp2f(acl);
#pragma unroll
          for (int pt = 0; pt < 2; ++pt)
#pragma unroll
              for (int e = 0; e < 16; ++e) O[pt][e] *= ea; }
        const int qm = q - 4 * hh;
#pragma unroll
        for (int i = 0; i < 4; ++i) { if (i <= j) {
            float xv[16];
            const LAS float* ap = acs_l + r * 128 + 32 * i + 4 * hh;
            float av[16];
#pragma unroll
            for (int e = 0; e < 16; ++e) av[e] = ap[(e & 3) + 8 * (e >> 2)];
            if (i < j) {
#pragma unroll
                for (int e = 0; e < 16; ++e) xv[e] = cbT[i][e] * __builtin_amdgcn_exp2f(acl - av[e]);
            } else {
#pragma unroll
                for (int e = 0; e < 16; ++e) { const int t0 = (e & 3) + 8 * (e >> 2);
                    const float m01 = (t0 <= qm) ? 1.0f : 0.0f, dg = (t0 == qm) ? diag : 0.0f;
                    xv[e] = cbT[i][e] * __builtin_amdgcn_exp2f(fminf(acl - av[e], 0.f)) * m01 + dg; } }
#pragma unroll
            for (int s2 = 0; s2 < 2; ++s2) { v4u w; w.x = pkbf(xv[8 * s2 + 0], xv[8 * s2 + 1]); w.y = pkbf(xv[8 * s2 + 2], xv[8 * s2 + 3]); w.z = pkbf(xv[8 * s2 + 4], xv[8 * s2 + 5]); w.w = pkbf(xv[8 * s2 + 6], xv[8 * s2 + 7]);
                const bf16x8_t xf = __builtin_bit_cast(bf16x8_t, w);
#pragma unroll
                for (int pt = 0; pt < 2; ++pt)
                    O[pt] = __builtin_amdgcn_mfma_f32_32x32x16_bf16(tr_frag<4, 8>(XD, P_XSTR, 32 * i + 16 * s2, 64 * r + 32 * pt, lane), xf, O[pt], 0, 0, 0); } } }
        if (hp == 0) S3_D1_LOAD_PZ(1);
        float ss = 0.f;
#pragma unroll
        for (int pt = 0; pt < 2; ++pt)
#pragma unroll
            for (int g4 = 0; g4 < 4; ++g4) { const int p = 32 * pt + 8 * g4 + 4 * hh;
                const v2u zz = *(const LAS v2u*)(Zt + (32 * j + q) * SD_ROW + (64 * h2 + p) * 2);
                const float u0 = O[pt][4 * g4] * silu_fast(bflo(zz.x)), u1 = O[pt][4 * g4 + 1] * silu_fast(bfhi(zz.x)), u2 = O[pt][4 * g4 + 2] * silu_fast(bflo(zz.y)), u3 = O[pt][4 * g4 + 3] * silu_fast(bfhi(zz.y));
                ss += (u0 * u0 + u1 * u1) + (u2 * u2 + u3 * u3);
                vk[hp][pt * 8 + g4 * 2] = pkbf(u0, u1); vk[hp][pt * 8 + g4 * 2 + 1] = pkbf(u2, u3); }
        ss += shx(ss, 32, lane);
        if (hh == 0) rss[r * 128 + 32 * j + q] = ss;
    }
#undef S3_D1_LOAD_PZ
    LDS_WAIT(); __syncthreads();
    asm volatile("" : "+v"(tid)); lane = tid & 63; q = lane & 31; hh = lane >> 5;
    { const int l = 32 * j + q; const float tot = (rss[l] + rss[128 + l]) + (rss[256 + l] + rss[384 + l]);
      const float rn = __builtin_amdgcn_rsqf(tot * (1.0f / 256.0f) + EPS);
      LAS unsigned char* Ot = F.lds;
#pragma unroll
      for (int hp = 0; hp < 2; ++hp) { const int r = 2 * hp + h2;
#pragma unroll
          for (int pt = 0; pt < 2; ++pt)
#pragma unroll
              for (int g4 = 0; g4 < 4; ++g4) { const int p = 32 * pt + 8 * g4 + 4 * hh;
                  const f32x4 ng = *(const LAS f32x4*)(ng_l + r * 64 + p);
                  const unsigned w0 = vk[hp][pt * 8 + g4 * 2], w1 = vk[hp][pt * 8 + g4 * 2 + 1];
                  v2u w; w.x = pkbf(bflo(w0) * rn * ng.x, bfhi(w0) * rn * ng.y); w.y = pkbf(bflo(w1) * rn * ng.z, bfhi(w1) * rn * ng.w);
                  *(LAS v2u*)(Ot + l * 528 + (r * 64 + p) * 2) = w; } } }
    LDS_WAIT(); __syncthreads();
    asm volatile("" : "+v"(tid));
#pragma unroll
    for (int k = 0; k < 8; ++k) { const int ch = tid + NTHREADS * k, l = ch >> 5, c8 = ch & 31;
        const v4u w = *(const LAS v4u*)(F.lds + l * 528 + c8 * 16);
        GAS bf16* orow = dummy ? (GAS bf16*)FB(BO_STATES) + (size_t)(m0 + l) * 512 : PROJ + (size_t)(m0 + l) * PP + CZ;
        *(GAS v4u*)(orow + g * 256 + c8 * 8) = w; }
}

__device__ __forceinline__ void ph_inproj(Frame& F, int L) {
    LAS float* rstd_tab = (LAS float*)(F.lds + RSTD_OFF);
    int li_ = F.li; asm volatile("" : "+s"(li_)); pg8::GroupOrder S; S.init(NPROJ, li_);
    const GAS f32x4* sp = (const GAS f32x4*)((const GAS float*)FWS(WS_SSQ) + ((size_t)F.b * SEQ + (li_ & 7) * 256 + (F.tid >> 1)) * 16 + (F.tid & 1) * 8);
    pg8::Gemm g{(const GAS bf16*)FWS(WS_XB) + (size_t)F.b * SEQ * D, (const GAS bf16*)FWS(WS_WIN) + (size_t)L * NPROJ * D, SEQ, NPROJ, D, D};
    pg8::EpiProj E{(GAS bf16*)FB(BO_PROJ), (GAS float*)FWS(WS_DTRAW) + (size_t)F.b * SEQ * 8, rstd_tab, sp[0], sp[1]};
    pg8::gemm_phase<pg8::EpiProj, pg8::GroupOrder, true, true>(F.lds + RING_OFF, g, S, E);
}
__device__ __forceinline__ void ph_outproj(Frame& F, int L, bool dummy = false) {
    int li_ = F.li; asm volatile("" : "+s"(li_)); pg8::GroupOrder S; S.init(D, li_);
    pg8::Gemm g{(const GAS bf16*)FB(BO_PROJ), (const GAS bf16*)FWS(WS_WOUT) + (size_t)L * D * D, SEQ, D, D, PP};
    GAS bf16* XBb = (GAS bf16*)FWS(WS_XB) + (size_t)F.b * SEQ * D;
    pg8::EpiRes<false> E{XBb, (GAS float*)FWS(WS_SSQ) + (size_t)F.b * SEQ * 16, nullptr, dummy ? (GAS bf16*)FB(BO_YPART) : XBb};
    pg8::gemm_phase<pg8::EpiRes<false>, pg8::GroupOrder, false, true>(F.lds + RING_OFF, g, S, E);
}
__device__ __forceinline__ void ph_up(Frame& F, int L) {
    LAS float* rstd_tab = (LAS float*)(F.lds + RSTD_OFF);
    int li_ = F.li; asm volatile("" : "+s"(li_)); pg8::GroupOrder S; S.init(FF, li_);
    const GAS f32x4* sp = (const GAS f32x4*)((const GAS float*)FWS(WS_SSQ) + ((size_t)F.b * SEQ + (li_ & 7) * 256 + (F.tid >> 1)) * 16 + (F.tid & 1) * 8);
    pg8::Gemm g{(const GAS bf16*)FWS(WS_XB) + (size_t)F.b * SEQ * D, (const GAS bf16*)FWS(WS_WUP) + (size_t)L * FF * D, SEQ, FF, D, D};
    pg8::EpiUp E{(GAS bf16*)FB(BO_HID), FF, rstd_tab, sp[0], sp[1]};
    pg8::gemm_phase<pg8::EpiUp, pg8::GroupOrder, true, true>(F.lds + RING_OFF, g, S, E);
}
__device__ __forceinline__ void ph_down(Frame& F, int L, bool dummy = false) {
    int li_ = F.li; asm volatile("" : "+s"(li_)); pg8::GroupOrder S; S.init(D, li_);
    pg8::Gemm g{(const GAS bf16*)FB(BO_HID), (const GAS bf16*)FWS(WS_WDOWN) + (size_t)L * D * FF, SEQ, D, FF, FF};
    GAS bf16* XBb = (GAS bf16*)FWS(WS_XB) + (size_t)F.b * SEQ * D; GAS float* SSQb = (GAS float*)FWS(WS_SSQ) + (size_t)F.b * SEQ * 16;
    if (L == DEPTH - 1 && !dummy) { pg8::EpiRes<true> E{XBb, SSQb, (GAS float*)ptr_at(F, I_OUT) + (size_t)F.b * SEQ * D, XBb};
        pg8::gemm_phase<pg8::EpiRes<true>, pg8::GroupOrder, false, true>(F.lds + RING_OFF, g, S, E); }
    else { pg8::EpiRes<false> E{XBb, SSQb, nullptr, dummy ? (GAS bf16*)FB(16 * MiB) : XBb};
        pg8::gemm_phase<pg8::EpiRes<false>, pg8::GroupOrder, false, true>(F.lds + RING_OFF, g, S, E); }
}

#ifndef PROBE_REP
#define PROBE_REP 0
#endif
struct Args { const float* in[17]; float* out; unsigned char* ws; int pad0, pad1; };
__global__ void __launch_bounds__(NTHREADS, 2) fwd(Args args) {
    extern __shared__ __attribute__((aligned(16))) unsigned char lds[];
    Frame F;
    F.lds = (LAS unsigned char*)lds;
    F.tid = threadIdx.x; F.lane = F.tid & 63; F.wave = __builtin_amdgcn_readfirstlane(F.tid >> 6); F.bid = blockIdx.x; F.G = gridDim.x; F.b = F.bid & 7; F.li = F.bid >> 3;
    for (int u = F.tid; u < (LDS_BYTES - LDSCTL_OFF) / 4; u += NTHREADS) ((LAS unsigned*)(F.lds + LDSCTL_OFF))[u] = 0u;
    __syncthreads();
    if (F.tid < I_NPTR) { const unsigned long long p = F.tid < 17 ? (unsigned long long)args.in[F.tid < 17 ? F.tid : 0] : (F.tid == I_OUT ? (unsigned long long)args.out : (unsigned long long)args.ws);
        LAS unsigned* t = (LAS unsigned*)(F.lds + PTR_OFF) + 2 * F.tid; t[0] = (unsigned)p; t[1] = (unsigned)(p >> 32); }
    LDS_WAIT(); __syncthreads();
    if (F.G != GRID) return;
#define GBAR_OBJ() XcdBarrier{(unsigned*)(unsigned char*)FWS(WS_CTL) + CW_BAR, xb_xcc_id(), (unsigned)GRID, (volatile LAS unsigned*)(F.lds + MISC_OFF) + 8}
#define GRP_OBJ()  XcdBarrier{(unsigned*)(unsigned char*)FWS(WS_CTL) + CW_GRP + (blockIdx.x & 7) * GRP_BAR_STRIDE, xb_xcc_id(), (unsigned)GRP, (volatile LAS unsigned*)(F.lds + MISC_OFF) + 12}
    (void)xcd_barrier_post((unsigned*)(unsigned char*)FWS(WS_CTL) + CW_BAR, (volatile LAS unsigned*)(F.lds + MISC_OFF) + 8, GRID);
    (void)xcd_barrier_post((unsigned*)(unsigned char*)FWS(WS_CTL) + CW_GRP + (blockIdx.x & 7) * GRP_BAR_STRIDE, (volatile LAS unsigned*)(F.lds + MISC_OFF) + 12, GRP);
#define RELAUNDER() do { int t_ = threadIdx.x; asm volatile("" : "+v"(t_)); F.tid = t_; F.lane = t_ & 63; F.wave = __builtin_amdgcn_readfirstlane(t_ >> 6); \
    int b_ = blockIdx.x; asm volatile("" : "+s"(b_)); F.bid = b_; F.b = b_ & 7; F.li = b_ >> 3; } while (0)
#define GRP_BAR() do { const XcdBarrier gb_ = GRP_OBJ(); xcd_barrier(gb_); } while (0)
#define GRID_BAR() do { const XcdBarrier gb_ = GBAR_OBJ(); xcd_barrier(gb_); } while (0)

    p0_prologue(F);
    if (PROBE_REP == 1) { GRID_BAR(); RELAUNDER(); p0_prologue(F); }
    GRID_BAR();
    for (int L = 0; L < DEPTH; ++L) {
        RELAUNDER(); ph_inproj(F, L); if (PROBE_REP == 2) { GRP_BAR(); RELAUNDER(); ph_inproj(F, L); }
        if (F.li >= 16) { RELAUNDER(); convert_rest(F, L); }
        GRP_BAR();
        RELAUNDER(); if (PROBE_REP == 20) { attn_fast(F, L, true); GRP_BAR(); RELAUNDER(); }
        if (PROBE_REP == 25) {
#pragma unroll 1
            for (int rep = 0; rep < 2; ++rep) { attn_fast(F, L, rep == 0); if (rep == 0) { GRP_BAR(); RELAUNDER(); } } }
        else attn_fast(F, L);
        ssd_states(F, L); if (PROBE_REP == 21) { GRP_BAR(); RELAUNDER(); ssd_states(F, L); } GRP_BAR();
        RELAUNDER(); ssd_scan(F, L); if (PROBE_REP == 22) { GRP_BAR(); RELAUNDER(); ssd_scan(F, L); } if (PROBE_REP == 24) { for (int k = 0; k < 8; ++k) GRP_BAR(); } GRP_BAR();
        RELAUNDER(); if (PROBE_REP == 23) { ssd_out(F, L, true); GRP_BAR(); RELAUNDER(); } ssd_out(F, L); GRP_BAR();
        RELAUNDER(); wait_weights(F, L); if (PROBE_REP == 30) { ph_outproj(F, L, true); GRP_BAR(); RELAUNDER(); } ph_outproj(F, L); GRP_BAR();
        RELAUNDER(); ph_up(F, L); if (PROBE_REP == 5) { GRP_BAR(); RELAUNDER(); ph_up(F, L); } GRP_BAR();
        RELAUNDER(); if (PROBE_REP == 31) { ph_down(F, L, true); GRP_BAR(); RELAUNDER(); } ph_down(F, L); if (L + 1 < DEPTH) GRP_BAR();
    }
}

extern "C" void kernel_launch(void* const* d_in, const int* in_sizes, int n_in, void* d_out, int out_size, void* d_ws, size_t ws_size, hipStream_t stream) {
    static int grid = 0;
    if (grid == 0) {
        if (n_in != 17 || in_sizes[0] != M * D || out_size != M * D || ws_size < WS_END) { fprintf(stderr, "kernel_launch: unexpected shapes (n_in %d, in0 %d, out %d, ws %zu)\n", n_in, n_in > 0 ? in_sizes[0] : -1, out_size, ws_size); grid = -1; return; }
        int dev = 0, cus = 0, per_cu = 0;
        if (hipGetDevice(&dev) != hipSuccess || hipDeviceGetAttribute(&cus, hipDeviceAttributeMultiprocessorCount, dev) != hipSuccess) { grid = -1; return; }
        if (hipFuncSetAttribute((const void*)fwd, hipFuncAttributeMaxDynamicSharedMemorySize, LDS_BYTES) != hipSuccess) { fprintf(stderr, "kernel_launch: hipFuncSetAttribute failed\n"); grid = -1; return; }
        if (hipOccupancyMaxActiveBlocksPerMultiprocessor(&per_cu, (const void*)fwd, NTHREADS, LDS_BYTES) != hipSuccess || per_cu < 1) { fprintf(stderr, "kernel_launch: occupancy query says %d\n", per_cu); per_cu = 0; }
        (void)hipGetLastError();
        if (cus * per_cu < GRID) { fprintf(stderr, "kernel_launch: this kernel needs %d co-resident workgroups (one per CU of a 256-CU device); the device admits %d x %d; nothing launched\n", GRID, cus, per_cu); grid = -1; return; }
        grid = GRID;
    }
    if (grid < 0) return;
    (void)hipMemsetAsync((char*)d_ws + WS_CTL, 0, CTL_ZERO_BYTES, stream);
    Args a{};
    for (int i = 0; i < 17; ++i) a.in[i] = (const float*)d_in[i];
    a.out = (float*)d_out; a.ws = (unsigned char*)d_ws;
    void* kargs[] = {&a};
    hipError_t e = hipLaunchCooperativeKernel((const void*)fwd, dim3(grid), dim3(NTHREADS), kargs, LDS_BYTES, stream);
    if (e != hipSuccess) fprintf(stderr, "kernel_launch: cooperative launch failed: %s (grid %d)\n", hipGetErrorString(e), grid);
}
```

```cpp
#include <hip/hip_runtime.h>
#include <cstdio>
#include <cstdint>
#define PROBE_REP 0


namespace pg8 {
#define PG8_LAS __attribute__((address_space(3)))
#define PG8_GAS __attribute__((address_space(1)))
typedef unsigned short bf16_t;
typedef short bf16x8 __attribute__((ext_vector_type(8)));
typedef float f32x4 __attribute__((ext_vector_type(4)));
typedef unsigned u32x4 __attribute__((ext_vector_type(4)));
constexpr int BM = 256, BK = 64, HALF = 128, HTB = HALF * BK * 2  , STAGE_BYTES = 8 * HTB, NXCD = 8, WGM = 8;

__host__ __device__ __forceinline__ int lds_byte(int r, int c) { const int st = (r >> 4) * 2 + (c >> 5), rr = r & 15, cc = c & 31, ob = rr * 64 + cc * 2; return st * 1024 + (ob ^ (((ob >> 9) & 1) << 5)); }
__host__ __device__ __forceinline__ void stage_rc(int b, int& R, int& C) { const int st = b / 1024, sb = b % 1024, swz = sb ^ (((sb >> 9) & 1) << 5); R = (st >> 1) * 16 + swz / 64; C = (st & 1) * 32 + (swz % 64) / 2; }
__host__ __device__ __forceinline__ int perm32(int rho) { const int n = rho >> 4, i = rho & 15; return 8 * (i >> 2) + 4 * n + (i & 3); }

struct Unit { int pm, pn; };
struct Gemm { const PG8_GAS bf16_t* A; const PG8_GAS bf16_t* Bt; int M, N, K, lda; };

struct StaticOrder {
    int nM, nN, nwg, G, c;
    __host__ __device__ void init(int M, int N, int G_, int c_) { nM = M / BM; nN = N / BM; nwg = nM * nN; G = G_; c = c_; }
    __host__ __device__ bool next(int i, Unit& u) const {
        const long L = (long)i * G + c; if (L >= nwg) return false;
        int wgid = (int)L; { const int q = nwg / NXCD, r = nwg % NXCD, xcd = wgid % NXCD, off = wgid / NXCD; wgid = (xcd < r ? xcd * (q + 1) : r * (q + 1) + (xcd - r) * q) + off; }
        const int nig = WGM * nN, gid = wgid / nig, fm = gid * WGM, gsz = (nM - fm) < WGM ? (nM - fm) : WGM;
        u.pm = fm + ((wgid % nig) % gsz); u.pn = (wgid % nig) / gsz; return true;
    }
    __device__ __forceinline__ void a_ready(const Unit&) const {}
    __device__ __forceinline__ void done(const Unit&) const {}
};

struct GroupOrder {
    int nN, li;
    __host__ __device__ void init(int N, int li_) { nN = N / BM; li = li_; }
    __host__ __device__ bool next(int i, Unit& u) const { const int T = i * 32 + li; if (T >= 8 * nN) return false; u.pm = T & 7; u.pn = T >> 3; return true; }
    __device__ __forceinline__ void a_ready(const Unit&) const {}
    __device__ __forceinline__ void done(const Unit&) const {}
};

__device__ __forceinline__ float shx(float v, int k, int lane) { return __builtin_bit_cast(float, __builtin_amdgcn_ds_bpermute((lane ^ k) << 2, __builtin_bit_cast(int, v))); }
typedef float f32x2_t __attribute__((ext_vector_type(2))); typedef __bf16 bf16x2_t __attribute__((ext_vector_type(2)));
__device__ __forceinline__ unsigned cvt_pk_bf16(float lo, float hi) { f32x2_t v = {lo, hi}; bf16x2_t b = __builtin_convertvector(v, bf16x2_t); return __builtin_bit_cast(unsigned, b); }

constexpr int PROJ_PITCH = 2304, DT_TILE = 9;
struct EpiProj {
    static constexpr bool PERM = true, AFTER_DRAIN = false, ACC_INIT = false, PRE_HOOK = true;
    PG8_GAS bf16_t* O; PG8_GAS float* dtraw; PG8_LAS float* rstd; f32x4 pa, pb;
    __device__ __forceinline__ void pre(int tid) const {
        float s = (pa[0] + pa[1]) + (pa[2] + pa[3]) + (pb[0] + pb[1]) + (pb[2] + pb[3]);
        s += shx(s, 1, tid & 63);
        if ((tid & 1) == 0) rstd[tid >> 1] = 1.0f / sqrtf(s * (1.0f / 1024.0f) + 1e-6f);
    }
    __device__ __forceinline__ void operator()(const f32x4 (&acc)[2][2][4][2], const Unit& u, int ui, int wr, int wc, int fr, int fq) const {
        int rt0 = wr * 64 + fr; asm volatile("" : "+v"(rt0));
        if (u.pn == DT_TILE) {
            if (wc == 0 && fq == 0) {
#pragma unroll
                for (int ai = 0; ai < 2; ++ai)
#pragma unroll
                    for (int m = 0; m < 4; ++m) { const int rt = ai * HALF + rt0 + m * 16; const float rs = rstd[rt]; PG8_GAS float* p = dtraw + (size_t)(u.pm * BM + rt) * 8;
                        *(PG8_GAS f32x4*)p = acc[ai][0][m][0] * rs; *(PG8_GAS f32x4*)(p + 4) = acc[ai][0][m][1] * rs; }
            }
            return;
        }
        const int col0 = u.pn * BM + wc * 32 + 8 * fq;
#pragma unroll
        for (int ai = 0; ai < 2; ++ai)
#pragma unroll
            for (int m = 0; m < 4; ++m) { const int rt = ai * HALF + rt0 + m * 16; const float rs = rstd[rt]; PG8_GAS bf16_t* rowp = O + (size_t)(u.pm * BM + rt) * PROJ_PITCH + col0;
#pragma unroll
                for (int bj = 0; bj < 2; ++bj) { const f32x4 v0 = acc[ai][bj][m][0] * rs, v1 = acc[ai][bj][m][1] * rs;
                    u32x4 w; w.x = cvt_pk_bf16(v0[0], v0[1]); w.y = cvt_pk_bf16(v0[2], v0[3]); w.z = cvt_pk_bf16(v1[0], v1[1]); w.w = cvt_pk_bf16(v1[2], v1[3]);
                    *(PG8_GAS u32x4*)(rowp + bj * HALF) = w; } }
    }
};
struct EpiUp {
    static constexpr bool PERM = true, AFTER_DRAIN = false, ACC_INIT = false, PRE_HOOK = true;
    PG8_GAS bf16_t* O; int ldc; PG8_LAS float* rstd; f32x4 pa, pb;
    __device__ __forceinline__ void pre(int tid) const {
        float s = (pa[0] + pa[1]) + (pa[2] + pa[3]) + (pb[0] + pb[1]) + (pb[2] + pb[3]);
        s += shx(s, 1, tid & 63);
        if ((tid & 1) == 0) rstd[tid >> 1] = 1.0f / sqrtf(s * (1.0f / 1024.0f) + 1e-6f);
    }
    __device__ __forceinline__ void operator()(const f32x4 (&acc)[2][2][4][2], const Unit& u, int ui, int wr, int wc, int fr, int fq) const {
        int rt0 = wr * 64 + fr; asm volatile("" : "+v"(rt0)); const int col0 = u.pn * BM + wc * 32 + 8 * fq;
#pragma unroll
        for (int ai = 0; ai < 2; ++ai)
#pragma unroll
            for (int m = 0; m < 4; ++m) { const int rt = ai * HALF + rt0 + m * 16; const float rs = rstd[rt]; PG8_GAS bf16_t* rowp = O + (size_t)(u.pm * BM + rt) * ldc + col0;
#pragma unroll
                for (int bj = 0; bj < 2; ++bj) { f32x4 v0 = acc[ai][bj][m][0] * rs, v1 = acc[ai][bj][m][1] * rs;
#pragma unroll
                    for (int e = 0; e < 4; ++e) { const float a = fmaxf(v0[e], 0.f), b = fmaxf(v1[e], 0.f); v0[e] = a * a; v1[e] = b * b; }
                    u32x4 w; w.x = cvt_pk_bf16(v0[0], v0[1]); w.y = cvt_pk_bf16(v0[2], v0[3]); w.z = cvt_pk_bf16(v1[0], v1[1]); w.w = cvt_pk_bf16(v1[2], v1[3]);
                    *(PG8_GAS u32x4*)(rowp + bj * HALF) = w; } }
    }
};
template <bool FINAL> struct EpiRes {
    static constexpr bool PERM = true, AFTER_DRAIN = false, ACC_INIT = true, PRE_HOOK = false;
    PG8_GAS bf16_t* xb; PG8_GAS float* ssq; PG8_GAS float* out; PG8_GAS bf16_t* xdst;
    __device__ __forceinline__ void init(f32x4 (&acc)[2][2][4][2], const Unit& u, int wr, int wc, int fr, int fq) const {
        const int rt0 = wr * 64 + fr, col0 = u.pn * BM + wc * 32 + 8 * fq;
#pragma unroll
        for (int ai = 0; ai < 2; ++ai)
#pragma unroll
            for (int m = 0; m < 4; ++m) { const int row = u.pm * BM + ai * HALF + rt0 + m * 16; const size_t off = (size_t)row * 1024 + col0;
#pragma unroll
                for (int bj = 0; bj < 2; ++bj) { const u32x4 rw = *(const PG8_GAS u32x4*)(xb + off + bj * HALF);
                    acc[ai][bj][m][0] = (f32x4){__uint_as_float(rw.x << 16), __uint_as_float(rw.x & 0xffff0000u), __uint_as_float(rw.y << 16), __uint_as_float(rw.y & 0xffff0000u)};
                    acc[ai][bj][m][1] = (f32x4){__uint_as_float(rw.z << 16), __uint_as_float(rw.z & 0xffff0000u), __uint_as_float(rw.w << 16), __uint_as_float(rw.w & 0xffff0000u)}; } }
    }
    __device__ __forceinline__ void operator()(const f32x4 (&acc)[2][2][4][2], const Unit& u, int ui, int wr, int wc, int fr, int fq) const {
        int rt0 = wr * 64 + fr; asm volatile("" : "+v"(rt0)); const int col0 = u.pn * BM + wc * 32 + 8 * fq;
#pragma unroll
        for (int ai = 0; ai < 2; ++ai)
#pragma unroll
            for (int m = 0; m < 4; ++m) { const int row = u.pm * BM + ai * HALF + rt0 + m * 16; const size_t off = (size_t)row * 1024 + col0; float s = 0.f;
#pragma unroll
                for (int bj = 0; bj < 2; ++bj) { const f32x4 v0 = acc[ai][bj][m][0], v1 = acc[ai][bj][m][1];
                    if (FINAL) { *(PG8_GAS f32x4*)(out + off + bj * HALF) = v0; *(PG8_GAS f32x4*)(out + off + bj * HALF + 4) = v1; }
                    else { u32x4 w; w.x = cvt_pk_bf16(v0[0], v0[1]); w.y = cvt_pk_bf16(v0[2], v0[3]); w.z = cvt_pk_bf16(v1[0], v1[1]); w.w = cvt_pk_bf16(v1[2], v1[3]);
                        *(PG8_GAS u32x4*)(xdst + off + bj * HALF) = w;
                        s += (v0[0] * v0[0] + v0[1] * v0[1]) + (v0[2] * v0[2] + v0[3] * v0[3]) + (v1[0] * v1[0] + v1[1] * v1[1]) + (v1[2] * v1[2] + v1[3] * v1[3]); } }
                if (!FINAL) { const int ln = fq * 16 + fr; s += shx(s, 16, ln); s += shx(s, 32, ln);
                    if (fq == 0) ssq[(size_t)row * 16 + u.pn * 4 + wc] = s; } }
    }
};

template <class Epi, class Sched, bool ALIGN_EPI = false, bool SP2 = false>
__device__ __forceinline__ void gemm_phase(PG8_LAS unsigned char* lds, const Gemm g, const Sched& S, const Epi& E) {
    int tid_ = threadIdx.x; asm volatile("" : "+v"(tid_));
    const int tid = tid_, wid = __builtin_amdgcn_readfirstlane(tid >> 6), lane = tid & 63, wr = wid >> 2, wc = wid & 3, fr = lane & 15, fq = lane >> 4;
    const int K = g.K, nt = K / BK;
    unsigned voffA[2], voffB[2];
#pragma unroll
    for (int i = 0; i < 2; ++i) { int R, C; stage_rc(tid * 16 + i * 8192, R, C); const int Rb = Epi::PERM ? ((R & ~31) + perm32(R & 31)) : R;
        voffA[i] = (unsigned)(R * g.lda + C) * 2u; voffB[i] = (unsigned)(Rb * K + C) * 2u; }
    const size_t kstep = (size_t)(BK * 2);
    const size_t hstepA = (size_t)HALF * g.lda * 2, hstepB = (size_t)HALF * K * 2;
    const size_t tstepA = 2 * hstepA, tstepB = 2 * hstepB;
    const unsigned ldsw = (unsigned)wid * 1024u;
    const int aoff = lds_byte(wr * 64 + fr, fq * 8), boff = lds_byte(wc * 32 + fr, fq * 8);
#define PG8_SA(b, h) (((b) * 2 + (h)) * HTB)
#define PG8_SB(b, h) ((4 + (b) * 2 + (h)) * HTB)
#define PG8_STAGE(bufoff, gbase, voff) do { _Pragma("unroll") for (int _i = 0; _i < 2; ++_i) \
        __builtin_amdgcn_global_load_lds((const unsigned*)((const char*)(gbase) + (voff)[_i]), (PG8_LAS unsigned*)(lds + (bufoff) + ldsw + _i * 8192), 16, 0, 0); } while (0)
#define PG8_LDA(dst, b, h) do { _Pragma("unroll") for (int m = 0; m < 4; ++m) _Pragma("unroll") for (int k = 0; k < 2; ++k) dst[m][k] = *(const PG8_LAS bf16x8*)(lds + PG8_SA(b, h) + aoff + m * 2048 + k * 1024); } while (0)
#define PG8_LDB(dst, b, h) do { _Pragma("unroll") for (int n = 0; n < 2; ++n) _Pragma("unroll") for (int k = 0; k < 2; ++k) dst[n][k] = *(const PG8_LAS bf16x8*)(lds + PG8_SB(b, h) + boff + n * 2048 + k * 1024); } while (0)
#define PG8_MMA(ai, bj, At, Bt) do { __builtin_amdgcn_s_setprio(1); _Pragma("unroll") for (int m = 0; m < 4; ++m) _Pragma("unroll") for (int n = 0; n < 2; ++n) _Pragma("unroll") for (int k = 0; k < 2; ++k) \
        acc[ai][bj][m][n] = __builtin_amdgcn_mfma_f32_16x16x32_bf16(Bt[n][k], At[m][k], acc[ai][bj][m][n], 0, 0, 0); __builtin_amdgcn_s_setprio(0); } while (0)
#define PG8_WAIT_V(n) asm volatile("s_waitcnt vmcnt(" #n ")" ::: "memory")
#define PG8_WAIT_L(n) asm volatile("s_waitcnt lgkmcnt(" #n ")" ::: "memory")
#define PG8_BAR __builtin_amdgcn_s_barrier()
#define PG8_SCHED __builtin_amdgcn_sched_barrier(0)
    Unit cur, nxt; int ui = 0;
    if (!S.next(0, cur)) return;
    f32x4 acc[2][2][4][2];
#pragma unroll
    for (int a = 0; a < 2; ++a)
#pragma unroll
        for (int b = 0; b < 2; ++b)
#pragma unroll
            for (int m = 0; m < 4; ++m)
#pragma unroll
                for (int n = 0; n < 2; ++n) acc[a][b][m][n] = (f32x4){0.f, 0.f, 0.f, 0.f};
    if constexpr (Epi::ACC_INIT) E.init(acc, cur, wr, wc, fr, fq);
    bf16x8 At[4][2], B0[2][2], B1[2][2];
    const char* cA = (const char*)g.A + (size_t)cur.pm * tstepA; const char* cB = (const char*)g.Bt + (size_t)cur.pn * tstepB;
    S.a_ready(cur);
    if constexpr (SP2) {
        PG8_STAGE(PG8_SB(0, 0), cB, voffB); PG8_STAGE(PG8_SB(0, 1), cB + hstepB, voffB); PG8_STAGE(PG8_SA(0, 0), cA, voffA); PG8_STAGE(PG8_SA(0, 1), cA + hstepA, voffA);
        if constexpr (Epi::PRE_HOOK) E.pre(tid);
        if (wr == 1) PG8_BAR;
        PG8_WAIT_V(2); PG8_BAR;
        PG8_STAGE(PG8_SB(1, 0), cB + kstep, voffB); PG8_STAGE(PG8_SA(1, 0), cA + kstep, voffA); PG8_STAGE(PG8_SB(1, 1), cB + hstepB + kstep, voffB);
        PG8_WAIT_V(6); PG8_BAR;
    } else {
        PG8_STAGE(PG8_SB(0, 0), cB, voffB); PG8_STAGE(PG8_SA(0, 0), cA, voffA); PG8_STAGE(PG8_SB(0, 1), cB + hstepB, voffB); PG8_STAGE(PG8_SA(0, 1), cA + hstepA, voffA);
        if (wr == 1) PG8_BAR;
        PG8_WAIT_V(4); PG8_BAR;
        PG8_STAGE(PG8_SB(1, 0), cB + kstep, voffB); PG8_STAGE(PG8_SA(1, 0), cA + kstep, voffA); PG8_STAGE(PG8_SB(1, 1), cB + hstepB + kstep, voffB);
        PG8_WAIT_V(6); PG8_BAR;
    }
    for (;;) {
        const bool has_next = S.next(ui + 1, nxt);
        const char* nA = has_next ? (const char*)g.A + (size_t)nxt.pm * tstepA : cA; const char* nB = has_next ? (const char*)g.Bt + (size_t)nxt.pn * tstepB : cB;
        for (int t = 0; t < nt; t += 2) {
            const bool last = (t == nt - 2);
            const char* a1 = cA + (size_t)(t + 1) * kstep;
            const char* a2 = last ? nA : cA + (size_t)(t + 2) * kstep; const char* b2 = last ? nB : cB + (size_t)(t + 2) * kstep;
            const char* a3 = a2 + kstep; const char* b3 = b2 + kstep;
            if (last && has_next) S.a_ready(nxt);
            if constexpr (SP2) {
            PG8_LDB(B0, 0, 0); PG8_LDB(B1, 0, 1); PG8_SCHED; PG8_LDA(At, 0, 0); PG8_STAGE(PG8_SA(1, 1), a1 + hstepA, voffA);
            PG8_WAIT_V(8); PG8_WAIT_L(0); PG8_BAR; PG8_MMA(0, 0, At, B0); PG8_MMA(0, 1, At, B1); PG8_BAR; PG8_SCHED;
            PG8_LDA(At, 0, 1); PG8_STAGE(PG8_SB(0, 0), b2, voffB); PG8_STAGE(PG8_SB(0, 1), b2 + hstepB, voffB); PG8_STAGE(PG8_SA(0, 0), a2, voffA);
            PG8_WAIT_V(8); PG8_WAIT_L(0); PG8_BAR; PG8_MMA(1, 0, At, B0); PG8_MMA(1, 1, At, B1); PG8_BAR; PG8_SCHED;
            PG8_LDB(B0, 1, 0); PG8_LDB(B1, 1, 1); PG8_SCHED; PG8_LDA(At, 1, 0); PG8_STAGE(PG8_SA(0, 1), a2 + hstepA, voffA);
            PG8_WAIT_V(8); PG8_WAIT_L(0); PG8_BAR; PG8_MMA(0, 0, At, B0); PG8_MMA(0, 1, At, B1); PG8_BAR; PG8_SCHED;
            PG8_LDA(At, 1, 1); PG8_STAGE(PG8_SB(1, 0), b3, voffB); PG8_STAGE(PG8_SB(1, 1), b3 + hstepB, voffB); PG8_STAGE(PG8_SA(1, 0), a3, voffA);
            PG8_WAIT_V(8); PG8_WAIT_L(0); PG8_BAR; PG8_MMA(1, 0, At, B0); PG8_MMA(1, 1, At, B1); PG8_BAR; PG8_SCHED;
            } else {
            PG8_LDB(B0, 0, 0); PG8_SCHED; PG8_LDA(At, 0, 0); PG8_STAGE(PG8_SA(1, 1), a1 + hstepA, voffA);
            PG8_WAIT_L(8); PG8_BAR; PG8_WAIT_L(0); PG8_MMA(0, 0, At, B0); PG8_BAR; PG8_SCHED;
            PG8_LDB(B1, 0, 1); PG8_STAGE(PG8_SB(0, 0), b2, voffB);
            PG8_BAR; PG8_WAIT_L(0); PG8_MMA(0, 1, At, B1); PG8_BAR;
            PG8_LDA(At, 0, 1); PG8_STAGE(PG8_SA(0, 0), a2, voffA);
            PG8_BAR; PG8_WAIT_L(0); PG8_MMA(1, 0, At, B0); PG8_BAR; PG8_SCHED;
            PG8_STAGE(PG8_SB(0, 1), b2 + hstepB, voffB);
            PG8_WAIT_V(6); PG8_BAR; PG8_MMA(1, 1, At, B1); PG8_BAR;
            PG8_LDB(B0, 1, 0); PG8_SCHED; PG8_LDA(At, 1, 0); PG8_STAGE(PG8_SA(0, 1), a2 + hstepA, voffA);
            PG8_WAIT_L(8); PG8_BAR; PG8_WAIT_L(0); PG8_MMA(0, 0, At, B0); PG8_BAR; PG8_SCHED;
            PG8_LDB(B1, 1, 1); PG8_STAGE(PG8_SB(1, 0), b3, voffB);
            PG8_BAR; PG8_WAIT_L(0); PG8_MMA(0, 1, At, B1); PG8_BAR;
            PG8_LDA(At, 1, 1); PG8_STAGE(PG8_SA(1, 0), a3, voffA);
            PG8_BAR; PG8_WAIT_L(0); PG8_MMA(1, 0, At, B0); PG8_BAR; PG8_SCHED;
            PG8_STAGE(PG8_SB(1, 1), b3 + hstepB, voffB);
            PG8_WAIT_V(6); PG8_BAR; PG8_MMA(1, 1, At, B1); PG8_BAR;
            }
        }
        if constexpr (ALIGN_EPI) { if (wr == 0) PG8_BAR; }
        if constexpr (!Epi::AFTER_DRAIN) { E(acc, cur, ui, wr, wc, fr, fq); S.done(cur); }
        if (!has_next) break;
#pragma unroll
        for (int a = 0; a < 2; ++a)
#pragma unroll
            for (int b = 0; b < 2; ++b)
#pragma unroll
                for (int m = 0; m < 4; ++m)
#pragma unroll
                    for (int n = 0; n < 2; ++n) acc[a][b][m][n] = (f32x4){0.f, 0.f, 0.f, 0.f};
        cur = nxt; cA = nA; cB = nB; ++ui;
        if constexpr (ALIGN_EPI) { if (wr == 1) PG8_BAR; }
    }
    PG8_WAIT_V(0);
    if constexpr (!ALIGN_EPI) { if (wr == 0) PG8_BAR; }
    PG8_BAR;

#undef PG8_SA
#undef PG8_SB
#undef PG8_STAGE
#undef PG8_LDA
#undef PG8_LDB
#undef PG8_MMA
#undef PG8_WAIT_V
#undef PG8_WAIT_L
#undef PG8_BAR
#undef PG8_SCHED
}
}

constexpr int NWAVES = 8, NTHREADS = NWAVES * 64;
constexpr int BATCH = 8, SEQ = 2048, D = 1024, M = BATCH * SEQ, FF = 4096, DEPTH = 2;
constexpr int D_IN = 2312, NPROJ = 2560, PP = pg8::PROJ_PITCH;
constexpr int CQ = 0, CZ = 512, CK = 1024, CV = 1152, CX = 1280, CBM = 1792, CCM = 2048;
constexpr float EPS = 1e-6f;
constexpr int GRID = 256, NGRP = 8, GRP = GRID / NGRP;

constexpr size_t MiB = 1u << 20;
constexpr size_t WS_CTL = 0, CTL_ZERO_BYTES = 1 * MiB;
constexpr size_t WS_SSQ = 1 * MiB;
constexpr size_t WS_DTRAW = 2 * MiB;
constexpr size_t WS_ACS = 2 * MiB + 512 * 1024, WS_CHDEC = 3 * MiB;
constexpr size_t WS_WIN = 4 * MiB, WS_WOUT = 14 * MiB, WS_WUP = 18 * MiB, WS_WDOWN = 34 * MiB;
constexpr size_t WS_XB = 50 * MiB;
constexpr size_t WS_BATCH0 = 82 * MiB, BATCH_STRIDE = 20 * MiB;
constexpr size_t BO_PROJ = 0;
constexpr size_t BO_STATES = 9 * MiB;
constexpr size_t BO_PREV = 13 * MiB;
constexpr size_t BO_YPART = 15 * MiB;
constexpr size_t BO_CC = 19 * MiB;
constexpr size_t BO_HID = 0;
constexpr size_t WS_END = WS_BATCH0 + BATCH * BATCH_STRIDE;
static_assert(WS_END <= 256 * MiB, "d_ws map");
constexpr int CW_BAR = 4096, CW_GRP = 16384, GRP_BAR_STRIDE = 4096;

constexpr int RING_OFF = 0, RING_BYTES = 131072;
constexpr int MIX_BYTES = 155648;
constexpr int LDSCTL_OFF = MIX_BYTES, MISC_OFF = LDSCTL_OFF + 320, RSTD_OFF = LDSCTL_OFF + 512, PTR_OFF = RSTD_OFF + 4096;
constexpr int LDS_BYTES = 163840;
static_assert(PTR_OFF + 512 <= LDS_BYTES && RING_BYTES <= MIX_BYTES, "LDS map");

#define GAS __attribute__((address_space(1)))
#define LAS __attribute__((address_space(3)))
typedef unsigned short bf16;
typedef unsigned v4u __attribute__((ext_vector_type(4)));
typedef unsigned v2u __attribute__((ext_vector_type(2)));
typedef float f32x4 __attribute__((ext_vector_type(4)));
#define LDS_WAIT() asm volatile("s_waitcnt lgkmcnt(0)" ::: "memory")
#define VM_WAIT() asm volatile("s_waitcnt vmcnt(0)" ::: "memory")
__device__ __forceinline__ unsigned f2bf(float f) { unsigned u = __builtin_bit_cast(unsigned, f); return (u + 0x7fffu + ((u >> 16) & 1u)) >> 16; }
__device__ __forceinline__ unsigned pk2(float lo, float hi) { return f2bf(lo) | (f2bf(hi) << 16); }
__device__ __forceinline__ float bflo(unsigned w) { return __uint_as_float(w << 16); }
__device__ __forceinline__ float bfhi(unsigned w) { return __uint_as_float(w & 0xffff0000u); }
__device__ __forceinline__ float silu_f(float v) { return v / (1.f + expf(-v)); }
__device__ __forceinline__ float softplus_f(float v) { return fmaxf(v, 0.f) + log1pf(expf(-fabsf(v))); }

#define XB_TMO      128
#define XB_XCNT(j)  (256  + 64 * (j))
#define XB_XSUB(j)  (1280 + 64 * (j))
#define XB_XGEN(j)  (2304 + 64 * (j))
#define XB_TOP      3328
#define XB_TOPGEN   3392
#define XCD_BAR_WORDS 3456
#define XB_SPIN_CAP (1u << 22)
__device__ __forceinline__ unsigned xb_ld(unsigned* p)              { return __hip_atomic_load(p, __ATOMIC_RELAXED, __HIP_MEMORY_SCOPE_AGENT); }
__device__ __forceinline__ unsigned xb_add(unsigned* p, unsigned v) { return __hip_atomic_fetch_add(p, v, __ATOMIC_RELAXED, __HIP_MEMORY_SCOPE_AGENT); }
__device__ __forceinline__ unsigned xb_xcc_id() { return (unsigned)__builtin_amdgcn_s_getreg((3 << 11) | 20) & 0xFu; }
#define XB_SPIN(cond, bar) do { unsigned _sp = 0; while (cond) { __builtin_amdgcn_s_sleep(1); \
    if ((++_sp & 255u) == 0u) { if (xb_ld(&(bar)[XB_TMO])) break; if (_sp > XB_SPIN_CAP) { atomicAdd(&(bar)[XB_TMO], 1u); break; } } } } while (0)
struct XcdBarrier { unsigned* bar; unsigned x; unsigned total; volatile LAS unsigned* st; };
__device__ __forceinline__ XcdBarrier xcd_barrier_post(unsigned* bar, volatile LAS unsigned* st, unsigned total) {
    XcdBarrier b; b.bar = bar; b.x = xb_xcc_id(); b.total = total; b.st = st;
    if (threadIdx.x == 0) (void)xb_add(&bar[XB_XCNT(b.x)], 1u);
    return b;
}
__device__ __forceinline__ void xcd_barrier_complete(unsigned* bar, unsigned x, unsigned G, unsigned& nloc, unsigned& nx) {
    unsigned sum, cnt, mine, sp = 0u;
    for (;;) {
        sum = 0u; cnt = 0u; mine = 0u;
#pragma unroll
        for (unsigned j = 0; j < 16; ++j) { const unsigned c = xb_ld(&bar[XB_XCNT(j)]); sum += c; cnt += (c > 0u) ? 1u : 0u; mine = (j == x) ? c : mine; }
        if (sum == G) break;
        __builtin_amdgcn_s_sleep(1);
        if ((++sp & 255u) == 0u) { if (xb_ld(&bar[XB_TMO])) break; if (sp > XB_SPIN_CAP) { atomicAdd(&bar[XB_TMO], 1u); break; } }
    }
    nloc = mine > 0u ? mine : 1u; nx = cnt > 0u ? cnt : 1u;
}
__device__ __forceinline__ void xcd_barrier(const XcdBarrier& b) {
    asm volatile("s_waitcnt vmcnt(0)" ::: "memory");
    __syncthreads();
    if (threadIdx.x == 0) {
        unsigned* bar = b.bar;
        __builtin_amdgcn_s_waitcnt(0);
        unsigned nloc = b.st[0], nx = b.st[1];
        if (nloc == 0u) { xcd_barrier_complete(bar, b.x, b.total, nloc, nx); b.st[0] = nloc; b.st[1] = nx; }
        const unsigned old = xb_add(&bar[XB_XSUB(b.x)], 1u);
        const unsigned gen = old / nloc;
        if (nx == 1u) {
            XB_SPIN(xb_ld(&bar[XB_XSUB(b.x)]) < (gen + 1u) * nloc, bar);
            __builtin_amdgcn_fence(__ATOMIC_ACQUIRE, "agent");
            asm volatile("s_waitcnt vmcnt(0)" ::: "memory");
        } else if (old + 1u == (gen + 1u) * nloc) {
            __builtin_amdgcn_fence(__ATOMIC_RELEASE, "agent");
            asm volatile("s_waitcnt vmcnt(0)" ::: "memory");
            const unsigned og = xb_add(&bar[XB_TOP], 1u);
            const unsigned tg = og / nx;
            if (og + 1u == (tg + 1u) * nx) xb_add(&bar[XB_TOPGEN], 1u);
            else XB_SPIN(xb_ld(&bar[XB_TOPGEN]) == tg, bar);
            __builtin_amdgcn_fence(__ATOMIC_ACQUIRE, "agent");
            xb_add(&bar[XB_XGEN(b.x)], 1u);
            asm volatile("s_waitcnt vmcnt(0)" ::: "memory");
        } else {
            XB_SPIN(xb_ld(&bar[XB_XGEN(b.x)]) == gen, bar);
            __builtin_amdgcn_fence(__ATOMIC_ACQUIRE, "agent");
            asm volatile("s_waitcnt vmcnt(0)" ::: "memory");
        }
    }
    __syncthreads();
}

struct Frame {
    LAS unsigned char* lds;
    int tid, lane, wave, bid, G;
    int b, li;
};
enum { I_X = 0, I_MIXG, I_WIN, I_QG, I_KG, I_SINK, I_RELB, I_CONVW, I_CONVB, I_DTB, I_ALOG, I_DSKIP, I_SSMG, I_WOUT, I_MLPG, I_WUP, I_WDOWN, I_OUT, I_WS, I_NPTR };
__device__ __forceinline__ GAS unsigned char* ptr_at(const Frame& F, int i) {
    const LAS unsigned* t = (const LAS unsigned*)(F.lds + PTR_OFF) + 2 * i;
    const unsigned lo = __builtin_amdgcn_readfirstlane(t[0]), hi = __builtin_amdgcn_readfirstlane(t[1]);
    return (GAS unsigned char*)(((unsigned long long)hi << 32) | lo);
}
#define FIN(i) ((const GAS float*)ptr_at(F, (i)))
#define FWS(off) (ptr_at(F, I_WS) + (off))
#define FB(off) (ptr_at(F, I_WS) + (WS_BATCH0 + (size_t)F.b * BATCH_STRIDE + (off)))
using pg8::shx;
__device__ __forceinline__ float shup(float v, int o, int lane) { return __builtin_bit_cast(float, __builtin_amdgcn_ds_bpermute(((lane - o) & 63) << 2, __builtin_bit_cast(int, v))); }
__device__ __forceinline__ float wave_sum(float v, int lane) {
#pragma unroll
    for (int o = 1; o < 64; o <<= 1) v += shx(v, o, lane);
    return v;
}

__device__ __forceinline__ void tr_item(const GAS float* W, int Nsrc, int nsrc0, int nvalid, int K, const GAS float* gain, GAS bf16* WT, int ndst0, int k0, LAS float* scr, int lane) {
    const int n = lane & 31;
    float tv[32];
#pragma unroll
    for (int i = 0; i < 32; ++i) { const int kk = 2 * i + (lane >> 5); tv[i] = __builtin_nontemporal_load(&W[(size_t)(k0 + kk) * Nsrc + nsrc0 + (n < nvalid ? n : 0)]); }
#pragma unroll
    for (int i = 0; i < 32; ++i) { const int kk = 2 * i + (lane >> 5); float v = (n < nvalid) ? tv[i] : 0.f; if (gain) v *= gain[k0 + kk];
        scr[kk * 33 + n] = v; }
    LDS_WAIT(); asm volatile("" ::: "memory");
    const int c = lane & 7;
#pragma unroll
    for (int j = 0; j < 4; ++j) { const int nn = (lane >> 3) + 8 * j; const LAS float* s = scr + (8 * c) * 33 + nn;
        v4u o; o.x = pk2(s[0 * 33], s[1 * 33]); o.y = pk2(s[2 * 33], s[3 * 33]); o.z = pk2(s[4 * 33], s[5 * 33]); o.w = pk2(s[6 * 33], s[7 * 33]);
        *(GAS v4u*)(WT + (size_t)(ndst0 + nn) * K + k0 + 8 * c) = o; }
    LDS_WAIT(); asm volatile("" ::: "memory");
}
__device__ __forceinline__ void win_item(Frame& F, int L, int r, LAS float* scr);
__device__ __forceinline__ void p0_prologue(Frame& F) {
    LAS float* scr = (LAS float*)(F.lds + RING_OFF + F.wave * 16384);
    const int gw = F.bid * NWAVES + F.wave, NGW = F.G * NWAVES;
    constexpr int I_IN = 16 * 80, I_OUT = 16 * 32, I_UP = 16 * 128, I_DN = 64 * 32, I_L = I_IN + I_OUT + I_UP + I_DN;
    for (int it = gw; it < I_IN; it += NGW) win_item(F, 0, it, scr);
    const GAS float* x = FIN(I_X) + (size_t)F.b * SEQ * D; GAS bf16* XB = (GAS bf16*)FWS(WS_XB) + (size_t)F.b * SEQ * D; GAS float* SSQ = (GAS float*)FWS(WS_SSQ) + (size_t)F.b * SEQ * 16;
    for (int m = F.li * NWAVES + F.wave; m < SEQ; m += 4 * GRP * NWAVES) {
        f32x4 v[4][4]; float s[4];
#pragma unroll
        for (int r = 0; r < 4; ++r) { const GAS f32x4* xr = (const GAS f32x4*)(x + (size_t)(m + r * GRP * NWAVES) * D) + F.lane;
#pragma unroll
            for (int j = 0; j < 4; ++j) v[r][j] = __builtin_nontemporal_load(xr + 64 * j); }
#pragma unroll
        for (int r = 0; r < 4; ++r) { float t = 0.f;
#pragma unroll
            for (int j = 0; j < 4; ++j) t += (v[r][j].x * v[r][j].x + v[r][j].y * v[r][j].y) + (v[r][j].z * v[r][j].z + v[r][j].w * v[r][j].w);
            s[r] = wave_sum(t, F.lane); }
#pragma unroll
        for (int r = 0; r < 4; ++r) { const size_t row = (size_t)(m + r * GRP * NWAVES); GAS v2u* o8 = (GAS v2u*)(XB + row * D) + F.lane;
#pragma unroll
            for (int j = 0; j < 4; ++j) { v2u o; o.x = pk2(v[r][j].x, v[r][j].y); o.y = pk2(v[r][j].z, v[r][j].w); o8[64 * j] = o; }
            if (F.lane < 16) SSQ[row * 16 + F.lane] = (F.lane == 0) ? s[r] : 0.f; }
    }
}
constexpr int CW_WCNT = 8192, N_CONVERTERS = NGRP * (GRP - 16);
__device__ __forceinline__ void win_item(Frame& F, int L, int r, LAS float* scr) {
    const int kb = r / 80, nb = r % 80; int src, nv = 32;
    if (nb < 16) src = nb * 32; else if (nb < 32) src = 768 + (nb - 16) * 32; else if (nb < 36) src = 512 + (nb - 32) * 32; else if (nb < 40) src = 640 + (nb - 36) * 32;
    else if (nb < 72) src = nb * 32; else if (nb == 72) { src = 2304; nv = 8; } else { src = 0; nv = 0; }
    tr_item(FIN(I_WIN) + (size_t)L * D * D_IN, D_IN, src, nv, D, FIN(I_MIXG) + L * D, (GAS bf16*)FWS(WS_WIN) + (size_t)L * NPROJ * D, nb * 32, kb * 64, scr, F.lane);
}
__device__ __forceinline__ void convert_rest(Frame& F, int slot) {
    LAS float* scr = (LAS float*)(F.lds + RING_OFF + F.wave * 16384);
    constexpr int I_IN = 16 * 80, I_OUT = 16 * 32, I_UP = 16 * 128, I_DN = 64 * 32, NCW = N_CONVERTERS * NWAVES;
    const GAS float *w_out = FIN(I_WOUT), *w_up = FIN(I_WUP), *mlp_g = FIN(I_MLPG), *w_down = FIN(I_WDOWN);
    GAS bf16 *WOUT = (GAS bf16*)FWS(WS_WOUT), *WUP = (GAS bf16*)FWS(WS_WUP), *WDOWN = (GAS bf16*)FWS(WS_WDOWN);
    const int L = slot, n_items = I_OUT + I_UP + I_DN + (slot == 0 ? I_IN : 0);
    for (int it = (F.b * (GRP - 16) + (F.li - 16)) * NWAVES + F.wave; it < n_items; it += NCW) {
        int r = it;
        if (r < I_OUT) { const int kb = r / 32, nb = r % 32; tr_item(w_out + (size_t)L * D * D, D, nb * 32, 32, D, nullptr, WOUT + (size_t)L * D * D, nb * 32, kb * 64, scr, F.lane); continue; }
        r -= I_OUT;
        if (r < I_UP) { const int kb = r / 128, nb = r % 128; tr_item(w_up + (size_t)L * D * FF, FF, nb * 32, 32, D, mlp_g + L * D, WUP + (size_t)L * FF * D, nb * 32, kb * 64, scr, F.lane); continue; }
        r -= I_UP;
        if (r < I_DN) { const int kb = r / 32, nb = r % 32; tr_item(w_down + (size_t)L * FF * D, D, nb * 32, 32, FF, nullptr, WDOWN + (size_t)L * D * FF, nb * 32, kb * 64, scr, F.lane); continue; }
        r -= I_DN;
        win_item(F, 1, r, scr);
    }
    asm volatile("s_waitcnt vmcnt(0)" ::: "memory");
    __syncthreads();
    if (F.tid == 0) { __builtin_amdgcn_fence(__ATOMIC_RELEASE, "agent"); asm volatile("s_waitcnt vmcnt(0)" ::: "memory");
        (void)xb_add((unsigned*)(unsigned char*)FWS(WS_CTL) + CW_WCNT + 64 * slot, 1u); }
}
__device__ __forceinline__ void wait_weights(Frame& F, int part) {
    if (F.tid == 0) { unsigned* wc = (unsigned*)(unsigned char*)FWS(WS_CTL) + CW_WCNT + 64 * part; unsigned sp = 0u;
        while (xb_ld(wc) < (unsigned)N_CONVERTERS) { __builtin_amdgcn_s_sleep(2); if (++sp > (1u << 22)) break; }
        __builtin_amdgcn_fence(__ATOMIC_ACQUIRE, "agent"); asm volatile("s_waitcnt vmcnt(0)" ::: "memory"); }
    __syncthreads();
}
__device__ __forceinline__ void rstd_prepass(Frame& F, const pg8::GroupOrder& S, LAS float* tab) {
    const GAS float* SSQ = (const GAS float*)FWS(WS_SSQ) + (size_t)F.b * SEQ * 16;
    pg8::Unit u;
    for (int i = 0; i < 4 && S.next(i, u); ++i) {
        const int r = F.tid >> 1, h = F.tid & 1;
        const GAS f32x4* p = (const GAS f32x4*)(SSQ + (size_t)(u.pm * 256 + r) * 16 + h * 8);
        const f32x4 a = p[0], b = p[1];
        float s = (a.x + a.y) + (a.z + a.w) + (b.x + b.y) + (b.z + b.w);
        s += shx(s, 1, F.lane);
        if (h == 0) tab[i * 256 + r] = 1.0f / sqrtf(s * (1.0f / D) + EPS);
    }
    LDS_WAIT(); __syncthreads();
}
__device__ __forceinline__ int t5_bucket(int d) {
    if (d < 16) return d;
    return 16 + (d >= 19) + (d >= 21) + (d >= 24) + (d >= 27) + (d >= 31) + (d >= 35) + (d >= 40) + (d >= 46) + (d >= 52) + (d >= 59) + (d >= 67) + (d >= 77) + (d >= 87) + (d >= 99) + (d >= 113);
}
__device__ __forceinline__ void ld8(const GAS bf16* p, float (&v)[8]) {
    const v4u w = *(const GAS v4u*)p;
    v[0] = bflo(w.x); v[1] = bfhi(w.x); v[2] = bflo(w.y); v[3] = bfhi(w.y); v[4] = bflo(w.z); v[5] = bfhi(w.z); v[6] = bflo(w.w); v[7] = bfhi(w.w);
}
typedef short bf16x8_t __attribute__((ext_vector_type(8)));
typedef float f32x16 __attribute__((ext_vector_type(16)));
constexpr float LOG2E = 1.4426950408889634f;
__device__ __forceinline__ unsigned pkbf(float lo, float hi) { return pg8::cvt_pk_bf16(lo, hi); }
__device__ __forceinline__ int crow32(int i, int hh) { return (i & 3) + 8 * (i >> 2) + 4 * hh; }
__device__ __forceinline__ float silu_fast(float v) { return v * __builtin_amdgcn_rcpf(1.0f + __builtin_amdgcn_exp2f(-v * LOG2E)); }
__device__ __forceinline__ void unpk8(const v4u w, float (&v)[8]) {
    v[0] = bflo(w.x); v[1] = bfhi(w.x); v[2] = bflo(w.y); v[3] = bfhi(w.y); v[4] = bflo(w.z); v[5] = bfhi(w.z); v[6] = bflo(w.w); v[7] = bfhi(w.w);
}

typedef short v4i16_t __attribute__((ext_vector_type(4)));
template <int RH, int RSEC> __device__ __forceinline__ bf16x8_t tr_frag(const LAS unsigned char* img, int stride, int rbase, int cbase, int lane) {
    const LAS unsigned char* p = img + (rbase + RH * (lane >> 5) + ((lane & 15) >> 2)) * stride + (cbase + 16 * ((lane >> 4) & 1) + 4 * (lane & 3)) * 2;
    const v4i16_t a = __builtin_amdgcn_ds_read_tr16_b64_v4i16((LAS v4i16_t*)p), b = __builtin_amdgcn_ds_read_tr16_b64_v4i16((LAS v4i16_t*)(p + RSEC * stride));
    return (bf16x8_t){a[0], a[1], a[2], a[3], b[0], b[1], b[2], b[3]};
}
constexpr int AT_KS = 0, AT_KSTRIDE = 144, AT_VT = 36864, AT_VSTRIDE = 192, AT_BIAS = AT_VT + 256 * AT_VSTRIDE;
constexpr int AT_BN = 192, AT_END = AT_BIAS + 4 * AT_BN * 4;
static_assert(AT_END <= MIX_BYTES, "attention LDS");
__device__ __forceinline__ void attn_fast(Frame& F, int L, bool dummy = false) {
    GAS bf16* PROJ = (GAS bf16*)FB(BO_PROJ);
    const GAS float* qg = FIN(I_QG) + L * 64; const GAS float* kg = FIN(I_KG) + L * 64; const GAS float* sinks = FIN(I_SINK) + L * 8; const GAS float* rel_bias = FIN(I_RELB);
    LAS unsigned char* Ks = F.lds + AT_KS; LAS unsigned char* Vt = F.lds + AT_VT; LAS float* biasR = (LAS float*)(F.lds + AT_BIAS);
    const int tid = F.tid, lane = F.lane, wave = F.wave, q = lane & 31, hh = lane >> 5;
    const int unit = F.li, kvh = unit >> 4, qb = unit & 15, m0 = qb * 128;
    const int gi = wave >> 1, qh = wave & 1, hq = kvh * 4 + gi;
    v4u qraw[2][4];
#pragma unroll
    for (int s = 0; s < 2; ++s)
#pragma unroll
        for (int d0 = 0; d0 < 4; ++d0) qraw[s][d0] = *(const GAS v4u*)(PROJ + (size_t)(m0 + 64 * qh + 32 * s + q) * PP + CQ + hq * 64 + d0 * 16 + hh * 8);
    v4u kwv[4], vwv[4];
#pragma unroll
    for (int i = 0; i < 4; ++i) { const int c = tid + NTHREADS * i, key = c >> 3, part = c & 7; const bool valid = (qb > 0) || (key >= 128); const unsigned msk = valid ? 0xffffffffu : 0u;
        const GAS bf16* kp = PROJ + (size_t)(valid ? m0 + key - 128 : 0) * PP + CK + kvh * 64 + part * 8;
        v4u a_ = *(const GAS v4u*)kp, b_ = *(const GAS v4u*)(kp + (CV - CK));
        a_.x &= msk; a_.y &= msk; a_.z &= msk; a_.w &= msk; b_.x &= msk; b_.y &= msk; b_.z &= msk; b_.w &= msk; kwv[i] = a_; vwv[i] = b_; }
    const f32x4 kg0 = *(const GAS f32x4*)(kg + (tid & 7) * 8), kg1 = *(const GAS f32x4*)(kg + (tid & 7) * 8 + 4);
    f32x4 qgv[4][2];
#pragma unroll
    for (int d0 = 0; d0 < 4; ++d0) { qgv[d0][0] = *(const GAS f32x4*)(qg + d0 * 16 + hh * 8); qgv[d0][1] = *(const GAS f32x4*)(qg + d0 * 16 + hh * 8 + 4); }
    const float sinkv = sinks[hq];
    float bent[2];
#pragma unroll
    for (int k = 0; k < 2; ++k) { const int x = tid + NTHREADS * k, g_ = x / AT_BN, xx = x - g_ * AT_BN; const bool ok = (x < 4 * AT_BN) && (xx >= 32) && (xx < 160);
        const float v = rel_bias[t5_bucket(ok ? 159 - xx : 0) * 8 + kvh * 4 + (ok ? g_ : 0)]; bent[k] = ok ? v * LOG2E : 0.f; }
    __syncthreads();
    biasR[tid] = bent[0]; if (tid + NTHREADS < 4 * AT_BN) biasR[tid + NTHREADS] = bent[1];
#pragma unroll
    for (int i = 0; i < 4; ++i) {
        const int c = tid + NTHREADS * i, key = c >> 3, part = c & 7;
        const v4u kw = kwv[i], vw = vwv[i];
        float kv[8]; unpk8(kw, kv);
        float ss = 0.f;
#pragma unroll
        for (int e = 0; e < 8; ++e) ss += kv[e] * kv[e];
        ss += shx(ss, 1, lane); ss += shx(ss, 2, lane); ss += shx(ss, 4, lane);
        const float rk = __builtin_amdgcn_rsqf(ss * (1.0f / 64.0f) + EPS);
        const f32x4 g0 = kg0, g1 = kg1;
        v4u ko; ko.x = pkbf(kv[0] * rk * g0.x, kv[1] * rk * g0.y); ko.y = pkbf(kv[2] * rk * g0.z, kv[3] * rk * g0.w); ko.z = pkbf(kv[4] * rk * g1.x, kv[5] * rk * g1.y); ko.w = pkbf(kv[6] * rk * g1.z, kv[7] * rk * g1.w);
        *(LAS v4u*)(Ks + key * AT_KSTRIDE + part * 16) = ko;
        *(LAS v4u*)(Vt + key * AT_VSTRIDE + part * 16) = vw;
    }
    LDS_WAIT(); __syncthreads();
    const float sink2 = sinkv * LOG2E;
    const LAS float* bb = biasR + gi * AT_BN + 31 - q + 4 * hh;
    const int qm = q - 4 * hh;
#pragma unroll
    for (int s = 0; s < 2; ++s) {
        const int a = 64 * qh + 32 * s;
        GAS bf16* qrow = PROJ + (size_t)(m0 + a + q) * PP + CQ + hq * 64;
        float qv[4][8]; float ss = 0.f;
#pragma unroll
        for (int d0 = 0; d0 < 4; ++d0) { unpk8(qraw[s][d0], qv[d0]);
#pragma unroll
            for (int e = 0; e < 8; ++e) ss += qv[d0][e] * qv[d0][e]; }
        ss += shx(ss, 32, lane);
        const float rq = __builtin_amdgcn_rsqf(ss * (1.0f / 64.0f) + EPS) * (0.125f * LOG2E);
        bf16x8_t qf[4];
#pragma unroll
        for (int d0 = 0; d0 < 4; ++d0) { const f32x4 g0 = qgv[d0][0], g1 = qgv[d0][1];
            v4u w; w.x = pkbf(qv[d0][0] * rq * g0.x, qv[d0][1] * rq * g0.y); w.y = pkbf(qv[d0][2] * rq * g0.z, qv[d0][3] * rq * g0.w);
            w.z = pkbf(qv[d0][4] * rq * g1.x, qv[d0][5] * rq * g1.y); w.w = pkbf(qv[d0][6] * rq * g1.z, qv[d0][7] * rq * g1.w);
            qf[d0] = __builtin_bit_cast(bf16x8_t, w); }
        const int kt_lo = (qb == 0) ? 4 - (a >> 5) : 0;
        f32x16 S[5]; float mx = sink2;
#pragma unroll
        for (int kt = 0; kt < 5; ++kt) { f32x16 acc = {};
#pragma unroll
            for (int d0 = 0; d0 < 4; ++d0) { const bf16x8_t kf = *(const LAS bf16x8_t*)(Ks + (a + 32 * kt + q) * AT_KSTRIDE + d0 * 32 + hh * 16);
                acc = __builtin_amdgcn_mfma_f32_32x32x16_bf16(kf, qf[d0], acc, 0, 0, 0); }
            if (kt < kt_lo) {
#pragma unroll
                for (int i = 0; i < 16; ++i) acc[i] = -INFINITY;
            } else {
#pragma unroll
                for (int i = 0; i < 16; ++i) { const int t0 = (i & 3) + 8 * (i >> 2); float v = acc[i] + bb[32 * kt + t0];
                    if (kt == 0) v = fminf(v, (t0 > qm) ? INFINITY : -INFINITY);
                    if (kt == 4) v = fminf(v, (t0 <= qm) ? INFINITY : -INFINITY);
                    acc[i] = v; mx = fmaxf(mx, v); } }
            S[kt] = acc; }
        mx = fmaxf(mx, shx(mx, 32, lane));
        float lsum = 0.f; bf16x8_t pf[5][2];
#pragma unroll
        for (int kt = 0; kt < 5; ++kt) {
#pragma unroll
            for (int i = 0; i < 16; ++i) { const float p = __builtin_amdgcn_exp2f(S[kt][i] - mx); S[kt][i] = p; lsum += p; }
#pragma unroll
            for (int s2 = 0; s2 < 2; ++s2) { v4u w; w.x = pkbf(S[kt][8 * s2 + 0], S[kt][8 * s2 + 1]); w.y = pkbf(S[kt][8 * s2 + 2], S[kt][8 * s2 + 3]);
                w.z = pkbf(S[kt][8 * s2 + 4], S[kt][8 * s2 + 5]); w.w = pkbf(S[kt][8 * s2 + 6], S[kt][8 * s2 + 7]); pf[kt][s2] = __builtin_bit_cast(bf16x8_t, w); } }
        lsum += shx(lsum, 32, lane);
        lsum += __builtin_amdgcn_exp2f(sink2 - mx);
        f32x16 O[2] = {{}, {}};
#pragma unroll
        for (int kt = 0; kt < 5; ++kt)
#pragma unroll
            for (int s2 = 0; s2 < 2; ++s2)
#pragma unroll
                for (int db = 0; db < 2; ++db)
                    O[db] = __builtin_amdgcn_mfma_f32_32x32x16_bf16(tr_frag<4, 8>(Vt, AT_VSTRIDE, a + 32 * kt + 16 * s2, 32 * db, lane), pf[kt][s2], O[db], 0, 0, 0);
        const float inv = __builtin_amdgcn_rcpf(lsum);
#pragma unroll
        for (int db = 0; db < 2; ++db)
#pragma unroll
            for (int g4 = 0; g4 < 4; ++g4) { v2u w; w.x = pkbf(O[db][4 * g4] * inv, O[db][4 * g4 + 1] * inv); w.y = pkbf(O[db][4 * g4 + 2] * inv, O[db][4 * g4 + 3] * inv);
                GAS bf16* orow = dummy ? (GAS bf16*)FB(BO_PREV) + (size_t)(m0 + a + q) * 512 + hq * 64 : qrow;
                *(GAS v2u*)(orow + 32 * db + 8 * g4 + 4 * hh) = w; }
    }
}

constexpr size_t WS_DTV = 3 * MiB + 512 * 1024;
constexpr int SD_ROW = 272, SD_XT = 264;
template <int NR> struct Raw8 { v4u u[NR + 3]; };
template <int NR> struct Raw4 { v2u u[NR + 3]; };
struct ConvW8 { f32x4 w[4][2], b[2]; };
struct ConvW4 { f32x4 w[4], b; };
template <int NR> __device__ __forceinline__ void conv_load(Raw8<NR>& R, const GAS bf16* PROJ, int m0, int c, int l0, int col0) {
#pragma unroll
    for (int i = 0; i < NR + 3; ++i) { const int row = l0 - 3 + i; const bool ok = (c > 0) || (row >= 0); const unsigned msk = ok ? 0xffffffffu : 0u;
        v4u x = *(const GAS v4u*)(PROJ + (size_t)(m0 + (ok ? row : 0)) * PP + col0); x.x &= msk; x.y &= msk; x.z &= msk; x.w &= msk; R.u[i] = x; }
}
template <int NR> __device__ __forceinline__ void conv_load(Raw4<NR>& R, const GAS bf16* PROJ, int m0, int c, int l0, int col0) {
#pragma unroll
    for (int i = 0; i < NR + 3; ++i) { const int row = l0 - 3 + i; const bool ok = (c > 0) || (row >= 0); const unsigned msk = ok ? 0xffffffffu : 0u;
        v2u x = *(const GAS v2u*)(PROJ + (size_t)(m0 + (ok ? row : 0)) * PP + col0); x.x &= msk; x.y &= msk; R.u[i] = x; }
}
__device__ __forceinline__ void convw_load(ConvW8& W, const GAS float* cw, const GAS float* cb) {
#pragma unroll
    for (int k = 0; k < 4; ++k) { W.w[k][0] = *(const GAS f32x4*)(cw + k * 1024); W.w[k][1] = *(const GAS f32x4*)(cw + k * 1024 + 4); }
    W.b[0] = *(const GAS f32x4*)cb; W.b[1] = *(const GAS f32x4*)(cb + 4);
}
__device__ __forceinline__ void convw_load(ConvW4& W, const GAS float* cw, const GAS float* cb) {
#pragma unroll
    for (int k = 0; k < 4; ++k) W.w[k] = *(const GAS f32x4*)(cw + k * 1024);
    W.b = *(const GAS f32x4*)cb;
}
template <int NR> __device__ __forceinline__ void conv_row(const Raw8<NR>& R, const ConvW8& W, int r, float (&out)[8]) {
    float acc[8];
#pragma unroll
    for (int e = 0; e < 8; ++e) acc[e] = W.b[e >> 2][e & 3];
#pragma unroll
    for (int k = 0; k < 4; ++k) { float u[8]; unpk8(R.u[r + k], u);
#pragma unroll
        for (int e = 0; e < 8; ++e) acc[e] += W.w[k][e >> 2][e & 3] * u[e]; }
#pragma unroll
    for (int e = 0; e < 8; ++e) out[e] = silu_fast(acc[e]);
}
template <int NR> __device__ __forceinline__ void conv_row(const Raw4<NR>& R, const ConvW4& W, int r, float (&out)[4]) {
    float acc[4];
#pragma unroll
    for (int e = 0; e < 4; ++e) acc[e] = W.b[e];
#pragma unroll
    for (int k = 0; k < 4; ++k) { const v2u x = R.u[r + k]; const float u[4] = {bflo(x.x), bfhi(x.x), bflo(x.y), bfhi(x.y)};
#pragma unroll
        for (int e = 0; e < 4; ++e) acc[e] += W.w[k][e] * u[e]; }
#pragma unroll
    for (int e = 0; e < 4; ++e) out[e] = silu_fast(acc[e]);
}
constexpr int P_XSTR = 576, P_BSTR = 304, P_XD = 0, P_BM = P_XD + 128 * P_XSTR, P_CM = P_BM + 128 * P_BSTR, P_FREE = P_CM + 128 * SD_ROW, P_DT = MIX_BYTES - 4096, P_ACS = P_DT + 2048;
static_assert(P_FREE + 4096 <= P_DT, "SSD LDS map");
__device__ __forceinline__ bf16x8_t scale_frag(bf16x8_t f, const f32x4 s0, const f32x4 s1) {
    const v4u w = __builtin_bit_cast(v4u, f); v4u o;
    o.x = pkbf(bflo(w.x) * s0.x, bfhi(w.x) * s0.y); o.y = pkbf(bflo(w.y) * s0.z, bfhi(w.y) * s0.w); o.z = pkbf(bflo(w.z) * s1.x, bfhi(w.z) * s1.y); o.w = pkbf(bflo(w.w) * s1.z, bfhi(w.w) * s1.w);
    return __builtin_bit_cast(bf16x8_t, o);
}
constexpr int S1_W = P_FREE, S1_WT = S1_W + 2048;
__device__ __forceinline__ void ssd_states(Frame& F, int L) {
    const GAS bf16* PROJ = (const GAS bf16*)FB(BO_PROJ);
    const GAS float* conv_w = FIN(I_CONVW) + (size_t)L * 4 * 1024; const GAS float* conv_b = FIN(I_CONVB) + L * 1024;
    const GAS float* dt_bias = FIN(I_DTB) + L * 8; const GAS float* a_log = FIN(I_ALOG) + L * 8;
    const GAS float* DTRAW = (const GAS float*)FWS(WS_DTRAW) + (size_t)F.b * SEQ * 8; GAS float* CHDEC = (GAS float*)FWS(WS_CHDEC) + F.b * 128;
    GAS bf16* STATES = (GAS bf16*)FB(BO_STATES);
    LAS unsigned char* XD = F.lds + P_XD; LAS unsigned char* BM = F.lds + P_BM;
    LAS float* dt_l = (LAS float*)(F.lds + P_DT); LAS float* acs_l = (LAS float*)(F.lds + P_ACS); LAS float* w_l = (LAS float*)(F.lds + S1_W); LAS float* wt = (LAS float*)(F.lds + S1_WT);
    const int wave = F.wave, unit = F.li, c = unit >> 1, g = unit & 1, m0 = c * 128;
    int tid = F.tid; asm volatile("" : "+v"(tid));
    int lane = tid & 63, q = lane & 31, hh = lane >> 5;
    const int xcg = tid & 31, xl0 = (tid >> 5) * 8, xcol = CX + g * 256 + xcg * 8;
    const int bcg = tid & 31, bl0 = (tid >> 5) * 8, isC = bcg >> 4, bn0 = (bcg & 15) * 8, bcol = (isC ? CCM : CBM) + g * 128 + bn0;
    Raw8<8> xr; ConvW8 xw; Raw8<8> br; ConvW8 bw;
    conv_load(xr, PROJ, m0, c, xl0, xcol); convw_load(xw, conv_w + (xcol - CX), conv_b + (xcol - CX));
    conv_load(br, PROJ, m0, c, bl0, bcol); convw_load(bw, conv_w + (bcol - CX), conv_b + (bcol - CX));
    const int ar = tid >> 7, al = tid & 127, ahead = 4 * g + ar;
    const float dtraw = DTRAW[(size_t)(m0 + al) * 8 + ahead], dtb = dt_bias[ahead], alog = a_log[ahead];
    __syncthreads();
    float acs_v;
    { const float dtv = softplus_f(dtraw + dtb);
      float v = dtv * (-expf(alog));
#pragma unroll
      for (int o = 1; o < 64; o <<= 1) { const float t = shup(v, o, lane); if (lane >= o) v += t; }
      if (lane == 63) wt[wave] = v;
      LDS_WAIT(); __syncthreads();
      if (wave & 1) v += wt[wave - 1];
      dt_l[tid] = dtv; acs_l[tid] = v * LOG2E; acs_v = v * LOG2E;
      if (al == 127) CHDEC[c * 8 + ahead] = expf(v); }
#pragma unroll
    for (int r = 0; r < 8; ++r) { float o[8]; conv_row(br, bw, r, o);
        v4u pk; pk.x = pkbf(o[0], o[1]); pk.y = pkbf(o[2], o[3]); pk.z = pkbf(o[4], o[5]); pk.w = pkbf(o[6], o[7]);
        *(LAS v4u*)(isC ? F.lds + P_CM + (bl0 + r) * SD_ROW + bn0 * 2 : BM + (bl0 + r) * P_BSTR + bn0 * 2) = pk; }
    LDS_WAIT(); __syncthreads();
    w_l[tid] = __builtin_amdgcn_exp2f(acs_l[ar * 128 + 127] - acs_v);
    { const int r4 = xcg >> 3;
#pragma unroll
      for (int r = 0; r < 8; ++r) { float o[8]; conv_row(xr, xw, r, o); const int l = xl0 + r; const float sc = dt_l[r4 * 128 + l];
          v4u pk; pk.x = pkbf(o[0] * sc, o[1] * sc); pk.y = pkbf(o[2] * sc, o[3] * sc); pk.z = pkbf(o[4] * sc, o[5] * sc); pk.w = pkbf(o[6] * sc, o[7] * sc);
          *(LAS v4u*)(XD + l * P_XSTR + xcg * 16) = pk; } }
    LDS_WAIT(); __syncthreads();
    asm volatile("" : "+v"(tid)); lane = tid & 63; q = lane & 31; hh = lane >> 5;
    { const int r4 = wave >> 1, nt0 = (wave & 1) * 2, head = 4 * g + r4;
      f32x16 St[2][2] = {{{}, {}}, {{}, {}}};
#pragma unroll
      for (int ks = 0; ks < 8; ++ks) { bf16x8_t af[2], bfr[2];
          const f32x4 w0 = *(const LAS f32x4*)(w_l + r4 * 128 + 16 * ks + 8 * hh), w1 = *(const LAS f32x4*)(w_l + r4 * 128 + 16 * ks + 8 * hh + 4);
#pragma unroll
          for (int pt = 0; pt < 2; ++pt) af[pt] = tr_frag<8, 4>(XD, P_XSTR, 16 * ks, r4 * 64 + 32 * pt, lane);
#pragma unroll
          for (int nn = 0; nn < 2; ++nn) bfr[nn] = scale_frag(tr_frag<8, 4>(BM, P_BSTR, 16 * ks, 32 * (nt0 + nn), lane), w0, w1);
#pragma unroll
          for (int pt = 0; pt < 2; ++pt)
#pragma unroll
              for (int nn = 0; nn < 2; ++nn) St[pt][nn] = __builtin_amdgcn_mfma_f32_32x32x16_bf16(af[pt], bfr[nn], St[pt][nn], 0, 0, 0); }
      GAS bf16* sp = STATES + ((size_t)c * 8 + head) * 8192 + 32 * nt0 + q;
#pragma unroll
      for (int pt = 0; pt < 2; ++pt)
#pragma unroll
          for (int nn = 0; nn < 2; ++nn)
#pragma unroll
              for (int e = 0; e < 16; e += 2) { const unsigned w = pkbf(St[pt][nn][e], St[pt][nn][e + 1]);
                  sp[(32 * pt + crow32(e, hh)) * 128 + 32 * nn] = (bf16)(w & 0xffffu); sp[(32 * pt + crow32(e + 1, hh)) * 128 + 32 * nn] = (bf16)(w >> 16); } }
}
__device__ __forceinline__ void ssd_scan(Frame& F, int L) {
    const GAS bf16* STATES = (const GAS bf16*)FB(BO_STATES); const GAS float* CHDEC = (const GAS float*)FWS(WS_CHDEC) + F.b * 128; GAS bf16* PREV = (GAS bf16*)FB(BO_PREV);
    for (int idx = F.li * NTHREADS + F.tid; idx < 8 * 64 * 32; idx += GRP * NTHREADS) {
        const int n4 = idx & 31, p = (idx >> 5) & 63, head = idx >> 11;
        v2u s[16]; float dec[16];
#pragma unroll
        for (int c = 0; c < 16; ++c) { const size_t o = ((size_t)c * 8 + head) * 8192 + p * 128 + 4 * n4; s[c] = *(const GAS v2u*)(STATES + o); dec[c] = CHDEC[c * 8 + head]; }
        f32x4 h = {0.f, 0.f, 0.f, 0.f};
#pragma unroll
        for (int c = 0; c < 16; ++c) { const size_t o = ((size_t)c * 8 + head) * 8192 + p * 128 + 4 * n4;
            v2u w; w.x = pkbf(h.x, h.y); w.y = pkbf(h.z, h.w); *(GAS v2u*)(PREV + o) = w;
            const f32x4 sv = {bflo(s[c].x), bfhi(s[c].x), bflo(s[c].y), bfhi(s[c].y)};
            h = h * dec[c] + sv; }
    }
}
constexpr int S3_PV = P_BM, S3_PVH = 64 * SD_ROW, S3_Z = S3_PV + 2 * S3_PVH, S3_NG = P_FREE, S3_RSS = S3_NG + 1024;
static_assert(S3_Z + 128 * SD_ROW <= P_FREE && S3_RSS + 2048 <= P_DT && 128 * 528 <= P_DT, "SSD part 3 LDS");
__device__ __forceinline__ void ssd_out(Frame& F, int L, bool dummy = false) {
    GAS bf16* PROJ = (GAS bf16*)FB(BO_PROJ); const GAS bf16* PREV = (const GAS bf16*)FB(BO_PREV);
    const GAS float* d_skip = FIN(I_DSKIP) + L * 8; const GAS float* ssm_g = FIN(I_SSMG) + L * 512;
    LAS unsigned char* Cm = F.lds + P_CM; LAS unsigned char* Bm = F.lds + P_BM; LAS unsigned char* Zt = F.lds + S3_Z; const LAS unsigned char* XD = F.lds + P_XD;
    LAS float* dt_l = (LAS float*)(F.lds + P_DT); LAS float* acs_l = (LAS float*)(F.lds + P_ACS); LAS float* rss = (LAS float*)(F.lds + S3_RSS); LAS float* ng_l = (LAS float*)(F.lds + S3_NG);
    const int wave = F.wave, unit = F.li, c = unit >> 1, g = unit & 1, m0 = c * 128;
    int tid = F.tid; asm volatile("" : "+v"(tid));
    int lane = tid & 63, q = lane & 31, hh = lane >> 5;
    const float ng_in = ssm_g[g * 256 + (tid & 255)];
    v4u pw[4], zw[4];
#define S3_D1_LOAD_PZ(hp_) do { \
        _Pragma("unroll") for (int k = 0; k < 4; ++k) { const int ch = tid + NTHREADS * k; \
            { const int hd = ch >> 10, rem = ch & 1023, p = rem >> 4, n8 = rem & 15; pw[k] = *(const GAS v4u*)(PREV + ((size_t)c * 8 + 4 * g + 2 * (hp_) + hd) * 8192 + p * 128 + n8 * 8); } \
            { const int l = ch >> 4, c8 = ch & 15; zw[k] = *(const GAS v4u*)(PROJ + (size_t)(m0 + l) * PP + CZ + (4 * g + 2 * (hp_)) * 64 + c8 * 8); } } } while (0)
    S3_D1_LOAD_PZ(0);
    if (tid < 256) ng_l[tid] = ng_in;
    const int j = (wave < 4) ? (wave & 3) : 3 - (wave & 3), h2 = wave >> 2;
    f32x16 cbT[4]; bf16x8_t cf[8];
#pragma unroll
    for (int ks = 0; ks < 8; ++ks) cf[ks] = *(const LAS bf16x8_t*)(Cm + (32 * j + q) * SD_ROW + (16 * ks + 8 * hh) * 2);
#pragma unroll
    for (int i = 0; i < 4; ++i) { f32x16 acc = {};
        if (i <= j) {
#pragma unroll
            for (int ks = 0; ks < 8; ++ks) { const bf16x8_t bfr = *(const LAS bf16x8_t*)(Bm + (32 * i + q) * P_BSTR + (16 * ks + 8 * hh) * 2);
                acc = __builtin_amdgcn_mfma_f32_32x32x16_bf16(bfr, cf[ks], acc, 0, 0, 0); } }
        cbT[i] = acc; }
    unsigned vk[2][16];
#pragma unroll
    for (int hp = 0; hp < 2; ++hp) {
        __syncthreads();
        {
#pragma unroll
          for (int k = 0; k < 4; ++k) { const int ch = tid + NTHREADS * k;
              { const int hd = ch >> 10, rem = ch & 1023, p = rem >> 4, n8 = rem & 15; *(LAS v4u*)(F.lds + S3_PV + hd * S3_PVH + p * SD_ROW + n8 * 16) = pw[k]; }
              { const int l = ch >> 4, c8 = ch & 15; *(LAS v4u*)(Zt + l * SD_ROW + c8 * 16) = zw[k]; } } }
        LDS_WAIT(); __syncthreads();
        asm volatile("" : "+v"(tid)); lane = tid & 63; q = lane & 31; hh = lane >> 5;
        const int r = 2 * hp + h2, head = 4 * g + r;
        const LAS unsigned char* P1 = F.lds + S3_PV + h2 * S3_PVH;
        f32x16 O[2] = {{}, {}};
#pragma unroll
        for (int ks = 0; ks < 8; ++ks)
#pragma unroll
            for (int pt = 0; pt < 2; ++pt) { const bf16x8_t af = *(const LAS bf16x8_t*)(P1 + (32 * pt + q) * SD_ROW + (16 * ks + 8 * hh) * 2);
                O[pt] = __builtin_amdgcn_mfma_f32_32x32x16_bf16(af, cf[ks], O[pt], 0, 0, 0); }
        const float acl = acs_l[r * 128 + 32 * j + q], diag = d_skip[head] * __builtin_amdgcn_rcpf(dt_l[r * 128 + 32 * j + q]);
        { const float ea = __builtin_amdgcn_exp2f(acl);
#pragma unroll
          for (int pt = 0; pt < 2; ++pt)
#pragma unroll
              for (int e = 0; e < 16; ++e) O[pt][e] *= ea; }
        const int qm = q - 4 * hh;
#pragma unroll
        for (int i = 0; i < 4; ++i) { if (i <= j) {
            float xv[16];
            const LAS float* ap = acs_l + r * 128 + 32 * i + 4 * hh;
            float av[16];
#pragma unroll
            for (int e = 0; e < 16; ++e) av[e] = ap[(e & 3) + 8 * (e >> 2)];
            if (i < j) {
#pragma unroll
                for (int e = 0; e < 16; ++e) xv[e] = cbT[i][e] * __builtin_amdgcn_exp2f(acl - av[e]);
            } else {
#pragma unroll
                for (int e = 0; e < 16; ++e) { const int t0 = (e & 3) + 8 * (e >> 2);
                    const float m01 = (t0 <= qm) ? 1.0f : 0.0f, dg = (t0 == qm) ? diag : 0.0f;
                    xv[e] = cbT[i][e] * __builtin_amdgcn_exp2f(fminf(acl - av[e], 0.f)) * m01 + dg; } }
#pragma unroll
            for (int s2 = 0; s2 < 2; ++s2) { v4u w; w.x = pkbf(xv[8 * s2 + 0], xv[8 * s2 + 1]); w.y = pkbf(xv[8 * s2 + 2], xv[8 * s2 + 3]); w.z = pkbf(xv[8 * s2 + 4], xv[8 * s2 + 5]); w.w = pkbf(xv[8 * s2 + 6], xv[8 * s2 + 7]);
                const bf16x8_t xf = __builtin_bit_cast(bf16x8_t, w);
#pragma unroll
                for (int pt = 0; pt < 2; ++pt)
                    O[pt] = __builtin_amdgcn_mfma_f32_32x32x16_bf16(tr_frag<4, 8>(XD, P_XSTR, 32 * i + 16 * s2, 64 * r + 32 * pt, lane), xf, O[pt], 0, 0, 0); } } }
        if (hp == 0) S3_D1_LOAD_PZ(1);
        float ss = 0.f;
#pragma unroll
        for (int pt = 0; pt < 2; ++pt)
#pragma unroll
            for (int g4 = 0; g4 < 4; ++g4) { const int p = 32 * pt + 8 * g4 + 4 * hh;
                const v2u zz = *(const LAS v2u*)(Zt + (32 * j + q) * SD_ROW + (64 * h2 + p) * 2);
                const float u0 = O[pt][4 * g4] * silu_fast(bflo(zz.x)), u1 = O[pt][4 * g4 + 1] * silu_fast(bfhi(zz.x)), u2 = O[pt][4 * g4 + 2] * silu_fast(bflo(zz.y)), u3 = O[pt][4 * g4 + 3] * silu_fast(bfhi(zz.y));
                ss += (u0 * u0 + u1 * u1) + (u2 * u2 + u3 * u3);
                vk[hp][pt * 8 + g4 * 2] = pkbf(u0, u1); vk[hp][pt * 8 + g4 * 2 + 1] = pkbf(u2, u3); }
        ss += shx(ss, 32, lane);
        if (hh == 0) rss[r * 128 + 32 * j + q] = ss;
    }
#undef S3_D1_LOAD_PZ
    LDS_WAIT(); __syncthreads();
    asm volatile("" : "+v"(tid)); lane = tid & 63; q = lane & 31; hh = lane >> 5;
    { const int l = 32 * j + q; const float tot = (rss[l] + rss[128 + l]) + (rss[256 + l] + rss[384 + l]);
      const float rn = __builtin_amdgcn_rsqf(tot * (1.0f / 256.0f) + EPS);
      LAS unsigned char* Ot = F.lds;
#pragma unroll
      for (int hp = 0; hp < 2; ++hp) { const int r = 2 * hp + h2;
#pragma unroll
          for (int pt = 0; pt < 2; ++pt)
#pragma unroll
              for (int g4 = 0; g4 < 4; ++g4) { const int p = 32 * pt + 8 * g4 + 4 * hh;
                  const f32x4 ng = *(const LAS f32x4*)(ng_l + r * 64 + p);
                  const unsigned w0 = vk[hp][pt * 8 + g4 * 2], w1 = vk[hp][pt * 8 + g4 * 2 + 1];
                  v2u w; w.x = pkbf(bflo(w0) * rn * ng.x, bfhi(w0) * rn * ng.y); w.y = pkbf(bflo(w1) * rn * ng.z, bfhi(w1) * rn * ng.w);
                  *(LAS v2u*)(Ot + l * 528 + (r * 64 + p) * 2) = w; } } }
    LDS_WAIT(); __syncthreads();
    asm volatile("" : "+v"(tid));
#pragma unroll
    for (int k = 0; k < 8; ++k) { const int ch = tid + NTHREADS * k, l = ch >> 5, c8 = ch & 31;
        const v4u w = *(const LAS v4u*)(F.lds + l * 528 + c8 * 16);
        GAS bf16* orow = dummy ? (GAS bf16*)FB(BO_STATES) + (size_t)(m0 + l) * 512 : PROJ + (size_t)(m0 + l) * PP + CZ;
        *(GAS v4u*)(orow + g * 256 + c8 * 8) = w; }
}

__device__ __forceinline__ void ph_inproj(Frame& F, int L) {
    LAS float* rstd_tab = (LAS float*)(F.lds + RSTD_OFF);
    int li_ = F.li; asm volatile("" : "+s"(li_)); pg8::GroupOrder S; S.init(NPROJ, li_);
    const GAS f32x4* sp = (const GAS f32x4*)((const GAS float*)FWS(WS_SSQ) + ((size_t)F.b * SEQ + (li_ & 7) * 256 + (F.tid >> 1)) * 16 + (F.tid & 1) * 8);
    pg8::Gemm g{(const GAS bf16*)FWS(WS_XB) + (size_t)F.b * SEQ * D, (const GAS bf16*)FWS(WS_WIN) + (size_t)L * NPROJ * D, SEQ, NPROJ, D, D};
    pg8::EpiProj E{(GAS bf16*)FB(BO_PROJ), (GAS float*)FWS(WS_DTRAW) + (size_t)F.b * SEQ * 8, rstd_tab, sp[0], sp[1]};
    pg8::gemm_phase<pg8::EpiProj, pg8::GroupOrder, true, true>(F.lds + RING_OFF, g, S, E);
}
__device__ __forceinline__ void ph_outproj(Frame& F, int L, bool dummy = false) {
    int li_ = F.li; asm volatile("" : "+s"(li_)); pg8::GroupOrder S; S.init(D, li_);
    pg8::Gemm g{(const GAS bf16*)FB(BO_PROJ), (const GAS bf16*)FWS(WS_WOUT) + (size_t)L * D * D, SEQ, D, D, PP};
    GAS bf16* XBb = (GAS bf16*)FWS(WS_XB) + (size_t)F.b * SEQ * D;
    pg8::EpiRes<false> E{XBb, (GAS float*)FWS(WS_SSQ) + (size_t)F.b * SEQ * 16, nullptr, dummy ? (GAS bf16*)FB(BO_YPART) : XBb};
    pg8::gemm_phase<pg8::EpiRes<false>, pg8::GroupOrder, false, true>(F.lds + RING_OFF, g, S, E);
}
__device__ __forceinline__ void ph_up(Frame& F, int L) {
    LAS float* rstd_tab = (LAS float*)(F.lds + RSTD_OFF);
    int li_ = F.li; asm volatile("" : "+s"(li_)); pg8::GroupOrder S; S.init(FF, li_);
    const GAS f32x4* sp = (const GAS f32x4*)((const GAS float*)FWS(WS_SSQ) + ((size_t)F.b * SEQ + (li_ & 7) * 256 + (F.tid >> 1)) * 16 + (F.tid & 1) * 8);
    pg8::Gemm g{(const GAS bf16*)FWS(WS_XB) + (size_t)F.b * SEQ * D, (const GAS bf16*)FWS(WS_WUP) + (size_t)L * FF * D, SEQ, FF, D, D};
    pg8::EpiUp E{(GAS bf16*)FB(BO_HID), FF, rstd_tab, sp[0], sp[1]};
    pg8::gemm_phase<pg8::EpiUp, pg8::GroupOrder, true, true>(F.lds + RING_OFF, g, S, E);
}
__device__ __forceinline__ void ph_down(Frame& F, int L, bool dummy = false) {
    int li_ = F.li; asm volatile("" : "+s"(li_)); pg8::GroupOrder S; S.init(D, li_);
    pg8::Gemm g{(const GAS bf16*)FB(BO_HID), (const GAS bf16*)FWS(WS_WDOWN) + (size_t)L * D * FF, SEQ, D, FF, FF};
    GAS bf16* XBb = (GAS bf16*)FWS(WS_XB) + (size_t)F.b * SEQ * D; GAS float* SSQb = (GAS float*)FWS(WS_SSQ) + (size_t)F.b * SEQ * 16;
    if (L == DEPTH - 1 && !dummy) { pg8::EpiRes<true> E{XBb, SSQb, (GAS float*)ptr_at(F, I_OUT) + (size_t)F.b * SEQ * D, XBb};
        pg8::gemm_phase<pg8::EpiRes<true>, pg8::GroupOrder, false, true>(F.lds + RING_OFF, g, S, E); }
    else { pg8::EpiRes<false> E{XBb, SSQb, nullptr, dummy ? (GAS bf16*)FB(16 * MiB) : XBb};
        pg8::gemm_phase<pg8::EpiRes<false>, pg8::GroupOrder, false, true>(F.lds + RING_OFF, g, S, E); }
}

#ifndef PROBE_REP
#define PROBE_REP 0
#endif
struct Args { const float* in[17]; float* out; unsigned char* ws; int pad0, pad1; };
__global__ void __launch_bounds__(NTHREADS, 2) fwd(Args args) {
    extern __shared__ __attribute__((aligned(16))) unsigned char lds[];
    Frame F;
    F.lds = (LAS unsigned char*)lds;
    F.tid = threadIdx.x; F.lane = F.tid & 63; F.wave = __builtin_amdgcn_readfirstlane(F.tid >> 6); F.bid = blockIdx.x; F.G = gridDim.x; F.b = F.bid & 7; F.li = F.bid >> 3;
    for (int u = F.tid; u < (LDS_BYTES - LDSCTL_OFF) / 4; u += NTHREADS) ((LAS unsigned*)(F.lds + LDSCTL_OFF))[u] = 0u;
    __syncthreads();
    if (F.tid < I_NPTR) { const unsigned long long p = F.tid < 17 ? (unsigned long long)args.in[F.tid < 17 ? F.tid : 0] : (F.tid == I_OUT ? (unsigned long long)args.out : (unsigned long long)args.ws);
        LAS unsigned* t = (LAS unsigned*)(F.lds + PTR_OFF) + 2 * F.tid; t[0] = (unsigned)p; t[1] = (unsigned)(p >> 32); }
    LDS_WAIT(); __syncthreads();
    if (F.G != GRID) return;
#define GBAR_OBJ() XcdBarrier{(unsigned*)(unsigned char*)FWS(WS_CTL) + CW_BAR, xb_xcc_id(), (unsigned)GRID, (volatile LAS unsigned*)(F.lds + MISC_OFF) + 8}
#define GRP_OBJ()  XcdBarrier{(unsigned*)(unsigned char*)FWS(WS_CTL) + CW_GRP + (blockIdx.x & 7) * GRP_BAR_STRIDE, xb_xcc_id(), (unsigned)GRP, (volatile LAS unsigned*)(F.lds + MISC_OFF) + 12}
    (void)xcd_barrier_post((unsigned*)(unsigned char*)FWS(WS_CTL) + CW_BAR, (volatile LAS unsigned*)(F.lds + MISC_OFF) + 8, GRID);
    (void)xcd_barrier_post((unsigned*)(unsigned char*)FWS(WS_CTL) + CW_GRP + (blockIdx.x & 7) * GRP_BAR_STRIDE, (volatile LAS unsigned*)(F.lds + MISC_OFF) + 12, GRP);
#define RELAUNDER() do { int t_ = threadIdx.x; asm volatile("" : "+v"(t_)); F.tid = t_; F.lane = t_ & 63; F.wave = __builtin_amdgcn_readfirstlane(t_ >> 6); \
    int b_ = blockIdx.x; asm volatile("" : "+s"(b_)); F.bid = b_; F.b = b_ & 7; F.li = b_ >> 3; } while (0)
#define GRP_BAR() do { const XcdBarrier gb_ = GRP_OBJ(); xcd_barrier(gb_); } while (0)
#define GRID_BAR() do { const XcdBarrier gb_ = GBAR_OBJ(); xcd_barrier(gb_); } while (0)

    p0_prologue(F);
    if (PROBE_REP == 1) { GRID_BAR(); RELAUNDER(); p0_prologue(F); }
    GRID_BAR();
    for (int L = 0; L < DEPTH; ++L) {
        RELAUNDER(); ph_inproj(F, L); if (PROBE_REP == 2) { GRP_BAR(); RELAUNDER(); ph_inproj(F, L); }
        if (F.li >= 16) { RELAUNDER(); convert_rest(F, L); }
        GRP_BAR();
        RELAUNDER(); if (PROBE_REP == 20) { attn_fast(F, L, true); GRP_BAR(); RELAUNDER(); }
        if (PROBE_REP == 25) {
#pragma unroll 1
            for (int rep = 0; rep < 2; ++rep) { attn_fast(F, L, rep == 0); if (rep == 0) { GRP_BAR(); RELAUNDER(); } } }
        else attn_fast(F, L);
        ssd_states(F, L); if (PROBE_REP == 21) { GRP_BAR(); RELAUNDER(); ssd_states(F, L); } GRP_BAR();
        RELAUNDER(); ssd_scan(F, L); if (PROBE_REP == 22) { GRP_BAR(); RELAUNDER(); ssd_scan(F, L); } if (PROBE_REP == 24) { for (int k = 0; k < 8; ++k) GRP_BAR(); } GRP_BAR();
        RELAUNDER(); if (PROBE_REP == 23) { ssd_out(F, L, true); GRP_BAR(); RELAUNDER(); } ssd_out(F, L); GRP_BAR();
        RELAUNDER(); wait_weights(F, L); if (PROBE_REP == 30) { ph_outproj(F, L, true); GRP_BAR(); RELAUNDER(); } ph_outproj(F, L); GRP_BAR();
        RELAUNDER(); ph_up(F, L); if (PROBE_REP == 5) { GRP_BAR(); RELAUNDER(); ph_up(F, L); } GRP_BAR();
        RELAUNDER(); if (PROBE_REP == 31) { ph_down(F, L, true); GRP_BAR(); RELAUNDER(); } ph_down(F, L); if (L + 1 < DEPTH) GRP_BAR();
    }
}

extern "C" void kernel_launch(void* const* d_in, const int* in_sizes, int n_in, void* d_out, int out_size, void* d_ws, size_t ws_size, hipStream_t stream) {
    static int grid = 0;
    if (grid == 0) {
        if (n_in != 17 || in_sizes[0] != M * D || out_size != M * D || ws_size < WS_END) { fprintf(stderr, "kernel_launch: unexpected shapes (n_in %d, in0 %d, out %d, ws %zu)\n", n_in, n_in > 0 ? in_sizes[0] : -1, out_size, ws_size); grid = -1; return; }
        int dev = 0, cus = 0, per_cu = 0;
        if (hipGetDevice(&dev) != hipSuccess || hipDeviceGetAttribute(&cus, hipDeviceAttributeMultiprocessorCount, dev) != hipSuccess) { grid = -1; return; }
        if (hipFuncSetAttribute((const void*)fwd, hipFuncAttributeMaxDynamicSharedMemorySize, LDS_BYTES) != hipSuccess) { fprintf(stderr, "kernel_launch: hipFuncSetAttribute failed\n"); grid = -1; return; }
        if (hipOccupancyMaxActiveBlocksPerMultiprocessor(&per_cu, (const void*)fwd, NTHREADS, LDS_BYTES) != hipSuccess || per_cu < 1) { fprintf(stderr, "kernel_launch: occupancy query says %d\n", per_cu); per_cu = 0; }
        (void)hipGetLastError();
        if (cus * per_cu < GRID) { fprintf(stderr, "kernel_launch: this kernel needs %d co-resident workgroups (one per CU of a 256-CU device); the device admits %d x %d; nothing launched\n", GRID, cus, per_cu); grid = -1; return; }
        grid = GRID;
    }
    if (grid < 0) return;
    (void)hipMemsetAsync((char*)d_ws + WS_CTL, 0, CTL_ZERO_BYTES, stream);
    Args a{};
    for (int i = 0; i < 17; ++i) a.in[i] = (const float*)d_in[i];
    a.out = (float*)d_out; a.ws = (unsigned char*)d_ws;
    void* kargs[] = {&a};
    hipError_t e = hipLaunchCooperativeKernel((const void*)fwd, dim3(grid), dim3(NTHREADS), kargs, LDS_BYTES, stream);
    if (e != hipSuccess) fprintf(stderr, "kernel_launch: cooperative launch failed: %s (grid %d)\n", hipGetErrorString(e), grid);
}
```

```cpp
#include <hip/hip_runtime.h>
#include <cstdio>
#include <cstdint>
#define PROBE_REP 0


namespace pg8 {
#define PG8_LAS __attribute__((address_space(3)))
#define PG8_GAS __attribute__((address_space(1)))
typedef unsigned short bf16_t;
typedef short bf16x8 __attribute__((ext_vector_type(8)));
typedef float f32x4 __attribute__((ext_vector_type(4)));
typedef unsigned u32x4 __attribute__((ext_vector_type(4)));
constexpr int BM = 256, BK = 64, HALF = 128, HTB = HALF * BK * 2  , STAGE_BYTES = 8 * HTB, NXCD = 8, WGM = 8;

__host__ __device__ __forceinline__ int lds_byte(int r, int c) { const int st = (r >> 4) * 2 + (c >> 5), rr = r & 15, cc = c & 31, ob = rr * 64 + cc * 2; return st * 1024 + (ob ^ (((ob >> 9) & 1) << 5)); }
__host__ __device__ __forceinline__ void stage_rc(int b, int& R, int& C) { const int st = b / 1024, sb = b % 1024, swz = sb ^ (((sb >> 9) & 1) << 5); R = (st >> 1) * 16 + swz / 64; C = (st & 1) * 32 + (swz % 64) / 2; }
__host__ __device__ __forceinline__ int perm32(int rho) { const int n = rho >> 4, i = rho & 15; return 8 * (i >> 2) + 4 * n + (i & 3); }

struct Unit { int pm, pn; };
struct Gemm { const PG8_GAS bf16_t* A; const PG8_GAS bf16_t* Bt; int M, N, K, lda; };

struct StaticOrder {
    int nM, nN, nwg, G, c;
    __host__ __device__ void init(int M, int N, int G_, int c_) { nM = M / BM; nN = N / BM; nwg = nM * nN; G = G_; c = c_; }
    __host__ __device__ bool next(int i, Unit& u) const {
        const long L = (long)i * G + c; if (L >= nwg) return false;
        int wgid = (int)L; { const int q = nwg / NXCD, r = nwg % NXCD, xcd = wgid % NXCD, off = wgid / NXCD; wgid = (xcd < r ? xcd * (q + 1) : r * (q + 1) + (xcd - r) * q) + off; }
        const int nig = WGM * nN, gid = wgid / nig, fm = gid * WGM, gsz = (nM - fm) < WGM ? (nM - fm) : WGM;
        u.pm = fm + ((wgid % nig) % gsz); u.pn = (wgid % nig) / gsz; return true;
    }
    __device__ __forceinline__ void a_ready(const Unit&) const {}
    __device__ __forceinline__ void done(const Unit&) const {}
};

struct GroupOrder {
    int nN, li, hot = 0;
    __host__ __device__ void init(int N, int li_) { nN = N / BM; li = li_; }
    __host__ __device__ bool next(int i, Unit& u) const { const int T = i * 32 + li; if (T >= 8 * nN) return false; u.pm = (hot & 2) ? 0 : (T & 7); u.pn = (hot & 1) ? 0 : (T >> 3); return true; }
    __device__ __forceinline__ void a_ready(const Unit&) const {}
    __device__ __forceinline__ void done(const Unit&) const {}
};

__device__ __forceinline__ float shx(float v, int k, int lane) { return __builtin_bit_cast(float, __builtin_amdgcn_ds_bpermute((lane ^ k) << 2, __builtin_bit_cast(int, v))); }
typedef float f32x2_t __attribute__((ext_vector_type(2))); typedef __bf16 bf16x2_t __attribute__((ext_vector_type(2)));
__device__ __forceinline__ unsigned cvt_pk_bf16(float lo, float hi) { f32x2_t v = {lo, hi}; bf16x2_t b = __builtin_convertvector(v, bf16x2_t); return __builtin_bit_cast(unsigned, b); }

constexpr int PROJ_PITCH = 2304, DT_TILE = 9;
struct EpiProj {
    static constexpr int TAG = 1;
    static constexpr bool PERM = true, AFTER_DRAIN = false, ACC_INIT = false, PRE_HOOK = true;
    PG8_GAS bf16_t* O; PG8_GAS float* dtraw; PG8_LAS float* rstd; f32x4 pa, pb;
    __device__ __forceinline__ void pre(int tid) const {
        float s = (pa[0] + pa[1]) + (pa[2] + pa[3]) + (pb[0] + pb[1]) + (pb[2] + pb[3]);
        s += shx(s, 1, tid & 63);
        if ((tid & 1) == 0) rstd[tid >> 1] = 1.0f / sqrtf(s * (1.0f / 1024.0f) + 1e-6f);
    }
    __device__ __forceinline__ void operator()(const f32x4 (&acc)[2][2][4][2], const Unit& u, int ui, int wr, int wc, int fr, int fq) const {
        int rt0 = wr * 64 + fr; asm volatile("" : "+v"(rt0));
        if (u.pn == DT_TILE) {
            if (wc == 0 && fq == 0) {
#pragma unroll
                for (int ai = 0; ai < 2; ++ai)
#pragma unroll
                    for (int m = 0; m < 4; ++m) { const int rt = ai * HALF + rt0 + m * 16; const float rs = rstd[rt]; PG8_GAS float* p = dtraw + (size_t)(u.pm * BM + rt) * 8;
                        *(PG8_GAS f32x4*)p = acc[ai][0][m][0] * rs; *(PG8_GAS f32x4*)(p + 4) = acc[ai][0][m][1] * rs; }
            }
            return;
        }
        const int col0 = u.pn * BM + wc * 32 + 8 * fq;
#pragma unroll
        for (int ai = 0; ai < 2; ++ai)
#pragma unroll
            for (int m = 0; m < 4; ++m) { const int rt = ai * HALF + rt0 + m * 16; const float rs = rstd[rt]; PG8_GAS bf16_t* rowp = O + (size_t)(u.pm * BM + rt) * PROJ_PITCH + col0;
#pragma unroll
                for (int bj = 0; bj < 2; ++bj) { const f32x4 v0 = acc[ai][bj][m][0] * rs, v1 = acc[ai][bj][m][1] * rs;
                    u32x4 w; w.x = cvt_pk_bf16(v0[0], v0[1]); w.y = cvt_pk_bf16(v0[2], v0[3]); w.z = cvt_pk_bf16(v1[0], v1[1]); w.w = cvt_pk_bf16(v1[2], v1[3]);
                    *(PG8_GAS u32x4*)(rowp + bj * HALF) = w; } }
    }
};
struct EpiUp {
    static constexpr int TAG = 2;
    static constexpr bool PERM = true, AFTER_DRAIN = false, ACC_INIT = false, PRE_HOOK = true;
    PG8_GAS bf16_t* O; int ldc; PG8_LAS float* rstd; f32x4 pa, pb;
    __device__ __forceinline__ void pre(int tid) const {
        float s = (pa[0] + pa[1]) + (pa[2] + pa[3]) + (pb[0] + pb[1]) + (pb[2] + pb[3]);
        s += shx(s, 1, tid & 63);
        if ((tid & 1) == 0) rstd[tid >> 1] = 1.0f / sqrtf(s * (1.0f / 1024.0f) + 1e-6f);
    }
    __device__ __forceinline__ void operator()(const f32x4 (&acc)[2][2][4][2], const Unit& u, int ui, int wr, int wc, int fr, int fq) const {
        int rt0 = wr * 64 + fr; asm volatile("" : "+v"(rt0)); const int col0 = u.pn * BM + wc * 32 + 8 * fq;
#pragma unroll
        for (int ai = 0; ai < 2; ++ai)
#pragma unroll
            for (int m = 0; m < 4; ++m) { const int rt = ai * HALF + rt0 + m * 16; const float rs = rstd[rt]; PG8_GAS bf16_t* rowp = O + (size_t)(u.pm * BM + rt) * ldc + col0;
#pragma unroll
                for (int bj = 0; bj < 2; ++bj) { f32x4 v0 = acc[ai][bj][m][0] * rs, v1 = acc[ai][bj][m][1] * rs;
#pragma unroll
                    for (int e = 0; e < 4; ++e) { const float a = fmaxf(v0[e], 0.f), b = fmaxf(v1[e], 0.f); v0[e] = a * a; v1[e] = b * b; }
                    u32x4 w; w.x = cvt_pk_bf16(v0[0], v0[1]); w.y = cvt_pk_bf16(v0[2], v0[3]); w.z = cvt_pk_bf16(v1[0], v1[1]); w.w = cvt_pk_bf16(v1[2], v1[3]);
                    *(PG8_GAS u32x4*)(rowp + bj * HALF) = w; } }
    }
};
template <bool FINAL> struct EpiRes {
    static constexpr int TAG = 3;
    static constexpr bool PERM = true, AFTER_DRAIN = false, ACC_INIT = true, PRE_HOOK = false;
    PG8_GAS bf16_t* xb; PG8_GAS float* ssq; PG8_GAS float* out; PG8_GAS bf16_t* xdst;
    __device__ __forceinline__ void init(f32x4 (&acc)[2][2][4][2], const Unit& u, int wr, int wc, int fr, int fq) const {
        const int rt0 = wr * 64 + fr, col0 = u.pn * BM + wc * 32 + 8 * fq;
#pragma unroll
        for (int ai = 0; ai < 2; ++ai)
#pragma unroll
            for (int m = 0; m < 4; ++m) { const int row = u.pm * BM + ai * HALF + rt0 + m * 16; const size_t off = (size_t)row * 1024 + col0;
#pragma unroll
                for (int bj = 0; bj < 2; ++bj) { const u32x4 rw = *(const PG8_GAS u32x4*)(xb + off + bj * HALF);
                    acc[ai][bj][m][0] = (f32x4){__uint_as_float(rw.x << 16), __uint_as_float(rw.x & 0xffff0000u), __uint_as_float(rw.y << 16), __uint_as_float(rw.y & 0xffff0000u)};
                    acc[ai][bj][m][1] = (f32x4){__uint_as_float(rw.z << 16), __uint_as_float(rw.z & 0xffff0000u), __uint_as_float(rw.w << 16), __uint_as_float(rw.w & 0xffff0000u)}; } }
    }
    __device__ __forceinline__ void operator()(const f32x4 (&acc)[2][2][4][2], const Unit& u, int ui, int wr, int wc, int fr, int fq) const {
        int rt0 = wr * 64 + fr; asm volatile("" : "+v"(rt0)); const int col0 = u.pn * BM + wc * 32 + 8 * fq;
#pragma unroll
        for (int ai = 0; ai < 2; ++ai)
#pragma unroll
            for (int m = 0; m < 4; ++m) { const int row = u.pm * BM + ai * HALF + rt0 + m * 16; const size_t off = (size_t)row * 1024 + col0; float s = 0.f;
#pragma unroll
                for (int bj = 0; bj < 2; ++bj) { const f32x4 v0 = acc[ai][bj][m][0], v1 = acc[ai][bj][m][1];
                    if (FINAL) { *(PG8_GAS f32x4*)(out + off + bj * HALF) = v0; *(PG8_GAS f32x4*)(out + off + bj * HALF + 4) = v1; }
                    else { u32x4 w; w.x = cvt_pk_bf16(v0[0], v0[1]); w.y = cvt_pk_bf16(v0[2], v0[3]); w.z = cvt_pk_bf16(v1[0], v1[1]); w.w = cvt_pk_bf16(v1[2], v1[3]);
                        *(PG8_GAS u32x4*)(xdst + off + bj * HALF) = w;
                        s += (v0[0] * v0[0] + v0[1] * v0[1]) + (v0[2] * v0[2] + v0[3] * v0[3]) + (v1[0] * v1[0] + v1[1] * v1[1]) + (v1[2] * v1[2] + v1[3] * v1[3]); } }
                if (!FINAL) { const int ln = fq * 16 + fr; s += shx(s, 16, ln); s += shx(s, 32, ln);
                    if (fq == 0) ssq[(size_t)row * 16 + u.pn * 4 + wc] = s; } }
    }
};

template <class Epi, class Sched, bool ALIGN_EPI = false, bool SP2 = false>
__device__ __forceinline__ void gemm_phase(PG8_LAS unsigned char* lds, const Gemm g, const Sched& S, const Epi& E) {
#if PROBE_REP >= 80
    if (PROBE_REP == 93 && Epi::TAG == 3 && g.K == 4096 && threadIdx.x == 0) *(PG8_LAS unsigned*)(lds + 161288) = (unsigned)__builtin_amdgcn_s_memrealtime();
    if (PROBE_REP == 88 && Epi::TAG == 2 && threadIdx.x == 0) *(PG8_LAS unsigned*)(lds + 161280) = (unsigned)__builtin_amdgcn_s_memrealtime() - *(PG8_LAS unsigned*)(lds + 161288);
#endif
    int tid_ = threadIdx.x; asm volatile("" : "+v"(tid_));
    const int tid = tid_, wid = __builtin_amdgcn_readfirstlane(tid >> 6), lane = tid & 63, wr = wid >> 2, wc = wid & 3, fr = lane & 15, fq = lane >> 4;
    const int K = g.K, nt = K / BK;
    unsigned voffA[2], voffB[2];
#pragma unroll
    for (int i = 0; i < 2; ++i) { int R, C; stage_rc(tid * 16 + i * 8192, R, C); const int Rb = Epi::PERM ? ((R & ~31) + perm32(R & 31)) : R;
        voffA[i] = (unsigned)(R * g.lda + C) * 2u; voffB[i] = (unsigned)(Rb * K + C) * 2u; }
    const size_t kstep = (size_t)(BK * 2);
    const size_t hstepA = (size_t)HALF * g.lda * 2, hstepB = (size_t)HALF * K * 2;
    const size_t tstepA = 2 * hstepA, tstepB = 2 * hstepB;
    const unsigned ldsw = (unsigned)wid * 1024u;
    const int aoff = lds_byte(wr * 64 + fr, fq * 8), boff = lds_byte(wc * 32 + fr, fq * 8);
#define PG8_SA(b, h) (((b) * 2 + (h)) * HTB)
#define PG8_SB(b, h) ((4 + (b) * 2 + (h)) * HTB)
#define PG8_STAGE(bufoff, gbase, voff) do { _Pragma("unroll") for (int _i = 0; _i < 2; ++_i) \
        __builtin_amdgcn_global_load_lds((const unsigned*)((const char*)(gbase) + (voff)[_i]), (PG8_LAS unsigned*)(lds + (bufoff) + ldsw + _i * 8192), 16, 0, 0); } while (0)
#define PG8_LDA(dst, b, h) do { _Pragma("unroll") for (int m = 0; m < 4; ++m) _Pragma("unroll") for (int k = 0; k < 2; ++k) dst[m][k] = *(const PG8_LAS bf16x8*)(lds + PG8_SA(b, h) + aoff + m * 2048 + k * 1024); } while (0)
#define PG8_LDB(dst, b, h) do { _Pragma("unroll") for (int n = 0; n < 2; ++n) _Pragma("unroll") for (int k = 0; k < 2; ++k) dst[n][k] = *(const PG8_LAS bf16x8*)(lds + PG8_SB(b, h) + boff + n * 2048 + k * 1024); } while (0)
#define PG8_MMA(ai, bj, At, Bt) do { __builtin_amdgcn_s_setprio(1); _Pragma("unroll") for (int m = 0; m < 4; ++m) _Pragma("unroll") for (int n = 0; n < 2; ++n) _Pragma("unroll") for (int k = 0; k < 2; ++k) \
        acc[ai][bj][m][n] = __builtin_amdgcn_mfma_f32_16x16x32_bf16(Bt[n][k], At[m][k], acc[ai][bj][m][n], 0, 0, 0); __builtin_amdgcn_s_setprio(0); } while (0)
#define PG8_WAIT_V(n) asm volatile("s_waitcnt vmcnt(" #n ")" ::: "memory")
#define PG8_WAIT_L(n) asm volatile("s_waitcnt lgkmcnt(" #n ")" ::: "memory")
#define PG8_BAR __builtin_amdgcn_s_barrier()
#define PG8_SCHED __builtin_amdgcn_sched_barrier(0)
    Unit cur, nxt; int ui = 0;
#if PROBE_REP >= 80
    unsigned long long pt0 = 0; if (PROBE_REP == 82) pt0 = __builtin_amdgcn_s_memrealtime();
#endif
    if (!S.next(0, cur)) return;
    f32x4 acc[2][2][4][2];
#pragma unroll
    for (int a = 0; a < 2; ++a)
#pragma unroll
        for (int b = 0; b < 2; ++b)
#pragma unroll
            for (int m = 0; m < 4; ++m)
#pragma unroll
                for (int n = 0; n < 2; ++n) acc[a][b][m][n] = (f32x4){0.f, 0.f, 0.f, 0.f};
    if constexpr (Epi::ACC_INIT) E.init(acc, cur, wr, wc, fr, fq);
    bf16x8 At[4][2], B0[2][2], B1[2][2];
    const char* cA = (const char*)g.A + (size_t)cur.pm * tstepA; const char* cB = (const char*)g.Bt + (size_t)cur.pn * tstepB;
    S.a_ready(cur);
    if constexpr (SP2) {
        PG8_STAGE(PG8_SB(0, 0), cB, voffB); PG8_STAGE(PG8_SB(0, 1), cB + hstepB, voffB); PG8_STAGE(PG8_SA(0, 0), cA, voffA); PG8_STAGE(PG8_SA(0, 1), cA + hstepA, voffA);
        if constexpr (Epi::PRE_HOOK) E.pre(tid);
        if (wr == 1) PG8_BAR;
        PG8_WAIT_V(2); PG8_BAR;
        PG8_STAGE(PG8_SB(1, 0), cB + kstep, voffB); PG8_STAGE(PG8_SA(1, 0), cA + kstep, voffA); PG8_STAGE(PG8_SB(1, 1), cB + hstepB + kstep, voffB);
        PG8_WAIT_V(6); PG8_BAR;
    } else {
        PG8_STAGE(PG8_SB(0, 0), cB, voffB); PG8_STAGE(PG8_SA(0, 0), cA, voffA); PG8_STAGE(PG8_SB(0, 1), cB + hstepB, voffB); PG8_STAGE(PG8_SA(0, 1), cA + hstepA, voffA);
        if (wr == 1) PG8_BAR;
        PG8_WAIT_V(4); PG8_BAR;
        PG8_STAGE(PG8_SB(1, 0), cB + kstep, voffB); PG8_STAGE(PG8_SA(1, 0), cA + kstep, voffA); PG8_STAGE(PG8_SB(1, 1), cB + hstepB + kstep, voffB);
        PG8_WAIT_V(6); PG8_BAR;
    }
    for (;;) {
        const bool has_next = S.next(ui + 1, nxt);
        const char* nA = has_next ? (const char*)g.A + (size_t)nxt.pm * tstepA : cA; const char* nB = has_next ? (const char*)g.Bt + (size_t)nxt.pn * tstepB : cB;
#if PROBE_REP >= 80
        if (Epi::TAG == 2 && ui == 0 && PROBE_REP == 82 && tid == 0) *(PG8_LAS unsigned*)(lds + 161280) = (unsigned)(__builtin_amdgcn_s_memrealtime() - pt0);
        if (Epi::TAG == 2 && ((PROBE_REP == 86 && ui == 0) || (PROBE_REP == 87 && ui == 3) || (PROBE_REP == 89 && ui == 0) || (PROBE_REP == 90 && ui == 2)) && tid == 0) *(PG8_LAS unsigned*)(lds + 161288) = (unsigned)__builtin_amdgcn_s_memrealtime();
        if (Epi::TAG == 3 && nt == 64 && PROBE_REP == 91 && tid == 0) *(PG8_LAS unsigned*)(lds + 161288) = (unsigned)__builtin_amdgcn_s_memrealtime();
        if (Epi::TAG == 3 && nt == 64 && PROBE_REP == 93 && tid == 0) *(PG8_LAS unsigned*)(lds + 161280) = (unsigned)__builtin_amdgcn_s_memrealtime() - *(PG8_LAS unsigned*)(lds + 161288);
        if (Epi::TAG == 2 && ui == 1) { if (PROBE_REP == 80) pt0 = __builtin_amdgcn_s_memrealtime(); if (PROBE_REP == 81 && tid == 0) *(PG8_LAS unsigned*)(lds + 161280) = (unsigned)(__builtin_amdgcn_s_memrealtime() - pt0); }
#endif
        for (int t = 0; t < nt; t += 2) {
            const bool last = (t == nt - 2);
            const char* a1 = cA + (size_t)(t + 1) * kstep;
            const char* a2 = last ? nA : cA + (size_t)(t + 2) * kstep; const char* b2 = last ? nB : cB + (size_t)(t + 2) * kstep;
            const char* a3 = a2 + kstep; const char* b3 = b2 + kstep;
            if (last && has_next) S.a_ready(nxt);
            if constexpr (SP2) {
            PG8_LDB(B0, 0, 0); PG8_LDB(B1, 0, 1); PG8_SCHED; PG8_LDA(At, 0, 0); PG8_STAGE(PG8_SA(1, 1), a1 + hstepA, voffA);
            PG8_WAIT_V(8); PG8_WAIT_L(0); PG8_BAR; PG8_MMA(0, 0, At, B0); PG8_MMA(0, 1, At, B1); PG8_BAR; PG8_SCHED;
            PG8_LDA(At, 0, 1); PG8_STAGE(PG8_SB(0, 0), b2, voffB); PG8_STAGE(PG8_SB(0, 1), b2 + hstepB, voffB); PG8_STAGE(PG8_SA(0, 0), a2, voffA);
            PG8_WAIT_V(8); PG8_WAIT_L(0); PG8_BAR; PG8_MMA(1, 0, At, B0); PG8_MMA(1, 1, At, B1); PG8_BAR; PG8_SCHED;
            PG8_LDB(B0, 1, 0); PG8_LDB(B1, 1, 1); PG8_SCHED; PG8_LDA(At, 1, 0); PG8_STAGE(PG8_SA(0, 1), a2 + hstepA, voffA);
            PG8_WAIT_V(8); PG8_WAIT_L(0); PG8_BAR; PG8_MMA(0, 0, At, B0); PG8_MMA(0, 1, At, B1); PG8_BAR; PG8_SCHED;
            PG8_LDA(At, 1, 1); PG8_STAGE(PG8_SB(1, 0), b3, voffB); PG8_STAGE(PG8_SB(1, 1), b3 + hstepB, voffB); PG8_STAGE(PG8_SA(1, 0), a3, voffA);
            PG8_WAIT_V(8); PG8_WAIT_L(0); PG8_BAR; PG8_MMA(1, 0, At, B0); PG8_MMA(1, 1, At, B1); PG8_BAR; PG8_SCHED;
            } else {
            PG8_LDB(B0, 0, 0); PG8_SCHED; PG8_LDA(At, 0, 0); PG8_STAGE(PG8_SA(1, 1), a1 + hstepA, voffA);
            PG8_WAIT_L(8); PG8_BAR; PG8_WAIT_L(0); PG8_MMA(0, 0, At, B0); PG8_BAR; PG8_SCHED;
            PG8_LDB(B1, 0, 1); PG8_STAGE(PG8_SB(0, 0), b2, voffB);
            PG8_BAR; PG8_WAIT_L(0); PG8_MMA(0, 1, At, B1); PG8_BAR;
            PG8_LDA(At, 0, 1); PG8_STAGE(PG8_SA(0, 0), a2, voffA);
            PG8_BAR; PG8_WAIT_L(0); PG8_MMA(1, 0, At, B0); PG8_BAR; PG8_SCHED;
            PG8_STAGE(PG8_SB(0, 1), b2 + hstepB, voffB);
            PG8_WAIT_V(6); PG8_BAR; PG8_MMA(1, 1, At, B1); PG8_BAR;
            PG8_LDB(B0, 1, 0); PG8_SCHED; PG8_LDA(At, 1, 0); PG8_STAGE(PG8_SA(0, 1), a2 + hstepA, voffA);
            PG8_WAIT_L(8); PG8_BAR; PG8_WAIT_L(0); PG8_MMA(0, 0, At, B0); PG8_BAR; PG8_SCHED;
            PG8_LDB(B1, 1, 1); PG8_STAGE(PG8_SB(1, 0), b3, voffB);
            PG8_BAR; PG8_WAIT_L(0); PG8_MMA(0, 1, At, B1); PG8_BAR;
            PG8_LDA(At, 1, 1); PG8_STAGE(PG8_SA(1, 0), a3, voffA);
            PG8_BAR; PG8_WAIT_L(0); PG8_MMA(1, 0, At, B0); PG8_BAR; PG8_SCHED;
            PG8_STAGE(PG8_SB(1, 1), b3 + hstepB, voffB);
            PG8_WAIT_V(6); PG8_BAR; PG8_MMA(1, 1, At, B1); PG8_BAR;
            }
        }
#if PROBE_REP >= 80
        if (Epi::TAG == 2 && ((PROBE_REP == 86 && ui == 0) || (PROBE_REP == 87 && ui == 3) || (PROBE_REP == 89 && ui == 3) || (PROBE_REP == 90 && ui == 2)) && tid == 0) *(PG8_LAS unsigned*)(lds + 161280) = (unsigned)__builtin_amdgcn_s_memrealtime() - *(PG8_LAS unsigned*)(lds + 161288);
        if (Epi::TAG == 3 && nt == 64 && PROBE_REP == 94 && tid == 0) *(PG8_LAS unsigned*)(lds + 161288) = (unsigned)__builtin_amdgcn_s_memrealtime();
        if (Epi::TAG == 3 && nt == 64 && PROBE_REP == 91 && tid == 0) *(PG8_LAS unsigned*)(lds + 161280) = (unsigned)__builtin_amdgcn_s_memrealtime() - *(PG8_LAS unsigned*)(lds + 161288);
        if (Epi::TAG == 2 && ui == 1 && PROBE_REP == 80 && tid == 0) *(PG8_LAS unsigned*)(lds + 161280) = (unsigned)(__builtin_amdgcn_s_memrealtime() - pt0);
        if (Epi::TAG == 2 && ui == 0 && PROBE_REP == 81) pt0 = __builtin_amdgcn_s_memrealtime();
#endif
        if constexpr (ALIGN_EPI) { if (wr == 0) PG8_BAR; }
        if constexpr (!Epi::AFTER_DRAIN) { E(acc, cur, ui, wr, wc, fr, fq); S.done(cur); }
#if PROBE_REP >= 80
        if (PROBE_REP == 83 && !has_next && tid == 0) *(PG8_LAS unsigned*)(lds + 161288) = (unsigned)__builtin_amdgcn_s_memrealtime();
#endif
        if (!has_next) break;
#pragma unroll
        for (int a = 0; a < 2; ++a)
#pragma unroll
            for (int b = 0; b < 2; ++b)
#pragma unroll
                for (int m = 0; m < 4; ++m)
#pragma unroll
                    for (int n = 0; n < 2; ++n) acc[a][b][m][n] = (f32x4){0.f, 0.f, 0.f, 0.f};
        cur = nxt; cA = nA; cB = nB; ++ui;
        if constexpr (ALIGN_EPI) { if (wr == 1) PG8_BAR; }
    }
    PG8_WAIT_V(0);
    if constexpr (!ALIGN_EPI) { if (wr == 0) PG8_BAR; }
    PG8_BAR;
#if PROBE_REP >= 80
    if (Epi::TAG == 3 && nt == 64 && PROBE_REP == 94 && tid == 0) *(PG8_LAS unsigned*)(lds + 161280) = (unsigned)__builtin_amdgcn_s_memrealtime() - *(PG8_LAS unsigned*)(lds + 161288);
    if (Epi::TAG == 2 && PROBE_REP == 83 && tid == 0) *(PG8_LAS unsigned*)(lds + 161280) = (unsigned)__builtin_amdgcn_s_memrealtime() - *(PG8_LAS unsigned*)(lds + 161288);
#endif

#undef PG8_SA
#undef PG8_SB
#undef PG8_STAGE
#undef PG8_LDA
#undef PG8_LDB
#undef PG8_MMA
#undef PG8_WAIT_V
#undef PG8_WAIT_L
#undef PG8_BAR
#undef PG8_SCHED
}
}

constexpr int NWAVES = 8, NTHREADS = NWAVES * 64;
constexpr int BATCH = 8, SEQ = 2048, D = 1024, M = BATCH * SEQ, FF = 4096, DEPTH = 2;
constexpr int D_IN = 2312, NPROJ = 2560, PP = pg8::PROJ_PITCH;
constexpr int CQ = 0, CZ = 512, CK = 1024, CV = 1152, CX = 1280, CBM = 1792, CCM = 2048;
constexpr float EPS = 1e-6f;
constexpr int GRID = 256, NGRP = 8, GRP = GRID / NGRP;

constexpr size_t MiB = 1u << 20;
constexpr size_t WS_CTL = 0, CTL_ZERO_BYTES = 1 * MiB;
constexpr size_t WS_SSQ = 1 * MiB;
constexpr size_t WS_DTRAW = 2 * MiB;
constexpr size_t WS_ACS = 2 * MiB + 512 * 1024, WS_CHDEC = 3 * MiB;
constexpr size_t WS_WIN = 4 * MiB, WS_WOUT = 14 * MiB, WS_WUP = 18 * MiB, WS_WDOWN = 34 * MiB;
constexpr size_t WS_XB = 50 * MiB;
constexpr size_t WS_BATCH0 = 82 * MiB, BATCH_STRIDE = 20 * MiB;
constexpr size_t BO_PROJ = 0;
constexpr size_t BO_STATES = 9 * MiB;
constexpr size_t BO_PREV = 13 * MiB;
constexpr size_t BO_YPART = 15 * MiB;
constexpr size_t BO_CC = 19 * MiB;
constexpr int HIDP = 4096;
constexpr size_t BO_HID = 0;
constexpr size_t WS_END = WS_BATCH0 + BATCH * BATCH_STRIDE;
static_assert(WS_END <= 256 * MiB, "d_ws map");
constexpr int CW_BAR = 4096, CW_GRP = 16384, GRP_BAR_STRIDE = 4096;

constexpr int RING_OFF = 0, RING_BYTES = 131072;
constexpr int MIX_BYTES = 155648;
constexpr int LDSCTL_OFF = MIX_BYTES, MISC_OFF = LDSCTL_OFF + 320, RSTD_OFF = LDSCTL_OFF + 512, PTR_OFF = RSTD_OFF + 4096;
constexpr int LDS_BYTES = 163840;
static_assert(PTR_OFF + 512 <= LDS_BYTES && RING_BYTES <= MIX_BYTES, "LDS map");

#define GAS __attribute__((address_space(1)))
#define LAS __attribute__((address_space(3)))
typedef unsigned short bf16;
typedef unsigned v4u __attribute__((ext_vector_type(4)));
typedef unsigned v2u __attribute__((ext_vector_type(2)));
typedef float f32x4 __attribute__((ext_vector_type(4)));
#define LDS_WAIT() asm volatile("s_waitcnt lgkmcnt(0)" ::: "memory")
#define VM_WAIT() asm volatile("s_waitcnt vmcnt(0)" ::: "memory")
__device__ __forceinline__ unsigned f2bf(float f) { unsigned u = __builtin_bit_cast(unsigned, f); return (u + 0x7fffu + ((u >> 16) & 1u)) >> 16; }
__device__ __forceinline__ unsigned pk2(float lo, float hi) { return f2bf(lo) | (f2bf(hi) << 16); }
__device__ __forceinline__ float bflo(unsigned w) { return __uint_as_float(w << 16); }
__device__ __forceinline__ float bfhi(unsigned w) { return __uint_as_float(w & 0xffff0000u); }
__device__ __forceinline__ float silu_f(float v) { return v / (1.f + expf(-v)); }
__device__ __forceinline__ float softplus_f(float v) { return fmaxf(v, 0.f) + log1pf(expf(-fabsf(v))); }

#define XB_TMO      128
#define XB_XCNT(j)  (256  + 64 * (j))
#define XB_XSUB(j)  (1280 + 64 * (j))
#define XB_XGEN(j)  (2304 + 64 * (j))
#define XB_TOP      3328
#define XB_TOPGEN   3392
#define XCD_BAR_WORDS 3456
#define XB_SPIN_CAP (1u << 22)
__device__ __forceinline__ unsigned xb_ld(unsigned* p)              { return __hip_atomic_load(p, __ATOMIC_RELAXED, __HIP_MEMORY_SCOPE_AGENT); }
__device__ __forceinline__ unsigned xb_add(unsigned* p, unsigned v) { return __hip_atomic_fetch_add(p, v, __ATOMIC_RELAXED, __HIP_MEMORY_SCOPE_AGENT); }
__device__ __forceinline__ unsigned xb_xcc_id() { return (unsigned)__builtin_amdgcn_s_getreg((3 << 11) | 20) & 0xFu; }
#define XB_SPIN(cond, bar) do { unsigned _sp = 0; while (cond) { __builtin_amdgcn_s_sleep(1); \
    if ((++_sp & 255u) == 0u) { if (xb_ld(&(bar)[XB_TMO])) break; if (_sp > XB_SPIN_CAP) { atomicAdd(&(bar)[XB_TMO], 1u); break; } } } } while (0)
struct XcdBarrier { unsigned* bar; unsigned x; unsigned total; volatile LAS unsigned* st; };
__device__ __forceinline__ XcdBarrier xcd_barrier_post(unsigned* bar, volatile LAS unsigned* st, unsigned total) {
    XcdBarrier b; b.bar = bar; b.x = xb_xcc_id(); b.total = total; b.st = st;
    if (threadIdx.x == 0) (void)xb_add(&bar[XB_XCNT(b.x)], 1u);
    return b;
}
__device__ __forceinline__ void xcd_barrier_complete(unsigned* bar, unsigned x, unsigned G, unsigned& nloc, unsigned& nx) {
    unsigned sum, cnt, mine, sp = 0u;
    for (;;) {
        sum = 0u; cnt = 0u; mine = 0u;
#pragma unroll
        for (unsigned j = 0; j < 16; ++j) { const unsigned c = xb_ld(&bar[XB_XCNT(j)]); sum += c; cnt += (c > 0u) ? 1u : 0u; mine = (j == x) ? c : mine; }
        if (sum == G) break;
        __builtin_amdgcn_s_sleep(1);
        if ((++sp & 255u) == 0u) { if (xb_ld(&bar[XB_TMO])) break; if (sp > XB_SPIN_CAP) { atomicAdd(&bar[XB_TMO], 1u); break; } }
    }
    nloc = mine > 0u ? mine : 1u; nx = cnt > 0u ? cnt : 1u;
}
__device__ __forceinline__ void xcd_barrier(const XcdBarrier& b) {
    asm volatile("s_waitcnt vmcnt(0)" ::: "memory");
    __syncthreads();
    if (threadIdx.x == 0) {
        unsigned* bar = b.bar;
        __builtin_amdgcn_s_waitcnt(0);
        unsigned nloc = b.st[0], nx = b.st[1];
        if (nloc == 0u) { xcd_barrier_complete(bar, b.x, b.total, nloc, nx); b.st[0] = nloc; b.st[1] = nx; }
        const unsigned old = xb_add(&bar[XB_XSUB(b.x)], 1u);
        const unsigned gen = old / nloc;
        if (nx == 1u) {
            XB_SPIN(xb_ld(&bar[XB_XSUB(b.x)]) < (gen + 1u) * nloc, bar);
            __builtin_amdgcn_fence(__ATOMIC_ACQUIRE, "agent");
            asm volatile("s_waitcnt vmcnt(0)" ::: "memory");
        } else if (old + 1u == (gen + 1u) * nloc) {
            __builtin_amdgcn_fence(__ATOMIC_RELEASE, "agent");
            asm volatile("s_waitcnt vmcnt(0)" ::: "memory");
            const unsigned og = xb_add(&bar[XB_TOP], 1u);
            const unsigned tg = og / nx;
            if (og + 1u == (tg + 1u) * nx) xb_add(&bar[XB_TOPGEN], 1u);
            else XB_SPIN(xb_ld(&bar[XB_TOPGEN]) == tg, bar);
            __builtin_amdgcn_fence(__ATOMIC_ACQUIRE, "agent");
            xb_add(&bar[XB_XGEN(b.x)], 1u);
            asm volatile("s_waitcnt vmcnt(0)" ::: "memory");
        } else {
            XB_SPIN(xb_ld(&bar[XB_XGEN(b.x)]) == gen, bar);
            __builtin_amdgcn_fence(__ATOMIC_ACQUIRE, "agent");
            asm volatile("s_waitcnt vmcnt(0)" ::: "memory");
        }
    }
    __syncthreads();
}

struct Frame {
    LAS unsigned char* lds;
    int tid, lane, wave, bid, G;
    int b, li;
};
enum { I_X = 0, I_MIXG, I_WIN, I_QG, I_KG, I_SINK, I_RELB, I_CONVW, I_CONVB, I_DTB, I_ALOG, I_DSKIP, I_SSMG, I_WOUT, I_MLPG, I_WUP, I_WDOWN, I_OUT, I_WS, I_NPTR };
__device__ __forceinline__ GAS unsigned char* ptr_at(const Frame& F, int i) {
    const LAS unsigned* t = (const LAS unsigned*)(F.lds + PTR_OFF) + 2 * i;
    const unsigned lo = __builtin_amdgcn_readfirstlane(t[0]), hi = __builtin_amdgcn_readfirstlane(t[1]);
    return (GAS unsigned char*)(((unsigned long long)hi << 32) | lo);
}
#define FIN(i) ((const GAS float*)ptr_at(F, (i)))
#define FWS(off) (ptr_at(F, I_WS) + (off))
#define FB(off) (ptr_at(F, I_WS) + (WS_BATCH0 + (size_t)F.b * BATCH_STRIDE + (off)))
using pg8::shx;
__device__ __forceinline__ float shup(float v, int o, int lane) { return __builtin_bit_cast(float, __builtin_amdgcn_ds_bpermute(((lane - o) & 63) << 2, __builtin_bit_cast(int, v))); }
__device__ __forceinline__ float wave_sum(float v, int lane) {
#pragma unroll
    for (int o = 1; o < 64; o <<= 1) v += shx(v, o, lane);
    return v;
}

__device__ __forceinline__ void st_wt16(GAS v4u* p, v4u v) { asm volatile("global_store_dwordx4 %0, %1, off sc0 sc1" :: "v"(p), "v"(v) : "memory"); }
__device__ __forceinline__ void st_wt8(GAS v2u* p, v2u v) { asm volatile("global_store_dwordx2 %0, %1, off sc0 sc1" :: "v"(p), "v"(v) : "memory"); }
__device__ __forceinline__ void st_wt4(GAS float* p, float v) { asm volatile("global_store_dword %0, %1, off sc0 sc1" :: "v"(p), "v"(v) : "memory"); }
template <bool WT = false> __device__ __forceinline__ void tr_item(const GAS float* W, int Nsrc, int nsrc0, int nvalid, int K, const GAS float* gain, GAS bf16* WT_, int ndst0, int k0, LAS float* scr, int lane) {
    const int n = lane & 31;
    float tv[32];
#pragma unroll
    for (int i = 0; i < 32; ++i) { const int kk = 2 * i + (lane >> 5); tv[i] = __builtin_nontemporal_load(&W[(size_t)(k0 + kk) * Nsrc + nsrc0 + (n < nvalid ? n : 0)]); }
#pragma unroll
    for (int i = 0; i < 32; ++i) { const int kk = 2 * i + (lane >> 5); float v = (n < nvalid) ? tv[i] : 0.f; if (gain) v *= gain[k0 + kk];
        scr[kk * 33 + n] = v; }
    LDS_WAIT(); asm volatile("" ::: "memory");
    const int c = lane & 7;
#pragma unroll
    for (int j = 0; j < 4; ++j) { const int nn = (lane >> 3) + 8 * j; const LAS float* s = scr + (8 * c) * 33 + nn;
        v4u o; o.x = pk2(s[0 * 33], s[1 * 33]); o.y = pk2(s[2 * 33], s[3 * 33]); o.z = pk2(s[4 * 33], s[5 * 33]); o.w = pk2(s[6 * 33], s[7 * 33]);
        if (WT) st_wt16((GAS v4u*)(WT_ + (size_t)(ndst0 + nn) * K + k0 + 8 * c), o); else *(GAS v4u*)(WT_ + (size_t)(ndst0 + nn) * K + k0 + 8 * c) = o; }
    LDS_WAIT(); asm volatile("" ::: "memory");
}
template <bool WT = false> __device__ __forceinline__ void win_item(Frame& F, int L, int r, LAS float* scr);
constexpr int CW_PCNT = 8192 + 64 * 8;
template <int R> __device__ __forceinline__ void xr_load(f32x4 (&v)[4][4], const GAS float* x, int m0, int nW, int lane) {
#pragma unroll
    for (int r = 0; r < R; ++r) { const int m = m0 + r * nW;
        if (m < SEQ) { const GAS f32x4* xr = (const GAS f32x4*)(x + (size_t)m * D) + lane;
#pragma unroll
            for (int j = 0; j < 4; ++j) v[r][j] = __builtin_nontemporal_load(xr + 64 * j); } }
}
template <int R> __device__ __forceinline__ void xr_store(const f32x4 (&v)[4][4], GAS bf16* XB, GAS float* SSQ, int m0, int nW, int lane) {
#pragma unroll
    for (int r = 0; r < R; ++r) { const int m = m0 + r * nW;
        if (m < SEQ) { float t = 0.f;
#pragma unroll
            for (int j = 0; j < 4; ++j) t += (v[r][j].x * v[r][j].x + v[r][j].y * v[r][j].y) + (v[r][j].z * v[r][j].z + v[r][j].w * v[r][j].w);
            const float s = wave_sum(t, lane); GAS v2u* o8 = (GAS v2u*)(XB + (size_t)m * D) + lane;
#pragma unroll
            for (int j = 0; j < 4; ++j) { v2u o; o.x = pk2(v[r][j].x, v[r][j].y); o.y = pk2(v[r][j].z, v[r][j].w); st_wt8(o8 + 64 * j, o); }
            if (lane < 16) st_wt4(SSQ + (size_t)m * 16 + lane, (lane == 0) ? s : 0.f); } }
}
template <int K> __device__ __forceinline__ void xb_stage(Frame& F, f32x4 (&va)[4][4], f32x4 (&vb)[4][4], const GAS float* X, GAS bf16* XBw, GAS float* SSQw, unsigned* pcnt) {
    constexpr int RK[10] = {1, 2, 2, 2, 2, 3, 4, 4, 4, 1};
    constexpr int bb = K < 8 ? K : 7, K1 = K + 1, bb1 = K1 < 8 ? K1 : 7;
    const int myb = F.b;
    if (bb <= myb) {
        const int nW = (NGRP - bb) * GRP * NWAVES, m0 = ((myb - bb) * GRP + F.li) * NWAVES + F.wave + (K == 8 ? 4 * nW : 0);
        f32x4 (&cur)[4][4] = (K & 1) ? vb : va; f32x4 (&nx)[4][4] = (K & 1) ? va : vb;
        if (K1 < 9 && bb1 <= myb) { const int nW1 = (NGRP - bb1) * GRP * NWAVES, m1 = ((myb - bb1) * GRP + F.li) * NWAVES + F.wave + (K1 == 8 ? 4 * nW1 : 0);
            xr_load<RK[K1]>(nx, X + (size_t)bb1 * SEQ * D, m1, nW1, F.lane); }
        xr_store<RK[K]>(cur, XBw + (size_t)bb * SEQ * D, SSQw + (size_t)bb * SEQ * 16, m0, nW, F.lane);
        if (K != 7) {
            VM_WAIT(); __syncthreads();
            if (F.tid == 0) (void)xb_add(pcnt + 64 * bb, 1u);
        }
    }
}
__device__ __forceinline__ void p0_prologue(Frame& F) {
    LAS float* scr = (LAS float*)(F.lds + RING_OFF + F.wave * 16384);
    const int gw = F.bid * NWAVES + F.wave, NGW = F.G * NWAVES;
    constexpr int I_IN = 16 * 80, I_OUT = 16 * 32, I_UP = 16 * 128, I_DN = 64 * 32, I_L = I_IN + I_OUT + I_UP + I_DN;
    for (int it = gw; it < I_IN; it += NGW) win_item<true>(F, 0, it, scr);
    const GAS float* X = FIN(I_X); GAS bf16* XBw = (GAS bf16*)FWS(WS_XB); GAS float* SSQw = (GAS float*)FWS(WS_SSQ);
    unsigned* pcnt = (unsigned*)(unsigned char*)FWS(WS_CTL) + CW_PCNT;
    const int myb = F.b;
    f32x4 va[4][4], vb[4][4];
#pragma unroll
    for (int r = 0; r < 4; ++r)
#pragma unroll
        for (int j = 0; j < 4; ++j) { va[r][j] = (f32x4){0.f, 0.f, 0.f, 0.f}; vb[r][j] = (f32x4){0.f, 0.f, 0.f, 0.f}; }
    xr_load<1>(va, X, (myb * GRP + F.li) * NWAVES + F.wave, NGRP * GRP * NWAVES, F.lane);
    xb_stage<0>(F, va, vb, X, XBw, SSQw, pcnt); xb_stage<1>(F, va, vb, X, XBw, SSQw, pcnt); xb_stage<2>(F, va, vb, X, XBw, SSQw, pcnt);
    xb_stage<3>(F, va, vb, X, XBw, SSQw, pcnt); xb_stage<4>(F, va, vb, X, XBw, SSQw, pcnt); xb_stage<5>(F, va, vb, X, XBw, SSQw, pcnt);
    xb_stage<6>(F, va, vb, X, XBw, SSQw, pcnt); xb_stage<7>(F, va, vb, X, XBw, SSQw, pcnt); xb_stage<8>(F, va, vb, X, XBw, SSQw, pcnt);
    if (F.tid == 0) { unsigned sp = 0u;
        while (xb_ld(pcnt) < (unsigned)(NGRP * GRP) || xb_ld(pcnt + 64 * myb) < (unsigned)((NGRP - myb) * GRP)) { __builtin_amdgcn_s_sleep(1); if (++sp > (1u << 22)) break; }
        __builtin_amdgcn_fence(__ATOMIC_ACQUIRE, "agent"); VM_WAIT(); }
    __syncthreads();
}
constexpr int CW_WCNT = 8192, N_CONVERTERS = NGRP * (GRP - 16);
template <bool WT> __device__ __forceinline__ void win_item(Frame& F, int L, int r, LAS float* scr) {
    const int kb = r / 80, nb = r % 80; int src, nv = 32;
    if (nb < 16) src = nb * 32; else if (nb < 32) src = 768 + (nb - 16) * 32; else if (nb < 36) src = 512 + (nb - 32) * 32; else if (nb < 40) src = 640 + (nb - 36) * 32;
    else if (nb < 72) src = nb * 32; else if (nb == 72) { src = 2304; nv = 8; } else { src = 0; nv = 0; }
    tr_item<WT>(FIN(I_WIN) + (size_t)L * D * D_IN, D_IN, src, nv, D, FIN(I_MIXG) + L * D, (GAS bf16*)FWS(WS_WIN) + (size_t)L * NPROJ * D, nb * 32, kb * 64, scr, F.lane);
}
__device__ __forceinline__ void convert_rest(Frame& F, int slot) {
    LAS float* scr = (LAS float*)(F.lds + RING_OFF + F.wave * 16384);
    constexpr int I_IN = 16 * 80, I_OUT = 16 * 32, I_UP = 16 * 128, I_DN = 64 * 32, NCW = N_CONVERTERS * NWAVES;
    const GAS float *w_out = FIN(I_WOUT), *w_up = FIN(I_WUP), *mlp_g = FIN(I_MLPG), *w_down = FIN(I_WDOWN);
    GAS bf16 *WOUT = (GAS bf16*)FWS(WS_WOUT), *WUP = (GAS bf16*)FWS(WS_WUP), *WDOWN = (GAS bf16*)FWS(WS_WDOWN);
    const int L = slot, n_items = I_OUT + I_UP + I_DN + (slot == 0 ? I_IN : 0);
    for (int it = (F.b * (GRP - 16) + (F.li - 16)) * NWAVES + F.wave; it < n_items; it += NCW) {
        int r = it;
        if (r < I_OUT) { const int kb = r / 32, nb = r % 32; tr_item(w_out + (size_t)L * D * D, D, nb * 32, 32, D, nullptr, WOUT + (size_t)L * D * D, nb * 32, kb * 64, scr, F.lane); continue; }
        r -= I_OUT;
        if (r < I_UP) { const int kb = r / 128, nb = r % 128; tr_item(w_up + (size_t)L * D * FF, FF, nb * 32, 32, D, mlp_g + L * D, WUP + (size_t)L * FF * D, nb * 32, kb * 64, scr, F.lane); continue; }
        r -= I_UP;
        if (r < I_DN) { const int kb = r / 32, nb = r % 32; tr_item(w_down + (size_t)L * FF * D, D, nb * 32, 32, FF, nullptr, WDOWN + (size_t)L * D * FF, nb * 32, kb * 64, scr, F.lane); continue; }
        r -= I_DN;
        win_item(F, 1, r, scr);
    }
    asm volatile("s_waitcnt vmcnt(0)" ::: "memory");
    __syncthreads();
    if (F.tid == 0) { __builtin_amdgcn_fence(__ATOMIC_RELEASE, "agent"); asm volatile("s_waitcnt vmcnt(0)" ::: "memory");
        (void)xb_add((unsigned*)(unsigned char*)FWS(WS_CTL) + CW_WCNT + 64 * slot, 1u); }
}
__device__ __forceinline__ void wait_weights(Frame& F, int part) {
    if (F.tid == 0) { unsigned* wc = (unsigned*)(unsigned char*)FWS(WS_CTL) + CW_WCNT + 64 * part; unsigned sp = 0u;
        while (xb_ld(wc) < (unsigned)N_CONVERTERS) { __builtin_amdgcn_s_sleep(2); if (++sp > (1u << 22)) break; }
        __builtin_amdgcn_fence(__ATOMIC_ACQUIRE, "agent"); asm volatile("s_waitcnt vmcnt(0)" ::: "memory"); }
    __syncthreads();
}
__device__ __forceinline__ void rstd_prepass(Frame& F, const pg8::GroupOrder& S, LAS float* tab) {
    const GAS float* SSQ = (const GAS float*)FWS(WS_SSQ) + (size_t)F.b * SEQ * 16;
    pg8::Unit u;
    for (int i = 0; i < 4 && S.next(i, u); ++i) {
        const int r = F.tid >> 1, h = F.tid & 1;
        const GAS f32x4* p = (const GAS f32x4*)(SSQ + (size_t)(u.pm * 256 + r) * 16 + h * 8);
        const f32x4 a = p[0], b = p[1];
        float s = (a.x + a.y) + (a.z + a.w) + (b.x + b.y) + (b.z + b.w);
        s += shx(s, 1, F.lane);
        if (h == 0) tab[i * 256 + r] = 1.0f / sqrtf(s * (1.0f / D) + EPS);
    }
    LDS_WAIT(); __syncthreads();
}
__device__ __forceinline__ int t5_bucket(int d) {
    if (d < 16) return d;
    return 16 + (d >= 19) + (d >= 21) + (d >= 24) + (d >= 27) + (d >= 31) + (d >= 35) + (d >= 40) + (d >= 46) + (d >= 52) + (d >= 59) + (d >= 67) + (d >= 77) + (d >= 87) + (d >= 99) + (d >= 113);
}
__device__ __forceinline__ void ld8(const GAS bf16* p, float (&v)[8]) {
    const v4u w = *(const GAS v4u*)p;
    v[0] = bflo(w.x); v[1] = bfhi(w.x); v[2] = bflo(w.y); v[3] = bfhi(w.y); v[4] = bflo(w.z); v[5] = bfhi(w.z); v[6] = bflo(w.w); v[7] = bfhi(w.w);
}
typedef short bf16x8_t __attribute__((ext_vector_type(8)));
typedef float f32x16 __attribute__((ext_vector_type(16)));
constexpr float LOG2E = 1.4426950408889634f;
__device__ __forceinline__ unsigned pkbf(float lo, float hi) { return pg8::cvt_pk_bf16(lo, hi); }
__device__ __forceinline__ int crow32(int i, int hh) { return (i & 3) + 8 * (i >> 2) + 4 * hh; }
__device__ __forceinline__ float silu_fast(float v) { return v * __builtin_amdgcn_rcpf(1.0f + __builtin_amdgcn_exp2f(-v * LOG2E)); }
__device__ __forceinline__ void unpk8(const v4u w, float (&v)[8]) {
    v[0] = bflo(w.x); v[1] = bfhi(w.x); v[2] = bflo(w.y); v[3] = bfhi(w.y); v[4] = bflo(w.z); v[5] = bfhi(w.z); v[6] = bflo(w.w); v[7] = bfhi(w.w);
}

typedef short v4i16_t __attribute__((ext_vector_type(4)));
template <int RH, int RSEC> __device__ __forceinline__ bf16x8_t tr_frag(const LAS unsigned char* img, int stride, int rbase, int cbase, int lane) {
    const LAS unsigned char* p = img + (rbase + RH * (lane >> 5) + ((lane & 15) >> 2)) * stride + (cbase + 16 * ((lane >> 4) & 1) + 4 * (lane & 3)) * 2;
    const v4i16_t a = __builtin_amdgcn_ds_read_tr16_b64_v4i16((LAS v4i16_t*)p), b = __builtin_amdgcn_ds_read_tr16_b64_v4i16((LAS v4i16_t*)(p + RSEC * stride));
    return (bf16x8_t){a[0], a[1], a[2], a[3], b[0], b[1], b[2], b[3]};
}
constexpr int AT_KS = 0, AT_KSTRIDE = 144, AT_VT = 36864, AT_VSTRIDE = 192, AT_BIAS = AT_VT + 256 * AT_VSTRIDE;
constexpr int AT_BN = 192, AT_END = AT_BIAS + 4 * AT_BN * 4;
static_assert(AT_END <= MIX_BYTES, "attention LDS");
__device__ __forceinline__ void attn_fast(Frame& F, int L, bool dummy = false) {
    GAS bf16* PROJ = (GAS bf16*)FB(BO_PROJ);
    const GAS float* qg = FIN(I_QG) + L * 64; const GAS float* kg = FIN(I_KG) + L * 64; const GAS float* sinks = FIN(I_SINK) + L * 8; const GAS float* rel_bias = FIN(I_RELB);
    LAS unsigned char* Ks = F.lds + AT_KS; LAS unsigned char* Vt = F.lds + AT_VT; LAS float* biasR = (LAS float*)(F.lds + AT_BIAS);
    const int tid = F.tid, lane = F.lane, wave = F.wave, q = lane & 31, hh = lane >> 5;
    const int unit = F.li, kvh = unit >> 4, qb = unit & 15, m0 = qb * 128;
    const int gi = wave >> 1, qh = wave & 1, hq = kvh * 4 + gi;
    v4u qraw[2][4];
#pragma unroll
    for (int s = 0; s < 2; ++s)
#pragma unroll
        for (int d0 = 0; d0 < 4; ++d0) qraw[s][d0] = *(const GAS v4u*)(PROJ + (size_t)(m0 + 64 * qh + 32 * s + q) * PP + CQ + hq * 64 + d0 * 16 + hh * 8);
    v4u kwv[4], vwv[4];
#pragma unroll
    for (int i = 0; i < 4; ++i) { const int c = tid + NTHREADS * i, key = c >> 3, part = c & 7; const bool valid = (qb > 0) || (key >= 128); const unsigned msk = valid ? 0xffffffffu : 0u;
        const GAS bf16* kp = PROJ + (size_t)(valid ? m0 + key - 128 : 0) * PP + CK + kvh * 64 + part * 8;
        v4u a_ = *(const GAS v4u*)kp, b_ = *(const GAS v4u*)(kp + (CV - CK));
        a_.x &= msk; a_.y &= msk; a_.z &= msk; a_.w &= msk; b_.x &= msk; b_.y &= msk; b_.z &= msk; b_.w &= msk; kwv[i] = a_; vwv[i] = b_; }
    const f32x4 kg0 = *(const GAS f32x4*)(kg + (tid & 7) * 8), kg1 = *(const GAS f32x4*)(kg + (tid & 7) * 8 + 4);
    f32x4 qgv[4][2];
#pragma unroll
    for (int d0 = 0; d0 < 4; ++d0) { qgv[d0][0] = *(const GAS f32x4*)(qg + d0 * 16 + hh * 8); qgv[d0][1] = *(const GAS f32x4*)(qg + d0 * 16 + hh * 8 + 4); }
    const float sinkv = sinks[hq];
    float bent[2];
#pragma unroll
    for (int k = 0; k < 2; ++k) { const int x = tid + NTHREADS * k, g_ = x / AT_BN, xx = x - g_ * AT_BN; const bool ok = (x < 4 * AT_BN) && (xx >= 32) && (xx < 160);
        const float v = rel_bias[t5_bucket(ok ? 159 - xx : 0) * 8 + kvh * 4 + (ok ? g_ : 0)]; bent[k] = ok ? v * LOG2E : 0.f; }
    __syncthreads();
    biasR[tid] = bent[0]; if (tid + NTHREADS < 4 * AT_BN) biasR[tid + NTHREADS] = bent[1];
#pragma unroll
    for (int i = 0; i < 4; ++i) {
        const int c = tid + NTHREADS * i, key = c >> 3, part = c & 7;
        const v4u kw = kwv[i], vw = vwv[i];
        float kv[8]; unpk8(kw, kv);
        float ss = 0.f;
#pragma unroll
        for (int e = 0; e < 8; ++e) ss += kv[e] * kv[e];
        ss += shx(ss, 1, lane); ss += shx(ss, 2, lane); ss += shx(ss, 4, lane);
        const float rk = __builtin_amdgcn_rsqf(ss * (1.0f / 64.0f) + EPS);
        const f32x4 g0 = kg0, g1 = kg1;
        v4u ko; ko.x = pkbf(kv[0] * rk * g0.x, kv[1] * rk * g0.y); ko.y = pkbf(kv[2] * rk * g0.z, kv[3] * rk * g0.w); ko.z = pkbf(kv[4] * rk * g1.x, kv[5] * rk * g1.y); ko.w = pkbf(kv[6] * rk * g1.z, kv[7] * rk * g1.w);
        *(LAS v4u*)(Ks + key * AT_KSTRIDE + part * 16) = ko;
        *(LAS v4u*)(Vt + key * AT_VSTRIDE + part * 16) = vw;
    }
    LDS_WAIT(); __syncthreads();
    const float sink2 = sinkv * LOG2E;
    const LAS float* bb = biasR + gi * AT_BN + 31 - q + 4 * hh;
    const int qm = q - 4 * hh;
#pragma unroll
    for (int s = 0; s < 2; ++s) {
        const int a = 64 * qh + 32 * s;
        GAS bf16* qrow = PROJ + (size_t)(m0 + a + q) * PP + CQ + hq * 64;
        float qv[4][8]; float ss = 0.f;
#pragma unroll
        for (int d0 = 0; d0 < 4; ++d0) { unpk8(qraw[s][d0], qv[d0]);
#pragma unroll
            for (int e = 0; e < 8; ++e) ss += qv[d0][e] * qv[d0][e]; }
        ss += shx(ss, 32, lane);
        const float rq = __builtin_amdgcn_rsqf(ss * (1.0f / 64.0f) + EPS) * (0.125f * LOG2E);
        bf16x8_t qf[4];
#pragma unroll
        for (int d0 = 0; d0 < 4; ++d0) { const f32x4 g0 = qgv[d0][0], g1 = qgv[d0][1];
            v4u w; w.x = pkbf(qv[d0][0] * rq * g0.x, qv[d0][1] * rq * g0.y); w.y = pkbf(qv[d0][2] * rq * g0.z, qv[d0][3] * rq * g0.w);
            w.z = pkbf(qv[d0][4] * rq * g1.x, qv[d0][5] * rq * g1.y); w.w = pkbf(qv[d0][6] * rq * g1.z, qv[d0][7] * rq * g1.w);
            qf[d0] = __builtin_bit_cast(bf16x8_t, w); }
        const int kt_lo = (qb == 0) ? 4 - (a >> 5) : 0;
        f32x16 S[5]; float mx = sink2;
#pragma unroll
        for (int kt = 0; kt < 5; ++kt) { f32x16 acc = {};
#pragma unroll
            for (int d0 = 0; d0 < 4; ++d0) { const bf16x8_t kf = *(const LAS bf16x8_t*)(Ks + (a + 32 * kt + q) * AT_KSTRIDE + d0 * 32 + hh * 16);
                acc = __builtin_amdgcn_mfma_f32_32x32x16_bf16(kf, qf[d0], acc, 0, 0, 0); }
            if (kt < kt_lo) {
#pragma unroll
                for (int i = 0; i < 16; ++i) acc[i] = -INFINITY;
            } else {
#pragma unroll
                for (int i = 0; i < 16; ++i) { const int t0 = (i & 3) + 8 * (i >> 2); float v = acc[i] + bb[32 * kt + t0];
                    if (kt == 0) v = fminf(v, (t0 > qm) ? INFINITY : -INFINITY);
                    if (kt == 4) v = fminf(v, (t0 <= qm) ? INFINITY : -INFINITY);
                    acc[i] = v; mx = fmaxf(mx, v); } }
            S[kt] = acc; }
        mx = fmaxf(mx, shx(mx, 32, lane));
        float lsum = 0.f; bf16x8_t pf[5][2];
#pragma unroll
        for (int kt = 0; kt < 5; ++kt) {
#pragma unroll
            for (int i = 0; i < 16; ++i) { const float p = __builtin_amdgcn_exp2f(S[kt][i] - mx); S[kt][i] = p; lsum += p; }
#pragma unroll
            for (int s2 = 0; s2 < 2; ++s2) { v4u w; w.x = pkbf(S[kt][8 * s2 + 0], S[kt][8 * s2 + 1]); w.y = pkbf(S[kt][8 * s2 + 2], S[kt][8 * s2 + 3]);
                w.z = pkbf(S[kt][8 * s2 + 4], S[kt][8 * s2 + 5]); w.w = pkbf(S[kt][8 * s2 + 6], S[kt][8 * s2 + 7]); pf[kt][s2] = __builtin_bit_cast(bf16x8_t, w); } }
        lsum += shx(lsum, 32, lane);
        lsum += __builtin_amdgcn_exp2f(sink2 - mx);
        f32x16 O[2] = {{}, {}};
#pragma unroll
        for (int kt = 0; kt < 5; ++kt)
#pragma unroll
            for (int s2 = 0; s2 < 2; ++s2)
#pragma unroll
                for (int db = 0; db < 2; ++db)
                    O[db] = __builtin_amdgcn_mfma_f32_32x32x16_bf16(tr_frag<4, 8>(Vt, AT_VSTRIDE, a + 32 * kt + 16 * s2, 32 * db, lane), pf[kt][s2], O[db], 0, 0, 0);
        const float inv = __builtin_amdgcn_rcpf(lsum);
#pragma unroll
        for (int db = 0; db < 2; ++db)
#pragma unroll
            for (int g4 = 0; g4 < 4; ++g4) { v2u w; w.x = pkbf(O[db][4 * g4] * inv, O[db][4 * g4 + 1] * inv); w.y = pkbf(O[db][4 * g4 + 2] * inv, O[db][4 * g4 + 3] * inv);
                GAS bf16* orow = dummy ? (GAS bf16*)FB(BO_PREV) + (size_t)(m0 + a + q) * 512 + hq * 64 : qrow;
                *(GAS v2u*)(orow + 32 * db + 8 * g4 + 4 * hh) = w; }
    }
}

constexpr size_t WS_DTV = 3 * MiB + 512 * 1024;
constexpr int SD_ROW = 272, SD_XT = 264;
template <int NR> struct Raw8 { v4u u[NR + 3]; };
template <int NR> struct Raw4 { v2u u[NR + 3]; };
struct ConvW8 { f32x4 w[4][2], b[2]; };
struct ConvW4 { f32x4 w[4], b; };
template <int NR> __device__ __forceinline__ void conv_load(Raw8<NR>& R, const GAS bf16* PROJ, int m0, int c, int l0, int col0) {
#pragma unroll
    for (int i = 0; i < NR + 3; ++i) { const int row = l0 - 3 + i; const bool ok = (c > 0) || (row >= 0); const unsigned msk = ok ? 0xffffffffu : 0u;
        v4u x = *(const GAS v4u*)(PROJ + (size_t)(m0 + (ok ? row : 0)) * PP + col0); x.x &= msk; x.y &= msk; x.z &= msk; x.w &= msk; R.u[i] = x; }
}
template <int NR> __device__ __forceinline__ void conv_load(Raw4<NR>& R, const GAS bf16* PROJ, int m0, int c, int l0, int col0) {
#pragma unroll
    for (int i = 0; i < NR + 3; ++i) { const int row = l0 - 3 + i; const bool ok = (c > 0) || (row >= 0); const unsigned msk = ok ? 0xffffffffu : 0u;
        v2u x = *(const GAS v2u*)(PROJ + (size_t)(m0 + (ok ? row : 0)) * PP + col0); x.x &= msk; x.y &= msk; R.u[i] = x; }
}
__device__ __forceinline__ void convw_load(ConvW8& W, const GAS float* cw, const GAS float* cb) {
#pragma unroll
    for (int k = 0; k < 4; ++k) { W.w[k][0] = *(const GAS f32x4*)(cw + k * 1024); W.w[k][1] = *(const GAS f32x4*)(cw + k * 1024 + 4); }
    W.b[0] = *(const GAS f32x4*)cb; W.b[1] = *(const GAS f32x4*)(cb + 4);
}
__device__ __forceinline__ void convw_load(ConvW4& W, const GAS float* cw, const GAS float* cb) {
#pragma unroll
    for (int k = 0; k < 4; ++k) W.w[k] = *(const GAS f32x4*)(cw + k * 1024);
    W.b = *(const GAS f32x4*)cb;
}
template <int NR> __device__ __forceinline__ void conv_row(const Raw8<NR>& R, const ConvW8& W, int r, float (&out)[8]) {
    float acc[8];
#pragma unroll
    for (int e = 0; e < 8; ++e) acc[e] = W.b[e >> 2][e & 3];
#pragma unroll
    for (int k = 0; k < 4; ++k) { float u[8]; unpk8(R.u[r + k], u);
#pragma unroll
        for (int e = 0; e < 8; ++e) acc[e] += W.w[k][e >> 2][e & 3] * u[e]; }
#pragma unroll
    for (int e = 0; e < 8; ++e) out[e] = silu_fast(acc[e]);
}
template <int NR> __device__ __forceinline__ void conv_row(const Raw4<NR>& R, const ConvW4& W, int r, float (&out)[4]) {
    float acc[4];
#pragma unroll
    for (int e = 0; e < 4; ++e) acc[e] = W.b[e];
#pragma unroll
    for (int k = 0; k < 4; ++k) { const v2u x = R.u[r + k]; const float u[4] = {bflo(x.x), bfhi(x.x), bflo(x.y), bfhi(x.y)};
#pragma unroll
        for (int e = 0; e < 4; ++e) acc[e] += W.w[k][e] * u[e]; }
#pragma unroll
    for (int e = 0; e < 4; ++e) out[e] = silu_fast(acc[e]);
}
constexpr int P_XSTR = 576, P_BSTR = 304, P_XD = 0, P_BM = P_XD + 128 * P_XSTR, P_CM = P_BM + 128 * P_BSTR, P_FREE = P_CM + 128 * SD_ROW, P_DT = MIX_BYTES - 4096, P_ACS = P_DT + 2048;
static_assert(P_FREE + 4096 <= P_DT, "SSD LDS map");
__device__ __forceinline__ bf16x8_t scale_frag(bf16x8_t f, const f32x4 s0, const f32x4 s1) {
    const v4u w = __builtin_bit_cast(v4u, f); v4u o;
    o.x = pkbf(bflo(w.x) * s0.x, bfhi(w.x) * s0.y); o.y = pkbf(bflo(w.y) * s0.z, bfhi(w.y) * s0.w); o.z = pkbf(bflo(w.z) * s1.x, bfhi(w.z) * s1.y); o.w = pkbf(bflo(w.w) * s1.z, bfhi(w.w) * s1.w);
    return __builtin_bit_cast(bf16x8_t, o);
}
constexpr int S1_W = P_FREE, S1_WT = S1_W + 2048;
__device__ __forceinline__ void ssd_states(Frame& F, int L) {
    const GAS bf16* PROJ = (const GAS bf16*)FB(BO_PROJ);
    const GAS float* conv_w = FIN(I_CONVW) + (size_t)L * 4 * 1024; const GAS float* conv_b = FIN(I_CONVB) + L * 1024;
    const GAS float* dt_bias = FIN(I_DTB) + L * 8; const GAS float* a_log = FIN(I_ALOG) + L * 8;
    const GAS float* DTRAW = (const GAS float*)FWS(WS_DTRAW) + (size_t)F.b * SEQ * 8; GAS float* CHDEC = (GAS float*)FWS(WS_CHDEC) + F.b * 128;
    GAS bf16* STATES = (GAS bf16*)FB(BO_STATES);
    LAS unsigned char* XD = F.lds + P_XD; LAS unsigned char* BM = F.lds + P_BM;
    LAS float* dt_l = (LAS float*)(F.lds + P_DT); LAS float* acs_l = (LAS float*)(F.lds + P_ACS); LAS float* w_l = (LAS float*)(F.lds + S1_W); LAS float* wt = (LAS float*)(F.lds + S1_WT);
    const int wave = F.wave, unit = F.li, c = unit >> 1, g = unit & 1, m0 = c * 128;
    int tid = F.tid; asm volatile("" : "+v"(tid));
    int lane = tid & 63, q = lane & 31, hh = lane >> 5;
    const int xcg = tid & 31, xl0 = (tid >> 5) * 8, xcol = CX + g * 256 + xcg * 8;
    const int bcg = tid & 31, bl0 = (tid >> 5) * 8, isC = bcg >> 4, bn0 = (bcg & 15) * 8, bcol = (isC ? CCM : CBM) + g * 128 + bn0;
    Raw8<8> xr; ConvW8 xw; Raw8<8> br; ConvW8 bw;
    conv_load(xr, PROJ, m0, c, xl0, xcol); convw_load(xw, conv_w + (xcol - CX), conv_b + (xcol - CX));
    conv_load(br, PROJ, m0, c, bl0, bcol); convw_load(bw, conv_w + (bcol - CX), conv_b + (bcol - CX));
    const int ar = tid >> 7, al = tid & 127, ahead = 4 * g + ar;
    const float dtraw = DTRAW[(size_t)(m0 + al) * 8 + ahead], dtb = dt_bias[ahead], alog = a_log[ahead];
    __syncthreads();
    float acs_v;
    { const float dtv = softplus_f(dtraw + dtb);
      float v = dtv * (-expf(alog));
#pragma unroll
      for (int o = 1; o < 64; o <<= 1) { const float t = shup(v, o, lane); if (lane >= o) v += t; }
      if (lane == 63) wt[wave] = v;
      LDS_WAIT(); __syncthreads();
      if (wave & 1) v += wt[wave - 1];
      dt_l[tid] = dtv; acs_l[tid] = v * LOG2E; acs_v = v * LOG2E;
      if (al == 127) CHDEC[c * 8 + ahead] = expf(v); }
#pragma unroll
    for (int r = 0; r < 8; ++r) { float o[8]; conv_row(br, bw, r, o);
        v4u pk; pk.x = pkbf(o[0], o[1]); pk.y = pkbf(o[2], o[3]); pk.z = pkbf(o[4], o[5]); pk.w = pkbf(o[6], o[7]);
        *(LAS v4u*)(isC ? F.lds + P_CM + (bl0 + r) * SD_ROW + bn0 * 2 : BM + (bl0 + r) * P_BSTR + bn0 * 2) = pk; }
    LDS_WAIT(); __syncthreads();
    w_l[tid] = __builtin_amdgcn_exp2f(acs_l[ar * 128 + 127] - acs_v);
    { const int r4 = xcg >> 3;
#pragma unroll
      for (int r = 0; r < 8; ++r) { float o[8]; conv_row(xr, xw, r, o); const int l = xl0 + r; const float sc = dt_l[r4 * 128 + l];
          v4u pk; pk.x = pkbf(o[0] * sc, o[1] * sc); pk.y = pkbf(o[2] * sc, o[3] * sc); pk.z = pkbf(o[4] * sc, o[5] * sc); pk.w = pkbf(o[6] * sc, o[7] * sc);
          *(LAS v4u*)(XD + l * P_XSTR + xcg * 16) = pk; } }
    LDS_WAIT(); __syncthreads();
    asm volatile("" : "+v"(tid)); lane = tid & 63; q = lane & 31; hh = lane >> 5;
    { const int r4 = wave >> 1, nt0 = (wave & 1) * 2, head = 4 * g + r4;
      f32x16 St[2][2] = {{{}, {}}, {{}, {}}};
#pragma unroll
      for (int ks = 0; ks < 8; ++ks) { bf16x8_t af[2], bfr[2];
          const f32x4 w0 = *(const LAS f32x4*)(w_l + r4 * 128 + 16 * ks + 8 * hh), w1 = *(const LAS f32x4*)(w_l + r4 * 128 + 16 * ks + 8 * hh + 4);
#pragma unroll
          for (int pt = 0; pt < 2; ++pt) af[pt] = tr_frag<8, 4>(XD, P_XSTR, 16 * ks, r4 * 64 + 32 * pt, lane);
#pragma unroll
          for (int nn = 0; nn < 2; ++nn) bfr[nn] = scale_frag(tr_frag<8, 4>(BM, P_BSTR, 16 * ks, 32 * (nt0 + nn), lane), w0, w1);
#pragma unroll
          for (int pt = 0; pt < 2; ++pt)
#pragma unroll
              for (int nn = 0; nn < 2; ++nn) St[pt][nn] = __builtin_amdgcn_mfma_f32_32x32x16_bf16(af[pt], bfr[nn], St[pt][nn], 0, 0, 0); }
      GAS bf16* sp = STATES + ((size_t)c * 8 + head) * 8192 + 32 * nt0 + q;
#pragma unroll
      for (int pt = 0; pt < 2; ++pt)
#pragma unroll
          for (int nn = 0; nn < 2; ++nn)
#pragma unroll
              for (int e = 0; e < 16; e += 2) { const unsigned w = pkbf(St[pt][nn][e], St[pt][nn][e + 1]);
                  sp[(32 * pt + crow32(e, hh)) * 128 + 32 * nn] = (bf16)(w & 0xffffu); sp[(32 * pt + crow32(e + 1, hh)) * 128 + 32 * nn] = (bf16)(w >> 16); } }
}
__device__ __forceinline__ void ssd_scan(Frame& F, int L) {
    const GAS bf16* STATES = (const GAS bf16*)FB(BO_STATES); const GAS float* CHDEC = (const GAS float*)FWS(WS_CHDEC) + F.b * 128; GAS bf16* PREV = (GAS bf16*)FB(BO_PREV);
    for (int idx = F.li * NTHREADS + F.tid; idx < 8 * 64 * 32; idx += GRP * NTHREADS) {
        const int n4 = idx & 31, p = (idx >> 5) & 63, head = idx >> 11;
        v2u s[16]; float dec[16];
#pragma unroll
        for (int c = 0; c < 16; ++c) { const size_t o = ((size_t)c * 8 + head) * 8192 + p * 128 + 4 * n4; s[c] = *(const GAS v2u*)(STATES + o); dec[c] = CHDEC[c * 8 + head]; }
        f32x4 h = {0.f, 0.f, 0.f, 0.f};
#pragma unroll
        for (int c = 0; c < 16; ++c) { const size_t o = ((size_t)c * 8 + head) * 8192 + p * 128 + 4 * n4;
            v2u w; w.x = pkbf(h.x, h.y); w.y = pkbf(h.z, h.w); *(GAS v2u*)(PREV + o) = w;
            const f32x4 sv = {bflo(s[c].x), bfhi(s[c].x), bflo(s[c].y), bfhi(s[c].y)};
            h = h * dec[c] + sv; }
    }
}
constexpr int S3_PV = P_BM, S3_PVH = 64 * SD_ROW, S3_Z = S3_PV + 2 * S3_PVH, S3_NG = P_FREE, S3_RSS = S3_NG + 1024;
static_assert(S3_Z + 128 * SD_ROW <= P_FREE && S3_RSS + 2048 <= P_DT && 128 * 528 <= P_DT, "SSD part 3 LDS");
__device__ __forceinline__ void ssd_out(Frame& F, int L, bool dummy = false) {
    GAS bf16* PROJ = (GAS bf16*)FB(BO_PROJ); const GAS bf16* PREV = (const GAS bf16*)FB(BO_PREV);
    const GAS float* d_skip = FIN(I_DSKIP) + L * 8; const GAS float* ssm_g = FIN(I_SSMG) + L * 512;
    LAS unsigned char* Cm = F.lds + P_CM; LAS unsigned char* Bm = F.lds + P_BM; LAS unsigned char* Zt = F.lds + S3_Z; const LAS unsigned char* XD = F.lds + P_XD;
    LAS float* dt_l = (LAS float*)(F.lds + P_DT); LAS float* acs_l = (LAS float*)(F.lds + P_ACS); LAS float* rss = (LAS float*)(F.lds + S3_RSS); LAS float* ng_l = (LAS float*)(F.lds + S3_NG);
    const int wave = F.wave, unit = F.li, c = unit >> 1, g = unit & 1, m0 = c * 128;
    int tid = F.tid; asm volatile("" : "+v"(tid));
    int lane = tid & 63, q = lane & 31, hh = lane >> 5;
    const float ng_in = ssm_g[g * 256 + (tid & 255)];
    v4u pw[4], zw[4];
#define S3_D1_LOAD_PZ(hp_) do { \
        _Pragma("unroll") for (int k = 0; k < 4; ++k) { const int ch = tid + NTHREADS * k; \
            { const int hd = ch >> 10, rem = ch & 1023, p = rem >> 4, n8 = rem & 15; pw[k] = *(const GAS v4u*)(PREV + ((size_t)c * 8 + 4 * g + 2 * (hp_) + hd) * 8192 + p * 128 + n8 * 8); } \
            { const int l = ch >> 4, c8 = ch & 15; zw[k] = *(const GAS v4u*)(PROJ + (size_t)(m0 + l) * PP + CZ + (4 * g + 2 * (hp_)) * 64 + c8 * 8); } } } while (0)
    S3_D1_LOAD_PZ(0);
    if (tid < 256) ng_l[tid] = ng_in;
    const int j = (wave < 4) ? (wave & 3) : 3 - (wave & 3), h2 = wave >> 2;
    f32x16 cbT[4]; bf16x8_t cf[8];
#pragma unroll
    for (int ks = 0; ks < 8; ++ks) cf[ks] = *(const LAS bf16x8_t*)(Cm + (32 * j + q) * SD_ROW + (16 * ks + 8 * hh) * 2);
#pragma unroll
    for (int i = 0; i < 4; ++i) { f32x16 acc = {};
        if (i <= j) {
#pragma unroll
            for (int ks = 0; ks < 8; ++ks) { const bf16x8_t bfr = *(const LAS bf16x8_t*)(Bm + (32 * i + q) * P_BSTR + (16 * ks + 8 * hh) * 2);
                acc = __builtin_amdgcn_mfma_f32_32x32x16_bf16(bfr, cf[ks], acc, 0, 0, 0); } }
        cbT[i] = acc; }
    unsigned vk[2][16];
#pragma unroll
    for (int hp = 0; hp < 2; ++hp) {
        __syncthreads();
        {
#pragma unroll
          for (int k = 0; k < 4; ++k) { const int ch = tid + NTHREADS * k;
              { const int hd = ch >> 10, rem = ch & 1023, p = rem >> 4, n8 = rem & 15; *(LAS v4u*)(F.lds + S3_PV + hd * S3_PVH + p * SD_ROW + n8 * 16) = pw[k]; }
              { const int l = ch >> 4, c8 = ch & 15; *(LAS v4u*)(Zt + l * SD_ROW + c8 * 16) = zw[k]; } } }
        LDS_WAIT(); __syncthreads();
        asm volatile("" : "+v"(tid)); lane = tid & 63; q = lane & 31; hh = lane >> 5;
        const int r = 2 * hp + h2, head = 4 * g + r;
        const LAS unsigned char* P1 = F.lds + S3_PV + h2 * S3_PVH;
        f32x16 O[2] = {{}, {}};
#pragma unroll
        for (int ks = 0; ks < 8; ++ks)
#pragma unroll
            for (int pt = 0; pt < 2; ++pt) { const bf16x8_t af = *(const LAS bf16x8_t*)(P1 + (32 * pt + q) * SD_ROW + (16 * ks + 8 * hh) * 2);
                O[pt] = __builtin_amdgcn_mfma_f32_32x32x16_bf16(af, cf[ks], O[pt], 0, 0, 0); }
        const float acl = acs_l[r * 128 + 32 * j + q], diag = d_skip[head] * __builtin_amdgcn_rcpf(dt_l[r * 128 + 32 * j + q]);
        { const float ea = __builtin_amdgcn_exp2f(acl);
#pragma unroll
          for (int pt = 0; pt < 2; ++pt)
#pragma unroll
              for (int e = 0; e < 16; ++e) O[pt][e] *= ea; }
        const int qm = q - 4 * hh;
#pragma unroll
        for (int i = 0; i < 4; ++i) { if (i <= j) {
            float xv[16];
            const LAS float* ap = acs_l + r * 128 + 32 * i + 4 * hh;
            float av[16];
#pragma unroll
            for (int e = 0; e < 16; ++e) av[e] = ap[(e & 3) + 8 * (e >> 2)];
            if (i < j) {
#pragma unroll
                for (int e = 0; e < 16; ++e) xv[e] = cbT[i][e] * __builtin_amdgcn_exp2f(acl - av[e]);
            } else {
#pragma unroll
                for (int e = 0; e < 16; ++e) { const int t0 = (e & 3) + 8 * (e >> 2);
                    const float m01 = (t0 <= qm) ? 1.0f : 0.0f, dg = (t0 == qm) ? diag : 0.0f;
                    xv[e] = cbT[i][e] * __builtin_amdgcn_exp2f(fminf(acl - av[e], 0.f)) * m01 + dg; } }
#pragma unroll
            for (int s2 = 0; s2 < 2; ++s2) { v4u w; w.x = pkbf(xv[8 * s2 + 0], xv[8 * s2 + 1]); w.y = pkbf(xv[8 * s2 + 2], xv[8 * s2 + 3]); w.z = pkbf(xv[8 * s2 + 4], xv[8 * s2 + 5]); w.w = pkbf(xv[8 * s2 + 6], xv[8 * s2 + 7]);
                const bf16x8_t xf = __builtin_bit_cast(bf16x8_t, w);
#pragma unroll
                for (int pt = 0; pt < 2; ++pt)
                    O[pt] = __builtin_amdgcn_mfma_f32_32x32x16_bf16(tr_frag<4, 8>(XD, P_XSTR, 32 * i + 16 * s2, 64 * r + 32 * pt, lane), xf, O[pt], 0, 0, 0); } } }
        if (hp == 0) S3_D1_LOAD_PZ(1);
        float ss = 0.f;
#pragma unroll
        for (int pt = 0; pt < 2; ++pt)
#pragma unroll
            for (int g4 = 0; g4 < 4; ++g4) { const int p = 32 * pt + 8 * g4 + 4 * hh;
                const v2u zz = *(const LAS v2u*)(Zt + (32 * j + q) * SD_ROW + (64 * h2 + p) * 2);
                const float u0 = O[pt][4 * g4] * silu_fast(bflo(zz.x)), u1 = O[pt][4 * g4 + 1] * silu_fast(bfhi(zz.x)), u2 = O[pt][4 * g4 + 2] * silu_fast(bflo(zz.y)), u3 = O[pt][4 * g4 + 3] * silu_fast(bfhi(zz.y));
                ss += (u0 * u0 + u1 * u1) + (u2 * u2 + u3 * u3);
                vk[hp][pt * 8 + g4 * 2] = pkbf(u0, u1); vk[hp][pt * 8 + g4 * 2 + 1] = pkbf(u2, u3); }
        ss += shx(ss, 32, lane);
        if (hh == 0) rss[r * 128 + 32 * j + q] = ss;
    }
#undef S3_D1_LOAD_PZ
    LDS_WAIT(); __syncthreads();
    asm volatile("" : "+v"(tid)); lane = tid & 63; q = lane & 31; hh = lane >> 5;
    { const int l = 32 * j + q; const float tot = (rss[l] + rss[128 + l]) + (rss[256 + l] + rss[384 + l]);
      const float rn = __builtin_amdgcn_rsqf(tot * (1.0f / 256.0f) + EPS);
      LAS unsigned char* Ot = F.lds;
#pragma unroll
      for (int hp = 0; hp < 2; ++hp) { const int r = 2 * hp + h2;
#pragma unroll
          for (int pt = 0; pt < 2; ++pt)
#pragma unroll
              for (int g4 = 0; g4 < 4; ++g4) { const int p = 32 * pt + 8 * g4 + 4 * hh;
                  const f32x4 ng = *(const LAS f32x4*)(ng_l + r * 64 + p);
                  const unsigned w0 = vk[hp][pt * 8 + g4 * 2], w1 = vk[hp][pt * 8 + g4 * 2 + 1];
                  v2u w; w.x = pkbf(bflo(w0) * rn * ng.x, bfhi(w0) * rn * ng.y); w.y = pkbf(bflo(w1) * rn * ng.z, bfhi(w1) * rn * ng.w);
                  *(LAS v2u*)(Ot + l * 528 + (r * 64 + p) * 2) = w; } } }
    LDS_WAIT(); __syncthreads();
    asm volatile("" : "+v"(tid));
#pragma unroll
    for (int k = 0; k < 8; ++k) { const int ch = tid + NTHREADS * k, l = ch >> 5, c8 = ch & 31;
        const v4u w = *(const LAS v4u*)(F.lds + l * 528 + c8 * 16);
        GAS bf16* orow = dummy ? (GAS bf16*)FB(BO_STATES) + (size_t)(m0 + l) * 512 : PROJ + (size_t)(m0 + l) * PP + CZ;
        *(GAS v4u*)(orow + g * 256 + c8 * 8) = w; }
}

__device__ __forceinline__ void ph_inproj(Frame& F, int L) {
    LAS float* rstd_tab = (LAS float*)(F.lds + RSTD_OFF);
    int li_ = F.li; asm volatile("" : "+s"(li_)); pg8::GroupOrder S; S.init(NPROJ, li_);
    const GAS f32x4* sp = (const GAS f32x4*)((const GAS float*)FWS(WS_SSQ) + ((size_t)F.b * SEQ + (li_ & 7) * 256 + (F.tid >> 1)) * 16 + (F.tid & 1) * 8);
    pg8::Gemm g{(const GAS bf16*)FWS(WS_XB) + (size_t)F.b * SEQ * D, (const GAS bf16*)FWS(WS_WIN) + (size_t)L * NPROJ * D, SEQ, NPROJ, D, D};
    pg8::EpiProj E{(GAS bf16*)FB(BO_PROJ), (GAS float*)FWS(WS_DTRAW) + (size_t)F.b * SEQ * 8, rstd_tab, sp[0], sp[1]};
    pg8::gemm_phase<pg8::EpiProj, pg8::GroupOrder, true, true>(F.lds + RING_OFF, g, S, E);
}
__device__ __forceinline__ void ph_outproj(Frame& F, int L, bool dummy = false) {
    int li_ = F.li; asm volatile("" : "+s"(li_)); pg8::GroupOrder S; S.init(D, li_);
    pg8::Gemm g{(const GAS bf16*)FB(BO_PROJ), (const GAS bf16*)FWS(WS_WOUT) + (size_t)L * D * D, SEQ, D, D, PP};
    GAS bf16* XBb = (GAS bf16*)FWS(WS_XB) + (size_t)F.b * SEQ * D;
    pg8::EpiRes<false> E{XBb, (GAS float*)FWS(WS_SSQ) + (size_t)F.b * SEQ * 16, nullptr, dummy ? (GAS bf16*)FB(BO_YPART) : XBb};
    pg8::gemm_phase<pg8::EpiRes<false>, pg8::GroupOrder, false, true>(F.lds + RING_OFF, g, S, E);
}
__device__ __forceinline__ void ph_up(Frame& F, int L, int hot = 0) {
    LAS float* rstd_tab = (LAS float*)(F.lds + RSTD_OFF);
    int li_ = F.li; asm volatile("" : "+s"(li_)); pg8::GroupOrder S; S.init(FF, li_); S.hot = hot;
    const GAS f32x4* sp = (const GAS f32x4*)((const GAS float*)FWS(WS_SSQ) + ((size_t)F.b * SEQ + (li_ & 7) * 256 + (F.tid >> 1)) * 16 + (F.tid & 1) * 8);
    pg8::Gemm g{(const GAS bf16*)FWS(WS_XB) + (size_t)F.b * SEQ * D, (const GAS bf16*)FWS(WS_WUP) + (size_t)L * FF * D, SEQ, FF, D, D};
    pg8::EpiUp E{(GAS bf16*)FB(BO_HID), HIDP, rstd_tab, sp[0], sp[1]};
    pg8::gemm_phase<pg8::EpiUp, pg8::GroupOrder, true, true>(F.lds + RING_OFF, g, S, E);
}
__device__ __forceinline__ void ph_down(Frame& F, int L, bool dummy = false, int hot = 0) {
    int li_ = F.li; asm volatile("" : "+s"(li_)); pg8::GroupOrder S; S.init(D, li_); S.hot = hot;
    pg8::Gemm g{(const GAS bf16*)FB(BO_HID), (const GAS bf16*)FWS(WS_WDOWN) + (size_t)L * D * FF, SEQ, D, FF, HIDP};
    GAS bf16* XBb = (GAS bf16*)FWS(WS_XB) + (size_t)F.b * SEQ * D; GAS float* SSQb = (GAS float*)FWS(WS_SSQ) + (size_t)F.b * SEQ * 16;
    if (L == DEPTH - 1 && !dummy) { pg8::EpiRes<true> E{XBb, SSQb, (GAS float*)ptr_at(F, I_OUT) + (size_t)F.b * SEQ * D, XBb};
        pg8::gemm_phase<pg8::EpiRes<true>, pg8::GroupOrder, false, true>(F.lds + RING_OFF, g, S, E); }
    else { pg8::EpiRes<false> E{XBb, SSQb, nullptr, dummy ? (GAS bf16*)FB(16 * MiB) : XBb};
        pg8::gemm_phase<pg8::EpiRes<false>, pg8::GroupOrder, false, true>(F.lds + RING_OFF, g, S, E); }
}

#ifndef PROBE_REP
#define PROBE_REP 0
#endif
struct Args { const float* in[17]; float* out; unsigned char* ws; int pad0, pad1; };
__global__ void __launch_bounds__(NTHREADS, 2) fwd(Args args) {
    extern __shared__ __attribute__((aligned(16))) unsigned char lds[];
    Frame F;
    F.lds = (LAS unsigned char*)lds;
    F.tid = threadIdx.x; F.lane = F.tid & 63; F.wave = __builtin_amdgcn_readfirstlane(F.tid >> 6); F.bid = blockIdx.x; F.G = gridDim.x; F.b = F.bid & 7; F.li = F.bid >> 3;
    for (int u = F.tid; u < (LDS_BYTES - LDSCTL_OFF) / 4; u += NTHREADS) ((LAS unsigned*)(F.lds + LDSCTL_OFF))[u] = 0u;
    __syncthreads();
    if (F.tid < I_NPTR) { const unsigned long long p = F.tid < 17 ? (unsigned long long)args.in[F.tid < 17 ? F.tid : 0] : (F.tid == I_OUT ? (unsigned long long)args.out : (unsigned long long)args.ws);
        LAS unsigned* t = (LAS unsigned*)(F.lds + PTR_OFF) + 2 * F.tid; t[0] = (unsigned)p; t[1] = (unsigned)(p >> 32); }
    LDS_WAIT(); __syncthreads();
    if (F.G != GRID) return;
#define GBAR_OBJ() XcdBarrier{(unsigned*)(unsigned char*)FWS(WS_CTL) + CW_BAR, xb_xcc_id(), (unsigned)GRID, (volatile LAS unsigned*)(F.lds + MISC_OFF) + 8}
#define GRP_OBJ()  XcdBarrier{(unsigned*)(unsigned char*)FWS(WS_CTL) + CW_GRP + (blockIdx.x & 7) * GRP_BAR_STRIDE, xb_xcc_id(), (unsigned)GRP, (volatile LAS unsigned*)(F.lds + MISC_OFF) + 12}
    (void)xcd_barrier_post((unsigned*)(unsigned char*)FWS(WS_CTL) + CW_GRP + (blockIdx.x & 7) * GRP_BAR_STRIDE, (volatile LAS unsigned*)(F.lds + MISC_OFF) + 12, GRP);
#define RELAUNDER() do { int t_ = threadIdx.x; asm volatile("" : "+v"(t_)); F.tid = t_; F.lane = t_ & 63; F.wave = __builtin_amdgcn_readfirstlane(t_ >> 6); \
    int b_ = blockIdx.x; asm volatile("" : "+s"(b_)); F.bid = b_; F.b = b_ & 7; F.li = b_ >> 3; } while (0)
#define GRP_BAR() do { const XcdBarrier gb_ = GRP_OBJ(); xcd_barrier(gb_); } while (0)
#define GRID_BAR() do { const XcdBarrier gb_ = GBAR_OBJ(); xcd_barrier(gb_); } while (0)

    if (PROBE_REP == 95 && threadIdx.x == 0) *(volatile LAS unsigned*)(F.lds + 161288) = (unsigned)__builtin_amdgcn_s_memrealtime();
    p0_prologue(F);
#ifdef STAGGER_TICKS
    { const unsigned long long t0 = __builtin_amdgcn_s_memrealtime(); const int g_ = blockIdx.x & 7; const unsigned long long w = (unsigned long long)(STAGGER_TICKS);
      while (__builtin_amdgcn_s_memrealtime() - t0 < w) __builtin_amdgcn_s_sleep(2); }
#endif
    if (PROBE_REP == 95 && threadIdx.x == 0) *(volatile LAS unsigned*)(F.lds + 161280) = (unsigned)__builtin_amdgcn_s_memrealtime() - *(volatile LAS unsigned*)(F.lds + 161288);
    for (int L = 0; L < DEPTH; ++L) {
        RELAUNDER(); ph_inproj(F, L); if (PROBE_REP == 2) { GRP_BAR(); RELAUNDER(); ph_inproj(F, L); }
        if (F.li >= 16) { RELAUNDER(); convert_rest(F, L); }
        GRP_BAR();
        RELAUNDER(); if (PROBE_REP == 20) { attn_fast(F, L, true); GRP_BAR(); RELAUNDER(); }
        if (PROBE_REP == 25) {
#pragma unroll 1
            for (int rep = 0; rep < 2; ++rep) { attn_fast(F, L, rep == 0); if (rep == 0) { GRP_BAR(); RELAUNDER(); } } }
        else attn_fast(F, L);
        ssd_states(F, L); if (PROBE_REP == 21) { GRP_BAR(); RELAUNDER(); ssd_states(F, L); } GRP_BAR();
        RELAUNDER(); ssd_scan(F, L); if (PROBE_REP == 22) { GRP_BAR(); RELAUNDER(); ssd_scan(F, L); } if (PROBE_REP == 24) { for (int k = 0; k < 8; ++k) GRP_BAR(); } GRP_BAR();
        RELAUNDER(); if (PROBE_REP == 23) { ssd_out(F, L, true); GRP_BAR(); RELAUNDER(); } ssd_out(F, L); GRP_BAR();
        RELAUNDER(); wait_weights(F, L); if (PROBE_REP == 30) { ph_outproj(F, L, true); GRP_BAR(); RELAUNDER(); } ph_outproj(F, L); GRP_BAR();
        unsigned long long pq0 = 0; if (PROBE_REP == 85) pq0 = __builtin_amdgcn_s_memrealtime();
        if (PROBE_REP == 88 && threadIdx.x == 0) *(volatile LAS unsigned*)(F.lds + 161288) = (unsigned)__builtin_amdgcn_s_memrealtime();
        RELAUNDER(); ph_up(F, L); if (PROBE_REP == 84) pq0 = __builtin_amdgcn_s_memrealtime(); if (PROBE_REP == 5) { GRP_BAR(); RELAUNDER(); ph_up(F, L); } if (PROBE_REP == 6) { GRP_BAR(); RELAUNDER(); ph_up(F, L, 1); } GRP_BAR();
        if ((PROBE_REP == 84 || PROBE_REP == 85) && threadIdx.x == 0) *(volatile LAS unsigned*)(F.lds + 161280) = (unsigned)(__builtin_amdgcn_s_memrealtime() - pq0);
        if (PROBE_REP == 92 && L == 0 && threadIdx.x == 0) *(volatile LAS unsigned*)(F.lds + 161288) = (unsigned)__builtin_amdgcn_s_memrealtime();
        RELAUNDER(); if (PROBE_REP == 31) { ph_down(F, L, true); GRP_BAR(); RELAUNDER(); } if (PROBE_REP == 32) { ph_down(F, L, true, 2); GRP_BAR(); RELAUNDER(); } if (PROBE_REP == 33) { ph_down(F, L, true, 1); GRP_BAR(); RELAUNDER(); } if (PROBE_REP == 34) { ph_down(F, L, true, 3); GRP_BAR(); RELAUNDER(); } ph_down(F, L); if (L + 1 < DEPTH) GRP_BAR();
        if (PROBE_REP == 92 && L == 0 && threadIdx.x == 0) *(volatile LAS unsigned*)(F.lds + 161280) = (unsigned)__builtin_amdgcn_s_memrealtime() - *(volatile LAS unsigned*)(F.lds + 161288);
    }
#ifndef PROBE_WG
#define PROBE_WG 0
#endif
    if (PROBE_REP >= 80 && blockIdx.x == PROBE_WG && threadIdx.x == 0) {
        const unsigned dtk = *(volatile LAS unsigned*)(F.lds + 161280); const unsigned long long t0 = __builtin_amdgcn_s_memrealtime();
        while (__builtin_amdgcn_s_memrealtime() - t0 < 64ull * dtk) __builtin_amdgcn_s_sleep(4);
    }
    if (PROBE_REP == 7) {
        typedef float pf4 __attribute__((ext_vector_type(4))); typedef __bf16 pb8 __attribute__((ext_vector_type(8)));
        pf4 a0 = {0, 0, 0, 0}, a1 = a0, a2 = a0, a3 = a0; pb8 x, y;
        for (int e = 0; e < 8; ++e) { x[e] = (__bf16)(float)(F.tid & 3); y[e] = (__bf16)(float)(F.lane & 1); }
#pragma unroll 1
        for (int it = 0; it < 2500; ++it) {
            asm volatile("v_mfma_f32_16x16x32_bf16 %0, %4, %5, %0\n\tv_mfma_f32_16x16x32_bf16 %1, %4, %5, %1\n\tv_mfma_f32_16x16x32_bf16 %2, %4, %5, %2\n\tv_mfma_f32_16x16x32_bf16 %3, %4, %5, %3"
                         : "+v"(a0), "+v"(a1), "+v"(a2), "+v"(a3) : "v"(x), "v"(y));
        }
        const pf4 s = a0 + a1 + a2 + a3;
        if (s[0] + s[1] + s[2] + s[3] == 1.2345f) *((GAS float*)FWS(WS_CTL) + 100000) = s[0];
    }
}

extern "C" void kernel_launch(void* const* d_in, const int* in_sizes, int n_in, void* d_out, int out_size, void* d_ws, size_t ws_size, hipStream_t stream) {
    static int grid = 0;
    if (grid == 0) {
        if (n_in != 17 || in_sizes[0] != M * D || out_size != M * D || ws_size < WS_END) { fprintf(stderr, "kernel_launch: unexpected shapes (n_in %d, in0 %d, out %d, ws %zu)\n", n_in, n_in > 0 ? in_sizes[0] : -1, out_size, ws_size); grid = -1; return; }
        int dev = 0, cus = 0, per_cu = 0;
        if (hipGetDevice(&dev) != hipSuccess || hipDeviceGetAttribute(&cus, hipDeviceAttributeMultiprocessorCount, dev) != hipSuccess) { grid = -1; return; }
        if (hipFuncSetAttribute((const void*)fwd, hipFuncAttributeMaxDynamicSharedMemorySize, LDS_BYTES) != hipSuccess) { fprintf(stderr, "kernel_launch: hipFuncSetAttribute failed\n"); grid = -1; return; }
        if (hipOccupancyMaxActiveBlocksPerMultiprocessor(&per_cu, (const void*)fwd, NTHREADS, LDS_BYTES) != hipSuccess || per_cu < 1) { fprintf(stderr, "kernel_launch: occupancy query says %d\n", per_cu); per_cu = 0; }
        (void)hipGetLastError();
        if (cus * per_cu < GRID) { fprintf(stderr, "kernel_launch: this kernel needs %d co-resident workgroups (one per CU of a 256-CU device); the device admits %d x %d; nothing launched\n", GRID, cus, per_cu); grid = -1; return; }
        grid = GRID;
    }
    if (grid < 0) return;
    (void)hipMemsetAsync((char*)d_ws + WS_CTL, 0, CTL_ZERO_BYTES, stream);
    Args a{};
    for (int i = 0; i < 17; ++i) a.in[i] = (const float*)d_in[i];
    a.out = (float*)d_out; a.ws = (unsigned char*)d_ws;
    void* kargs[] = {&a};
    hipError_t e = hipLaunchCooperativeKernel((const void*)fwd, dim3(grid), dim3(NTHREADS), kargs, LDS_BYTES, stream);
    if (e != hipSuccess) fprintf(stderr, "kernel_launch: cooperative launch failed: %s (grid %d)\n", hipGetErrorString(e), grid);
}
```

```cpp
#include <hip/hip_runtime.h>
#include <cstdio>
#include <cstdint>
#define PROBE_REP 0


namespace pg8 {
#define PG8_LAS __attribute__((address_space(3)))
#define PG8_GAS __attribute__((address_space(1)))
typedef unsigned short bf16_t;
typedef short bf16x8 __attribute__((ext_vector_type(8)));
typedef float f32x4 __attribute__((ext_vector_type(4)));
typedef unsigned u32x4 __attribute__((ext_vector_type(4)));
constexpr int BM = 256, BK = 64, HALF = 128, HTB = HALF * BK * 2  , STAGE_BYTES = 8 * HTB, NXCD = 8, WGM = 8;

__host__ __device__ __forceinline__ int lds_byte(int r, int c) { const int st = (r >> 4) * 2 + (c >> 5), rr = r & 15, cc = c & 31, ob = rr * 64 + cc * 2; return st * 1024 + (ob ^ (((ob >> 9) & 1) << 5)); }
__host__ __device__ __forceinline__ void stage_rc(int b, int& R, int& C) { const int st = b / 1024, sb = b % 1024, swz = sb ^ (((sb >> 9) & 1) << 5); R = (st >> 1) * 16 + swz / 64; C = (st & 1) * 32 + (swz % 64) / 2; }
__host__ __device__ __forceinline__ int perm32(int rho) { const int n = rho >> 4, i = rho & 15; return 8 * (i >> 2) + 4 * n + (i & 3); }

struct Unit { int pm, pn; };
struct Gemm { const PG8_GAS bf16_t* A; const PG8_GAS bf16_t* Bt; int M, N, K, lda; };

struct StaticOrder {
    int nM, nN, nwg, G, c;
    __host__ __device__ void init(int M, int N, int G_, int c_) { nM = M / BM; nN = N / BM; nwg = nM * nN; G = G_; c = c_; }
    __host__ __device__ bool next(int i, Unit& u) const {
        const long L = (long)i * G + c; if (L >= nwg) return false;
        int wgid = (int)L; { const int q = nwg / NXCD, r = nwg % NXCD, xcd = wgid % NXCD, off = wgid / NXCD; wgid = (xcd < r ? xcd * (q + 1) : r * (q + 1) + (xcd - r) * q) + off; }
        const int nig = WGM * nN, gid = wgid / nig, fm = gid * WGM, gsz = (nM - fm) < WGM ? (nM - fm) : WGM;
        u.pm = fm + ((wgid % nig) % gsz); u.pn = (wgid % nig) / gsz; return true;
    }
    __device__ __forceinline__ void a_ready(const Unit&) const {}
    __device__ __forceinline__ void done(const Unit&) const {}
};

struct GroupOrder {
    int nN, li, hot = 0;
    __host__ __device__ void init(int N, int li_) { nN = N / BM; li = li_; }
    __host__ __device__ bool next(int i, Unit& u) const { const int T = i * 32 + li; if (T >= 8 * nN) return false; u.pm = (hot & 2) ? 0 : (T & 7); u.pn = (hot & 1) ? 0 : (T >> 3); return true; }
    __device__ __forceinline__ void a_ready(const Unit&) const {}
    __device__ __forceinline__ void done(const Unit&) const {}
};

__device__ __forceinline__ float shx(float v, int k, int lane) { return __builtin_bit_cast(float, __builtin_amdgcn_ds_bpermute((lane ^ k) << 2, __builtin_bit_cast(int, v))); }
typedef float f32x2_t __attribute__((ext_vector_type(2))); typedef __bf16 bf16x2_t __attribute__((ext_vector_type(2)));
__device__ __forceinline__ unsigned cvt_pk_bf16(float lo, float hi) { f32x2_t v = {lo, hi}; bf16x2_t b = __builtin_convertvector(v, bf16x2_t); return __builtin_bit_cast(unsigned, b); }

constexpr int PROJ_PITCH = 2304, DT_TILE = 9;
struct EpiProj {
    static constexpr int TAG = 1; static constexpr bool ZERO_C = false;
    static constexpr bool PERM = true, AFTER_DRAIN = false, ACC_INIT = false, PRE_HOOK = true;
    PG8_GAS bf16_t* O; PG8_GAS float* dtraw; PG8_LAS float* rstd; f32x4 pa, pb;
    __device__ __forceinline__ void pre(int tid) const {
        float s = (pa[0] + pa[1]) + (pa[2] + pa[3]) + (pb[0] + pb[1]) + (pb[2] + pb[3]);
        s += shx(s, 1, tid & 63);
        if ((tid & 1) == 0) rstd[tid >> 1] = 1.0f / sqrtf(s * (1.0f / 1024.0f) + 1e-6f);
    }
    __device__ __forceinline__ void operator()(const f32x4 (&acc)[2][2][4][2], const Unit& u, int ui, int wr, int wc, int fr, int fq) const {
        int rt0 = wr * 64 + fr; asm volatile("" : "+v"(rt0));
        if (u.pn == DT_TILE) {
            if (wc == 0 && fq == 0) {
#pragma unroll
                for (int ai = 0; ai < 2; ++ai)
#pragma unroll
                    for (int m = 0; m < 4; ++m) { const int rt = ai * HALF + rt0 + m * 16; const float rs = rstd[rt]; PG8_GAS float* p = dtraw + (size_t)(u.pm * BM + rt) * 8;
                        *(PG8_GAS f32x4*)p = acc[ai][0][m][0] * rs; *(PG8_GAS f32x4*)(p + 4) = acc[ai][0][m][1] * rs; }
            }
            return;
        }
        const int col0 = u.pn * BM + wc * 32 + 8 * fq;
#pragma unroll
        for (int ai = 0; ai < 2; ++ai)
#pragma unroll
            for (int m = 0; m < 4; ++m) { const int rt = ai * HALF + rt0 + m * 16; const float rs = rstd[rt]; PG8_GAS bf16_t* rowp = O + (size_t)(u.pm * BM + rt) * PROJ_PITCH + col0;
#pragma unroll
                for (int bj = 0; bj < 2; ++bj) { const f32x4 v0 = acc[ai][bj][m][0] * rs, v1 = acc[ai][bj][m][1] * rs;
                    u32x4 w; w.x = cvt_pk_bf16(v0[0], v0[1]); w.y = cvt_pk_bf16(v0[2], v0[3]); w.z = cvt_pk_bf16(v1[0], v1[1]); w.w = cvt_pk_bf16(v1[2], v1[3]);
                    *(PG8_GAS u32x4*)(rowp + bj * HALF) = w; } }
    }
};
struct EpiUp {
    static constexpr int TAG = 2; static constexpr bool ZERO_C = true;
    static constexpr bool PERM = true, AFTER_DRAIN = false, ACC_INIT = false, PRE_HOOK = true;
    PG8_GAS bf16_t* O; int ldc; PG8_LAS float* rstd; f32x4 pa, pb;
    __device__ __forceinline__ void pre(int tid) const {
        float s = (pa[0] + pa[1]) + (pa[2] + pa[3]) + (pb[0] + pb[1]) + (pb[2] + pb[3]);
        s += shx(s, 1, tid & 63);
        if ((tid & 1) == 0) rstd[tid >> 1] = 1.0f / sqrtf(s * (1.0f / 1024.0f) + 1e-6f);
    }
    __device__ __forceinline__ void operator()(const f32x4 (&acc)[2][2][4][2], const Unit& u, int ui, int wr, int wc, int fr, int fq) const {
        int rt0 = wr * 64 + fr; asm volatile("" : "+v"(rt0)); const int col0 = u.pn * BM + wc * 32 + 8 * fq;
#pragma unroll
        for (int ai = 0; ai < 2; ++ai)
#pragma unroll
            for (int m = 0; m < 4; ++m) { const int rt = ai * HALF + rt0 + m * 16; const float rs = rstd[rt]; PG8_GAS bf16_t* rowp = O + (size_t)(u.pm * BM + rt) * ldc + col0;
#pragma unroll
                for (int bj = 0; bj < 2; ++bj) { f32x4 v0 = acc[ai][bj][m][0] * rs, v1 = acc[ai][bj][m][1] * rs;
#pragma unroll
                    for (int e = 0; e < 4; ++e) { const float a = fmaxf(v0[e], 0.f), b = fmaxf(v1[e], 0.f); v0[e] = a * a; v1[e] = b * b; }
                    u32x4 w; w.x = cvt_pk_bf16(v0[0], v0[1]); w.y = cvt_pk_bf16(v0[2], v0[3]); w.z = cvt_pk_bf16(v1[0], v1[1]); w.w = cvt_pk_bf16(v1[2], v1[3]);
                    *(PG8_GAS u32x4*)(rowp + bj * HALF) = w; } }
    }
};
template <bool FINAL> struct EpiRes {
    static constexpr int TAG = 3; static constexpr bool ZERO_C = false;
    static constexpr bool PERM = true, AFTER_DRAIN = false, ACC_INIT = true, PRE_HOOK = false;
    PG8_GAS bf16_t* xb; PG8_GAS float* ssq; PG8_GAS float* out; PG8_GAS bf16_t* xdst;
    __device__ __forceinline__ void init(f32x4 (&acc)[2][2][4][2], const Unit& u, int wr, int wc, int fr, int fq) const {
        const int rt0 = wr * 64 + fr, col0 = u.pn * BM + wc * 32 + 8 * fq;
#pragma unroll
        for (int ai = 0; ai < 2; ++ai)
#pragma unroll
            for (int m = 0; m < 4; ++m) { const int row = u.pm * BM + ai * HALF + rt0 + m * 16; const size_t off = (size_t)row * 1024 + col0;
#pragma unroll
                for (int bj = 0; bj < 2; ++bj) { const u32x4 rw = *(const PG8_GAS u32x4*)(xb + off + bj * HALF);
                    acc[ai][bj][m][0] = (f32x4){__uint_as_float(rw.x << 16), __uint_as_float(rw.x & 0xffff0000u), __uint_as_float(rw.y << 16), __uint_as_float(rw.y & 0xffff0000u)};
                    acc[ai][bj][m][1] = (f32x4){__uint_as_float(rw.z << 16), __uint_as_float(rw.z & 0xffff0000u), __uint_as_float(rw.w << 16), __uint_as_float(rw.w & 0xffff0000u)}; } }
    }
    __device__ __forceinline__ void load_raw(u32x4 (&raw)[16], const Unit& u, int wr, int wc, int fr, int fq) const {
        const int rt0 = wr * 64 + fr, col0 = u.pn * BM + wc * 32 + 8 * fq;
#pragma unroll
        for (int ai = 0; ai < 2; ++ai)
#pragma unroll
            for (int m = 0; m < 4; ++m) { const int row = u.pm * BM + ai * HALF + rt0 + m * 16; const size_t off = (size_t)row * 1024 + col0;
#pragma unroll
                for (int bj = 0; bj < 2; ++bj) raw[(ai * 4 + m) * 2 + bj] = *(const PG8_GAS u32x4*)(xb + off + bj * HALF); }
    }
    __device__ __forceinline__ const char* res_base(const Unit& u) const { return (const char*)(xb + (size_t)u.pm * BM * 1024 + u.pn * BM); }
    __device__ __forceinline__ void load_raw2(u32x4 (&raw8)[8], const Unit& u, int wr, int wc, int fr, int fq) const {
#pragma unroll
        for (int ai = 0; ai < 2; ++ai)
#pragma unroll
            for (int mm = 0; mm < 2; ++mm) { const size_t off = (size_t)(u.pm * BM + ai * HALF + wr * 64 + (2 + mm) * 16 + fr) * 1024 + u.pn * BM + wc * 32 + 8 * fq;
                raw8[(ai * 2 + mm) * 2] = *(const PG8_GAS u32x4*)(xb + off); raw8[(ai * 2 + mm) * 2 + 1] = *(const PG8_GAS u32x4*)(xb + off + HALF); }
    }
    __device__ __forceinline__ static void add_piece(f32x4 (&a)[2], const u32x4 rw) {
        a[0] += (f32x4){__uint_as_float(rw.x << 16), __uint_as_float(rw.x & 0xffff0000u), __uint_as_float(rw.y << 16), __uint_as_float(rw.y & 0xffff0000u)};
        a[1] += (f32x4){__uint_as_float(rw.z << 16), __uint_as_float(rw.z & 0xffff0000u), __uint_as_float(rw.w << 16), __uint_as_float(rw.w & 0xffff0000u)};
    }
    __device__ __forceinline__ void init_raw2(f32x4 (&acc)[2][2][4][2], const u32x4 (&raw8)[8]) const {
#pragma unroll
        for (int ai = 0; ai < 2; ++ai)
#pragma unroll
            for (int bj = 0; bj < 2; ++bj)
#pragma unroll
                for (int m = 0; m < 4; ++m) { acc[ai][bj][m][0] = (f32x4){0.f, 0.f, 0.f, 0.f}; acc[ai][bj][m][1] = (f32x4){0.f, 0.f, 0.f, 0.f}; }
#pragma unroll
        for (int ai = 0; ai < 2; ++ai)
#pragma unroll
            for (int mm = 0; mm < 2; ++mm)
#pragma unroll
                for (int bj = 0; bj < 2; ++bj) add_piece(acc[ai][bj][2 + mm], raw8[(ai * 2 + mm) * 2 + bj]);
    }
    __device__ __forceinline__ void init_raw(f32x4 (&acc)[2][2][4][2], const u32x4 (&raw)[16]) const {
#pragma unroll
        for (int ai = 0; ai < 2; ++ai)
#pragma unroll
            for (int m = 0; m < 4; ++m)
#pragma unroll
                for (int bj = 0; bj < 2; ++bj) { const u32x4 rw = raw[(ai * 4 + m) * 2 + bj];
                    acc[ai][bj][m][0] = (f32x4){__uint_as_float(rw.x << 16), __uint_as_float(rw.x & 0xffff0000u), __uint_as_float(rw.y << 16), __uint_as_float(rw.y & 0xffff0000u)};
                    acc[ai][bj][m][1] = (f32x4){__uint_as_float(rw.z << 16), __uint_as_float(rw.z & 0xffff0000u), __uint_as_float(rw.w << 16), __uint_as_float(rw.w & 0xffff0000u)}; }
    }
    __device__ __forceinline__ void operator()(const f32x4 (&acc)[2][2][4][2], const Unit& u, int ui, int wr, int wc, int fr, int fq) const {
        int rt0 = wr * 64 + fr; asm volatile("" : "+v"(rt0)); const int col0 = u.pn * BM + wc * 32 + 8 * fq;
#pragma unroll
        for (int ai = 0; ai < 2; ++ai)
#pragma unroll
            for (int m = 0; m < 4; ++m) { const int row = u.pm * BM + ai * HALF + rt0 + m * 16; const size_t off = (size_t)row * 1024 + col0; float s = 0.f;
#pragma unroll
                for (int bj = 0; bj < 2; ++bj) { const f32x4 v0 = acc[ai][bj][m][0], v1 = acc[ai][bj][m][1];
                    if (FINAL) { *(PG8_GAS f32x4*)(out + off + bj * HALF) = v0; *(PG8_GAS f32x4*)(out + off + bj * HALF + 4) = v1; }
                    else { u32x4 w; w.x = cvt_pk_bf16(v0[0], v0[1]); w.y = cvt_pk_bf16(v0[2], v0[3]); w.z = cvt_pk_bf16(v1[0], v1[1]); w.w = cvt_pk_bf16(v1[2], v1[3]);
                        *(PG8_GAS u32x4*)(xdst + off + bj * HALF) = w;
                        s += (v0[0] * v0[0] + v0[1] * v0[1]) + (v0[2] * v0[2] + v0[3] * v0[3]) + (v1[0] * v1[0] + v1[1] * v1[1]) + (v1[2] * v1[2] + v1[3] * v1[3]); } }
                if (!FINAL) { const int ln = fq * 16 + fr; s += shx(s, 16, ln); s += shx(s, 32, ln);
                    if (fq == 0) ssq[(size_t)row * 16 + u.pn * 4 + wc] = s; } }
    }
};

template <class Epi, class Sched> __device__ __forceinline__ void gemm_prefetch(PG8_LAS unsigned char* lds, const Gemm g, const Sched& S, const Epi& E, u32x4 (&raw)[16]) {
    int tid_ = threadIdx.x; asm volatile("" : "+v"(tid_));
    const int tid = tid_, wid = __builtin_amdgcn_readfirstlane(tid >> 6), lane = tid & 63, wr = wid >> 2, wc = wid & 3, fr = lane & 15, fq = lane >> 4;
    Unit cur; if (!S.next(0, cur)) return;
    const int K = g.K; unsigned voffB[2];
#pragma unroll
    for (int i = 0; i < 2; ++i) { int R, C; stage_rc(tid * 16 + i * 8192, R, C); const int Rb = Epi::PERM ? ((R & ~31) + perm32(R & 31)) : R; voffB[i] = (unsigned)(Rb * K + C) * 2u; }
    const size_t kstep = (size_t)(BK * 2), hstepB = (size_t)HALF * K * 2, tstepB = 2 * hstepB; const unsigned ldsw = (unsigned)wid * 1024u;
    const char* cB = (const char*)g.Bt + (size_t)cur.pn * tstepB;
#define PG8_PF(slot, gbase) do { _Pragma("unroll") for (int _i = 0; _i < 2; ++_i) \
        __builtin_amdgcn_global_load_lds((const unsigned*)((const char*)(gbase) + voffB[_i]), (PG8_LAS unsigned*)(lds + (4 + (slot)) * HTB + ldsw + _i * 8192), 16, 0, 0); } while (0)
    PG8_PF(0, cB); PG8_PF(1, cB + hstepB); PG8_PF(2, cB + kstep); PG8_PF(3, cB + hstepB + kstep);
#undef PG8_PF
    E.load_raw(raw, cur, wr, wc, fr, fq);
}
template <bool PERM, class Sched> __device__ __forceinline__ void gemm_prefetch_b(PG8_LAS unsigned char* lds, const Gemm g, const Sched& S) {
    int tid_ = threadIdx.x; asm volatile("" : "+v"(tid_));
    const int tid = tid_, wid = __builtin_amdgcn_readfirstlane(tid >> 6);
    Unit cur; if (!S.next(0, cur)) return;
    const int K = g.K; unsigned voffB[2];
#pragma unroll
    for (int i = 0; i < 2; ++i) { int R, C; stage_rc(tid * 16 + i * 8192, R, C); const int Rb = PERM ? ((R & ~31) + perm32(R & 31)) : R; voffB[i] = (unsigned)(Rb * K + C) * 2u; }
    const size_t kstep = (size_t)(BK * 2), hstepB = (size_t)HALF * K * 2, tstepB = 2 * hstepB; const unsigned ldsw = (unsigned)wid * 1024u;
    const char* cB = (const char*)g.Bt + (size_t)cur.pn * tstepB;
#define PG8_PF(slot, gbase) do { _Pragma("unroll") for (int _i = 0; _i < 2; ++_i) \
        __builtin_amdgcn_global_load_lds((const unsigned*)((const char*)(gbase) + voffB[_i]), (PG8_LAS unsigned*)(lds + (4 + (slot)) * HTB + ldsw + _i * 8192), 16, 0, 0); } while (0)
    PG8_PF(0, cB); PG8_PF(1, cB + hstepB); PG8_PF(2, cB + kstep); PG8_PF(3, cB + hstepB + kstep);
#undef PG8_PF
}
template <class Epi, class Sched> __device__ __forceinline__ void gemm_prefetch_res(PG8_LAS unsigned char* lds, const Gemm g, const Sched& S, const Epi& E, u32x4 (&raw2)[8]) {
    gemm_prefetch_b<Epi::PERM>(lds, g, S);
    int tid_ = threadIdx.x; asm volatile("" : "+v"(tid_));
    const int wid = __builtin_amdgcn_readfirstlane(tid_ >> 6), lane = tid_ & 63;
    Unit cur; if (!S.next(0, cur)) return;
    E.load_raw2(raw2, cur, wid >> 2, wid & 3, lane & 15, lane >> 4);
}
template <class Epi, class Sched, bool ALIGN_EPI = false, bool SP2 = false, int PRE = 0>
__device__ __forceinline__ void gemm_phase(PG8_LAS unsigned char* lds, const Gemm g, const Sched& S, const Epi& E, const u32x4* raw = nullptr) {
#if PROBE_REP >= 80
    if (PROBE_REP == 93 && Epi::TAG == 3 && g.K == 4096 && threadIdx.x == 0) *(PG8_LAS unsigned*)(lds + 161288) = (unsigned)__builtin_amdgcn_s_memrealtime();
    if (PROBE_REP == 98 && Epi::TAG == 3 && g.K == 4096 && threadIdx.x == 0) *(PG8_LAS unsigned*)(lds + 161280) = (unsigned)__builtin_amdgcn_s_memrealtime() - *(PG8_LAS unsigned*)(lds + 161288);
    if (PROBE_REP == 88 && Epi::TAG == 2 && threadIdx.x == 0) *(PG8_LAS unsigned*)(lds + 161280) = (unsigned)__builtin_amdgcn_s_memrealtime() - *(PG8_LAS unsigned*)(lds + 161288);
#endif
    int tid_ = threadIdx.x; asm volatile("" : "+v"(tid_));
    const int tid = tid_, wid = __builtin_amdgcn_readfirstlane(tid >> 6), lane = tid & 63, wr = wid >> 2, wc = wid & 3, fr = lane & 15, fq = lane >> 4;
    const int K = g.K, nt = K / BK;
    unsigned voffA[2], voffB[2];
#pragma unroll
    for (int i = 0; i < 2; ++i) { int R, C; stage_rc(tid * 16 + i * 8192, R, C); const int Rb = Epi::PERM ? ((R & ~31) + perm32(R & 31)) : R;
        voffA[i] = (unsigned)(R * g.lda + C) * 2u; voffB[i] = (unsigned)(Rb * K + C) * 2u; }
    const size_t kstep = (size_t)(BK * 2);
    const size_t hstepA = (size_t)HALF * g.lda * 2, hstepB = (size_t)HALF * K * 2;
    const size_t tstepA = 2 * hstepA, tstepB = 2 * hstepB;
    const unsigned ldsw = (unsigned)wid * 1024u;
    const int aoff = lds_byte(wr * 64 + fr, fq * 8), boff = lds_byte(wc * 32 + fr, fq * 8);
#define PG8_SA(b, h) (((b) * 2 + (h)) * HTB)
#define PG8_SB(b, h) ((4 + (b) * 2 + (h)) * HTB)
#define PG8_STAGE(bufoff, gbase, voff) do { _Pragma("unroll") for (int _i = 0; _i < 2; ++_i) \
        __builtin_amdgcn_global_load_lds((const unsigned*)((const char*)(gbase) + (voff)[_i]), (PG8_LAS unsigned*)(lds + (bufoff) + ldsw + _i * 8192), 16, 0, 0); } while (0)
#define PG8_ROFF(k) ((unsigned)((((k) >> 3) * 128 + (((k) >> 1) & 3) * 16) * 1024 + ((k) & 1) * 128) * 2u)
#define PG8_RPIECE(p) ((p) == 4 ? 0 : (p) == 5 ? 2 : (p) == 0 ? 8 : 10)
#define PG8_RSTAGE(p, bufoff, gbase, voff) do { if (PRE == 3 && last && !has_next && ((p) == 4 || (p) == 5 || (p) == 0 || (p) == 1)) { int t2_ = threadIdx.x; asm volatile("" : "+v"(t2_)); const int l2_ = t2_ & 63;     \
        const unsigned rl_ = (unsigned)((wr * 64 + (l2_ & 15)) * 1024 + wc * 32 + (l2_ >> 4) * 8) * 2u; \
        const unsigned ro_[2] = {rl_ + PG8_ROFF(PG8_RPIECE(p)), rl_ + PG8_ROFF(PG8_RPIECE(p) + 1)}; PG8_STAGE(bufoff, rbase, ro_); } else PG8_STAGE(bufoff, gbase, voff); } while (0)
#define PG8_LDA(dst, b, h) do { _Pragma("unroll") for (int m = 0; m < 4; ++m) _Pragma("unroll") for (int k = 0; k < 2; ++k) dst[m][k] = *(const PG8_LAS bf16x8*)(lds + PG8_SA(b, h) + aoff + m * 2048 + k * 1024); } while (0)
#define PG8_LDB(dst, b, h) do { _Pragma("unroll") for (int n = 0; n < 2; ++n) _Pragma("unroll") for (int k = 0; k < 2; ++k) dst[n][k] = *(const PG8_LAS bf16x8*)(lds + PG8_SB(b, h) + boff + n * 2048 + k * 1024); } while (0)
#define PG8_MMA(ai, bj, At, Bt) do { __builtin_amdgcn_s_setprio(1); _Pragma("unroll") for (int m = 0; m < 4; ++m) _Pragma("unroll") for (int n = 0; n < 2; ++n) _Pragma("unroll") for (int k = 0; k < 2; ++k) \
        acc[ai][bj][m][n] = __builtin_amdgcn_mfma_f32_16x16x32_bf16(Bt[n][k], At[m][k], acc[ai][bj][m][n], 0, 0, 0); __builtin_amdgcn_s_setprio(0); } while (0)
#define PG8_MMA0(ai, bj, At, Bt) do { __builtin_amdgcn_s_setprio(1); \
        _Pragma("unroll") for (int m = 0; m < 4; ++m) _Pragma("unroll") for (int n = 0; n < 2; ++n) acc[ai][bj][m][n] = __builtin_amdgcn_mfma_f32_16x16x32_bf16(Bt[n][0], At[m][0], (f32x4){0.f, 0.f, 0.f, 0.f}, 0, 0, 0); \
        _Pragma("unroll") for (int m = 0; m < 4; ++m) _Pragma("unroll") for (int n = 0; n < 2; ++n) acc[ai][bj][m][n] = __builtin_amdgcn_mfma_f32_16x16x32_bf16(Bt[n][1], At[m][1], acc[ai][bj][m][n], 0, 0, 0); \
        __builtin_amdgcn_s_setprio(0); } while (0)
#define PG8_WAIT_V(n) asm volatile("s_waitcnt vmcnt(" #n ")" ::: "memory")
#define PG8_WAIT_L(n) asm volatile("s_waitcnt lgkmcnt(" #n ")" ::: "memory")
#define PG8_BAR __builtin_amdgcn_s_barrier()
#define PG8_SCHED __builtin_amdgcn_sched_barrier(0)
    Unit cur, nxt; int ui = 0;
#if PROBE_REP >= 80
    unsigned long long pt0 = 0; if (PROBE_REP == 82) pt0 = __builtin_amdgcn_s_memrealtime();
#endif
    if (!S.next(0, cur)) return;
    constexpr bool ZC = SP2 && !Epi::ACC_INIT && Epi::ZERO_C;
    f32x4 acc[2][2][4][2];
    if constexpr (!ZC) {
#pragma unroll
    for (int a = 0; a < 2; ++a)
#pragma unroll
        for (int b = 0; b < 2; ++b)
#pragma unroll
            for (int m = 0; m < 4; ++m)
#pragma unroll
                for (int n = 0; n < 2; ++n) acc[a][b][m][n] = (f32x4){0.f, 0.f, 0.f, 0.f};
    }
    if constexpr (Epi::ACC_INIT && PRE == 0) E.init(acc, cur, wr, wc, fr, fq);
    bf16x8 At[4][2], B0[2][2], B1[2][2];
    const char* cA = (const char*)g.A + (size_t)cur.pm * tstepA; const char* cB = (const char*)g.Bt + (size_t)cur.pn * tstepB;
    S.a_ready(cur);
    const char* rbase = nullptr; if constexpr (PRE == 3) rbase = E.res_base(cur);
    if constexpr (PRE != 0) {
        static_assert(SP2, "PRE: the SP2 loop");
        PG8_STAGE(PG8_SA(0, 0), cA, voffA); PG8_STAGE(PG8_SA(0, 1), cA + hstepA, voffA);
        if constexpr (PRE == 3) E.init_raw2(acc, *(const u32x4 (*)[8])raw); else if constexpr (Epi::ACC_INIT) E.init_raw(acc, *(const u32x4 (*)[16])raw);
        if constexpr (Epi::PRE_HOOK) E.pre(tid);
        if (wr == 1) PG8_BAR;
        PG8_WAIT_V(2); PG8_BAR;
        PG8_STAGE(PG8_SA(1, 0), cA + kstep, voffA);
        PG8_WAIT_V(2); PG8_BAR;
    } else if constexpr (SP2) {
        PG8_STAGE(PG8_SB(0, 0), cB, voffB); PG8_STAGE(PG8_SB(0, 1), cB + hstepB, voffB); PG8_STAGE(PG8_SA(0, 0), cA, voffA); PG8_STAGE(PG8_SA(0, 1), cA + hstepA, voffA);
        if constexpr (Epi::PRE_HOOK) E.pre(tid);
        if (wr == 1) PG8_BAR;
        PG8_WAIT_V(2); PG8_BAR;
        PG8_STAGE(PG8_SB(1, 0), cB + kstep, voffB); PG8_STAGE(PG8_SA(1, 0), cA + kstep, voffA); PG8_STAGE(PG8_SB(1, 1), cB + hstepB + kstep, voffB);
        PG8_WAIT_V(6); PG8_BAR;
    } else {
        PG8_STAGE(PG8_SB(0, 0), cB, voffB); PG8_STAGE(PG8_SA(0, 0), cA, voffA); PG8_STAGE(PG8_SB(0, 1), cB + hstepB, voffB); PG8_STAGE(PG8_SA(0, 1), cA + hstepA, voffA);
        if (wr == 1) PG8_BAR;
        PG8_WAIT_V(4); PG8_BAR;
        PG8_STAGE(PG8_SB(1, 0), cB + kstep, voffB); PG8_STAGE(PG8_SA(1, 0), cA + kstep, voffA); PG8_STAGE(PG8_SB(1, 1), cB + hstepB + kstep, voffB);
        PG8_WAIT_V(6); PG8_BAR;
    }
    for (;;) {
        const bool has_next = S.next(ui + 1, nxt);
        const char* nA = has_next ? (const char*)g.A + (size_t)nxt.pm * tstepA : cA; const char* nB = has_next ? (const char*)g.Bt + (size_t)nxt.pn * tstepB : cB;
#if PROBE_REP >= 80
        if (Epi::TAG == 2 && ui == 0 && PROBE_REP == 82 && tid == 0) *(PG8_LAS unsigned*)(lds + 161280) = (unsigned)(__builtin_amdgcn_s_memrealtime() - pt0);
        if (Epi::TAG == 2 && ((PROBE_REP == 86 && ui == 0) || (PROBE_REP == 87 && ui == 3) || (PROBE_REP == 89 && ui == 0) || (PROBE_REP == 90 && ui == 2)) && tid == 0) *(PG8_LAS unsigned*)(lds + 161288) = (unsigned)__builtin_amdgcn_s_memrealtime();
        if (Epi::TAG == 3 && nt == 64 && PROBE_REP == 91 && tid == 0) *(PG8_LAS unsigned*)(lds + 161288) = (unsigned)__builtin_amdgcn_s_memrealtime();
        if (Epi::TAG == 3 && nt == 64 && PROBE_REP == 93 && tid == 0) *(PG8_LAS unsigned*)(lds + 161280) = (unsigned)__builtin_amdgcn_s_memrealtime() - *(PG8_LAS unsigned*)(lds + 161288);
        if (Epi::TAG == 2 && ui == 1) { if (PROBE_REP == 80) pt0 = __builtin_amdgcn_s_memrealtime(); if (PROBE_REP == 81 && tid == 0) *(PG8_LAS unsigned*)(lds + 161280) = (unsigned)(__builtin_amdgcn_s_memrealtime() - pt0); }
#endif
        int t0 = 0;
        if constexpr (ZC) {
            size_t ks = kstep; asm volatile("" : "+s"(ks));
            const char* a1 = cA + ks; const char* a2 = cA + 2 * ks; const char* b2 = cB + 2 * ks; const char* a3 = a2 + ks; const char* b3 = b2 + ks;
            PG8_LDB(B0, 0, 0); PG8_LDB(B1, 0, 1); PG8_SCHED; PG8_LDA(At, 0, 0); PG8_STAGE(PG8_SA(1, 1), a1 + hstepA, voffA);
            PG8_WAIT_V(8); PG8_WAIT_L(0); PG8_BAR; PG8_MMA0(0, 0, At, B0); PG8_MMA0(0, 1, At, B1); PG8_BAR; PG8_SCHED;
            PG8_LDA(At, 0, 1); PG8_STAGE(PG8_SB(0, 0), b2, voffB); PG8_STAGE(PG8_SB(0, 1), b2 + hstepB, voffB); PG8_STAGE(PG8_SA(0, 0), a2, voffA);
            PG8_WAIT_V(8); PG8_WAIT_L(0); PG8_BAR; PG8_MMA0(1, 0, At, B0); PG8_MMA0(1, 1, At, B1); PG8_BAR; PG8_SCHED;
            PG8_LDB(B0, 1, 0); PG8_LDB(B1, 1, 1); PG8_SCHED; PG8_LDA(At, 1, 0); PG8_STAGE(PG8_SA(0, 1), a2 + hstepA, voffA);
            PG8_WAIT_V(8); PG8_WAIT_L(0); PG8_BAR; PG8_MMA(0, 0, At, B0); PG8_MMA(0, 1, At, B1); PG8_BAR; PG8_SCHED;
            PG8_LDA(At, 1, 1); PG8_STAGE(PG8_SB(1, 0), b3, voffB); PG8_STAGE(PG8_SB(1, 1), b3 + hstepB, voffB); PG8_STAGE(PG8_SA(1, 0), a3, voffA);
            PG8_WAIT_V(8); PG8_WAIT_L(0); PG8_BAR; PG8_MMA(1, 0, At, B0); PG8_MMA(1, 1, At, B1); PG8_BAR; PG8_SCHED;
            t0 = 2;
        }
        for (int t = t0; t < nt; t += 2) {
            const bool last = (t == nt - 2);
            const char* a1 = cA + (size_t)(t + 1) * kstep;
            const char* a2 = last ? nA : cA + (size_t)(t + 2) * kstep; const char* b2 = last ? nB : cB + (size_t)(t + 2) * kstep;
            const char* a3 = a2 + kstep; const char* b3 = b2 + kstep;
            if (last && has_next) S.a_ready(nxt);
            if constexpr (SP2) {
            PG8_LDB(B0, 0, 0); PG8_LDB(B1, 0, 1); PG8_SCHED; PG8_LDA(At, 0, 0); PG8_STAGE(PG8_SA(1, 1), a1 + hstepA, voffA);
            PG8_WAIT_V(8); PG8_WAIT_L(0); PG8_BAR; PG8_MMA(0, 0, At, B0); PG8_MMA(0, 1, At, B1); PG8_BAR; PG8_SCHED;
            PG8_LDA(At, 0, 1); PG8_RSTAGE(4, PG8_SB(0, 0), b2, voffB); PG8_RSTAGE(5, PG8_SB(0, 1), b2 + hstepB, voffB); PG8_RSTAGE(0, PG8_SA(0, 0), a2, voffA);
            PG8_WAIT_V(8); PG8_WAIT_L(0); PG8_BAR; PG8_MMA(1, 0, At, B0); PG8_MMA(1, 1, At, B1); PG8_BAR; PG8_SCHED;
            PG8_LDB(B0, 1, 0); PG8_LDB(B1, 1, 1); PG8_SCHED; PG8_LDA(At, 1, 0); PG8_RSTAGE(1, PG8_SA(0, 1), a2 + hstepA, voffA);
            PG8_WAIT_V(8); PG8_WAIT_L(0); PG8_BAR; PG8_MMA(0, 0, At, B0); PG8_MMA(0, 1, At, B1); PG8_BAR; PG8_SCHED;
            PG8_LDA(At, 1, 1); PG8_RSTAGE(6, PG8_SB(1, 0), b3, voffB); PG8_RSTAGE(7, PG8_SB(1, 1), b3 + hstepB, voffB); PG8_RSTAGE(2, PG8_SA(1, 0), a3, voffA);
            PG8_WAIT_V(8); PG8_WAIT_L(0); PG8_BAR; PG8_MMA(1, 0, At, B0); PG8_MMA(1, 1, At, B1); PG8_BAR; PG8_SCHED;
            } else {
            PG8_LDB(B0, 0, 0); PG8_SCHED; PG8_LDA(At, 0, 0); PG8_STAGE(PG8_SA(1, 1), a1 + hstepA, voffA);
            PG8_WAIT_L(8); PG8_BAR; PG8_WAIT_L(0); PG8_MMA(0, 0, At, B0); PG8_BAR; PG8_SCHED;
            PG8_LDB(B1, 0, 1); PG8_STAGE(PG8_SB(0, 0), b2, voffB);
            PG8_BAR; PG8_WAIT_L(0); PG8_MMA(0, 1, At, B1); PG8_BAR;
            PG8_LDA(At, 0, 1); PG8_STAGE(PG8_SA(0, 0), a2, voffA);
            PG8_BAR; PG8_WAIT_L(0); PG8_MMA(1, 0, At, B0); PG8_BAR; PG8_SCHED;
            PG8_STAGE(PG8_SB(0, 1), b2 + hstepB, voffB);
            PG8_WAIT_V(6); PG8_BAR; PG8_MMA(1, 1, At, B1); PG8_BAR;
            PG8_LDB(B0, 1, 0); PG8_SCHED; PG8_LDA(At, 1, 0); PG8_STAGE(PG8_SA(0, 1), a2 + hstepA, voffA);
            PG8_WAIT_L(8); PG8_BAR; PG8_WAIT_L(0); PG8_MMA(0, 0, At, B0); PG8_BAR; PG8_SCHED;
            PG8_LDB(B1, 1, 1); PG8_STAGE(PG8_SB(1, 0), b3, voffB);
            PG8_BAR; PG8_WAIT_L(0); PG8_MMA(0, 1, At, B1); PG8_BAR;
            PG8_LDA(At, 1, 1); PG8_STAGE(PG8_SA(1, 0), a3, voffA);
            PG8_BAR; PG8_WAIT_L(0); PG8_MMA(1, 0, At, B0); PG8_BAR; PG8_SCHED;
            PG8_STAGE(PG8_SB(1, 1), b3 + hstepB, voffB);
            PG8_WAIT_V(6); PG8_BAR; PG8_MMA(1, 1, At, B1); PG8_BAR;
            }
        }
#if PROBE_REP >= 80
        if (Epi::TAG == 2 && ((PROBE_REP == 86 && ui == 0) || (PROBE_REP == 87 && ui == 3) || (PROBE_REP == 89 && ui == 3) || (PROBE_REP == 90 && ui == 2)) && tid == 0) *(PG8_LAS unsigned*)(lds + 161280) = (unsigned)__builtin_amdgcn_s_memrealtime() - *(PG8_LAS unsigned*)(lds + 161288);
        if (Epi::TAG == 3 && nt == 64 && PROBE_REP == 94 && tid == 0) *(PG8_LAS unsigned*)(lds + 161288) = (unsigned)__builtin_amdgcn_s_memrealtime();
        if (Epi::TAG == 3 && nt == 64 && PROBE_REP == 91 && tid == 0) *(PG8_LAS unsigned*)(lds + 161280) = (unsigned)__builtin_amdgcn_s_memrealtime() - *(PG8_LAS unsigned*)(lds + 161288);
        if (Epi::TAG == 2 && ui == 1 && PROBE_REP == 80 && tid == 0) *(PG8_LAS unsigned*)(lds + 161280) = (unsigned)(__builtin_amdgcn_s_memrealtime() - pt0);
        if (Epi::TAG == 2 && ui == 0 && PROBE_REP == 81) pt0 = __builtin_amdgcn_s_memrealtime();
#endif
        if constexpr (ALIGN_EPI) { if (wr == 0) PG8_BAR; }
        if constexpr (!Epi::AFTER_DRAIN && PRE != 3) { E(acc, cur, ui, wr, wc, fr, fq); S.done(cur); }
#if PROBE_REP >= 80
        if (PROBE_REP == 83 && !has_next && tid == 0) *(PG8_LAS unsigned*)(lds + 161288) = (unsigned)__builtin_amdgcn_s_memrealtime();
#endif
        if (!has_next) break;
        if constexpr (!ZC) {
#pragma unroll
        for (int a = 0; a < 2; ++a)
#pragma unroll
            for (int b = 0; b < 2; ++b)
#pragma unroll
                for (int m = 0; m < 4; ++m)
#pragma unroll
                    for (int n = 0; n < 2; ++n) acc[a][b][m][n] = (f32x4){0.f, 0.f, 0.f, 0.f};
        }
        cur = nxt; cA = nA; cB = nB; ++ui;
        if constexpr (ALIGN_EPI) { if (wr == 1) PG8_BAR; }
    }
    PG8_WAIT_V(0);
    if constexpr (!ALIGN_EPI) { if (wr == 0) PG8_BAR; }
    PG8_BAR;
    if constexpr (PRE == 3) {
        { constexpr int RP[4] = {4, 5, 0, 1};
#pragma unroll
          for (int q4 = 0; q4 < 4; ++q4) { const int p_ = RP[q4], k0 = (p_ == 4 ? 0 : p_ == 5 ? 2 : p_ == 0 ? 8 : 10);
#pragma unroll
              for (int i = 0; i < 2; ++i) { const int k = k0 + i; const u32x4 rw = *(const PG8_LAS u32x4*)(lds + p_ * HTB + ldsw + i * 8192 + lane * 16);
                  Epi::add_piece(acc[k >> 3][k & 1][(k >> 1) & 3], rw); } } }
        E(acc, cur, ui, wr, wc, fr, fq); S.done(cur);
    }
#if PROBE_REP >= 80
    if (Epi::TAG == 3 && nt == 64 && PROBE_REP == 94 && tid == 0) *(PG8_LAS unsigned*)(lds + 161280) = (unsigned)__builtin_amdgcn_s_memrealtime() - *(PG8_LAS unsigned*)(lds + 161288);
    if (Epi::TAG == 2 && PROBE_REP == 83 && tid == 0) *(PG8_LAS unsigned*)(lds + 161280) = (unsigned)__builtin_amdgcn_s_memrealtime() - *(PG8_LAS unsigned*)(lds + 161288);
#endif

#undef PG8_SA
#undef PG8_SB
#undef PG8_STAGE
#undef PG8_RSTAGE
#undef PG8_RPIECE
#undef PG8_ROFF
#undef PG8_LDA
#undef PG8_LDB
#undef PG8_MMA
#undef PG8_MMA0
#undef PG8_WAIT_V
#undef PG8_WAIT_L
#undef PG8_BAR
#undef PG8_SCHED
}
}

constexpr int NWAVES = 8, NTHREADS = NWAVES * 64;
constexpr int BATCH = 8, SEQ = 2048, D = 1024, M = BATCH * SEQ, FF = 4096, DEPTH = 2;
constexpr int D_IN = 2312, NPROJ = 2560, PP = pg8::PROJ_PITCH;
constexpr int CQ = 0, CZ = 512, CK = 1024, CV = 1152, CX = 1280, CBM = 1792, CCM = 2048;
constexpr float EPS = 1e-6f;
constexpr int GRID = 256, NGRP = 8, GRP = GRID / NGRP;

constexpr size_t MiB = 1u << 20;
constexpr size_t WS_CTL = 0, CTL_ZERO_BYTES = 192 * 1024;
constexpr size_t WS_SSQ = 1 * MiB;
constexpr size_t WS_DTRAW = 2 * MiB;
constexpr size_t WS_ACS = 2 * MiB + 512 * 1024, WS_CHDEC = 3 * MiB;
constexpr size_t WS_WIN = 4 * MiB, WS_WOUT = 14 * MiB, WS_WUP = 18 * MiB, WS_WDOWN = 34 * MiB;
constexpr size_t WS_XB = 50 * MiB;
constexpr size_t WS_BATCH0 = 82 * MiB, BATCH_STRIDE = 20 * MiB;
constexpr size_t BO_PROJ = 0;
constexpr size_t BO_STATES = 9 * MiB;
constexpr size_t BO_PREV = 13 * MiB;
constexpr size_t BO_YPART = 15 * MiB;
constexpr size_t BO_CC = 19 * MiB;
constexpr int HIDP = 4096;
constexpr size_t BO_HID = 0;
constexpr size_t WS_END = WS_BATCH0 + BATCH * BATCH_STRIDE;
static_assert(WS_END <= 256 * MiB, "d_ws map");
constexpr int CW_BAR = 4096, CW_GRP = 16384, GRP_BAR_STRIDE = 4096; static_assert((size_t)(CW_GRP + 8 * GRP_BAR_STRIDE) * 4 <= CTL_ZERO_BYTES, "control words inside the zeroed region");

constexpr int RING_OFF = 0, RING_BYTES = 131072;
constexpr int MIX_BYTES = 155648;
constexpr int LDSCTL_OFF = MIX_BYTES, MISC_OFF = LDSCTL_OFF + 320, RSTD_OFF = LDSCTL_OFF + 512, PTR_OFF = RSTD_OFF + 4096;
constexpr int LDS_BYTES = 163840;
static_assert(PTR_OFF + 512 <= LDS_BYTES && RING_BYTES <= MIX_BYTES, "LDS map");

#define GAS __attribute__((address_space(1)))
#define LAS __attribute__((address_space(3)))
typedef unsigned short bf16;
typedef unsigned v4u __attribute__((ext_vector_type(4)));
typedef unsigned v2u __attribute__((ext_vector_type(2)));
typedef float f32x4 __attribute__((ext_vector_type(4)));
#define LDS_WAIT() asm volatile("s_waitcnt lgkmcnt(0)" ::: "memory")
#define VM_WAIT() asm volatile("s_waitcnt vmcnt(0)" ::: "memory")
__device__ __forceinline__ unsigned f2bf(float f) { unsigned u = __builtin_bit_cast(unsigned, f); return (u + 0x7fffu + ((u >> 16) & 1u)) >> 16; }
__device__ __forceinline__ unsigned pk2(float lo, float hi) { return f2bf(lo) | (f2bf(hi) << 16); }
__device__ __forceinline__ float bflo(unsigned w) { return __uint_as_float(w << 16); }
__device__ __forceinline__ float bfhi(unsigned w) { return __uint_as_float(w & 0xffff0000u); }
__device__ __forceinline__ float silu_f(float v) { return v / (1.f + expf(-v)); }
__device__ __forceinline__ float softplus_f(float v) { return fmaxf(v, 0.f) + log1pf(expf(-fabsf(v))); }

#define XB_TMO      128
#define XB_XCNT(j)  (256  + 64 * (j))
#define XB_XSUB(j)  (1280 + 64 * (j))
#define XB_XGEN(j)  (2304 + 64 * (j))
#define XB_TOP      3328
#define XB_TOPGEN   3392
#define XCD_BAR_WORDS 3456
#define XB_SPIN_CAP (1u << 22)
__device__ __forceinline__ unsigned xb_ld(unsigned* p)              { return __hip_atomic_load(p, __ATOMIC_RELAXED, __HIP_MEMORY_SCOPE_AGENT); }
__device__ __forceinline__ unsigned xb_add(unsigned* p, unsigned v) { return __hip_atomic_fetch_add(p, v, __ATOMIC_RELAXED, __HIP_MEMORY_SCOPE_AGENT); }
__device__ __forceinline__ unsigned xb_xcc_id() { return (unsigned)__builtin_amdgcn_s_getreg((3 << 11) | 20) & 0xFu; }
#define XB_SPIN(cond, bar) do { unsigned _sp = 0; while (cond) { __builtin_amdgcn_s_sleep(1); \
    if ((++_sp & 255u) == 0u) { if (xb_ld(&(bar)[XB_TMO])) break; if (_sp > XB_SPIN_CAP) { atomicAdd(&(bar)[XB_TMO], 1u); break; } } } } while (0)
struct XcdBarrier { unsigned* bar; unsigned x; unsigned total; volatile LAS unsigned* st; };
__device__ __forceinline__ XcdBarrier xcd_barrier_post(unsigned* bar, volatile LAS unsigned* st, unsigned total) {
    XcdBarrier b; b.bar = bar; b.x = xb_xcc_id(); b.total = total; b.st = st;
    if (threadIdx.x == 0) (void)xb_add(&bar[XB_XCNT(b.x)], 1u);
    return b;
}
__device__ __forceinline__ void xcd_barrier_complete(unsigned* bar, unsigned x, unsigned G, unsigned& nloc, unsigned& nx) {
    unsigned sum, cnt, mine, sp = 0u;
    for (;;) {
        sum = 0u; cnt = 0u; mine = 0u;
#pragma unroll
        for (unsigned j = 0; j < 16; ++j) { const unsigned c = xb_ld(&bar[XB_XCNT(j)]); sum += c; cnt += (c > 0u) ? 1u : 0u; mine = (j == x) ? c : mine; }
        if (sum == G) break;
        __builtin_amdgcn_s_sleep(1);
        if ((++sp & 255u) == 0u) { if (xb_ld(&bar[XB_TMO])) break; if (sp > XB_SPIN_CAP) { atomicAdd(&bar[XB_TMO], 1u); break; } }
    }
    nloc = mine > 0u ? mine : 1u; nx = cnt > 0u ? cnt : 1u;
}
template <class H> __device__ __forceinline__ void xcd_barrier_hook(const XcdBarrier& b, H&& hook) {
    asm volatile("s_waitcnt vmcnt(0)" ::: "memory");
    __syncthreads();
    unsigned nloc = 1u, nx = 1u, old = 0u, gen = 0u;
    if (threadIdx.x == 0) {
        __builtin_amdgcn_s_waitcnt(0);
        nloc = b.st[0]; nx = b.st[1];
        if (nloc == 0u) { xcd_barrier_complete(b.bar, b.x, b.total, nloc, nx); b.st[0] = nloc; b.st[1] = nx; }
        if (nx != 1u) { __builtin_amdgcn_fence(__ATOMIC_RELEASE, "agent"); asm volatile("s_waitcnt vmcnt(0)" ::: "memory"); }
        old = xb_add(&b.bar[XB_XSUB(b.x)], 1u); gen = old / nloc;
    }
    hook();
    if (threadIdx.x == 0) {
        unsigned* bar = b.bar;
        if (nx == 1u) { if (old + 1u != (gen + 1u) * nloc) XB_SPIN(xb_ld(&bar[XB_XSUB(b.x)]) < (gen + 1u) * nloc, bar); }
        else if (old + 1u == (gen + 1u) * nloc) {
            const unsigned og = xb_add(&bar[XB_TOP], 1u); const unsigned tg = og / nx;
            if (og + 1u == (tg + 1u) * nx) xb_add(&bar[XB_TOPGEN], 1u); else XB_SPIN(xb_ld(&bar[XB_TOPGEN]) == tg, bar);
            xb_add(&bar[XB_XGEN(b.x)], 1u);
        } else { XB_SPIN(xb_ld(&bar[XB_XGEN(b.x)]) == gen, bar); }
        __builtin_amdgcn_fence(__ATOMIC_ACQUIRE, "agent");
        asm volatile("s_waitcnt vmcnt(0)" ::: "memory");
    }
    __syncthreads();
}
__device__ __forceinline__ void xcd_barrier(const XcdBarrier& b) {
    asm volatile("s_waitcnt vmcnt(0)" ::: "memory");
    __syncthreads();
    if (threadIdx.x == 0) {
        unsigned* bar = b.bar;
        __builtin_amdgcn_s_waitcnt(0);
        unsigned nloc = b.st[0], nx = b.st[1];
        if (nloc == 0u) { xcd_barrier_complete(bar, b.x, b.total, nloc, nx); b.st[0] = nloc; b.st[1] = nx; }
        const unsigned old = xb_add(&bar[XB_XSUB(b.x)], 1u);
        const unsigned gen = old / nloc;
        if (nx == 1u) {
            if (old + 1u != (gen + 1u) * nloc) XB_SPIN(xb_ld(&bar[XB_XSUB(b.x)]) < (gen + 1u) * nloc, bar);
            __builtin_amdgcn_fence(__ATOMIC_ACQUIRE, "agent");
            asm volatile("s_waitcnt vmcnt(0)" ::: "memory");
        } else if (old + 1u == (gen + 1u) * nloc) {
            __builtin_amdgcn_fence(__ATOMIC_RELEASE, "agent");
            asm volatile("s_waitcnt vmcnt(0)" ::: "memory");
            const unsigned og = xb_add(&bar[XB_TOP], 1u);
            const unsigned tg = og / nx;
            if (og + 1u == (tg + 1u) * nx) xb_add(&bar[XB_TOPGEN], 1u);
            else XB_SPIN(xb_ld(&bar[XB_TOPGEN]) == tg, bar);
            __builtin_amdgcn_fence(__ATOMIC_ACQUIRE, "agent");
            xb_add(&bar[XB_XGEN(b.x)], 1u);
            asm volatile("s_waitcnt vmcnt(0)" ::: "memory");
        } else {
            XB_SPIN(xb_ld(&bar[XB_XGEN(b.x)]) == gen, bar);
            __builtin_amdgcn_fence(__ATOMIC_ACQUIRE, "agent");
            asm volatile("s_waitcnt vmcnt(0)" ::: "memory");
        }
    }
    __syncthreads();
}

struct Frame {
    LAS unsigned char* lds;
    int tid, lane, wave, bid, G;
    int b, li;
};
enum { I_X = 0, I_MIXG, I_WIN, I_QG, I_KG, I_SINK, I_RELB, I_CONVW, I_CONVB, I_DTB, I_ALOG, I_DSKIP, I_SSMG, I_WOUT, I_MLPG, I_WUP, I_WDOWN, I_OUT, I_WS, I_NPTR };
__device__ __forceinline__ GAS unsigned char* ptr_at(const Frame& F, int i) {
    const LAS unsigned* t = (const LAS unsigned*)(F.lds + PTR_OFF) + 2 * i;
    const unsigned lo = __builtin_amdgcn_readfirstlane(t[0]), hi = __builtin_amdgcn_readfirstlane(t[1]);
    return (GAS unsigned char*)(((unsigned long long)hi << 32) | lo);
}
#define FIN(i) ((const GAS float*)ptr_at(F, (i)))
#define FWS(off) (ptr_at(F, I_WS) + (off))
#define FB(off) (ptr_at(F, I_WS) + (WS_BATCH0 + (size_t)F.b * BATCH_STRIDE + (off)))
using pg8::shx;
__device__ __forceinline__ float shup(float v, int o, int lane) { return __builtin_bit_cast(float, __builtin_amdgcn_ds_bpermute(((lane - o) & 63) << 2, __builtin_bit_cast(int, v))); }
__device__ __forceinline__ float wave_sum(float v, int lane) {
#pragma unroll
    for (int o = 1; o < 64; o <<= 1) v += shx(v, o, lane);
    return v;
}

__device__ __forceinline__ void st_wt16(GAS v4u* p, v4u v) { asm volatile("global_store_dwordx4 %0, %1, off sc0 sc1" :: "v"(p), "v"(v) : "memory"); }
__device__ __forceinline__ void st_wt8(GAS v2u* p, v2u v) { asm volatile("global_store_dwordx2 %0, %1, off sc0 sc1" :: "v"(p), "v"(v) : "memory"); }
__device__ __forceinline__ void st_wt4(GAS float* p, float v) { asm volatile("global_store_dword %0, %1, off sc0 sc1" :: "v"(p), "v"(v) : "memory"); }
template <bool WT = false> __device__ __forceinline__ void tr_item(const GAS float* W, int Nsrc, int nsrc0, int nvalid, int K, const GAS float* gain, GAS bf16* WT_, int ndst0, int k0, LAS float* scr, int lane) {
    const int n = lane & 31;
    float tv[32];
#pragma unroll
    for (int i = 0; i < 32; ++i) { const int kk = 2 * i + (lane >> 5); tv[i] = __builtin_nontemporal_load(&W[(size_t)(k0 + kk) * Nsrc + nsrc0 + (n < nvalid ? n : 0)]); }
#pragma unroll
    for (int i = 0; i < 32; ++i) { const int kk = 2 * i + (lane >> 5); float v = (n < nvalid) ? tv[i] : 0.f; if (gain) v *= gain[k0 + kk];
        scr[kk * 33 + n] = v; }
    LDS_WAIT(); asm volatile("" ::: "memory");
    const int c = lane & 7;
#pragma unroll
    for (int j = 0; j < 4; ++j) { const int nn = (lane >> 3) + 8 * j; const LAS float* s = scr + (8 * c) * 33 + nn;
        v4u o; o.x = pk2(s[0 * 33], s[1 * 33]); o.y = pk2(s[2 * 33], s[3 * 33]); o.z = pk2(s[4 * 33], s[5 * 33]); o.w = pk2(s[6 * 33], s[7 * 33]);
        if (WT) st_wt16((GAS v4u*)(WT_ + (size_t)(ndst0 + nn) * K + k0 + 8 * c), o); else *(GAS v4u*)(WT_ + (size_t)(ndst0 + nn) * K + k0 + 8 * c) = o; }
    LDS_WAIT(); asm volatile("" ::: "memory");
}
template <bool WT = false> __device__ __forceinline__ void win_item(Frame& F, int L, int r, LAS float* scr);
constexpr int CW_PCNT = 8192 + 64 * 8;
template <int R> __device__ __forceinline__ void xr_load(f32x4 (&v)[4][4], const GAS float* x, int m0, int nW, int lane) {
#pragma unroll
    for (int r = 0; r < R; ++r) { const int m = m0 + r * nW;
        if (m < SEQ) { const GAS f32x4* xr = (const GAS f32x4*)(x + (size_t)m * D) + lane;
#pragma unroll
            for (int j = 0; j < 4; ++j) v[r][j] = __builtin_nontemporal_load(xr + 64 * j); } }
}
template <int R> __device__ __forceinline__ void xr_store(const f32x4 (&v)[4][4], GAS bf16* XB, GAS float* SSQ, int m0, int nW, int lane) {
#pragma unroll
    for (int r = 0; r < R; ++r) { const int m = m0 + r * nW;
        if (m < SEQ) { float t = 0.f;
#pragma unroll
            for (int j = 0; j < 4; ++j) t += (v[r][j].x * v[r][j].x + v[r][j].y * v[r][j].y) + (v[r][j].z * v[r][j].z + v[r][j].w * v[r][j].w);
            const float s = wave_sum(t, lane); GAS v2u* o8 = (GAS v2u*)(XB + (size_t)m * D) + lane;
#pragma unroll
            for (int j = 0; j < 4; ++j) { v2u o; o.x = pk2(v[r][j].x, v[r][j].y); o.y = pk2(v[r][j].z, v[r][j].w); st_wt8(o8 + 64 * j, o); }
            if (lane < 16) st_wt4(SSQ + (size_t)m * 16 + lane, (lane == 0) ? s : 0.f); } }
}
template <int K> __device__ __forceinline__ void xb_stage(Frame& F, f32x4 (&va)[4][4], f32x4 (&vb)[4][4], const GAS float* X, GAS bf16* XBw, GAS float* SSQw, unsigned* pcnt) {
    constexpr int RK[10] = {1, 2, 2, 2, 2, 3, 4, 4, 4, 1};
    constexpr int bb = K < 8 ? K : 7, K1 = K + 1, bb1 = K1 < 8 ? K1 : 7;
    const int myb = F.b;
    if (bb <= myb) {
        const int nW = (NGRP - bb) * GRP * NWAVES, m0 = ((myb - bb) * GRP + F.li) * NWAVES + F.wave + (K == 8 ? 4 * nW : 0);
        f32x4 (&cur)[4][4] = (K & 1) ? vb : va; f32x4 (&nx)[4][4] = (K & 1) ? va : vb;
        if (K1 < 9 && bb1 <= myb) { const int nW1 = (NGRP - bb1) * GRP * NWAVES, m1 = ((myb - bb1) * GRP + F.li) * NWAVES + F.wave + (K1 == 8 ? 4 * nW1 : 0);
            xr_load<RK[K1]>(nx, X + (size_t)bb1 * SEQ * D, m1, nW1, F.lane); }
        xr_store<RK[K]>(cur, XBw + (size_t)bb * SEQ * D, SSQw + (size_t)bb * SEQ * 16, m0, nW, F.lane);
        if (K != 7) {
            VM_WAIT(); __syncthreads();
            if (F.tid == 0) (void)xb_add(pcnt + 64 * bb, 1u);
        }
    }
}
__device__ __forceinline__ void p0_prologue(Frame& F) {
    LAS float* scr = (LAS float*)(F.lds + RING_OFF + F.wave * 16384);
    const int gw = F.bid * NWAVES + F.wave, NGW = F.G * NWAVES;
    constexpr int I_IN = 16 * 80, I_OUT = 16 * 32, I_UP = 16 * 128, I_DN = 64 * 32, I_L = I_IN + I_OUT + I_UP + I_DN;
    for (int it = gw; it < I_IN; it += NGW) win_item<true>(F, 0, it, scr);
    const GAS float* X = FIN(I_X); GAS bf16* XBw = (GAS bf16*)FWS(WS_XB); GAS float* SSQw = (GAS float*)FWS(WS_SSQ);
    unsigned* pcnt = (unsigned*)(unsigned char*)FWS(WS_CTL) + CW_PCNT;
    const int myb = F.b;
    f32x4 va[4][4], vb[4][4];
#pragma unroll
    for (int r = 0; r < 4; ++r)
#pragma unroll
        for (int j = 0; j < 4; ++j) { va[r][j] = (f32x4){0.f, 0.f, 0.f, 0.f}; vb[r][j] = (f32x4){0.f, 0.f, 0.f, 0.f}; }
    xr_load<1>(va, X, (myb * GRP + F.li) * NWAVES + F.wave, NGRP * GRP * NWAVES, F.lane);
    xb_stage<0>(F, va, vb, X, XBw, SSQw, pcnt); xb_stage<1>(F, va, vb, X, XBw, SSQw, pcnt); xb_stage<2>(F, va, vb, X, XBw, SSQw, pcnt);
    xb_stage<3>(F, va, vb, X, XBw, SSQw, pcnt); xb_stage<4>(F, va, vb, X, XBw, SSQw, pcnt); xb_stage<5>(F, va, vb, X, XBw, SSQw, pcnt);
    xb_stage<6>(F, va, vb, X, XBw, SSQw, pcnt); xb_stage<7>(F, va, vb, X, XBw, SSQw, pcnt); xb_stage<8>(F, va, vb, X, XBw, SSQw, pcnt);
    if (F.tid == 0) { unsigned sp = 0u;
        while (xb_ld(pcnt) < (unsigned)(NGRP * GRP) || xb_ld(pcnt + 64 * myb) < (unsigned)((NGRP - myb) * GRP)) { __builtin_amdgcn_s_sleep(1); if (++sp > (1u << 22)) break; }
        __builtin_amdgcn_fence(__ATOMIC_ACQUIRE, "agent"); VM_WAIT(); }
    __syncthreads();
}
constexpr int CW_WCNT = 8192, N_CONVERTERS = NGRP * (GRP - 16);
template <bool WT> __device__ __forceinline__ void win_item(Frame& F, int L, int r, LAS float* scr) {
    const int kb = r / 80, nb = r % 80; int src, nv = 32;
    if (nb < 16) src = nb * 32; else if (nb < 32) src = 768 + (nb - 16) * 32; else if (nb < 36) src = 512 + (nb - 32) * 32; else if (nb < 40) src = 640 + (nb - 36) * 32;
    else if (nb < 72) src = nb * 32; else if (nb == 72) { src = 2304; nv = 8; } else { src = 0; nv = 0; }
    tr_item<WT>(FIN(I_WIN) + (size_t)L * D * D_IN, D_IN, src, nv, D, FIN(I_MIXG) + L * D, (GAS bf16*)FWS(WS_WIN) + (size_t)L * NPROJ * D, nb * 32, kb * 64, scr, F.lane);
}
struct TrDesc { const GAS float* W; const GAS float* gain; GAS bf16* WT; int Nsrc, nsrc0, nvalid, K, ndst0, k0, has_gain; };
__device__ __forceinline__ void tr_load(const TrDesc& d, float (&tv)[32], f32x4& g0, f32x4& g1, int lane) {
    const int n = lane & 31, c = lane & 7;
#pragma unroll
    for (int i = 0; i < 32; ++i) { const int kk = 2 * i + (lane >> 5); tv[i] = __builtin_nontemporal_load(&d.W[(size_t)(d.k0 + kk) * d.Nsrc + d.nsrc0 + (n < d.nvalid ? n : 0)]); }
    const GAS float* gp = d.gain + (d.has_gain ? d.k0 : 0) + 8 * c;
    g0 = *(const GAS f32x4*)gp; g1 = *(const GAS f32x4*)(gp + 4);
}
__device__ __forceinline__ void tr_finish(const TrDesc& d, const float (&tv)[32], f32x4 g0, f32x4 g1, LAS float* scr, int lane) {
    const int n = lane & 31, c = lane & 7;
    if (!d.has_gain) { g0 = (f32x4){1.f, 1.f, 1.f, 1.f}; g1 = g0; }
#pragma unroll
    for (int i = 0; i < 32; ++i) { const int kk = 2 * i + (lane >> 5); scr[kk * 33 + n] = (n < d.nvalid) ? tv[i] : 0.f; }
    LDS_WAIT(); asm volatile("" ::: "memory");
#pragma unroll
    for (int j = 0; j < 4; ++j) { const int nn = (lane >> 3) + 8 * j; const LAS float* s = scr + (8 * c) * 33 + nn;
        v4u o; o.x = pk2(s[0 * 33] * g0.x, s[1 * 33] * g0.y); o.y = pk2(s[2 * 33] * g0.z, s[3 * 33] * g0.w); o.z = pk2(s[4 * 33] * g1.x, s[5 * 33] * g1.y); o.w = pk2(s[6 * 33] * g1.z, s[7 * 33] * g1.w);
        st_wt16((GAS v4u*)(d.WT + (size_t)(d.ndst0 + nn) * d.K + d.k0 + 8 * c), o); }
    LDS_WAIT(); asm volatile("" ::: "memory");
}
__device__ __forceinline__ void convert_rest(Frame& F, int slot) {
    LAS float* scr = (LAS float*)(F.lds + RING_OFF + F.wave * 16384);
    constexpr int I_IN = 16 * 80, I_OUT = 16 * 32, I_UP = 16 * 128, I_DN = 64 * 32, NCW = N_CONVERTERS * NWAVES;
    const GAS float *w_out = FIN(I_WOUT), *w_up = FIN(I_WUP), *mlp_g = FIN(I_MLPG), *w_down = FIN(I_WDOWN), *w_in = FIN(I_WIN), *mix_g = FIN(I_MIXG);
    GAS bf16 *WOUT = (GAS bf16*)FWS(WS_WOUT), *WUP = (GAS bf16*)FWS(WS_WUP), *WDOWN = (GAS bf16*)FWS(WS_WDOWN), *WINw = (GAS bf16*)FWS(WS_WIN);
    const int L = slot, n_items = I_OUT + I_UP + I_DN + (slot == 0 ? I_IN : 0);
    const int it0 = (F.b * (GRP - 16) + (F.li - 16)) * NWAVES + F.wave, last = it0 + ((n_items - 1 - it0) / NCW) * NCW, nit = (n_items + NCW - 1) / NCW;
    auto desc = [&](int j) -> TrDesc { int r = it0 + j * NCW; if (r > last) r = last; TrDesc d;
        if (r < I_OUT) { const int kb = r / 32, nb = r % 32; d = TrDesc{w_out + (size_t)L * D * D, mlp_g, WOUT + (size_t)L * D * D, D, nb * 32, 32, D, nb * 32, kb * 64, 0}; return d; }
        r -= I_OUT;
        if (r < I_UP) { const int kb = r / 128, nb = r % 128; d = TrDesc{w_up + (size_t)L * D * FF, mlp_g + L * D, WUP + (size_t)L * FF * D, FF, nb * 32, 32, D, nb * 32, kb * 64, 1}; return d; }
        r -= I_UP;
        if (r < I_DN) { const int kb = r / 32, nb = r % 32; d = TrDesc{w_down + (size_t)L * FF * D, mlp_g, WDOWN + (size_t)L * D * FF, D, nb * 32, 32, FF, nb * 32, kb * 64, 0}; return d; }
        r -= I_DN;
        { const int kb = r / 80, nb = r % 80; int src, nv = 32;
          if (nb < 16) src = nb * 32; else if (nb < 32) src = 768 + (nb - 16) * 32; else if (nb < 36) src = 512 + (nb - 32) * 32; else if (nb < 40) src = 640 + (nb - 36) * 32;
          else if (nb < 72) src = nb * 32; else if (nb == 72) { src = 2304; nv = 8; } else { src = 0; nv = 0; }
          d = TrDesc{w_in + (size_t)1 * D * D_IN, mix_g + 1 * D, WINw + (size_t)1 * NPROJ * D, D_IN, src, nv, D, nb * 32, kb * 64, 1}; return d; } };
    float ta[32], tb[32]; f32x4 ga0, ga1, gb0, gb1;
    TrDesc da = desc(0), db;
    tr_load(da, ta, ga0, ga1, F.lane);
    for (int k = 0; k < nit; k += 2) {
        db = desc(k + 1); tr_load(db, tb, gb0, gb1, F.lane); tr_finish(da, ta, ga0, ga1, scr, F.lane);
        da = desc(k + 2); tr_load(da, ta, ga0, ga1, F.lane); tr_finish(db, tb, gb0, gb1, scr, F.lane);
    }
    asm volatile("s_waitcnt vmcnt(0)" ::: "memory");
    __syncthreads();
    if (F.tid == 0) (void)xb_add((unsigned*)(unsigned char*)FWS(WS_CTL) + CW_WCNT + 64 * slot, 1u);
}
__device__ __forceinline__ void wait_weights(Frame& F, int part) {
    if (F.tid == 0) { unsigned* wc = (unsigned*)(unsigned char*)FWS(WS_CTL) + CW_WCNT + 64 * part; unsigned sp = 0u;
        while (xb_ld(wc) < (unsigned)N_CONVERTERS) { __builtin_amdgcn_s_sleep(2); if (++sp > (1u << 22)) break; }
        __builtin_amdgcn_fence(__ATOMIC_ACQUIRE, "agent"); asm volatile("s_waitcnt vmcnt(0)" ::: "memory"); }
    __syncthreads();
}
__device__ __forceinline__ void rstd_prepass(Frame& F, const pg8::GroupOrder& S, LAS float* tab) {
    const GAS float* SSQ = (const GAS float*)FWS(WS_SSQ) + (size_t)F.b * SEQ * 16;
    pg8::Unit u;
    for (int i = 0; i < 4 && S.next(i, u); ++i) {
        const int r = F.tid >> 1, h = F.tid & 1;
        const GAS f32x4* p = (const GAS f32x4*)(SSQ + (size_t)(u.pm * 256 + r) * 16 + h * 8);
        const f32x4 a = p[0], b = p[1];
        float s = (a.x + a.y) + (a.z + a.w) + (b.x + b.y) + (b.z + b.w);
        s += shx(s, 1, F.lane);
        if (h == 0) tab[i * 256 + r] = 1.0f / sqrtf(s * (1.0f / D) + EPS);
    }
    LDS_WAIT(); __syncthreads();
}
__device__ __forceinline__ int t5_bucket(int d) {
    if (d < 16) return d;
    return 16 + (d >= 19) + (d >= 21) + (d >= 24) + (d >= 27) + (d >= 31) + (d >= 35) + (d >= 40) + (d >= 46) + (d >= 52) + (d >= 59) + (d >= 67) + (d >= 77) + (d >= 87) + (d >= 99) + (d >= 113);
}
__device__ __forceinline__ void ld8(const GAS bf16* p, float (&v)[8]) {
    const v4u w = *(const GAS v4u*)p;
    v[0] = bflo(w.x); v[1] = bfhi(w.x); v[2] = bflo(w.y); v[3] = bfhi(w.y); v[4] = bflo(w.z); v[5] = bfhi(w.z); v[6] = bflo(w.w); v[7] = bfhi(w.w);
}
#define GRP_OBJ()  XcdBarrier{(unsigned*)(unsigned char*)FWS(WS_CTL) + CW_GRP + (blockIdx.x & 7) * GRP_BAR_STRIDE, xb_xcc_id(), (unsigned)GRP, (volatile LAS unsigned*)(F.lds + MISC_OFF) + 12}
typedef short bf16x8_t __attribute__((ext_vector_type(8)));
typedef float f32x16 __attribute__((ext_vector_type(16)));
constexpr float LOG2E = 1.4426950408889634f;
__device__ __forceinline__ unsigned pkbf(float lo, float hi) { return pg8::cvt_pk_bf16(lo, hi); }
__device__ __forceinline__ int crow32(int i, int hh) { return (i & 3) + 8 * (i >> 2) + 4 * hh; }
__device__ __forceinline__ float silu_fast(float v) { return v * __builtin_amdgcn_rcpf(1.0f + __builtin_amdgcn_exp2f(-v * LOG2E)); }
__device__ __forceinline__ void unpk8(const v4u w, float (&v)[8]) {
    v[0] = bflo(w.x); v[1] = bfhi(w.x); v[2] = bflo(w.y); v[3] = bfhi(w.y); v[4] = bflo(w.z); v[5] = bfhi(w.z); v[6] = bflo(w.w); v[7] = bfhi(w.w);
}

typedef short v4i16_t __attribute__((ext_vector_type(4)));
template <int RH, int RSEC> __device__ __forceinline__ bf16x8_t tr_frag(const LAS unsigned char* img, int stride, int rbase, int cbase, int lane) {
    const LAS unsigned char* p = img + (rbase + RH * (lane >> 5) + ((lane & 15) >> 2)) * stride + (cbase + 16 * ((lane >> 4) & 1) + 4 * (lane & 3)) * 2;
    const v4i16_t a = __builtin_amdgcn_ds_read_tr16_b64_v4i16((LAS v4i16_t*)p), b = __builtin_amdgcn_ds_read_tr16_b64_v4i16((LAS v4i16_t*)(p + RSEC * stride));
    return (bf16x8_t){a[0], a[1], a[2], a[3], b[0], b[1], b[2], b[3]};
}
constexpr int AT_KS = 0, AT_KSTRIDE = 144, AT_VT = 36864, AT_VSTRIDE = 192, AT_BIAS = AT_VT + 256 * AT_VSTRIDE;
constexpr int AT_BN = 192, AT_END = AT_BIAS + 4 * AT_BN * 4;
static_assert(AT_END <= MIX_BYTES, "attention LDS");
__device__ __forceinline__ void attn_fast(Frame& F, int L, bool dummy = false) {
    GAS bf16* PROJ = (GAS bf16*)FB(BO_PROJ);
    const GAS float* qg = FIN(I_QG) + L * 64; const GAS float* kg = FIN(I_KG) + L * 64; const GAS float* sinks = FIN(I_SINK) + L * 8; const GAS float* rel_bias = FIN(I_RELB);
    LAS unsigned char* Ks = F.lds + AT_KS; LAS unsigned char* Vt = F.lds + AT_VT; LAS float* biasR = (LAS float*)(F.lds + AT_BIAS);
    const int tid = F.tid, lane = F.lane, wave = F.wave, q = lane & 31, hh = lane >> 5;
    const int unit = F.li, kvh = unit >> 4, qb = unit & 15, m0 = qb * 128;
    const int gi = wave >> 1, qh = wave & 1, hq = kvh * 4 + gi;
    v4u qraw[2][4];
#pragma unroll
    for (int s = 0; s < 2; ++s)
#pragma unroll
        for (int d0 = 0; d0 < 4; ++d0) qraw[s][d0] = *(const GAS v4u*)(PROJ + (size_t)(m0 + 64 * qh + 32 * s + q) * PP + CQ + hq * 64 + d0 * 16 + hh * 8);
    v4u kwv[4], vwv[4];
#pragma unroll
    for (int i = 0; i < 4; ++i) { const int c = tid + NTHREADS * i, key = c >> 3, part = c & 7; const bool valid = (qb > 0) || (key >= 128); const unsigned msk = valid ? 0xffffffffu : 0u;
        const GAS bf16* kp = PROJ + (size_t)(valid ? m0 + key - 128 : 0) * PP + CK + kvh * 64 + part * 8;
        v4u a_ = *(const GAS v4u*)kp, b_ = *(const GAS v4u*)(kp + (CV - CK));
        a_.x &= msk; a_.y &= msk; a_.z &= msk; a_.w &= msk; b_.x &= msk; b_.y &= msk; b_.z &= msk; b_.w &= msk; kwv[i] = a_; vwv[i] = b_; }
    const f32x4 kg0 = *(const GAS f32x4*)(kg + (tid & 7) * 8), kg1 = *(const GAS f32x4*)(kg + (tid & 7) * 8 + 4);
    f32x4 qgv[4][2];
#pragma unroll
    for (int d0 = 0; d0 < 4; ++d0) { qgv[d0][0] = *(const GAS f32x4*)(qg + d0 * 16 + hh * 8); qgv[d0][1] = *(const GAS f32x4*)(qg + d0 * 16 + hh * 8 + 4); }
    const float sinkv = sinks[hq];
    float bent[2];
#pragma unroll
    for (int k = 0; k < 2; ++k) { const int x = tid + NTHREADS * k, g_ = x / AT_BN, xx = x - g_ * AT_BN; const bool ok = (x < 4 * AT_BN) && (xx >= 32) && (xx < 160);
        const float v = rel_bias[t5_bucket(ok ? 159 - xx : 0) * 8 + kvh * 4 + (ok ? g_ : 0)]; bent[k] = ok ? v * LOG2E : 0.f; }
    __syncthreads();
    biasR[tid] = bent[0]; if (tid + NTHREADS < 4 * AT_BN) biasR[tid + NTHREADS] = bent[1];
#pragma unroll
    for (int i = 0; i < 4; ++i) {
        const int c = tid + NTHREADS * i, key = c >> 3, part = c & 7;
        const v4u kw = kwv[i], vw = vwv[i];
        float kv[8]; unpk8(kw, kv);
        float ss = 0.f;
#pragma unroll
        for (int e = 0; e < 8; ++e) ss += kv[e] * kv[e];
        ss += shx(ss, 1, lane); ss += shx(ss, 2, lane); ss += shx(ss, 4, lane);
        const float rk = __builtin_amdgcn_rsqf(ss * (1.0f / 64.0f) + EPS);
        const f32x4 g0 = kg0, g1 = kg1;
        v4u ko; ko.x = pkbf(kv[0] * rk * g0.x, kv[1] * rk * g0.y); ko.y = pkbf(kv[2] * rk * g0.z, kv[3] * rk * g0.w); ko.z = pkbf(kv[4] * rk * g1.x, kv[5] * rk * g1.y); ko.w = pkbf(kv[6] * rk * g1.z, kv[7] * rk * g1.w);
        *(LAS v4u*)(Ks + key * AT_KSTRIDE + part * 16) = ko;
        *(LAS v4u*)(Vt + key * AT_VSTRIDE + part * 16) = vw;
    }
    LDS_WAIT(); __syncthreads();
    const float sink2 = sinkv * LOG2E;
    const LAS float* bb = biasR + gi * AT_BN + 31 - q + 4 * hh;
    const int qm = q - 4 * hh;
#pragma unroll
    for (int s = 0; s < 2; ++s) {
        const int a = 64 * qh + 32 * s;
        GAS bf16* qrow = PROJ + (size_t)(m0 + a + q) * PP + CQ + hq * 64;
        float qv[4][8]; float ss = 0.f;
#pragma unroll
        for (int d0 = 0; d0 < 4; ++d0) { unpk8(qraw[s][d0], qv[d0]);
#pragma unroll
            for (int e = 0; e < 8; ++e) ss += qv[d0][e] * qv[d0][e]; }
        ss += shx(ss, 32, lane);
        const float rq = __builtin_amdgcn_rsqf(ss * (1.0f / 64.0f) + EPS) * (0.125f * LOG2E);
        bf16x8_t qf[4];
#pragma unroll
        for (int d0 = 0; d0 < 4; ++d0) { const f32x4 g0 = qgv[d0][0], g1 = qgv[d0][1];
            v4u w; w.x = pkbf(qv[d0][0] * rq * g0.x, qv[d0][1] * rq * g0.y); w.y = pkbf(qv[d0][2] * rq * g0.z, qv[d0][3] * rq * g0.w);
            w.z = pkbf(qv[d0][4] * rq * g1.x, qv[d0][5] * rq * g1.y); w.w = pkbf(qv[d0][6] * rq * g1.z, qv[d0][7] * rq * g1.w);
            qf[d0] = __builtin_bit_cast(bf16x8_t, w); }
        const int kt_lo = (qb == 0) ? 4 - (a >> 5) : 0;
        f32x16 S[5]; float mx = sink2;
#pragma unroll
        for (int kt = 0; kt < 5; ++kt) { f32x16 acc = {};
#pragma unroll
            for (int d0 = 0; d0 < 4; ++d0) { const bf16x8_t kf = *(const LAS bf16x8_t*)(Ks + (a + 32 * kt + q) * AT_KSTRIDE + d0 * 32 + hh * 16);
                acc = __builtin_amdgcn_mfma_f32_32x32x16_bf16(kf, qf[d0], acc, 0, 0, 0); }
            if (kt < kt_lo) {
#pragma unroll
                for (int i = 0; i < 16; ++i) acc[i] = -INFINITY;
            } else {
#pragma unroll
                for (int i = 0; i < 16; ++i) { const int t0 = (i & 3) + 8 * (i >> 2); float v = acc[i] + bb[32 * kt + t0];
                    if (kt == 0) v = fminf(v, (t0 > qm) ? INFINITY : -INFINITY);
                    if (kt == 4) v = fminf(v, (t0 <= qm) ? INFINITY : -INFINITY);
                    acc[i] = v; mx = fmaxf(mx, v); } }
            S[kt] = acc; }
        mx = fmaxf(mx, shx(mx, 32, lane));
        float lsum = 0.f; bf16x8_t pf[5][2];
#pragma unroll
        for (int kt = 0; kt < 5; ++kt) {
#pragma unroll
            for (int i = 0; i < 16; ++i) { const float p = __builtin_amdgcn_exp2f(S[kt][i] - mx); S[kt][i] = p; lsum += p; }
#pragma unroll
            for (int s2 = 0; s2 < 2; ++s2) { v4u w; w.x = pkbf(S[kt][8 * s2 + 0], S[kt][8 * s2 + 1]); w.y = pkbf(S[kt][8 * s2 + 2], S[kt][8 * s2 + 3]);
                w.z = pkbf(S[kt][8 * s2 + 4], S[kt][8 * s2 + 5]); w.w = pkbf(S[kt][8 * s2 + 6], S[kt][8 * s2 + 7]); pf[kt][s2] = __builtin_bit_cast(bf16x8_t, w); } }
        lsum += shx(lsum, 32, lane);
        lsum += __builtin_amdgcn_exp2f(sink2 - mx);
        f32x16 O[2] = {{}, {}};
#pragma unroll
        for (int kt = 0; kt < 5; ++kt)
#pragma unroll
            for (int s2 = 0; s2 < 2; ++s2)
#pragma unroll
                for (int db = 0; db < 2; ++db)
                    O[db] = __builtin_amdgcn_mfma_f32_32x32x16_bf16(tr_frag<4, 8>(Vt, AT_VSTRIDE, a + 32 * kt + 16 * s2, 32 * db, lane), pf[kt][s2], O[db], 0, 0, 0);
        const float inv = __builtin_amdgcn_rcpf(lsum);
#pragma unroll
        for (int db = 0; db < 2; ++db)
#pragma unroll
            for (int g4 = 0; g4 < 4; ++g4) { v2u w; w.x = pkbf(O[db][4 * g4] * inv, O[db][4 * g4 + 1] * inv); w.y = pkbf(O[db][4 * g4 + 2] * inv, O[db][4 * g4 + 3] * inv);
                GAS bf16* orow = dummy ? (GAS bf16*)FB(BO_PREV) + (size_t)(m0 + a + q) * 512 + hq * 64 : qrow;
                *(GAS v2u*)(orow + 32 * db + 8 * g4 + 4 * hh) = w; }
    }
}

constexpr size_t WS_DTV = 3 * MiB + 512 * 1024;
constexpr int SD_ROW = 272, SD_XT = 264;
template <int NR> struct Raw8 { v4u u[NR + 3]; };
template <int NR> struct Raw4 { v2u u[NR + 3]; };
struct ConvW8 { f32x4 w[4][2], b[2]; };
struct ConvW4 { f32x4 w[4], b; };
template <int NR> __device__ __forceinline__ void conv_load(Raw8<NR>& R, const GAS bf16* PROJ, int m0, int c, int l0, int col0) {
#pragma unroll
    for (int i = 0; i < NR + 3; ++i) { const int row = l0 - 3 + i; const bool ok = (c > 0) || (row >= 0); const unsigned msk = ok ? 0xffffffffu : 0u;
        v4u x = *(const GAS v4u*)(PROJ + (size_t)(m0 + (ok ? row : 0)) * PP + col0); x.x &= msk; x.y &= msk; x.z &= msk; x.w &= msk; R.u[i] = x; }
}
template <int NR> __device__ __forceinline__ void conv_load(Raw4<NR>& R, const GAS bf16* PROJ, int m0, int c, int l0, int col0) {
#pragma unroll
    for (int i = 0; i < NR + 3; ++i) { const int row = l0 - 3 + i; const bool ok = (c > 0) || (row >= 0); const unsigned msk = ok ? 0xffffffffu : 0u;
        v2u x = *(const GAS v2u*)(PROJ + (size_t)(m0 + (ok ? row : 0)) * PP + col0); x.x &= msk; x.y &= msk; R.u[i] = x; }
}
__device__ __forceinline__ void convw_load(ConvW8& W, const GAS float* cw, const GAS float* cb) {
#pragma unroll
    for (int k = 0; k < 4; ++k) { W.w[k][0] = *(const GAS f32x4*)(cw + k * 1024); W.w[k][1] = *(const GAS f32x4*)(cw + k * 1024 + 4); }
    W.b[0] = *(const GAS f32x4*)cb; W.b[1] = *(const GAS f32x4*)(cb + 4);
}
__device__ __forceinline__ void convw_load(ConvW4& W, const GAS float* cw, const GAS float* cb) {
#pragma unroll
    for (int k = 0; k < 4; ++k) W.w[k] = *(const GAS f32x4*)(cw + k * 1024);
    W.b = *(const GAS f32x4*)cb;
}
template <int NR> __device__ __forceinline__ void conv_row(const Raw8<NR>& R, const ConvW8& W, int r, float (&out)[8]) {
    float acc[8];
#pragma unroll
    for (int e = 0; e < 8; ++e) acc[e] = W.b[e >> 2][e & 3];
#pragma unroll
    for (int k = 0; k < 4; ++k) { float u[8]; unpk8(R.u[r + k], u);
#pragma unroll
        for (int e = 0; e < 8; ++e) acc[e] += W.w[k][e >> 2][e & 3] * u[e]; }
#pragma unroll
    for (int e = 0; e < 8; ++e) out[e] = silu_fast(acc[e]);
}
template <int NR> __device__ __forceinline__ void conv_row(const Raw4<NR>& R, const ConvW4& W, int r, float (&out)[4]) {
    float acc[4];
#pragma unroll
    for (int e = 0; e < 4; ++e) acc[e] = W.b[e];
#pragma unroll
    for (int k = 0; k < 4; ++k) { const v2u x = R.u[r + k]; const float u[4] = {bflo(x.x), bfhi(x.x), bflo(x.y), bfhi(x.y)};
#pragma unroll
        for (int e = 0; e < 4; ++e) acc[e] += W.w[k][e] * u[e]; }
#pragma unroll
    for (int e = 0; e < 4; ++e) out[e] = silu_fast(acc[e]);
}
constexpr int P_XSTR = 576, P_BSTR = 304, P_XD = 0, P_BM = P_XD + 128 * P_XSTR, P_CM = P_BM + 128 * P_BSTR, P_FREE = P_CM + 128 * SD_ROW, P_DT = MIX_BYTES - 4096, P_ACS = P_DT + 2048;
static_assert(P_FREE + 4096 <= P_DT, "SSD LDS map");
__device__ __forceinline__ bf16x8_t scale_frag(bf16x8_t f, const f32x4 s0, const f32x4 s1) {
    const v4u w = __builtin_bit_cast(v4u, f); v4u o;
    o.x = pkbf(bflo(w.x) * s0.x, bfhi(w.x) * s0.y); o.y = pkbf(bflo(w.y) * s0.z, bfhi(w.y) * s0.w); o.z = pkbf(bflo(w.z) * s1.x, bfhi(w.z) * s1.y); o.w = pkbf(bflo(w.w) * s1.z, bfhi(w.w) * s1.w);
    return __builtin_bit_cast(bf16x8_t, o);
}
constexpr int S1_W = P_FREE, S1_WT = S1_W + 2048;
__device__ __forceinline__ void ssd_states(Frame& F, int L) {
    const GAS bf16* PROJ = (const GAS bf16*)FB(BO_PROJ);
    const GAS float* conv_w = FIN(I_CONVW) + (size_t)L * 4 * 1024; const GAS float* conv_b = FIN(I_CONVB) + L * 1024;
    const GAS float* dt_bias = FIN(I_DTB) + L * 8; const GAS float* a_log = FIN(I_ALOG) + L * 8;
    const GAS float* DTRAW = (const GAS float*)FWS(WS_DTRAW) + (size_t)F.b * SEQ * 8; GAS float* CHDEC = (GAS float*)FWS(WS_CHDEC) + F.b * 128;
    GAS bf16* STATES = (GAS bf16*)FB(BO_STATES);
    LAS unsigned char* XD = F.lds + P_XD; LAS unsigned char* BM = F.lds + P_BM;
    LAS float* dt_l = (LAS float*)(F.lds + P_DT); LAS float* acs_l = (LAS float*)(F.lds + P_ACS); LAS float* w_l = (LAS float*)(F.lds + S1_W); LAS float* wt = (LAS float*)(F.lds + S1_WT);
    const int wave = F.wave, unit = F.li, c = unit >> 1, g = unit & 1, m0 = c * 128;
    int tid = F.tid; asm volatile("" : "+v"(tid));
    int lane = tid & 63, q = lane & 31, hh = lane >> 5;
    const int xcg = tid & 31, xl0 = (tid >> 5) * 8, xcol = CX + g * 256 + xcg * 8;
    const int bcg = tid & 31, bl0 = (tid >> 5) * 8, isC = bcg >> 4, bn0 = (bcg & 15) * 8, bcol = (isC ? CCM : CBM) + g * 128 + bn0;
    Raw8<8> xr; ConvW8 xw; Raw8<8> br; ConvW8 bw;
    conv_load(xr, PROJ, m0, c, xl0, xcol); convw_load(xw, conv_w + (xcol - CX), conv_b + (xcol - CX));
    conv_load(br, PROJ, m0, c, bl0, bcol); convw_load(bw, conv_w + (bcol - CX), conv_b + (bcol - CX));
    const int ar = tid >> 7, al = tid & 127, ahead = 4 * g + ar;
    const float dtraw = DTRAW[(size_t)(m0 + al) * 8 + ahead], dtb = dt_bias[ahead], alog = a_log[ahead];
    __syncthreads();
    float acs_v;
    { const float dtv = softplus_f(dtraw + dtb);
      float v = dtv * (-expf(alog));
#pragma unroll
      for (int o = 1; o < 64; o <<= 1) { const float t = shup(v, o, lane); if (lane >= o) v += t; }
      if (lane == 63) wt[wave] = v;
      LDS_WAIT(); __syncthreads();
      if (wave & 1) v += wt[wave - 1];
      dt_l[tid] = dtv; acs_l[tid] = v * LOG2E; acs_v = v * LOG2E;
      if (al == 127) CHDEC[c * 8 + ahead] = expf(v); }
#pragma unroll
    for (int r = 0; r < 8; ++r) { float o[8]; conv_row(br, bw, r, o);
        v4u pk; pk.x = pkbf(o[0], o[1]); pk.y = pkbf(o[2], o[3]); pk.z = pkbf(o[4], o[5]); pk.w = pkbf(o[6], o[7]);
        *(LAS v4u*)(isC ? F.lds + P_CM + (bl0 + r) * SD_ROW + bn0 * 2 : BM + (bl0 + r) * P_BSTR + bn0 * 2) = pk; }
    LDS_WAIT(); __syncthreads();
    w_l[tid] = __builtin_amdgcn_exp2f(acs_l[ar * 128 + 127] - acs_v);
    { const int r4 = xcg >> 3;
#pragma unroll
      for (int r = 0; r < 8; ++r) { float o[8]; conv_row(xr, xw, r, o); const int l = xl0 + r; const float sc = dt_l[r4 * 128 + l];
          v4u pk; pk.x = pkbf(o[0] * sc, o[1] * sc); pk.y = pkbf(o[2] * sc, o[3] * sc); pk.z = pkbf(o[4] * sc, o[5] * sc); pk.w = pkbf(o[6] * sc, o[7] * sc);
          *(LAS v4u*)(XD + l * P_XSTR + xcg * 16) = pk; } }
    LDS_WAIT(); __syncthreads();
    asm volatile("" : "+v"(tid)); lane = tid & 63; q = lane & 31; hh = lane >> 5;
    { const int r4 = wave >> 1, nt0 = (wave & 1) * 2, head = 4 * g + r4;
      f32x16 St[2][2] = {{{}, {}}, {{}, {}}};
#pragma unroll
      for (int ks = 0; ks < 8; ++ks) { bf16x8_t af[2], bfr[2];
          const f32x4 w0 = *(const LAS f32x4*)(w_l + r4 * 128 + 16 * ks + 8 * hh), w1 = *(const LAS f32x4*)(w_l + r4 * 128 + 16 * ks + 8 * hh + 4);
#pragma unroll
          for (int pt = 0; pt < 2; ++pt) af[pt] = tr_frag<8, 4>(XD, P_XSTR, 16 * ks, r4 * 64 + 32 * pt, lane);
#pragma unroll
          for (int nn = 0; nn < 2; ++nn) bfr[nn] = scale_frag(tr_frag<8, 4>(BM, P_BSTR, 16 * ks, 32 * (nt0 + nn), lane), w0, w1);
#pragma unroll
          for (int pt = 0; pt < 2; ++pt)
#pragma unroll
              for (int nn = 0; nn < 2; ++nn) St[pt][nn] = __builtin_amdgcn_mfma_f32_32x32x16_bf16(af[pt], bfr[nn], St[pt][nn], 0, 0, 0); }
      GAS bf16* sp = STATES + ((size_t)c * 8 + head) * 8192 + 32 * nt0 + q;
#pragma unroll
      for (int pt = 0; pt < 2; ++pt)
#pragma unroll
          for (int nn = 0; nn < 2; ++nn)
#pragma unroll
              for (int e = 0; e < 16; e += 2) { const unsigned w = pkbf(St[pt][nn][e], St[pt][nn][e + 1]);
                  sp[(32 * pt + crow32(e, hh)) * 128 + 32 * nn] = (bf16)(w & 0xffffu); sp[(32 * pt + crow32(e + 1, hh)) * 128 + 32 * nn] = (bf16)(w >> 16); } }
}
__device__ __forceinline__ void ssd_scan(Frame& F, int L) {
    const GAS bf16* STATES = (const GAS bf16*)FB(BO_STATES); const GAS float* CHDEC = (const GAS float*)FWS(WS_CHDEC) + F.b * 128; GAS bf16* PREV = (GAS bf16*)FB(BO_PREV);
    for (int idx = F.li * NTHREADS + F.tid; idx < 8 * 64 * 32; idx += GRP * NTHREADS) {
        const int n4 = idx & 31, p = (idx >> 5) & 63, head = idx >> 11;
        v2u s[16]; float dec[16];
#pragma unroll
        for (int c = 0; c < 16; ++c) { const size_t o = ((size_t)c * 8 + head) * 8192 + p * 128 + 4 * n4; s[c] = *(const GAS v2u*)(STATES + o); dec[c] = CHDEC[c * 8 + head]; }
        f32x4 h = {0.f, 0.f, 0.f, 0.f};
#pragma unroll
        for (int c = 0; c < 16; ++c) { const size_t o = ((size_t)c * 8 + head) * 8192 + p * 128 + 4 * n4;
            v2u w; w.x = pkbf(h.x, h.y); w.y = pkbf(h.z, h.w); *(GAS v2u*)(PREV + o) = w;
            const f32x4 sv = {bflo(s[c].x), bfhi(s[c].x), bflo(s[c].y), bfhi(s[c].y)};
            h = h * dec[c] + sv; }
    }
}
constexpr int S3_PV = P_BM, S3_PVH = 64 * SD_ROW, S3_Z = S3_PV + 2 * S3_PVH, S3_NG = P_FREE, S3_RSS = S3_NG + 1024;
static_assert(S3_Z + 128 * SD_ROW <= P_FREE && S3_RSS + 2048 <= P_DT && 128 * 528 <= P_DT, "SSD part 3 LDS");
struct SsdCarry { f32x16 cbT[4]; bf16x8_t cf[8]; f32x16 Od[2][2]; };
__device__ __forceinline__ void ssd_cbt(Frame& F, SsdCarry& K) {
    const LAS unsigned char* Cm = F.lds + P_CM; const LAS unsigned char* Bm = F.lds + P_BM;
    int tid = F.tid; asm volatile("" : "+v"(tid));
    const int lane = tid & 63, q = lane & 31, hh = lane >> 5, wave = F.wave, j = (wave < 4) ? (wave & 3) : 3 - (wave & 3);
#pragma unroll
    for (int ks = 0; ks < 8; ++ks) K.cf[ks] = *(const LAS bf16x8_t*)(Cm + (32 * j + q) * SD_ROW + (16 * ks + 8 * hh) * 2);
#pragma unroll
    for (int i = 0; i < 4; ++i) { f32x16 acc = {};
        if (i <= j) {
#pragma unroll
            for (int ks = 0; ks < 8; ++ks) { const bf16x8_t bfr = *(const LAS bf16x8_t*)(Bm + (32 * i + q) * P_BSTR + (16 * ks + 8 * hh) * 2);
                acc = __builtin_amdgcn_mfma_f32_32x32x16_bf16(bfr, K.cf[ks], acc, 0, 0, 0); } }
        K.cbT[i] = acc; }
}
__device__ __forceinline__ void ssd_ydiag(Frame& F, int L, SsdCarry& K, int hp) {
    const GAS float* d_skip = FIN(I_DSKIP) + L * 8; const LAS unsigned char* XD = F.lds + P_XD;
    const LAS float* dt_l = (const LAS float*)(F.lds + P_DT); const LAS float* acs_l = (const LAS float*)(F.lds + P_ACS);
    int tid = F.tid; asm volatile("" : "+v"(tid));
    const int lane = tid & 63, q = lane & 31, hh = lane >> 5, wave = F.wave, j = (wave < 4) ? (wave & 3) : 3 - (wave & 3), h2 = wave >> 2, g = F.li & 1, r = 2 * hp + h2;
    f32x16 (&cbT)[4] = K.cbT; f32x16 (&O)[2] = K.Od[hp];
    O[0] = f32x16{}; O[1] = f32x16{};

        const float acl = acs_l[r * 128 + 32 * j + q], diag = d_skip[4 * g + r] * __builtin_amdgcn_rcpf(dt_l[r * 128 + 32 * j + q]);
        const int qm = q - 4 * hh;
#pragma unroll
        for (int i = 0; i < 4; ++i) { if (i <= j) {
            float xv[16];
            const LAS float* ap = acs_l + r * 128 + 32 * i + 4 * hh;
            float av[16];
#pragma unroll
            for (int e = 0; e < 16; ++e) av[e] = ap[(e & 3) + 8 * (e >> 2)];
            if (i < j) {
#pragma unroll
                for (int e = 0; e < 16; ++e) xv[e] = cbT[i][e] * __builtin_amdgcn_exp2f(acl - av[e]);
            } else {
#pragma unroll
                for (int e = 0; e < 16; ++e) { const int t0 = (e & 3) + 8 * (e >> 2);
                    const float m01 = (t0 <= qm) ? 1.0f : 0.0f, dg = (t0 == qm) ? diag : 0.0f;
                    xv[e] = cbT[i][e] * __builtin_amdgcn_exp2f(fminf(acl - av[e], 0.f)) * m01 + dg; } }
#pragma unroll
            for (int s2 = 0; s2 < 2; ++s2) { v4u w; w.x = pkbf(xv[8 * s2 + 0], xv[8 * s2 + 1]); w.y = pkbf(xv[8 * s2 + 2], xv[8 * s2 + 3]); w.z = pkbf(xv[8 * s2 + 4], xv[8 * s2 + 5]); w.w = pkbf(xv[8 * s2 + 6], xv[8 * s2 + 7]);
                const bf16x8_t xf = __builtin_bit_cast(bf16x8_t, w);
#pragma unroll
                for (int pt = 0; pt < 2; ++pt)
                    O[pt] = __builtin_amdgcn_mfma_f32_32x32x16_bf16(tr_frag<4, 8>(XD, P_XSTR, 32 * i + 16 * s2, 64 * r + 32 * pt, lane), xf, O[pt], 0, 0, 0); } } } }
__device__ __forceinline__ void ssd_out(Frame& F, int L, SsdCarry& K) {
    GAS bf16* PROJ = (GAS bf16*)FB(BO_PROJ); const GAS bf16* PREV = (const GAS bf16*)FB(BO_PREV);
    const GAS float* d_skip = FIN(I_DSKIP) + L * 8; const GAS float* ssm_g = FIN(I_SSMG) + L * 512;
    LAS unsigned char* Cm = F.lds + P_CM; LAS unsigned char* Bm = F.lds + P_BM; LAS unsigned char* Zt = F.lds + S3_Z; const LAS unsigned char* XD = F.lds + P_XD;
    LAS float* dt_l = (LAS float*)(F.lds + P_DT); LAS float* acs_l = (LAS float*)(F.lds + P_ACS); LAS float* rss = (LAS float*)(F.lds + S3_RSS); LAS float* ng_l = (LAS float*)(F.lds + S3_NG);
    const int wave = F.wave, unit = F.li, c = unit >> 1, g = unit & 1, m0 = c * 128;
    int tid = F.tid; asm volatile("" : "+v"(tid));
    int lane = tid & 63, q = lane & 31, hh = lane >> 5;
    float ng_in;
    v4u pw[4], zw[4];
#define S3_LOAD_P(hp_) do { _Pragma("unroll") for (int k = 0; k < 4; ++k) { const int ch = tid + NTHREADS * k; const int hd = ch >> 10, rem = ch & 1023, p = rem >> 4, n8 = rem & 15; \
            pw[k] = *(const GAS v4u*)(PREV + ((size_t)c * 8 + 4 * g + 2 * (hp_) + hd) * 8192 + p * 128 + n8 * 8); } } while (0)
#define S3_LOAD_Z(hp_) do { _Pragma("unroll") for (int k = 0; k < 4; ++k) { const int ch = tid + NTHREADS * k; const int l = ch >> 4, c8 = ch & 15; \
            zw[k] = *(const GAS v4u*)(PROJ + (size_t)(m0 + l) * PP + CZ + (4 * g + 2 * (hp_)) * 64 + c8 * 8); } } while (0)
#define S3_D1_LOAD_PZ(hp_) do { S3_LOAD_P(hp_); S3_LOAD_Z(hp_); } while (0)
    const int j = (wave < 4) ? (wave & 3) : 3 - (wave & 3), h2 = wave >> 2;
    f32x16 (&cbT)[4] = K.cbT; bf16x8_t (&cf)[8] = K.cf;
    { const XcdBarrier gb_ = GRP_OBJ(); xcd_barrier_hook(gb_, [&]() {
        ng_in = ssm_g[g * 256 + (tid & 255)];
        S3_LOAD_Z(0);
        ssd_ydiag(F, L, K, 1); }); }
    S3_LOAD_P(0);
    if (tid < 256) ng_l[tid] = ng_in;
    unsigned vk[2][16];
#pragma unroll
    for (int hp = 0; hp < 2; ++hp) {
        __syncthreads();
        {
#pragma unroll
          for (int k = 0; k < 4; ++k) { const int ch = tid + NTHREADS * k;
              { const int hd = ch >> 10, rem = ch & 1023, p = rem >> 4, n8 = rem & 15; *(LAS v4u*)(F.lds + S3_PV + hd * S3_PVH + p * SD_ROW + n8 * 16) = pw[k]; }
              { const int l = ch >> 4, c8 = ch & 15; *(LAS v4u*)(Zt + l * SD_ROW + c8 * 16) = zw[k]; } } }
        LDS_WAIT(); __syncthreads();
        asm volatile("" : "+v"(tid)); lane = tid & 63; q = lane & 31; hh = lane >> 5;
        const int r = 2 * hp + h2;
        const LAS unsigned char* P1 = F.lds + S3_PV + h2 * S3_PVH;
        f32x16 O[2] = {{}, {}};
#pragma unroll
        for (int ks = 0; ks < 8; ++ks)
#pragma unroll
            for (int pt = 0; pt < 2; ++pt) { const bf16x8_t af = *(const LAS bf16x8_t*)(P1 + (32 * pt + q) * SD_ROW + (16 * ks + 8 * hh) * 2);
                O[pt] = __builtin_amdgcn_mfma_f32_32x32x16_bf16(af, cf[ks], O[pt], 0, 0, 0); }
        { const float ea = __builtin_amdgcn_exp2f(acs_l[r * 128 + 32 * j + q]);
#pragma unroll
          for (int pt = 0; pt < 2; ++pt)
#pragma unroll
              for (int e = 0; e < 16; ++e) O[pt][e] = O[pt][e] * ea + K.Od[hp][pt][e]; }
        if (hp == 0) S3_D1_LOAD_PZ(1);
        float ss = 0.f;
#pragma unroll
        for (int pt = 0; pt < 2; ++pt)
#pragma unroll
            for (int g4 = 0; g4 < 4; ++g4) { const int p = 32 * pt + 8 * g4 + 4 * hh;
                const v2u zz = *(const LAS v2u*)(Zt + (32 * j + q) * SD_ROW + (64 * h2 + p) * 2);
                const float u0 = O[pt][4 * g4] * silu_fast(bflo(zz.x)), u1 = O[pt][4 * g4 + 1] * silu_fast(bfhi(zz.x)), u2 = O[pt][4 * g4 + 2] * silu_fast(bflo(zz.y)), u3 = O[pt][4 * g4 + 3] * silu_fast(bfhi(zz.y));
                ss += (u0 * u0 + u1 * u1) + (u2 * u2 + u3 * u3);
                vk[hp][pt * 8 + g4 * 2] = pkbf(u0, u1); vk[hp][pt * 8 + g4 * 2 + 1] = pkbf(u2, u3); }
        ss += shx(ss, 32, lane);
        if (hh == 0) rss[r * 128 + 32 * j + q] = ss;
    }
#undef S3_D1_LOAD_PZ
    LDS_WAIT(); __syncthreads();
    asm volatile("" : "+v"(tid)); lane = tid & 63; q = lane & 31; hh = lane >> 5;
    { const int l = 32 * j + q; const float tot = (rss[l] + rss[128 + l]) + (rss[256 + l] + rss[384 + l]);
      const float rn = __builtin_amdgcn_rsqf(tot * (1.0f / 256.0f) + EPS);
      LAS unsigned char* Ot = F.lds;
#pragma unroll
      for (int hp = 0; hp < 2; ++hp) { const int r = 2 * hp + h2;
#pragma unroll
          for (int pt = 0; pt < 2; ++pt)
#pragma unroll
              for (int g4 = 0; g4 < 4; ++g4) { const int p = 32 * pt + 8 * g4 + 4 * hh;
                  const f32x4 ng = *(const LAS f32x4*)(ng_l + r * 64 + p);
                  const unsigned w0 = vk[hp][pt * 8 + g4 * 2], w1 = vk[hp][pt * 8 + g4 * 2 + 1];
                  v2u w; w.x = pkbf(bflo(w0) * rn * ng.x, bfhi(w0) * rn * ng.y); w.y = pkbf(bflo(w1) * rn * ng.z, bfhi(w1) * rn * ng.w);
                  *(LAS v2u*)(Ot + l * 528 + (r * 64 + p) * 2) = w; } } }
    LDS_WAIT(); __syncthreads();
    asm volatile("" : "+v"(tid));
#pragma unroll
    for (int k = 0; k < 8; ++k) { const int ch = tid + NTHREADS * k, l = ch >> 5, c8 = ch & 31;
        const v4u w = *(const LAS v4u*)(F.lds + l * 528 + c8 * 16);
        GAS bf16* orow = PROJ + (size_t)(m0 + l) * PP + CZ;
        *(GAS v4u*)(orow + g * 256 + c8 * 8) = w; }
}

__device__ __forceinline__ void ph_inproj(Frame& F, int L) {
    LAS float* rstd_tab = (LAS float*)(F.lds + RSTD_OFF);
    int li_ = F.li; asm volatile("" : "+s"(li_)); pg8::GroupOrder S; S.init(NPROJ, li_);
    const GAS f32x4* sp = (const GAS f32x4*)((const GAS float*)FWS(WS_SSQ) + ((size_t)F.b * SEQ + (li_ & 7) * 256 + (F.tid >> 1)) * 16 + (F.tid & 1) * 8);
    pg8::Gemm g{(const GAS bf16*)FWS(WS_XB) + (size_t)F.b * SEQ * D, (const GAS bf16*)FWS(WS_WIN) + (size_t)L * NPROJ * D, SEQ, NPROJ, D, D};
    if (L > 0) {
        LAS unsigned char* ring = F.lds + RING_OFF;
        { const XcdBarrier gb_ = GRP_OBJ(); xcd_barrier_hook(gb_, [&]() { pg8::gemm_prefetch_b<true>(ring, g, S); }); }
        pg8::EpiProj E{(GAS bf16*)FB(BO_PROJ), (GAS float*)FWS(WS_DTRAW) + (size_t)F.b * SEQ * 8, rstd_tab, sp[0], sp[1]};
        pg8::gemm_phase<pg8::EpiProj, pg8::GroupOrder, true, true, 1>(ring, g, S, E);
        return; }
    pg8::EpiProj E{(GAS bf16*)FB(BO_PROJ), (GAS float*)FWS(WS_DTRAW) + (size_t)F.b * SEQ * 8, rstd_tab, sp[0], sp[1]};
    pg8::gemm_phase<pg8::EpiProj, pg8::GroupOrder, true, true>(F.lds + RING_OFF, g, S, E);
}
__device__ __forceinline__ void ph_outproj(Frame& F, int L, bool dummy = false) {
    int li_ = F.li; asm volatile("" : "+s"(li_)); pg8::GroupOrder S; S.init(D, li_);
    pg8::Gemm g{(const GAS bf16*)FB(BO_PROJ), (const GAS bf16*)FWS(WS_WOUT) + (size_t)L * D * D, SEQ, D, D, PP};
    GAS bf16* XBb = (GAS bf16*)FWS(WS_XB) + (size_t)F.b * SEQ * D;
    pg8::EpiRes<false> E{XBb, (GAS float*)FWS(WS_SSQ) + (size_t)F.b * SEQ * 16, nullptr, dummy ? (GAS bf16*)FB(BO_YPART) : XBb};
    if (dummy) { pg8::gemm_phase<pg8::EpiRes<false>, pg8::GroupOrder, false, true>(F.lds + RING_OFF, g, S, E); return; }
    pg8::u32x4 raw2[8]; LAS unsigned char* ring = F.lds + RING_OFF;
    { const XcdBarrier gb_ = GRP_OBJ(); xcd_barrier_hook(gb_, [&]() { pg8::gemm_prefetch_res(ring, g, S, E, raw2); }); }
    pg8::gemm_phase<pg8::EpiRes<false>, pg8::GroupOrder, false, true, 3>(ring, g, S, E, raw2);
}
__device__ __forceinline__ void ph_up(Frame& F, int L, int hot = 0) {
    LAS float* rstd_tab = (LAS float*)(F.lds + RSTD_OFF);
    int li_ = F.li; asm volatile("" : "+s"(li_)); pg8::GroupOrder S; S.init(FF, li_); S.hot = hot;
    const GAS f32x4* sp = (const GAS f32x4*)((const GAS float*)FWS(WS_SSQ) + ((size_t)F.b * SEQ + (li_ & 7) * 256 + (F.tid >> 1)) * 16 + (F.tid & 1) * 8);
    pg8::Gemm g{(const GAS bf16*)FWS(WS_XB) + (size_t)F.b * SEQ * D, (const GAS bf16*)FWS(WS_WUP) + (size_t)L * FF * D, SEQ, FF, D, D};
    if (hot) { pg8::EpiUp E{(GAS bf16*)FB(BO_HID), HIDP, rstd_tab, sp[0], sp[1]}; pg8::gemm_phase<pg8::EpiUp, pg8::GroupOrder, true, true>(F.lds + RING_OFF, g, S, E); return; }
    LAS unsigned char* ring = F.lds + RING_OFF;
    { const XcdBarrier gb_ = GRP_OBJ(); xcd_barrier_hook(gb_, [&]() { pg8::gemm_prefetch_b<true>(ring, g, S); }); }
    pg8::EpiUp E{(GAS bf16*)FB(BO_HID), HIDP, rstd_tab, sp[0], sp[1]};
    pg8::gemm_phase<pg8::EpiUp, pg8::GroupOrder, true, true, 1>(ring, g, S, E);
}
__device__ __forceinline__ void ph_down(Frame& F, int L, bool dummy = false, int hot = 0) {
    int li_ = F.li; asm volatile("" : "+s"(li_)); pg8::GroupOrder S; S.init(D, li_); S.hot = hot;
    pg8::Gemm g{(const GAS bf16*)FB(BO_HID), (const GAS bf16*)FWS(WS_WDOWN) + (size_t)L * D * FF, SEQ, D, FF, HIDP};
    GAS bf16* XBb = (GAS bf16*)FWS(WS_XB) + (size_t)F.b * SEQ * D; GAS float* SSQb = (GAS float*)FWS(WS_SSQ) + (size_t)F.b * SEQ * 16;
    pg8::u32x4 raw2[8]; LAS unsigned char* ring = F.lds + RING_OFF;
    if (dummy) { pg8::EpiRes<false> E{XBb, SSQb, nullptr, (GAS bf16*)FB(16 * MiB)}; pg8::gemm_phase<pg8::EpiRes<false>, pg8::GroupOrder, false, true>(ring, g, S, E); return; }
    if (L == DEPTH - 1) { pg8::EpiRes<true> E{XBb, SSQb, (GAS float*)ptr_at(F, I_OUT) + (size_t)F.b * SEQ * D, XBb};
        { const XcdBarrier gb_ = GRP_OBJ(); xcd_barrier_hook(gb_, [&]() { pg8::gemm_prefetch_res(ring, g, S, E, raw2); }); }
        pg8::gemm_phase<pg8::EpiRes<true>, pg8::GroupOrder, false, true, 3>(ring, g, S, E, raw2); }
    else { pg8::EpiRes<false> E{XBb, SSQb, nullptr, XBb};
        { const XcdBarrier gb_ = GRP_OBJ(); xcd_barrier_hook(gb_, [&]() { pg8::gemm_prefetch_res(ring, g, S, E, raw2); }); }
        pg8::gemm_phase<pg8::EpiRes<false>, pg8::GroupOrder, false, true, 3>(ring, g, S, E, raw2); }
}

#ifndef PROBE_REP
#define PROBE_REP 0
#endif
struct Args { const float* in[17]; float* out; unsigned char* ws; int pad0, pad1; };
__global__ void __launch_bounds__(NTHREADS, 2) fwd(Args args) {
    extern __shared__ __attribute__((aligned(16))) unsigned char lds[];
    Frame F;
    F.lds = (LAS unsigned char*)lds;
    F.tid = threadIdx.x; F.lane = F.tid & 63; F.wave = __builtin_amdgcn_readfirstlane(F.tid >> 6); F.bid = blockIdx.x; F.G = gridDim.x; F.b = F.bid & 7; F.li = F.bid >> 3;
    for (int u = F.tid; u < (LDS_BYTES - LDSCTL_OFF) / 4; u += NTHREADS) ((LAS unsigned*)(F.lds + LDSCTL_OFF))[u] = 0u;
    __syncthreads();
    if (F.tid < I_NPTR) { const unsigned long long p = F.tid < 17 ? (unsigned long long)args.in[F.tid < 17 ? F.tid : 0] : (F.tid == I_OUT ? (unsigned long long)args.out : (unsigned long long)args.ws);
        LAS unsigned* t = (LAS unsigned*)(F.lds + PTR_OFF) + 2 * F.tid; t[0] = (unsigned)p; t[1] = (unsigned)(p >> 32); }
    LDS_WAIT(); __syncthreads();
    if (F.G != GRID) return;
#define GBAR_OBJ() XcdBarrier{(unsigned*)(unsigned char*)FWS(WS_CTL) + CW_BAR, xb_xcc_id(), (unsigned)GRID, (volatile LAS unsigned*)(F.lds + MISC_OFF) + 8}
    (void)xcd_barrier_post((unsigned*)(unsigned char*)FWS(WS_CTL) + CW_GRP + (blockIdx.x & 7) * GRP_BAR_STRIDE, (volatile LAS unsigned*)(F.lds + MISC_OFF) + 12, GRP);
#define RELAUNDER() do { int t_ = threadIdx.x; asm volatile("" : "+v"(t_)); F.tid = t_; F.lane = t_ & 63; F.wave = __builtin_amdgcn_readfirstlane(t_ >> 6); \
    int b_ = blockIdx.x; asm volatile("" : "+s"(b_)); F.bid = b_; F.b = b_ & 7; F.li = b_ >> 3; } while (0)
#define GRP_BAR() do { const XcdBarrier gb_ = GRP_OBJ(); xcd_barrier(gb_); } while (0)
#define GRID_BAR() do { const XcdBarrier gb_ = GBAR_OBJ(); xcd_barrier(gb_); } while (0)

    if ((PROBE_REP >= 95 && PROBE_REP <= 97) && threadIdx.x == 0) *(volatile LAS unsigned*)(F.lds + 161288) = (unsigned)__builtin_amdgcn_s_memrealtime();
    p0_prologue(F);
#ifdef STAGGER_TICKS
    { const unsigned long long t0 = __builtin_amdgcn_s_memrealtime(); const int g_ = blockIdx.x & 7; const unsigned long long w = (unsigned long long)(STAGGER_TICKS);
      while (__builtin_amdgcn_s_memrealtime() - t0 < w) __builtin_amdgcn_s_sleep(2); }
#endif
    if (PROBE_REP == 95 && threadIdx.x == 0) *(volatile LAS unsigned*)(F.lds + 161280) = (unsigned)__builtin_amdgcn_s_memrealtime() - *(volatile LAS unsigned*)(F.lds + 161288);
    for (int L = 0; L < DEPTH; ++L) {
        RELAUNDER(); ph_inproj(F, L);
        if (F.li >= 16) { RELAUNDER(); convert_rest(F, L); }
        GRP_BAR();
        RELAUNDER(); attn_fast(F, L); ssd_states(F, L);
        SsdCarry carry;
        RELAUNDER(); ssd_cbt(F, carry);
        { const XcdBarrier gb_ = GRP_OBJ(); xcd_barrier_hook(gb_, [&]() { ssd_ydiag(F, L, carry, 0); }); }
        RELAUNDER(); ssd_scan(F, L);
        RELAUNDER(); ssd_out(F, L, carry);
        RELAUNDER(); wait_weights(F, L); ph_outproj(F, L);
        RELAUNDER(); ph_up(F, L);
        if (PROBE_REP == 98 && threadIdx.x == 0) *(volatile LAS unsigned*)(F.lds + 161288) = (unsigned)__builtin_amdgcn_s_memrealtime();
        RELAUNDER(); ph_down(F, L);
    }
#ifndef PROBE_WG
#define PROBE_WG 0
#endif
    if (PROBE_REP >= 80 && blockIdx.x == PROBE_WG && threadIdx.x == 0) {
        const unsigned dtk = *(volatile LAS unsigned*)(F.lds + 161280); const unsigned long long t0 = __builtin_amdgcn_s_memrealtime();
        while (__builtin_amdgcn_s_memrealtime() - t0 < 64ull * dtk) __builtin_amdgcn_s_sleep(4);
    }
    if (PROBE_REP == 7) {
        typedef float pf4 __attribute__((ext_vector_type(4))); typedef __bf16 pb8 __attribute__((ext_vector_type(8)));
        pf4 a0 = {0, 0, 0, 0}, a1 = a0, a2 = a0, a3 = a0; pb8 x, y;
        for (int e = 0; e < 8; ++e) { x[e] = (__bf16)(float)(F.tid & 3); y[e] = (__bf16)(float)(F.lane & 1); }
#pragma unroll 1
        for (int it = 0; it < 2500; ++it) {
            asm volatile("v_mfma_f32_16x16x32_bf16 %0, %4, %5, %0\n\tv_mfma_f32_16x16x32_bf16 %1, %4, %5, %1\n\tv_mfma_f32_16x16x32_bf16 %2, %4, %5, %2\n\tv_mfma_f32_16x16x32_bf16 %3, %4, %5, %3"
                         : "+v"(a0), "+v"(a1), "+v"(a2), "+v"(a3) : "v"(x), "v"(y));
        }
        const pf4 s = a0 + a1 + a2 + a3;
        if (s[0] + s[1] + s[2] + s[3] == 1.2345f) *((GAS float*)FWS(WS_CTL) + 100000) = s[0];
    }
}

extern "C" void kernel_launch(void* const* d_in, const int* in_sizes, int n_in, void* d_out, int out_size, void* d_ws, size_t ws_size, hipStream_t stream) {
    static int grid = 0;
    if (grid == 0) {
        if (n_in != 17 || in_sizes[0] != M * D || out_size != M * D || ws_size < WS_END) { fprintf(stderr, "kernel_launch: unexpected shapes (n_in %d, in0 %d, out %d, ws %zu)\n", n_in, n_in > 0 ? in_sizes[0] : -1, out_size, ws_size); grid = -1; return; }
        int dev = 0, cus = 0, per_cu = 0;
        if (hipGetDevice(&dev) != hipSuccess || hipDeviceGetAttribute(&cus, hipDeviceAttributeMultiprocessorCount, dev) != hipSuccess) { grid = -1; return; }
        if (hipFuncSetAttribute((const void*)fwd, hipFuncAttributeMaxDynamicSharedMemorySize, LDS_BYTES) != hipSuccess) { fprintf(stderr, "kernel_launch: hipFuncSetAttribute failed\n"); grid = -1; return; }
        if (hipOccupancyMaxActiveBlocksPerMultiprocessor(&per_cu, (const void*)fwd, NTHREADS, LDS_BYTES) != hipSuccess || per_cu < 1) { fprintf(stderr, "kernel_launch: occupancy query says %d\n", per_cu); per_cu = 0; }
        (void)hipGetLastError();
        if (cus * per_cu < GRID) { fprintf(stderr, "kernel_launch: this kernel needs %d co-resident workgroups (one per CU of a 256-CU device); the device admits %d x %d; nothing launched\n", GRID, cus, per_cu); grid = -1; return; }
        grid = GRID;
    }
    if (grid < 0) return;
    (void)hipMemsetAsync((char*)d_ws + WS_CTL, 0, CTL_ZERO_BYTES, stream);
    Args a{};
    for (int i = 0; i < 17; ++i) a.in[i] = (const float*)d_in[i];
    a.out = (float*)d_out; a.ws = (unsigned char*)d_ws;
    void* kargs[] = {&a};
    hipError_t e = hipLaunchCooperativeKernel((const void*)fwd, dim3(grid), dim3(NTHREADS), kargs, LDS_BYTES, stream);
    if (e != hipSuccess) fprintf(stderr, "kernel_launch: cooperative launch failed: %s (grid %d)\n", hipGetErrorString(e), grid);
}
```
